# Optimizing an MI355X kernel written in HIP

```python
import math
import jax, jax.numpy as jnp
from jax import lax
import numpy as np

D_MODEL = 1024
BATCH = 4
SEQ = 8192
DEPTH = 1

D_PLE = 256
D_MIX = D_MODEL
S5_WIDTH = D_MIX // 2
S5_GROUP = 16
S5_GROUPS = S5_WIDTH // S5_GROUP
S5_STATE = 64
RWKV_WIDTH = D_MIX - S5_WIDTH
RWKV_HEAD = 64
RWKV_HEADS = RWKV_WIDTH // RWKV_HEAD
D_IN = S5_WIDTH + 3 * RWKV_WIDTH
DECAY_LORA = 64
ICLR_LORA = 64
GATE_LORA = 128
RWKV_GN_EPS = 64e-5
N_EXPERTS = 32
TOP_K = 4
D_FF = D_MODEL
SWIGLU_LIMIT = 7.0
SWIGLU_ALPHA = 1.702
MOE_BLOCK = 256
RMS_EPS = 1e-6
LAMBDA_RE_MAX = -1e-4

kernel_name = 'hybrid_s5_rwkv7_moe_ple_layer'


def rms_norm(x, g):
    xf = x.astype(jnp.float32)
    y = xf * lax.rsqrt(jnp.mean(xf * xf, axis=-1, keepdims=True) + RMS_EPS)
    return (y * g.astype(jnp.float32)).astype(x.dtype)


def token_shift(t):
    return jnp.pad(t, ((0, 0), (1, 0), (0, 0)))[:, :-1]


def s5_mixer(u, lam_re, lam_im, log_dt, b_re, b_im, c_re, c_im, d_skip, w_glu):
    f32 = jnp.float32
    bsz, seq, _ = u.shape
    uf = u.astype(f32)
    ug = uf.reshape(bsz, seq, S5_GROUPS, S5_GROUP)
    lre = jnp.minimum(lam_re.astype(f32), LAMBDA_RE_MAX)
    lim = lam_im.astype(f32)
    dt = jnp.exp(log_dt.astype(f32))[:, None]
    mag = jnp.exp(lre * dt)
    lb_re = mag * jnp.cos(lim * dt)
    lb_im = mag * jnp.sin(lim * dt)
    den = lre * lre + lim * lim
    z_re = lb_re - 1.0
    coef_re = ((z_re * lre + lb_im * lim) / den)[..., None]
    coef_im = ((lb_im * lre - z_re * lim) / den)[..., None]
    b_re = b_re.astype(f32)
    b_im = b_im.astype(f32)
    bb_re = coef_re * b_re - coef_im * b_im
    bb_im = coef_re * b_im + coef_im * b_re
    bu_re = jnp.einsum('bsgc,gpc->bsgp', ug, bb_re)
    bu_im = jnp.einsum('bsgc,gpc->bsgp', ug, bb_im)
    a_re = jnp.broadcast_to(lb_re, bu_re.shape)
    a_im = jnp.broadcast_to(lb_im, bu_im.shape)

    def combine(e1, e2):
        a1r, a1i, b1r, b1i = e1
        a2r, a2i, b2r, b2i = e2
        return (a2r * a1r - a2i * a1i,
                a2r * a1i + a2i * a1r,
                a2r * b1r - a2i * b1i + b2r,
                a2r * b1i + a2i * b1r + b2i)

    _, _, xs_re, xs_im = lax.associative_scan(combine, (a_re, a_im, bu_re, bu_im), axis=1)
    y = (jnp.einsum('bsgp,gcp->bsgc', xs_re, c_re.astype(f32))
         - jnp.einsum('bsgp,gcp->bsgc', xs_im, c_im.astype(f32)))
    y = y.reshape(bsz, seq, S5_WIDTH) + d_skip.astype(f32) * uf
    y = jax.nn.gelu(y)
    y = y * jax.nn.sigmoid(y @ w_glu.astype(f32))
    return y.astype(u.dtype)


def rwkv7_step(state, inp):
    r_t, w_t, k_t, v_t, neg_kk_t, kka_t = inp
    sa = jnp.einsum('bhvk,bhk->bhv', state, neg_kk_t)
    state = (state * w_t[:, :, None, :]
             + sa[..., None] * kka_t[:, :, None, :]
             + v_t[..., None] * k_t[:, :, None, :])
    return state, jnp.einsum('bhvk,bhk->bhv', state, r_t)


def rwkv7_mixer(h, r, k, v, mu_rkv, mu_wag, w0, w1, w2, a0, a1, a2, g1, g2,
                k_k, k_a, r_k, ln_w, ln_b):
    f32 = jnp.float32
    bsz, seq, _ = h.shape
    hf = h.astype(f32)
    dh = token_shift(hf) - hf
    xw = hf + dh * mu_wag[0]
    xa = hf + dh * mu_wag[1]
    xg = hf + dh * mu_wag[2]
    r = r.astype(f32)
    k = k.astype(f32)
    v = v.astype(f32)
    r = r + (token_shift(r) - r) * mu_rkv[0]
    k = k + (token_shift(k) - k) * mu_rkv[1]
    v = v + (token_shift(v) - v) * mu_rkv[2]
    w_log = -jax.nn.softplus(-(w0 + jnp.tanh(xw @ w1) @ w2)) - 0.5
    decay = jnp.exp(-jnp.exp(w_log))
    a = jax.nn.sigmoid(a0 + (xa @ a1) @ a2)
    g = jax.nn.sigmoid(xg @ g1) @ g2

    def heads(t):
        return t.reshape(bsz, seq, RWKV_HEADS, RWKV_HEAD)

    kk = heads(k * k_k)
    kk = kk / jnp.maximum(jnp.sqrt(jnp.sum(kk * kk, axis=-1, keepdims=True)), 1e-12)
    k = k * (1.0 + (a - 1.0) * k_a)
    rh, kh, vh, wh, ah = heads(r), heads(k), heads(v), heads(decay), heads(a)

    def seq_first(t):
        return jnp.moveaxis(t, 1, 0)

    state0 = jnp.zeros((bsz, RWKV_HEADS, RWKV_HEAD, RWKV_HEAD), f32)
    _, ys = lax.scan(rwkv7_step, state0,
                     (seq_first(rh), seq_first(wh), seq_first(kh), seq_first(vh),
                      seq_first(-kk), seq_first(kk * ah)))
    y = jnp.moveaxis(ys, 0, 1)
    mean = jnp.mean(y, axis=-1, keepdims=True)
    var = jnp.mean(jnp.square(y - mean), axis=-1, keepdims=True)
    yn = ((y - mean) * lax.rsqrt(var + RWKV_GN_EPS)).reshape(bsz, seq, RWKV_WIDTH)
    yn = yn * ln_w + ln_b
    bonus = jnp.sum(rh * kh * r_k, axis=-1, keepdims=True) * vh
    out = (yn + bonus.reshape(bsz, seq, RWKV_WIDTH)) * g
    return out.astype(h.dtype)


def moe_ffn(h, router_w, router_b, w_gate, b_gate, w_up, b_up, w_down, b_down):
    f32 = jnp.float32
    bsz, seq, dm = h.shape
    n_tok = bsz * seq
    hf = h.reshape(n_tok, dm)
    logits = (hf @ router_w).astype(f32) + router_b.astype(f32)
    top_v, top_i = lax.top_k(logits, TOP_K)
    gates = jax.nn.softmax(top_v, axis=-1)
    m = n_tok * TOP_K
    e_flat = top_i.reshape(m)
    tok_flat = jnp.repeat(jnp.arange(n_tok, dtype=jnp.int32), TOP_K)
    g_flat = gates.reshape(m)
    order = jnp.argsort(e_flat)
    e_s = e_flat[order]
    tok_s = tok_flat[order]
    g_s = g_flat[order]
    counts = jnp.bincount(e_flat, length=N_EXPERTS)
    starts = jnp.cumsum(counts) - counts
    padded = ((counts + MOE_BLOCK - 1) // MOE_BLOCK) * MOE_BLOCK
    pends = jnp.cumsum(padded)
    pstarts = pends - padded
    dest = pstarts[e_s] + (jnp.arange(m) - starts[e_s])
    n_blocks = (m + MOE_BLOCK - 1) // MOE_BLOCK + N_EXPERTS
    m_pad = n_blocks * MOE_BLOCK
    tok_pad = jnp.zeros((m_pad,), jnp.int32).at[dest].set(tok_s)
    g_pad = jnp.zeros((m_pad,), f32).at[dest].set(g_s)
    block_e = jnp.minimum(
        jnp.searchsorted(pends, jnp.arange(n_blocks) * MOE_BLOCK, side='right'),
        N_EXPERTS - 1)

    def run_block(args):
        e, toks, gw = args
        xb = hf[toks]
        gt = jnp.minimum(xb @ w_gate[e] + b_gate[e], SWIGLU_LIMIT)
        up = jnp.clip(xb @ w_up[e] + b_up[e], -SWIGLU_LIMIT, SWIGLU_LIMIT)
        act = (up + 1.0) * gt * jax.nn.sigmoid(SWIGLU_ALPHA * gt)
        yb = act @ w_down[e] + b_down[e]
        return yb.astype(f32) * gw[:, None]

    ys = lax.map(run_block, (block_e, tok_pad.reshape(n_blocks, MOE_BLOCK),
                             g_pad.reshape(n_blocks, MOE_BLOCK)))
    out = jnp.zeros((n_tok, dm), f32).at[tok_pad].add(ys.reshape(m_pad, dm))
    return out.reshape(bsz, seq, dm).astype(h.dtype)


def setup_inputs(seed: int = 0) -> dict:
    key = jax.random.key(seed)
    ks = iter(jax.random.split(key, 64))
    f32 = jnp.float32
    L, D = DEPTH, D_MODEL

    def nrm(shape, scale):
        return jax.random.normal(next(ks), shape, f32) * scale

    def unif(shape, lo, hi):
        return jax.random.uniform(next(ks), shape, f32, lo, hi)

    lam_im = jnp.broadcast_to(jnp.pi * jnp.arange(S5_STATE, dtype=f32), (L, S5_GROUPS, S5_STATE))
    return {
        'x': nrm((BATCH, SEQ, D), 1.0),
        'p': nrm((DEPTH, BATCH, SEQ, D_PLE), 1.0),
        'norm_mix_g': 1.0 + nrm((L, D), 0.02),
        'w_in': nrm((L, D, D_IN), D ** -0.5),
        's5_lam_re': -0.5 + nrm((L, S5_GROUPS, S5_STATE), 0.01),
        's5_lam_im': lam_im,
        's5_log_dt': unif((L, S5_GROUPS), math.log(1e-3), math.log(1e-1)),
        's5_b_re': nrm((L, S5_GROUPS, S5_STATE, S5_GROUP), (2 * S5_GROUP) ** -0.5),
        's5_b_im': nrm((L, S5_GROUPS, S5_STATE, S5_GROUP), (2 * S5_GROUP) ** -0.5),
        's5_c_re': nrm((L, S5_GROUPS, S5_GROUP, S5_STATE), (2 * S5_STATE) ** -0.5),
        's5_c_im': nrm((L, S5_GROUPS, S5_GROUP, S5_STATE), (2 * S5_STATE) ** -0.5),
        's5_d': nrm((L, S5_WIDTH), 1.0),
        's5_w_glu': nrm((L, S5_WIDTH, S5_WIDTH), S5_WIDTH ** -0.5),
        'rwkv_mu_rkv': unif((L, 3, RWKV_WIDTH), 0.2, 0.8),
        'rwkv_mu_wag': unif((L, 3, D), 0.2, 0.8),
        'rwkv_w0': unif((L, RWKV_WIDTH), -6.0, -1.0),
        'rwkv_w1': nrm((L, D, DECAY_LORA), D ** -0.5),
        'rwkv_w2': nrm((L, DECAY_LORA, RWKV_WIDTH), 0.5 * DECAY_LORA ** -0.5),
        'rwkv_a0': nrm((L, RWKV_WIDTH), 0.1),
        'rwkv_a1': nrm((L, D, ICLR_LORA), D ** -0.5),
        'rwkv_a2': nrm((L, ICLR_LORA, RWKV_WIDTH), 0.5 * ICLR_LORA ** -0.5),
        'rwkv_g1': nrm((L, D, GATE_LORA), D ** -0.5),
        'rwkv_g2': nrm((L, GATE_LORA, RWKV_WIDTH), GATE_LORA ** -0.5),
        'rwkv_k_k': 0.85 + nrm((L, RWKV_WIDTH), 0.02),
        'rwkv_k_a': 1.0 + nrm((L, RWKV_WIDTH), 0.02),
        'rwkv_r_k': nrm((L, RWKV_HEADS, RWKV_HEAD), 0.1),
        'rwkv_ln_w': 1.0 + nrm((L, RWKV_WIDTH), 0.02),
        'rwkv_ln_b': nrm((L, RWKV_WIDTH), 0.02),
        'w_out': nrm((L, D_MIX, D), D_MIX ** -0.5),
        'norm_moe_g': 1.0 + nrm((L, D), 0.02),
        'router_w': nrm((L, D, N_EXPERTS), D ** -0.5),
        'router_b': nrm((L, N_EXPERTS), 0.01),
        'exp_w_gate': nrm((L, N_EXPERTS, D, D_FF), D ** -0.5),
        'exp_b_gate': nrm((L, N_EXPERTS, D_FF), 0.01),
        'exp_w_up': nrm((L, N_EXPERTS, D, D_FF), D ** -0.5),
        'exp_b_up': nrm((L, N_EXPERTS, D_FF), 0.01),
        'exp_w_down': nrm((L, N_EXPERTS, D_FF, D), D_FF ** -0.5),
        'exp_b_down': nrm((L, N_EXPERTS, D), 0.01),
        'norm_ple_g': 1.0 + nrm((L, D), 0.02),
        'ple_w_proj': nrm((L, D_PLE, D), D_PLE ** -0.5),
        'ple_w_gate': nrm((L, D, D), D ** -0.5),
        'final_norm_g': 1.0 + nrm((D,), 0.02),
    }


def reference(x, p, norm_mix_g, w_in, s5_lam_re, s5_lam_im, s5_log_dt, s5_b_re, s5_b_im,
              s5_c_re, s5_c_im, s5_d, s5_w_glu, rwkv_mu_rkv, rwkv_mu_wag, rwkv_w0, rwkv_w1,
              rwkv_w2, rwkv_a0, rwkv_a1, rwkv_a2, rwkv_g1, rwkv_g2, rwkv_k_k, rwkv_k_a,
              rwkv_r_k, rwkv_ln_w, rwkv_ln_b, w_out, norm_moe_g, router_w, router_b,
              exp_w_gate, exp_b_gate, exp_w_up, exp_b_up, exp_w_down, exp_b_down,
              norm_ple_g, ple_w_proj, ple_w_gate, final_norm_g):
    r0 = S5_WIDTH
    k0 = r0 + RWKV_WIDTH
    v0 = k0 + RWKV_WIDTH
    for i in range(DEPTH):
        h = rms_norm(x, norm_mix_g[i])
        proj = h @ w_in[i]
        y_s5 = s5_mixer(proj[..., :r0], s5_lam_re[i], s5_lam_im[i], s5_log_dt[i],
                        s5_b_re[i], s5_b_im[i], s5_c_re[i], s5_c_im[i], s5_d[i], s5_w_glu[i])
        y_rwkv = rwkv7_mixer(h, proj[..., r0:k0], proj[..., k0:v0], proj[..., v0:],
                             rwkv_mu_rkv[i], rwkv_mu_wag[i], rwkv_w0[i], rwkv_w1[i], rwkv_w2[i],
                             rwkv_a0[i], rwkv_a1[i], rwkv_a2[i], rwkv_g1[i], rwkv_g2[i],
                             rwkv_k_k[i], rwkv_k_a[i], rwkv_r_k[i], rwkv_ln_w[i], rwkv_ln_b[i])
        x = x + jnp.concatenate([y_s5, y_rwkv], axis=-1) @ w_out[i]
        x = x + moe_ffn(rms_norm(x, norm_moe_g[i]), router_w[i], router_b[i],
                        exp_w_gate[i], exp_b_gate[i], exp_w_up[i], exp_b_up[i],
                        exp_w_down[i], exp_b_down[i])
        gate = jax.nn.sigmoid(rms_norm(x, norm_ple_g[i]) @ ple_w_gate[i])
        x = x + (p[i] @ ple_w_proj[i]) * gate
    return rms_norm(x, final_norm_g)
```

```cpp
#include <hip/hip_runtime.h>
#include <cstdio>
#include <cstdint>

#ifndef MK_PER_PHASE
#define MK_PER_PHASE 0
#endif

#define LAS __attribute__((address_space(3)))
#define GAS __attribute__((address_space(1)))
typedef unsigned short bf16;
typedef short bf16x8 __attribute__((ext_vector_type(8)));
typedef float f32x4 __attribute__((ext_vector_type(4)));
typedef float f32x2 __attribute__((ext_vector_type(2)));
typedef unsigned u32x4 __attribute__((ext_vector_type(4)));
typedef unsigned u32x2 __attribute__((ext_vector_type(2)));
typedef GAS unsigned gu32;

constexpr int NB = 4, SEQ = 8192, DM = 1024, M = NB * SEQ;
constexpr int NEXP = 32, TOPK = 4;
constexpr int NWAVES = 8, NTHR = 512;
constexpr size_t MiB = 1u << 20;

constexpr size_t WS_CTL = 0, CTL_ZERO_BYTES = 1 * MiB;
constexpr size_t WS_HIST = 1 * MiB;
constexpr size_t WS_TOPE = 2 * MiB;
constexpr size_t WS_TOPG = 3 * MiB;
constexpr size_t WS_TOKSLOT = 4 * MiB;
constexpr size_t WS_SLOTTOK = 5 * MiB;
constexpr size_t WS_AT = 6 * MiB;
constexpr size_t WS_DL = 6 * MiB + 65536;
constexpr size_t WS_WCAT = 8 * MiB;
constexpr size_t WS_WL2 = 13 * MiB;
constexpr size_t WS_WGLU = 14 * MiB;
constexpr size_t WS_WPP = 14 * MiB + 524288;
constexpr size_t WS_WOUT = 15 * MiB;
constexpr size_t WS_WPG = 17 * MiB;
constexpr size_t WS_S5BT = 19 * MiB;
constexpr size_t WS_S5ET = 39 * MiB;
constexpr size_t WS_PBF = 48 * MiB;
constexpr size_t WS_R1 = 64 * MiB;
constexpr size_t WS_RKV = 128 * MiB;
constexpr size_t WS_WAG = 224 * MiB;
constexpr size_t WS_AG = 320 * MiB;
constexpr size_t WS_U = 360 * MiB;
constexpr size_t WS_LP = 392 * MiB;
constexpr size_t WS_LACT = 424 * MiB;
constexpr size_t WS_W1 = 440 * MiB;
constexpr size_t WS_ULOC = 472 * MiB;
constexpr size_t WS_Y1 = 504 * MiB;
constexpr size_t WS_H2 = WS_R1;
constexpr size_t WS_WGU = 128 * MiB;
constexpr size_t WS_WDN = 192 * MiB;
constexpr size_t WS_ACT = 224 * MiB;
constexpr size_t WS_Y = 392 * MiB;
constexpr int RMAX = 86016;
constexpr int MAXEPP = 16;
constexpr size_t WS_PP = 128 * MiB;
constexpr size_t WS_END = 560 * MiB;
static_assert(WS_Y + (size_t)RMAX * 2048 <= WS_END && WS_ACT + (size_t)RMAX * 2048 <= WS_Y, "moe map");

constexpr int CW_BAR = 4096;

constexpr int LDS_PLAN = 147456;
constexpr int LDS_MISC = 155648;
constexpr int LDS_BYTES = 156672;
constexpr int PL_CNT = 0, PL_PSTART = 32, PL_NPASS = 72, PL_PE0 = 80, PL_PROW0 = 88, PL_TILEE = 128, PL_TMP = 768;

#define LDS_WAIT() asm volatile("s_waitcnt lgkmcnt(0)" ::: "memory")
#define VM_WAIT() asm volatile("s_waitcnt vmcnt(0)" ::: "memory")
__device__ __forceinline__ float bf2f(unsigned b) { return __uint_as_float(b << 16); }
typedef __bf16 bf16n2 __attribute__((ext_vector_type(2)));
__device__ __forceinline__ unsigned cvt_pk_bf16(float lo, float hi) { const f32x2 f = {lo, hi}; const bf16n2 v = __builtin_convertvector(f, bf16n2); return __builtin_bit_cast(unsigned, v); }
__device__ __forceinline__ unsigned pk2(float lo, float hi) { return cvt_pk_bf16(lo, hi); }
__device__ __forceinline__ float lo16(unsigned w) { return __uint_as_float(w << 16); }
__device__ __forceinline__ float hi16(unsigned w) { return __uint_as_float(w & 0xffff0000u); }
__device__ __forceinline__ float frcp(float x) { return __builtin_amdgcn_rcpf(x); }
__device__ __forceinline__ float fsigmoid(float x) { return frcp(1.0f + __expf(-x)); }
__device__ __forceinline__ float ftanh(float x) { const float e = __expf(-2.0f * fabsf(x)); const float t = (1.0f - e) * frcp(1.0f + e); return x < 0.f ? -t : t; }
__device__ __forceinline__ float gelu_tanh(float x) { const float u = 0.7978845608f * (x + 0.044715f * x * x * x); return 0.5f * x * (1.0f + ftanh(u)); }
__device__ __forceinline__ float wave_sum(float v) {
#pragma unroll
    for (int o = 1; o < 64; o <<= 1) v += __shfl_xor(v, o);
    return v;
}
__device__ __forceinline__ float wave_max(float v) {
#pragma unroll
    for (int o = 1; o < 64; o <<= 1) v = fmaxf(v, __shfl_xor(v, o));
    return v;
}

#define XB_TMO      128
#define XB_XCNT(j)  (256  + 64 * (j))
#define XB_XSUB(j)  (1280 + 64 * (j))
#define XB_XGEN(j)  (2304 + 64 * (j))
#define XB_TOP      3328
#define XB_TOPGEN   3392
#define XCD_BAR_WORDS 3456
#define XB_SPIN_CAP (1u << 22)

__device__ __forceinline__ unsigned xb_ld(unsigned* p)              { return __hip_atomic_load(p, __ATOMIC_RELAXED, __HIP_MEMORY_SCOPE_AGENT); }
__device__ __forceinline__ unsigned xb_add(unsigned* p, unsigned v) { return __hip_atomic_fetch_add(p, v, __ATOMIC_RELAXED, __HIP_MEMORY_SCOPE_AGENT); }
__device__ __forceinline__ unsigned xb_xcc_id() { return (unsigned)__builtin_amdgcn_s_getreg((3 << 11) | 20) & 0xFu; }
#define XB_SPIN(cond, bar) do { unsigned _sp = 0; while (cond) { __builtin_amdgcn_s_sleep(1); \
    if ((++_sp & 255u) == 0u) { if (xb_ld(&(bar)[XB_TMO])) break; if (_sp > XB_SPIN_CAP) { atomicAdd(&(bar)[XB_TMO], 1u); break; } } } } while (0)

struct XcdBarrier { unsigned* bar; unsigned x; volatile LAS unsigned* st; };

__device__ __forceinline__ XcdBarrier xcd_barrier_post(unsigned* bar, volatile LAS unsigned* st) {
    XcdBarrier b; b.bar = bar; b.x = xb_xcc_id(); b.st = st;
    if (threadIdx.x == 0) (void)xb_add(&bar[XB_XCNT(b.x)], 1u);
    return b;
}
__device__ __forceinline__ void xcd_barrier_complete(unsigned* bar, unsigned x, unsigned& nloc, unsigned& nx) {
    const unsigned G = gridDim.x * gridDim.y * gridDim.z;
    unsigned sum, cnt, mine, sp = 0u;
    for (;;) {
        sum = 0u; cnt = 0u; mine = 0u;
#pragma unroll
        for (unsigned j = 0; j < 16; ++j) { const unsigned c = xb_ld(&bar[XB_XCNT(j)]); sum += c; cnt += (c > 0u) ? 1u : 0u; mine = (j == x) ? c : mine; }
        if (sum == G) break;
        __builtin_amdgcn_s_sleep(1);
        if ((++sp & 255u) == 0u) { if (xb_ld(&bar[XB_TMO])) break; if (sp > XB_SPIN_CAP) { atomicAdd(&bar[XB_TMO], 1u); break; } }
    }
    nloc = mine > 0u ? mine : 1u; nx = cnt > 0u ? cnt : 1u;
}
__device__ __forceinline__ void xcd_barrier(const XcdBarrier& b) {
    asm volatile("s_waitcnt vmcnt(0)" ::: "memory");
    __syncthreads();
    if (threadIdx.x == 0) {
        unsigned* bar = b.bar;
        __builtin_amdgcn_s_waitcnt(0);
        unsigned nloc = b.st[0], nx = b.st[1];
        if (nloc == 0u) { xcd_barrier_complete(bar, b.x, nloc, nx); b.st[0] = nloc; b.st[1] = nx; }
        const unsigned old = xb_add(&bar[XB_XSUB(b.x)], 1u);
        const unsigned gen = old / nloc;
        if (old + 1u == (gen + 1u) * nloc) {
            __builtin_amdgcn_fence(__ATOMIC_RELEASE, "agent");
            asm volatile("s_waitcnt vmcnt(0)" ::: "memory");
            const unsigned og = xb_add(&bar[XB_TOP], 1u);
            const unsigned tg = og / nx;
            if (og + 1u == (tg + 1u) * nx) xb_add(&bar[XB_TOPGEN], 1u);
            else XB_SPIN(xb_ld(&bar[XB_TOPGEN]) == tg, bar);
            __builtin_amdgcn_fence(__ATOMIC_ACQUIRE, "agent");
            xb_add(&bar[XB_XGEN(b.x)], 1u);
            asm volatile("s_waitcnt vmcnt(0)" ::: "memory");
        } else {
            XB_SPIN(xb_ld(&bar[XB_XGEN(b.x)]) == gen, bar);
            __builtin_amdgcn_fence(__ATOMIC_ACQUIRE, "agent");
            asm volatile("s_waitcnt vmcnt(0)" ::: "memory");
        }
    }
    __syncthreads();
}

namespace pg8 {
constexpr int BM = 256, BK = 64, HALF = 128, HTB = HALF * BK * 2, STAGE_BYTES = 8 * HTB, NXCD = 8, WGM = 8;
__host__ __device__ __forceinline__ int lds_byte(int r, int c) { const int st = (r >> 4) * 2 + (c >> 5), rr = r & 15, cc = c & 31, ob = rr * 64 + cc * 2; return st * 1024 + (ob ^ (((ob >> 9) & 1) << 5)); }
__host__ __device__ __forceinline__ void stage_rc(int b, int& R, int& C) { const int st = b / 1024, sb = b % 1024, swz = sb ^ (((sb >> 9) & 1) << 5); R = (st >> 1) * 16 + swz / 64; C = (st & 1) * 32 + (swz % 64) / 2; }
__host__ __device__ __forceinline__ int perm32(int rho) { const int n = rho >> 4, i = rho & 15; return 8 * (i >> 2) + 4 * n + (i & 3); }

struct Unit { int pm, pn, aux; };

struct Order {
    int nM, nN, nwg, G, c;
    __device__ __forceinline__ void init(int nM_, int nN_, int G_, int c_) { nM = nM_; nN = nN_; nwg = nM * nN; G = G_; c = c_; }
    __device__ __forceinline__ bool tile(int i, int& pm, int& pn) const {
        const long L = (long)i * G + c; if (L >= nwg) return false;
        int wgid = (int)L; { const int q = nwg / NXCD, r = nwg % NXCD, xcd = wgid % NXCD, off = wgid / NXCD; wgid = (xcd < r ? xcd * (q + 1) : r * (q + 1) + (xcd - r) * q) + off; }
        const int nig = WGM * nN, gid = wgid / nig, fm = gid * WGM, gsz = (nM - fm) < WGM ? (nM - fm) : WGM;
        pm = fm + ((wgid % nig) % gsz); pn = (wgid % nig) / gsz; return true;
    }
};


template <class Epi, class Sched, bool ALIGN_EPI, bool SP2, bool GATHER>
__device__ __forceinline__ void gemm_phase(LAS unsigned char* lds, const int tid, const int K, const int lda, const int ldb, const Sched& S, const Epi& E) {
    const int wid = __builtin_amdgcn_readfirstlane(tid >> 6), lane = tid & 63, wr = wid >> 2, wc = wid & 3, fr = lane & 15, fq = lane >> 4;
    const int nt = K / BK;
    unsigned voffA[2], voffB[2]; int rA[2], cA2[2];
#pragma unroll
    for (int i = 0; i < 2; ++i) { int R, C; stage_rc(tid * 16 + i * 8192, R, C); const int Rb = Epi::PERM ? ((R & ~31) + perm32(R & 31)) : R;
        voffA[i] = (unsigned)(R * lda + C) * 2u; voffB[i] = (unsigned)(Rb * ldb + C) * 2u; rA[i] = R; cA2[i] = C * 2; }
    const size_t kstep = (size_t)(BK * 2);
    const size_t hstepA = (size_t)HALF * lda * 2, hstepB = (size_t)HALF * ldb * 2;
    const unsigned ldsw = (unsigned)wid * 1024u;
    const int aoff = lds_byte(wr * 64 + fr, fq * 8), boff = lds_byte(wc * 32 + fr, fq * 8);
    unsigned cv0[2] = {0u, 0u}, cv1[2] = {0u, 0u}, nv0[2] = {0u, 0u}, nv1[2] = {0u, 0u};
#define PG8_SA(b, h) (((b) * 2 + (h)) * HTB)
#define PG8_SB(b, h) ((4 + (b) * 2 + (h)) * HTB)
#define PG8_STAGE(bufoff, gbase, voff) do { _Pragma("unroll") for (int _i = 0; _i < 2; ++_i) \
        __builtin_amdgcn_global_load_lds((const unsigned*)((const char*)(gbase) + (voff)[_i]), (LAS unsigned*)(lds + (bufoff) + ldsw + _i * 8192), 16, 0, 0); } while (0)
#define PG8_STAGE_A(bufoff, ptr, h, nx) do { if constexpr (GATHER) { unsigned _v[2]; _v[0] = (nx) ? ((h) ? nv1[0] : nv0[0]) : ((h) ? cv1[0] : cv0[0]); _v[1] = (nx) ? ((h) ? nv1[1] : nv0[1]) : ((h) ? cv1[1] : cv0[1]); PG8_STAGE(bufoff, ptr, _v); } \
        else { PG8_STAGE(bufoff, (ptr) + (h) * hstepA, voffA); } } while (0)
#define PG8_LDA(dst, b, h) do { _Pragma("unroll") for (int m = 0; m < 4; ++m) _Pragma("unroll") for (int k = 0; k < 2; ++k) dst[m][k] = *(const LAS bf16x8*)(lds + PG8_SA(b, h) + aoff + m * 2048 + k * 1024); } while (0)
#define PG8_LDB(dst, b, h) do { _Pragma("unroll") for (int n = 0; n < 2; ++n) _Pragma("unroll") for (int k = 0; k < 2; ++k) dst[n][k] = *(const LAS bf16x8*)(lds + PG8_SB(b, h) + boff + n * 2048 + k * 1024); } while (0)
#define PG8_MMA(ai, bj, At, Bt) do { __builtin_amdgcn_s_setprio(1); _Pragma("unroll") for (int m = 0; m < 4; ++m) _Pragma("unroll") for (int n = 0; n < 2; ++n) _Pragma("unroll") for (int k = 0; k < 2; ++k) \
        acc[ai][bj][m][n] = __builtin_amdgcn_mfma_f32_16x16x32_bf16(Bt[n][k], At[m][k], acc[ai][bj][m][n], 0, 0, 0); __builtin_amdgcn_s_setprio(0); } while (0)
#define PG8_WAIT_V(n) asm volatile("s_waitcnt vmcnt(" #n ")" ::: "memory")
#define PG8_WAIT_L(n) asm volatile("s_waitcnt lgkmcnt(" #n ")" ::: "memory")
#define PG8_BAR __builtin_amdgcn_s_barrier()
#define PG8_SCHED __builtin_amdgcn_sched_barrier(0)
#define PG8_ROWS(u, d0, d1) do { _Pragma("unroll") for (int _i = 0; _i < 2; ++_i) { const int _r0 = S.a_row(u, rA[_i]), _r1 = S.a_row(u, HALF + rA[_i]); \
        d0[_i] = (unsigned)_r0 * (unsigned)(lda * 2) + (unsigned)cA2[_i]; d1[_i] = (unsigned)_r1 * (unsigned)(lda * 2) + (unsigned)cA2[_i]; } } while (0)
    Unit cur, nxt; int ui = 0;
    if (!S.next(0, cur)) return;
    f32x4 acc[2][2][4][2];
#pragma unroll
    for (int a = 0; a < 2; ++a)
#pragma unroll
        for (int b = 0; b < 2; ++b)
#pragma unroll
            for (int m = 0; m < 4; ++m)
#pragma unroll
                for (int n = 0; n < 2; ++n) acc[a][b][m][n] = (f32x4){0.f, 0.f, 0.f, 0.f};
    bf16x8 At[4][2], B0[2][2], B1[2][2];
    const char* cA = S.a_ptr(cur); const char* cB = S.b_ptr(cur);
    if constexpr (GATHER) { PG8_ROWS(cur, cv0, cv1); }
    if constexpr (SP2) {
        PG8_STAGE(PG8_SB(0, 0), cB, voffB); PG8_STAGE(PG8_SB(0, 1), cB + hstepB, voffB); PG8_STAGE_A(PG8_SA(0, 0), cA, 0, false); PG8_STAGE_A(PG8_SA(0, 1), cA, 1, false);
        if (wr == 1) PG8_BAR;
        PG8_WAIT_V(2); PG8_BAR;
        PG8_STAGE(PG8_SB(1, 0), cB + kstep, voffB); PG8_STAGE_A(PG8_SA(1, 0), cA + kstep, 0, false); PG8_STAGE(PG8_SB(1, 1), cB + hstepB + kstep, voffB);
        PG8_WAIT_V(6); PG8_BAR;
    } else {
        PG8_STAGE(PG8_SB(0, 0), cB, voffB); PG8_STAGE_A(PG8_SA(0, 0), cA, 0, false); PG8_STAGE(PG8_SB(0, 1), cB + hstepB, voffB); PG8_STAGE_A(PG8_SA(0, 1), cA, 1, false);
        if (wr == 1) PG8_BAR;
        PG8_WAIT_V(4); PG8_BAR;
        PG8_STAGE(PG8_SB(1, 0), cB + kstep, voffB); PG8_STAGE_A(PG8_SA(1, 0), cA + kstep, 0, false); PG8_STAGE(PG8_SB(1, 1), cB + hstepB + kstep, voffB);
        PG8_WAIT_V(6); PG8_BAR;
    }
    for (;;) {
        const bool has_next = S.next(ui + 1, nxt);
        const char* nA = has_next ? S.a_ptr(nxt) : cA; const char* nB = has_next ? S.b_ptr(nxt) : cB;
        if constexpr (GATHER) { if (has_next) { PG8_ROWS(nxt, nv0, nv1); } else { nv0[0] = cv0[0]; nv0[1] = cv0[1]; nv1[0] = cv1[0]; nv1[1] = cv1[1]; } }
        for (int t = 0; t < nt; t += 2) {
            const bool last = (t == nt - 2);
            const char* a1 = cA + (size_t)(t + 1) * kstep;
            const char* a2 = last ? nA : cA + (size_t)(t + 2) * kstep; const char* b2 = last ? nB : cB + (size_t)(t + 2) * kstep;
            const char* a3 = a2 + kstep; const char* b3 = b2 + kstep;
            if constexpr (SP2) {
            PG8_LDB(B0, 0, 0); PG8_LDB(B1, 0, 1); PG8_SCHED; PG8_LDA(At, 0, 0); PG8_STAGE_A(PG8_SA(1, 1), a1, 1, false);
            PG8_WAIT_V(8); PG8_WAIT_L(0); PG8_BAR; PG8_MMA(0, 0, At, B0); PG8_MMA(0, 1, At, B1); PG8_BAR; PG8_SCHED;
            PG8_LDA(At, 0, 1); PG8_STAGE(PG8_SB(0, 0), b2, voffB); PG8_STAGE(PG8_SB(0, 1), b2 + hstepB, voffB); PG8_STAGE_A(PG8_SA(0, 0), a2, 0, last);
            PG8_WAIT_V(8); PG8_WAIT_L(0); PG8_BAR; PG8_MMA(1, 0, At, B0); PG8_MMA(1, 1, At, B1); PG8_BAR; PG8_SCHED;
            PG8_LDB(B0, 1, 0); PG8_LDB(B1, 1, 1); PG8_SCHED; PG8_LDA(At, 1, 0); PG8_STAGE_A(PG8_SA(0, 1), a2, 1, last);
            PG8_WAIT_V(8); PG8_WAIT_L(0); PG8_BAR; PG8_MMA(0, 0, At, B0); PG8_MMA(0, 1, At, B1); PG8_BAR; PG8_SCHED;
            PG8_LDA(At, 1, 1); PG8_STAGE(PG8_SB(1, 0), b3, voffB); PG8_STAGE(PG8_SB(1, 1), b3 + hstepB, voffB); PG8_STAGE_A(PG8_SA(1, 0), a3, 0, last);
            PG8_WAIT_V(8); PG8_WAIT_L(0); PG8_BAR; PG8_MMA(1, 0, At, B0); PG8_MMA(1, 1, At, B1); PG8_BAR; PG8_SCHED;
            } else {
            PG8_LDB(B0, 0, 0); PG8_SCHED; PG8_LDA(At, 0, 0); PG8_STAGE_A(PG8_SA(1, 1), a1, 1, false);
            PG8_WAIT_L(8); PG8_BAR; PG8_WAIT_L(0); PG8_MMA(0, 0, At, B0); PG8_BAR; PG8_SCHED;
            PG8_LDB(B1, 0, 1); PG8_STAGE(PG8_SB(0, 0), b2, voffB);
            PG8_BAR; PG8_WAIT_L(0); PG8_MMA(0, 1, At, B1); PG8_BAR;
            PG8_LDA(At, 0, 1); PG8_STAGE_A(PG8_SA(0, 0), a2, 0, last);
            PG8_BAR; PG8_WAIT_L(0); PG8_MMA(1, 0, At, B0); PG8_BAR; PG8_SCHED;
            PG8_STAGE(PG8_SB(0, 1), b2 + hstepB, voffB);
            PG8_WAIT_V(6); PG8_BAR; PG8_MMA(1, 1, At, B1); PG8_BAR;
            PG8_LDB(B0, 1, 0); PG8_SCHED; PG8_LDA(At, 1, 0); PG8_STAGE_A(PG8_SA(0, 1), a2, 1, last);
            PG8_WAIT_L(8); PG8_BAR; PG8_WAIT_L(0); PG8_MMA(0, 0, At, B0); PG8_BAR; PG8_SCHED;
            PG8_LDB(B1, 1, 1); PG8_STAGE(PG8_SB(1, 0), b3, voffB);
            PG8_BAR; PG8_WAIT_L(0); PG8_MMA(0, 1, At, B1); PG8_BAR;
            PG8_LDA(At, 1, 1); PG8_STAGE_A(PG8_SA(1, 0), a3, 0, last);
            PG8_BAR; PG8_WAIT_L(0); PG8_MMA(1, 0, At, B0); PG8_BAR; PG8_SCHED;
            PG8_STAGE(PG8_SB(1, 1), b3 + hstepB, voffB);
            PG8_WAIT_V(6); PG8_BAR; PG8_MMA(1, 1, At, B1); PG8_BAR;
            }
        }
        if constexpr (ALIGN_EPI) { if (wr == 0) PG8_BAR; }
        E(acc, cur, wr, wc, fr, fq);
        if (!has_next) break;
#pragma unroll
        for (int a = 0; a < 2; ++a)
#pragma unroll
            for (int b = 0; b < 2; ++b)
#pragma unroll
                for (int m = 0; m < 4; ++m)
#pragma unroll
                    for (int n = 0; n < 2; ++n) acc[a][b][m][n] = (f32x4){0.f, 0.f, 0.f, 0.f};
        cur = nxt; cA = nA; cB = nB; ++ui;
        if constexpr (GATHER) { cv0[0] = nv0[0]; cv0[1] = nv0[1]; cv1[0] = nv1[0]; cv1[1] = nv1[1]; }
        if constexpr (ALIGN_EPI) { if (wr == 1) PG8_BAR; }
    }
    PG8_WAIT_V(0);
    if constexpr (!ALIGN_EPI) { if (wr == 0) PG8_BAR; }
    PG8_BAR;
#undef PG8_SA
#undef PG8_SB
#undef PG8_STAGE
#undef PG8_STAGE_A
#undef PG8_LDA
#undef PG8_LDB
#undef PG8_MMA
#undef PG8_WAIT_V
#undef PG8_WAIT_L
#undef PG8_BAR
#undef PG8_SCHED
#undef PG8_ROWS
}
}

using pg8::Unit;
struct SchedPlain : pg8::Order {
    const char* A; const char* B; size_t a_tile, b_tile;
    __device__ __forceinline__ bool next(int i, Unit& u) const { u.aux = 0; return tile(i, u.pm, u.pn); }
    __device__ __forceinline__ const char* a_ptr(const Unit& u) const { return A + (size_t)u.pm * a_tile; }
    __device__ __forceinline__ const char* b_ptr(const Unit& u) const { return B + (size_t)u.pn * b_tile; }
    __device__ __forceinline__ int a_row(const Unit&, int) const { return 0; }
};
struct SchedS5 : pg8::Order {
    const char* A; const char* B; size_t a_tile, b_tile, b_group;
    __device__ __forceinline__ bool next(int i, Unit& u) const { u.aux = 0; return tile(i, u.pm, u.pn); }
    __device__ __forceinline__ const char* a_ptr(const Unit& u) const { return A + (size_t)u.pm * a_tile; }
    __device__ __forceinline__ const char* b_ptr(const Unit& u) const { return B + (size_t)(u.pm >> 2) * b_group + (size_t)u.pn * b_tile; }
    __device__ __forceinline__ int a_row(const Unit&, int) const { return 0; }
};
template <bool GATHER> struct SchedMoe : pg8::Order {
    const char* A; const char* B; size_t a_tile, b_tile, b_exp; const LAS int* tile_e; int tile0, e0; const int* slot_tok; int row0;
    __device__ __forceinline__ bool next(int i, Unit& u) const { const bool ok = tile(i, u.pm, u.pn); u.aux = ok ? tile_e[tile0 + u.pm] : 0; return ok; }
    __device__ __forceinline__ const char* a_ptr(const Unit& u) const { return GATHER ? A : A + (size_t)u.pm * a_tile; }
    __device__ __forceinline__ const char* b_ptr(const Unit& u) const { return B + (size_t)(u.aux - e0) * b_exp + (size_t)u.pn * b_tile; }
    __device__ __forceinline__ int a_row(const Unit& u, int r) const { return slot_tok[row0 + u.pm * 256 + r]; }
};

__device__ __forceinline__ void st8(bf16* p, const f32x4 v0, const f32x4 v1) {
    u32x4 w; w.x = cvt_pk_bf16(v0[0], v0[1]); w.y = cvt_pk_bf16(v0[2], v0[3]); w.z = cvt_pk_bf16(v1[0], v1[1]); w.w = cvt_pk_bf16(v1[2], v1[3]); *(u32x4*)p = w;
}
__device__ __forceinline__ void ld8(const bf16* p, f32x4& v0, f32x4& v1) {
    const u32x4 w = *(const u32x4*)p; v0 = (f32x4){lo16(w.x), hi16(w.x), lo16(w.y), hi16(w.y)}; v1 = (f32x4){lo16(w.z), hi16(w.z), lo16(w.w), hi16(w.w)};
}
#define EPI_LOOP_AM _Pragma("unroll") for (int ai = 0; ai < 2; ++ai) _Pragma("unroll") for (int m = 0; m < 4; ++m)
#define EPI_ARGS const f32x4 (&acc)[2][2][4][2], const Unit& u, int wr, int wc, int fr, int fq

struct EpiProj { static constexpr bool PERM = true; bf16 *U, *RKV, *LP;
    __device__ __forceinline__ void operator()(EPI_ARGS) const {
        bf16* base; int ldc, c0;
        if (u.pn < 2) { base = U; ldc = 512; c0 = u.pn * 256; } else if (u.pn < 8) { base = RKV; ldc = 1536; c0 = (u.pn - 2) * 256; } else { base = LP; ldc = 512; c0 = (u.pn - 8) * 256; }
        const int row0 = u.pm * 256 + wr * 64 + fr, col0 = c0 + wc * 32 + 8 * fq;
        EPI_LOOP_AM { bf16* rowp = base + (size_t)(row0 + ai * 128 + m * 16) * ldc + col0;
#pragma unroll
            for (int bj = 0; bj < 2; ++bj) st8(rowp + bj * 128, acc[ai][bj][m][0], acc[ai][bj][m][1]); }
    }
};
struct EpiBf16Plain { static constexpr bool PERM = true; bf16* O; int ldc;
    __device__ __forceinline__ void operator()(EPI_ARGS) const {
        const int row0 = u.pm * 256 + wr * 64 + fr, col0 = u.pn * 256 + wc * 32 + 8 * fq;
        EPI_LOOP_AM { bf16* rowp = O + (size_t)(row0 + ai * 128 + m * 16) * ldc + col0;
#pragma unroll
            for (int bj = 0; bj < 2; ++bj) st8(rowp + bj * 128, acc[ai][bj][m][0], acc[ai][bj][m][1]); }
    }
};
struct EpiF32 { static constexpr bool PERM = false; float* C; int ldc;
    __device__ __forceinline__ void operator()(EPI_ARGS) const {
        const int row0 = u.pm * 256 + wr * 64 + fr, col0 = u.pn * 256 + wc * 32 + 4 * fq;
        EPI_LOOP_AM { float* rowp = C + (size_t)(row0 + ai * 128 + m * 16) * ldc + col0;
#pragma unroll
            for (int bj = 0; bj < 2; ++bj)
#pragma unroll
                for (int n = 0; n < 2; ++n) *(f32x4*)(rowp + bj * 128 + n * 16) = acc[ai][bj][m][n]; }
    }
};
struct EpiS5Y { static constexpr bool PERM = true; const bf16* AG; const float* dskip; bf16* Y1;
    __device__ __forceinline__ void operator()(EPI_ARGS) const {
        const int g = u.pm >> 2, crow0 = (u.pm & 3) * 256 + wr * 64 + fr, col0 = u.pn * 256 + wc * 32 + 8 * fq;
        EPI_LOOP_AM { const int crow = crow0 + ai * 128 + m * 16;
#pragma unroll
            for (int bj = 0; bj < 2; ++bj) { const int col = col0 + bj * 128, t = col >> 4, c = col & 15;
                f32x4 u0, u1; ld8(AG + ((size_t)(g * 1024 + crow)) * 640 + col, u0, u1);
                const f32x4 d0 = *(const f32x4*)(dskip + g * 16 + c), d1 = *(const f32x4*)(dskip + g * 16 + c + 4);
                f32x4 v0 = acc[ai][bj][m][0] + d0 * u0, v1 = acc[ai][bj][m][1] + d1 * u1;
#pragma unroll
                for (int j = 0; j < 4; ++j) { v0[j] = gelu_tanh(v0[j]); v1[j] = gelu_tanh(v1[j]); }
                st8(Y1 + (size_t)(crow * 32 + t) * 512 + g * 16 + c, v0, v1); } }
    }
};
struct EpiGlu { static constexpr bool PERM = true; const bf16* Y1; bf16* MIX;
    __device__ __forceinline__ void operator()(EPI_ARGS) const {
        const int row0 = u.pm * 256 + wr * 64 + fr, col0 = u.pn * 256 + wc * 32 + 8 * fq;
        EPI_LOOP_AM { const int row = row0 + ai * 128 + m * 16;
#pragma unroll
            for (int bj = 0; bj < 2; ++bj) { const int col = col0 + bj * 128; f32x4 y0, y1v; ld8(Y1 + (size_t)row * 512 + col, y0, y1v);
                f32x4 v0, v1;
#pragma unroll
                for (int j = 0; j < 4; ++j) { v0[j] = y0[j] * fsigmoid(acc[ai][bj][m][0][j]); v1[j] = y1v[j] * fsigmoid(acc[ai][bj][m][1][j]); }
                st8(MIX + (size_t)row * 1024 + col, v0, v1); } }
    }
};
struct EpiResid { static constexpr bool PERM = false; const float* X; float* O;
    __device__ __forceinline__ void operator()(EPI_ARGS) const {
        const int row0 = u.pm * 256 + wr * 64 + fr, col0 = u.pn * 256 + wc * 32 + 4 * fq;
        EPI_LOOP_AM { const size_t off = (size_t)(row0 + ai * 128 + m * 16) * 1024 + col0;
#pragma unroll
            for (int bj = 0; bj < 2; ++bj)
#pragma unroll
                for (int n = 0; n < 2; ++n) *(f32x4*)(O + off + bj * 128 + n * 16) = *(const f32x4*)(X + off + bj * 128 + n * 16) + acc[ai][bj][m][n]; }
    }
};
struct EpiGU { static constexpr bool PERM = true; bf16* ACT; const float* bg; const float* bu;
    __device__ __forceinline__ void operator()(EPI_ARGS) const {
        const int row0 = u.pm * 256 + wr * 64 + fr, col = u.pn * 128 + wc * 32 + 8 * fq; const int e = u.aux;
        const f32x4 g0 = *(const f32x4*)(bg + e * 1024 + col), g1 = *(const f32x4*)(bg + e * 1024 + col + 4), u0 = *(const f32x4*)(bu + e * 1024 + col), u1 = *(const f32x4*)(bu + e * 1024 + col + 4);
        EPI_LOOP_AM { f32x4 v0, v1;
#pragma unroll
            for (int j = 0; j < 4; ++j) {
                const float gt0 = fminf(acc[ai][0][m][0][j] + g0[j], 7.0f), up0 = fminf(fmaxf(acc[ai][1][m][0][j] + u0[j], -7.0f), 7.0f);
                const float gt1 = fminf(acc[ai][0][m][1][j] + g1[j], 7.0f), up1 = fminf(fmaxf(acc[ai][1][m][1][j] + u1[j], -7.0f), 7.0f);
                v0[j] = (up0 + 1.0f) * gt0 * fsigmoid(1.702f * gt0); v1[j] = (up1 + 1.0f) * gt1 * fsigmoid(1.702f * gt1); }
            st8(ACT + (size_t)(row0 + ai * 128 + m * 16) * 1024 + col, v0, v1); }
    }
};
struct EpiDown { static constexpr bool PERM = true; bf16* Y; const float* bd;
    __device__ __forceinline__ void operator()(EPI_ARGS) const {
        const int row0 = u.pm * 256 + wr * 64 + fr, col0 = u.pn * 256 + wc * 32 + 8 * fq; const int e = u.aux;
        EPI_LOOP_AM { bf16* rowp = Y + (size_t)(row0 + ai * 128 + m * 16) * 1024 + col0;
#pragma unroll
            for (int bj = 0; bj < 2; ++bj) { const f32x4 b0 = *(const f32x4*)(bd + e * 1024 + col0 + bj * 128), b1 = *(const f32x4*)(bd + e * 1024 + col0 + bj * 128 + 4);
                st8(rowp + bj * 128, acc[ai][bj][m][0] + b0, acc[ai][bj][m][1] + b1); } }
    }
};
struct EpiPle { static constexpr bool PERM = false; const bf16* PP; float* O;
    __device__ __forceinline__ void operator()(EPI_ARGS) const {
        const int row0 = u.pm * 256 + wr * 64 + fr, col0 = u.pn * 256 + wc * 32 + 4 * fq;
        EPI_LOOP_AM { const size_t off = (size_t)(row0 + ai * 128 + m * 16) * 1024 + col0;
#pragma unroll
            for (int bj = 0; bj < 2; ++bj)
#pragma unroll
                for (int n = 0; n < 2; ++n) { const size_t o = off + bj * 128 + n * 16; const u32x2 w = *(const u32x2*)(PP + o); const f32x4 pp = (f32x4){lo16(w.x), hi16(w.x), lo16(w.y), hi16(w.y)};
                    f32x4 x = *(const f32x4*)(O + o);
#pragma unroll
                    for (int j = 0; j < 4; ++j) x[j] += pp[j] * fsigmoid(acc[ai][bj][m][n][j]);
                    *(f32x4*)(O + o) = x; } }
    }
};

struct Ctx { LAS unsigned char* lds; int tid, lane, wave, G, wg, gw, NGW; };

__device__ __forceinline__ void transpose_item(const float* W, int N, int k0, int n0, bf16* dst, int ldk, const float* scl, int flip, LAS float* scr, int lane) {
#pragma unroll 8
    for (int i = 0; i < 32; ++i) { const int kk = 2 * i + (lane >> 5); float v = W[(size_t)(k0 + kk) * N + n0 + (lane & 31)];
        if (scl) { const float s = scl[k0 + kk]; v *= flip ? (1.0f - s) : s; }
        scr[kk * 33 + (lane & 31)] = v; }
    LDS_WAIT(); asm volatile("" ::: "memory");
    const int c = lane & 7;
#pragma unroll
    for (int j = 0; j < 4; ++j) { const int n = (lane >> 3) + 8 * j; const LAS float* s = scr + (8 * c) * 33 + n;
        u32x4 o; o.x = pk2(s[0 * 33], s[1 * 33]); o.y = pk2(s[2 * 33], s[3 * 33]); o.z = pk2(s[4 * 33], s[5 * 33]); o.w = pk2(s[6 * 33], s[7 * 33]);
        *(u32x4*)(dst + (size_t)n * ldk + 8 * c) = o; }
    LDS_WAIT(); asm volatile("" ::: "memory");
}
__device__ __forceinline__ void transpose_matrix(const Ctx& cx, const float* W, int K, int N, bf16* WT, int row_off, int ldk, int koff, const float* scl, int flip) {
    LAS float* scr = (LAS float*)(cx.lds + cx.wave * 8448);
    const int nblk = N / 32, nitems = (K / 64) * nblk;
    for (int it = cx.gw; it < nitems; it += cx.NGW) { const int kb = it / nblk, nb = it % nblk;
        transpose_item(W, N, 64 * kb, 32 * nb, WT + (size_t)(row_off + 32 * nb) * ldk + koff + 64 * kb, ldk, scl, flip, scr, cx.lane); }
}
__device__ __forceinline__ void rms_row_to_bf16(const float* xrow, const float* g, bf16* orow, int lane) {
    const f32x4* xr = (const f32x4*)xrow + lane; const f32x4* gr = (const f32x4*)g + lane;
    f32x4 v[4]; float s = 0.f;
#pragma unroll
    for (int j = 0; j < 4; ++j) { v[j] = xr[64 * j]; s += (v[j].x * v[j].x + v[j].y * v[j].y) + (v[j].z * v[j].z + v[j].w * v[j].w); }
    const float rinv = rsqrtf(wave_sum(s) * (1.f / 1024.f) + 1e-6f);
    u32x2* o8 = (u32x2*)orow + lane;
#pragma unroll
    for (int j = 0; j < 4; ++j) { const f32x4 gg = gr[64 * j]; u32x2 w; w.x = pk2(v[j].x * rinv * gg.x, v[j].y * rinv * gg.y); w.y = pk2(v[j].z * rinv * gg.z, v[j].w * rinv * gg.w); o8[64 * j] = w; }
}

__device__ __forceinline__ void s5_tables_item(const Ctx& cx, int g, int part, const float* lam_re, const float* lam_im, const float* log_dt, const float* b_re, const float* b_im, const float* c_re, const float* c_im,
                                               bf16* BT, bf16* ET, float* AT) {
    LAS float* apr = (LAS float*)cx.lds; LAS float* api = apr + 33 * 64; LAS float* bbr = api + 33 * 64; LAS float* bbi = bbr + 1024; LAS float* cr = bbi + 1024; LAS float* ci = cr + 1024; LAS float* kt = ci + 1024;
    const int tid = cx.tid;
    const float dt = __expf(log_dt[g]);
    for (int idx = tid; idx < 33 * 64; idx += NTHR) { const int j = idx >> 6, p = idx & 63;
        const float lre = fminf(lam_re[g * 64 + p], -1e-4f), lim = lam_im[g * 64 + p];
        const float mag = expf(lre * dt * (float)j), ang = lim * dt * (float)j; float sn, cs; sincosf(ang, &sn, &cs);
        apr[idx] = mag * cs; api[idx] = mag * sn; }
    for (int idx = tid; idx < 1024; idx += NTHR) { const int p = idx >> 4;
        const float lre = fminf(lam_re[g * 64 + p], -1e-4f), lim = lam_im[g * 64 + p];
        const float mag = expf(lre * dt); float sn, cs; sincosf(lim * dt, &sn, &cs); const float lbr = mag * cs, lbi = mag * sn;
        const float den = lre * lre + lim * lim, zr = lbr - 1.0f; const float cor = (zr * lre + lbi * lim) / den, coi = (lbi * lre - zr * lim) / den;
        const float br = b_re[g * 1024 + idx], bi = b_im[g * 1024 + idx];
        bbr[idx] = cor * br - coi * bi; bbi[idx] = cor * bi + coi * br;
        cr[idx] = c_re[g * 1024 + idx]; ci[idx] = c_im[g * 1024 + idx]; }
    __syncthreads();
    for (int idx = tid; idx < 1024; idx += NTHR) { const int jl = idx >> 8, c = (idx >> 4) & 15, c2 = idx & 15, j = 4 * part + jl; float s = 0.f;
        for (int p = 0; p < 64; ++p) { const float ar = apr[j * 64 + p], ai = api[j * 64 + p], xr = cr[c * 64 + p], xi = ci[c * 64 + p];
            const float car = xr * ar - xi * ai, cai = xr * ai + xi * ar; s += car * bbr[p * 16 + c2] - cai * bbi[p * 16 + c2]; }
        kt[idx] = s; }
    __syncthreads();
    bf16* BTg = BT + (size_t)g * 512 * 640; bf16* ETg = ET + (size_t)g * 256 * 512;
    for (int idx = tid; idx < 4096; idx += NTHR) { const int hf = idx & 1, c = (idx >> 1) & 15, t = (idx >> 5) & 31, jl = idx >> 10, j = 4 * part + jl;
        if (t >= j) { const LAS float* s = kt + jl * 256 + c * 16 + hf * 8; u32x4 o; o.x = pk2(s[0], s[1]); o.y = pk2(s[2], s[3]); o.z = pk2(s[4], s[5]); o.w = pk2(s[6], s[7]);
            *(u32x4*)(BTg + (size_t)(t * 16 + c) * 640 + (t - j) * 16 + hf * 8) = o; } }
    for (int idx = tid; idx < 4096; idx += NTHR) { const int hf = idx & 1, c = (idx >> 1) & 15, s = (idx >> 5) & 31, t = 4 * part + (idx >> 10);
        if (s > t) *(u32x4*)(BTg + (size_t)(t * 16 + c) * 640 + s * 16 + hf * 8) = (u32x4){0u, 0u, 0u, 0u}; }
    for (int idx = tid; idx < 1024; idx += NTHR) { const int ch = idx & 15, c = (idx >> 4) & 15, t = 4 * part + (idx >> 8); const int im = ch >> 3, p0 = (ch & 7) * 8; float v[8];
#pragma unroll
        for (int q = 0; q < 8; ++q) { const int p = p0 + q; const float ar = apr[(t + 1) * 64 + p], ai = api[(t + 1) * 64 + p], xr = cr[c * 64 + p], xi = ci[c * 64 + p];
            v[q] = im ? -(xr * ai + xi * ar) : (xr * ar - xi * ai); }
        u32x4 o; o.x = pk2(v[0], v[1]); o.y = pk2(v[2], v[3]); o.z = pk2(v[4], v[5]); o.w = pk2(v[6], v[7]);
        *(u32x4*)(BTg + (size_t)(t * 16 + c) * 640 + 512 + im * 64 + p0) = o; }
    for (int idx = tid; idx < 1024; idx += NTHR) { const int hf = idx & 1, sl = (idx >> 1) & 3, n = idx >> 3, s = 4 * part + sl, p = n & 63, im = n >> 6; float v[8];
        const float ar = apr[(31 - s) * 64 + p], ai = api[(31 - s) * 64 + p];
#pragma unroll
        for (int q = 0; q < 8; ++q) { const float br = bbr[p * 16 + hf * 8 + q], bi = bbi[p * 16 + hf * 8 + q]; v[q] = im ? (ar * bi + ai * br) : (ar * br - ai * bi); }
        u32x4 o; o.x = pk2(v[0], v[1]); o.y = pk2(v[2], v[3]); o.z = pk2(v[4], v[5]); o.w = pk2(v[6], v[7]);
        *(u32x4*)(ETg + (size_t)n * 512 + s * 16 + hf * 8) = o; }
    for (int idx = tid; idx < 1024; idx += NTHR) { const int ch = idx & 63, r = 128 + 16 * part + (idx >> 6); *(u32x4*)(ETg + (size_t)r * 512 + ch * 8) = (u32x4){0u, 0u, 0u, 0u}; }
    if (part == 0 && tid < 64) { AT[(g * 64 + tid) * 2] = apr[32 * 64 + tid]; AT[(g * 64 + tid) * 2 + 1] = api[32 * 64 + tid]; }
    __syncthreads();
}

constexpr int IMG_B = 9216;
#define IMG(k) ((LAS bf16*)(lds + (k) * IMG_B))
struct MmCtx { int tr, tc0, l15, q; };
__device__ __forceinline__ void mm64(const LAS bf16* A, const LAS bf16* Bt, f32x4 (&acc)[2], const MmCtx& w) {
#pragma unroll
    for (int s = 0; s < 2; ++s) {
        const bf16x8 a = *(const LAS bf16x8*)(A + (16 * w.tr + w.l15) * 72 + 32 * s + 8 * w.q);
#pragma unroll
        for (int c = 0; c < 2; ++c) { const bf16x8 b = *(const LAS bf16x8*)(Bt + (16 * (w.tc0 + c) + w.l15) * 72 + 32 * s + 8 * w.q);
            acc[c] = __builtin_amdgcn_mfma_f32_16x16x32_bf16(a, b, acc[c], 0, 0, 0); }
    }
}
__device__ __forceinline__ void st_rm(LAS bf16* img, const f32x4 v, int tr, int tc, const MmCtx& w) {
#pragma unroll
    for (int r = 0; r < 4; ++r) img[(16 * tr + 4 * w.q + r) * 72 + 16 * tc + w.l15] = (bf16)(cvt_pk_bf16(v[r], 0.f) & 0xffffu);
}
__device__ __forceinline__ void st_tr(LAS bf16* img, const f32x4 v, int tr, int tc, const MmCtx& w) {
    u32x2 o; o.x = pk2(v[0], v[1]); o.y = pk2(v[2], v[3]); *(LAS u32x2*)(img + (16 * tc + w.l15) * 72 + 16 * tr + 4 * w.q) = o;
}
__device__ __forceinline__ void img_to_global(const LAS bf16* img, bf16* g, int tid) { const int row = tid >> 3, ch = tid & 7; *(u32x4*)(g + row * 64 + ch * 8) = *(const LAS u32x4*)(img + row * 72 + ch * 8); }
__device__ __forceinline__ void global_to_img(LAS bf16* img, const bf16* g, int tid) { const int row = tid >> 3, ch = tid & 7; *(LAS u32x4*)(img + row * 72 + ch * 8) = *(const u32x4*)(g + row * 64 + ch * 8); }
__device__ __forceinline__ void st_tm8(LAS bf16* img, int t, int cg, const float (&v)[8]) {
    u32x4 o; o.x = pk2(v[0], v[1]); o.y = pk2(v[2], v[3]); o.z = pk2(v[4], v[5]); o.w = pk2(v[6], v[7]); *(LAS u32x4*)(img + t * 72 + 8 * cg) = o;
}
__device__ __forceinline__ void st_cm8(LAS bf16* img, int t, int cg, const float (&v)[8]) {
#pragma unroll
    for (int i = 0; i < 8; ++i) img[(8 * cg + i) * 72 + t] = (bf16)(cvt_pk_bf16(v[i], 0.f) & 0xffffu);
}
__device__ __forceinline__ float red8(float v) { v += __shfl_xor(v, 1); v += __shfl_xor(v, 2); v += __shfl_xor(v, 4); return v; }

struct RwkvP { const bf16* rkv; const bf16* wag; const float *mu_rkv, *w0, *a0, *k_k, *k_a, *r_k, *ln_w, *ln_b; };

__device__ __forceinline__ void unpack8(const u32x4 w, float (&o)[8]) { o[0] = lo16(w.x); o[1] = hi16(w.x); o[2] = lo16(w.y); o[3] = hi16(w.y); o[4] = lo16(w.z); o[5] = hi16(w.z); o[6] = lo16(w.w); o[7] = hi16(w.w); }
__device__ __forceinline__ void ldp8(const float* p, float (&o)[8]) { const f32x4 a = *(const f32x4*)p, b = *(const f32x4*)(p + 4); o[0] = a.x; o[1] = a.y; o[2] = a.z; o[3] = a.w; o[4] = b.x; o[5] = b.y; o[6] = b.z; o[7] = b.w; }

template <bool PASS3>
__device__ __forceinline__ void rwkv_prep(const RwkvP& P, int cidx, int tid, float (&kq)[8], float (&vv)[8], float (&rr)[8], float (&kap)[8], float (&bet)[8], float (&lw)[8], float (&gg)[8]) {
    const int t = tid >> 3, cg = tid & 7, bh = cidx >> 7, c = cidx & 127, b = bh >> 3, h = bh & 7, ch = h * 64 + 8 * cg;
    const size_t tok = (size_t)b * SEQ + c * 64 + t; const bool first = (c == 0 && t == 0);
    const bf16* row = P.rkv + tok * 1536 + ch; const bf16* prow = row - 1536;
    float kc[8], kp[8], vc[8], vp[8], m[8];
    unpack8(*(const u32x4*)(row + 512), kc); unpack8(*(const u32x4*)(row + 1024), vc);
    if (first) {
#pragma unroll
        for (int i = 0; i < 8; ++i) { kp[i] = 0.f; vp[i] = 0.f; }
    } else { unpack8(*(const u32x4*)(prow + 512), kp); unpack8(*(const u32x4*)(prow + 1024), vp); }
    float k[8];
    ldp8(P.mu_rkv + 512 + ch, m);
#pragma unroll
    for (int i = 0; i < 8; ++i) k[i] = kc[i] + (kp[i] - kc[i]) * m[i];
    ldp8(P.mu_rkv + 1024 + ch, m);
#pragma unroll
    for (int i = 0; i < 8; ++i) vv[i] = vc[i] + (vp[i] - vc[i]) * m[i];
    if (PASS3) { float rc[8], rp[8]; unpack8(*(const u32x4*)row, rc);
        if (first) {
#pragma unroll
            for (int i = 0; i < 8; ++i) rp[i] = 0.f;
        } else unpack8(*(const u32x4*)prow, rp);
        ldp8(P.mu_rkv + ch, m);
#pragma unroll
        for (int i = 0; i < 8; ++i) rr[i] = rc[i] + (rp[i] - rc[i]) * m[i];
        unpack8(*(const u32x4*)(P.wag + tok * 1536 + 1024 + ch), gg);
    } else {
#pragma unroll
        for (int i = 0; i < 8; ++i) { rr[i] = 0.f; gg[i] = 0.f; }
    }
    float wl[8], al[8], a[8];
    unpack8(*(const u32x4*)(P.wag + tok * 1536 + ch), wl); unpack8(*(const u32x4*)(P.wag + tok * 1536 + 512 + ch), al);
    ldp8(P.w0 + ch, m);
#pragma unroll
    for (int i = 0; i < 8; ++i) lw[i] = -0.6065306597126334f * fsigmoid(m[i] + wl[i]);
    ldp8(P.a0 + ch, m);
#pragma unroll
    for (int i = 0; i < 8; ++i) a[i] = fsigmoid(m[i] + al[i]);
    ldp8(P.k_k + ch, m);
    float ss = 0.f;
#pragma unroll
    for (int i = 0; i < 8; ++i) { kap[i] = k[i] * m[i]; ss += kap[i] * kap[i]; }
    ss = red8(ss);
    const float inv = 1.0f / fmaxf(sqrtf(ss), 1e-12f);
    ldp8(P.k_a + ch, m);
#pragma unroll
    for (int i = 0; i < 8; ++i) { kap[i] *= inv; bet[i] = kap[i] * a[i]; kq[i] = k[i] * (1.0f + (a[i] - 1.0f) * m[i]); }
}
__device__ __forceinline__ void rwkv_cumsum(LAS unsigned char* lds, int tid, const float (&lw)[8], float (&cum)[8], float (&cumL)[8]) {
    LAS float* LW = (LAS float*)(lds + 12 * IMG_B); LAS float* SEG = (LAS float*)(lds + 14 * IMG_B);
    const int t = tid >> 3, cg = tid & 7, j = tid & 63, seg = tid >> 6;
#pragma unroll
    for (int i = 0; i < 8; ++i) LW[t * 65 + 8 * cg + i] = lw[i];
    __syncthreads();
    { float run = 0.f;
#pragma unroll
      for (int tt = 0; tt < 8; ++tt) { const int idx = (8 * seg + tt) * 65 + j; run += LW[idx]; LW[idx] = run; }
      SEG[seg * 64 + j] = run; }
    __syncthreads();
    { float pre = 0.f;
#pragma unroll
      for (int s2 = 0; s2 < 8; ++s2) { const float x = SEG[s2 * 64 + j]; pre += (s2 < seg) ? x : 0.f; }
#pragma unroll
      for (int tt = 0; tt < 8; ++tt) LW[(8 * seg + tt) * 65 + j] += pre; }
    __syncthreads();
#pragma unroll
    for (int i = 0; i < 8; ++i) { cum[i] = LW[t * 65 + 8 * cg + i]; cumL[i] = LW[63 * 65 + 8 * cg + i]; }
}

__device__ __forceinline__ void rwkv_pass1_chunk(LAS unsigned char* lds, const RwkvP& P, int cidx, int tid, bf16* QCT, float* HCT, bf16* W1G, bf16* ULG, float* DLG) {
    const int lane = tid & 63, wv = __builtin_amdgcn_readfirstlane(tid >> 6); MmCtx w; w.tr = wv >> 1; w.tc0 = (wv & 1) * 2; w.l15 = lane & 15; w.q = lane >> 4;
    const int t = tid >> 3, cg = tid & 7;
    {
        float kq[8], vv[8], rr[8], kap[8], bet[8], lw[8], gg[8], cum[8], cumL[8];
        rwkv_prep<false>(P, cidx, tid, kq, vv, rr, kap, bet, lw, gg);
        rwkv_cumsum(lds, tid, lw, cum, cumL);
        float x[8];
#pragma unroll
        for (int i = 0; i < 8; ++i) { const float en = __expf(-cum[i]); x[i] = kq[i] * en; bet[i] *= 1.0f; rr[i] = bet[i] * en; }
        st_tm8(IMG(0), t, cg, x);
        st_tm8(IMG(1), t, cg, rr);
#pragma unroll
        for (int i = 0; i < 8; ++i) x[i] = kap[i] * __expf(cum[i] - lw[i]);
        st_tm8(IMG(2), t, cg, x);
        st_cm8(IMG(3), t, cg, x);
#pragma unroll
        for (int i = 0; i < 8; ++i) { const float eh = __expf(cumL[i] - cum[i]); x[i] = kq[i] * eh; rr[i] = bet[i] * eh; }
        st_cm8(IMG(4), t, cg, x);
        st_cm8(IMG(5), t, cg, rr);
        st_cm8(IMG(6), t, cg, vv);
        if (t == 0) {
#pragma unroll
            for (int i = 0; i < 8; ++i) DLG[(size_t)cidx * 64 + 8 * cg + i] = __expf(cumL[i]);
        }
    }
    __syncthreads();
    f32x4 accX[2];
    {
        f32x4 a[2] = {(f32x4){0.f, 0.f, 0.f, 0.f}, (f32x4){0.f, 0.f, 0.f, 0.f}}, kk[2] = {(f32x4){0.f, 0.f, 0.f, 0.f}, (f32x4){0.f, 0.f, 0.f, 0.f}};
        mm64(IMG(1), IMG(2), a, w); mm64(IMG(0), IMG(2), kk, w);
#pragma unroll
        for (int c = 0; c < 2; ++c) { const int n = 16 * (w.tc0 + c) + w.l15;
#pragma unroll
            for (int r = 0; r < 4; ++r) { const int m = 16 * w.tr + 4 * w.q + r; a[c][r] = (m < n) ? a[c][r] : 0.f; kk[c][r] = (m < n) ? kk[c][r] : 0.f; accX[c][r] = ((m == n) ? 1.0f : 0.f) - a[c][r]; }
            st_rm(IMG(7), a[c], w.tr, w.tc0 + c, w); st_tr(IMG(8), a[c], w.tr, w.tc0 + c, w); st_rm(IMG(10), accX[c], w.tr, w.tc0 + c, w); st_rm(IMG(9), kk[c], w.tr, w.tc0 + c, w); }
    }
    __syncthreads();
    {
        f32x4 p[2] = {(f32x4){0.f, 0.f, 0.f, 0.f}, (f32x4){0.f, 0.f, 0.f, 0.f}};
        mm64(IMG(7), IMG(8), p, w);
#pragma unroll
        for (int c = 0; c < 2; ++c) { st_rm(IMG(12), p[c], w.tr, w.tc0 + c, w); st_tr(IMG(13), p[c], w.tr, w.tc0 + c, w); }
    }
    __syncthreads();
#define NEUMANN(XC, XN, PC, PTC, PN, PTN, LASTR) do { mm64(IMG(XC), IMG(PTC), accX, w); \
        if (!(LASTR)) { f32x4 p[2] = {(f32x4){0.f, 0.f, 0.f, 0.f}, (f32x4){0.f, 0.f, 0.f, 0.f}}; mm64(IMG(PC), IMG(PTC), p, w); \
            _Pragma("unroll") for (int c = 0; c < 2; ++c) { st_rm(IMG(PN), p[c], w.tr, w.tc0 + c, w); st_tr(IMG(PTN), p[c], w.tr, w.tc0 + c, w); st_rm(IMG(XN), accX[c], w.tr, w.tc0 + c, w); } } \
        __syncthreads(); } while (0)
    NEUMANN(10, 11, 12, 13, 14, 15, false);
    NEUMANN(11, 10, 14, 15, 12, 13, false);
    NEUMANN(10, 11, 12, 13, 14, 15, false);
    NEUMANN(11, 10, 14, 15, 12, 13, false);
    NEUMANN(10, 11, 12, 13, 14, 15, true);
#undef NEUMANN
#pragma unroll
    for (int c = 0; c < 2; ++c) st_tr(IMG(7), accX[c], w.tr, w.tc0 + c, w);
    __syncthreads();
    {
        f32x4 a[2] = {(f32x4){0.f, 0.f, 0.f, 0.f}, (f32x4){0.f, 0.f, 0.f, 0.f}}, g[2] = {(f32x4){0.f, 0.f, 0.f, 0.f}, (f32x4){0.f, 0.f, 0.f, 0.f}};
        mm64(IMG(3), IMG(7), a, w); mm64(IMG(9), IMG(7), g, w);
#pragma unroll
        for (int c = 0; c < 2; ++c) { st_rm(IMG(12), a[c], w.tr, w.tc0 + c, w); st_tr(IMG(14), a[c], w.tr, w.tc0 + c, w); st_tr(IMG(8), g[c], w.tr, w.tc0 + c, w); }
    }
    __syncthreads();
    {
        f32x4 u[2] = {(f32x4){0.f, 0.f, 0.f, 0.f}, (f32x4){0.f, 0.f, 0.f, 0.f}}, qc[2] = {(f32x4){0.f, 0.f, 0.f, 0.f}, (f32x4){0.f, 0.f, 0.f, 0.f}};
        mm64(IMG(6), IMG(8), u, w); mm64(IMG(5), IMG(12), qc, w);
#pragma unroll
        for (int c = 0; c < 2; ++c) { st_rm(IMG(13), u[c], w.tr, w.tc0 + c, w);
            const int tc = w.tc0 + c, cp = 32 * (tc >> 1) + 8 * (w.l15 >> 2) + 4 * (tc & 1) + (w.l15 & 3);
#pragma unroll
            for (int r = 0; r < 4; ++r) IMG(15)[(16 * w.tr + 4 * w.q + r) * 72 + cp] = (bf16)(cvt_pk_bf16(qc[c][r], 0.f) & 0xffffu); }
        img_to_global(IMG(14), W1G + (size_t)cidx * 4096, tid);
    }
    __syncthreads();
    {
        f32x4 hp[2] = {(f32x4){0.f, 0.f, 0.f, 0.f}, (f32x4){0.f, 0.f, 0.f, 0.f}}, hn[2] = {(f32x4){0.f, 0.f, 0.f, 0.f}, (f32x4){0.f, 0.f, 0.f, 0.f}};
        mm64(IMG(4), IMG(6), hp, w); mm64(IMG(5), IMG(13), hn, w);
#pragma unroll
        for (int c = 0; c < 2; ++c) *(f32x4*)(HCT + (((size_t)cidx * 16 + w.tr * 4 + w.tc0 + c) * 64 + lane) * 4) = hp[c] - hn[c];
        img_to_global(IMG(13), ULG + (size_t)cidx * 4096, tid);
        img_to_global(IMG(15), QCT + (size_t)cidx * 4096, tid);
    }
    __syncthreads();
}

__device__ __forceinline__ void rwkv_pass2(int bh, int ti, int lane, const bf16* QCT, const float* HCT, const float* DLG, bf16* S0G) {
    const int l15 = lane & 15, q = lane >> 4;
    f32x4 X[4];
#pragma unroll
    for (int tj = 0; tj < 4; ++tj) X[tj] = (f32x4){0.f, 0.f, 0.f, 0.f};
    bf16x8 an[4][2]; f32x4 hn[4], dn[4];
#define P2_LOAD(cc) do { const size_t ci_ = (size_t)bh * 128 + (cc); \
        _Pragma("unroll") for (int tj = 0; tj < 4; ++tj) { _Pragma("unroll") for (int s = 0; s < 2; ++s) an[tj][s] = *(const bf16x8*)(QCT + (ci_ * 64 + 16 * tj + l15) * 64 + 32 * s + 8 * q); \
            hn[tj] = *(const f32x4*)(HCT + ((ci_ * 16 + tj * 4 + ti) * 64 + lane) * 4); dn[tj] = *(const f32x4*)(DLG + ci_ * 64 + 16 * tj + 4 * q); } } while (0)
    P2_LOAD(0);
    for (int c = 0; c < 128; ++c) {
        bf16x8 a[4][2]; f32x4 h[4], d[4];
#pragma unroll
        for (int tj = 0; tj < 4; ++tj) { a[tj][0] = an[tj][0]; a[tj][1] = an[tj][1]; h[tj] = hn[tj]; d[tj] = dn[tj]; }
        if (c + 1 < 128) P2_LOAD(c + 1);
        const size_t cidx = (size_t)bh * 128 + c;
#pragma unroll
        for (int tj = 0; tj < 4; ++tj) { u32x2 o; o.x = pk2(X[tj][0], X[tj][1]); o.y = pk2(X[tj][2], X[tj][3]); *(u32x2*)(S0G + (cidx * 64 + 16 * ti + l15) * 64 + 16 * tj + 4 * q) = o; }
        bf16x8 b[2];
#pragma unroll
        for (int s = 0; s < 2; ++s) { u32x4 o; o.x = pk2(X[2 * s][0], X[2 * s][1]); o.y = pk2(X[2 * s][2], X[2 * s][3]); o.z = pk2(X[2 * s + 1][0], X[2 * s + 1][1]); o.w = pk2(X[2 * s + 1][2], X[2 * s + 1][3]); b[s] = __builtin_bit_cast(bf16x8, o); }
#pragma unroll
        for (int tj = 0; tj < 4; ++tj) { f32x4 acc = (f32x4){0.f, 0.f, 0.f, 0.f};
            acc = __builtin_amdgcn_mfma_f32_16x16x32_bf16(a[tj][0], b[0], acc, 0, 0, 0); acc = __builtin_amdgcn_mfma_f32_16x16x32_bf16(a[tj][1], b[1], acc, 0, 0, 0);
            X[tj] = d[tj] * X[tj] + h[tj] - acc; }
    }
#undef P2_LOAD
}

__device__ __forceinline__ void rwkv_pass3_chunk(LAS unsigned char* lds, const RwkvP& P, int cidx, int tid, const bf16* S0G, const bf16* W1G, const bf16* ULG, bf16* MIX) {
    const int lane = tid & 63, wv = __builtin_amdgcn_readfirstlane(tid >> 6); MmCtx w; w.tr = wv >> 1; w.tc0 = (wv & 1) * 2; w.l15 = lane & 15; w.q = lane >> 4;
    const int t = tid >> 3, cg = tid & 7, bh = cidx >> 7, c = cidx & 127, b = bh >> 3, h = bh & 7, ch = h * 64 + 8 * cg;
    float vv[8], gg[8], bonus;
    {
        float kq[8], rr[8], kap[8], bet[8], lw[8], cum[8], cumL[8];
        rwkv_prep<true>(P, cidx, tid, kq, vv, rr, kap, bet, lw, gg);
        rwkv_cumsum(lds, tid, lw, cum, cumL);
        float m[8]; ldp8(P.r_k + ch, m); float bs = 0.f;
#pragma unroll
        for (int i = 0; i < 8; ++i) bs += rr[i] * kq[i] * m[i];
        bonus = red8(bs);
        float x[8], y[8];
#pragma unroll
        for (int i = 0; i < 8; ++i) { const float en = __expf(-cum[i]); x[i] = kq[i] * en; y[i] = bet[i] * en; }
        st_tm8(IMG(1), t, cg, x);
        st_tm8(IMG(2), t, cg, y);
#pragma unroll
        for (int i = 0; i < 8; ++i) x[i] = rr[i] * __expf(cum[i]);
        st_tm8(IMG(0), t, cg, x);
        st_cm8(IMG(3), t, cg, vv);
        global_to_img(IMG(4), S0G + (size_t)cidx * 4096, tid);
        global_to_img(IMG(5), W1G + (size_t)cidx * 4096, tid);
        global_to_img(IMG(6), ULG + (size_t)cidx * 4096, tid);
    }
    __syncthreads();
    {
        f32x4 kr[2] = {(f32x4){0.f, 0.f, 0.f, 0.f}, (f32x4){0.f, 0.f, 0.f, 0.f}}, br[2] = {(f32x4){0.f, 0.f, 0.f, 0.f}, (f32x4){0.f, 0.f, 0.f, 0.f}}, u[2] = {(f32x4){0.f, 0.f, 0.f, 0.f}, (f32x4){0.f, 0.f, 0.f, 0.f}};
        mm64(IMG(0), IMG(1), kr, w); mm64(IMG(0), IMG(2), br, w); mm64(IMG(4), IMG(5), u, w);
#pragma unroll
        for (int cc = 0; cc < 2; ++cc) { const int n = 16 * (w.tc0 + cc) + w.l15;
#pragma unroll
            for (int r = 0; r < 4; ++r) { const int m = 16 * w.tr + 4 * w.q + r; kr[cc][r] = (n <= m) ? kr[cc][r] : 0.f; br[cc][r] = (n <= m) ? br[cc][r] : 0.f; u[cc][r] += bf2f(IMG(6)[m * 72 + n]); }
            st_rm(IMG(7), kr[cc], w.tr, w.tc0 + cc, w); st_rm(IMG(8), br[cc], w.tr, w.tc0 + cc, w); st_rm(IMG(9), u[cc], w.tr, w.tc0 + cc, w); }
    }
    __syncthreads();
    {
        f32x4 yp[2] = {(f32x4){0.f, 0.f, 0.f, 0.f}, (f32x4){0.f, 0.f, 0.f, 0.f}}, yn[2] = {(f32x4){0.f, 0.f, 0.f, 0.f}, (f32x4){0.f, 0.f, 0.f, 0.f}};
        mm64(IMG(0), IMG(4), yp, w); mm64(IMG(7), IMG(3), yp, w); mm64(IMG(8), IMG(9), yn, w);
        LAS float* YF = (LAS float*)(lds + 10 * IMG_B);
#pragma unroll
        for (int cc = 0; cc < 2; ++cc)
#pragma unroll
            for (int r = 0; r < 4; ++r) YF[(16 * w.tr + 4 * w.q + r) * 65 + 16 * (w.tc0 + cc) + w.l15] = yp[cc][r] - yn[cc][r];
    }
    __syncthreads();
    {
        const LAS float* YF = (const LAS float*)(lds + 10 * IMG_B);
        float y[8], s = 0.f;
#pragma unroll
        for (int i = 0; i < 8; ++i) { y[i] = YF[t * 65 + 8 * cg + i]; s += y[i]; }
        const float mean = red8(s) * (1.0f / 64.0f); float qv = 0.f;
#pragma unroll
        for (int i = 0; i < 8; ++i) { y[i] -= mean; qv += y[i] * y[i]; }
        const float rstd = rsqrtf(red8(qv) * (1.0f / 64.0f) + 64e-5f);
        float lwv[8], lbv[8]; ldp8(P.ln_w + ch, lwv); ldp8(P.ln_b + ch, lbv);
        float o[8];
#pragma unroll
        for (int i = 0; i < 8; ++i) o[i] = (y[i] * rstd * lwv[i] + lbv[i] + bonus * vv[i]) * gg[i];
        const size_t tok = (size_t)b * SEQ + c * 64 + t;
        u32x4 ov; ov.x = pk2(o[0], o[1]); ov.y = pk2(o[2], o[3]); ov.z = pk2(o[4], o[5]); ov.w = pk2(o[6], o[7]);
        *(u32x4*)(MIX + tok * 1024 + 512 + ch) = ov;
    }
}

__device__ __forceinline__ void router_phase(const Ctx& cx, const float* X1, const float* gnorm, const float* rw, const float* rb, bf16* H2, int* TOPE, float* TOPG, unsigned* HIST) {
    LAS float* RW = (LAS float*)cx.lds;
    LAS unsigned* hcnt = (LAS unsigned*)(cx.lds + 131072);
    const int lane = cx.lane;
    for (int idx = cx.tid; idx < 32768; idx += NTHR) { const int col = idx >> 5, e = idx & 31; RW[e * 1024 + col] = rw[idx]; }
    const int myexp = (lane >> 1) & 31; const float mybias = rb[myexp];
    for (int tb = cx.wg; tb < 256; tb += cx.G) {
        if (cx.tid < 32) hcnt[cx.tid] = 0u;
        __syncthreads();
        for (int r = 0; r < 16; ++r) {
            const int tok = tb * 128 + cx.wave * 16 + r;
            const f32x4* xr = (const f32x4*)(X1 + (size_t)tok * 1024) + lane; const f32x4* gr = (const f32x4*)gnorm + lane;
            f32x4 v[4]; float s = 0.f;
#pragma unroll
            for (int j = 0; j < 4; ++j) { v[j] = xr[64 * j]; s += (v[j].x * v[j].x + v[j].y * v[j].y) + (v[j].z * v[j].z + v[j].w * v[j].w); }
            const float rinv = rsqrtf(wave_sum(s) * (1.f / 1024.f) + 1e-6f);
            u32x2* o8 = (u32x2*)(H2 + (size_t)tok * 1024) + lane;
#pragma unroll
            for (int j = 0; j < 4; ++j) { const f32x4 gg = gr[64 * j]; v[j].x *= rinv * gg.x; v[j].y *= rinv * gg.y; v[j].z *= rinv * gg.z; v[j].w *= rinv * gg.w;
                u32x2 w; w.x = pk2(v[j].x, v[j].y); w.y = pk2(v[j].z, v[j].w); o8[64 * j] = w; }
            float part[32];
#pragma unroll
            for (int e = 0; e < 32; ++e) { float p = 0.f;
#pragma unroll
                for (int j = 0; j < 4; ++j) { const f32x4 wv = *(const LAS f32x4*)(RW + e * 1024 + 256 * j + 4 * lane); p += (v[j].x * wv.x + v[j].y * wv.y) + (v[j].z * wv.z + v[j].w * wv.w); }
                part[e] = p; }
            float a16[16], a8[8], a4[4], a2[2];
            { const bool bb = (lane & 32) != 0;
#pragma unroll
              for (int i = 0; i < 16; ++i) { const float keep = bb ? part[i + 16] : part[i], send = bb ? part[i] : part[i + 16]; a16[i] = keep + __shfl_xor(send, 32); } }
            { const bool bb = (lane & 16) != 0;
#pragma unroll
              for (int i = 0; i < 8; ++i) { const float keep = bb ? a16[i + 8] : a16[i], send = bb ? a16[i] : a16[i + 8]; a8[i] = keep + __shfl_xor(send, 16); } }
            { const bool bb = (lane & 8) != 0;
#pragma unroll
              for (int i = 0; i < 4; ++i) { const float keep = bb ? a8[i + 4] : a8[i], send = bb ? a8[i] : a8[i + 4]; a4[i] = keep + __shfl_xor(send, 8); } }
            { const bool bb = (lane & 4) != 0;
#pragma unroll
              for (int i = 0; i < 2; ++i) { const float keep = bb ? a4[i + 2] : a4[i], send = bb ? a4[i] : a4[i + 2]; a2[i] = keep + __shfl_xor(send, 4); } }
            float val;
            { const bool bb = (lane & 2) != 0; const float keep = bb ? a2[1] : a2[0], send = bb ? a2[0] : a2[1]; val = keep + __shfl_xor(send, 2); }
            val += __shfl_xor(val, 1);
            val += mybias;
            int se[4]; float sv[4];
#pragma unroll
            for (int k = 0; k < 4; ++k) { const float mx = wave_max(val); const unsigned long long mask = __ballot(val == mx); const int first = __ffsll((long long)mask) - 1;
                se[k] = first >> 1; sv[k] = mx; if (myexp == se[k]) val = -INFINITY; }
            const float w1 = __expf(sv[1] - sv[0]), w2 = __expf(sv[2] - sv[0]), w3 = __expf(sv[3] - sv[0]); const float inv = 1.0f / (1.0f + w1 + w2 + w3);
            if (lane == 0) {
                *(int4*)(TOPE + (size_t)tok * 4) = make_int4(se[0], se[1], se[2], se[3]);
                *(float4*)(TOPG + (size_t)tok * 4) = make_float4(inv, w1 * inv, w2 * inv, w3 * inv);
                atomicAdd((unsigned*)(hcnt + se[0]), 1u); atomicAdd((unsigned*)(hcnt + se[1]), 1u); atomicAdd((unsigned*)(hcnt + se[2]), 1u); atomicAdd((unsigned*)(hcnt + se[3]), 1u);
            }
        }
        __syncthreads();
        if (cx.tid < 32) HIST[tb * 32 + cx.tid] = hcnt[cx.tid];
        __syncthreads();
    }
}

constexpr int PL_BASE = 1280, PL_WCNT = 1312;
__device__ __forceinline__ void moe_plan(const Ctx& cx, const unsigned* HIST) {
    LAS int* PL = (LAS int*)(cx.lds + LDS_PLAN);
    const int e = cx.tid & 31, part = cx.tid >> 5;
    { int s = 0; for (int w = 16 * part; w < 16 * part + 16; ++w) s += (int)HIST[w * 32 + e]; PL[PL_TMP + part * 32 + e] = s; }
    __syncthreads();
    if (cx.tid < 32) { int c = 0; for (int p = 0; p < 16; ++p) c += PL[PL_TMP + p * 32 + cx.tid]; PL[PL_CNT + cx.tid] = c; }
    __syncthreads();
    if (cx.tid == 0) {
        int ps = 0;
        for (int x = 0; x < 32; ++x) { PL[PL_PSTART + x] = ps; const int pad = (PL[PL_CNT + x] + 255) & ~255; for (int i = 0; i < pad / 256; ++i) PL[PL_TILEE + ps / 256 + i] = x; ps += pad; }
        PL[PL_PSTART + 32] = ps;
        int np = 0, e0 = 0;
        while (e0 < 32 && np < 7) { PL[PL_PE0 + np] = e0; PL[PL_PROW0 + np] = PL[PL_PSTART + e0]; int rows = 0, e1 = e0;
            while (e1 < 32 && e1 - e0 < MAXEPP) { const int pad = PL[PL_PSTART + e1 + 1] - PL[PL_PSTART + e1]; if (rows + pad > RMAX && e1 > e0) break; rows += pad; ++e1; }
            e0 = e1; ++np; }
        PL[PL_PE0 + np] = 32; PL[PL_PROW0 + np] = ps; PL[PL_NPASS] = np;
    }
    __syncthreads();
}
__device__ __forceinline__ void dispatch_phase(const Ctx& cx, const unsigned* HIST, const int* TOPE, int* SLOTTOK, int* TOKSLOT) {
    LAS int* PL = (LAS int*)(cx.lds + LDS_PLAN);
    const int e5 = cx.tid & 31, part = cx.tid >> 5, lane = cx.lane;
    for (int tb = cx.wg; tb < 256; tb += cx.G) {
        { int s = 0; for (int w = 16 * part; w < 16 * part + 16; ++w) s += (w < tb) ? (int)HIST[w * 32 + e5] : 0; PL[PL_TMP + part * 32 + e5] = s; }
        const int tok = tb * 128 + (cx.tid >> 2), k = cx.tid & 3; const int e = TOPE[(size_t)tok * 4 + k];
        int rank = 0;
        for (int ee = 0; ee < 32; ++ee) { const unsigned long long mask = __ballot(e == ee); if (e == ee) rank = __popcll(mask & ((1ull << lane) - 1ull)); if (lane == 0) PL[PL_WCNT + cx.wave * 32 + ee] = __popcll(mask); }
        __syncthreads();
        if (cx.tid < 32) { int c = 0; for (int p = 0; p < 16; ++p) c += PL[PL_TMP + p * 32 + cx.tid]; PL[PL_BASE + cx.tid] = c; }
        __syncthreads();
        int off = 0; for (int w2 = 0; w2 < 8; ++w2) off += (w2 < cx.wave) ? PL[PL_WCNT + w2 * 32 + e] : 0;
        const int slot = PL[PL_PSTART + e] + PL[PL_BASE + e] + off + rank;
        SLOTTOK[slot] = tok; TOKSLOT[(size_t)tok * 4 + k] = slot;
        __syncthreads();
    }
    for (int e = cx.wg; e < 32; e += cx.G) { const int c = PL[PL_CNT + e], ps = PL[PL_PSTART + e], pe = PL[PL_PSTART + e + 1]; for (int r = ps + c + cx.tid; r < pe; r += NTHR) SLOTTOK[r] = 0; }
}
__device__ __forceinline__ void convert_pass(const Ctx& cx, int e0, int e1, const float* wg, const float* wu, const float* wd, bf16* WGU, bf16* WDN) {
    LAS float* scr = (LAS float*)(cx.lds + cx.wave * 8448);
    const int nitems = (e1 - e0) * 1536;
    for (int it = cx.gw; it < nitems; it += cx.NGW) { const int le = it / 1536, r = it % 1536, mat = r >> 9, kb = (r & 511) >> 5, nb = r & 31, n0 = 32 * nb; const size_t eo = (size_t)(e0 + le) * 1048576;
        if (mat == 2) transpose_item(wd + eo, 1024, 64 * kb, n0, WDN + (size_t)le * 1048576 + (size_t)n0 * 1024 + 64 * kb, 1024, nullptr, 0, scr, cx.lane);
        else { const int drow = (n0 >> 7) * 256 + (n0 & 127) + mat * 128; transpose_item((mat ? wu : wg) + eo, 1024, 64 * kb, n0, WGU + (size_t)le * 2097152 + (size_t)drow * 1024 + 64 * kb, 1024, nullptr, 0, scr, cx.lane); } }
}
__device__ __forceinline__ void combine_pass(const Ctx& cx, int e0, int e1, int row0, const int* TOPE, const float* TOPG, const int* TOKSLOT, const bf16* Y, float* X) {
    for (int tok = cx.gw; tok < M; tok += cx.NGW) {
        const int4 es = *(const int4*)(TOPE + (size_t)tok * 4); const float4 gs = *(const float4*)(TOPG + (size_t)tok * 4); const int4 sl = *(const int4*)(TOKSLOT + (size_t)tok * 4);
        const int ee[4] = {es.x, es.y, es.z, es.w}; const float gg[4] = {gs.x, gs.y, gs.z, gs.w}; const int ss[4] = {sl.x, sl.y, sl.z, sl.w};
        bool any = false;
#pragma unroll
        for (int k = 0; k < 4; ++k) any |= (ee[k] >= e0 && ee[k] < e1);
        if (!any) continue;
        f32x4* xr = (f32x4*)(X + (size_t)tok * 1024) + cx.lane; f32x4 v[4];
#pragma unroll
        for (int j = 0; j < 4; ++j) v[j] = xr[64 * j];
#pragma unroll
        for (int k = 0; k < 4; ++k) if (ee[k] >= e0 && ee[k] < e1) { const u32x2* yr = (const u32x2*)(Y + (size_t)(ss[k] - row0) * 1024) + cx.lane; const float g = gg[k];
#pragma unroll
            for (int j = 0; j < 4; ++j) { const u32x2 w = yr[64 * j]; v[j].x += g * lo16(w.x); v[j].y += g * hi16(w.x); v[j].z += g * lo16(w.y); v[j].w += g * hi16(w.y); } }
#pragma unroll
        for (int j = 0; j < 4; ++j) xr[64 * j] = v[j];
    }
}

#define HBUF ((bf16*)(ws + WS_R1))
#define RKV ((bf16*)(ws + WS_RKV))
#define WAG ((bf16*)(ws + WS_WAG))
#define AG ((bf16*)(ws + WS_AG))
#define UB ((bf16*)(ws + WS_U))
#define LP ((bf16*)(ws + WS_LP))
#define LACT ((bf16*)(ws + WS_LACT))
#define Y1 ((bf16*)(ws + WS_Y1))
#define MIX ((bf16*)(ws + WS_R1))
#define EBUF ((float*)(ws + WS_LP))
#define S0G ((bf16*)(ws + WS_LP))
#define QCT ((bf16*)(ws + WS_U))
#define HCT ((float*)(ws + WS_R1))
#define W1G ((bf16*)(ws + WS_W1))
#define ULG ((bf16*)(ws + WS_ULOC))
#define DLG ((float*)(ws + WS_DL))
#define ATG ((float*)(ws + WS_AT))
#define WCAT ((bf16*)(ws + WS_WCAT))
#define WL2 ((bf16*)(ws + WS_WL2))
#define WGLU ((bf16*)(ws + WS_WGLU))
#define WPP ((bf16*)(ws + WS_WPP))
#define WOUT ((bf16*)(ws + WS_WOUT))
#define WPG ((bf16*)(ws + WS_WPG))
#define S5BT ((bf16*)(ws + WS_S5BT))
#define S5ET ((bf16*)(ws + WS_S5ET))
#define PBF ((bf16*)(ws + WS_PBF))
#define H2 ((bf16*)(ws + WS_H2))
#define WGU ((bf16*)(ws + WS_WGU))
#define WDN ((bf16*)(ws + WS_WDN))
#define ACT ((bf16*)(ws + WS_ACT))
#define YB ((bf16*)(ws + WS_Y))
#define PP ((bf16*)(ws + WS_PP))
#define HIST ((unsigned*)(ws + WS_HIST))
#define TOPE ((int*)(ws + WS_TOPE))
#define TOPG ((float*)(ws + WS_TOPG))
#define TOKSLOT ((int*)(ws + WS_TOKSLOT))
#define SLOTTOK ((int*)(ws + WS_SLOTTOK))
#ifndef ONLY_PHASE
#define ONLY_PHASE -1
#endif
constexpr int NPH = 31;
struct Args { const float* in[42]; float* out; unsigned char* ws; int ph_lo, ph_hi; };

__global__ void __launch_bounds__(NTHR, 2) mk_fwd(Args args) {
    extern __shared__ __attribute__((aligned(16))) unsigned char lds_raw[];
    LAS unsigned char* lds = (LAS unsigned char*)lds_raw;
#define FRESH_CX Ctx cx; { int t_ = threadIdx.x; asm volatile("" : "+v"(t_)); cx.lds = lds; cx.tid = t_; cx.lane = t_ & 63; cx.wave = __builtin_amdgcn_readfirstlane(t_ >> 6); cx.G = gridDim.x; cx.wg = blockIdx.x; cx.gw = cx.wg * NWAVES + cx.wave; cx.NGW = cx.G * NWAVES; }
    unsigned char* ws = args.ws;
    const int lo = args.ph_lo, hi = args.ph_hi;
    volatile LAS unsigned* MISC = (volatile LAS unsigned*)(lds + LDS_MISC);
    if (threadIdx.x < 64) MISC[threadIdx.x] = 0u;
    __syncthreads();
    XcdBarrier bar; bar.bar = (unsigned*)(ws + WS_CTL) + CW_BAR; bar.x = 0; bar.st = nullptr;
    if (hi - lo > 1) bar = xcd_barrier_post((unsigned*)(ws + WS_CTL) + CW_BAR, MISC + 8);
#define IN(k) ((ONLY_PHASE < 0 || ONLY_PHASE == (k) || (ONLY_PHASE >= 10 && ONLY_PHASE < 28 && (k) >= 10 && (k) < 28 && ((k) - 10) % 3 == (ONLY_PHASE - 10) % 3)) && lo <= (k) && (k) < hi)
#define SEAM(k) do { if (IN(k) && IN((k) + 1)) xcd_barrier(bar); } while (0)
    const float* const* I = args.in;
    const float* x = I[0];
#define MAKE_RP RwkvP RP; RP.rkv = RKV; RP.wag = WAG; RP.mu_rkv = I[13]; RP.w0 = I[15]; RP.a0 = I[18]; RP.k_k = I[23]; RP.k_a = I[24]; RP.r_k = I[25]; RP.ln_w = I[26]; RP.ln_b = I[27]
#define OPQ(v) ({ int _k = (v); asm volatile("" : "+s"(_k)); _k; })

    if (IN(0)) {
        FRESH_CX;
        for (int it = cx.wg; it < 256; it += cx.G) s5_tables_item(cx, it >> 3, it & 7, I[4], I[5], I[6], I[7], I[8], I[9], I[10], S5BT, S5ET, ATG);
        const float* mu = I[14];
        transpose_matrix(cx, I[3], 1024, 2048, WCAT, 0, 1024, 0, nullptr, 0);
        transpose_matrix(cx, I[16], 1024, 64, WCAT, 2048, 1024, 0, mu, 1);          transpose_matrix(cx, I[16], 1024, 64, WCAT, 2304, 1024, 0, mu, 0);
        transpose_matrix(cx, I[19], 1024, 64, WCAT, 2112, 1024, 0, mu + 1024, 1);   transpose_matrix(cx, I[19], 1024, 64, WCAT, 2368, 1024, 0, mu + 1024, 0);
        transpose_matrix(cx, I[21], 1024, 128, WCAT, 2176, 1024, 0, mu + 2048, 1);  transpose_matrix(cx, I[21], 1024, 128, WCAT, 2432, 1024, 0, mu + 2048, 0);
        transpose_matrix(cx, I[17], 64, 512, WL2, 0, 256, 0, nullptr, 0);
        transpose_matrix(cx, I[20], 64, 512, WL2, 512, 256, 64, nullptr, 0);
        transpose_matrix(cx, I[22], 128, 512, WL2, 1024, 256, 128, nullptr, 0);
        for (int idx = cx.wg * NTHR + cx.tid; idx < 1536 * 32; idx += cx.G * NTHR) { const int row = idx >> 5, ch = idx & 31, blk = row >> 9; const int kb = blk == 0 ? 0 : (blk == 1 ? 64 : 128), ke = blk == 0 ? 64 : (blk == 1 ? 128 : 256);
            if (ch * 8 < kb || ch * 8 >= ke) *(u32x4*)(WL2 + (size_t)row * 256 + ch * 8) = (u32x4){0u, 0u, 0u, 0u}; }
        transpose_matrix(cx, I[12], 512, 512, WGLU, 0, 512, 0, nullptr, 0);
        transpose_matrix(cx, I[39], 256, 1024, WPP, 0, 256, 0, nullptr, 0);
        transpose_matrix(cx, I[28], 1024, 1024, WOUT, 0, 1024, 0, nullptr, 0);
        transpose_matrix(cx, I[40], 1024, 1024, WPG, 0, 1024, 0, nullptr, 0);
        for (int m = cx.gw; m < M; m += cx.NGW) rms_row_to_bf16(x + (size_t)m * 1024, I[2], HBUF + (size_t)m * 1024, cx.lane);
        for (int m = cx.gw; m < M; m += cx.NGW) { const f32x4 v = *((const f32x4*)(I[1] + (size_t)m * 256) + cx.lane); u32x2 w; w.x = pk2(v.x, v.y); w.y = pk2(v.z, v.w); *((u32x2*)(PBF + (size_t)m * 256) + cx.lane) = w; }
    }
    SEAM(0);
    if (IN(1)) {
        FRESH_CX;
        SchedPlain S; S.init(128, 10, cx.G, cx.wg); S.A = (const char*)HBUF; S.B = (const char*)WCAT; S.a_tile = 256 * 1024 * 2; S.b_tile = 256 * 1024 * 2;
        EpiProj E{UB, RKV, LP};
        pg8::gemm_phase<EpiProj, SchedPlain, true, true, false>(lds, cx.tid, OPQ(1024), OPQ(1024), OPQ(1024), S, E);
    }
    SEAM(1);
    if (IN(2)) {
        FRESH_CX;
        for (int m = cx.gw; m < M; m += cx.NGW) {
            const int lane = cx.lane; const bool first = (m & (SEQ - 1)) == 0;
            const u32x2 a = *((const u32x2*)(LP + (size_t)m * 512) + lane); u32x2 b = (u32x2){0u, 0u}; if (!first) b = *((const u32x2*)(LP + (size_t)(m - 1) * 512 + 256) + lane);
            float v[4] = {lo16(a.x) + lo16(b.x), hi16(a.x) + hi16(b.x), lo16(a.y) + lo16(b.y), hi16(a.y) + hi16(b.y)};
#pragma unroll
            for (int i = 0; i < 4; ++i) v[i] = lane < 16 ? ftanh(v[i]) : (lane < 32 ? v[i] : fsigmoid(v[i]));
            u32x2 o; o.x = pk2(v[0], v[1]); o.y = pk2(v[2], v[3]); *((u32x2*)(LACT + (size_t)m * 256) + lane) = o;
            const u32x4 uu = *((const u32x4*)(UB + (size_t)m * 512) + lane); const int g = lane >> 1;
            *(u32x4*)(AG + ((size_t)(g * 1024 + (m >> 5))) * 640 + (m & 31) * 16 + (lane & 1) * 8) = uu;
        }
    }
    SEAM(2);
    if (IN(3)) {
        FRESH_CX;
        { SchedPlain S; S.init(128, 6, cx.G, cx.wg); S.A = (const char*)LACT; S.B = (const char*)WL2; S.a_tile = 256 * 256 * 2; S.b_tile = 256 * 256 * 2;
          EpiBf16Plain E{WAG, 1536};
          pg8::gemm_phase<EpiBf16Plain, SchedPlain, true, true, false>(lds, cx.tid, OPQ(256), OPQ(256), OPQ(256), S, E); }
        { SchedS5 S; S.init(128, 1, cx.G, cx.wg); S.A = (const char*)AG; S.B = (const char*)S5ET; S.a_tile = 256 * 640 * 2; S.b_tile = 0; S.b_group = 256 * 512 * 2;
          EpiF32 E{EBUF, 256};
          pg8::gemm_phase<EpiF32, SchedS5, true, true, false>(lds, cx.tid, OPQ(512), OPQ(640), OPQ(512), S, E); }
    }
    SEAM(3);
    if (IN(4)) {
        FRESH_CX;
        if (cx.wave == 0 && cx.lane < 32) {
            for (int idx = cx.wg * 32 + cx.lane; idx < 8192; idx += cx.G * 32) { const int b = idx >> 11, g = (idx >> 6) & 31, p = idx & 63;
                const float ar = ATG[(g * 64 + p) * 2], ai = ATG[(g * 64 + p) * 2 + 1]; float sr = 0.f, si = 0.f;
                const size_t row0 = (size_t)g * 1024 + b * 256;
                for (int k0 = 0; k0 < 256; k0 += 16) { float er[16], ei[16];
#pragma unroll
                    for (int k = 0; k < 16; ++k) { er[k] = EBUF[(row0 + k0 + k) * 256 + p]; ei[k] = EBUF[(row0 + k0 + k) * 256 + 64 + p]; }
#pragma unroll
                    for (int k = 0; k < 16; ++k) { bf16* d = AG + (row0 + k0 + k) * 640 + 512 + p; d[0] = (bf16)(pk2(sr, 0.f) & 0xffffu); d[64] = (bf16)(pk2(si, 0.f) & 0xffffu);
                        const float nr = ar * sr - ai * si + er[k], ni = ar * si + ai * sr + ei[k]; sr = nr; si = ni; } }
            }
        }
        MAKE_RP;
        for (int ci = cx.wg; ci < 4096; ci += cx.G) rwkv_pass1_chunk(lds, RP, (cx.G == 256 ? (cx.wg * 16 + (ci >> 8)) : ci), cx.tid, QCT, HCT, W1G, ULG, DLG);
    }
    SEAM(4);
    if (IN(5)) {
        FRESH_CX;
        { SchedS5 S; S.init(128, 2, cx.G, cx.wg); S.A = (const char*)AG; S.B = (const char*)S5BT; S.a_tile = 256 * 640 * 2; S.b_tile = 256 * 640 * 2; S.b_group = 512 * 640 * 2;
          EpiS5Y E{AG, I[11], Y1};
          pg8::gemm_phase<EpiS5Y, SchedS5, true, true, false>(lds, cx.tid, OPQ(640), OPQ(640), OPQ(640), S, E); }
        if (cx.wave == 0) for (int it = cx.wg; it < 128; it += cx.G) rwkv_pass2(it >> 2, it & 3, cx.lane, QCT, HCT, DLG, S0G);
    }
    SEAM(5);
    if (IN(6)) {
        FRESH_CX;
        MAKE_RP;
        for (int ci = cx.wg; ci < 4096; ci += cx.G) rwkv_pass3_chunk(lds, RP, (cx.G == 256 ? (cx.wg * 16 + (ci >> 8)) : ci), cx.tid, S0G, W1G, ULG, MIX);
        __syncthreads();
        { SchedPlain S; S.init(128, 2, cx.G, cx.wg); S.A = (const char*)Y1; S.B = (const char*)WGLU; S.a_tile = 256 * 512 * 2; S.b_tile = 256 * 512 * 2;
          EpiGlu E{Y1, MIX};
          pg8::gemm_phase<EpiGlu, SchedPlain, true, true, false>(lds, cx.tid, OPQ(512), OPQ(512), OPQ(512), S, E); }
    }
    SEAM(6);
    if (IN(7)) {
        FRESH_CX;
        SchedPlain S; S.init(128, 4, cx.G, cx.wg); S.A = (const char*)MIX; S.B = (const char*)WOUT; S.a_tile = 256 * 1024 * 2; S.b_tile = 256 * 1024 * 2;
        EpiResid E{x, args.out};
        pg8::gemm_phase<EpiResid, SchedPlain, true, true, false>(lds, cx.tid, OPQ(1024), OPQ(1024), OPQ(1024), S, E);
    }
    SEAM(7);
    if (IN(8)) { FRESH_CX; router_phase(cx, args.out, I[29], I[30], I[31], H2, TOPE, TOPG, HIST); }
    SEAM(8);
    LAS int* PL = (LAS int*)(lds + LDS_PLAN);
    if (hi > 9 && lo < 28) { FRESH_CX; __syncthreads(); moe_plan(cx, HIST); }
    const int npass = (hi > 9 && lo < 28) ? PL[PL_NPASS] : 0;
    if (IN(9)) { FRESH_CX; dispatch_phase(cx, HIST, TOPE, SLOTTOK, TOKSLOT); convert_pass(cx, PL[PL_PE0], PL[PL_PE0 + 1], I[32], I[34], I[36], WGU, WDN); }
    SEAM(9);
    for (int p = 0; p < 6; ++p) {
        const bool actv = p < npass;
        const int e0 = actv ? PL[PL_PE0 + p] : 0, e1 = actv ? PL[PL_PE0 + p + 1] : 0, row0 = actv ? PL[PL_PROW0 + p] : 0, rows = actv ? PL[PL_PROW0 + p + 1] - row0 : 0;
        if (IN(10 + 3 * p) && actv) {
            FRESH_CX;
            SchedMoe<true> S; S.init(rows / 256, 8, cx.G, cx.wg); S.A = (const char*)H2; S.B = (const char*)WGU; S.a_tile = 0; S.b_tile = 256 * 1024 * 2; S.b_exp = (size_t)2048 * 1024 * 2; S.tile_e = PL + PL_TILEE; S.tile0 = row0 / 256; S.e0 = e0; S.slot_tok = SLOTTOK; S.row0 = row0;
            EpiGU E{ACT, I[33], I[35]};
            pg8::gemm_phase<EpiGU, SchedMoe<true>, true, true, true>(lds, cx.tid, OPQ(1024), OPQ(1024), OPQ(1024), S, E);
        }
        if (actv) SEAM(10 + 3 * p);
        if (IN(11 + 3 * p) && actv) {
            FRESH_CX;
            SchedMoe<false> S; S.init(rows / 256, 4, cx.G, cx.wg); S.A = (const char*)ACT; S.B = (const char*)WDN; S.a_tile = 256 * 1024 * 2; S.b_tile = 256 * 1024 * 2; S.b_exp = (size_t)1024 * 1024 * 2; S.tile_e = PL + PL_TILEE; S.tile0 = row0 / 256; S.e0 = e0; S.slot_tok = SLOTTOK; S.row0 = row0;
            EpiDown E{YB, I[37]};
            pg8::gemm_phase<EpiDown, SchedMoe<false>, true, true, false>(lds, cx.tid, OPQ(1024), OPQ(1024), OPQ(1024), S, E);
        }
        if (actv) SEAM(11 + 3 * p);
        if (IN(12 + 3 * p) && actv) {
            FRESH_CX;
            combine_pass(cx, e0, e1, row0, TOPE, TOPG, TOKSLOT, YB, args.out);
            if (p + 1 < npass) convert_pass(cx, PL[PL_PE0 + p + 1], PL[PL_PE0 + p + 2], I[32], I[34], I[36], WGU, WDN);
        }
        if (actv) SEAM(12 + 3 * p);
    }
    if (IN(28)) {
        FRESH_CX;
        bf16* H3 = (bf16*)(ws + WS_R1);
        for (int m = cx.gw; m < M; m += cx.NGW) rms_row_to_bf16(args.out + (size_t)m * 1024, I[38], H3 + (size_t)m * 1024, cx.lane);
        SchedPlain S; S.init(128, 4, cx.G, cx.wg); S.A = (const char*)PBF; S.B = (const char*)WPP; S.a_tile = 256 * 256 * 2; S.b_tile = 256 * 256 * 2;
        EpiBf16Plain E{PP, 1024};
        pg8::gemm_phase<EpiBf16Plain, SchedPlain, true, true, false>(lds, cx.tid, OPQ(256), OPQ(256), OPQ(256), S, E);
    }
    SEAM(28);
    if (IN(29)) {
        FRESH_CX;
        SchedPlain S; S.init(128, 4, cx.G, cx.wg); S.A = (const char*)(ws + WS_R1); S.B = (const char*)WPG; S.a_tile = 256 * 1024 * 2; S.b_tile = 256 * 1024 * 2;
        EpiPle E{PP, args.out};
        pg8::gemm_phase<EpiPle, SchedPlain, true, true, false>(lds, cx.tid, OPQ(1024), OPQ(1024), OPQ(1024), S, E);
    }
    SEAM(29);
    if (IN(30)) {
        FRESH_CX;
        for (int m = cx.gw; m < M; m += cx.NGW) {
            f32x4* xr = (f32x4*)(args.out + (size_t)m * 1024) + cx.lane; const f32x4* gr = (const f32x4*)I[41] + cx.lane; f32x4 v[4]; float s = 0.f;
#pragma unroll
            for (int j = 0; j < 4; ++j) { v[j] = xr[64 * j]; s += (v[j].x * v[j].x + v[j].y * v[j].y) + (v[j].z * v[j].z + v[j].w * v[j].w); }
            const float rinv = rsqrtf(wave_sum(s) * (1.f / 1024.f) + 1e-6f);
#pragma unroll
            for (int j = 0; j < 4; ++j) { const f32x4 gg = gr[64 * j]; xr[64 * j] = (f32x4){v[j].x * rinv * gg.x, v[j].y * rinv * gg.y, v[j].z * rinv * gg.z, v[j].w * rinv * gg.w}; }
        }
    }
#undef IN
#undef SEAM
}

extern "C" void kernel_launch(void* const* d_in, const int* in_sizes, int n_in, void* d_out, int out_size, void* d_ws, size_t ws_size, hipStream_t stream) {
    static int grid = 0;
    if (grid == 0) {
        if (n_in != 42 || out_size != M * DM || ws_size < WS_END) { fprintf(stderr, "kernel_launch: unexpected shapes (n_in %d out %d ws %zu)\n", n_in, out_size, ws_size); grid = -1; return; }
        int dev = 0, cus = 0, per_cu = 0;
        if (hipGetDevice(&dev) != hipSuccess || hipDeviceGetAttribute(&cus, hipDeviceAttributeMultiprocessorCount, dev) != hipSuccess) { grid = -1; return; }
        if (hipFuncSetAttribute((const void*)mk_fwd, hipFuncAttributeMaxDynamicSharedMemorySize, LDS_BYTES) != hipSuccess) { fprintf(stderr, "kernel_launch: hipFuncSetAttribute failed\n"); grid = -1; return; }
        if (hipOccupancyMaxActiveBlocksPerMultiprocessor(&per_cu, (const void*)mk_fwd, NTHR, LDS_BYTES) != hipSuccess || per_cu < 1) fprintf(stderr, "kernel_launch: occupancy query says %d\n", per_cu);
        (void)hipGetLastError();
        grid = cus > 256 ? 256 : cus;
    }
    if (grid < 0) return;
    (void)hipMemsetAsync((char*)d_ws + WS_CTL, 0, CTL_ZERO_BYTES, stream);
    Args a{};
    for (int i = 0; i < 42; ++i) a.in[i] = (const float*)d_in[i];
    a.out = (float*)d_out; a.ws = (unsigned char*)d_ws;
#if MK_PER_PHASE
    for (int ph = 0; ph < NPH; ++ph) { a.ph_lo = ph; a.ph_hi = ph + 1; hipLaunchKernelGGL(mk_fwd, dim3(grid), dim3(NTHR), LDS_BYTES, stream, a); }
#else
    a.ph_lo = 0; a.ph_hi = NPH;
    hipLaunchKernelGGL(mk_fwd, dim3(grid), dim3(NTHR), LDS_BYTES, stream, a);
#endif
}
```

```cpp
#include <hip/hip_runtime.h>
#include <cstdio>
#include <cstdint>

#ifndef MK_PER_PHASE
#define MK_PER_PHASE 0
#endif

#define LAS __attribute__((address_space(3)))
#define GAS __attribute__((address_space(1)))
typedef unsigned short bf16;
typedef short bf16x8 __attribute__((ext_vector_type(8)));
typedef float f32x4 __attribute__((ext_vector_type(4)));
typedef float f32x2 __attribute__((ext_vector_type(2)));
typedef unsigned u32x4 __attribute__((ext_vector_type(4)));
typedef unsigned u32x2 __attribute__((ext_vector_type(2)));
typedef GAS unsigned gu32;

constexpr int NB = 4, SEQ = 8192, DM = 1024, M = NB * SEQ;
constexpr int NEXP = 32, TOPK = 4;
constexpr int NWAVES = 8, NTHR = 512;
constexpr size_t MiB = 1u << 20;

constexpr size_t WS_CTL = 0, CTL_ZERO_BYTES = 1 * MiB;
constexpr size_t WS_HIST = 1 * MiB;
constexpr size_t WS_TOPE = 2 * MiB;
constexpr size_t WS_TOPG = 3 * MiB;
constexpr size_t WS_TOKSLOT = 4 * MiB;
constexpr size_t WS_SLOTTOK = 5 * MiB;
constexpr size_t WS_AT = 6 * MiB;
constexpr size_t WS_DL = 6 * MiB + 65536;
constexpr size_t WS_WCAT = 8 * MiB;
constexpr size_t WS_WL2 = 13 * MiB;
constexpr size_t WS_WGLU = 14 * MiB;
constexpr size_t WS_WPP = 14 * MiB + 524288;
constexpr size_t WS_WOUT = 15 * MiB;
constexpr size_t WS_WPG = 17 * MiB;
constexpr size_t WS_S5BT = 19 * MiB;
constexpr size_t WS_S5ET = 39 * MiB;
constexpr size_t WS_PBF = 48 * MiB;
constexpr size_t WS_R1 = 64 * MiB;
constexpr size_t WS_RKV = 128 * MiB;
constexpr size_t WS_WAG = 224 * MiB;
constexpr size_t WS_AG = 320 * MiB;
constexpr size_t WS_U = 360 * MiB;
constexpr size_t WS_LP = 392 * MiB;
constexpr size_t WS_LACT = 424 * MiB;
constexpr size_t WS_W1 = 440 * MiB;
constexpr size_t WS_ULOC = 472 * MiB;
constexpr size_t WS_Y1 = 504 * MiB;
constexpr size_t WS_H2 = 64 * MiB;
constexpr size_t WS_WDN = 96 * MiB;
constexpr size_t WS_ACT = 128 * MiB;
constexpr size_t WS_Y = 264 * MiB;
constexpr size_t WS_WGU = 264 * MiB;
constexpr int RMAX = 139264;
constexpr int MAXEPP = 32;
constexpr size_t WS_END = 560 * MiB;
static_assert(WS_Y + (size_t)RMAX * 2048 <= WS_END && WS_ACT + (size_t)RMAX * 1024 <= WS_Y, "moe map");

constexpr int CW_BAR = 4096;

constexpr int LDS_PLAN = 147456;
constexpr int LDS_MISC = 155648;
constexpr int LDS_BYTES = 156672;
constexpr int PL_CNT = 0, PL_PSTART = 32, PL_NPASS = 72, PL_PE0 = 80, PL_PROW0 = 88, PL_TILEE = 128, PL_TMP = 768;

#define LDS_WAIT() asm volatile("s_waitcnt lgkmcnt(0)" ::: "memory")
#define VM_WAIT() asm volatile("s_waitcnt vmcnt(0)" ::: "memory")
__device__ __forceinline__ float bf2f(unsigned b) { return __uint_as_float(b << 16); }
typedef __bf16 bf16n2 __attribute__((ext_vector_type(2)));
__device__ __forceinline__ unsigned cvt_pk_bf16(float lo, float hi) { const f32x2 f = {lo, hi}; const bf16n2 v = __builtin_convertvector(f, bf16n2); return __builtin_bit_cast(unsigned, v); }
__device__ __forceinline__ unsigned pk2(float lo, float hi) { return cvt_pk_bf16(lo, hi); }
__device__ __forceinline__ float lo16(unsigned w) { return __uint_as_float(w << 16); }
__device__ __forceinline__ float hi16(unsigned w) { return __uint_as_float(w & 0xffff0000u); }
__device__ __forceinline__ unsigned pk4_fp8(float a, float b, float c, float d) { unsigned w = 0u; w = (unsigned)__builtin_amdgcn_cvt_pk_fp8_f32(a, b, (int)w, false); w = (unsigned)__builtin_amdgcn_cvt_pk_fp8_f32(c, d, (int)w, true); return w; }
__device__ __forceinline__ float frcp(float x) { return __builtin_amdgcn_rcpf(x); }
__device__ __forceinline__ float fsigmoid(float x) { return frcp(1.0f + __expf(-x)); }
__device__ __forceinline__ float ftanh(float x) { const float e = __expf(-2.0f * fabsf(x)); const float t = (1.0f - e) * frcp(1.0f + e); return x < 0.f ? -t : t; }
__device__ __forceinline__ float gelu_tanh(float x) { const float u = 0.7978845608f * (x + 0.044715f * x * x * x); return 0.5f * x * (1.0f + ftanh(u)); }
__device__ __forceinline__ float wave_sum(float v) {
#pragma unroll
    for (int o = 1; o < 64; o <<= 1) v += __shfl_xor(v, o);
    return v;
}
__device__ __forceinline__ float wave_max(float v) {
#pragma unroll
    for (int o = 1; o < 64; o <<= 1) v = fmaxf(v, __shfl_xor(v, o));
    return v;
}

#define XB_TMO      128
#define XB_XCNT(j)  (256  + 64 * (j))
#define XB_XSUB(j)  (1280 + 64 * (j))
#define XB_XGEN(j)  (2304 + 64 * (j))
#define XB_TOP      3328
#define XB_TOPGEN   3392
#define XCD_BAR_WORDS 3456
#define XB_SPIN_CAP (1u << 22)

__device__ __forceinline__ unsigned xb_ld(unsigned* p)              { return __hip_atomic_load(p, __ATOMIC_RELAXED, __HIP_MEMORY_SCOPE_AGENT); }
__device__ __forceinline__ unsigned xb_add(unsigned* p, unsigned v) { return __hip_atomic_fetch_add(p, v, __ATOMIC_RELAXED, __HIP_MEMORY_SCOPE_AGENT); }
__device__ __forceinline__ unsigned xb_xcc_id() { return (unsigned)__builtin_amdgcn_s_getreg((3 << 11) | 20) & 0xFu; }
#define XB_SPIN(cond, bar) do { unsigned _sp = 0; while (cond) { __builtin_amdgcn_s_sleep(1); \
    if ((++_sp & 255u) == 0u) { if (xb_ld(&(bar)[XB_TMO])) break; if (_sp > XB_SPIN_CAP) { atomicAdd(&(bar)[XB_TMO], 1u); break; } } } } while (0)

struct XcdBarrier { unsigned* bar; unsigned x; volatile LAS unsigned* st; };

__device__ __forceinline__ XcdBarrier xcd_barrier_post(unsigned* bar, volatile LAS unsigned* st) {
    XcdBarrier b; b.bar = bar; b.x = xb_xcc_id(); b.st = st;
    if (threadIdx.x == 0) (void)xb_add(&bar[XB_XCNT(b.x)], 1u);
    return b;
}
__device__ __forceinline__ void xcd_barrier_complete(unsigned* bar, unsigned x, unsigned& nloc, unsigned& nx) {
    const unsigned G = gridDim.x * gridDim.y * gridDim.z;
    unsigned sum, cnt, mine, sp = 0u;
    for (;;) {
        sum = 0u; cnt = 0u; mine = 0u;
#pragma unroll
        for (unsigned j = 0; j < 16; ++j) { const unsigned c = xb_ld(&bar[XB_XCNT(j)]); sum += c; cnt += (c > 0u) ? 1u : 0u; mine = (j == x) ? c : mine; }
        if (sum == G) break;
        __builtin_amdgcn_s_sleep(1);
        if ((++sp & 255u) == 0u) { if (xb_ld(&bar[XB_TMO])) break; if (sp > XB_SPIN_CAP) { atomicAdd(&bar[XB_TMO], 1u); break; } }
    }
    nloc = mine > 0u ? mine : 1u; nx = cnt > 0u ? cnt : 1u;
}
__device__ __forceinline__ void xcd_barrier(const XcdBarrier& b) {
    asm volatile("s_waitcnt vmcnt(0)" ::: "memory");
    __syncthreads();
    if (threadIdx.x == 0) {
        unsigned* bar = b.bar;
        __builtin_amdgcn_s_waitcnt(0);
        unsigned nloc = b.st[0], nx = b.st[1];
        if (nloc == 0u) { xcd_barrier_complete(bar, b.x, nloc, nx); b.st[0] = nloc; b.st[1] = nx; }
        const unsigned old = xb_add(&bar[XB_XSUB(b.x)], 1u);
        const unsigned gen = old / nloc;
        if (old + 1u == (gen + 1u) * nloc) {
            __builtin_amdgcn_fence(__ATOMIC_RELEASE, "agent");
            asm volatile("s_waitcnt vmcnt(0)" ::: "memory");
            const unsigned og = xb_add(&bar[XB_TOP], 1u);
            const unsigned tg = og / nx;
            if (og + 1u == (tg + 1u) * nx) xb_add(&bar[XB_TOPGEN], 1u);
            else XB_SPIN(xb_ld(&bar[XB_TOPGEN]) == tg, bar);
            __builtin_amdgcn_fence(__ATOMIC_ACQUIRE, "agent");
            xb_add(&bar[XB_XGEN(b.x)], 1u);
            asm volatile("s_waitcnt vmcnt(0)" ::: "memory");
        } else {
            XB_SPIN(xb_ld(&bar[XB_XGEN(b.x)]) == gen, bar);
            __builtin_amdgcn_fence(__ATOMIC_ACQUIRE, "agent");
            asm volatile("s_waitcnt vmcnt(0)" ::: "memory");
        }
    }
    __syncthreads();
}

namespace pg8 {
constexpr int BM = 256, BK = 64, HALF = 128, HTB = HALF * BK * 2, STAGE_BYTES = 8 * HTB, NXCD = 8, WGM = 8;
__host__ __device__ __forceinline__ int lds_byte(int r, int c) { const int st = (r >> 4) * 2 + (c >> 5), rr = r & 15, cc = c & 31, ob = rr * 64 + cc * 2; return st * 1024 + (ob ^ (((ob >> 9) & 1) << 5)); }
__host__ __device__ __forceinline__ void stage_rc(int b, int& R, int& C) { const int st = b / 1024, sb = b % 1024, swz = sb ^ (((sb >> 9) & 1) << 5); R = (st >> 1) * 16 + swz / 64; C = (st & 1) * 32 + (swz % 64) / 2; }
__host__ __device__ __forceinline__ int perm32(int rho) { const int n = rho >> 4, i = rho & 15; return 8 * (i >> 2) + 4 * n + (i & 3); }

struct Unit { int pm, pn, aux; };

struct Order {
    int nM, nN, nwg, G, c;
    __device__ __forceinline__ void init(int nM_, int nN_, int G_, int c_) { nM = nM_; nN = nN_; nwg = nM * nN; G = G_; c = c_; }
    __device__ __forceinline__ bool tile(int i, int& pm, int& pn) const {
        const long L = (long)i * G + c; if (L >= nwg) return false;
        int wgid = (int)L; { const int q = nwg / NXCD, r = nwg % NXCD, xcd = wgid % NXCD, off = wgid / NXCD; wgid = (xcd < r ? xcd * (q + 1) : r * (q + 1) + (xcd - r) * q) + off; }
        const int nig = WGM * nN, gid = wgid / nig, fm = gid * WGM, gsz = (nM - fm) < WGM ? (nM - fm) : WGM;
        pm = fm + ((wgid % nig) % gsz); pn = (wgid % nig) / gsz; return true;
    }
};


template <class Epi, class Sched, bool ALIGN_EPI, bool SP2, bool GATHER, bool FP8 = false>
__device__ __forceinline__ void gemm_phase(LAS unsigned char* lds, const int tid, const int K, const int lda, const int ldb, const Sched& S, const Epi& E) {
    const int wid = __builtin_amdgcn_readfirstlane(tid >> 6), lane = tid & 63, wr = wid >> 2, wc = wid & 3, fr = lane & 15, fq = lane >> 4;
    const int nt = K / BK;
    unsigned voffA[2], voffB[2]; int rA[2], cA2[2];
#pragma unroll
    for (int i = 0; i < 2; ++i) { int R, C; stage_rc(tid * 16 + i * 8192, R, C); const int Rb = Epi::PERM ? ((R & ~31) + perm32(R & 31)) : R;
        voffA[i] = (unsigned)(R * lda + C) * 2u; voffB[i] = (unsigned)(Rb * ldb + C) * 2u; rA[i] = R; cA2[i] = C * 2; }
    const size_t kstep = (size_t)(BK * 2);
    const size_t hstepA = (size_t)HALF * lda * 2, hstepB = (size_t)HALF * ldb * 2;
    const unsigned ldsw = (unsigned)wid * 1024u;
    const int aoff = FP8 ? lds_byte(wr * 64 + fr, fq * 16) : lds_byte(wr * 64 + fr, fq * 8), boff = FP8 ? lds_byte(wc * 32 + fr, fq * 16) : lds_byte(wc * 32 + fr, fq * 8);
    unsigned cv0[2] = {0u, 0u}, cv1[2] = {0u, 0u}, nv0[2] = {0u, 0u}, nv1[2] = {0u, 0u};
#define PG8_SA(b, h) (((b) * 2 + (h)) * HTB)
#define PG8_SB(b, h) ((4 + (b) * 2 + (h)) * HTB)
#define PG8_STAGE(bufoff, gbase, voff) do { _Pragma("unroll") for (int _i = 0; _i < 2; ++_i) \
        __builtin_amdgcn_global_load_lds((const unsigned*)((const char*)(gbase) + (voff)[_i]), (LAS unsigned*)(lds + (bufoff) + ldsw + _i * 8192), 16, 0, 0); } while (0)
#define PG8_STAGE_A(bufoff, ptr, h, nx) do { if constexpr (GATHER) { unsigned _v[2]; _v[0] = (nx) ? ((h) ? nv1[0] : nv0[0]) : ((h) ? cv1[0] : cv0[0]); _v[1] = (nx) ? ((h) ? nv1[1] : nv0[1]) : ((h) ? cv1[1] : cv0[1]); PG8_STAGE(bufoff, ptr, _v); } \
        else { PG8_STAGE(bufoff, (ptr) + (h) * hstepA, voffA); } } while (0)
#define PG8_LDA(dst, b, h) do { if constexpr (FP8) { _Pragma("unroll") for (int m = 0; m < 4; ++m) { dst##8[m].lo = *(const LAS v4i_*)(lds + PG8_SA(b, h) + aoff + m * 2048); dst##8[m].hi = *(const LAS v4i_*)(lds + PG8_SA(b, h) + aoff + m * 2048 + 16); } } \
        else { _Pragma("unroll") for (int m = 0; m < 4; ++m) _Pragma("unroll") for (int k = 0; k < 2; ++k) dst[m][k] = *(const LAS bf16x8*)(lds + PG8_SA(b, h) + aoff + m * 2048 + k * 1024); } } while (0)
#define PG8_LDB(dst, b, h) do { if constexpr (FP8) { _Pragma("unroll") for (int n = 0; n < 2; ++n) { dst##8[n].lo = *(const LAS v4i_*)(lds + PG8_SB(b, h) + boff + n * 2048); dst##8[n].hi = *(const LAS v4i_*)(lds + PG8_SB(b, h) + boff + n * 2048 + 16); } } \
        else { _Pragma("unroll") for (int n = 0; n < 2; ++n) _Pragma("unroll") for (int k = 0; k < 2; ++k) dst[n][k] = *(const LAS bf16x8*)(lds + PG8_SB(b, h) + boff + n * 2048 + k * 1024); } } while (0)
#define PG8_MMA(ai, bj, At, Bt) do { __builtin_amdgcn_s_setprio(1); _Pragma("unroll") for (int m = 0; m < 4; ++m) _Pragma("unroll") for (int n = 0; n < 2; ++n) { \
        if constexpr (FP8) asm volatile("v_mfma_scale_f32_16x16x128_f8f6f4 %0, %1, %2, %0, %3, %4 op_sel_hi:[0,0,0]" : "+v"(acc[ai][bj][m][n]) : "v"(Bt##8[n]), "v"(At##8[m]), "v"(sclW), "v"(sclA));   \
        else { _Pragma("unroll") for (int k = 0; k < 2; ++k) acc[ai][bj][m][n] = __builtin_amdgcn_mfma_f32_16x16x32_bf16(Bt[n][k], At[m][k], acc[ai][bj][m][n], 0, 0, 0); } } \
        __builtin_amdgcn_s_setprio(0); } while (0)
#define PG8_WAIT_V(n) asm volatile("s_waitcnt vmcnt(" #n ")" ::: "memory")
#define PG8_WAIT_L(n) asm volatile("s_waitcnt lgkmcnt(" #n ")" ::: "memory")
#define PG8_BAR __builtin_amdgcn_s_barrier()
#define PG8_SCHED __builtin_amdgcn_sched_barrier(0)
#define PG8_ROWS(u, d0, d1) do { _Pragma("unroll") for (int _i = 0; _i < 2; ++_i) { const int _r0 = S.a_row(u, rA[_i]), _r1 = S.a_row(u, HALF + rA[_i]); \
        d0[_i] = (unsigned)_r0 * (unsigned)(lda * 2) + (unsigned)cA2[_i]; d1[_i] = (unsigned)_r1 * (unsigned)(lda * 2) + (unsigned)cA2[_i]; } } while (0)
    Unit cur, nxt; int ui = 0;
    if (!S.next(0, cur)) return;
    f32x4 acc[2][2][4][2];
#pragma unroll
    for (int a = 0; a < 2; ++a)
#pragma unroll
        for (int b = 0; b < 2; ++b)
#pragma unroll
            for (int m = 0; m < 4; ++m)
#pragma unroll
                for (int n = 0; n < 2; ++n) acc[a][b][m][n] = (f32x4){0.f, 0.f, 0.f, 0.f};
    typedef int v8i_ __attribute__((ext_vector_type(8))); typedef int v4i_ __attribute__((ext_vector_type(4)));
    bf16x8 At[4][2], B0[2][2], B1[2][2]; v8i_ At8[4], B08[2], B18[2];
    const int sclW = 0x7a7a7a7a, sclA = 0x7f7f7f7f;
    const char* cA = S.a_ptr(cur); const char* cB = S.b_ptr(cur);
    if constexpr (GATHER) { PG8_ROWS(cur, cv0, cv1); }
    if constexpr (SP2) {
        PG8_STAGE(PG8_SB(0, 0), cB, voffB); PG8_STAGE(PG8_SB(0, 1), cB + hstepB, voffB); PG8_STAGE_A(PG8_SA(0, 0), cA, 0, false); PG8_STAGE_A(PG8_SA(0, 1), cA, 1, false);
        if (wr == 1) PG8_BAR;
        PG8_WAIT_V(2); PG8_BAR;
        PG8_STAGE(PG8_SB(1, 0), cB + kstep, voffB); PG8_STAGE_A(PG8_SA(1, 0), cA + kstep, 0, false); PG8_STAGE(PG8_SB(1, 1), cB + hstepB + kstep, voffB);
        PG8_WAIT_V(6); PG8_BAR;
    } else {
        PG8_STAGE(PG8_SB(0, 0), cB, voffB); PG8_STAGE_A(PG8_SA(0, 0), cA, 0, false); PG8_STAGE(PG8_SB(0, 1), cB + hstepB, voffB); PG8_STAGE_A(PG8_SA(0, 1), cA, 1, false);
        if (wr == 1) PG8_BAR;
        PG8_WAIT_V(4); PG8_BAR;
        PG8_STAGE(PG8_SB(1, 0), cB + kstep, voffB); PG8_STAGE_A(PG8_SA(1, 0), cA + kstep, 0, false); PG8_STAGE(PG8_SB(1, 1), cB + hstepB + kstep, voffB);
        PG8_WAIT_V(6); PG8_BAR;
    }
    for (;;) {
        const bool has_next = S.next(ui + 1, nxt);
        const char* nA = has_next ? S.a_ptr(nxt) : cA; const char* nB = has_next ? S.b_ptr(nxt) : cB;
        if constexpr (GATHER) { if (has_next) { PG8_ROWS(nxt, nv0, nv1); } else { nv0[0] = cv0[0]; nv0[1] = cv0[1]; nv1[0] = cv1[0]; nv1[1] = cv1[1]; } }
        for (int t = 0; t < nt; t += 2) {
            const bool last = (t == nt - 2);
            const char* a1 = cA + (size_t)(t + 1) * kstep;
            const char* a2 = last ? nA : cA + (size_t)(t + 2) * kstep; const char* b2 = last ? nB : cB + (size_t)(t + 2) * kstep;
            const char* a3 = a2 + kstep; const char* b3 = b2 + kstep;
            if constexpr (SP2) {
            PG8_LDB(B0, 0, 0); PG8_LDB(B1, 0, 1); PG8_SCHED; PG8_LDA(At, 0, 0); PG8_STAGE_A(PG8_SA(1, 1), a1, 1, false);
            PG8_WAIT_V(8); PG8_WAIT_L(0); PG8_BAR; PG8_MMA(0, 0, At, B0); PG8_MMA(0, 1, At, B1); PG8_BAR; PG8_SCHED;
            PG8_LDA(At, 0, 1); PG8_STAGE(PG8_SB(0, 0), b2, voffB); PG8_STAGE(PG8_SB(0, 1), b2 + hstepB, voffB); PG8_STAGE_A(PG8_SA(0, 0), a2, 0, last);
            PG8_WAIT_V(8); PG8_WAIT_L(0); PG8_BAR; PG8_MMA(1, 0, At, B0); PG8_MMA(1, 1, At, B1); PG8_BAR; PG8_SCHED;
            PG8_LDB(B0, 1, 0); PG8_LDB(B1, 1, 1); PG8_SCHED; PG8_LDA(At, 1, 0); PG8_STAGE_A(PG8_SA(0, 1), a2, 1, last);
            PG8_WAIT_V(8); PG8_WAIT_L(0); PG8_BAR; PG8_MMA(0, 0, At, B0); PG8_MMA(0, 1, At, B1); PG8_BAR; PG8_SCHED;
            PG8_LDA(At, 1, 1); PG8_STAGE(PG8_SB(1, 0), b3, voffB); PG8_STAGE(PG8_SB(1, 1), b3 + hstepB, voffB); PG8_STAGE_A(PG8_SA(1, 0), a3, 0, last);
            PG8_WAIT_V(8); PG8_WAIT_L(0); PG8_BAR; PG8_MMA(1, 0, At, B0); PG8_MMA(1, 1, At, B1); PG8_BAR; PG8_SCHED;
            } else {
            PG8_LDB(B0, 0, 0); PG8_SCHED; PG8_LDA(At, 0, 0); PG8_STAGE_A(PG8_SA(1, 1), a1, 1, false);
            PG8_WAIT_L(8); PG8_BAR; PG8_WAIT_L(0); PG8_MMA(0, 0, At, B0); PG8_BAR; PG8_SCHED;
            PG8_LDB(B1, 0, 1); PG8_STAGE(PG8_SB(0, 0), b2, voffB);
            PG8_BAR; PG8_WAIT_L(0); PG8_MMA(0, 1, At, B1); PG8_BAR;
            PG8_LDA(At, 0, 1); PG8_STAGE_A(PG8_SA(0, 0), a2, 0, last);
            PG8_BAR; PG8_WAIT_L(0); PG8_MMA(1, 0, At, B0); PG8_BAR; PG8_SCHED;
            PG8_STAGE(PG8_SB(0, 1), b2 + hstepB, voffB);
            PG8_WAIT_V(6); PG8_BAR; PG8_MMA(1, 1, At, B1); PG8_BAR;
            PG8_LDB(B0, 1, 0); PG8_SCHED; PG8_LDA(At, 1, 0); PG8_STAGE_A(PG8_SA(0, 1), a2, 1, last);
            PG8_WAIT_L(8); PG8_BAR; PG8_WAIT_L(0); PG8_MMA(0, 0, At, B0); PG8_BAR; PG8_SCHED;
            PG8_LDB(B1, 1, 1); PG8_STAGE(PG8_SB(1, 0), b3, voffB);
            PG8_BAR; PG8_WAIT_L(0); PG8_MMA(0, 1, At, B1); PG8_BAR;
            PG8_LDA(At, 1, 1); PG8_STAGE_A(PG8_SA(1, 0), a3, 0, last);
            PG8_BAR; PG8_WAIT_L(0); PG8_MMA(1, 0, At, B0); PG8_BAR; PG8_SCHED;
            PG8_STAGE(PG8_SB(1, 1), b3 + hstepB, voffB);
            PG8_WAIT_V(6); PG8_BAR; PG8_MMA(1, 1, At, B1); PG8_BAR;
            }
        }
        if constexpr (ALIGN_EPI) { if (wr == 0) PG8_BAR; }
        if constexpr (FP8) asm volatile("s_nop 15\n\ts_nop 15" ::: "memory");
        E(acc, cur, wr, wc, fr, fq);
        if (!has_next) break;
#pragma unroll
        for (int a = 0; a < 2; ++a)
#pragma unroll
            for (int b = 0; b < 2; ++b)
#pragma unroll
                for (int m = 0; m < 4; ++m)
#pragma unroll
                    for (int n = 0; n < 2; ++n) acc[a][b][m][n] = (f32x4){0.f, 0.f, 0.f, 0.f};
        cur = nxt; cA = nA; cB = nB; ++ui;
        if constexpr (GATHER) { cv0[0] = nv0[0]; cv0[1] = nv0[1]; cv1[0] = nv1[0]; cv1[1] = nv1[1]; }
        if constexpr (ALIGN_EPI) { if (wr == 1) PG8_BAR; }
    }
    PG8_WAIT_V(0);
    if constexpr (!ALIGN_EPI) { if (wr == 0) PG8_BAR; }
    PG8_BAR;
#undef PG8_SA
#undef PG8_SB
#undef PG8_STAGE
#undef PG8_STAGE_A
#undef PG8_LDA
#undef PG8_LDB
#undef PG8_MMA
#undef PG8_WAIT_V
#undef PG8_WAIT_L
#undef PG8_BAR
#undef PG8_SCHED
#undef PG8_ROWS
}
}

using pg8::Unit;
struct SchedPlain : pg8::Order {
    const char* A; const char* B; size_t a_tile, b_tile;
    __device__ __forceinline__ bool next(int i, Unit& u) const { u.aux = 0; return tile(i, u.pm, u.pn); }
    __device__ __forceinline__ const char* a_ptr(const Unit& u) const { return A + (size_t)u.pm * a_tile; }
    __device__ __forceinline__ const char* b_ptr(const Unit& u) const { return B + (size_t)u.pn * b_tile; }
    __device__ __forceinline__ int a_row(const Unit&, int) const { return 0; }
};
struct SchedS5 : pg8::Order {
    const char* A; const char* B; size_t a_tile, b_tile, b_group;
    __device__ __forceinline__ bool next(int i, Unit& u) const { u.aux = 0; return tile(i, u.pm, u.pn); }
    __device__ __forceinline__ const char* a_ptr(const Unit& u) const { return A + (size_t)u.pm * a_tile; }
    __device__ __forceinline__ const char* b_ptr(const Unit& u) const { return B + (size_t)(u.pm >> 2) * b_group + (size_t)u.pn * b_tile; }
    __device__ __forceinline__ int a_row(const Unit&, int) const { return 0; }
};
template <bool GATHER> struct SchedMoe : pg8::Order {
    const char* A; const char* B; size_t a_tile, b_tile, b_exp; const LAS int* tile_e; int tile0, e0; const int* slot_tok; int row0;
    __device__ __forceinline__ bool next(int i, Unit& u) const { const bool ok = tile(i, u.pm, u.pn); u.aux = ok ? tile_e[tile0 + u.pm] : 0; return ok; }
    __device__ __forceinline__ const char* a_ptr(const Unit& u) const { return GATHER ? A : A + (size_t)u.pm * a_tile; }
    __device__ __forceinline__ const char* b_ptr(const Unit& u) const { return B + (size_t)(u.aux - e0) * b_exp + (size_t)u.pn * b_tile; }
    __device__ __forceinline__ int a_row(const Unit& u, int r) const { return slot_tok[row0 + u.pm * 256 + r]; }
};

__device__ __forceinline__ void st8(bf16* p, const f32x4 v0, const f32x4 v1) {
    u32x4 w; w.x = cvt_pk_bf16(v0[0], v0[1]); w.y = cvt_pk_bf16(v0[2], v0[3]); w.z = cvt_pk_bf16(v1[0], v1[1]); w.w = cvt_pk_bf16(v1[2], v1[3]); *(u32x4*)p = w;
}
__device__ __forceinline__ void ld8(const bf16* p, f32x4& v0, f32x4& v1) {
    const u32x4 w = *(const u32x4*)p; v0 = (f32x4){lo16(w.x), hi16(w.x), lo16(w.y), hi16(w.y)}; v1 = (f32x4){lo16(w.z), hi16(w.z), lo16(w.w), hi16(w.w)};
}
#define EPI_LOOP_AM _Pragma("unroll") for (int ai = 0; ai < 2; ++ai) _Pragma("unroll") for (int m = 0; m < 4; ++m)
#define EPI_ARGS const f32x4 (&acc)[2][2][4][2], const Unit& u, int wr, int wc, int fr, int fq

struct EpiProj { static constexpr bool PERM = true; bf16 *U, *RKV, *LP;
    __device__ __forceinline__ void operator()(EPI_ARGS) const {
        bf16* base; int ldc, c0;
        if (u.pn < 2) { base = U; ldc = 512; c0 = u.pn * 256; } else if (u.pn < 8) { base = RKV; ldc = 1536; c0 = (u.pn - 2) * 256; } else { base = LP; ldc = 512; c0 = (u.pn - 8) * 256; }
        const int row0 = u.pm * 256 + wr * 64 + fr, col0 = c0 + wc * 32 + 8 * fq;
        EPI_LOOP_AM { bf16* rowp = base + (size_t)(row0 + ai * 128 + m * 16) * ldc + col0;
#pragma unroll
            for (int bj = 0; bj < 2; ++bj) st8(rowp + bj * 128, acc[ai][bj][m][0], acc[ai][bj][m][1]); }
    }
};
struct EpiBf16Plain { static constexpr bool PERM = true; bf16* O; int ldc;
    __device__ __forceinline__ void operator()(EPI_ARGS) const {
        const int row0 = u.pm * 256 + wr * 64 + fr, col0 = u.pn * 256 + wc * 32 + 8 * fq;
        EPI_LOOP_AM { bf16* rowp = O + (size_t)(row0 + ai * 128 + m * 16) * ldc + col0;
#pragma unroll
            for (int bj = 0; bj < 2; ++bj) st8(rowp + bj * 128, acc[ai][bj][m][0], acc[ai][bj][m][1]); }
    }
};
struct EpiF32 { static constexpr bool PERM = false; float* C; int ldc;
    __device__ __forceinline__ void operator()(EPI_ARGS) const {
        const int row0 = u.pm * 256 + wr * 64 + fr, col0 = u.pn * 256 + wc * 32 + 4 * fq;
        EPI_LOOP_AM { float* rowp = C + (size_t)(row0 + ai * 128 + m * 16) * ldc + col0;
#pragma unroll
            for (int bj = 0; bj < 2; ++bj)
#pragma unroll
                for (int n = 0; n < 2; ++n) *(f32x4*)(rowp + bj * 128 + n * 16) = acc[ai][bj][m][n]; }
    }
};
struct EpiS5Y { static constexpr bool PERM = true; const bf16* AG; const float* dskip; bf16* Y1;
    __device__ __forceinline__ void operator()(EPI_ARGS) const {
        const int g = u.pm >> 2, crow0 = (u.pm & 3) * 256 + wr * 64 + fr, col0 = u.pn * 256 + wc * 32 + 8 * fq;
        EPI_LOOP_AM { const int crow = crow0 + ai * 128 + m * 16;
#pragma unroll
            for (int bj = 0; bj < 2; ++bj) { const int col = col0 + bj * 128, t = col >> 4, c = col & 15;
                f32x4 u0, u1; ld8(AG + ((size_t)(g * 1024 + crow)) * 640 + col, u0, u1);
                const f32x4 d0 = *(const f32x4*)(dskip + g * 16 + c), d1 = *(const f32x4*)(dskip + g * 16 + c + 4);
                f32x4 v0 = acc[ai][bj][m][0] + d0 * u0, v1 = acc[ai][bj][m][1] + d1 * u1;
#pragma unroll
                for (int j = 0; j < 4; ++j) { v0[j] = gelu_tanh(v0[j]); v1[j] = gelu_tanh(v1[j]); }
                st8(Y1 + (size_t)(crow * 32 + t) * 512 + g * 16 + c, v0, v1); } }
    }
};
struct EpiGlu { static constexpr bool PERM = true; const bf16* Y1; bf16* MIX;
    __device__ __forceinline__ void operator()(EPI_ARGS) const {
        const int row0 = u.pm * 256 + wr * 64 + fr, col0 = u.pn * 256 + wc * 32 + 8 * fq;
        EPI_LOOP_AM { const int row = row0 + ai * 128 + m * 16;
#pragma unroll
            for (int bj = 0; bj < 2; ++bj) { const int col = col0 + bj * 128; f32x4 y0, y1v; ld8(Y1 + (size_t)row * 512 + col, y0, y1v);
                f32x4 v0, v1;
#pragma unroll
                for (int j = 0; j < 4; ++j) { v0[j] = y0[j] * fsigmoid(acc[ai][bj][m][0][j]); v1[j] = y1v[j] * fsigmoid(acc[ai][bj][m][1][j]); }
                st8(MIX + (size_t)row * 1024 + col, v0, v1); } }
    }
};
struct EpiResid { static constexpr bool PERM = false; const float* X; float* O;
    __device__ __forceinline__ void operator()(EPI_ARGS) const {
        const int row0 = u.pm * 256 + wr * 64 + fr, col0 = u.pn * 256 + wc * 32 + 4 * fq;
        EPI_LOOP_AM { const size_t off = (size_t)(row0 + ai * 128 + m * 16) * 1024 + col0;
#pragma unroll
            for (int bj = 0; bj < 2; ++bj)
#pragma unroll
                for (int n = 0; n < 2; ++n) *(f32x4*)(O + off + bj * 128 + n * 16) = *(const f32x4*)(X + off + bj * 128 + n * 16) + acc[ai][bj][m][n]; }
    }
};
struct EpiGU { static constexpr bool PERM = true; unsigned char* ACT; const float* bg; const float* bu;
    __device__ __forceinline__ void operator()(EPI_ARGS) const {
        const int row0 = u.pm * 256 + wr * 64 + fr, col = u.pn * 128 + wc * 32 + 8 * fq; const int e = u.aux;
        const f32x4 g0 = *(const f32x4*)(bg + e * 1024 + col), g1 = *(const f32x4*)(bg + e * 1024 + col + 4), u0 = *(const f32x4*)(bu + e * 1024 + col), u1 = *(const f32x4*)(bu + e * 1024 + col + 4);
        EPI_LOOP_AM { f32x4 v0, v1;
#pragma unroll
            for (int j = 0; j < 4; ++j) {
                const float gt0 = fminf(acc[ai][0][m][0][j] + g0[j], 7.0f), up0 = fminf(fmaxf(acc[ai][1][m][0][j] + u0[j], -7.0f), 7.0f);
                const float gt1 = fminf(acc[ai][0][m][1][j] + g1[j], 7.0f), up1 = fminf(fmaxf(acc[ai][1][m][1][j] + u1[j], -7.0f), 7.0f);
                v0[j] = (up0 + 1.0f) * gt0 * fsigmoid(1.702f * gt0); v1[j] = (up1 + 1.0f) * gt1 * fsigmoid(1.702f * gt1); }
            u32x2 w; w.x = pk4_fp8(v0[0], v0[1], v0[2], v0[3]); w.y = pk4_fp8(v1[0], v1[1], v1[2], v1[3]); *(u32x2*)(ACT + (size_t)(row0 + ai * 128 + m * 16) * 1024 + col) = w; }
    }
};
struct EpiDown { static constexpr bool PERM = true; bf16* Y; const float* bd;
    __device__ __forceinline__ void operator()(EPI_ARGS) const {
        const int row0 = u.pm * 256 + wr * 64 + fr, col0 = u.pn * 256 + wc * 32 + 8 * fq; const int e = u.aux;
        EPI_LOOP_AM { bf16* rowp = Y + (size_t)(row0 + ai * 128 + m * 16) * 1024 + col0;
#pragma unroll
            for (int bj = 0; bj < 2; ++bj) { const f32x4 b0 = *(const f32x4*)(bd + e * 1024 + col0 + bj * 128), b1 = *(const f32x4*)(bd + e * 1024 + col0 + bj * 128 + 4);
                st8(rowp + bj * 128, acc[ai][bj][m][0] + b0, acc[ai][bj][m][1] + b1); } }
    }
};
struct EpiPle { static constexpr bool PERM = false; const bf16* PP; float* O;
    __device__ __forceinline__ void operator()(EPI_ARGS) const {
        const int row0 = u.pm * 256 + wr * 64 + fr, col0 = u.pn * 256 + wc * 32 + 4 * fq;
        EPI_LOOP_AM { const size_t off = (size_t)(row0 + ai * 128 + m * 16) * 1024 + col0;
#pragma unroll
            for (int bj = 0; bj < 2; ++bj)
#pragma unroll
                for (int n = 0; n < 2; ++n) { const size_t o = off + bj * 128 + n * 16; const u32x2 w = *(const u32x2*)(PP + o); const f32x4 pp = (f32x4){lo16(w.x), hi16(w.x), lo16(w.y), hi16(w.y)};
                    f32x4 x = *(const f32x4*)(O + o);
#pragma unroll
                    for (int j = 0; j < 4; ++j) x[j] += pp[j] * fsigmoid(acc[ai][bj][m][n][j]);
                    *(f32x4*)(O + o) = x; } }
    }
};

struct Ctx { LAS unsigned char* lds; int tid, lane, wave, G, wg, gw, NGW; };

template <int NBW>
__device__ __forceinline__ void transpose_item(const float* W, int N, int k0, int n0, bf16* dst, int ldk, const float* scl, int flip, LAS float* scr, int lane) {
    constexpr int LPR = NBW / 4, RPI = 64 / LPR, NI = 64 / RPI;
    const int rr = lane / LPR, cc = (lane % LPR) * 4;
    f32x4 v[NI];
#pragma unroll
    for (int i = 0; i < NI; ++i) v[i] = *(const f32x4*)(W + (size_t)(k0 + i * RPI + rr) * N + n0 + cc);
#pragma unroll
    for (int i = 0; i < NI; ++i) { const int kk = i * RPI + rr; f32x4 x = v[i];
        if (scl) { const float s0 = scl[k0 + kk]; const float f = flip ? (1.0f - s0) : s0; x = x * f; }
        LAS float* d = scr + kk * 65 + cc; d[0] = x.x; d[1] = x.y; d[2] = x.z; d[3] = x.w; }
    LDS_WAIT(); asm volatile("" ::: "memory");
    const int c = lane & 7;
#pragma unroll
    for (int j = 0; j < NBW / 8; ++j) { const int n = (lane >> 3) + 8 * j; const LAS float* s = scr + (8 * c) * 65 + n;
        u32x4 o; o.x = pk2(s[0 * 65], s[1 * 65]); o.y = pk2(s[2 * 65], s[3 * 65]); o.z = pk2(s[4 * 65], s[5 * 65]); o.w = pk2(s[6 * 65], s[7 * 65]);
        *(u32x4*)(dst + (size_t)n * ldk + 8 * c) = o; }
    LDS_WAIT(); asm volatile("" ::: "memory");
}
__device__ __forceinline__ void transpose_item_fp8(const float* W, int N, int k0, int n0, unsigned char* dst, int ldk, float scale, LAS float* scr, int lane) {
    const int rr = lane >> 4, cc = (lane & 15) * 4;
    f32x4 v[16];
#pragma unroll
    for (int i = 0; i < 16; ++i) v[i] = *(const f32x4*)(W + (size_t)(k0 + i * 4 + rr) * N + n0 + cc);
#pragma unroll
    for (int i = 0; i < 16; ++i) { const int kk = i * 4 + rr; LAS float* d = scr + kk * 65 + cc; d[0] = v[i].x * scale; d[1] = v[i].y * scale; d[2] = v[i].z * scale; d[3] = v[i].w * scale; }
    LDS_WAIT(); asm volatile("" ::: "memory");
    const int c = lane & 3;
#pragma unroll
    for (int j = 0; j < 4; ++j) { const int n = (lane >> 2) + 16 * j; const LAS float* s = scr + (16 * c) * 65 + n;
        u32x4 o; o.x = pk4_fp8(s[0 * 65], s[1 * 65], s[2 * 65], s[3 * 65]); o.y = pk4_fp8(s[4 * 65], s[5 * 65], s[6 * 65], s[7 * 65]); o.z = pk4_fp8(s[8 * 65], s[9 * 65], s[10 * 65], s[11 * 65]); o.w = pk4_fp8(s[12 * 65], s[13 * 65], s[14 * 65], s[15 * 65]);
        *(u32x4*)(dst + (size_t)n * ldk + 16 * c) = o; }
    LDS_WAIT(); asm volatile("" ::: "memory");
}
__device__ __forceinline__ void transpose_matrix(const Ctx& cx, const float* W, int K, int N, bf16* WT, int row_off, int ldk, int koff, const float* scl, int flip) {
    LAS float* scr = (LAS float*)(cx.lds + cx.wave * 16640);
    const int nblk = N / 64, nitems = (K / 64) * nblk;
    for (int it = cx.gw; it < nitems; it += cx.NGW) { const int kb = it / nblk, nb = it % nblk;
        transpose_item<64>(W, N, 64 * kb, 64 * nb, WT + (size_t)(row_off + 64 * nb) * ldk + koff + 64 * kb, ldk, scl, flip, scr, cx.lane); }
}
__device__ __forceinline__ void rms_row_to_bf16(const float* xrow, const float* g, bf16* orow, int lane) {
    const f32x4* xr = (const f32x4*)xrow + lane; const f32x4* gr = (const f32x4*)g + lane;
    f32x4 v[4]; float s = 0.f;
#pragma unroll
    for (int j = 0; j < 4; ++j) { v[j] = xr[64 * j]; s += (v[j].x * v[j].x + v[j].y * v[j].y) + (v[j].z * v[j].z + v[j].w * v[j].w); }
    const float rinv = rsqrtf(wave_sum(s) * (1.f / 1024.f) + 1e-6f);
    u32x2* o8 = (u32x2*)orow + lane;
#pragma unroll
    for (int j = 0; j < 4; ++j) { const f32x4 gg = gr[64 * j]; u32x2 w; w.x = pk2(v[j].x * rinv * gg.x, v[j].y * rinv * gg.y); w.y = pk2(v[j].z * rinv * gg.z, v[j].w * rinv * gg.w); o8[64 * j] = w; }
}

__device__ __forceinline__ void s5_tables_item(const Ctx& cx, int g, int part, const float* lam_re, const float* lam_im, const float* log_dt, const float* b_re, const float* b_im, const float* c_re, const float* c_im,
                                               bf16* BT, bf16* ET, float* AT) {
    LAS float* apr = (LAS float*)cx.lds; LAS float* api = apr + 33 * 64; LAS float* bbr = api + 33 * 64; LAS float* bbi = bbr + 1024; LAS float* cr = bbi + 1024; LAS float* ci = cr + 1024; LAS float* kt = ci + 1024;
    const int tid = cx.tid;
    const float dt = __expf(log_dt[g]);
    for (int idx = tid; idx < 33 * 64; idx += NTHR) { const int j = idx >> 6, p = idx & 63;
        const float lre = fminf(lam_re[g * 64 + p], -1e-4f), lim = lam_im[g * 64 + p];
        const float mag = expf(lre * dt * (float)j), ang = lim * dt * (float)j; float sn, cs; sincosf(ang, &sn, &cs);
        apr[idx] = mag * cs; api[idx] = mag * sn; }
    for (int idx = tid; idx < 1024; idx += NTHR) { const int p = idx >> 4;
        const float lre = fminf(lam_re[g * 64 + p], -1e-4f), lim = lam_im[g * 64 + p];
        const float mag = expf(lre * dt); float sn, cs; sincosf(lim * dt, &sn, &cs); const float lbr = mag * cs, lbi = mag * sn;
        const float den = lre * lre + lim * lim, zr = lbr - 1.0f; const float cor = (zr * lre + lbi * lim) / den, coi = (lbi * lre - zr * lim) / den;
        const float br = b_re[g * 1024 + idx], bi = b_im[g * 1024 + idx];
        bbr[idx] = cor * br - coi * bi; bbi[idx] = cor * bi + coi * br;
        cr[idx] = c_re[g * 1024 + idx]; ci[idx] = c_im[g * 1024 + idx]; }
    __syncthreads();
    for (int idx = tid; idx < 1024; idx += NTHR) { const int jl = idx >> 8, c = (idx >> 4) & 15, c2 = idx & 15, j = 4 * part + jl; float s = 0.f;
        for (int p = 0; p < 64; ++p) { const float ar = apr[j * 64 + p], ai = api[j * 64 + p], xr = cr[c * 64 + p], xi = ci[c * 64 + p];
            const float car = xr * ar - xi * ai, cai = xr * ai + xi * ar; s += car * bbr[p * 16 + c2] - cai * bbi[p * 16 + c2]; }
        kt[idx] = s; }
    __syncthreads();
    bf16* BTg = BT + (size_t)g * 512 * 640; bf16* ETg = ET + (size_t)g * 256 * 512;
    for (int idx = tid; idx < 4096; idx += NTHR) { const int hf = idx & 1, c = (idx >> 1) & 15, t = (idx >> 5) & 31, jl = idx >> 10, j = 4 * part + jl;
        if (t >= j) { const LAS float* s = kt + jl * 256 + c * 16 + hf * 8; u32x4 o; o.x = pk2(s[0], s[1]); o.y = pk2(s[2], s[3]); o.z = pk2(s[4], s[5]); o.w = pk2(s[6], s[7]);
            *(u32x4*)(BTg + (size_t)(t * 16 + c) * 640 + (t - j) * 16 + hf * 8) = o; } }
    for (int idx = tid; idx < 4096; idx += NTHR) { const int hf = idx & 1, c = (idx >> 1) & 15, s = (idx >> 5) & 31, t = 4 * part + (idx >> 10);
        if (s > t) *(u32x4*)(BTg + (size_t)(t * 16 + c) * 640 + s * 16 + hf * 8) = (u32x4){0u, 0u, 0u, 0u}; }
    for (int idx = tid; idx < 1024; idx += NTHR) { const int ch = idx & 15, c = (idx >> 4) & 15, t = 4 * part + (idx >> 8); const int im = ch >> 3, p0 = (ch & 7) * 8; float v[8];
#pragma unroll
        for (int q = 0; q < 8; ++q) { const int p = p0 + q; const float ar = apr[(t + 1) * 64 + p], ai = api[(t + 1) * 64 + p], xr = cr[c * 64 + p], xi = ci[c * 64 + p];
            v[q] = im ? -(xr * ai + xi * ar) : (xr * ar - xi * ai); }
        u32x4 o; o.x = pk2(v[0], v[1]); o.y = pk2(v[2], v[3]); o.z = pk2(v[4], v[5]); o.w = pk2(v[6], v[7]);
        *(u32x4*)(BTg + (size_t)(t * 16 + c) * 640 + 512 + im * 64 + p0) = o; }
    for (int idx = tid; idx < 1024; idx += NTHR) { const int hf = idx & 1, sl = (idx >> 1) & 3, n = idx >> 3, s = 4 * part + sl, p = n & 63, im = n >> 6; float v[8];
        const float ar = apr[(31 - s) * 64 + p], ai = api[(31 - s) * 64 + p];
#pragma unroll
        for (int q = 0; q < 8; ++q) { const float br = bbr[p * 16 + hf * 8 + q], bi = bbi[p * 16 + hf * 8 + q]; v[q] = im ? (ar * bi + ai * br) : (ar * br - ai * bi); }
        u32x4 o; o.x = pk2(v[0], v[1]); o.y = pk2(v[2], v[3]); o.z = pk2(v[4], v[5]); o.w = pk2(v[6], v[7]);
        *(u32x4*)(ETg + (size_t)n * 512 + s * 16 + hf * 8) = o; }
    for (int idx = tid; idx < 1024; idx += NTHR) { const int ch = idx & 63, r = 128 + 16 * part + (idx >> 6); *(u32x4*)(ETg + (size_t)r * 512 + ch * 8) = (u32x4){0u, 0u, 0u, 0u}; }
    if (part == 0 && tid < 64) { AT[(g * 64 + tid) * 2] = apr[32 * 64 + tid]; AT[(g * 64 + tid) * 2 + 1] = api[32 * 64 + tid]; }
    __syncthreads();
}

constexpr int IMG_B = 9216;
#define IMG(k) ((LAS bf16*)(lds + (k) * IMG_B))
struct MmCtx { int tr, tc0, l15, q; };
__device__ __forceinline__ void mm64(const LAS bf16* A, const LAS bf16* Bt, f32x4 (&acc)[2], const MmCtx& w) {
#pragma unroll
    for (int s = 0; s < 2; ++s) {
        const bf16x8 a = *(const LAS bf16x8*)(A + (16 * w.tr + w.l15) * 72 + 32 * s + 8 * w.q);
#pragma unroll
        for (int c = 0; c < 2; ++c) { const bf16x8 b = *(const LAS bf16x8*)(Bt + (16 * (w.tc0 + c) + w.l15) * 72 + 32 * s + 8 * w.q);
            acc[c] = __builtin_amdgcn_mfma_f32_16x16x32_bf16(a, b, acc[c], 0, 0, 0); }
    }
}
__device__ __forceinline__ void st_rm(LAS bf16* img, const f32x4 v, int tr, int tc, const MmCtx& w) {
#pragma unroll
    for (int r = 0; r < 4; ++r) img[(16 * tr + 4 * w.q + r) * 72 + 16 * tc + w.l15] = (bf16)(cvt_pk_bf16(v[r], 0.f) & 0xffffu);
}
__device__ __forceinline__ void st_tr(LAS bf16* img, const f32x4 v, int tr, int tc, const MmCtx& w) {
    u32x2 o; o.x = pk2(v[0], v[1]); o.y = pk2(v[2], v[3]); *(LAS u32x2*)(img + (16 * tc + w.l15) * 72 + 16 * tr + 4 * w.q) = o;
}
__device__ __forceinline__ void img_to_global(const LAS bf16* img, bf16* g, int tid) { const int row = tid >> 3, ch = tid & 7; *(u32x4*)(g + row * 64 + ch * 8) = *(const LAS u32x4*)(img + row * 72 + ch * 8); }
__device__ __forceinline__ void global_to_img(LAS bf16* img, const bf16* g, int tid) { const int row = tid >> 3, ch = tid & 7; *(LAS u32x4*)(img + row * 72 + ch * 8) = *(const u32x4*)(g + row * 64 + ch * 8); }
__device__ __forceinline__ void st_tm8(LAS bf16* img, int t, int cg, const float (&v)[8]) {
    u32x4 o; o.x = pk2(v[0], v[1]); o.y = pk2(v[2], v[3]); o.z = pk2(v[4], v[5]); o.w = pk2(v[6], v[7]); *(LAS u32x4*)(img + t * 72 + 8 * cg) = o;
}
__device__ __forceinline__ void st_cm8(LAS bf16* img, int t, int cg, const float (&v)[8]) {
#pragma unroll
    for (int i = 0; i < 8; ++i) img[(8 * cg + i) * 72 + t] = (bf16)(cvt_pk_bf16(v[i], 0.f) & 0xffffu);
}
__device__ __forceinline__ float red8(float v) { v += __shfl_xor(v, 1); v += __shfl_xor(v, 2); v += __shfl_xor(v, 4); return v; }

struct RwkvP { const bf16* rkv; const bf16* wag; const float *mu_rkv, *w0, *a0, *k_k, *k_a, *r_k, *ln_w, *ln_b; };

__device__ __forceinline__ void unpack8(const u32x4 w, float (&o)[8]) { o[0] = lo16(w.x); o[1] = hi16(w.x); o[2] = lo16(w.y); o[3] = hi16(w.y); o[4] = lo16(w.z); o[5] = hi16(w.z); o[6] = lo16(w.w); o[7] = hi16(w.w); }
__device__ __forceinline__ void ldp8(const float* p, float (&o)[8]) { const f32x4 a = *(const f32x4*)p, b = *(const f32x4*)(p + 4); o[0] = a.x; o[1] = a.y; o[2] = a.z; o[3] = a.w; o[4] = b.x; o[5] = b.y; o[6] = b.z; o[7] = b.w; }

template <bool PASS3>
__device__ __forceinline__ void rwkv_prep(const RwkvP& P, int cidx, int tid, float (&kq)[8], float (&vv)[8], float (&rr)[8], float (&kap)[8], float (&bet)[8], float (&lw)[8], float (&gg)[8]) {
    const int t = tid >> 3, cg = tid & 7, bh = cidx >> 7, c = cidx & 127, b = bh >> 3, h = bh & 7, ch = h * 64 + 8 * cg;
    const size_t tok = (size_t)b * SEQ + c * 64 + t; const bool first = (c == 0 && t == 0);
    const bf16* row = P.rkv + tok * 1536 + ch; const bf16* prow = row - 1536;
    float kc[8], kp[8], vc[8], vp[8], m[8];
    unpack8(*(const u32x4*)(row + 512), kc); unpack8(*(const u32x4*)(row + 1024), vc);
    if (first) {
#pragma unroll
        for (int i = 0; i < 8; ++i) { kp[i] = 0.f; vp[i] = 0.f; }
    } else { unpack8(*(const u32x4*)(prow + 512), kp); unpack8(*(const u32x4*)(prow + 1024), vp); }
    float k[8];
    ldp8(P.mu_rkv + 512 + ch, m);
#pragma unroll
    for (int i = 0; i < 8; ++i) k[i] = kc[i] + (kp[i] - kc[i]) * m[i];
    ldp8(P.mu_rkv + 1024 + ch, m);
#pragma unroll
    for (int i = 0; i < 8; ++i) vv[i] = vc[i] + (vp[i] - vc[i]) * m[i];
    if (PASS3) { float rc[8], rp[8]; unpack8(*(const u32x4*)row, rc);
        if (first) {
#pragma unroll
            for (int i = 0; i < 8; ++i) rp[i] = 0.f;
        } else unpack8(*(const u32x4*)prow, rp);
        ldp8(P.mu_rkv + ch, m);
#pragma unroll
        for (int i = 0; i < 8; ++i) rr[i] = rc[i] + (rp[i] - rc[i]) * m[i];
        unpack8(*(const u32x4*)(P.wag + tok * 1536 + 1024 + ch), gg);
    } else {
#pragma unroll
        for (int i = 0; i < 8; ++i) { rr[i] = 0.f; gg[i] = 0.f; }
    }
    float wl[8], al[8], a[8];
    unpack8(*(const u32x4*)(P.wag + tok * 1536 + ch), wl); unpack8(*(const u32x4*)(P.wag + tok * 1536 + 512 + ch), al);
    ldp8(P.w0 + ch, m);
#pragma unroll
    for (int i = 0; i < 8; ++i) lw[i] = -0.6065306597126334f * fsigmoid(m[i] + wl[i]);
    ldp8(P.a0 + ch, m);
#pragma unroll
    for (int i = 0; i < 8; ++i) a[i] = fsigmoid(m[i] + al[i]);
    ldp8(P.k_k + ch, m);
    float ss = 0.f;
#pragma unroll
    for (int i = 0; i < 8; ++i) { kap[i] = k[i] * m[i]; ss += kap[i] * kap[i]; }
    ss = red8(ss);
    const float inv = 1.0f / fmaxf(sqrtf(ss), 1e-12f);
    ldp8(P.k_a + ch, m);
#pragma unroll
    for (int i = 0; i < 8; ++i) { kap[i] *= inv; bet[i] = kap[i] * a[i]; kq[i] = k[i] * (1.0f + (a[i] - 1.0f) * m[i]); }
}
__device__ __forceinline__ void rwkv_cumsum(LAS unsigned char* lds, int tid, const float (&lw)[8], float (&cum)[8], float (&cumL)[8]) {
    LAS float* LW = (LAS float*)(lds + 12 * IMG_B); LAS float* SEG = (LAS float*)(lds + 14 * IMG_B);
    const int t = tid >> 3, cg = tid & 7, j = tid & 63, seg = tid >> 6;
#pragma unroll
    for (int i = 0; i < 8; ++i) LW[t * 65 + 8 * cg + i] = lw[i];
    __syncthreads();
    { float run = 0.f;
#pragma unroll
      for (int tt = 0; tt < 8; ++tt) { const int idx = (8 * seg + tt) * 65 + j; run += LW[idx]; LW[idx] = run; }
      SEG[seg * 64 + j] = run; }
    __syncthreads();
    { float pre = 0.f;
#pragma unroll
      for (int s2 = 0; s2 < 8; ++s2) { const float x = SEG[s2 * 64 + j]; pre += (s2 < seg) ? x : 0.f; }
#pragma unroll
      for (int tt = 0; tt < 8; ++tt) LW[(8 * seg + tt) * 65 + j] += pre; }
    __syncthreads();
#pragma unroll
    for (int i = 0; i < 8; ++i) { cum[i] = LW[t * 65 + 8 * cg + i]; cumL[i] = LW[63 * 65 + 8 * cg + i]; }
}

__device__ __forceinline__ void rwkv_pass1_chunk(LAS unsigned char* lds, const RwkvP& P, int cidx, int tid, bf16* QCT, float* HCT, bf16* W1G, bf16* ULG, float* DLG) {
    const int lane = tid & 63, wv = __builtin_amdgcn_readfirstlane(tid >> 6); MmCtx w; w.tr = wv >> 1; w.tc0 = (wv & 1) * 2; w.l15 = lane & 15; w.q = lane >> 4;
    const int t = tid >> 3, cg = tid & 7;
    {
        float kq[8], vv[8], rr[8], kap[8], bet[8], lw[8], gg[8], cum[8], cumL[8];
        rwkv_prep<false>(P, cidx, tid, kq, vv, rr, kap, bet, lw, gg);
        rwkv_cumsum(lds, tid, lw, cum, cumL);
        float x[8];
#pragma unroll
        for (int i = 0; i < 8; ++i) { const float en = __expf(-cum[i]); x[i] = kq[i] * en; bet[i] *= 1.0f; rr[i] = bet[i] * en; }
        st_tm8(IMG(0), t, cg, x);
        st_tm8(IMG(1), t, cg, rr);
#pragma unroll
        for (int i = 0; i < 8; ++i) x[i] = kap[i] * __expf(cum[i] - lw[i]);
        st_tm8(IMG(2), t, cg, x);
        st_cm8(IMG(3), t, cg, x);
#pragma unroll
        for (int i = 0; i < 8; ++i) { const float eh = __expf(cumL[i] - cum[i]); x[i] = kq[i] * eh; rr[i] = bet[i] * eh; }
        st_cm8(IMG(4), t, cg, x);
        st_cm8(IMG(5), t, cg, rr);
        st_cm8(IMG(6), t, cg, vv);
        if (t == 0) {
#pragma unroll
            for (int i = 0; i < 8; ++i) DLG[(size_t)cidx * 64 + 8 * cg + i] = __expf(cumL[i]);
        }
    }
    __syncthreads();
    f32x4 accX[2];
    {
        f32x4 a[2] = {(f32x4){0.f, 0.f, 0.f, 0.f}, (f32x4){0.f, 0.f, 0.f, 0.f}}, kk[2] = {(f32x4){0.f, 0.f, 0.f, 0.f}, (f32x4){0.f, 0.f, 0.f, 0.f}};
        mm64(IMG(1), IMG(2), a, w); mm64(IMG(0), IMG(2), kk, w);
#pragma unroll
        for (int c = 0; c < 2; ++c) { const int n = 16 * (w.tc0 + c) + w.l15;
#pragma unroll
            for (int r = 0; r < 4; ++r) { const int m = 16 * w.tr + 4 * w.q + r; a[c][r] = (m < n) ? a[c][r] : 0.f; kk[c][r] = (m < n) ? kk[c][r] : 0.f; accX[c][r] = ((m == n) ? 1.0f : 0.f) - a[c][r]; }
            st_rm(IMG(7), a[c], w.tr, w.tc0 + c, w); st_tr(IMG(8), a[c], w.tr, w.tc0 + c, w); st_rm(IMG(10), accX[c], w.tr, w.tc0 + c, w); st_rm(IMG(9), kk[c], w.tr, w.tc0 + c, w); }
    }
    __syncthreads();
    {
        f32x4 p[2] = {(f32x4){0.f, 0.f, 0.f, 0.f}, (f32x4){0.f, 0.f, 0.f, 0.f}};
        mm64(IMG(7), IMG(8), p, w);
#pragma unroll
        for (int c = 0; c < 2; ++c) { st_rm(IMG(12), p[c], w.tr, w.tc0 + c, w); st_tr(IMG(13), p[c], w.tr, w.tc0 + c, w); }
    }
    __syncthreads();
#define NEUMANN(XC, XN, PC, PTC, PN, PTN, LASTR) do { mm64(IMG(XC), IMG(PTC), accX, w); \
        if (!(LASTR)) { f32x4 p[2] = {(f32x4){0.f, 0.f, 0.f, 0.f}, (f32x4){0.f, 0.f, 0.f, 0.f}}; mm64(IMG(PC), IMG(PTC), p, w); \
            _Pragma("unroll") for (int c = 0; c < 2; ++c) { st_rm(IMG(PN), p[c], w.tr, w.tc0 + c, w); st_tr(IMG(PTN), p[c], w.tr, w.tc0 + c, w); st_rm(IMG(XN), accX[c], w.tr, w.tc0 + c, w); } } \
        __syncthreads(); } while (0)
    NEUMANN(10, 11, 12, 13, 14, 15, false);
    NEUMANN(11, 10, 14, 15, 12, 13, false);
    NEUMANN(10, 11, 12, 13, 14, 15, false);
    NEUMANN(11, 10, 14, 15, 12, 13, false);
    NEUMANN(10, 11, 12, 13, 14, 15, true);
#undef NEUMANN
#pragma unroll
    for (int c = 0; c < 2; ++c) st_tr(IMG(7), accX[c], w.tr, w.tc0 + c, w);
    __syncthreads();
    {
        f32x4 a[2] = {(f32x4){0.f, 0.f, 0.f, 0.f}, (f32x4){0.f, 0.f, 0.f, 0.f}}, g[2] = {(f32x4){0.f, 0.f, 0.f, 0.f}, (f32x4){0.f, 0.f, 0.f, 0.f}};
        mm64(IMG(3), IMG(7), a, w); mm64(IMG(9), IMG(7), g, w);
#pragma unroll
        for (int c = 0; c < 2; ++c) { st_rm(IMG(12), a[c], w.tr, w.tc0 + c, w); st_tr(IMG(14), a[c], w.tr, w.tc0 + c, w); st_tr(IMG(8), g[c], w.tr, w.tc0 + c, w); }
    }
    __syncthreads();
    {
        f32x4 u[2] = {(f32x4){0.f, 0.f, 0.f, 0.f}, (f32x4){0.f, 0.f, 0.f, 0.f}}, qc[2] = {(f32x4){0.f, 0.f, 0.f, 0.f}, (f32x4){0.f, 0.f, 0.f, 0.f}};
        mm64(IMG(6), IMG(8), u, w); mm64(IMG(5), IMG(12), qc, w);
#pragma unroll
        for (int c = 0; c < 2; ++c) { st_rm(IMG(13), u[c], w.tr, w.tc0 + c, w);
            const int tc = w.tc0 + c, cp = 32 * (tc >> 1) + 8 * (w.l15 >> 2) + 4 * (tc & 1) + (w.l15 & 3);
#pragma unroll
            for (int r = 0; r < 4; ++r) IMG(15)[(16 * w.tr + 4 * w.q + r) * 72 + cp] = (bf16)(cvt_pk_bf16(qc[c][r], 0.f) & 0xffffu); }
        img_to_global(IMG(14), W1G + (size_t)cidx * 4096, tid);
    }
    __syncthreads();
    {
        f32x4 hp[2] = {(f32x4){0.f, 0.f, 0.f, 0.f}, (f32x4){0.f, 0.f, 0.f, 0.f}}, hn[2] = {(f32x4){0.f, 0.f, 0.f, 0.f}, (f32x4){0.f, 0.f, 0.f, 0.f}};
        mm64(IMG(4), IMG(6), hp, w); mm64(IMG(5), IMG(13), hn, w);
#pragma unroll
        for (int c = 0; c < 2; ++c) *(f32x4*)(HCT + (((size_t)cidx * 16 + w.tr * 4 + w.tc0 + c) * 64 + lane) * 4) = hp[c] - hn[c];
        img_to_global(IMG(13), ULG + (size_t)cidx * 4096, tid);
        img_to_global(IMG(15), QCT + (size_t)cidx * 4096, tid);
    }
    __syncthreads();
}

__device__ __forceinline__ void rwkv_pass2(int bh, int ti, int lane, const bf16* QCT, const float* HCT, const float* DLG, bf16* S0G) {
    const int l15 = lane & 15, q = lane >> 4;
    f32x4 X[4];
#pragma unroll
    for (int tj = 0; tj < 4; ++tj) X[tj] = (f32x4){0.f, 0.f, 0.f, 0.f};
    bf16x8 aA[4][2], aB[4][2]; f32x4 hA[4], hB[4], dA[4], dB[4];
#define P2_LOAD(a_, h_, d_, cc) do { const size_t ci_ = (size_t)bh * 128 + (cc); \
        _Pragma("unroll") for (int tj = 0; tj < 4; ++tj) { _Pragma("unroll") for (int s = 0; s < 2; ++s) a_[tj][s] = *(const bf16x8*)(QCT + (ci_ * 64 + 16 * tj + l15) * 64 + 32 * s + 8 * q); \
            h_[tj] = *(const f32x4*)(HCT + ((ci_ * 16 + tj * 4 + ti) * 64 + lane) * 4); d_[tj] = *(const f32x4*)(DLG + ci_ * 64 + 16 * tj + 4 * q); } } while (0)
#define P2_STEP(a_, h_, d_, cc) do { const size_t cidx = (size_t)bh * 128 + (cc); \
        _Pragma("unroll") for (int tj = 0; tj < 4; ++tj) { u32x2 o; o.x = pk2(X[tj][0], X[tj][1]); o.y = pk2(X[tj][2], X[tj][3]); *(u32x2*)(S0G + (cidx * 64 + 16 * ti + l15) * 64 + 16 * tj + 4 * q) = o; } \
        bf16x8 b[2]; \
        _Pragma("unroll") for (int s = 0; s < 2; ++s) { u32x4 o; o.x = pk2(X[2 * s][0], X[2 * s][1]); o.y = pk2(X[2 * s][2], X[2 * s][3]); o.z = pk2(X[2 * s + 1][0], X[2 * s + 1][1]); o.w = pk2(X[2 * s + 1][2], X[2 * s + 1][3]); b[s] = __builtin_bit_cast(bf16x8, o); } \
        _Pragma("unroll") for (int tj = 0; tj < 4; ++tj) { f32x4 acc = (f32x4){0.f, 0.f, 0.f, 0.f}; \
            acc = __builtin_amdgcn_mfma_f32_16x16x32_bf16(a_[tj][0], b[0], acc, 0, 0, 0); acc = __builtin_amdgcn_mfma_f32_16x16x32_bf16(a_[tj][1], b[1], acc, 0, 0, 0); \
            X[tj] = d_[tj] * X[tj] + h_[tj] - acc; } } while (0)
    P2_LOAD(aA, hA, dA, 0); P2_LOAD(aB, hB, dB, 1);
    for (int c = 0; c < 128; c += 2) {
        P2_STEP(aA, hA, dA, c);
        if (c + 2 < 128) P2_LOAD(aA, hA, dA, c + 2);
        P2_STEP(aB, hB, dB, c + 1);
        if (c + 3 < 128) P2_LOAD(aB, hB, dB, c + 3);
    }
#undef P2_LOAD
#undef P2_STEP
}

__device__ __forceinline__ void rwkv_pass3_chunk(LAS unsigned char* lds, const RwkvP& P, int cidx, int tid, const bf16* S0G, const bf16* W1G, const bf16* ULG, bf16* MIX) {
    const int lane = tid & 63, wv = __builtin_amdgcn_readfirstlane(tid >> 6); MmCtx w; w.tr = wv >> 1; w.tc0 = (wv & 1) * 2; w.l15 = lane & 15; w.q = lane >> 4;
    const int t = tid >> 3, cg = tid & 7, bh = cidx >> 7, c = cidx & 127, b = bh >> 3, h = bh & 7, ch = h * 64 + 8 * cg;
    float vv[8], gg[8], bonus;
    {
        float kq[8], rr[8], kap[8], bet[8], lw[8], cum[8], cumL[8];
        rwkv_prep<true>(P, cidx, tid, kq, vv, rr, kap, bet, lw, gg);
        rwkv_cumsum(lds, tid, lw, cum, cumL);
        float m[8]; ldp8(P.r_k + ch, m); float bs = 0.f;
#pragma unroll
        for (int i = 0; i < 8; ++i) bs += rr[i] * kq[i] * m[i];
        bonus = red8(bs);
        float x[8], y[8];
#pragma unroll
        for (int i = 0; i < 8; ++i) { const float en = __expf(-cum[i]); x[i] = kq[i] * en; y[i] = bet[i] * en; }
        st_tm8(IMG(1), t, cg, x);
        st_tm8(IMG(2), t, cg, y);
#pragma unroll
        for (int i = 0; i < 8; ++i) x[i] = rr[i] * __expf(cum[i]);
        st_tm8(IMG(0), t, cg, x);
        st_cm8(IMG(3), t, cg, vv);
        global_to_img(IMG(4), S0G + (size_t)cidx * 4096, tid);
        global_to_img(IMG(5), W1G + (size_t)cidx * 4096, tid);
        global_to_img(IMG(6), ULG + (size_t)cidx * 4096, tid);
    }
    __syncthreads();
    {
        f32x4 kr[2] = {(f32x4){0.f, 0.f, 0.f, 0.f}, (f32x4){0.f, 0.f, 0.f, 0.f}}, br[2] = {(f32x4){0.f, 0.f, 0.f, 0.f}, (f32x4){0.f, 0.f, 0.f, 0.f}}, u[2] = {(f32x4){0.f, 0.f, 0.f, 0.f}, (f32x4){0.f, 0.f, 0.f, 0.f}};
        mm64(IMG(0), IMG(1), kr, w); mm64(IMG(0), IMG(2), br, w); mm64(IMG(4), IMG(5), u, w);
#pragma unroll
        for (int cc = 0; cc < 2; ++cc) { const int n = 16 * (w.tc0 + cc) + w.l15;
#pragma unroll
            for (int r = 0; r < 4; ++r) { const int m = 16 * w.tr + 4 * w.q + r; kr[cc][r] = (n <= m) ? kr[cc][r] : 0.f; br[cc][r] = (n <= m) ? br[cc][r] : 0.f; u[cc][r] += bf2f(IMG(6)[m * 72 + n]); }
            st_rm(IMG(7), kr[cc], w.tr, w.tc0 + cc, w); st_rm(IMG(8), br[cc], w.tr, w.tc0 + cc, w); st_rm(IMG(9), u[cc], w.tr, w.tc0 + cc, w); }
    }
    __syncthreads();
    {
        f32x4 yp[2] = {(f32x4){0.f, 0.f, 0.f, 0.f}, (f32x4){0.f, 0.f, 0.f, 0.f}}, yn[2] = {(f32x4){0.f, 0.f, 0.f, 0.f}, (f32x4){0.f, 0.f, 0.f, 0.f}};
        mm64(IMG(0), IMG(4), yp, w); mm64(IMG(7), IMG(3), yp, w); mm64(IMG(8), IMG(9), yn, w);
        LAS float* YF = (LAS float*)(lds + 10 * IMG_B);
#pragma unroll
        for (int cc = 0; cc < 2; ++cc)
#pragma unroll
            for (int r = 0; r < 4; ++r) YF[(16 * w.tr + 4 * w.q + r) * 65 + 16 * (w.tc0 + cc) + w.l15] = yp[cc][r] - yn[cc][r];
    }
    __syncthreads();
    {
        const LAS float* YF = (const LAS float*)(lds + 10 * IMG_B);
        float y[8], s = 0.f;
#pragma unroll
        for (int i = 0; i < 8; ++i) { y[i] = YF[t * 65 + 8 * cg + i]; s += y[i]; }
        const float mean = red8(s) * (1.0f / 64.0f); float qv = 0.f;
#pragma unroll
        for (int i = 0; i < 8; ++i) { y[i] -= mean; qv += y[i] * y[i]; }
        const float rstd = rsqrtf(red8(qv) * (1.0f / 64.0f) + 64e-5f);
        float lwv[8], lbv[8]; ldp8(P.ln_w + ch, lwv); ldp8(P.ln_b + ch, lbv);
        float o[8];
#pragma unroll
        for (int i = 0; i < 8; ++i) o[i] = (y[i] * rstd * lwv[i] + lbv[i] + bonus * vv[i]) * gg[i];
        const size_t tok = (size_t)b * SEQ + c * 64 + t;
        u32x4 ov; ov.x = pk2(o[0], o[1]); ov.y = pk2(o[2], o[3]); ov.z = pk2(o[4], o[5]); ov.w = pk2(o[6], o[7]);
        *(u32x4*)(MIX + tok * 1024 + 512 + ch) = ov;
    }
}

__device__ __forceinline__ void router_phase(const Ctx& cx, const float* X1, const float* gnorm, const float* rw, const float* rb, unsigned char* H2, int* TOPE, float* TOPG, unsigned* HIST) {
    LAS float* RW = (LAS float*)cx.lds;
    LAS unsigned* hcnt = (LAS unsigned*)(cx.lds + 131072);
    const int lane = cx.lane;
    for (int idx = cx.tid; idx < 32768; idx += NTHR) { const int col = idx >> 5, e = idx & 31; RW[e * 1024 + col] = rw[idx]; }
    const int myexp = (lane >> 1) & 31; const float mybias = rb[myexp];
    for (int tb = cx.wg; tb < 256; tb += cx.G) {
        if (cx.tid < 32) hcnt[cx.tid] = 0u;
        __syncthreads();
        for (int r = 0; r < 16; ++r) {
            const int tok = tb * 128 + cx.wave * 16 + r;
            const f32x4* xr = (const f32x4*)(X1 + (size_t)tok * 1024) + lane; const f32x4* gr = (const f32x4*)gnorm + lane;
            f32x4 v[4]; float s = 0.f;
#pragma unroll
            for (int j = 0; j < 4; ++j) { v[j] = xr[64 * j]; s += (v[j].x * v[j].x + v[j].y * v[j].y) + (v[j].z * v[j].z + v[j].w * v[j].w); }
            const float rinv = rsqrtf(wave_sum(s) * (1.f / 1024.f) + 1e-6f);
            unsigned* o4 = (unsigned*)(H2 + (size_t)tok * 1024) + lane;
#pragma unroll
            for (int j = 0; j < 4; ++j) { const f32x4 gg = gr[64 * j]; v[j].x *= rinv * gg.x; v[j].y *= rinv * gg.y; v[j].z *= rinv * gg.z; v[j].w *= rinv * gg.w;
                o4[64 * j] = pk4_fp8(v[j].x, v[j].y, v[j].z, v[j].w); }
            float part[32];
#pragma unroll
            for (int e = 0; e < 32; ++e) { float p = 0.f;
#pragma unroll
                for (int j = 0; j < 4; ++j) { const f32x4 wv = *(const LAS f32x4*)(RW + e * 1024 + 256 * j + 4 * lane); p += (v[j].x * wv.x + v[j].y * wv.y) + (v[j].z * wv.z + v[j].w * wv.w); }
                part[e] = p; }
            float a16[16], a8[8], a4[4], a2[2];
            { const bool bb = (lane & 32) != 0;
#pragma unroll
              for (int i = 0; i < 16; ++i) { const float keep = bb ? part[i + 16] : part[i], send = bb ? part[i] : part[i + 16]; a16[i] = keep + __shfl_xor(send, 32); } }
            { const bool bb = (lane & 16) != 0;
#pragma unroll
              for (int i = 0; i < 8; ++i) { const float keep = bb ? a16[i + 8] : a16[i], send = bb ? a16[i] : a16[i + 8]; a8[i] = keep + __shfl_xor(send, 16); } }
            { const bool bb = (lane & 8) != 0;
#pragma unroll
              for (int i = 0; i < 4; ++i) { const float keep = bb ? a8[i + 4] : a8[i], send = bb ? a8[i] : a8[i + 4]; a4[i] = keep + __shfl_xor(send, 8); } }
            { const bool bb = (lane & 4) != 0;
#pragma unroll
              for (int i = 0; i < 2; ++i) { const float keep = bb ? a4[i + 2] : a4[i], send = bb ? a4[i] : a4[i + 2]; a2[i] = keep + __shfl_xor(send, 4); } }
            float val;
            { const bool bb = (lane & 2) != 0; const float keep = bb ? a2[1] : a2[0], send = bb ? a2[0] : a2[1]; val = keep + __shfl_xor(send, 2); }
            val += __shfl_xor(val, 1);
            val += mybias;
            int se[4]; float sv[4];
#pragma unroll
            for (int k = 0; k < 4; ++k) { const float mx = wave_max(val); const unsigned long long mask = __ballot(val == mx); const int first = __ffsll((long long)mask) - 1;
                se[k] = first >> 1; sv[k] = mx; if (myexp == se[k]) val = -INFINITY; }
            const float w1 = __expf(sv[1] - sv[0]), w2 = __expf(sv[2] - sv[0]), w3 = __expf(sv[3] - sv[0]); const float inv = 1.0f / (1.0f + w1 + w2 + w3);
            if (lane == 0) {
                *(int4*)(TOPE + (size_t)tok * 4) = make_int4(se[0], se[1], se[2], se[3]);
                *(float4*)(TOPG + (size_t)tok * 4) = make_float4(inv, w1 * inv, w2 * inv, w3 * inv);
                atomicAdd((unsigned*)(hcnt + se[0]), 1u); atomicAdd((unsigned*)(hcnt + se[1]), 1u); atomicAdd((unsigned*)(hcnt + se[2]), 1u); atomicAdd((unsigned*)(hcnt + se[3]), 1u);
            }
        }
        __syncthreads();
        if (cx.tid < 32) HIST[tb * 32 + cx.tid] = hcnt[cx.tid];
        __syncthreads();
    }
}

constexpr int PL_BASE = 1280, PL_WCNT = 1312;
__device__ __forceinline__ void moe_plan(const Ctx& cx, const unsigned* HIST) {
    LAS int* PL = (LAS int*)(cx.lds + LDS_PLAN);
    const int e = cx.tid & 31, part = cx.tid >> 5;
    { int s = 0; for (int w = 16 * part; w < 16 * part + 16; ++w) s += (int)HIST[w * 32 + e]; PL[PL_TMP + part * 32 + e] = s; }
    __syncthreads();
    if (cx.tid < 32) { int c = 0; for (int p = 0; p < 16; ++p) c += PL[PL_TMP + p * 32 + cx.tid]; PL[PL_CNT + cx.tid] = c; }
    __syncthreads();
    if (cx.tid == 0) {
        int ps = 0;
        for (int x = 0; x < 32; ++x) { PL[PL_PSTART + x] = ps; const int pad = (PL[PL_CNT + x] + 255) & ~255; for (int i = 0; i < pad / 256; ++i) PL[PL_TILEE + ps / 256 + i] = x; ps += pad; }
        PL[PL_PSTART + 32] = ps;
        int np = 0, e0 = 0;
        while (e0 < 32 && np < 7) { PL[PL_PE0 + np] = e0; PL[PL_PROW0 + np] = PL[PL_PSTART + e0]; int rows = 0, e1 = e0;
            while (e1 < 32 && e1 - e0 < MAXEPP) { const int pad = PL[PL_PSTART + e1 + 1] - PL[PL_PSTART + e1]; if (rows + pad > RMAX && e1 > e0) break; rows += pad; ++e1; }
            e0 = e1; ++np; }
        PL[PL_PE0 + np] = 32; PL[PL_PROW0 + np] = ps; PL[PL_NPASS] = np;
    }
    __syncthreads();
}
__device__ __forceinline__ void dispatch_phase(const Ctx& cx, const unsigned* HIST, const int* TOPE, int* SLOTTOK, int* TOKSLOT) {
    LAS int* PL = (LAS int*)(cx.lds + LDS_PLAN);
    const int e5 = cx.tid & 31, part = cx.tid >> 5, lane = cx.lane;
    for (int tb = cx.wg; tb < 256; tb += cx.G) {
        { int s = 0; for (int w = 16 * part; w < 16 * part + 16; ++w) s += (w < tb) ? (int)HIST[w * 32 + e5] : 0; PL[PL_TMP + part * 32 + e5] = s; }
        const int tok = tb * 128 + (cx.tid >> 2), k = cx.tid & 3; const int e = TOPE[(size_t)tok * 4 + k];
        int rank = 0;
        for (int ee = 0; ee < 32; ++ee) { const unsigned long long mask = __ballot(e == ee); if (e == ee) rank = __popcll(mask & ((1ull << lane) - 1ull)); if (lane == 0) PL[PL_WCNT + cx.wave * 32 + ee] = __popcll(mask); }
        __syncthreads();
        if (cx.tid < 32) { int c = 0; for (int p = 0; p < 16; ++p) c += PL[PL_TMP + p * 32 + cx.tid]; PL[PL_BASE + cx.tid] = c; }
        __syncthreads();
        int off = 0; for (int w2 = 0; w2 < 8; ++w2) off += (w2 < cx.wave) ? PL[PL_WCNT + w2 * 32 + e] : 0;
        const int slot = PL[PL_PSTART + e] + PL[PL_BASE + e] + off + rank;
        SLOTTOK[slot] = tok; TOKSLOT[(size_t)tok * 4 + k] = slot;
        __syncthreads();
    }
    for (int e = cx.wg; e < 32; e += cx.G) { const int c = PL[PL_CNT + e], ps = PL[PL_PSTART + e], pe = PL[PL_PSTART + e + 1]; for (int r = ps + c + cx.tid; r < pe; r += NTHR) SLOTTOK[r] = 0; }
}
__device__ __forceinline__ void convert_pass(const Ctx& cx, int e0, int e1, const float* wg, const float* wu, const float* wd, unsigned char* WGU, unsigned char* WDN) {
    LAS float* scr = (LAS float*)(cx.lds + cx.wave * 16640);
    const int nitems = (e1 - e0) * 768;
    for (int it = cx.gw; it < nitems; it += cx.NGW) { const int le = it / 768, r = it % 768, mat = r >> 8, kb = (r & 255) >> 4, nb = r & 15, n0 = 64 * nb; const size_t eo = (size_t)(e0 + le) * 1048576;
        if (mat == 2) transpose_item_fp8(wd + eo, 1024, 64 * kb, n0, WDN + (size_t)le * 1048576 + (size_t)n0 * 1024 + 64 * kb, 1024, 32.0f, scr, cx.lane);
        else { const int drow = (n0 >> 7) * 256 + (n0 & 127) + mat * 128; transpose_item_fp8((mat ? wu : wg) + eo, 1024, 64 * kb, n0, WGU + (size_t)le * 2097152 + (size_t)drow * 1024 + 64 * kb, 1024, 32.0f, scr, cx.lane); } }
}
template <bool LAST>
__device__ __forceinline__ void combine_pass(const Ctx& cx, int e0, int e1, int row0, const int* TOPE, const float* TOPG, const int* TOKSLOT, const bf16* Y, float* X, const float* gnorm, bf16* H3) {
    for (int tok = cx.gw; tok < M; tok += cx.NGW) {
        const int4 es = *(const int4*)(TOPE + (size_t)tok * 4); const float4 gs = *(const float4*)(TOPG + (size_t)tok * 4); const int4 sl = *(const int4*)(TOKSLOT + (size_t)tok * 4);
        const int ee[4] = {es.x, es.y, es.z, es.w}; const float gg[4] = {gs.x, gs.y, gs.z, gs.w}; const int ss[4] = {sl.x, sl.y, sl.z, sl.w};
        bool any = false;
#pragma unroll
        for (int k = 0; k < 4; ++k) any |= (ee[k] >= e0 && ee[k] < e1);
        if (!LAST && !any) continue;
        f32x4* xr = (f32x4*)(X + (size_t)tok * 1024) + cx.lane; f32x4 v[4];
#pragma unroll
        for (int j = 0; j < 4; ++j) v[j] = xr[64 * j];
#pragma unroll
        for (int k = 0; k < 4; ++k) if (ee[k] >= e0 && ee[k] < e1) { const u32x2* yr = (const u32x2*)(Y + (size_t)(ss[k] - row0) * 1024) + cx.lane; const float g = gg[k];
#pragma unroll
            for (int j = 0; j < 4; ++j) { const u32x2 w = yr[64 * j]; v[j].x += g * lo16(w.x); v[j].y += g * hi16(w.x); v[j].z += g * lo16(w.y); v[j].w += g * hi16(w.y); } }
        if (any) {
#pragma unroll
            for (int j = 0; j < 4; ++j) xr[64 * j] = v[j];
        }
        if (LAST) { float s = 0.f;
#pragma unroll
            for (int j = 0; j < 4; ++j) s += (v[j].x * v[j].x + v[j].y * v[j].y) + (v[j].z * v[j].z + v[j].w * v[j].w);
            const float rinv = rsqrtf(wave_sum(s) * (1.f / 1024.f) + 1e-6f); const f32x4* gr = (const f32x4*)gnorm + cx.lane; u32x2* o8 = (u32x2*)(H3 + (size_t)tok * 1024) + cx.lane;
#pragma unroll
            for (int j = 0; j < 4; ++j) { const f32x4 gg = gr[64 * j]; u32x2 w; w.x = pk2(v[j].x * rinv * gg.x, v[j].y * rinv * gg.y); w.y = pk2(v[j].z * rinv * gg.z, v[j].w * rinv * gg.w); o8[64 * j] = w; } }
    }
}

#define HBUF ((bf16*)(ws + WS_R1))
#define RKV ((bf16*)(ws + WS_RKV))
#define WAG ((bf16*)(ws + WS_WAG))
#define AG ((bf16*)(ws + WS_AG))
#define UB ((bf16*)(ws + WS_U))
#define LP ((bf16*)(ws + WS_LP))
#define LACT ((bf16*)(ws + WS_LACT))
#define Y1 ((bf16*)(ws + WS_Y1))
#define MIX ((bf16*)(ws + WS_R1))
#define EBUF ((float*)(ws + WS_LP))
#define S0G ((bf16*)(ws + WS_LP))
#define QCT ((bf16*)(ws + WS_U))
#define HCT ((float*)(ws + WS_R1))
#define W1G ((bf16*)(ws + WS_W1))
#define ULG ((bf16*)(ws + WS_ULOC))
#define DLG ((float*)(ws + WS_DL))
#define ATG ((float*)(ws + WS_AT))
#define WCAT ((bf16*)(ws + WS_WCAT))
#define WL2 ((bf16*)(ws + WS_WL2))
#define WGLU ((bf16*)(ws + WS_WGLU))
#define WPP ((bf16*)(ws + WS_WPP))
#define WOUT ((bf16*)(ws + WS_WOUT))
#define WPG ((bf16*)(ws + WS_WPG))
#define S5BT ((bf16*)(ws + WS_S5BT))
#define S5ET ((bf16*)(ws + WS_S5ET))
#define PBF ((bf16*)(ws + WS_PBF))
#define H2 ((unsigned char*)(ws + WS_H2))
#define WGU ((unsigned char*)(ws + WS_WGU))
#define WDN ((unsigned char*)(ws + WS_WDN))
#define ACT ((unsigned char*)(ws + WS_ACT))
#define YB ((bf16*)(ws + WS_Y))
#define PP ((bf16*)(ws + WS_ACT))
#define HIST ((unsigned*)(ws + WS_HIST))
#define TOPE ((int*)(ws + WS_TOPE))
#define TOPG ((float*)(ws + WS_TOPG))
#define TOKSLOT ((int*)(ws + WS_TOKSLOT))
#define SLOTTOK ((int*)(ws + WS_SLOTTOK))
#ifndef PROBE_PH
#define PROBE_PH -1
#endif
#ifndef PROBE_N
#define PROBE_N 2
#endif
#define REPS(k) ((((k) >= 10 && (k) < 28) ? 10 + ((k) - 10) % 3 : (k)) == PROBE_PH ? PROBE_N : 1)
#ifndef ONLY_PHASE
#define ONLY_PHASE -1
#endif
constexpr int NPH = 31;
struct Args { const float* in[42]; float* out; unsigned char* ws; int ph_lo, ph_hi; };

__global__ void __launch_bounds__(NTHR, 2) mk_fwd(Args args) {
    extern __shared__ __attribute__((aligned(16))) unsigned char lds_raw[];
    LAS unsigned char* lds = (LAS unsigned char*)lds_raw;
#define FRESH_CX Ctx cx; { int t_ = threadIdx.x; asm volatile("" : "+v"(t_)); cx.lds = lds; cx.tid = t_; cx.lane = t_ & 63; cx.wave = __builtin_amdgcn_readfirstlane(t_ >> 6); cx.G = gridDim.x; cx.wg = blockIdx.x; cx.gw = cx.wg * NWAVES + cx.wave; cx.NGW = cx.G * NWAVES; }
    unsigned char* ws = args.ws;
    const int lo = args.ph_lo, hi = args.ph_hi;
    volatile LAS unsigned* MISC = (volatile LAS unsigned*)(lds + LDS_MISC);
    if (threadIdx.x < 64) MISC[threadIdx.x] = 0u;
    __syncthreads();
    XcdBarrier bar; bar.bar = (unsigned*)(ws + WS_CTL) + CW_BAR; bar.x = 0; bar.st = nullptr;
    if (hi - lo > 1) bar = xcd_barrier_post((unsigned*)(ws + WS_CTL) + CW_BAR, MISC + 8);
#define IN(k) ((ONLY_PHASE < 0 || ONLY_PHASE == (k) || (ONLY_PHASE >= 10 && ONLY_PHASE < 28 && (k) >= 10 && (k) < 28 && ((k) - 10) % 3 == (ONLY_PHASE - 10) % 3)) && lo <= (k) && (k) < hi)
#define SEAM(k) do { if (IN(k) && IN((k) + 1)) xcd_barrier(bar); } while (0)
    const float* const* I = args.in;
    const float* x = I[0];
#define MAKE_RP RwkvP RP; RP.rkv = RKV; RP.wag = WAG; RP.mu_rkv = I[13]; RP.w0 = I[15]; RP.a0 = I[18]; RP.k_k = I[23]; RP.k_a = I[24]; RP.r_k = I[25]; RP.ln_w = I[26]; RP.ln_b = I[27]
#define OPQ(v) ({ int _k = (v); asm volatile("" : "+s"(_k)); _k; })

    if (IN(0)) for (int rep_ = 0; rep_ < REPS(0); ++rep_) {
        FRESH_CX;
        for (int it = cx.wg; it < 256; it += cx.G) s5_tables_item(cx, it >> 3, it & 7, I[4], I[5], I[6], I[7], I[8], I[9], I[10], S5BT, S5ET, ATG);
        const float* mu = I[14];
        transpose_matrix(cx, I[3], 1024, 2048, WCAT, 0, 1024, 0, nullptr, 0);
        transpose_matrix(cx, I[16], 1024, 64, WCAT, 2048, 1024, 0, mu, 1);          transpose_matrix(cx, I[16], 1024, 64, WCAT, 2304, 1024, 0, mu, 0);
        transpose_matrix(cx, I[19], 1024, 64, WCAT, 2112, 1024, 0, mu + 1024, 1);   transpose_matrix(cx, I[19], 1024, 64, WCAT, 2368, 1024, 0, mu + 1024, 0);
        transpose_matrix(cx, I[21], 1024, 128, WCAT, 2176, 1024, 0, mu + 2048, 1);  transpose_matrix(cx, I[21], 1024, 128, WCAT, 2432, 1024, 0, mu + 2048, 0);
        transpose_matrix(cx, I[17], 64, 512, WL2, 0, 256, 0, nullptr, 0);
        transpose_matrix(cx, I[20], 64, 512, WL2, 512, 256, 64, nullptr, 0);
        transpose_matrix(cx, I[22], 128, 512, WL2, 1024, 256, 128, nullptr, 0);
        for (int idx = cx.wg * NTHR + cx.tid; idx < 1536 * 32; idx += cx.G * NTHR) { const int row = idx >> 5, ch = idx & 31, blk = row >> 9; const int kb = blk == 0 ? 0 : (blk == 1 ? 64 : 128), ke = blk == 0 ? 64 : (blk == 1 ? 128 : 256);
            if (ch * 8 < kb || ch * 8 >= ke) *(u32x4*)(WL2 + (size_t)row * 256 + ch * 8) = (u32x4){0u, 0u, 0u, 0u}; }
        transpose_matrix(cx, I[12], 512, 512, WGLU, 0, 512, 0, nullptr, 0);
        transpose_matrix(cx, I[39], 256, 1024, WPP, 0, 256, 0, nullptr, 0);
        transpose_matrix(cx, I[28], 1024, 1024, WOUT, 0, 1024, 0, nullptr, 0);
        transpose_matrix(cx, I[40], 1024, 1024, WPG, 0, 1024, 0, nullptr, 0);
        for (int m = cx.gw; m < M; m += cx.NGW) rms_row_to_bf16(x + (size_t)m * 1024, I[2], HBUF + (size_t)m * 1024, cx.lane);
        for (int m = cx.gw; m < M; m += cx.NGW) { const f32x4 v = *((const f32x4*)(I[1] + (size_t)m * 256) + cx.lane); u32x2 w; w.x = pk2(v.x, v.y); w.y = pk2(v.z, v.w); *((u32x2*)(PBF + (size_t)m * 256) + cx.lane) = w; }
    }
    SEAM(0);
    if (IN(1)) for (int rep_ = 0; rep_ < REPS(1); ++rep_) {
        FRESH_CX;
        SchedPlain S; S.init(128, 10, cx.G, cx.wg); S.A = (const char*)HBUF; S.B = (const char*)WCAT; S.a_tile = 256 * 1024 * 2; S.b_tile = 256 * 1024 * 2;
        EpiProj E{UB, RKV, LP};
        pg8::gemm_phase<EpiProj, SchedPlain, true, true, false>(lds, cx.tid, OPQ(1024), OPQ(1024), OPQ(1024), S, E);
    }
    SEAM(1);
    if (IN(2)) for (int rep_ = 0; rep_ < REPS(2); ++rep_) {
        FRESH_CX;
        for (int m = cx.gw; m < M; m += cx.NGW) {
            const int lane = cx.lane; const bool first = (m & (SEQ - 1)) == 0;
            const u32x2 a = *((const u32x2*)(LP + (size_t)m * 512) + lane); u32x2 b = (u32x2){0u, 0u}; if (!first) b = *((const u32x2*)(LP + (size_t)(m - 1) * 512 + 256) + lane);
            float v[4] = {lo16(a.x) + lo16(b.x), hi16(a.x) + hi16(b.x), lo16(a.y) + lo16(b.y), hi16(a.y) + hi16(b.y)};
#pragma unroll
            for (int i = 0; i < 4; ++i) v[i] = lane < 16 ? ftanh(v[i]) : (lane < 32 ? v[i] : fsigmoid(v[i]));
            u32x2 o; o.x = pk2(v[0], v[1]); o.y = pk2(v[2], v[3]); *((u32x2*)(LACT + (size_t)m * 256) + lane) = o;
            const u32x4 uu = *((const u32x4*)(UB + (size_t)m * 512) + lane); const int g = lane >> 1;
            *(u32x4*)(AG + ((size_t)(g * 1024 + (m >> 5))) * 640 + (m & 31) * 16 + (lane & 1) * 8) = uu;
        }
    }
    SEAM(2);
    if (IN(3)) for (int rep_ = 0; rep_ < REPS(3); ++rep_) {
        FRESH_CX;
        { SchedPlain S; S.init(128, 6, cx.G, cx.wg); S.A = (const char*)LACT; S.B = (const char*)WL2; S.a_tile = 256 * 256 * 2; S.b_tile = 256 * 256 * 2;
          EpiBf16Plain E{WAG, 1536};
          pg8::gemm_phase<EpiBf16Plain, SchedPlain, true, true, false>(lds, cx.tid, OPQ(256), OPQ(256), OPQ(256), S, E); }
        { SchedS5 S; S.init(128, 1, cx.G, cx.wg); S.A = (const char*)AG; S.B = (const char*)S5ET; S.a_tile = 256 * 640 * 2; S.b_tile = 0; S.b_group = 256 * 512 * 2;
          EpiF32 E{EBUF, 256};
          pg8::gemm_phase<EpiF32, SchedS5, true, true, false>(lds, cx.tid, OPQ(512), OPQ(640), OPQ(512), S, E); }
    }
    SEAM(3);
    if (IN(4)) for (int rep_ = 0; rep_ < REPS(4); ++rep_) {
        FRESH_CX;
        if (cx.wave == 0 && cx.lane < 32) {
            for (int idx = cx.wg * 32 + cx.lane; idx < 8192; idx += cx.G * 32) { const int b = idx >> 11, g = (idx >> 6) & 31, p = idx & 63;
                const float ar = ATG[(g * 64 + p) * 2], ai = ATG[(g * 64 + p) * 2 + 1]; float sr = 0.f, si = 0.f;
                const size_t row0 = (size_t)g * 1024 + b * 256;
                for (int k0 = 0; k0 < 256; k0 += 16) { float er[16], ei[16];
#pragma unroll
                    for (int k = 0; k < 16; ++k) { er[k] = EBUF[(row0 + k0 + k) * 256 + p]; ei[k] = EBUF[(row0 + k0 + k) * 256 + 64 + p]; }
#pragma unroll
                    for (int k = 0; k < 16; ++k) { bf16* d = AG + (row0 + k0 + k) * 640 + 512 + p; d[0] = (bf16)(pk2(sr, 0.f) & 0xffffu); d[64] = (bf16)(pk2(si, 0.f) & 0xffffu);
                        const float nr = ar * sr - ai * si + er[k], ni = ar * si + ai * sr + ei[k]; sr = nr; si = ni; } }
            }
        }
        MAKE_RP;
        for (int ci = cx.wg; ci < 4096; ci += cx.G) rwkv_pass1_chunk(lds, RP, (cx.G == 256 ? (cx.wg * 16 + (ci >> 8)) : ci), cx.tid, QCT, HCT, W1G, ULG, DLG);
    }
    SEAM(4);
    if (IN(5)) for (int rep_ = 0; rep_ < REPS(5); ++rep_) {
        FRESH_CX;
        { SchedS5 S; S.init(128, 2, cx.G, cx.wg); S.A = (const char*)AG; S.B = (const char*)S5BT; S.a_tile = 256 * 640 * 2; S.b_tile = 256 * 640 * 2; S.b_group = 512 * 640 * 2;
          EpiS5Y E{AG, I[11], Y1};
          pg8::gemm_phase<EpiS5Y, SchedS5, true, true, false>(lds, cx.tid, OPQ(640), OPQ(640), OPQ(640), S, E); }
        if (cx.wave == 0) for (int it = cx.wg; it < 128; it += cx.G) rwkv_pass2(it >> 2, it & 3, cx.lane, QCT, HCT, DLG, S0G);
    }
    SEAM(5);
    if (IN(6)) for (int rep_ = 0; rep_ < REPS(6); ++rep_) {
        FRESH_CX;
        MAKE_RP;
        for (int ci = cx.wg; ci < 4096; ci += cx.G) rwkv_pass3_chunk(lds, RP, (cx.G == 256 ? (cx.wg * 16 + (ci >> 8)) : ci), cx.tid, S0G, W1G, ULG, MIX);
        __syncthreads();
        { SchedPlain S; S.init(128, 2, cx.G, cx.wg); S.A = (const char*)Y1; S.B = (const char*)WGLU; S.a_tile = 256 * 512 * 2; S.b_tile = 256 * 512 * 2;
          EpiGlu E{Y1, MIX};
          pg8::gemm_phase<EpiGlu, SchedPlain, true, true, false>(lds, cx.tid, OPQ(512), OPQ(512), OPQ(512), S, E); }
    }
    SEAM(6);
    if (IN(7)) for (int rep_ = 0; rep_ < REPS(7); ++rep_) {
        FRESH_CX;
        SchedPlain S; S.init(128, 4, cx.G, cx.wg); S.A = (const char*)MIX; S.B = (const char*)WOUT; S.a_tile = 256 * 1024 * 2; S.b_tile = 256 * 1024 * 2;
        EpiResid E{x, args.out};
        pg8::gemm_phase<EpiResid, SchedPlain, true, true, false>(lds, cx.tid, OPQ(1024), OPQ(1024), OPQ(1024), S, E);
    }
    SEAM(7);
    if (IN(8)) for (int rep_ = 0; rep_ < REPS(8); ++rep_) { FRESH_CX; router_phase(cx, args.out, I[29], I[30], I[31], H2, TOPE, TOPG, HIST); }
    SEAM(8);
    LAS int* PL = (LAS int*)(lds + LDS_PLAN);
    if (hi > 9 && lo < 28) { FRESH_CX; __syncthreads(); moe_plan(cx, HIST); }
    const int npass = (hi > 9 && lo < 28) ? PL[PL_NPASS] : 0;
    if (IN(9)) for (int rep_ = 0; rep_ < REPS(9); ++rep_) { FRESH_CX; dispatch_phase(cx, HIST, TOPE, SLOTTOK, TOKSLOT); convert_pass(cx, PL[PL_PE0], PL[PL_PE0 + 1], I[32], I[34], I[36], WGU, WDN); }
    SEAM(9);
    for (int p = 0; p < 6; ++p) {
        const bool actv = p < npass;
        const int e0 = actv ? PL[PL_PE0 + p] : 0, e1 = actv ? PL[PL_PE0 + p + 1] : 0, row0 = actv ? PL[PL_PROW0 + p] : 0, rows = actv ? PL[PL_PROW0 + p + 1] - row0 : 0;
        if (IN(10 + 3 * p) && actv) for (int rep_ = 0; rep_ < REPS(10); ++rep_) {
            FRESH_CX;
            SchedMoe<true> S; S.init(rows / 256, 8, cx.G, cx.wg); S.A = (const char*)H2; S.B = (const char*)WGU; S.a_tile = 0; S.b_tile = 256 * 1024; S.b_exp = (size_t)2048 * 1024; S.tile_e = PL + PL_TILEE; S.tile0 = row0 / 256; S.e0 = e0; S.slot_tok = SLOTTOK; S.row0 = row0;
            EpiGU E{ACT, I[33], I[35]};
            pg8::gemm_phase<EpiGU, SchedMoe<true>, true, true, true, true>(lds, cx.tid, OPQ(512), OPQ(512), OPQ(512), S, E);
        }
        if (actv) SEAM(10 + 3 * p);
        if (IN(11 + 3 * p) && actv) for (int rep_ = 0; rep_ < REPS(11); ++rep_) {
            FRESH_CX;
            SchedMoe<false> S; S.init(rows / 256, 4, cx.G, cx.wg); S.A = (const char*)ACT; S.B = (const char*)WDN; S.a_tile = 256 * 1024; S.b_tile = 256 * 1024; S.b_exp = (size_t)1024 * 1024; S.tile_e = PL + PL_TILEE; S.tile0 = row0 / 256; S.e0 = e0; S.slot_tok = SLOTTOK; S.row0 = row0;
            EpiDown E{YB, I[37]};
            pg8::gemm_phase<EpiDown, SchedMoe<false>, true, true, false, true>(lds, cx.tid, OPQ(512), OPQ(512), OPQ(512), S, E);
        }
        if (actv) SEAM(11 + 3 * p);
        if (IN(12 + 3 * p) && actv) for (int rep_ = 0; rep_ < REPS(12); ++rep_) {
            FRESH_CX;
            if (p + 1 < npass) { combine_pass<false>(cx, e0, e1, row0, TOPE, TOPG, TOKSLOT, YB, args.out, nullptr, nullptr); convert_pass(cx, PL[PL_PE0 + p + 1], PL[PL_PE0 + p + 2], I[32], I[34], I[36], WGU, WDN); }
            else {
                combine_pass<true>(cx, e0, e1, row0, TOPE, TOPG, TOKSLOT, YB, args.out, I[38], (bf16*)(ws + WS_R1));
                SchedPlain S; S.init(128, 4, cx.G, cx.wg); S.A = (const char*)PBF; S.B = (const char*)WPP; S.a_tile = 256 * 256 * 2; S.b_tile = 256 * 256 * 2;
                EpiBf16Plain E{PP, 1024};
                pg8::gemm_phase<EpiBf16Plain, SchedPlain, true, true, false>(lds, cx.tid, OPQ(256), OPQ(256), OPQ(256), S, E);
            }
        }
        if (actv) SEAM(12 + 3 * p);
    }
    if (IN(29)) for (int rep_ = 0; rep_ < REPS(29); ++rep_) {
        FRESH_CX;
        SchedPlain S; S.init(128, 4, cx.G, cx.wg); S.A = (const char*)(ws + WS_R1); S.B = (const char*)WPG; S.a_tile = 256 * 1024 * 2; S.b_tile = 256 * 1024 * 2;
        EpiPle E{PP, args.out};
        pg8::gemm_phase<EpiPle, SchedPlain, true, true, false>(lds, cx.tid, OPQ(1024), OPQ(1024), OPQ(1024), S, E);
    }
    SEAM(29);
    if (IN(30)) for (int rep_ = 0; rep_ < REPS(30); ++rep_) {
        FRESH_CX;
        for (int m = cx.gw; m < M; m += cx.NGW) {
            f32x4* xr = (f32x4*)(args.out + (size_t)m * 1024) + cx.lane; const f32x4* gr = (const f32x4*)I[41] + cx.lane; f32x4 v[4]; float s = 0.f;
#pragma unroll
            for (int j = 0; j < 4; ++j) { v[j] = xr[64 * j]; s += (v[j].x * v[j].x + v[j].y * v[j].y) + (v[j].z * v[j].z + v[j].w * v[j].w); }
            const float rinv = rsqrtf(wave_sum(s) * (1.f / 1024.f) + 1e-6f);
#pragma unroll
            for (int j = 0; j < 4; ++j) { const f32x4 gg = gr[64 * j]; xr[64 * j] = (f32x4){v[j].x * rinv * gg.x, v[j].y * rinv * gg.y, v[j].z * rinv * gg.z, v[j].w * rinv * gg.w}; }
        }
    }
#undef IN
#undef SEAM
}

extern "C" void kernel_launch(void* const* d_in, const int* in_sizes, int n_in, void* d_out, int out_size, void* d_ws, size_t ws_size, hipStream_t stream) {
    static int grid = 0;
    if (grid == 0) {
        if (n_in != 42 || out_size != M * DM || ws_size < WS_END) { fprintf(stderr, "kernel_launch: unexpected shapes (n_in %d out %d ws %zu)\n", n_in, out_size, ws_size); grid = -1; return; }
        int dev = 0, cus = 0, per_cu = 0;
        if (hipGetDevice(&dev) != hipSuccess || hipDeviceGetAttribute(&cus, hipDeviceAttributeMultiprocessorCount, dev) != hipSuccess) { grid = -1; return; }
        if (hipFuncSetAttribute((const void*)mk_fwd, hipFuncAttributeMaxDynamicSharedMemorySize, LDS_BYTES) != hipSuccess) { fprintf(stderr, "kernel_launch: hipFuncSetAttribute failed\n"); grid = -1; return; }
        if (hipOccupancyMaxActiveBlocksPerMultiprocessor(&per_cu, (const void*)mk_fwd, NTHR, LDS_BYTES) != hipSuccess || per_cu < 1) fprintf(stderr, "kernel_launch: occupancy query says %d\n", per_cu);
        (void)hipGetLastError();
        grid = cus > 256 ? 256 : cus;
    }
    if (grid < 0) return;
    (void)hipMemsetAsync((char*)d_ws + WS_CTL, 0, CTL_ZERO_BYTES, stream);
    Args a{};
    for (int i = 0; i < 42; ++i) a.in[i] = (const float*)d_in[i];
    a.out = (float*)d_out; a.ws = (unsigned char*)d_ws;
#if MK_PER_PHASE
    for (int ph = 0; ph < NPH; ++ph) { a.ph_lo = ph; a.ph_hi = ph + 1; hipLaunchKernelGGL(mk_fwd, dim3(grid), dim3(NTHR), LDS_BYTES, stream, a); }
#else
    a.ph_lo = 0; a.ph_hi = NPH;
    hipLaunchKernelGGL(mk_fwd, dim3(grid), dim3(NTHR), LDS_BYTES, stream, a);
#endif
}
```

```cpp
#include <hip/hip_runtime.h>
#include <cstdio>
#include <cstdint>

#ifndef MK_PER_PHASE
#define MK_PER_PHASE 0
#endif

#define LAS __attribute__((address_space(3)))
#define GAS __attribute__((address_space(1)))
typedef unsigned short bf16;
typedef short bf16x8 __attribute__((ext_vector_type(8)));
typedef float f32x4 __attribute__((ext_vector_type(4)));
typedef float f32x2 __attribute__((ext_vector_type(2)));
typedef unsigned u32x4 __attribute__((ext_vector_type(4)));
typedef unsigned u32x2 __attribute__((ext_vector_type(2)));
typedef GAS unsigned gu32;

constexpr int NB = 4, SEQ = 8192, DM = 1024, M = NB * SEQ;
constexpr int NEXP = 32, TOPK = 4;
constexpr int NWAVES = 8, NTHR = 512;
constexpr size_t MiB = 1u << 20;

constexpr size_t WS_CTL = 0, CTL_ZERO_BYTES = 1 * MiB;
constexpr size_t WS_HIST = 1 * MiB;
constexpr size_t WS_TOPE = 2 * MiB;
constexpr size_t WS_TOPG = 3 * MiB;
constexpr size_t WS_TOKSLOT = 4 * MiB;
constexpr size_t WS_SLOTTOK = 5 * MiB;
constexpr size_t WS_AT = 6 * MiB;
constexpr size_t WS_DL = 6 * MiB + 65536;
constexpr size_t WS_WCAT = 8 * MiB;
constexpr size_t WS_WL2 = 13 * MiB;
constexpr size_t WS_WGLU = 14 * MiB;
constexpr size_t WS_WPP = 14 * MiB + 524288;
constexpr size_t WS_WOUT = 15 * MiB;
constexpr size_t WS_WPG = 17 * MiB;
constexpr size_t WS_S5BT = 19 * MiB;
constexpr size_t WS_S5ET = 39 * MiB;
constexpr size_t WS_PBF = 48 * MiB;
constexpr size_t WS_R1 = 64 * MiB;
constexpr size_t WS_RKV = 128 * MiB;
constexpr size_t WS_WAG = 224 * MiB;
constexpr size_t WS_AG = 320 * MiB;
constexpr size_t WS_U = 360 * MiB;
constexpr size_t WS_LP = 392 * MiB;
constexpr size_t WS_LACT = 424 * MiB;
constexpr size_t WS_W1 = 440 * MiB;
constexpr size_t WS_ULOC = 472 * MiB;
constexpr size_t WS_Y1 = 504 * MiB;
constexpr size_t WS_H2 = 64 * MiB;
constexpr size_t WS_WDN = 96 * MiB;
constexpr size_t WS_ACT = 128 * MiB;
constexpr size_t WS_Y = 264 * MiB;
constexpr size_t WS_WGU = 264 * MiB;
constexpr int RMAX = 139264;
constexpr int MAXEPP = 32;
constexpr size_t WS_END = 560 * MiB;
static_assert(WS_Y + (size_t)RMAX * 2048 <= WS_END && WS_ACT + (size_t)RMAX * 1024 <= WS_Y, "moe map");

constexpr int CW_BAR = 4096;

constexpr int LDS_PLAN = 147456;
constexpr int LDS_MISC = 155648;
constexpr int LDS_BYTES = 156672;
constexpr int PL_CNT = 0, PL_PSTART = 32, PL_NPASS = 72, PL_PE0 = 80, PL_PROW0 = 88, PL_TILEE = 128, PL_TMP = 768;

#define LDS_WAIT() asm volatile("s_waitcnt lgkmcnt(0)" ::: "memory")
#define VM_WAIT() asm volatile("s_waitcnt vmcnt(0)" ::: "memory")
__device__ __forceinline__ float bf2f(unsigned b) { return __uint_as_float(b << 16); }
typedef __bf16 bf16n2 __attribute__((ext_vector_type(2)));
__device__ __forceinline__ unsigned cvt_pk_bf16(float lo, float hi) { const f32x2 f = {lo, hi}; const bf16n2 v = __builtin_convertvector(f, bf16n2); return __builtin_bit_cast(unsigned, v); }
__device__ __forceinline__ unsigned pk2(float lo, float hi) { return cvt_pk_bf16(lo, hi); }
__device__ __forceinline__ float lo16(unsigned w) { return __uint_as_float(w << 16); }
__device__ __forceinline__ float hi16(unsigned w) { return __uint_as_float(w & 0xffff0000u); }
__device__ __forceinline__ unsigned pk4_fp8(float a, float b, float c, float d) { unsigned w = 0u; w = (unsigned)__builtin_amdgcn_cvt_pk_fp8_f32(a, b, (int)w, false); w = (unsigned)__builtin_amdgcn_cvt_pk_fp8_f32(c, d, (int)w, true); return w; }
__device__ __forceinline__ float frcp(float x) { return __builtin_amdgcn_rcpf(x); }
__device__ __forceinline__ float fsigmoid(float x) { return frcp(1.0f + __expf(-x)); }
__device__ __forceinline__ float ftanh(float x) { const float e = __expf(-2.0f * fabsf(x)); const float t = (1.0f - e) * frcp(1.0f + e); return x < 0.f ? -t : t; }
__device__ __forceinline__ float gelu_tanh(float x) { const float u = 0.7978845608f * (x + 0.044715f * x * x * x); return 0.5f * x * (1.0f + ftanh(u)); }
__device__ __forceinline__ float wave_sum(float v) {
#pragma unroll
    for (int o = 1; o < 64; o <<= 1) v += __shfl_xor(v, o);
    return v;
}
__device__ __forceinline__ float wave_max(float v) {
#pragma unroll
    for (int o = 1; o < 64; o <<= 1) v = fmaxf(v, __shfl_xor(v, o));
    return v;
}

#define XB_TMO      128
#define XB_XCNT(j)  (256  + 64 * (j))
#define XB_XSUB(j)  (1280 + 64 * (j))
#define XB_XGEN(j)  (2304 + 64 * (j))
#define XB_TOP      3328
#define XB_TOPGEN   3392
#define XCD_BAR_WORDS 3456
#define XB_SPIN_CAP (1u << 22)

__device__ __forceinline__ unsigned xb_ld(unsigned* p)              { return __hip_atomic_load(p, __ATOMIC_RELAXED, __HIP_MEMORY_SCOPE_AGENT); }
__device__ __forceinline__ unsigned xb_add(unsigned* p, unsigned v) { return __hip_atomic_fetch_add(p, v, __ATOMIC_RELAXED, __HIP_MEMORY_SCOPE_AGENT); }
__device__ __forceinline__ unsigned xb_xcc_id() { return (unsigned)__builtin_amdgcn_s_getreg((3 << 11) | 20) & 0xFu; }
#define XB_SPIN(cond, bar) do { unsigned _sp = 0; while (cond) { __builtin_amdgcn_s_sleep(1); \
    if ((++_sp & 255u) == 0u) { if (xb_ld(&(bar)[XB_TMO])) break; if (_sp > XB_SPIN_CAP) { atomicAdd(&(bar)[XB_TMO], 1u); break; } } } } while (0)

struct XcdBarrier { unsigned* bar; unsigned x; volatile LAS unsigned* st; };

__device__ __forceinline__ XcdBarrier xcd_barrier_post(unsigned* bar, volatile LAS unsigned* st) {
    XcdBarrier b; b.bar = bar; b.x = xb_xcc_id(); b.st = st;
    if (threadIdx.x == 0) (void)xb_add(&bar[XB_XCNT(b.x)], 1u);
    return b;
}
__device__ __forceinline__ void xcd_barrier_complete(unsigned* bar, unsigned x, unsigned& nloc, unsigned& nx) {
    const unsigned G = gridDim.x * gridDim.y * gridDim.z;
    unsigned sum, cnt, mine, sp = 0u;
    for (;;) {
        sum = 0u; cnt = 0u; mine = 0u;
#pragma unroll
        for (unsigned j = 0; j < 16; ++j) { const unsigned c = xb_ld(&bar[XB_XCNT(j)]); sum += c; cnt += (c > 0u) ? 1u : 0u; mine = (j == x) ? c : mine; }
        if (sum == G) break;
        __builtin_amdgcn_s_sleep(1);
        if ((++sp & 255u) == 0u) { if (xb_ld(&bar[XB_TMO])) break; if (sp > XB_SPIN_CAP) { atomicAdd(&bar[XB_TMO], 1u); break; } }
    }
    nloc = mine > 0u ? mine : 1u; nx = cnt > 0u ? cnt : 1u;
}
__device__ __forceinline__ void xcd_barrier(const XcdBarrier& b) {
    asm volatile("s_waitcnt vmcnt(0)" ::: "memory");
    __syncthreads();
    if (threadIdx.x == 0) {
        unsigned* bar = b.bar;
        __builtin_amdgcn_s_waitcnt(0);
        unsigned nloc = b.st[0], nx = b.st[1];
        if (nloc == 0u) { xcd_barrier_complete(bar, b.x, nloc, nx); b.st[0] = nloc; b.st[1] = nx; }
        const unsigned old = xb_add(&bar[XB_XSUB(b.x)], 1u);
        const unsigned gen = old / nloc;
        if (old + 1u == (gen + 1u) * nloc) {
            __builtin_amdgcn_fence(__ATOMIC_RELEASE, "agent");
            asm volatile("s_waitcnt vmcnt(0)" ::: "memory");
            const unsigned og = xb_add(&bar[XB_TOP], 1u);
            const unsigned tg = og / nx;
            if (og + 1u == (tg + 1u) * nx) xb_add(&bar[XB_TOPGEN], 1u);
            else XB_SPIN(xb_ld(&bar[XB_TOPGEN]) == tg, bar);
            __builtin_amdgcn_fence(__ATOMIC_ACQUIRE, "agent");
            xb_add(&bar[XB_XGEN(b.x)], 1u);
            asm volatile("s_waitcnt vmcnt(0)" ::: "memory");
        } else {
            XB_SPIN(xb_ld(&bar[XB_XGEN(b.x)]) == gen, bar);
            __builtin_amdgcn_fence(__ATOMIC_ACQUIRE, "agent");
            asm volatile("s_waitcnt vmcnt(0)" ::: "memory");
        }
    }
    __syncthreads();
}

namespace pg8 {
constexpr int BM = 256, BK = 64, HALF = 128, HTB = HALF * BK * 2, STAGE_BYTES = 8 * HTB, NXCD = 8, WGM = 8;
__host__ __device__ __forceinline__ int lds_byte(int r, int c) { const int st = (r >> 4) * 2 + (c >> 5), rr = r & 15, cc = c & 31, ob = rr * 64 + cc * 2; return st * 1024 + (ob ^ (((ob >> 9) & 1) << 5)); }
__host__ __device__ __forceinline__ void stage_rc(int b, int& R, int& C) { const int st = b / 1024, sb = b % 1024, swz = sb ^ (((sb >> 9) & 1) << 5); R = (st >> 1) * 16 + swz / 64; C = (st & 1) * 32 + (swz % 64) / 2; }
__host__ __device__ __forceinline__ int perm32(int rho) { const int n = rho >> 4, i = rho & 15; return 8 * (i >> 2) + 4 * n + (i & 3); }

struct Unit { int pm, pn, aux; };

struct Order {
    int nM, nN, nwg, G, c;
    __device__ __forceinline__ void init(int nM_, int nN_, int G_, int c_) { nM = nM_; nN = nN_; nwg = nM * nN; G = G_; c = c_; }
    __device__ __forceinline__ bool tile(int i, int& pm, int& pn) const {
        const long L = (long)i * G + c; if (L >= nwg) return false;
        int wgid = (int)L; { const int q = nwg / NXCD, r = nwg % NXCD, xcd = wgid % NXCD, off = wgid / NXCD; wgid = (xcd < r ? xcd * (q + 1) : r * (q + 1) + (xcd - r) * q) + off; }
        const int nig = WGM * nN, gid = wgid / nig, fm = gid * WGM, gsz = (nM - fm) < WGM ? (nM - fm) : WGM;
        pm = fm + ((wgid % nig) % gsz); pn = (wgid % nig) / gsz; return true;
    }
};


template <class Epi, class Sched, bool ALIGN_EPI, bool SP2, bool GATHER, bool FP8 = false>
__device__ __forceinline__ void gemm_phase(LAS unsigned char* lds, const int tid, const int K, const int lda, const int ldb, const Sched& S, const Epi& E) {
    const int wid = __builtin_amdgcn_readfirstlane(tid >> 6), lane = tid & 63, wr = wid >> 2, wc = wid & 3, fr = lane & 15, fq = lane >> 4;
    const int nt = K / BK;
    unsigned voffA[2], voffB[2]; int rA[2], cA2[2];
#pragma unroll
    for (int i = 0; i < 2; ++i) { int R, C; stage_rc(tid * 16 + i * 8192, R, C); const int Rb = Epi::PERM ? ((R & ~31) + perm32(R & 31)) : R;
        voffA[i] = (unsigned)(R * lda + C) * 2u; voffB[i] = (unsigned)(Rb * ldb + C) * 2u; rA[i] = R; cA2[i] = C * 2; }
    const size_t kstep = (size_t)(BK * 2);
    const size_t hstepA = (size_t)HALF * lda * 2, hstepB = (size_t)HALF * ldb * 2;
    const unsigned ldsw = (unsigned)wid * 1024u;
    const int aoff = FP8 ? lds_byte(wr * 64 + fr, fq * 16) : lds_byte(wr * 64 + fr, fq * 8), boff = FP8 ? lds_byte(wc * 32 + fr, fq * 16) : lds_byte(wc * 32 + fr, fq * 8);
    unsigned cv0[2] = {0u, 0u}, cv1[2] = {0u, 0u}, nv0[2] = {0u, 0u}, nv1[2] = {0u, 0u};
#define PG8_SA(b, h) (((b) * 2 + (h)) * HTB)
#define PG8_SB(b, h) ((4 + (b) * 2 + (h)) * HTB)
#define PG8_STAGE(bufoff, gbase, voff) do { _Pragma("unroll") for (int _i = 0; _i < 2; ++_i) \
        __builtin_amdgcn_global_load_lds((const unsigned*)((const char*)(gbase) + (voff)[_i]), (LAS unsigned*)(lds + (bufoff) + ldsw + _i * 8192), 16, 0, 0); } while (0)
#define PG8_STAGE_A(bufoff, ptr, h, nx) do { if constexpr (GATHER) { unsigned _v[2]; _v[0] = (nx) ? ((h) ? nv1[0] : nv0[0]) : ((h) ? cv1[0] : cv0[0]); _v[1] = (nx) ? ((h) ? nv1[1] : nv0[1]) : ((h) ? cv1[1] : cv0[1]); PG8_STAGE(bufoff, ptr, _v); } \
        else { PG8_STAGE(bufoff, (ptr) + (h) * hstepA, voffA); } } while (0)
#define PG8_LDA(dst, b, h) do { if constexpr (FP8) { _Pragma("unroll") for (int m = 0; m < 4; ++m) { dst##8[m].lo = *(const LAS v4i_*)(lds + PG8_SA(b, h) + aoff + m * 2048); dst##8[m].hi = *(const LAS v4i_*)(lds + PG8_SA(b, h) + aoff + m * 2048 + 16); } } \
        else { _Pragma("unroll") for (int m = 0; m < 4; ++m) _Pragma("unroll") for (int k = 0; k < 2; ++k) dst[m][k] = *(const LAS bf16x8*)(lds + PG8_SA(b, h) + aoff + m * 2048 + k * 1024); } } while (0)
#define PG8_LDB(dst, b, h) do { if constexpr (FP8) { _Pragma("unroll") for (int n = 0; n < 2; ++n) { dst##8[n].lo = *(const LAS v4i_*)(lds + PG8_SB(b, h) + boff + n * 2048); dst##8[n].hi = *(const LAS v4i_*)(lds + PG8_SB(b, h) + boff + n * 2048 + 16); } } \
        else { _Pragma("unroll") for (int n = 0; n < 2; ++n) _Pragma("unroll") for (int k = 0; k < 2; ++k) dst[n][k] = *(const LAS bf16x8*)(lds + PG8_SB(b, h) + boff + n * 2048 + k * 1024); } } while (0)
#define PG8_MMA(ai, bj, At, Bt) do { __builtin_amdgcn_s_setprio(1); _Pragma("unroll") for (int m = 0; m < 4; ++m) _Pragma("unroll") for (int n = 0; n < 2; ++n) { \
        if constexpr (FP8) asm volatile("v_mfma_scale_f32_16x16x128_f8f6f4 %0, %1, %2, %0, %3, %4 op_sel_hi:[0,0,0]" : "+v"(acc[ai][bj][m][n]) : "v"(Bt##8[n]), "v"(At##8[m]), "v"(sclW), "v"(sclA));   \
        else { _Pragma("unroll") for (int k = 0; k < 2; ++k) acc[ai][bj][m][n] = __builtin_amdgcn_mfma_f32_16x16x32_bf16(Bt[n][k], At[m][k], acc[ai][bj][m][n], 0, 0, 0); } } \
        __builtin_amdgcn_s_setprio(0); } while (0)
#define PG8_WAIT_V(n) asm volatile("s_waitcnt vmcnt(" #n ")" ::: "memory")
#define PG8_WAIT_L(n) asm volatile("s_waitcnt lgkmcnt(" #n ")" ::: "memory")
#define PG8_BAR __builtin_amdgcn_s_barrier()
#define PG8_SCHED __builtin_amdgcn_sched_barrier(0)
#define PG8_ROWS(u, d0, d1) do { _Pragma("unroll") for (int _i = 0; _i < 2; ++_i) { const int _r0 = S.a_row(u, rA[_i]), _r1 = S.a_row(u, HALF + rA[_i]); \
        d0[_i] = (unsigned)_r0 * (unsigned)(lda * 2) + (unsigned)cA2[_i]; d1[_i] = (unsigned)_r1 * (unsigned)(lda * 2) + (unsigned)cA2[_i]; } } while (0)
    Unit cur, nxt; int ui = 0;
    if (!S.next(0, cur)) return;
    f32x4 acc[2][2][4][2];
#pragma unroll
    for (int a = 0; a < 2; ++a)
#pragma unroll
        for (int b = 0; b < 2; ++b)
#pragma unroll
            for (int m = 0; m < 4; ++m)
#pragma unroll
                for (int n = 0; n < 2; ++n) acc[a][b][m][n] = (f32x4){0.f, 0.f, 0.f, 0.f};
    typedef int v8i_ __attribute__((ext_vector_type(8))); typedef int v4i_ __attribute__((ext_vector_type(4)));
    bf16x8 At[4][2], B0[2][2], B1[2][2]; v8i_ At8[4], B08[2], B18[2];
    const int sclW = 0x7a7a7a7a, sclA = 0x7f7f7f7f;
    const char* cA = S.a_ptr(cur); const char* cB = S.b_ptr(cur);
    if constexpr (GATHER) { PG8_ROWS(cur, cv0, cv1); }
    if constexpr (SP2) {
        PG8_STAGE(PG8_SB(0, 0), cB, voffB); PG8_STAGE(PG8_SB(0, 1), cB + hstepB, voffB); PG8_STAGE_A(PG8_SA(0, 0), cA, 0, false); PG8_STAGE_A(PG8_SA(0, 1), cA, 1, false);
        if (wr == 1) PG8_BAR;
        PG8_WAIT_V(2); PG8_BAR;
        PG8_STAGE(PG8_SB(1, 0), cB + kstep, voffB); PG8_STAGE_A(PG8_SA(1, 0), cA + kstep, 0, false); PG8_STAGE(PG8_SB(1, 1), cB + hstepB + kstep, voffB);
        PG8_WAIT_V(6); PG8_BAR;
    } else {
        PG8_STAGE(PG8_SB(0, 0), cB, voffB); PG8_STAGE_A(PG8_SA(0, 0), cA, 0, false); PG8_STAGE(PG8_SB(0, 1), cB + hstepB, voffB); PG8_STAGE_A(PG8_SA(0, 1), cA, 1, false);
        if (wr == 1) PG8_BAR;
        PG8_WAIT_V(4); PG8_BAR;
        PG8_STAGE(PG8_SB(1, 0), cB + kstep, voffB); PG8_STAGE_A(PG8_SA(1, 0), cA + kstep, 0, false); PG8_STAGE(PG8_SB(1, 1), cB + hstepB + kstep, voffB);
        PG8_WAIT_V(6); PG8_BAR;
    }
    for (;;) {
        const bool has_next = S.next(ui + 1, nxt);
        const char* nA = has_next ? S.a_ptr(nxt) : cA; const char* nB = has_next ? S.b_ptr(nxt) : cB;
        if constexpr (GATHER) { if (has_next) { PG8_ROWS(nxt, nv0, nv1); } else { nv0[0] = cv0[0]; nv0[1] = cv0[1]; nv1[0] = cv1[0]; nv1[1] = cv1[1]; } }
        for (int t = 0; t < nt; t += 2) {
            const bool last = (t == nt - 2);
            const char* a1 = cA + (size_t)(t + 1) * kstep;
            const char* a2 = last ? nA : cA + (size_t)(t + 2) * kstep; const char* b2 = last ? nB : cB + (size_t)(t + 2) * kstep;
            const char* a3 = a2 + kstep; const char* b3 = b2 + kstep;
            if constexpr (SP2) {
            PG8_LDB(B0, 0, 0); PG8_LDB(B1, 0, 1); PG8_SCHED; PG8_LDA(At, 0, 0); PG8_STAGE_A(PG8_SA(1, 1), a1, 1, false);
            PG8_WAIT_V(8); PG8_WAIT_L(0); PG8_BAR; PG8_MMA(0, 0, At, B0); PG8_MMA(0, 1, At, B1); PG8_BAR; PG8_SCHED;
            PG8_LDA(At, 0, 1); PG8_STAGE(PG8_SB(0, 0), b2, voffB); PG8_STAGE(PG8_SB(0, 1), b2 + hstepB, voffB); PG8_STAGE_A(PG8_SA(0, 0), a2, 0, last);
            PG8_WAIT_V(8); PG8_WAIT_L(0); PG8_BAR; PG8_MMA(1, 0, At, B0); PG8_MMA(1, 1, At, B1); PG8_BAR; PG8_SCHED;
            PG8_LDB(B0, 1, 0); PG8_LDB(B1, 1, 1); PG8_SCHED; PG8_LDA(At, 1, 0); PG8_STAGE_A(PG8_SA(0, 1), a2, 1, last);
            PG8_WAIT_V(8); PG8_WAIT_L(0); PG8_BAR; PG8_MMA(0, 0, At, B0); PG8_MMA(0, 1, At, B1); PG8_BAR; PG8_SCHED;
            PG8_LDA(At, 1, 1); PG8_STAGE(PG8_SB(1, 0), b3, voffB); PG8_STAGE(PG8_SB(1, 1), b3 + hstepB, voffB); PG8_STAGE_A(PG8_SA(1, 0), a3, 0, last);
            PG8_WAIT_V(8); PG8_WAIT_L(0); PG8_BAR; PG8_MMA(1, 0, At, B0); PG8_MMA(1, 1, At, B1); PG8_BAR; PG8_SCHED;
            } else {
            PG8_LDB(B0, 0, 0); PG8_SCHED; PG8_LDA(At, 0, 0); PG8_STAGE_A(PG8_SA(1, 1), a1, 1, false);
            PG8_WAIT_L(8); PG8_BAR; PG8_WAIT_L(0); PG8_MMA(0, 0, At, B0); PG8_BAR; PG8_SCHED;
            PG8_LDB(B1, 0, 1); PG8_STAGE(PG8_SB(0, 0), b2, voffB);
            PG8_BAR; PG8_WAIT_L(0); PG8_MMA(0, 1, At, B1); PG8_BAR;
            PG8_LDA(At, 0, 1); PG8_STAGE_A(PG8_SA(0, 0), a2, 0, last);
            PG8_BAR; PG8_WAIT_L(0); PG8_MMA(1, 0, At, B0); PG8_BAR; PG8_SCHED;
            PG8_STAGE(PG8_SB(0, 1), b2 + hstepB, voffB);
            PG8_WAIT_V(6); PG8_BAR; PG8_MMA(1, 1, At, B1); PG8_BAR;
            PG8_LDB(B0, 1, 0); PG8_SCHED; PG8_LDA(At, 1, 0); PG8_STAGE_A(PG8_SA(0, 1), a2, 1, last);
            PG8_WAIT_L(8); PG8_BAR; PG8_WAIT_L(0); PG8_MMA(0, 0, At, B0); PG8_BAR; PG8_SCHED;
            PG8_LDB(B1, 1, 1); PG8_STAGE(PG8_SB(1, 0), b3, voffB);
            PG8_BAR; PG8_WAIT_L(0); PG8_MMA(0, 1, At, B1); PG8_BAR;
            PG8_LDA(At, 1, 1); PG8_STAGE_A(PG8_SA(1, 0), a3, 0, last);
            PG8_BAR; PG8_WAIT_L(0); PG8_MMA(1, 0, At, B0); PG8_BAR; PG8_SCHED;
            PG8_STAGE(PG8_SB(1, 1), b3 + hstepB, voffB);
            PG8_WAIT_V(6); PG8_BAR; PG8_MMA(1, 1, At, B1); PG8_BAR;
            }
        }
        if constexpr (ALIGN_EPI) { if (wr == 0) PG8_BAR; }
        if constexpr (FP8) asm volatile("s_nop 15\n\ts_nop 15" ::: "memory");
        E(acc, cur, wr, wc, fr, fq);
        if (!has_next) break;
#pragma unroll
        for (int a = 0; a < 2; ++a)
#pragma unroll
            for (int b = 0; b < 2; ++b)
#pragma unroll
                for (int m = 0; m < 4; ++m)
#pragma unroll
                    for (int n = 0; n < 2; ++n) acc[a][b][m][n] = (f32x4){0.f, 0.f, 0.f, 0.f};
        cur = nxt; cA = nA; cB = nB; ++ui;
        if constexpr (GATHER) { cv0[0] = nv0[0]; cv0[1] = nv0[1]; cv1[0] = nv1[0]; cv1[1] = nv1[1]; }
        if constexpr (ALIGN_EPI) { if (wr == 1) PG8_BAR; }
    }
    PG8_WAIT_V(0);
    if constexpr (!ALIGN_EPI) { if (wr == 0) PG8_BAR; }
    PG8_BAR;
#undef PG8_SA
#undef PG8_SB
#undef PG8_STAGE
#undef PG8_STAGE_A
#undef PG8_LDA
#undef PG8_LDB
#undef PG8_MMA
#undef PG8_WAIT_V
#undef PG8_WAIT_L
#undef PG8_BAR
#undef PG8_SCHED
#undef PG8_ROWS
}
}

using pg8::Unit;
struct SchedPlain : pg8::Order {
    const char* A; const char* B; size_t a_tile, b_tile;
    __device__ __forceinline__ bool next(int i, Unit& u) const { u.aux = 0; return tile(i, u.pm, u.pn); }
    __device__ __forceinline__ const char* a_ptr(const Unit& u) const { return A + (size_t)u.pm * a_tile; }
    __device__ __forceinline__ const char* b_ptr(const Unit& u) const { return B + (size_t)u.pn * b_tile; }
    __device__ __forceinline__ int a_row(const Unit&, int) const { return 0; }
};
struct SchedS5 : pg8::Order {
    const char* A; const char* B; size_t a_tile, b_tile, b_group;
    __device__ __forceinline__ bool next(int i, Unit& u) const { u.aux = 0; return tile(i, u.pm, u.pn); }
    __device__ __forceinline__ const char* a_ptr(const Unit& u) const { return A + (size_t)u.pm * a_tile; }
    __device__ __forceinline__ const char* b_ptr(const Unit& u) const { return B + (size_t)(u.pm >> 2) * b_group + (size_t)u.pn * b_tile; }
    __device__ __forceinline__ int a_row(const Unit&, int) const { return 0; }
};
template <bool GATHER> struct SchedMoe : pg8::Order {
    const char* A; const char* B; size_t a_tile, b_tile, b_exp; const LAS int* tile_e; int tile0, e0; const int* slot_tok; int row0;
    __device__ __forceinline__ bool next(int i, Unit& u) const { const bool ok = tile(i, u.pm, u.pn); u.aux = ok ? tile_e[tile0 + u.pm] : 0; return ok; }
    __device__ __forceinline__ const char* a_ptr(const Unit& u) const { return GATHER ? A : A + (size_t)u.pm * a_tile; }
    __device__ __forceinline__ const char* b_ptr(const Unit& u) const { return B + (size_t)(u.aux - e0) * b_exp + (size_t)u.pn * b_tile; }
    __device__ __forceinline__ int a_row(const Unit& u, int r) const { return slot_tok[row0 + u.pm * 256 + r]; }
};

__device__ __forceinline__ void st8(bf16* p, const f32x4 v0, const f32x4 v1) {
    u32x4 w; w.x = cvt_pk_bf16(v0[0], v0[1]); w.y = cvt_pk_bf16(v0[2], v0[3]); w.z = cvt_pk_bf16(v1[0], v1[1]); w.w = cvt_pk_bf16(v1[2], v1[3]); *(u32x4*)p = w;
}
__device__ __forceinline__ void ld8(const bf16* p, f32x4& v0, f32x4& v1) {
    const u32x4 w = *(const u32x4*)p; v0 = (f32x4){lo16(w.x), hi16(w.x), lo16(w.y), hi16(w.y)}; v1 = (f32x4){lo16(w.z), hi16(w.z), lo16(w.w), hi16(w.w)};
}
#define EPI_LOOP_AM _Pragma("unroll") for (int ai = 0; ai < 2; ++ai) _Pragma("unroll") for (int m = 0; m < 4; ++m)
#define EPI_ARGS const f32x4 (&acc)[2][2][4][2], const Unit& u, int wr, int wc, int fr, int fq

struct EpiProj { static constexpr bool PERM = true; bf16 *AG, *RKV, *LP;
    __device__ __forceinline__ void operator()(EPI_ARGS) const {
        const int row0 = u.pm * 256 + wr * 64 + fr;
        if (u.pn < 2) { const int col0 = u.pn * 256 + wc * 32 + 8 * fq;
            EPI_LOOP_AM { const int row = row0 + ai * 128 + m * 16;
#pragma unroll
                for (int bj = 0; bj < 2; ++bj) { const int c = col0 + bj * 128; st8(AG + ((size_t)((c >> 4) * 1024 + (row >> 5))) * 640 + (row & 31) * 16 + (c & 15), acc[ai][bj][m][0], acc[ai][bj][m][1]); } }
        } else {
            bf16* base; int ldc, c0;
            if (u.pn < 8) { base = RKV; ldc = 1536; c0 = (u.pn - 2) * 256; } else { base = LP; ldc = 512; c0 = (u.pn - 8) * 256; }
            const int col0 = c0 + wc * 32 + 8 * fq;
            EPI_LOOP_AM { bf16* rowp = base + (size_t)(row0 + ai * 128 + m * 16) * ldc + col0;
#pragma unroll
                for (int bj = 0; bj < 2; ++bj) st8(rowp + bj * 128, acc[ai][bj][m][0], acc[ai][bj][m][1]); }
        }
    }
};
struct EpiBf16Plain { static constexpr bool PERM = true; bf16* O; int ldc;
    __device__ __forceinline__ void operator()(EPI_ARGS) const {
        const int row0 = u.pm * 256 + wr * 64 + fr, col0 = u.pn * 256 + wc * 32 + 8 * fq;
        EPI_LOOP_AM { bf16* rowp = O + (size_t)(row0 + ai * 128 + m * 16) * ldc + col0;
#pragma unroll
            for (int bj = 0; bj < 2; ++bj) st8(rowp + bj * 128, acc[ai][bj][m][0], acc[ai][bj][m][1]); }
    }
};
struct EpiF32 { static constexpr bool PERM = false; float* C; int ldc;
    __device__ __forceinline__ void operator()(EPI_ARGS) const {
        const int row0 = u.pm * 256 + wr * 64 + fr, col0 = u.pn * 256 + wc * 32 + 4 * fq;
        EPI_LOOP_AM { float* rowp = C + (size_t)(row0 + ai * 128 + m * 16) * ldc + col0;
#pragma unroll
            for (int bj = 0; bj < 2; ++bj)
#pragma unroll
                for (int n = 0; n < 2; ++n) *(f32x4*)(rowp + bj * 128 + n * 16) = acc[ai][bj][m][n]; }
    }
};
struct EpiS5Y { static constexpr bool PERM = true; const bf16* AG; const float* dskip; bf16* Y1;
    __device__ __forceinline__ void operator()(EPI_ARGS) const {
        const int g = u.pm >> 2, crow0 = (u.pm & 3) * 256 + wr * 64 + fr, col0 = u.pn * 256 + wc * 32 + 8 * fq;
        EPI_LOOP_AM { const int crow = crow0 + ai * 128 + m * 16;
#pragma unroll
            for (int bj = 0; bj < 2; ++bj) { const int col = col0 + bj * 128, t = col >> 4, c = col & 15;
                f32x4 u0, u1; ld8(AG + ((size_t)(g * 1024 + crow)) * 640 + col, u0, u1);
                const f32x4 d0 = *(const f32x4*)(dskip + g * 16 + c), d1 = *(const f32x4*)(dskip + g * 16 + c + 4);
                f32x4 v0 = acc[ai][bj][m][0] + d0 * u0, v1 = acc[ai][bj][m][1] + d1 * u1;
#pragma unroll
                for (int j = 0; j < 4; ++j) { v0[j] = gelu_tanh(v0[j]); v1[j] = gelu_tanh(v1[j]); }
                st8(Y1 + (size_t)(crow * 32 + t) * 512 + g * 16 + c, v0, v1); } }
    }
};
struct EpiGlu { static constexpr bool PERM = true; const bf16* Y1; bf16* MIX;
    __device__ __forceinline__ void operator()(EPI_ARGS) const {
        const int row0 = u.pm * 256 + wr * 64 + fr, col0 = u.pn * 256 + wc * 32 + 8 * fq;
        EPI_LOOP_AM { const int row = row0 + ai * 128 + m * 16;
#pragma unroll
            for (int bj = 0; bj < 2; ++bj) { const int col = col0 + bj * 128; f32x4 y0, y1v; ld8(Y1 + (size_t)row * 512 + col, y0, y1v);
                f32x4 v0, v1;
#pragma unroll
                for (int j = 0; j < 4; ++j) { v0[j] = y0[j] * fsigmoid(acc[ai][bj][m][0][j]); v1[j] = y1v[j] * fsigmoid(acc[ai][bj][m][1][j]); }
                st8(MIX + (size_t)row * 1024 + col, v0, v1); } }
    }
};
struct EpiResid { static constexpr bool PERM = false; const float* X; float* O;
    __device__ __forceinline__ void operator()(EPI_ARGS) const {
        const int row0 = u.pm * 256 + wr * 64 + fr, col0 = u.pn * 256 + wc * 32 + 4 * fq;
        EPI_LOOP_AM { const size_t off = (size_t)(row0 + ai * 128 + m * 16) * 1024 + col0;
#pragma unroll
            for (int bj = 0; bj < 2; ++bj)
#pragma unroll
                for (int n = 0; n < 2; ++n) *(f32x4*)(O + off + bj * 128 + n * 16) = *(const f32x4*)(X + off + bj * 128 + n * 16) + acc[ai][bj][m][n]; }
    }
};
struct EpiGU { static constexpr bool PERM = true; unsigned char* ACT; const float* bg; const float* bu;
    __device__ __forceinline__ void operator()(EPI_ARGS) const {
        const int row0 = u.pm * 256 + wr * 64 + fr, col = u.pn * 128 + wc * 32 + 8 * fq; const int e = u.aux;
        const f32x4 g0 = *(const f32x4*)(bg + e * 1024 + col), g1 = *(const f32x4*)(bg + e * 1024 + col + 4), u0 = *(const f32x4*)(bu + e * 1024 + col), u1 = *(const f32x4*)(bu + e * 1024 + col + 4);
        EPI_LOOP_AM { f32x4 v0, v1;
#pragma unroll
            for (int j = 0; j < 4; ++j) {
                const float gt0 = fminf(acc[ai][0][m][0][j] + g0[j], 7.0f), up0 = fminf(fmaxf(acc[ai][1][m][0][j] + u0[j], -7.0f), 7.0f);
                const float gt1 = fminf(acc[ai][0][m][1][j] + g1[j], 7.0f), up1 = fminf(fmaxf(acc[ai][1][m][1][j] + u1[j], -7.0f), 7.0f);
                v0[j] = (up0 + 1.0f) * gt0 * fsigmoid(1.702f * gt0); v1[j] = (up1 + 1.0f) * gt1 * fsigmoid(1.702f * gt1); }
            u32x2 w; w.x = pk4_fp8(v0[0], v0[1], v0[2], v0[3]); w.y = pk4_fp8(v1[0], v1[1], v1[2], v1[3]); *(u32x2*)(ACT + (size_t)(row0 + ai * 128 + m * 16) * 1024 + col) = w; }
    }
};
struct EpiDown { static constexpr bool PERM = true; bf16* Y; const float* bd;
    __device__ __forceinline__ void operator()(EPI_ARGS) const {
        const int row0 = u.pm * 256 + wr * 64 + fr, col0 = u.pn * 256 + wc * 32 + 8 * fq; const int e = u.aux;
        EPI_LOOP_AM { bf16* rowp = Y + (size_t)(row0 + ai * 128 + m * 16) * 1024 + col0;
#pragma unroll
            for (int bj = 0; bj < 2; ++bj) { const f32x4 b0 = *(const f32x4*)(bd + e * 1024 + col0 + bj * 128), b1 = *(const f32x4*)(bd + e * 1024 + col0 + bj * 128 + 4);
                st8(rowp + bj * 128, acc[ai][bj][m][0] + b0, acc[ai][bj][m][1] + b1); } }
    }
};
struct EpiPle { static constexpr bool PERM = false; const bf16* PP; float* O;
    __device__ __forceinline__ void operator()(EPI_ARGS) const {
        const int row0 = u.pm * 256 + wr * 64 + fr, col0 = u.pn * 256 + wc * 32 + 4 * fq;
        EPI_LOOP_AM { const size_t off = (size_t)(row0 + ai * 128 + m * 16) * 1024 + col0;
#pragma unroll
            for (int bj = 0; bj < 2; ++bj)
#pragma unroll
                for (int n = 0; n < 2; ++n) { const size_t o = off + bj * 128 + n * 16; const u32x2 w = *(const u32x2*)(PP + o); const f32x4 pp = (f32x4){lo16(w.x), hi16(w.x), lo16(w.y), hi16(w.y)};
                    f32x4 x = *(const f32x4*)(O + o);
#pragma unroll
                    for (int j = 0; j < 4; ++j) x[j] += pp[j] * fsigmoid(acc[ai][bj][m][n][j]);
                    *(f32x4*)(O + o) = x; } }
    }
};

struct Ctx { LAS unsigned char* lds; int tid, lane, wave, G, wg, gw, NGW; };

template <int NBW>
__device__ __forceinline__ void transpose_item(const float* W, int N, int k0, int n0, bf16* dst, int ldk, const float* scl, int flip, LAS float* scr, int lane) {
    constexpr int LPR = NBW / 4, RPI = 64 / LPR, NI = 64 / RPI;
    const int rr = lane / LPR, cc = (lane % LPR) * 4;
    f32x4 v[NI];
#pragma unroll
    for (int i = 0; i < NI; ++i) v[i] = *(const f32x4*)(W + (size_t)(k0 + i * RPI + rr) * N + n0 + cc);
#pragma unroll
    for (int i = 0; i < NI; ++i) { const int kk = i * RPI + rr; f32x4 x = v[i];
        if (scl) { const float s0 = scl[k0 + kk]; const float f = flip ? (1.0f - s0) : s0; x = x * f; }
        LAS float* d = scr + kk * 65 + cc; d[0] = x.x; d[1] = x.y; d[2] = x.z; d[3] = x.w; }
    LDS_WAIT(); asm volatile("" ::: "memory");
    const int c = lane & 7;
#pragma unroll
    for (int j = 0; j < NBW / 8; ++j) { const int n = (lane >> 3) + 8 * j; const LAS float* s = scr + (8 * c) * 65 + n;
        u32x4 o; o.x = pk2(s[0 * 65], s[1 * 65]); o.y = pk2(s[2 * 65], s[3 * 65]); o.z = pk2(s[4 * 65], s[5 * 65]); o.w = pk2(s[6 * 65], s[7 * 65]);
        *(u32x4*)(dst + (size_t)n * ldk + 8 * c) = o; }
    LDS_WAIT(); asm volatile("" ::: "memory");
}
__device__ __forceinline__ void transpose_item_fp8(const float* W, int N, int k0, int n0, unsigned char* dst, int ldk, float scale, LAS float* scr, int lane) {
    const int rr = lane >> 4, cc = (lane & 15) * 4;
    f32x4 v[16];
#pragma unroll
    for (int i = 0; i < 16; ++i) v[i] = *(const f32x4*)(W + (size_t)(k0 + i * 4 + rr) * N + n0 + cc);
#pragma unroll
    for (int i = 0; i < 16; ++i) { const int kk = i * 4 + rr; LAS float* d = scr + kk * 65 + cc; d[0] = v[i].x * scale; d[1] = v[i].y * scale; d[2] = v[i].z * scale; d[3] = v[i].w * scale; }
    LDS_WAIT(); asm volatile("" ::: "memory");
    const int c = lane & 3;
#pragma unroll
    for (int j = 0; j < 4; ++j) { const int n = (lane >> 2) + 16 * j; const LAS float* s = scr + (16 * c) * 65 + n;
        u32x4 o; o.x = pk4_fp8(s[0 * 65], s[1 * 65], s[2 * 65], s[3 * 65]); o.y = pk4_fp8(s[4 * 65], s[5 * 65], s[6 * 65], s[7 * 65]); o.z = pk4_fp8(s[8 * 65], s[9 * 65], s[10 * 65], s[11 * 65]); o.w = pk4_fp8(s[12 * 65], s[13 * 65], s[14 * 65], s[15 * 65]);
        *(u32x4*)(dst + (size_t)n * ldk + 16 * c) = o; }
    LDS_WAIT(); asm volatile("" ::: "memory");
}
__device__ __forceinline__ void transpose_matrix(const Ctx& cx, const float* W, int K, int N, bf16* WT, int row_off, int ldk, int koff, const float* scl, int flip) {
    LAS float* scr = (LAS float*)(cx.lds + cx.wave * 16640);
    const int nblk = N / 64, nitems = (K / 64) * nblk;
    for (int it = cx.gw; it < nitems; it += cx.NGW) { const int kb = it / nblk, nb = it % nblk;
        transpose_item<64>(W, N, 64 * kb, 64 * nb, WT + (size_t)(row_off + 64 * nb) * ldk + koff + 64 * kb, ldk, scl, flip, scr, cx.lane); }
}
__device__ __forceinline__ void rms_row_to_bf16(const float* xrow, const float* g, bf16* orow, int lane) {
    const f32x4* xr = (const f32x4*)xrow + lane; const f32x4* gr = (const f32x4*)g + lane;
    f32x4 v[4]; float s = 0.f;
#pragma unroll
    for (int j = 0; j < 4; ++j) { v[j] = xr[64 * j]; s += (v[j].x * v[j].x + v[j].y * v[j].y) + (v[j].z * v[j].z + v[j].w * v[j].w); }
    const float rinv = rsqrtf(wave_sum(s) * (1.f / 1024.f) + 1e-6f);
    u32x2* o8 = (u32x2*)orow + lane;
#pragma unroll
    for (int j = 0; j < 4; ++j) { const f32x4 gg = gr[64 * j]; u32x2 w; w.x = pk2(v[j].x * rinv * gg.x, v[j].y * rinv * gg.y); w.y = pk2(v[j].z * rinv * gg.z, v[j].w * rinv * gg.w); o8[64 * j] = w; }
}

__device__ __forceinline__ void rms_rows2_to_bf16(const float* xa, const float* xb, const float* g, bf16* oa, bf16* ob, int lane) {
    const f32x4* ra = (const f32x4*)xa + lane; const f32x4* rb = (const f32x4*)xb + lane; const f32x4* gr = (const f32x4*)g + lane;
    f32x4 va[4], vb[4]; float sa = 0.f, sb = 0.f;
#pragma unroll
    for (int j = 0; j < 4; ++j) { va[j] = ra[64 * j]; vb[j] = rb[64 * j]; }
#pragma unroll
    for (int j = 0; j < 4; ++j) { sa += (va[j].x * va[j].x + va[j].y * va[j].y) + (va[j].z * va[j].z + va[j].w * va[j].w); sb += (vb[j].x * vb[j].x + vb[j].y * vb[j].y) + (vb[j].z * vb[j].z + vb[j].w * vb[j].w); }
#pragma unroll
    for (int o = 1; o < 64; o <<= 1) { sa += __shfl_xor(sa, o); sb += __shfl_xor(sb, o); }
    const float ia = rsqrtf(sa * (1.f / 1024.f) + 1e-6f), ib = rsqrtf(sb * (1.f / 1024.f) + 1e-6f);
    u32x2* pa = (u32x2*)oa + lane; u32x2* pb = (u32x2*)ob + lane;
#pragma unroll
    for (int j = 0; j < 4; ++j) { const f32x4 gg = gr[64 * j]; u32x2 w; w.x = pk2(va[j].x * ia * gg.x, va[j].y * ia * gg.y); w.y = pk2(va[j].z * ia * gg.z, va[j].w * ia * gg.w); pa[64 * j] = w;
        w.x = pk2(vb[j].x * ib * gg.x, vb[j].y * ib * gg.y); w.y = pk2(vb[j].z * ib * gg.z, vb[j].w * ib * gg.w); pb[64 * j] = w; }
}

__device__ __forceinline__ void s5_tables_item(const Ctx& cx, int g, int part, const float* lam_re, const float* lam_im, const float* log_dt, const float* b_re, const float* b_im, const float* c_re, const float* c_im,
                                               bf16* BT, bf16* ET, float* AT) {
    LAS float* apr = (LAS float*)cx.lds; LAS float* api = apr + 33 * 64; LAS float* bbr = api + 33 * 64; LAS float* bbi = bbr + 1024; LAS float* cr = bbi + 1024; LAS float* ci = cr + 1024; LAS float* kt = ci + 1024;
    const int tid = cx.tid;
    const float dt = __expf(log_dt[g]);
    for (int idx = tid; idx < 33 * 64; idx += NTHR) { const int j = idx >> 6, p = idx & 63;
        const float lre = fminf(lam_re[g * 64 + p], -1e-4f), lim = lam_im[g * 64 + p];
        const float mag = expf(lre * dt * (float)j), ang = lim * dt * (float)j; float sn, cs; sincosf(ang, &sn, &cs);
        apr[idx] = mag * cs; api[idx] = mag * sn; }
    for (int idx = tid; idx < 1024; idx += NTHR) { const int p = idx >> 4;
        const float lre = fminf(lam_re[g * 64 + p], -1e-4f), lim = lam_im[g * 64 + p];
        const float mag = expf(lre * dt); float sn, cs; sincosf(lim * dt, &sn, &cs); const float lbr = mag * cs, lbi = mag * sn;
        const float den = lre * lre + lim * lim, zr = lbr - 1.0f; const float cor = (zr * lre + lbi * lim) / den, coi = (lbi * lre - zr * lim) / den;
        const float br = b_re[g * 1024 + idx], bi = b_im[g * 1024 + idx];
        bbr[idx] = cor * br - coi * bi; bbi[idx] = cor * bi + coi * br;
        cr[idx] = c_re[g * 1024 + idx]; ci[idx] = c_im[g * 1024 + idx]; }
    __syncthreads();
    if (tid < 64) { const int jl = tid >> 4, c = tid & 15, j = 4 * part + jl; float acc[16];
#pragma unroll
        for (int i = 0; i < 16; ++i) acc[i] = 0.f;
        for (int p = 0; p < 64; ++p) { const float ar = apr[j * 64 + p], ai = api[j * 64 + p], xr = cr[c * 64 + p], xi = ci[c * 64 + p];
            const float car = xr * ar - xi * ai, cai = xr * ai + xi * ar;
#pragma unroll
            for (int v4 = 0; v4 < 4; ++v4) { const f32x4 br = *(const LAS f32x4*)(bbr + p * 16 + 4 * v4), bi = *(const LAS f32x4*)(bbi + p * 16 + 4 * v4);
                acc[4 * v4 + 0] += car * br.x - cai * bi.x; acc[4 * v4 + 1] += car * br.y - cai * bi.y; acc[4 * v4 + 2] += car * br.z - cai * bi.z; acc[4 * v4 + 3] += car * br.w - cai * bi.w; } }
#pragma unroll
        for (int i = 0; i < 16; ++i) kt[jl * 256 + c * 16 + i] = acc[i]; }
    __syncthreads();
    bf16* BTg = BT + (size_t)g * 512 * 640; bf16* ETg = ET + (size_t)g * 256 * 512;
    for (int idx = tid; idx < 4096; idx += NTHR) { const int hf = idx & 1, c = (idx >> 1) & 15, t = (idx >> 5) & 31, jl = idx >> 10, j = 4 * part + jl;
        if (t >= j) { const LAS float* s = kt + jl * 256 + c * 16 + hf * 8; u32x4 o; o.x = pk2(s[0], s[1]); o.y = pk2(s[2], s[3]); o.z = pk2(s[4], s[5]); o.w = pk2(s[6], s[7]);
            *(u32x4*)(BTg + (size_t)(t * 16 + c) * 640 + (t - j) * 16 + hf * 8) = o; } }
    for (int idx = tid; idx < 4096; idx += NTHR) { const int hf = idx & 1, c = (idx >> 1) & 15, s = (idx >> 5) & 31, t = 4 * part + (idx >> 10);
        if (s > t) *(u32x4*)(BTg + (size_t)(t * 16 + c) * 640 + s * 16 + hf * 8) = (u32x4){0u, 0u, 0u, 0u}; }
    for (int idx = tid; idx < 1024; idx += NTHR) { const int ch = idx & 15, c = (idx >> 4) & 15, t = 4 * part + (idx >> 8); const int im = ch >> 3, p0 = (ch & 7) * 8; float v[8];
#pragma unroll
        for (int q = 0; q < 8; ++q) { const int p = p0 + q; const float ar = apr[(t + 1) * 64 + p], ai = api[(t + 1) * 64 + p], xr = cr[c * 64 + p], xi = ci[c * 64 + p];
            v[q] = im ? -(xr * ai + xi * ar) : (xr * ar - xi * ai); }
        u32x4 o; o.x = pk2(v[0], v[1]); o.y = pk2(v[2], v[3]); o.z = pk2(v[4], v[5]); o.w = pk2(v[6], v[7]);
        *(u32x4*)(BTg + (size_t)(t * 16 + c) * 640 + 512 + im * 64 + p0) = o; }
    for (int idx = tid; idx < 1024; idx += NTHR) { const int hf = idx & 1, sl = (idx >> 1) & 3, n = idx >> 3, s = 4 * part + sl, p = n & 63, im = n >> 6; float v[8];
        const float ar = apr[(31 - s) * 64 + p], ai = api[(31 - s) * 64 + p];
#pragma unroll
        for (int q = 0; q < 8; ++q) { const float br = bbr[p * 16 + hf * 8 + q], bi = bbi[p * 16 + hf * 8 + q]; v[q] = im ? (ar * bi + ai * br) : (ar * br - ai * bi); }
        u32x4 o; o.x = pk2(v[0], v[1]); o.y = pk2(v[2], v[3]); o.z = pk2(v[4], v[5]); o.w = pk2(v[6], v[7]);
        *(u32x4*)(ETg + (size_t)n * 512 + s * 16 + hf * 8) = o; }
    for (int idx = tid; idx < 1024; idx += NTHR) { const int ch = idx & 63, r = 128 + 16 * part + (idx >> 6); *(u32x4*)(ETg + (size_t)r * 512 + ch * 8) = (u32x4){0u, 0u, 0u, 0u}; }
    if (part == 0 && tid < 64) { AT[(g * 64 + tid) * 2] = apr[32 * 64 + tid]; AT[(g * 64 + tid) * 2 + 1] = api[32 * 64 + tid]; }
    __syncthreads();
}

constexpr int IMG_LD = 80, IMG_B = 64 * IMG_LD * 2;
#define IMG(k) ((LAS bf16*)(lds + (k) * IMG_B))
#define LDS_BARRIER() do { asm volatile("s_waitcnt lgkmcnt(0)" ::: "memory"); __builtin_amdgcn_s_barrier(); asm volatile("" ::: "memory"); } while (0)
struct MmCtx { int tr, tc0, l15, q; };
__device__ __forceinline__ void mm64(const LAS bf16* A, const LAS bf16* Bt, f32x4 (&acc)[2], const MmCtx& w) {
#pragma unroll
    for (int s = 0; s < 2; ++s) {
        const bf16x8 a = *(const LAS bf16x8*)(A + (16 * w.tr + w.l15) * IMG_LD + 32 * s + 8 * w.q);
#pragma unroll
        for (int c = 0; c < 2; ++c) { const bf16x8 b = *(const LAS bf16x8*)(Bt + (16 * (w.tc0 + c) + w.l15) * IMG_LD + 32 * s + 8 * w.q);
            acc[c] = __builtin_amdgcn_mfma_f32_16x16x32_bf16(a, b, acc[c], 0, 0, 0); }
    }
}
__device__ __forceinline__ void st_rm(LAS bf16* img, const f32x4 v, int tr, int tc, const MmCtx& w) {
#pragma unroll
    for (int r = 0; r < 4; ++r) img[(16 * tr + 4 * w.q + r) * IMG_LD + 16 * tc + w.l15] = (bf16)(cvt_pk_bf16(v[r], 0.f) & 0xffffu);
}
__device__ __forceinline__ void st_tr(LAS bf16* img, const f32x4 v, int tr, int tc, const MmCtx& w) {
    u32x2 o; o.x = pk2(v[0], v[1]); o.y = pk2(v[2], v[3]); *(LAS u32x2*)(img + (16 * tc + w.l15) * IMG_LD + 16 * tr + 4 * w.q) = o;
}
__device__ __forceinline__ void img_to_global(const LAS bf16* img, bf16* g, int tid) { const int row = tid >> 3, ch = tid & 7; *(u32x4*)(g + row * 64 + ch * 8) = *(const LAS u32x4*)(img + row * IMG_LD + ch * 8); }
__device__ __forceinline__ void st_tm8(LAS bf16* img, int t, int cg, const float (&v)[8]) {
    u32x4 o; o.x = pk2(v[0], v[1]); o.y = pk2(v[2], v[3]); o.z = pk2(v[4], v[5]); o.w = pk2(v[6], v[7]); *(LAS u32x4*)(img + t * IMG_LD + 8 * cg) = o;
}
__device__ __forceinline__ void st_cm8(LAS bf16* img, int t, int cg, const float (&v)[8]) {
#pragma unroll
    for (int i = 0; i < 8; ++i) img[(8 * cg + i) * IMG_LD + t] = (bf16)(cvt_pk_bf16(v[i], 0.f) & 0xffffu);
}
__device__ __forceinline__ float red8(float v) { v += __shfl_xor(v, 1); v += __shfl_xor(v, 2); v += __shfl_xor(v, 4); return v; }
__device__ __forceinline__ void unpack8(const u32x4 w, float (&o)[8]) { o[0] = lo16(w.x); o[1] = hi16(w.x); o[2] = lo16(w.y); o[3] = hi16(w.y); o[4] = lo16(w.z); o[5] = hi16(w.z); o[6] = lo16(w.w); o[7] = hi16(w.w); }
__device__ __forceinline__ void ldp8(const float* p, float (&o)[8]) { const f32x4 a = *(const f32x4*)p, b = *(const f32x4*)(p + 4); o[0] = a.x; o[1] = a.y; o[2] = a.z; o[3] = a.w; o[4] = b.x; o[5] = b.y; o[6] = b.z; o[7] = b.w; }

struct RwkvP { const bf16* rkv; const bf16* wag; const float *mu_rkv, *w0, *a0, *k_k, *k_a, *r_k, *ln_w, *ln_b; };
struct RwkvRaw { u32x4 kc, kp, vc, vp, wl, al, rc, rp, gg; };
template <bool PASS3>
__device__ __forceinline__ void rwkv_load(const RwkvP& P, int cidx, int tid, RwkvRaw& R) {
    const int t = tid >> 3, cg = tid & 7, bh = cidx >> 7, c = cidx & 127, b = bh >> 3, h = bh & 7, ch = h * 64 + 8 * cg;
    const size_t tok = (size_t)b * SEQ + c * 64 + t; const bool first = (c == 0 && t == 0);
    const bf16* row = P.rkv + tok * 1536 + ch; const bf16* prow = first ? row : row - 1536;
    R.kc = *(const u32x4*)(row + 512); R.vc = *(const u32x4*)(row + 1024); R.kp = *(const u32x4*)(prow + 512); R.vp = *(const u32x4*)(prow + 1024);
    R.wl = *(const u32x4*)(P.wag + tok * 1536 + ch); R.al = *(const u32x4*)(P.wag + tok * 1536 + 512 + ch);
    if (PASS3) { R.rc = *(const u32x4*)row; R.rp = *(const u32x4*)prow; R.gg = *(const u32x4*)(P.wag + tok * 1536 + 1024 + ch); }
}
struct RwkvC { float mu_r[8], mu_k[8], mu_v[8], w0[8], a0[8], kk[8], ka[8]; };
__device__ __forceinline__ void rwkv_consts(const RwkvP& P, int h, int cg, RwkvC& C) { const int ch = h * 64 + 8 * cg;
    ldp8(P.mu_rkv + ch, C.mu_r); ldp8(P.mu_rkv + 512 + ch, C.mu_k); ldp8(P.mu_rkv + 1024 + ch, C.mu_v); ldp8(P.w0 + ch, C.w0); ldp8(P.a0 + ch, C.a0); ldp8(P.k_k + ch, C.kk); ldp8(P.k_a + ch, C.ka); }
template <bool PASS3>
__device__ __forceinline__ void rwkv_prep(const RwkvRaw& R, const RwkvC& C, bool first, float (&kq)[8], float (&vv)[8], float (&rr)[8], float (&kap)[8], float (&bet)[8], float (&lw)[8]) {
    float kc[8], kp[8], vc[8], vp[8], k[8], wl[8], al[8], a[8];
    unpack8(R.kc, kc); unpack8(R.vc, vc); unpack8(R.kp, kp); unpack8(R.vp, vp); unpack8(R.wl, wl); unpack8(R.al, al);
    const float pm = first ? 0.f : 1.f;
#pragma unroll
    for (int i = 0; i < 8; ++i) { k[i] = kc[i] + (pm * kp[i] - kc[i]) * C.mu_k[i]; vv[i] = vc[i] + (pm * vp[i] - vc[i]) * C.mu_v[i]; }
    if (PASS3) { float rc[8], rp[8]; unpack8(R.rc, rc); unpack8(R.rp, rp);
#pragma unroll
        for (int i = 0; i < 8; ++i) rr[i] = rc[i] + (pm * rp[i] - rc[i]) * C.mu_r[i];
    } else {
#pragma unroll
        for (int i = 0; i < 8; ++i) rr[i] = 0.f;
    }
    float ss = 0.f;
#pragma unroll
    for (int i = 0; i < 8; ++i) { lw[i] = -0.6065306597126334f * fsigmoid(C.w0[i] + wl[i]); a[i] = fsigmoid(C.a0[i] + al[i]); kap[i] = k[i] * C.kk[i]; ss += kap[i] * kap[i]; }
    ss = red8(ss);
    const float inv = 1.0f / fmaxf(sqrtf(ss), 1e-12f);
#pragma unroll
    for (int i = 0; i < 8; ++i) { kap[i] *= inv; bet[i] = kap[i] * a[i]; kq[i] = k[i] * (1.0f + (a[i] - 1.0f) * C.ka[i]); }
}
template <int SEGSLOT>
__device__ __forceinline__ void rwkv_cumsum(LAS unsigned char* lds, int tid, const float (&lw)[8], float (&cum)[8], float (&cumL)[8]) {
    LAS float* LW = (LAS float*)(lds + 12 * IMG_B); LAS float* SEG = (LAS float*)(lds + SEGSLOT * IMG_B);
    const int t = tid >> 3, cg = tid & 7, j = tid & 63, seg = tid >> 6;
#pragma unroll
    for (int i = 0; i < 8; ++i) LW[t * 65 + 8 * cg + i] = lw[i];
    LDS_BARRIER();
    { float run = 0.f;
#pragma unroll
      for (int tt = 0; tt < 8; ++tt) { const int idx = (8 * seg + tt) * 65 + j; run += LW[idx]; LW[idx] = run; }
      SEG[seg * 64 + j] = run; }
    LDS_BARRIER();
    { float pre = 0.f;
#pragma unroll
      for (int s2 = 0; s2 < 8; ++s2) { const float x = SEG[s2 * 64 + j]; pre += (s2 < seg) ? x : 0.f; }
#pragma unroll
      for (int tt = 0; tt < 8; ++tt) LW[(8 * seg + tt) * 65 + j] += pre; }
    LDS_BARRIER();
#pragma unroll
    for (int i = 0; i < 8; ++i) { cum[i] = LW[t * 65 + 8 * cg + i]; cumL[i] = LW[63 * 65 + 8 * cg + i]; }
}
#define Z4 (f32x4){0.f, 0.f, 0.f, 0.f}

__device__ __forceinline__ void rwkv_pass1(LAS unsigned char* lds, const RwkvP& P, int c0, int n, int tid, bf16* QCT, float* HCT, bf16* W1G, bf16* ULG, float* DLG) {
    const int lane = tid & 63, wv = __builtin_amdgcn_readfirstlane(tid >> 6); MmCtx w; w.tr = wv >> 1; w.tc0 = (wv & 1) * 2; w.l15 = lane & 15; w.q = lane >> 4;
    const int t = tid >> 3, cg = tid & 7;
    RwkvC C; rwkv_consts(P, (c0 >> 7) & 7, cg, C);
    RwkvRaw R; rwkv_load<false>(P, c0, tid, R);
    for (int ci = 0; ci < n; ++ci) {
        const int cidx = c0 + ci;
        {
            float kq[8], vv[8], rr[8], kap[8], bet[8], lw[8], cum[8], cumL[8];
            rwkv_prep<false>(R, C, (cidx & 127) == 0 && t == 0, kq, vv, rr, kap, bet, lw);
            if (ci + 1 < n) rwkv_load<false>(P, cidx + 1, tid, R);
            rwkv_cumsum<11>(lds, tid, lw, cum, cumL);
            float x[8], y[8];
#pragma unroll
            for (int i = 0; i < 8; ++i) { const float en = __expf(-cum[i]); x[i] = kq[i] * en; y[i] = bet[i] * en; }
            st_tm8(IMG(0), t, cg, x);
            st_tm8(IMG(1), t, cg, y);
#pragma unroll
            for (int i = 0; i < 8; ++i) x[i] = kap[i] * __expf(cum[i] - lw[i]);
            st_tm8(IMG(2), t, cg, x);
            st_cm8(IMG(3), t, cg, x);
#pragma unroll
            for (int i = 0; i < 8; ++i) { const float eh = __expf(cumL[i] - cum[i]); x[i] = kq[i] * eh; y[i] = bet[i] * eh; }
            st_cm8(IMG(4), t, cg, x);
            st_cm8(IMG(5), t, cg, y);
            st_cm8(IMG(6), t, cg, vv);
            if (t == 0) {
#pragma unroll
                for (int i = 0; i < 8; ++i) DLG[(size_t)cidx * 64 + 8 * cg + i] = __expf(cumL[i]);
            }
        }
        LDS_BARRIER();
        f32x4 accX[2];
        {
            f32x4 a[2] = {Z4, Z4}, kk[2] = {Z4, Z4};
            mm64(IMG(1), IMG(2), a, w); mm64(IMG(0), IMG(2), kk, w);
#pragma unroll
            for (int c = 0; c < 2; ++c) { const int nn = 16 * (w.tc0 + c) + w.l15;
#pragma unroll
                for (int r = 0; r < 4; ++r) { const int m = 16 * w.tr + 4 * w.q + r; a[c][r] = (m < nn) ? a[c][r] : 0.f; kk[c][r] = (m < nn) ? kk[c][r] : 0.f; accX[c][r] = ((m == nn) ? 1.0f : 0.f) - a[c][r]; }
                st_rm(IMG(7), a[c], w.tr, w.tc0 + c, w); st_tr(IMG(8), a[c], w.tr, w.tc0 + c, w); st_rm(IMG(10), accX[c], w.tr, w.tc0 + c, w); st_rm(IMG(9), kk[c], w.tr, w.tc0 + c, w); }
        }
        LDS_BARRIER();
        {
            f32x4 p[2] = {Z4, Z4};
            mm64(IMG(7), IMG(8), p, w);
#pragma unroll
            for (int c = 0; c < 2; ++c) { st_rm(IMG(12), p[c], w.tr, w.tc0 + c, w); st_tr(IMG(13), p[c], w.tr, w.tc0 + c, w); }
        }
        LDS_BARRIER();
#define NEUMANN(XC, XN, PC, PTC, PN, PTN, LASTR) do { mm64(IMG(XC), IMG(PTC), accX, w); \
            if (!(LASTR)) { f32x4 p[2] = {Z4, Z4}; mm64(IMG(PC), IMG(PTC), p, w); \
                _Pragma("unroll") for (int c = 0; c < 2; ++c) { st_rm(IMG(PN), p[c], w.tr, w.tc0 + c, w); st_tr(IMG(PTN), p[c], w.tr, w.tc0 + c, w); st_rm(IMG(XN), accX[c], w.tr, w.tc0 + c, w); } } \
            LDS_BARRIER(); } while (0)
        NEUMANN(10, 11, 12, 13, 0, 1, false);
        NEUMANN(11, 10, 0, 1, 12, 13, false);
        NEUMANN(10, 11, 12, 13, 0, 1, false);
        NEUMANN(11, 10, 0, 1, 12, 13, false);
        NEUMANN(10, 11, 12, 13, 0, 1, true);
#undef NEUMANN
#pragma unroll
        for (int c = 0; c < 2; ++c) st_tr(IMG(7), accX[c], w.tr, w.tc0 + c, w);
        LDS_BARRIER();
        {
            f32x4 a[2] = {Z4, Z4}, g[2] = {Z4, Z4};
            mm64(IMG(3), IMG(7), a, w); mm64(IMG(9), IMG(7), g, w);
#pragma unroll
            for (int c = 0; c < 2; ++c) { st_rm(IMG(12), a[c], w.tr, w.tc0 + c, w); st_tr(IMG(2), a[c], w.tr, w.tc0 + c, w); st_tr(IMG(8), g[c], w.tr, w.tc0 + c, w); }
        }
        LDS_BARRIER();
        {
            f32x4 u[2] = {Z4, Z4}, qc[2] = {Z4, Z4};
            mm64(IMG(6), IMG(8), u, w); mm64(IMG(5), IMG(12), qc, w);
#pragma unroll
            for (int c = 0; c < 2; ++c) { st_rm(IMG(13), u[c], w.tr, w.tc0 + c, w);
                const int tc = w.tc0 + c, cp = 32 * (tc >> 1) + 8 * (w.l15 >> 2) + 4 * (tc & 1) + (w.l15 & 3);
#pragma unroll
                for (int r = 0; r < 4; ++r) IMG(0)[(16 * w.tr + 4 * w.q + r) * IMG_LD + cp] = (bf16)(cvt_pk_bf16(qc[c][r], 0.f) & 0xffffu); }
            img_to_global(IMG(2), W1G + (size_t)cidx * 4096, tid);
        }
        LDS_BARRIER();
        {
            f32x4 hp[2] = {Z4, Z4}, hn[2] = {Z4, Z4};
            mm64(IMG(4), IMG(6), hp, w); mm64(IMG(5), IMG(13), hn, w);
#pragma unroll
            for (int c = 0; c < 2; ++c) *(f32x4*)(HCT + (((size_t)cidx * 16 + w.tr * 4 + w.tc0 + c) * 64 + lane) * 4) = hp[c] - hn[c];
            img_to_global(IMG(13), ULG + (size_t)cidx * 4096, tid);
            img_to_global(IMG(0), QCT + (size_t)cidx * 4096, tid);
        }
        LDS_BARRIER();
    }
}

constexpr int P2_SLOT = 12544, P2_DEPTH = 5;
__device__ __forceinline__ void rwkv_pass2(LAS unsigned char* lds, int bh, int ti, int lane, const bf16* QCT, const float* HCT, const float* DLG, bf16* S0G) {
    const int l15 = lane & 15, q = lane >> 4;
    f32x4 X[4];
#pragma unroll
    for (int tj = 0; tj < 4; ++tj) X[tj] = Z4;
#define P2_DMA(cc) do { const size_t ci_ = (size_t)bh * 128 + (cc); LAS unsigned char* sl_ = lds + ((cc) % P2_DEPTH) * P2_SLOT; \
        _Pragma("unroll") for (int i = 0; i < 8; ++i) { const int row_ = i * 8 + (lane >> 3), pc_ = (lane & 7) ^ (row_ & 7); \
            __builtin_amdgcn_global_load_lds((const unsigned*)((const char*)QCT + (ci_ * 64 + row_) * 128 + pc_ * 16), (LAS unsigned*)(sl_ + i * 1024), 16, 0, 0); } \
        _Pragma("unroll") for (int tj = 0; tj < 4; ++tj) __builtin_amdgcn_global_load_lds((const unsigned*)((const char*)HCT + ((ci_ * 16 + tj * 4 + ti) * 64 + lane) * 16), (LAS unsigned*)(sl_ + 8192 + tj * 1024), 16, 0, 0); \
        __builtin_amdgcn_global_load_lds((const unsigned*)((const char*)DLG + (ci_ * 64 + lane) * 4), (LAS unsigned*)(sl_ + 12288), 4, 0, 0); } while (0)
    P2_DMA(0); P2_DMA(1); P2_DMA(2); P2_DMA(3);
    for (int c = 0; c < 128; ++c) {
        if (c < 124) asm volatile("s_waitcnt vmcnt(39)" ::: "memory"); else asm volatile("s_waitcnt vmcnt(0)" ::: "memory");
        const LAS unsigned char* sl = lds + (c % P2_DEPTH) * P2_SLOT;
        bf16x8 a[4][2]; f32x4 h[4], d[4];
#pragma unroll
        for (int tj = 0; tj < 4; ++tj) { const int row = 16 * tj + l15;
#pragma unroll
            for (int s = 0; s < 2; ++s) a[tj][s] = *(const LAS bf16x8*)(sl + row * 128 + (((4 * s + q) ^ (row & 7)) * 16));
            h[tj] = *(const LAS f32x4*)(sl + 8192 + tj * 1024 + lane * 16); d[tj] = *(const LAS f32x4*)(sl + 12288 + (16 * tj + 4 * q) * 4); }
        asm volatile("s_waitcnt lgkmcnt(0)" ::: "memory");
        if (c + 4 < 128) P2_DMA(c + 4);
        const size_t cidx = (size_t)bh * 128 + c;
#pragma unroll
        for (int tj = 0; tj < 4; ++tj) { u32x2 o; o.x = pk2(X[tj][0], X[tj][1]); o.y = pk2(X[tj][2], X[tj][3]); *(u32x2*)(S0G + (cidx * 64 + 16 * ti + l15) * 64 + 16 * tj + 4 * q) = o; }
        bf16x8 b[2];
#pragma unroll
        for (int s = 0; s < 2; ++s) { u32x4 o; o.x = pk2(X[2 * s][0], X[2 * s][1]); o.y = pk2(X[2 * s][2], X[2 * s][3]); o.z = pk2(X[2 * s + 1][0], X[2 * s + 1][1]); o.w = pk2(X[2 * s + 1][2], X[2 * s + 1][3]); b[s] = __builtin_bit_cast(bf16x8, o); }
#pragma unroll
        for (int tj = 0; tj < 4; ++tj) { f32x4 acc = Z4;
            acc = __builtin_amdgcn_mfma_f32_16x16x32_bf16(a[tj][0], b[0], acc, 0, 0, 0); acc = __builtin_amdgcn_mfma_f32_16x16x32_bf16(a[tj][1], b[1], acc, 0, 0, 0);
            X[tj] = d[tj] * X[tj] + h[tj] - acc; }
    }
    asm volatile("s_waitcnt vmcnt(0)" ::: "memory");
#undef P2_DMA
}

__device__ __forceinline__ void rwkv_pass3(LAS unsigned char* lds, const RwkvP& P, int c0, int n, int tid, const bf16* S0G, const bf16* W1G, const bf16* ULG, bf16* MIX) {
    const int lane = tid & 63, wv = __builtin_amdgcn_readfirstlane(tid >> 6); MmCtx w; w.tr = wv >> 1; w.tc0 = (wv & 1) * 2; w.l15 = lane & 15; w.q = lane >> 4;
    const int t = tid >> 3, cg = tid & 7, bh = c0 >> 7, b = bh >> 3, h = bh & 7, ch = h * 64 + 8 * cg;
    RwkvC C; rwkv_consts(P, h, cg, C);
    RwkvRaw R; rwkv_load<true>(P, c0, tid, R);
    u32x4 gS0, gW1, gUL;
    { const int row = tid >> 3, chk = tid & 7; const size_t o = (size_t)c0 * 4096 + row * 64 + chk * 8; gS0 = *(const u32x4*)(S0G + o); gW1 = *(const u32x4*)(W1G + o); gUL = *(const u32x4*)(ULG + o); }
    for (int ci = 0; ci < n; ++ci) {
        const int cidx = c0 + ci, c = cidx & 127;
        float vv[8], gg[8], bonus;
        {
            float kq[8], rr[8], kap[8], bet[8], lw[8], cum[8], cumL[8];
            rwkv_prep<true>(R, C, c == 0 && t == 0, kq, vv, rr, kap, bet, lw);
            unpack8(R.gg, gg);
            const u32x4 s0v = gS0, w1v = gW1, ulv = gUL;
            if (ci + 1 < n) { rwkv_load<true>(P, cidx + 1, tid, R);
                const int row = tid >> 3, chk = tid & 7; const size_t o = (size_t)(cidx + 1) * 4096 + row * 64 + chk * 8; gS0 = *(const u32x4*)(S0G + o); gW1 = *(const u32x4*)(W1G + o); gUL = *(const u32x4*)(ULG + o); }
            rwkv_cumsum<9>(lds, tid, lw, cum, cumL);
            float bs = 0.f, rk[8]; ldp8(P.r_k + ch, rk);
#pragma unroll
            for (int i = 0; i < 8; ++i) bs += rr[i] * kq[i] * rk[i];
            bonus = red8(bs);
            float x[8], y[8];
#pragma unroll
            for (int i = 0; i < 8; ++i) { const float en = __expf(-cum[i]); x[i] = kq[i] * en; y[i] = bet[i] * en; }
            st_tm8(IMG(1), t, cg, x);
            st_tm8(IMG(2), t, cg, y);
#pragma unroll
            for (int i = 0; i < 8; ++i) x[i] = rr[i] * __expf(cum[i]);
            st_tm8(IMG(0), t, cg, x);
            st_cm8(IMG(3), t, cg, vv);
            { const int row = tid >> 3, chk = tid & 7; *(LAS u32x4*)(IMG(4) + row * IMG_LD + chk * 8) = s0v; *(LAS u32x4*)(IMG(5) + row * IMG_LD + chk * 8) = w1v; *(LAS u32x4*)(IMG(6) + row * IMG_LD + chk * 8) = ulv; }
        }
        LDS_BARRIER();
        {
            f32x4 kr[2] = {Z4, Z4}, br[2] = {Z4, Z4}, u[2] = {Z4, Z4};
            mm64(IMG(0), IMG(1), kr, w); mm64(IMG(0), IMG(2), br, w); mm64(IMG(4), IMG(5), u, w);
#pragma unroll
            for (int cc = 0; cc < 2; ++cc) { const int nn = 16 * (w.tc0 + cc) + w.l15;
#pragma unroll
                for (int r = 0; r < 4; ++r) { const int m = 16 * w.tr + 4 * w.q + r; kr[cc][r] = (nn <= m) ? kr[cc][r] : 0.f; br[cc][r] = (nn <= m) ? br[cc][r] : 0.f; u[cc][r] += bf2f(IMG(6)[m * IMG_LD + nn]); }
                st_rm(IMG(7), kr[cc], w.tr, w.tc0 + cc, w); st_rm(IMG(8), br[cc], w.tr, w.tc0 + cc, w); st_rm(IMG(9), u[cc], w.tr, w.tc0 + cc, w); }
        }
        LDS_BARRIER();
        {
            f32x4 yp[2] = {Z4, Z4}, yn[2] = {Z4, Z4};
            mm64(IMG(0), IMG(4), yp, w); mm64(IMG(7), IMG(3), yp, w); mm64(IMG(8), IMG(9), yn, w);
            LAS float* YF = (LAS float*)(lds + 10 * IMG_B);
#pragma unroll
            for (int cc = 0; cc < 2; ++cc)
#pragma unroll
                for (int r = 0; r < 4; ++r) YF[(16 * w.tr + 4 * w.q + r) * 65 + 16 * (w.tc0 + cc) + w.l15] = yp[cc][r] - yn[cc][r];
        }
        LDS_BARRIER();
        {
            const LAS float* YF = (const LAS float*)(lds + 10 * IMG_B);
            float y[8], s = 0.f;
#pragma unroll
            for (int i = 0; i < 8; ++i) { y[i] = YF[t * 65 + 8 * cg + i]; s += y[i]; }
            const float mean = red8(s) * (1.0f / 64.0f); float qv = 0.f;
#pragma unroll
            for (int i = 0; i < 8; ++i) { y[i] -= mean; qv += y[i] * y[i]; }
            const float rstd = rsqrtf(red8(qv) * (1.0f / 64.0f) + 64e-5f);
            float o[8], lnw[8], lnb[8]; ldp8(P.ln_w + ch, lnw); ldp8(P.ln_b + ch, lnb);
#pragma unroll
            for (int i = 0; i < 8; ++i) o[i] = (y[i] * rstd * lnw[i] + lnb[i] + bonus * vv[i]) * gg[i];
            const size_t tok = (size_t)b * SEQ + c * 64 + t;
            u32x4 ov; ov.x = pk2(o[0], o[1]); ov.y = pk2(o[2], o[3]); ov.z = pk2(o[4], o[5]); ov.w = pk2(o[6], o[7]);
            *(u32x4*)(MIX + tok * 1024 + 512 + ch) = ov;
        }
    }
}

constexpr int RW_LD = 1032;
__device__ __forceinline__ void router_phase(const Ctx& cx, const float* X1, const float* gnorm, const float* rw, const float* rb, unsigned char* H2, int* TOPE, float* TOPG, unsigned* HIST) {
    LAS bf16* WH = (LAS bf16*)cx.lds; LAS bf16* WL = WH + 32 * RW_LD;
    LAS unsigned* hcnt = (LAS unsigned*)(cx.lds + 135168);
    const int lane = cx.lane, l15 = lane & 15, q = lane >> 4;
    for (int idx = cx.tid; idx < 32768; idx += NTHR) { const int col = idx >> 5, e = idx & 31; const float v = rw[idx] * gnorm[col];
        const unsigned h = cvt_pk_bf16(v, 0.f) & 0xffffu; const float lo = v - bf2f(h); WH[e * RW_LD + col] = (bf16)h; WL[e * RW_LD + col] = (bf16)(cvt_pk_bf16(lo, 0.f) & 0xffffu); }
    const float b0 = rb[l15], b1 = rb[l15 + 16];
    for (int tb = cx.wg; tb < 256; tb += cx.G) {
        if (cx.tid < 32) hcnt[cx.tid] = 0u;
        __syncthreads();
        const int tok0 = tb * 128 + cx.wave * 16;
        const float* xrow = X1 + (size_t)(tok0 + l15) * 1024 + 8 * q;
        f32x4 acc[2] = {(f32x4){0.f, 0.f, 0.f, 0.f}, (f32x4){0.f, 0.f, 0.f, 0.f}}; float ss = 0.f;
#pragma unroll 4
        for (int s = 0; s < 32; ++s) {
            const f32x4 x0 = *(const f32x4*)(xrow + 32 * s), x1 = *(const f32x4*)(xrow + 32 * s + 4);
            ss += (x0.x * x0.x + x0.y * x0.y) + (x0.z * x0.z + x0.w * x0.w) + (x1.x * x1.x + x1.y * x1.y) + (x1.z * x1.z + x1.w * x1.w);
            u32x4 hi; hi.x = pk2(x0.x, x0.y); hi.y = pk2(x0.z, x0.w); hi.z = pk2(x1.x, x1.y); hi.w = pk2(x1.z, x1.w);
            u32x4 lo; lo.x = pk2(x0.x - lo16(hi.x), x0.y - hi16(hi.x)); lo.y = pk2(x0.z - lo16(hi.y), x0.w - hi16(hi.y)); lo.z = pk2(x1.x - lo16(hi.z), x1.y - hi16(hi.z)); lo.w = pk2(x1.z - lo16(hi.w), x1.w - hi16(hi.w));
            const bf16x8 ah = __builtin_bit_cast(bf16x8, hi), al = __builtin_bit_cast(bf16x8, lo);
#pragma unroll
            for (int n = 0; n < 2; ++n) { const bf16x8 bh = *(const LAS bf16x8*)(WH + (l15 + 16 * n) * RW_LD + 32 * s + 8 * q), bl = *(const LAS bf16x8*)(WL + (l15 + 16 * n) * RW_LD + 32 * s + 8 * q);
                acc[n] = __builtin_amdgcn_mfma_f32_16x16x32_bf16(ah, bh, acc[n], 0, 0, 0); acc[n] = __builtin_amdgcn_mfma_f32_16x16x32_bf16(al, bh, acc[n], 0, 0, 0); acc[n] = __builtin_amdgcn_mfma_f32_16x16x32_bf16(ah, bl, acc[n], 0, 0, 0); }
        }
        ss += __shfl_xor(ss, 16); ss += __shfl_xor(ss, 32);
        const float rinv_l = rsqrtf(ss * (1.f / 1024.f) + 1e-6f);
#pragma unroll
        for (int r = 0; r < 4; ++r) {
            const float ri = __shfl(rinv_l, 4 * q + r);
            float v0 = acc[0][r] * ri + b0, v1 = acc[1][r] * ri + b1; int se[4]; float sv[4];
#pragma unroll
            for (int k = 0; k < 4; ++k) { float bv = (v1 > v0) ? v1 : v0; int be = (v1 > v0) ? (l15 + 16) : l15;
#pragma unroll
                for (int off = 1; off < 16; off <<= 1) { const float ov = __shfl_xor(bv, off); const int oe = __shfl_xor(be, off); const bool take = (ov > bv) || (ov == bv && oe < be); bv = take ? ov : bv; be = take ? oe : be; }
                se[k] = be; sv[k] = bv; if (be == l15) v0 = -INFINITY; if (be == l15 + 16) v1 = -INFINITY; }
            if (l15 == r) { const int tok = tok0 + 4 * q + r;
                const float w1 = __expf(sv[1] - sv[0]), w2 = __expf(sv[2] - sv[0]), w3 = __expf(sv[3] - sv[0]); const float inv = 1.0f / (1.0f + w1 + w2 + w3);
                *(int4*)(TOPE + (size_t)tok * 4) = make_int4(se[0], se[1], se[2], se[3]);
                *(float4*)(TOPG + (size_t)tok * 4) = make_float4(inv, w1 * inv, w2 * inv, w3 * inv);
                atomicAdd((unsigned*)(hcnt + se[0]), 1u); atomicAdd((unsigned*)(hcnt + se[1]), 1u); atomicAdd((unsigned*)(hcnt + se[2]), 1u); atomicAdd((unsigned*)(hcnt + se[3]), 1u); }
        }
        const f32x4* gr = (const f32x4*)gnorm + lane;
#pragma unroll 2
        for (int i = 0; i < 16; ++i) { const float ri = __shfl(rinv_l, i); const f32x4* xr = (const f32x4*)(X1 + (size_t)(tok0 + i) * 1024) + lane; unsigned* o4 = (unsigned*)(H2 + (size_t)(tok0 + i) * 1024) + lane;
#pragma unroll
            for (int j = 0; j < 4; ++j) { const f32x4 v = xr[64 * j], gg = gr[64 * j]; o4[64 * j] = pk4_fp8(v.x * ri * gg.x, v.y * ri * gg.y, v.z * ri * gg.z, v.w * ri * gg.w); } }
        __syncthreads();
        if (cx.tid < 32) HIST[tb * 32 + cx.tid] = hcnt[cx.tid];
        __syncthreads();
    }
}

constexpr int PL_BASE = 1280, PL_WCNT = 1312;
__device__ __forceinline__ void moe_plan(const Ctx& cx, const unsigned* HIST) {
    LAS int* PL = (LAS int*)(cx.lds + LDS_PLAN);
    const int e = cx.tid & 31, part = cx.tid >> 5;
    { int s = 0; for (int w = 16 * part; w < 16 * part + 16; ++w) s += (int)HIST[w * 32 + e]; PL[PL_TMP + part * 32 + e] = s; }
    __syncthreads();
    if (cx.tid < 32) { int c = 0; for (int p = 0; p < 16; ++p) c += PL[PL_TMP + p * 32 + cx.tid]; PL[PL_CNT + cx.tid] = c; }
    __syncthreads();
    if (cx.tid == 0) {
        int ps = 0;
        for (int x = 0; x < 32; ++x) { PL[PL_PSTART + x] = ps; const int pad = (PL[PL_CNT + x] + 255) & ~255; for (int i = 0; i < pad / 256; ++i) PL[PL_TILEE + ps / 256 + i] = x; ps += pad; }
        PL[PL_PSTART + 32] = ps;
        int np = 0, e0 = 0;
        while (e0 < 32 && np < 7) { PL[PL_PE0 + np] = e0; PL[PL_PROW0 + np] = PL[PL_PSTART + e0]; int rows = 0, e1 = e0;
            while (e1 < 32 && e1 - e0 < MAXEPP) { const int pad = PL[PL_PSTART + e1 + 1] - PL[PL_PSTART + e1]; if (rows + pad > RMAX && e1 > e0) break; rows += pad; ++e1; }
            e0 = e1; ++np; }
        PL[PL_PE0 + np] = 32; PL[PL_PROW0 + np] = ps; PL[PL_NPASS] = np;
    }
    __syncthreads();
}
__device__ __forceinline__ void dispatch_phase(const Ctx& cx, const unsigned* HIST, const int* TOPE, int* SLOTTOK, int* TOKSLOT) {
    LAS int* PL = (LAS int*)(cx.lds + LDS_PLAN);
    const int e5 = cx.tid & 31, part = cx.tid >> 5, lane = cx.lane;
    for (int tb = cx.wg; tb < 256; tb += cx.G) {
        { int s = 0; for (int w = 16 * part; w < 16 * part + 16; ++w) s += (w < tb) ? (int)HIST[w * 32 + e5] : 0; PL[PL_TMP + part * 32 + e5] = s; }
        const int tok = tb * 128 + (cx.tid >> 2), k = cx.tid & 3; const int e = TOPE[(size_t)tok * 4 + k];
        int rank = 0;
        for (int ee = 0; ee < 32; ++ee) { const unsigned long long mask = __ballot(e == ee); if (e == ee) rank = __popcll(mask & ((1ull << lane) - 1ull)); if (lane == 0) PL[PL_WCNT + cx.wave * 32 + ee] = __popcll(mask); }
        __syncthreads();
        if (cx.tid < 32) { int c = 0; for (int p = 0; p < 16; ++p) c += PL[PL_TMP + p * 32 + cx.tid]; PL[PL_BASE + cx.tid] = c; }
        __syncthreads();
        int off = 0; for (int w2 = 0; w2 < 8; ++w2) off += (w2 < cx.wave) ? PL[PL_WCNT + w2 * 32 + e] : 0;
        const int slot = PL[PL_PSTART + e] + PL[PL_BASE + e] + off + rank;
        SLOTTOK[slot] = tok; TOKSLOT[(size_t)tok * 4 + k] = slot;
        __syncthreads();
    }
    for (int e = cx.wg; e < 32; e += cx.G) { const int c = PL[PL_CNT + e], ps = PL[PL_PSTART + e], pe = PL[PL_PSTART + e + 1]; for (int r = ps + c + cx.tid; r < pe; r += NTHR) SLOTTOK[r] = 0; }
}
__device__ __forceinline__ void convert_pass(const Ctx& cx, int e0, int e1, const float* wg, const float* wu, const float* wd, unsigned char* WGU, unsigned char* WDN) {
    LAS float* scr = (LAS float*)(cx.lds + cx.wave * 16640);
    const int nitems = (e1 - e0) * 768;
    for (int it = cx.gw; it < nitems; it += cx.NGW) { const int le = it / 768, r = it % 768, mat = r >> 8, kb = (r & 255) >> 4, nb = r & 15, n0 = 64 * nb; const size_t eo = (size_t)(e0 + le) * 1048576;
        if (mat == 2) transpose_item_fp8(wd + eo, 1024, 64 * kb, n0, WDN + (size_t)le * 1048576 + (size_t)n0 * 1024 + 64 * kb, 1024, 32.0f, scr, cx.lane);
        else { const int drow = (n0 >> 7) * 256 + (n0 & 127) + mat * 128; transpose_item_fp8((mat ? wu : wg) + eo, 1024, 64 * kb, n0, WGU + (size_t)le * 2097152 + (size_t)drow * 1024 + 64 * kb, 1024, 32.0f, scr, cx.lane); } }
}
template <bool LAST>
__device__ __forceinline__ void combine_pass(const Ctx& cx, int e0, int e1, int row0, const int* TOPE, const float* TOPG, const int* TOKSLOT, const bf16* Y, float* X, const float* gnorm, unsigned char* H3) {
    for (int tok = cx.gw; tok < M; tok += cx.NGW) {
        const int4 es = *(const int4*)(TOPE + (size_t)tok * 4); const float4 gs = *(const float4*)(TOPG + (size_t)tok * 4); const int4 sl = *(const int4*)(TOKSLOT + (size_t)tok * 4);
        const int ee[4] = {es.x, es.y, es.z, es.w}; const float gg[4] = {gs.x, gs.y, gs.z, gs.w}; const int ss[4] = {sl.x, sl.y, sl.z, sl.w};
        bool any = false;
#pragma unroll
        for (int k = 0; k < 4; ++k) any |= (ee[k] >= e0 && ee[k] < e1);
        if (!LAST && !any) continue;
        f32x4* xr = (f32x4*)(X + (size_t)tok * 1024) + cx.lane; f32x4 v[4];
#pragma unroll
        for (int j = 0; j < 4; ++j) v[j] = xr[64 * j];
#pragma unroll
        for (int k = 0; k < 4; ++k) if (ee[k] >= e0 && ee[k] < e1) { const u32x2* yr = (const u32x2*)(Y + (size_t)(ss[k] - row0) * 1024) + cx.lane; const float g = gg[k];
#pragma unroll
            for (int j = 0; j < 4; ++j) { const u32x2 w = yr[64 * j]; v[j].x += g * lo16(w.x); v[j].y += g * hi16(w.x); v[j].z += g * lo16(w.y); v[j].w += g * hi16(w.y); } }
        if (any) {
#pragma unroll
            for (int j = 0; j < 4; ++j) xr[64 * j] = v[j];
        }
        if (LAST) { float s = 0.f;
#pragma unroll
            for (int j = 0; j < 4; ++j) s += (v[j].x * v[j].x + v[j].y * v[j].y) + (v[j].z * v[j].z + v[j].w * v[j].w);
            const float rinv = rsqrtf(wave_sum(s) * (1.f / 1024.f) + 1e-6f); const f32x4* gr = (const f32x4*)gnorm + cx.lane; unsigned* o8 = (unsigned*)(H3 + (size_t)tok * 1024) + cx.lane;
#pragma unroll
            for (int j = 0; j < 4; ++j) { const f32x4 gg = gr[64 * j]; o8[64 * j] = pk4_fp8(v[j].x * rinv * gg.x, v[j].y * rinv * gg.y, v[j].z * rinv * gg.z, v[j].w * rinv * gg.w); } }
    }
}

#define HBUF ((bf16*)(ws + WS_R1))
#define RKV ((bf16*)(ws + WS_RKV))
#define WAG ((bf16*)(ws + WS_WAG))
#define AG ((bf16*)(ws + WS_AG))
#define UB ((bf16*)(ws + WS_U))
#define LP ((bf16*)(ws + WS_LP))
#define LACT ((bf16*)(ws + WS_LACT))
#define Y1 ((bf16*)(ws + WS_Y1))
#define MIX ((bf16*)(ws + WS_R1))
#define EBUF ((float*)(ws + WS_LP))
#define S0G ((bf16*)(ws + WS_LP))
#define QCT ((bf16*)(ws + WS_U))
#define HCT ((float*)(ws + WS_R1))
#define W1G ((bf16*)(ws + WS_W1))
#define ULG ((bf16*)(ws + WS_ULOC))
#define DLG ((float*)(ws + WS_DL))
#define ATG ((float*)(ws + WS_AT))
#define WCAT ((bf16*)(ws + WS_WCAT))
#define WL2 ((bf16*)(ws + WS_WL2))
#define WGLU ((bf16*)(ws + WS_WGLU))
#define WPP ((bf16*)(ws + WS_WPP))
#define WOUT ((bf16*)(ws + WS_WOUT))
#define WPG ((unsigned char*)(ws + WS_WPG))
#define S5BT ((bf16*)(ws + WS_S5BT))
#define S5ET ((bf16*)(ws + WS_S5ET))
#define PBF ((bf16*)(ws + WS_PBF))
#define H2 ((unsigned char*)(ws + WS_H2))
#define WGU ((unsigned char*)(ws + WS_WGU))
#define WDN ((unsigned char*)(ws + WS_WDN))
#define ACT ((unsigned char*)(ws + WS_ACT))
#define YB ((bf16*)(ws + WS_Y))
#define PP ((bf16*)(ws + WS_ACT))
#define HIST ((unsigned*)(ws + WS_HIST))
#define TOPE ((int*)(ws + WS_TOPE))
#define TOPG ((float*)(ws + WS_TOPG))
#define TOKSLOT ((int*)(ws + WS_TOKSLOT))
#define SLOTTOK ((int*)(ws + WS_SLOTTOK))
#ifndef PROBE_PH
#define PROBE_PH -1
#endif
#ifndef PROBE_N
#define PROBE_N 2
#endif
#define REPS(k) ((((k) >= 10 && (k) < 28) ? 10 + ((k) - 10) % 3 : (k)) == PROBE_PH ? PROBE_N : 1)
#ifndef ONLY_PHASE
#define ONLY_PHASE -1
#endif
constexpr int NPH = 31;
struct Args { const float* in[42]; float* out; unsigned char* ws; int ph_lo, ph_hi; };

__global__ void __launch_bounds__(NTHR, 2) mk_fwd(Args args) {
    extern __shared__ __attribute__((aligned(16))) unsigned char lds_raw[];
    LAS unsigned char* lds = (LAS unsigned char*)lds_raw;
#define CAS __attribute__((address_space(4)))
#define FRESH_CX const CAS char* ka_ = (const CAS char*)__builtin_amdgcn_kernarg_segment_ptr(); asm volatile("" : "+s"(ka_)); const float* const CAS* I = (const float* const CAS*)ka_; unsigned char* ws = *(unsigned char* const CAS*)(ka_ + 344); float* OUTP = *(float* const CAS*)(ka_ + 336); (void)I; (void)ws; (void)OUTP; \
    Ctx cx; { int t_ = threadIdx.x; asm volatile("" : "+v"(t_)); cx.lds = lds; cx.tid = t_; cx.lane = t_ & 63; cx.wave = __builtin_amdgcn_readfirstlane(t_ >> 6); cx.G = gridDim.x; cx.wg = blockIdx.x; cx.gw = cx.wg * NWAVES + cx.wave; cx.NGW = cx.G * NWAVES; }
    unsigned char* ws = args.ws;
    const int lo = args.ph_lo, hi = args.ph_hi;
    volatile LAS unsigned* MISC = (volatile LAS unsigned*)(lds + LDS_MISC);
    if (threadIdx.x < 64) MISC[threadIdx.x] = 0u;
    __syncthreads();
    XcdBarrier bar; bar.bar = (unsigned*)(ws + WS_CTL) + CW_BAR; bar.x = 0; bar.st = nullptr;
    if (hi - lo > 1) bar = xcd_barrier_post((unsigned*)(ws + WS_CTL) + CW_BAR, MISC + 8);

#define IN(k) ((ONLY_PHASE < 0 || ONLY_PHASE == (k) || (ONLY_PHASE >= 10 && ONLY_PHASE < 28 && (k) >= 10 && (k) < 28 && ((k) - 10) % 3 == (ONLY_PHASE - 10) % 3)) && lo <= (k) && (k) < hi)
#ifndef PROBE_BAR
#define PROBE_BAR 1
#endif
#ifndef PROBE_T
#define PROBE_T -1
#endif
#define STAMP() do { if (PROBE_T >= 0 && blockIdx.x == 0 && threadIdx.x == 0) { const unsigned long long t_ = __builtin_amdgcn_s_memrealtime(); MISC[16 + 2 * nst] = (unsigned)t_; MISC[17 + 2 * nst] = (unsigned)(t_ >> 32); } ++nst; } while (0)
#define SEAM(k) do { if (IN(k) && IN((k) + 1)) { for (int b_ = 0; b_ < PROBE_BAR; ++b_) xcd_barrier(bar); STAMP(); } } while (0)
    int nst = 0; STAMP();
#define MAKE_RP RwkvP RP; RP.rkv = RKV; RP.wag = WAG; RP.mu_rkv = I[13]; RP.w0 = I[15]; RP.a0 = I[18]; RP.k_k = I[23]; RP.k_a = I[24]; RP.r_k = I[25]; RP.ln_w = I[26]; RP.ln_b = I[27]
#define OPQ(v) ({ int _k = (v); asm volatile("" : "+s"(_k)); _k; })

    if (IN(0)) for (int rep_ = 0; rep_ < REPS(0); ++rep_) {
        FRESH_CX;
        for (int it = cx.wg; it < 256; it += cx.G) s5_tables_item(cx, it >> 3, it & 7, I[4], I[5], I[6], I[7], I[8], I[9], I[10], S5BT, S5ET, ATG);
        const float* mu = I[14];
        transpose_matrix(cx, I[3], 1024, 2048, WCAT, 0, 1024, 0, nullptr, 0);
        transpose_matrix(cx, I[16], 1024, 64, WCAT, 2048, 1024, 0, mu, 1);          transpose_matrix(cx, I[16], 1024, 64, WCAT, 2304, 1024, 0, mu, 0);
        transpose_matrix(cx, I[19], 1024, 64, WCAT, 2112, 1024, 0, mu + 1024, 1);   transpose_matrix(cx, I[19], 1024, 64, WCAT, 2368, 1024, 0, mu + 1024, 0);
        transpose_matrix(cx, I[21], 1024, 128, WCAT, 2176, 1024, 0, mu + 2048, 1);  transpose_matrix(cx, I[21], 1024, 128, WCAT, 2432, 1024, 0, mu + 2048, 0);
        transpose_matrix(cx, I[17], 64, 512, WL2, 0, 256, 0, nullptr, 0);
        transpose_matrix(cx, I[20], 64, 512, WL2, 512, 256, 64, nullptr, 0);
        transpose_matrix(cx, I[22], 128, 512, WL2, 1024, 256, 128, nullptr, 0);
        for (int idx = cx.wg * NTHR + cx.tid; idx < 1536 * 32; idx += cx.G * NTHR) { const int row = idx >> 5, ch = idx & 31, blk = row >> 9; const int kb = blk == 0 ? 0 : (blk == 1 ? 64 : 128), ke = blk == 0 ? 64 : (blk == 1 ? 128 : 256);
            if (ch * 8 < kb || ch * 8 >= ke) *(u32x4*)(WL2 + (size_t)row * 256 + ch * 8) = (u32x4){0u, 0u, 0u, 0u}; }
        transpose_matrix(cx, I[12], 512, 512, WGLU, 0, 512, 0, nullptr, 0);
        transpose_matrix(cx, I[39], 256, 1024, WPP, 0, 256, 0, nullptr, 0);
        transpose_matrix(cx, I[28], 1024, 1024, WOUT, 0, 1024, 0, nullptr, 0);
        { LAS float* scr = (LAS float*)(cx.lds + cx.wave * 16640);
          for (int it = cx.gw; it < 256; it += cx.NGW) { const int kb = it >> 4, nb = it & 15;
              transpose_item_fp8(I[40], 1024, 64 * kb, 64 * nb, WPG + (size_t)(64 * nb) * 1024 + 64 * kb, 1024, 32.0f, scr, cx.lane); } }
        for (int m = 2 * cx.gw; m < M; m += 2 * cx.NGW) rms_rows2_to_bf16(I[0] + (size_t)m * 1024, I[0] + (size_t)(m + 1) * 1024, I[2], HBUF + (size_t)m * 1024, HBUF + (size_t)(m + 1) * 1024, cx.lane);
        for (int m = 4 * cx.gw; m < M; m += 4 * cx.NGW) { f32x4 v[4];
#pragma unroll
            for (int r = 0; r < 4; ++r) v[r] = *((const f32x4*)(I[1] + (size_t)(m + r) * 256) + cx.lane);
#pragma unroll
            for (int r = 0; r < 4; ++r) { u32x2 w; w.x = pk2(v[r].x, v[r].y); w.y = pk2(v[r].z, v[r].w); *((u32x2*)(PBF + (size_t)(m + r) * 256) + cx.lane) = w; } }
    }
    SEAM(0);
    if (IN(1)) for (int rep_ = 0; rep_ < REPS(1); ++rep_) {
        FRESH_CX;
        SchedPlain S; S.init(128, 10, cx.G, cx.wg); S.A = (const char*)HBUF; S.B = (const char*)WCAT; S.a_tile = 256 * 1024 * 2; S.b_tile = 256 * 1024 * 2;
        EpiProj E{AG, RKV, LP};
        pg8::gemm_phase<EpiProj, SchedPlain, true, true, false>(lds, cx.tid, OPQ(1024), OPQ(1024), OPQ(1024), S, E);
    }
    SEAM(1);
    if (IN(2)) for (int rep_ = 0; rep_ < REPS(2); ++rep_) {
        FRESH_CX;
        for (int m = 2 * cx.gw; m < M; m += 2 * cx.NGW) {
            const int lane = cx.lane; const bool first = (m & (SEQ - 1)) == 0;
            const u32x2 a0 = *((const u32x2*)(LP + (size_t)m * 512) + lane), a1 = *((const u32x2*)(LP + (size_t)(m + 1) * 512) + lane), b1 = *((const u32x2*)(LP + (size_t)m * 512 + 256) + lane);
            u32x2 b0 = (u32x2){0u, 0u}; if (!first) b0 = *((const u32x2*)(LP + (size_t)(m - 1) * 512 + 256) + lane);
            float v[8] = {lo16(a0.x) + lo16(b0.x), hi16(a0.x) + hi16(b0.x), lo16(a0.y) + lo16(b0.y), hi16(a0.y) + hi16(b0.y), lo16(a1.x) + lo16(b1.x), hi16(a1.x) + hi16(b1.x), lo16(a1.y) + lo16(b1.y), hi16(a1.y) + hi16(b1.y)};
#pragma unroll
            for (int i = 0; i < 8; ++i) v[i] = lane < 16 ? ftanh(v[i]) : (lane < 32 ? v[i] : fsigmoid(v[i]));
            u32x2 o; o.x = pk2(v[0], v[1]); o.y = pk2(v[2], v[3]); *((u32x2*)(LACT + (size_t)m * 256) + lane) = o;
            o.x = pk2(v[4], v[5]); o.y = pk2(v[6], v[7]); *((u32x2*)(LACT + (size_t)(m + 1) * 256) + lane) = o;
        }
    }
    SEAM(2);
    if (IN(3)) for (int rep_ = 0; rep_ < REPS(3); ++rep_) {
        FRESH_CX;
        { SchedPlain S; S.init(128, 6, cx.G, cx.wg); S.A = (const char*)LACT; S.B = (const char*)WL2; S.a_tile = 256 * 256 * 2; S.b_tile = 256 * 256 * 2;
          EpiBf16Plain E{WAG, 1536};
          pg8::gemm_phase<EpiBf16Plain, SchedPlain, true, true, false>(lds, cx.tid, OPQ(256), OPQ(256), OPQ(256), S, E); }
        { SchedS5 S; S.init(128, 1, cx.G, cx.wg); S.A = (const char*)AG; S.B = (const char*)S5ET; S.a_tile = 256 * 640 * 2; S.b_tile = 0; S.b_group = 256 * 512 * 2;
          EpiF32 E{EBUF, 256};
          pg8::gemm_phase<EpiF32, SchedS5, true, true, false>(lds, cx.tid, OPQ(512), OPQ(640), OPQ(512), S, E); }
    }
    SEAM(3);
    if (IN(4)) for (int rep_ = 0; rep_ < REPS(4); ++rep_) {
        FRESH_CX;
        if (cx.wave == 0 && cx.lane < 32) {
            for (int idx = cx.wg * 32 + cx.lane; idx < 8192; idx += cx.G * 32) { const int b = idx >> 11, g = (idx >> 6) & 31, p = idx & 63;
                const float ar = ATG[(g * 64 + p) * 2], ai = ATG[(g * 64 + p) * 2 + 1]; float sr = 0.f, si = 0.f;
                const size_t row0 = (size_t)g * 1024 + b * 256;
                for (int k0 = 0; k0 < 256; k0 += 16) { float er[16], ei[16];
#pragma unroll
                    for (int k = 0; k < 16; ++k) { er[k] = EBUF[(row0 + k0 + k) * 256 + p]; ei[k] = EBUF[(row0 + k0 + k) * 256 + 64 + p]; }
#pragma unroll
                    for (int k = 0; k < 16; ++k) { bf16* d = AG + (row0 + k0 + k) * 640 + 512 + p; d[0] = (bf16)(pk2(sr, 0.f) & 0xffffu); d[64] = (bf16)(pk2(si, 0.f) & 0xffffu);
                        const float nr = ar * sr - ai * si + er[k], ni = ar * si + ai * sr + ei[k]; sr = nr; si = ni; } }
            }
        }
        MAKE_RP;
        for (int grp = cx.wg; grp < 256; grp += cx.G) rwkv_pass1(lds, RP, grp * 16, 16, cx.tid, QCT, HCT, W1G, ULG, DLG);
    }
    SEAM(4);
    if (IN(5)) for (int rep_ = 0; rep_ < REPS(5); ++rep_) {
        FRESH_CX;
        { SchedS5 S; S.init(128, 2, cx.G, cx.wg); S.A = (const char*)AG; S.B = (const char*)S5BT; S.a_tile = 256 * 640 * 2; S.b_tile = 256 * 640 * 2; S.b_group = 512 * 640 * 2;
          EpiS5Y E{AG, I[11], Y1};
          pg8::gemm_phase<EpiS5Y, SchedS5, true, true, false>(lds, cx.tid, OPQ(640), OPQ(640), OPQ(640), S, E); }
        if (cx.wave == 0) for (int it = cx.wg; it < 128; it += cx.G) rwkv_pass2(lds, it >> 2, it & 3, cx.lane, QCT, HCT, DLG, S0G);
    }
    SEAM(5);
    if (IN(6)) for (int rep_ = 0; rep_ < REPS(6); ++rep_) {
        FRESH_CX;
        MAKE_RP;
        for (int grp = cx.wg; grp < 256; grp += cx.G) rwkv_pass3(lds, RP, grp * 16, 16, cx.tid, S0G, W1G, ULG, MIX);
        __syncthreads();
        { SchedPlain S; S.init(128, 2, cx.G, cx.wg); S.A = (const char*)Y1; S.B = (const char*)WGLU; S.a_tile = 256 * 512 * 2; S.b_tile = 256 * 512 * 2;
          EpiGlu E{Y1, MIX};
          pg8::gemm_phase<EpiGlu, SchedPlain, true, true, false>(lds, cx.tid, OPQ(512), OPQ(512), OPQ(512), S, E); }
    }
    SEAM(6);
    if (IN(7)) for (int rep_ = 0; rep_ < REPS(7); ++rep_) {
        FRESH_CX;
        SchedPlain S; S.init(128, 4, cx.G, cx.wg); S.A = (const char*)MIX; S.B = (const char*)WOUT; S.a_tile = 256 * 1024 * 2; S.b_tile = 256 * 1024 * 2;
        EpiResid E{I[0], OUTP};
        pg8::gemm_phase<EpiResid, SchedPlain, true, true, false>(lds, cx.tid, OPQ(1024), OPQ(1024), OPQ(1024), S, E);
    }
    SEAM(7);
    if (IN(8)) for (int rep_ = 0; rep_ < REPS(8); ++rep_) { FRESH_CX; router_phase(cx, OUTP, I[29], I[30], I[31], H2, TOPE, TOPG, HIST); }
    SEAM(8);
    LAS int* PL = (LAS int*)(lds + LDS_PLAN);
    if (hi > 9 && lo < 28) { FRESH_CX; __syncthreads(); moe_plan(cx, HIST); }
    const int npass = (hi > 9 && lo < 28) ? PL[PL_NPASS] : 0;
    if (IN(9)) for (int rep_ = 0; rep_ < REPS(9); ++rep_) { FRESH_CX; dispatch_phase(cx, HIST, TOPE, SLOTTOK, TOKSLOT); convert_pass(cx, PL[PL_PE0], PL[PL_PE0 + 1], I[32], I[34], I[36], WGU, WDN); }
    SEAM(9);
    for (int p = 0; p < 6; ++p) {
        const bool actv = p < npass;
        const int e0 = actv ? PL[PL_PE0 + p] : 0, e1 = actv ? PL[PL_PE0 + p + 1] : 0, row0 = actv ? PL[PL_PROW0 + p] : 0, rows = actv ? PL[PL_PROW0 + p + 1] - row0 : 0;
        if (IN(10 + 3 * p) && actv) for (int rep_ = 0; rep_ < REPS(10); ++rep_) {
            FRESH_CX;
            SchedMoe<true> S; S.init(rows / 256, 8, cx.G, cx.wg); S.A = (const char*)H2; S.B = (const char*)WGU; S.a_tile = 0; S.b_tile = 256 * 1024; S.b_exp = (size_t)2048 * 1024; S.tile_e = PL + PL_TILEE; S.tile0 = row0 / 256; S.e0 = e0; S.slot_tok = SLOTTOK; S.row0 = row0;
            EpiGU E{ACT, I[33], I[35]};
            pg8::gemm_phase<EpiGU, SchedMoe<true>, true, true, true, true>(lds, cx.tid, OPQ(512), OPQ(512), OPQ(512), S, E);
        }
        if (actv) SEAM(10 + 3 * p);
        if (IN(11 + 3 * p) && actv) for (int rep_ = 0; rep_ < REPS(11); ++rep_) {
            FRESH_CX;
            SchedMoe<false> S; S.init(rows / 256, 4, cx.G, cx.wg); S.A = (const char*)ACT; S.B = (const char*)WDN; S.a_tile = 256 * 1024; S.b_tile = 256 * 1024; S.b_exp = (size_t)1024 * 1024; S.tile_e = PL + PL_TILEE; S.tile0 = row0 / 256; S.e0 = e0; S.slot_tok = SLOTTOK; S.row0 = row0;
            EpiDown E{YB, I[37]};
            pg8::gemm_phase<EpiDown, SchedMoe<false>, true, true, false, true>(lds, cx.tid, OPQ(512), OPQ(512), OPQ(512), S, E);
        }
        if (actv) SEAM(11 + 3 * p);
        if (IN(12 + 3 * p) && actv) for (int rep_ = 0; rep_ < REPS(12); ++rep_) {
            FRESH_CX;
            if (p + 1 < npass) { combine_pass<false>(cx, e0, e1, row0, TOPE, TOPG, TOKSLOT, YB, OUTP, nullptr, nullptr); convert_pass(cx, PL[PL_PE0 + p + 1], PL[PL_PE0 + p + 2], I[32], I[34], I[36], WGU, WDN); }
            else {
                combine_pass<true>(cx, e0, e1, row0, TOPE, TOPG, TOKSLOT, YB, OUTP, I[38], (unsigned char*)(ws + WS_R1));
                SchedPlain S; S.init(128, 4, cx.G, cx.wg); S.A = (const char*)PBF; S.B = (const char*)WPP; S.a_tile = 256 * 256 * 2; S.b_tile = 256 * 256 * 2;
                EpiBf16Plain E{PP, 1024};
                pg8::gemm_phase<EpiBf16Plain, SchedPlain, true, true, false>(lds, cx.tid, OPQ(256), OPQ(256), OPQ(256), S, E);
            }
        }
        if (actv) SEAM(12 + 3 * p);
    }
    if (IN(29)) for (int rep_ = 0; rep_ < REPS(29); ++rep_) {
        FRESH_CX;
        SchedPlain S; S.init(128, 4, cx.G, cx.wg); S.A = (const char*)(ws + WS_R1); S.B = (const char*)WPG; S.a_tile = 256 * 1024; S.b_tile = 256 * 1024;
        EpiPle E{PP, OUTP};
        pg8::gemm_phase<EpiPle, SchedPlain, true, true, false, true>(lds, cx.tid, OPQ(512), OPQ(512), OPQ(512), S, E);
    }
    SEAM(29);
    if (IN(30)) for (int rep_ = 0; rep_ < REPS(30); ++rep_) {
        FRESH_CX;
        for (int m = 2 * cx.gw; m < M; m += 2 * cx.NGW) {
            f32x4* xa = (f32x4*)(OUTP + (size_t)m * 1024) + cx.lane; f32x4* xb = xa + 256; const f32x4* gr = (const f32x4*)I[41] + cx.lane; f32x4 va[4], vb[4]; float sa = 0.f, sb = 0.f;
#pragma unroll
            for (int j = 0; j < 4; ++j) { va[j] = xa[64 * j]; vb[j] = xb[64 * j]; }
#pragma unroll
            for (int j = 0; j < 4; ++j) { sa += (va[j].x * va[j].x + va[j].y * va[j].y) + (va[j].z * va[j].z + va[j].w * va[j].w); sb += (vb[j].x * vb[j].x + vb[j].y * vb[j].y) + (vb[j].z * vb[j].z + vb[j].w * vb[j].w); }
#pragma unroll
            for (int o = 1; o < 64; o <<= 1) { sa += __shfl_xor(sa, o); sb += __shfl_xor(sb, o); }
            const float ia = rsqrtf(sa * (1.f / 1024.f) + 1e-6f), ib = rsqrtf(sb * (1.f / 1024.f) + 1e-6f);
#pragma unroll
            for (int j = 0; j < 4; ++j) { const f32x4 gg = gr[64 * j]; xa[64 * j] = (f32x4){va[j].x * ia * gg.x, va[j].y * ia * gg.y, va[j].z * ia * gg.z, va[j].w * ia * gg.w}; xb[64 * j] = (f32x4){vb[j].x * ib * gg.x, vb[j].y * ib * gg.y, vb[j].z * ib * gg.z, vb[j].w * ib * gg.w}; }
        }
    }
    if (PROBE_T >= 0 && blockIdx.x == 0 && threadIdx.x == 0) { STAMP(); asm volatile("s_waitcnt vmcnt(0)" ::: "memory");
        const unsigned long long t0_ = ((unsigned long long)MISC[17 + 2 * PROBE_T] << 32) | MISC[16 + 2 * PROBE_T], t1_ = ((unsigned long long)MISC[19 + 2 * PROBE_T] << 32) | MISC[18 + 2 * PROBE_T];
        (*(float* const CAS*)((const CAS char*)__builtin_amdgcn_kernarg_segment_ptr() + 336))[0] = (float)(t1_ - t0_) * 0.01f; }
#undef IN
#undef SEAM
}

extern "C" void kernel_launch(void* const* d_in, const int* in_sizes, int n_in, void* d_out, int out_size, void* d_ws, size_t ws_size, hipStream_t stream) {
    static int grid = 0;
    if (grid == 0) {
        if (n_in != 42 || out_size != M * DM || ws_size < WS_END) { fprintf(stderr, "kernel_launch: unexpected shapes (n_in %d out %d ws %zu)\n", n_in, out_size, ws_size); grid = -1; return; }
        int dev = 0, cus = 0, per_cu = 0;
        if (hipGetDevice(&dev) != hipSuccess || hipDeviceGetAttribute(&cus, hipDeviceAttributeMultiprocessorCount, dev) != hipSuccess) { grid = -1; return; }
        if (hipFuncSetAttribute((const void*)mk_fwd, hipFuncAttributeMaxDynamicSharedMemorySize, LDS_BYTES) != hipSuccess) { fprintf(stderr, "kernel_launch: hipFuncSetAttribute failed\n"); grid = -1; return; }
        if (hipOccupancyMaxActiveBlocksPerMultiprocessor(&per_cu, (const void*)mk_fwd, NTHR, LDS_BYTES) != hipSuccess || per_cu < 1) fprintf(stderr, "kernel_launch: occupancy query says %d\n", per_cu);
        (void)hipGetLastError();
        grid = cus > 256 ? 256 : cus;
    }
    if (grid < 0) return;
    (void)hipMemsetAsync((char*)d_ws + WS_CTL, 0, CTL_ZERO_BYTES, stream);
    Args a{};
    for (int i = 0; i < 42; ++i) a.in[i] = (const float*)d_in[i];
    a.out = (float*)d_out; a.ws = (unsigned char*)d_ws;
#if MK_PER_PHASE
    for (int ph = 0; ph < NPH; ++ph) { a.ph_lo = ph; a.ph_hi = ph + 1; hipLaunchKernelGGL(mk_fwd, dim3(grid), dim3(NTHR), LDS_BYTES, stream, a); }
#else
    a.ph_lo = 0; a.ph_hi = NPH;
    hipLaunchKernelGGL(mk_fwd, dim3(grid), dim3(NTHR), LDS_BYTES, stream, a);
#endif
}
```

```cpp
#include <hip/hip_runtime.h>
#include <cstdio>
#include <cstdint>

#ifndef MK_PER_PHASE
#define MK_PER_PHASE 0
#endif

#define LAS __attribute__((address_space(3)))
#define GAS __attribute__((address_space(1)))
typedef unsigned short bf16;
typedef short bf16x8 __attribute__((ext_vector_type(8)));
typedef float f32x4 __attribute__((ext_vector_type(4)));
typedef float f32x2 __attribute__((ext_vector_type(2)));
typedef unsigned u32x4 __attribute__((ext_vector_type(4)));
typedef unsigned u32x2 __attribute__((ext_vector_type(2)));
typedef GAS unsigned gu32;

constexpr int NB = 4, SEQ = 8192, DM = 1024, M = NB * SEQ;
constexpr int NEXP = 32, TOPK = 4;
constexpr int NWAVES = 8, NTHR = 512;
constexpr size_t MiB = 1u << 20;

constexpr size_t WS_CTL = 0, CTL_ZERO_BYTES = 1 * MiB;
constexpr size_t WS_HIST = 1 * MiB;
constexpr size_t WS_TOPE = 2 * MiB;
constexpr size_t WS_TOPG = 3 * MiB;
constexpr size_t WS_TOKSLOT = 4 * MiB;
constexpr size_t WS_SLOTTOK = 5 * MiB;
constexpr size_t WS_AT = 6 * MiB;
constexpr size_t WS_DL = 6 * MiB + 65536;
constexpr size_t WS_WCAT = 8 * MiB;
constexpr size_t WS_WL2 = 13 * MiB;
constexpr size_t WS_WGLU = 14 * MiB;
constexpr size_t WS_WPP = 14 * MiB + 524288;
constexpr size_t WS_WOUT = 15 * MiB;
constexpr size_t WS_WPG = 17 * MiB;
constexpr size_t WS_S5BT = 19 * MiB;
constexpr size_t WS_S5ET = 39 * MiB;
constexpr size_t WS_PBF = 48 * MiB;
constexpr size_t WS_R1 = 64 * MiB;
constexpr size_t WS_RKV = 128 * MiB;
constexpr size_t WS_WAG = 224 * MiB;
constexpr size_t WS_AG = 320 * MiB;
constexpr size_t WS_U = 360 * MiB;
constexpr size_t WS_LP = 392 * MiB;
constexpr size_t WS_LACT = 424 * MiB;
constexpr size_t WS_W1 = 440 * MiB;
constexpr size_t WS_ULOC = 472 * MiB;
constexpr size_t WS_Y1 = 504 * MiB;
constexpr size_t WS_H2 = 64 * MiB;
constexpr size_t WS_WDN = 96 * MiB;
constexpr size_t WS_ACT = 128 * MiB;
constexpr size_t WS_Y = 264 * MiB;
constexpr size_t WS_XB = 400 * MiB;
constexpr size_t WS_WGU = 264 * MiB;
constexpr int RMAX = 139264;
constexpr int MAXEPP = 32;
constexpr size_t WS_END = 560 * MiB;
static_assert(WS_Y + (size_t)RMAX * 1024 <= WS_XB && WS_XB + (size_t)M * 2048 <= WS_END && WS_ACT + (size_t)RMAX * 1024 <= WS_Y, "moe map");

constexpr int CW_BAR = 4096;

constexpr int LDS_PLAN = 147456;
constexpr int LDS_MISC = 155648;
constexpr int LDS_BYTES = 156672;
constexpr int PL_CNT = 0, PL_PSTART = 32, PL_NPASS = 72, PL_PE0 = 80, PL_PROW0 = 88, PL_TILEE = 128, PL_TMP = 768;

#define LDS_WAIT() asm volatile("s_waitcnt lgkmcnt(0)" ::: "memory")
#define VM_WAIT() asm volatile("s_waitcnt vmcnt(0)" ::: "memory")
__device__ __forceinline__ float bf2f(unsigned b) { return __uint_as_float(b << 16); }
typedef __bf16 bf16n2 __attribute__((ext_vector_type(2)));
__device__ __forceinline__ unsigned cvt_pk_bf16(float lo, float hi) { const f32x2 f = {lo, hi}; const bf16n2 v = __builtin_convertvector(f, bf16n2); return __builtin_bit_cast(unsigned, v); }
__device__ __forceinline__ unsigned pk2(float lo, float hi) { return cvt_pk_bf16(lo, hi); }
__device__ __forceinline__ float lo16(unsigned w) { return __uint_as_float(w << 16); }
__device__ __forceinline__ float hi16(unsigned w) { return __uint_as_float(w & 0xffff0000u); }
__device__ __forceinline__ unsigned pk4_fp8(float a, float b, float c, float d) { unsigned w = 0u; w = (unsigned)__builtin_amdgcn_cvt_pk_fp8_f32(a, b, (int)w, false); w = (unsigned)__builtin_amdgcn_cvt_pk_fp8_f32(c, d, (int)w, true); return w; }
__device__ __forceinline__ f32x4 up4_fp8(unsigned w) { const f32x2 lo = __builtin_amdgcn_cvt_pk_f32_fp8((int)w, false), hi = __builtin_amdgcn_cvt_pk_f32_fp8((int)w, true); return (f32x4){lo.x, lo.y, hi.x, hi.y}; }
__device__ __forceinline__ float frcp(float x) { return __builtin_amdgcn_rcpf(x); }
__device__ __forceinline__ float fsigmoid(float x) { return frcp(1.0f + __expf(-x)); }
__device__ __forceinline__ float ftanh(float x) { const float e = __expf(-2.0f * fabsf(x)); const float t = (1.0f - e) * frcp(1.0f + e); return x < 0.f ? -t : t; }
__device__ __forceinline__ float gelu_tanh(float x) { const float u = 0.7978845608f * (x + 0.044715f * x * x * x); return 0.5f * x * (1.0f + ftanh(u)); }
__device__ __forceinline__ float wave_sum(float v) {
#pragma unroll
    for (int o = 1; o < 64; o <<= 1) v += __shfl_xor(v, o);
    return v;
}
__device__ __forceinline__ float wave_max(float v) {
#pragma unroll
    for (int o = 1; o < 64; o <<= 1) v = fmaxf(v, __shfl_xor(v, o));
    return v;
}

#define XB_TMO      128
#define XB_XCNT(j)  (256  + 64 * (j))
#define XB_XSUB(j)  (1280 + 64 * (j))
#define XB_XGEN(j)  (2304 + 64 * (j))
#define XB_TOP      3328
#define XB_TOPGEN   3392
#define XCD_BAR_WORDS 3456
#define XB_SPIN_CAP (1u << 22)

__device__ __forceinline__ unsigned xb_ld(unsigned* p)              { return __hip_atomic_load(p, __ATOMIC_RELAXED, __HIP_MEMORY_SCOPE_AGENT); }
__device__ __forceinline__ unsigned xb_add(unsigned* p, unsigned v) { return __hip_atomic_fetch_add(p, v, __ATOMIC_RELAXED, __HIP_MEMORY_SCOPE_AGENT); }
__device__ __forceinline__ unsigned xb_xcc_id() { return (unsigned)__builtin_amdgcn_s_getreg((3 << 11) | 20) & 0xFu; }
#define XB_SPIN(cond, bar) do { unsigned _sp = 0; while (cond) { __builtin_amdgcn_s_sleep(1); \
    if ((++_sp & 255u) == 0u) { if (xb_ld(&(bar)[XB_TMO])) break; if (_sp > XB_SPIN_CAP) { atomicAdd(&(bar)[XB_TMO], 1u); break; } } } } while (0)

struct XcdBarrier { unsigned* bar; unsigned x; volatile LAS unsigned* st; };

__device__ __forceinline__ XcdBarrier xcd_barrier_post(unsigned* bar, volatile LAS unsigned* st) {
    XcdBarrier b; b.bar = bar; b.x = xb_xcc_id(); b.st = st;
    if (threadIdx.x == 0) (void)xb_add(&bar[XB_XCNT(b.x)], 1u);
    return b;
}
__device__ __forceinline__ void xcd_barrier_complete(unsigned* bar, unsigned x, unsigned& nloc, unsigned& nx) {
    const unsigned G = gridDim.x * gridDim.y * gridDim.z;
    unsigned sum, cnt, mine, sp = 0u;
    for (;;) {
        sum = 0u; cnt = 0u; mine = 0u;
#pragma unroll
        for (unsigned j = 0; j < 16; ++j) { const unsigned c = xb_ld(&bar[XB_XCNT(j)]); sum += c; cnt += (c > 0u) ? 1u : 0u; mine = (j == x) ? c : mine; }
        if (sum == G) break;
        __builtin_amdgcn_s_sleep(1);
        if ((++sp & 255u) == 0u) { if (xb_ld(&bar[XB_TMO])) break; if (sp > XB_SPIN_CAP) { atomicAdd(&bar[XB_TMO], 1u); break; } }
    }
    nloc = mine > 0u ? mine : 1u; nx = cnt > 0u ? cnt : 1u;
}
__device__ __forceinline__ void xcd_barrier(const XcdBarrier& b) {
    asm volatile("s_waitcnt vmcnt(0)" ::: "memory");
    __syncthreads();
    if (threadIdx.x == 0) {
        unsigned* bar = b.bar;
        __builtin_amdgcn_s_waitcnt(0);
        unsigned nloc = b.st[0], nx = b.st[1];
        if (nloc == 0u) { xcd_barrier_complete(bar, b.x, nloc, nx); b.st[0] = nloc; b.st[1] = nx; }
        const unsigned old = xb_add(&bar[XB_XSUB(b.x)], 1u);
        const unsigned gen = old / nloc;
        if (old + 1u == (gen + 1u) * nloc) {
            __builtin_amdgcn_fence(__ATOMIC_RELEASE, "agent");
            asm volatile("s_waitcnt vmcnt(0)" ::: "memory");
            const unsigned og = xb_add(&bar[XB_TOP], 1u);
            const unsigned tg = og / nx;
            if (og + 1u == (tg + 1u) * nx) xb_add(&bar[XB_TOPGEN], 1u);
            else XB_SPIN(xb_ld(&bar[XB_TOPGEN]) == tg, bar);
            __builtin_amdgcn_fence(__ATOMIC_ACQUIRE, "agent");
            xb_add(&bar[XB_XGEN(b.x)], 1u);
            asm volatile("s_waitcnt vmcnt(0)" ::: "memory");
        } else {
            XB_SPIN(xb_ld(&bar[XB_XGEN(b.x)]) == gen, bar);
            __builtin_amdgcn_fence(__ATOMIC_ACQUIRE, "agent");
            asm volatile("s_waitcnt vmcnt(0)" ::: "memory");
        }
    }
    __syncthreads();
}

namespace pg8 {
constexpr int BM = 256, BK = 64, HALF = 128, HTB = HALF * BK * 2, STAGE_BYTES = 8 * HTB, NXCD = 8, WGM = 8;
__host__ __device__ __forceinline__ int lds_byte(int r, int c) { const int st = (r >> 4) * 2 + (c >> 5), rr = r & 15, cc = c & 31, ob = rr * 64 + cc * 2; return st * 1024 + (ob ^ (((ob >> 9) & 1) << 5)); }
__host__ __device__ __forceinline__ void stage_rc(int b, int& R, int& C) { const int st = b / 1024, sb = b % 1024, swz = sb ^ (((sb >> 9) & 1) << 5); R = (st >> 1) * 16 + swz / 64; C = (st & 1) * 32 + (swz % 64) / 2; }
__host__ __device__ __forceinline__ int perm32(int rho) { const int n = rho >> 4, i = rho & 15; return 8 * (i >> 2) + 4 * n + (i & 3); }

struct Unit { int pm, pn, aux; };

struct Order {
    int nM, nN, nwg, G, c;
    __device__ __forceinline__ void init(int nM_, int nN_, int G_, int c_) { nM = nM_; nN = nN_; nwg = nM * nN; G = G_; c = c_; }
    __device__ __forceinline__ bool tile(int i, int& pm, int& pn) const {
        const long L = (long)i * G + c; if (L >= nwg) return false;
        int wgid = (int)L; { const int q = nwg / NXCD, r = nwg % NXCD, xcd = wgid % NXCD, off = wgid / NXCD; wgid = (xcd < r ? xcd * (q + 1) : r * (q + 1) + (xcd - r) * q) + off; }
        const int nig = WGM * nN, gid = wgid / nig, fm = gid * WGM, gsz = (nM - fm) < WGM ? (nM - fm) : WGM;
        pm = fm + ((wgid % nig) % gsz); pn = (wgid % nig) / gsz; return true;
    }
};


template <class Epi, class Sched, bool ALIGN_EPI, bool SP2, bool GATHER, bool FP8 = false>
__device__ __forceinline__ void gemm_phase(LAS unsigned char* lds, const int tid, const int K, const int lda, const int ldb, const Sched& S, const Epi& E) {
    const int wid = __builtin_amdgcn_readfirstlane(tid >> 6), lane = tid & 63, wr = wid >> 2, wc = wid & 3, fr = lane & 15, fq = lane >> 4;
    const int nt = K / BK;
    unsigned voffA[2], voffB[2]; int rA[2], cA2[2];
#pragma unroll
    for (int i = 0; i < 2; ++i) { int R, C; stage_rc(tid * 16 + i * 8192, R, C); const int Rb = Epi::PERM ? ((R & ~31) + perm32(R & 31)) : R;
        voffA[i] = (unsigned)(R * lda + C) * 2u; voffB[i] = (unsigned)(Rb * ldb + C) * 2u; rA[i] = R; cA2[i] = C * 2; }
    const size_t kstep = (size_t)(BK * 2);
    const size_t hstepA = (size_t)HALF * lda * 2, hstepB = (size_t)HALF * ldb * 2;
    const unsigned ldsw = (unsigned)wid * 1024u;
    const int aoff = FP8 ? lds_byte(wr * 64 + fr, fq * 16) : lds_byte(wr * 64 + fr, fq * 8), boff = FP8 ? lds_byte(wc * 32 + fr, fq * 16) : lds_byte(wc * 32 + fr, fq * 8);
    unsigned cv0[2] = {0u, 0u}, cv1[2] = {0u, 0u}, nv0[2] = {0u, 0u}, nv1[2] = {0u, 0u};
#define PG8_SA(b, h) (((b) * 2 + (h)) * HTB)
#define PG8_SB(b, h) ((4 + (b) * 2 + (h)) * HTB)
#define PG8_STAGE(bufoff, gbase, voff) do { _Pragma("unroll") for (int _i = 0; _i < 2; ++_i) \
        __builtin_amdgcn_global_load_lds((const unsigned*)((const char*)(gbase) + (voff)[_i]), (LAS unsigned*)(lds + (bufoff) + ldsw + _i * 8192), 16, 0, 0); } while (0)
#define PG8_STAGE_A(bufoff, ptr, h, nx) do { if constexpr (GATHER) { unsigned _v[2]; _v[0] = (nx) ? ((h) ? nv1[0] : nv0[0]) : ((h) ? cv1[0] : cv0[0]); _v[1] = (nx) ? ((h) ? nv1[1] : nv0[1]) : ((h) ? cv1[1] : cv0[1]); PG8_STAGE(bufoff, ptr, _v); } \
        else { PG8_STAGE(bufoff, (ptr) + (h) * hstepA, voffA); } } while (0)
#define PG8_LDA(dst, b, h) do { if constexpr (FP8) { _Pragma("unroll") for (int m = 0; m < 4; ++m) { dst##8[m].lo = *(const LAS v4i_*)(lds + PG8_SA(b, h) + aoff + m * 2048); dst##8[m].hi = *(const LAS v4i_*)(lds + PG8_SA(b, h) + aoff + m * 2048 + 16); } } \
        else { _Pragma("unroll") for (int m = 0; m < 4; ++m) _Pragma("unroll") for (int k = 0; k < 2; ++k) dst[m][k] = *(const LAS bf16x8*)(lds + PG8_SA(b, h) + aoff + m * 2048 + k * 1024); } } while (0)
#define PG8_LDB(dst, b, h) do { if constexpr (FP8) { _Pragma("unroll") for (int n = 0; n < 2; ++n) { dst##8[n].lo = *(const LAS v4i_*)(lds + PG8_SB(b, h) + boff + n * 2048); dst##8[n].hi = *(const LAS v4i_*)(lds + PG8_SB(b, h) + boff + n * 2048 + 16); } } \
        else { _Pragma("unroll") for (int n = 0; n < 2; ++n) _Pragma("unroll") for (int k = 0; k < 2; ++k) dst[n][k] = *(const LAS bf16x8*)(lds + PG8_SB(b, h) + boff + n * 2048 + k * 1024); } } while (0)
#define PG8_MMA(ai, bj, At, Bt) do { __builtin_amdgcn_s_setprio(1); _Pragma("unroll") for (int m = 0; m < 4; ++m) _Pragma("unroll") for (int n = 0; n < 2; ++n) { \
        if constexpr (FP8) asm volatile("v_mfma_scale_f32_16x16x128_f8f6f4 %0, %1, %2, %0, %3, %4 op_sel_hi:[0,0,0]" : "+v"(acc[ai][bj][m][n]) : "v"(Bt##8[n]), "v"(At##8[m]), "v"(sclW), "v"(sclA));   \
        else { _Pragma("unroll") for (int k = 0; k < 2; ++k) acc[ai][bj][m][n] = __builtin_amdgcn_mfma_f32_16x16x32_bf16(Bt[n][k], At[m][k], acc[ai][bj][m][n], 0, 0, 0); } } \
        __builtin_amdgcn_s_setprio(0); } while (0)
#define PG8_WAIT_V(n) asm volatile("s_waitcnt vmcnt(" #n ")" ::: "memory")
#define PG8_WAIT_L(n) asm volatile("s_waitcnt lgkmcnt(" #n ")" ::: "memory")
#define PG8_BAR __builtin_amdgcn_s_barrier()
#define PG8_SCHED __builtin_amdgcn_sched_barrier(0)
#define PG8_ROWS(u, d0, d1) do { _Pragma("unroll") for (int _i = 0; _i < 2; ++_i) { const int _r0 = S.a_row(u, rA[_i]), _r1 = S.a_row(u, HALF + rA[_i]); \
        d0[_i] = (unsigned)_r0 * (unsigned)(lda * 2) + (unsigned)cA2[_i]; d1[_i] = (unsigned)_r1 * (unsigned)(lda * 2) + (unsigned)cA2[_i]; } } while (0)
    Unit cur, nxt; int ui = 0;
    if (!S.next(0, cur)) return;
    f32x4 acc[2][2][4][2];
#pragma unroll
    for (int a = 0; a < 2; ++a)
#pragma unroll
        for (int b = 0; b < 2; ++b)
#pragma unroll
            for (int m = 0; m < 4; ++m)
#pragma unroll
                for (int n = 0; n < 2; ++n) acc[a][b][m][n] = (f32x4){0.f, 0.f, 0.f, 0.f};
    typedef int v8i_ __attribute__((ext_vector_type(8))); typedef int v4i_ __attribute__((ext_vector_type(4)));
    bf16x8 At[4][2], B0[2][2], B1[2][2]; v8i_ At8[4], B08[2], B18[2];
    const int sclW = 0x7a7a7a7a, sclA = 0x7f7f7f7f;
    const char* cA = S.a_ptr(cur); const char* cB = S.b_ptr(cur);
    if constexpr (GATHER) { PG8_ROWS(cur, cv0, cv1); }
    if constexpr (SP2) {
        PG8_STAGE(PG8_SB(0, 0), cB, voffB); PG8_STAGE(PG8_SB(0, 1), cB + hstepB, voffB); PG8_STAGE_A(PG8_SA(0, 0), cA, 0, false); PG8_STAGE_A(PG8_SA(0, 1), cA, 1, false);
        if (wr == 1) PG8_BAR;
        PG8_WAIT_V(2); PG8_BAR;
        PG8_STAGE(PG8_SB(1, 0), cB + kstep, voffB); PG8_STAGE_A(PG8_SA(1, 0), cA + kstep, 0, false); PG8_STAGE(PG8_SB(1, 1), cB + hstepB + kstep, voffB);
        PG8_WAIT_V(6); PG8_BAR;
    } else {
        PG8_STAGE(PG8_SB(0, 0), cB, voffB); PG8_STAGE_A(PG8_SA(0, 0), cA, 0, false); PG8_STAGE(PG8_SB(0, 1), cB + hstepB, voffB); PG8_STAGE_A(PG8_SA(0, 1), cA, 1, false);
        if (wr == 1) PG8_BAR;
        PG8_WAIT_V(4); PG8_BAR;
        PG8_STAGE(PG8_SB(1, 0), cB + kstep, voffB); PG8_STAGE_A(PG8_SA(1, 0), cA + kstep, 0, false); PG8_STAGE(PG8_SB(1, 1), cB + hstepB + kstep, voffB);
        PG8_WAIT_V(6); PG8_BAR;
    }
    for (;;) {
        const bool has_next = S.next(ui + 1, nxt);
        const char* nA = has_next ? S.a_ptr(nxt) : cA; const char* nB = has_next ? S.b_ptr(nxt) : cB;
        if constexpr (GATHER) { if (has_next) { PG8_ROWS(nxt, nv0, nv1); } else { nv0[0] = cv0[0]; nv0[1] = cv0[1]; nv1[0] = cv1[0]; nv1[1] = cv1[1]; } }
        for (int t = 0; t < nt; t += 2) {
            const bool last = (t == nt - 2);
            const char* a1 = cA + (size_t)(t + 1) * kstep;
            const char* a2 = last ? nA : cA + (size_t)(t + 2) * kstep; const char* b2 = last ? nB : cB + (size_t)(t + 2) * kstep;
            const char* a3 = a2 + kstep; const char* b3 = b2 + kstep;
            if constexpr (SP2) {
            PG8_LDB(B0, 0, 0); PG8_LDB(B1, 0, 1); PG8_SCHED; PG8_LDA(At, 0, 0); PG8_STAGE_A(PG8_SA(1, 1), a1, 1, false);
            PG8_WAIT_V(8); PG8_WAIT_L(0); PG8_BAR; PG8_MMA(0, 0, At, B0); PG8_MMA(0, 1, At, B1); PG8_BAR; PG8_SCHED;
            PG8_LDA(At, 0, 1); PG8_STAGE(PG8_SB(0, 0), b2, voffB); PG8_STAGE(PG8_SB(0, 1), b2 + hstepB, voffB); PG8_STAGE_A(PG8_SA(0, 0), a2, 0, last);
            PG8_WAIT_V(8); PG8_WAIT_L(0); PG8_BAR; PG8_MMA(1, 0, At, B0); PG8_MMA(1, 1, At, B1); PG8_BAR; PG8_SCHED;
            PG8_LDB(B0, 1, 0); PG8_LDB(B1, 1, 1); PG8_SCHED; PG8_LDA(At, 1, 0); PG8_STAGE_A(PG8_SA(0, 1), a2, 1, last);
            PG8_WAIT_V(8); PG8_WAIT_L(0); PG8_BAR; PG8_MMA(0, 0, At, B0); PG8_MMA(0, 1, At, B1); PG8_BAR; PG8_SCHED;
            PG8_LDA(At, 1, 1); PG8_STAGE(PG8_SB(1, 0), b3, voffB); PG8_STAGE(PG8_SB(1, 1), b3 + hstepB, voffB); PG8_STAGE_A(PG8_SA(1, 0), a3, 0, last);
            PG8_WAIT_V(8); PG8_WAIT_L(0); PG8_BAR; PG8_MMA(1, 0, At, B0); PG8_MMA(1, 1, At, B1); PG8_BAR; PG8_SCHED;
            } else {
            PG8_LDB(B0, 0, 0); PG8_SCHED; PG8_LDA(At, 0, 0); PG8_STAGE_A(PG8_SA(1, 1), a1, 1, false);
            PG8_WAIT_L(8); PG8_BAR; PG8_WAIT_L(0); PG8_MMA(0, 0, At, B0); PG8_BAR; PG8_SCHED;
            PG8_LDB(B1, 0, 1); PG8_STAGE(PG8_SB(0, 0), b2, voffB);
            PG8_BAR; PG8_WAIT_L(0); PG8_MMA(0, 1, At, B1); PG8_BAR;
            PG8_LDA(At, 0, 1); PG8_STAGE_A(PG8_SA(0, 0), a2, 0, last);
            PG8_BAR; PG8_WAIT_L(0); PG8_MMA(1, 0, At, B0); PG8_BAR; PG8_SCHED;
            PG8_STAGE(PG8_SB(0, 1), b2 + hstepB, voffB);
            PG8_WAIT_V(6); PG8_BAR; PG8_MMA(1, 1, At, B1); PG8_BAR;
            PG8_LDB(B0, 1, 0); PG8_SCHED; PG8_LDA(At, 1, 0); PG8_STAGE_A(PG8_SA(0, 1), a2, 1, last);
            PG8_WAIT_L(8); PG8_BAR; PG8_WAIT_L(0); PG8_MMA(0, 0, At, B0); PG8_BAR; PG8_SCHED;
            PG8_LDB(B1, 1, 1); PG8_STAGE(PG8_SB(1, 0), b3, voffB);
            PG8_BAR; PG8_WAIT_L(0); PG8_MMA(0, 1, At, B1); PG8_BAR;
            PG8_LDA(At, 1, 1); PG8_STAGE_A(PG8_SA(1, 0), a3, 0, last);
            PG8_BAR; PG8_WAIT_L(0); PG8_MMA(1, 0, At, B0); PG8_BAR; PG8_SCHED;
            PG8_STAGE(PG8_SB(1, 1), b3 + hstepB, voffB);
            PG8_WAIT_V(6); PG8_BAR; PG8_MMA(1, 1, At, B1); PG8_BAR;
            }
        }
        if constexpr (ALIGN_EPI) { if (wr == 0) PG8_BAR; }
        if constexpr (FP8) asm volatile("s_nop 15\n\ts_nop 15" ::: "memory");
        E(acc, cur, wr, wc, fr, fq);
        if (!has_next) break;
#pragma unroll
        for (int a = 0; a < 2; ++a)
#pragma unroll
            for (int b = 0; b < 2; ++b)
#pragma unroll
                for (int m = 0; m < 4; ++m)
#pragma unroll
                    for (int n = 0; n < 2; ++n) acc[a][b][m][n] = (f32x4){0.f, 0.f, 0.f, 0.f};
        cur = nxt; cA = nA; cB = nB; ++ui;
        if constexpr (GATHER) { cv0[0] = nv0[0]; cv0[1] = nv0[1]; cv1[0] = nv1[0]; cv1[1] = nv1[1]; }
        if constexpr (ALIGN_EPI) { if (wr == 1) PG8_BAR; }
    }
    PG8_WAIT_V(0);
    if constexpr (!ALIGN_EPI) { if (wr == 0) PG8_BAR; }
    PG8_BAR;
#undef PG8_SA
#undef PG8_SB
#undef PG8_STAGE
#undef PG8_STAGE_A
#undef PG8_LDA
#undef PG8_LDB
#undef PG8_MMA
#undef PG8_WAIT_V
#undef PG8_WAIT_L
#undef PG8_BAR
#undef PG8_SCHED
#undef PG8_ROWS
}
}

using pg8::Unit;
struct SchedPlain : pg8::Order {
    const char* A; const char* B; size_t a_tile, b_tile;
    __device__ __forceinline__ bool next(int i, Unit& u) const { u.aux = 0; return tile(i, u.pm, u.pn); }
    __device__ __forceinline__ const char* a_ptr(const Unit& u) const { return A + (size_t)u.pm * a_tile; }
    __device__ __forceinline__ const char* b_ptr(const Unit& u) const { return B + (size_t)u.pn * b_tile; }
    __device__ __forceinline__ int a_row(const Unit&, int) const { return 0; }
};
struct SchedS5 : pg8::Order {
    const char* A; const char* B; size_t a_tile, b_tile, b_group;
    __device__ __forceinline__ bool next(int i, Unit& u) const { u.aux = 0; return tile(i, u.pm, u.pn); }
    __device__ __forceinline__ const char* a_ptr(const Unit& u) const { return A + (size_t)u.pm * a_tile; }
    __device__ __forceinline__ const char* b_ptr(const Unit& u) const { return B + (size_t)(u.pm >> 2) * b_group + (size_t)u.pn * b_tile; }
    __device__ __forceinline__ int a_row(const Unit&, int) const { return 0; }
};
template <bool GATHER> struct SchedMoe : pg8::Order {
    const char* A; const char* B; size_t a_tile, b_tile, b_exp; const LAS int* tile_e; int tile0, e0; const int* slot_tok; int row0;
    __device__ __forceinline__ bool next(int i, Unit& u) const { const bool ok = tile(i, u.pm, u.pn); u.aux = ok ? tile_e[tile0 + u.pm] : 0; return ok; }
    __device__ __forceinline__ const char* a_ptr(const Unit& u) const { return GATHER ? A : A + (size_t)u.pm * a_tile; }
    __device__ __forceinline__ const char* b_ptr(const Unit& u) const { return B + (size_t)(u.aux - e0) * b_exp + (size_t)u.pn * b_tile; }
    __device__ __forceinline__ int a_row(const Unit& u, int r) const { return slot_tok[row0 + u.pm * 256 + r]; }
};

__device__ __forceinline__ void st8(bf16* p, const f32x4 v0, const f32x4 v1) {
    u32x4 w; w.x = cvt_pk_bf16(v0[0], v0[1]); w.y = cvt_pk_bf16(v0[2], v0[3]); w.z = cvt_pk_bf16(v1[0], v1[1]); w.w = cvt_pk_bf16(v1[2], v1[3]); *(u32x4*)p = w;
}
__device__ __forceinline__ void ld8(const bf16* p, f32x4& v0, f32x4& v1) {
    const u32x4 w = *(const u32x4*)p; v0 = (f32x4){lo16(w.x), hi16(w.x), lo16(w.y), hi16(w.y)}; v1 = (f32x4){lo16(w.z), hi16(w.z), lo16(w.w), hi16(w.w)};
}
#define EPI_LOOP_AM _Pragma("unroll") for (int ai = 0; ai < 2; ++ai) _Pragma("unroll") for (int m = 0; m < 4; ++m)
#define EPI_ARGS const f32x4 (&acc)[2][2][4][2], const Unit& u, int wr, int wc, int fr, int fq

struct EpiProj { static constexpr bool PERM = true; bf16 *AG, *RKV, *LP;
    __device__ __forceinline__ void operator()(EPI_ARGS) const {
        const int row0 = u.pm * 256 + wr * 64 + fr;
        if (u.pn < 2) { const int col0 = u.pn * 256 + wc * 32 + 8 * fq;
            EPI_LOOP_AM { const int row = row0 + ai * 128 + m * 16;
#pragma unroll
                for (int bj = 0; bj < 2; ++bj) { const int c = col0 + bj * 128; st8(AG + ((size_t)((c >> 4) * 1024 + (row >> 5))) * 640 + (row & 31) * 16 + (c & 15), acc[ai][bj][m][0], acc[ai][bj][m][1]); } }
        } else {
            bf16* base; int ldc, c0;
            if (u.pn < 8) { base = RKV; ldc = 1536; c0 = (u.pn - 2) * 256; } else { base = LP; ldc = 512; c0 = (u.pn - 8) * 256; }
            const int col0 = c0 + wc * 32 + 8 * fq;
            EPI_LOOP_AM { bf16* rowp = base + (size_t)(row0 + ai * 128 + m * 16) * ldc + col0;
#pragma unroll
                for (int bj = 0; bj < 2; ++bj) st8(rowp + bj * 128, acc[ai][bj][m][0], acc[ai][bj][m][1]); }
        }
    }
};
struct EpiBf16Plain { static constexpr bool PERM = true; bf16* O; int ldc;
    __device__ __forceinline__ void operator()(EPI_ARGS) const {
        const int row0 = u.pm * 256 + wr * 64 + fr, col0 = u.pn * 256 + wc * 32 + 8 * fq;
        EPI_LOOP_AM { bf16* rowp = O + (size_t)(row0 + ai * 128 + m * 16) * ldc + col0;
#pragma unroll
            for (int bj = 0; bj < 2; ++bj) st8(rowp + bj * 128, acc[ai][bj][m][0], acc[ai][bj][m][1]); }
    }
};
struct EpiF32 { static constexpr bool PERM = false; float* C; int ldc;
    __device__ __forceinline__ void operator()(EPI_ARGS) const {
        const int row0 = u.pm * 256 + wr * 64 + fr, col0 = u.pn * 256 + wc * 32 + 4 * fq;
        EPI_LOOP_AM { float* rowp = C + (size_t)(row0 + ai * 128 + m * 16) * ldc + col0;
#pragma unroll
            for (int bj = 0; bj < 2; ++bj)
#pragma unroll
                for (int n = 0; n < 2; ++n) *(f32x4*)(rowp + bj * 128 + n * 16) = acc[ai][bj][m][n]; }
    }
};
struct EpiS5Y { static constexpr bool PERM = true; const bf16* AG; const float* dskip; bf16* Y1;
    __device__ __forceinline__ void operator()(EPI_ARGS) const {
        const int g = u.pm >> 2, crow0 = (u.pm & 3) * 256 + wr * 64 + fr, col0 = u.pn * 256 + wc * 32 + 8 * fq;
        EPI_LOOP_AM { const int crow = crow0 + ai * 128 + m * 16;
#pragma unroll
            for (int bj = 0; bj < 2; ++bj) { const int col = col0 + bj * 128, t = col >> 4, c = col & 15;
                f32x4 u0, u1; ld8(AG + ((size_t)(g * 1024 + crow)) * 640 + col, u0, u1);
                const f32x4 d0 = *(const f32x4*)(dskip + g * 16 + c), d1 = *(const f32x4*)(dskip + g * 16 + c + 4);
                f32x4 v0 = acc[ai][bj][m][0] + d0 * u0, v1 = acc[ai][bj][m][1] + d1 * u1;
#pragma unroll
                for (int j = 0; j < 4; ++j) { v0[j] = gelu_tanh(v0[j]); v1[j] = gelu_tanh(v1[j]); }
                st8(Y1 + (size_t)(crow * 32 + t) * 512 + g * 16 + c, v0, v1); } }
    }
};
struct EpiGlu { static constexpr bool PERM = true; const bf16* Y1; bf16* MIX;
    __device__ __forceinline__ void operator()(EPI_ARGS) const {
        const int row0 = u.pm * 256 + wr * 64 + fr, col0 = u.pn * 256 + wc * 32 + 8 * fq;
        EPI_LOOP_AM { const int row = row0 + ai * 128 + m * 16;
#pragma unroll
            for (int bj = 0; bj < 2; ++bj) { const int col = col0 + bj * 128; f32x4 y0, y1v; ld8(Y1 + (size_t)row * 512 + col, y0, y1v);
                f32x4 v0, v1;
#pragma unroll
                for (int j = 0; j < 4; ++j) { v0[j] = y0[j] * fsigmoid(acc[ai][bj][m][0][j]); v1[j] = y1v[j] * fsigmoid(acc[ai][bj][m][1][j]); }
                st8(MIX + (size_t)row * 1024 + col, v0, v1); } }
    }
};
struct EpiResid { static constexpr bool PERM = true; const float* X; bf16* O;
    __device__ __forceinline__ void operator()(EPI_ARGS) const {
        const int row0 = u.pm * 256 + wr * 64 + fr, col0 = u.pn * 256 + wc * 32 + 8 * fq;
        EPI_LOOP_AM { const size_t off = (size_t)(row0 + ai * 128 + m * 16) * 1024 + col0;
#pragma unroll
            for (int bj = 0; bj < 2; ++bj) { const f32x4 x0 = *(const f32x4*)(X + off + bj * 128), x1 = *(const f32x4*)(X + off + bj * 128 + 4); st8(O + off + bj * 128, x0 + acc[ai][bj][m][0], x1 + acc[ai][bj][m][1]); } }
    }
};
struct EpiGU { static constexpr bool PERM = true; unsigned char* ACT; const float* bg; const float* bu;
    __device__ __forceinline__ void operator()(EPI_ARGS) const {
        const int row0 = u.pm * 256 + wr * 64 + fr, col = u.pn * 128 + wc * 32 + 8 * fq; const int e = u.aux;
        const f32x4 g0 = *(const f32x4*)(bg + e * 1024 + col), g1 = *(const f32x4*)(bg + e * 1024 + col + 4), u0 = *(const f32x4*)(bu + e * 1024 + col), u1 = *(const f32x4*)(bu + e * 1024 + col + 4);
        EPI_LOOP_AM { f32x4 v0, v1;
#pragma unroll
            for (int j = 0; j < 4; ++j) {
                const float gt0 = fminf(acc[ai][0][m][0][j] + g0[j], 7.0f), up0 = fminf(fmaxf(acc[ai][1][m][0][j] + u0[j], -7.0f), 7.0f);
                const float gt1 = fminf(acc[ai][0][m][1][j] + g1[j], 7.0f), up1 = fminf(fmaxf(acc[ai][1][m][1][j] + u1[j], -7.0f), 7.0f);
                v0[j] = (up0 + 1.0f) * gt0 * fsigmoid(1.702f * gt0); v1[j] = (up1 + 1.0f) * gt1 * fsigmoid(1.702f * gt1); }
            u32x2 w; w.x = pk4_fp8(v0[0], v0[1], v0[2], v0[3]); w.y = pk4_fp8(v1[0], v1[1], v1[2], v1[3]); *(u32x2*)(ACT + (size_t)(row0 + ai * 128 + m * 16) * 1024 + col) = w; }
    }
};
struct EpiDown { static constexpr bool PERM = true; unsigned char* Y; const float* bd;
    __device__ __forceinline__ void operator()(EPI_ARGS) const {
        const int row0 = u.pm * 256 + wr * 64 + fr, col0 = u.pn * 256 + wc * 32 + 8 * fq; const int e = u.aux;
        EPI_LOOP_AM { unsigned char* rowp = Y + (size_t)(row0 + ai * 128 + m * 16) * 1024 + col0;
#pragma unroll
            for (int bj = 0; bj < 2; ++bj) { const f32x4 b0 = *(const f32x4*)(bd + e * 1024 + col0 + bj * 128), b1 = *(const f32x4*)(bd + e * 1024 + col0 + bj * 128 + 4);
                const f32x4 v0 = acc[ai][bj][m][0] + b0, v1 = acc[ai][bj][m][1] + b1; u32x2 w; w.x = pk4_fp8(v0[0], v0[1], v0[2], v0[3]); w.y = pk4_fp8(v1[0], v1[1], v1[2], v1[3]); *(u32x2*)(rowp + bj * 128) = w; } }
    }
};
struct EpiPle { static constexpr bool PERM = true; const bf16* PP; bf16* O;
    __device__ __forceinline__ void operator()(EPI_ARGS) const {
        const int row0 = u.pm * 256 + wr * 64 + fr, col0 = u.pn * 256 + wc * 32 + 8 * fq;
        EPI_LOOP_AM { const size_t off = (size_t)(row0 + ai * 128 + m * 16) * 1024 + col0;
#pragma unroll
            for (int bj = 0; bj < 2; ++bj) { f32x4 p0, p1, x0, x1; ld8(PP + off + bj * 128, p0, p1); ld8(O + off + bj * 128, x0, x1);
#pragma unroll
                for (int j = 0; j < 4; ++j) { x0[j] += p0[j] * fsigmoid(acc[ai][bj][m][0][j]); x1[j] += p1[j] * fsigmoid(acc[ai][bj][m][1][j]); }
                st8(O + off + bj * 128, x0, x1); } }
    }
};

struct Ctx { LAS unsigned char* lds; int tid, lane, wave, G, wg, gw, NGW; };

template <int NBW>
__device__ __forceinline__ void transpose_item(const float* W, int N, int k0, int n0, bf16* dst, int ldk, const float* scl, int flip, LAS float* scr, int lane) {
    constexpr int LPR = NBW / 4, RPI = 64 / LPR, NI = 64 / RPI;
    const int rr = lane / LPR, cc = (lane % LPR) * 4;
    f32x4 v[NI];
#pragma unroll
    for (int i = 0; i < NI; ++i) v[i] = *(const f32x4*)(W + (size_t)(k0 + i * RPI + rr) * N + n0 + cc);
#pragma unroll
    for (int i = 0; i < NI; ++i) { const int kk = i * RPI + rr; f32x4 x = v[i];
        if (scl) { const float s0 = scl[k0 + kk]; const float f = flip ? (1.0f - s0) : s0; x = x * f; }
        LAS float* d = scr + kk * 65 + cc; d[0] = x.x; d[1] = x.y; d[2] = x.z; d[3] = x.w; }
    LDS_WAIT(); asm volatile("" ::: "memory");
    const int c = lane & 7;
#pragma unroll
    for (int j = 0; j < NBW / 8; ++j) { const int n = (lane >> 3) + 8 * j; const LAS float* s = scr + (8 * c) * 65 + n;
        u32x4 o; o.x = pk2(s[0 * 65], s[1 * 65]); o.y = pk2(s[2 * 65], s[3 * 65]); o.z = pk2(s[4 * 65], s[5 * 65]); o.w = pk2(s[6 * 65], s[7 * 65]);
        *(u32x4*)(dst + (size_t)n * ldk + 8 * c) = o; }
    LDS_WAIT(); asm volatile("" ::: "memory");
}
__device__ __forceinline__ void transpose_item_fp8(const float* W, int N, int k0, int n0, unsigned char* dst, int ldk, float scale, LAS float* scr, int lane) {
    const int rr = lane >> 4, cc = (lane & 15) * 4;
    f32x4 v[16];
#pragma unroll
    for (int i = 0; i < 16; ++i) v[i] = *(const f32x4*)(W + (size_t)(k0 + i * 4 + rr) * N + n0 + cc);
#pragma unroll
    for (int i = 0; i < 16; ++i) { const int kk = i * 4 + rr; LAS float* d = scr + kk * 65 + cc; d[0] = v[i].x * scale; d[1] = v[i].y * scale; d[2] = v[i].z * scale; d[3] = v[i].w * scale; }
    LDS_WAIT(); asm volatile("" ::: "memory");
    const int c = lane & 3;
#pragma unroll
    for (int j = 0; j < 4; ++j) { const int n = (lane >> 2) + 16 * j; const LAS float* s = scr + (16 * c) * 65 + n;
        u32x4 o; o.x = pk4_fp8(s[0 * 65], s[1 * 65], s[2 * 65], s[3 * 65]); o.y = pk4_fp8(s[4 * 65], s[5 * 65], s[6 * 65], s[7 * 65]); o.z = pk4_fp8(s[8 * 65], s[9 * 65], s[10 * 65], s[11 * 65]); o.w = pk4_fp8(s[12 * 65], s[13 * 65], s[14 * 65], s[15 * 65]);
        *(u32x4*)(dst + (size_t)n * ldk + 16 * c) = o; }
    LDS_WAIT(); asm volatile("" ::: "memory");
}
__device__ __forceinline__ void transpose_matrix(const Ctx& cx, const float* W, int K, int N, bf16* WT, int row_off, int ldk, int koff, const float* scl, int flip) {
    LAS float* scr = (LAS float*)(cx.lds + cx.wave * 16640);
    const int nblk = N / 64, nitems = (K / 64) * nblk;
    for (int it = cx.gw; it < nitems; it += cx.NGW) { const int kb = it / nblk, nb = it % nblk;
        transpose_item<64>(W, N, 64 * kb, 64 * nb, WT + (size_t)(row_off + 64 * nb) * ldk + koff + 64 * kb, ldk, scl, flip, scr, cx.lane); }
}
__device__ __forceinline__ void rms_row_to_bf16(const float* xrow, const float* g, bf16* orow, int lane) {
    const f32x4* xr = (const f32x4*)xrow + lane; const f32x4* gr = (const f32x4*)g + lane;
    f32x4 v[4]; float s = 0.f;
#pragma unroll
    for (int j = 0; j < 4; ++j) { v[j] = xr[64 * j]; s += (v[j].x * v[j].x + v[j].y * v[j].y) + (v[j].z * v[j].z + v[j].w * v[j].w); }
    const float rinv = rsqrtf(wave_sum(s) * (1.f / 1024.f) + 1e-6f);
    u32x2* o8 = (u32x2*)orow + lane;
#pragma unroll
    for (int j = 0; j < 4; ++j) { const f32x4 gg = gr[64 * j]; u32x2 w; w.x = pk2(v[j].x * rinv * gg.x, v[j].y * rinv * gg.y); w.y = pk2(v[j].z * rinv * gg.z, v[j].w * rinv * gg.w); o8[64 * j] = w; }
}

__device__ __forceinline__ void rms_rows2_to_bf16(const float* xa, const float* xb, const float* g, bf16* oa, bf16* ob, int lane) {
    const f32x4* ra = (const f32x4*)xa + lane; const f32x4* rb = (const f32x4*)xb + lane; const f32x4* gr = (const f32x4*)g + lane;
    f32x4 va[4], vb[4]; float sa = 0.f, sb = 0.f;
#pragma unroll
    for (int j = 0; j < 4; ++j) { va[j] = ra[64 * j]; vb[j] = rb[64 * j]; }
#pragma unroll
    for (int j = 0; j < 4; ++j) { sa += (va[j].x * va[j].x + va[j].y * va[j].y) + (va[j].z * va[j].z + va[j].w * va[j].w); sb += (vb[j].x * vb[j].x + vb[j].y * vb[j].y) + (vb[j].z * vb[j].z + vb[j].w * vb[j].w); }
#pragma unroll
    for (int o = 1; o < 64; o <<= 1) { sa += __shfl_xor(sa, o); sb += __shfl_xor(sb, o); }
    const float ia = rsqrtf(sa * (1.f / 1024.f) + 1e-6f), ib = rsqrtf(sb * (1.f / 1024.f) + 1e-6f);
    u32x2* pa = (u32x2*)oa + lane; u32x2* pb = (u32x2*)ob + lane;
#pragma unroll
    for (int j = 0; j < 4; ++j) { const f32x4 gg = gr[64 * j]; u32x2 w; w.x = pk2(va[j].x * ia * gg.x, va[j].y * ia * gg.y); w.y = pk2(va[j].z * ia * gg.z, va[j].w * ia * gg.w); pa[64 * j] = w;
        w.x = pk2(vb[j].x * ib * gg.x, vb[j].y * ib * gg.y); w.y = pk2(vb[j].z * ib * gg.z, vb[j].w * ib * gg.w); pb[64 * j] = w; }
}

__device__ __forceinline__ void s5_tables_item(const Ctx& cx, int g, int part, const float* lam_re, const float* lam_im, const float* log_dt, const float* b_re, const float* b_im, const float* c_re, const float* c_im,
                                               bf16* BT, bf16* ET, float* AT) {
    LAS float* apr = (LAS float*)cx.lds; LAS float* api = apr + 33 * 64; LAS float* bbr = api + 33 * 64; LAS float* bbi = bbr + 1024; LAS float* cr = bbi + 1024; LAS float* ci = cr + 1024; LAS float* kt = ci + 1024;
    const int tid = cx.tid;
    const float dt = __expf(log_dt[g]);
    for (int idx = tid; idx < 33 * 64; idx += NTHR) { const int j = idx >> 6, p = idx & 63;
        const float lre = fminf(lam_re[g * 64 + p], -1e-4f), lim = lam_im[g * 64 + p];
        const float mag = expf(lre * dt * (float)j), ang = lim * dt * (float)j; float sn, cs; sincosf(ang, &sn, &cs);
        apr[idx] = mag * cs; api[idx] = mag * sn; }
    for (int idx = tid; idx < 1024; idx += NTHR) { const int p = idx >> 4;
        const float lre = fminf(lam_re[g * 64 + p], -1e-4f), lim = lam_im[g * 64 + p];
        const float mag = expf(lre * dt); float sn, cs; sincosf(lim * dt, &sn, &cs); const float lbr = mag * cs, lbi = mag * sn;
        const float den = lre * lre + lim * lim, zr = lbr - 1.0f; const float cor = (zr * lre + lbi * lim) / den, coi = (lbi * lre - zr * lim) / den;
        const float br = b_re[g * 1024 + idx], bi = b_im[g * 1024 + idx];
        bbr[idx] = cor * br - coi * bi; bbi[idx] = cor * bi + coi * br;
        cr[idx] = c_re[g * 1024 + idx]; ci[idx] = c_im[g * 1024 + idx]; }
    __syncthreads();
    if (tid < 64) { const int jl = tid >> 4, c = tid & 15, j = 4 * part + jl; float acc[16];
#pragma unroll
        for (int i = 0; i < 16; ++i) acc[i] = 0.f;
        for (int p = 0; p < 64; ++p) { const float ar = apr[j * 64 + p], ai = api[j * 64 + p], xr = cr[c * 64 + p], xi = ci[c * 64 + p];
            const float car = xr * ar - xi * ai, cai = xr * ai + xi * ar;
#pragma unroll
            for (int v4 = 0; v4 < 4; ++v4) { const f32x4 br = *(const LAS f32x4*)(bbr + p * 16 + 4 * v4), bi = *(const LAS f32x4*)(bbi + p * 16 + 4 * v4);
                acc[4 * v4 + 0] += car * br.x - cai * bi.x; acc[4 * v4 + 1] += car * br.y - cai * bi.y; acc[4 * v4 + 2] += car * br.z - cai * bi.z; acc[4 * v4 + 3] += car * br.w - cai * bi.w; } }
#pragma unroll
        for (int i = 0; i < 16; ++i) kt[jl * 256 + c * 16 + i] = acc[i]; }
    __syncthreads();
    bf16* BTg = BT + (size_t)g * 512 * 640; bf16* ETg = ET + (size_t)g * 256 * 512;
    for (int idx = tid; idx < 4096; idx += NTHR) { const int hf = idx & 1, c = (idx >> 1) & 15, t = (idx >> 5) & 31, jl = idx >> 10, j = 4 * part + jl;
        if (t >= j) { const LAS float* s = kt + jl * 256 + c * 16 + hf * 8; u32x4 o; o.x = pk2(s[0], s[1]); o.y = pk2(s[2], s[3]); o.z = pk2(s[4], s[5]); o.w = pk2(s[6], s[7]);
            *(u32x4*)(BTg + (size_t)(t * 16 + c) * 640 + (t - j) * 16 + hf * 8) = o; } }
    for (int idx = tid; idx < 4096; idx += NTHR) { const int hf = idx & 1, c = (idx >> 1) & 15, s = (idx >> 5) & 31, t = 4 * part + (idx >> 10);
        if (s > t) *(u32x4*)(BTg + (size_t)(t * 16 + c) * 640 + s * 16 + hf * 8) = (u32x4){0u, 0u, 0u, 0u}; }
    for (int idx = tid; idx < 1024; idx += NTHR) { const int ch = idx & 15, c = (idx >> 4) & 15, t = 4 * part + (idx >> 8); const int im = ch >> 3, p0 = (ch & 7) * 8; float v[8];
#pragma unroll
        for (int q = 0; q < 8; ++q) { const int p = p0 + q; const float ar = apr[(t + 1) * 64 + p], ai = api[(t + 1) * 64 + p], xr = cr[c * 64 + p], xi = ci[c * 64 + p];
            v[q] = im ? -(xr * ai + xi * ar) : (xr * ar - xi * ai); }
        u32x4 o; o.x = pk2(v[0], v[1]); o.y = pk2(v[2], v[3]); o.z = pk2(v[4], v[5]); o.w = pk2(v[6], v[7]);
        *(u32x4*)(BTg + (size_t)(t * 16 + c) * 640 + 512 + im * 64 + p0) = o; }
    for (int idx = tid; idx < 1024; idx += NTHR) { const int hf = idx & 1, sl = (idx >> 1) & 3, n = idx >> 3, s = 4 * part + sl, p = n & 63, im = n >> 6; float v[8];
        const float ar = apr[(31 - s) * 64 + p], ai = api[(31 - s) * 64 + p];
#pragma unroll
        for (int q = 0; q < 8; ++q) { const float br = bbr[p * 16 + hf * 8 + q], bi = bbi[p * 16 + hf * 8 + q]; v[q] = im ? (ar * bi + ai * br) : (ar * br - ai * bi); }
        u32x4 o; o.x = pk2(v[0], v[1]); o.y = pk2(v[2], v[3]); o.z = pk2(v[4], v[5]); o.w = pk2(v[6], v[7]);
        *(u32x4*)(ETg + (size_t)n * 512 + s * 16 + hf * 8) = o; }
    for (int idx = tid; idx < 1024; idx += NTHR) { const int ch = idx & 63, r = 128 + 16 * part + (idx >> 6); *(u32x4*)(ETg + (size_t)r * 512 + ch * 8) = (u32x4){0u, 0u, 0u, 0u}; }
    if (part == 0 && tid < 64) { AT[(g * 64 + tid) * 2] = apr[32 * 64 + tid]; AT[(g * 64 + tid) * 2 + 1] = api[32 * 64 + tid]; }
    __syncthreads();
}

constexpr int IMG_LD = 80, IMG_B = 64 * IMG_LD * 2;
#define IMG(k) ((LAS bf16*)(lds + (k) * IMG_B))
#define LDS_BARRIER() do { asm volatile("s_waitcnt lgkmcnt(0)" ::: "memory"); __builtin_amdgcn_s_barrier(); asm volatile("" ::: "memory"); } while (0)
struct MmCtx { int tr, tc0, l15, q; };
__device__ __forceinline__ void mm64(const LAS bf16* A, const LAS bf16* Bt, f32x4 (&acc)[2], const MmCtx& w) {
#pragma unroll
    for (int s = 0; s < 2; ++s) {
        const bf16x8 a = *(const LAS bf16x8*)(A + (16 * w.tr + w.l15) * IMG_LD + 32 * s + 8 * w.q);
#pragma unroll
        for (int c = 0; c < 2; ++c) { const bf16x8 b = *(const LAS bf16x8*)(Bt + (16 * (w.tc0 + c) + w.l15) * IMG_LD + 32 * s + 8 * w.q);
            acc[c] = __builtin_amdgcn_mfma_f32_16x16x32_bf16(a, b, acc[c], 0, 0, 0); }
    }
}
__device__ __forceinline__ void mm64_2a(const LAS bf16* A1, const LAS bf16* A2, const LAS bf16* Bt, f32x4 (&acc1)[2], f32x4 (&acc2)[2], const MmCtx& w) {
#pragma unroll
    for (int s = 0; s < 2; ++s) {
        const bf16x8 a1 = *(const LAS bf16x8*)(A1 + (16 * w.tr + w.l15) * IMG_LD + 32 * s + 8 * w.q), a2 = *(const LAS bf16x8*)(A2 + (16 * w.tr + w.l15) * IMG_LD + 32 * s + 8 * w.q);
#pragma unroll
        for (int c = 0; c < 2; ++c) { const bf16x8 b = *(const LAS bf16x8*)(Bt + (16 * (w.tc0 + c) + w.l15) * IMG_LD + 32 * s + 8 * w.q);
            acc1[c] = __builtin_amdgcn_mfma_f32_16x16x32_bf16(a1, b, acc1[c], 0, 0, 0); acc2[c] = __builtin_amdgcn_mfma_f32_16x16x32_bf16(a2, b, acc2[c], 0, 0, 0); }
    }
}
__device__ __forceinline__ void mm64_2b(const LAS bf16* A, const LAS bf16* Bt1, const LAS bf16* Bt2, f32x4 (&acc1)[2], f32x4 (&acc2)[2], const MmCtx& w) {
#pragma unroll
    for (int s = 0; s < 2; ++s) {
        const bf16x8 a = *(const LAS bf16x8*)(A + (16 * w.tr + w.l15) * IMG_LD + 32 * s + 8 * w.q);
#pragma unroll
        for (int c = 0; c < 2; ++c) { const bf16x8 b1 = *(const LAS bf16x8*)(Bt1 + (16 * (w.tc0 + c) + w.l15) * IMG_LD + 32 * s + 8 * w.q), b2 = *(const LAS bf16x8*)(Bt2 + (16 * (w.tc0 + c) + w.l15) * IMG_LD + 32 * s + 8 * w.q);
            acc1[c] = __builtin_amdgcn_mfma_f32_16x16x32_bf16(a, b1, acc1[c], 0, 0, 0); acc2[c] = __builtin_amdgcn_mfma_f32_16x16x32_bf16(a, b2, acc2[c], 0, 0, 0); }
    }
}
__device__ __forceinline__ float dpp_x1(float v) { return __int_as_float(__builtin_amdgcn_update_dpp(0, __float_as_int(v), 0xB1, 0xF, 0xF, true)); }
__device__ __forceinline__ float dpp_x2(float v) { return __int_as_float(__builtin_amdgcn_update_dpp(0, __float_as_int(v), 0x4E, 0xF, 0xF, true)); }
__device__ __forceinline__ f32x4 quad_transpose(const f32x4 v, int b) {
    const bool odd = (b & 1) != 0, hi = (b & 2) != 0;
    const float r0 = dpp_x1(odd ? v[0] : v[1]), r1 = dpp_x1(odd ? v[2] : v[3]);
    const float p0a = odd ? r0 : v[0], p0b = odd ? v[1] : r0, p1a = odd ? r1 : v[2], p1b = odd ? v[3] : r1;
    const float ra = dpp_x2(hi ? p0a : p1a), rb = dpp_x2(hi ? p0b : p1b);
    return hi ? (f32x4){ra, rb, p1a, p1b} : (f32x4){p0a, p0b, ra, rb};
}
__device__ __forceinline__ void st_rm(LAS bf16* img, const f32x4 v, int tr, int tc, const MmCtx& w) {
    const unsigned p01 = pk2(v[0], v[1]), p23 = pk2(v[2], v[3]); LAS bf16* d = img + (16 * tr + 4 * w.q) * IMG_LD + 16 * tc + w.l15;
    d[0] = (bf16)p01; d[IMG_LD] = (bf16)(p01 >> 16); d[2 * IMG_LD] = (bf16)p23; d[3 * IMG_LD] = (bf16)(p23 >> 16);
}
__device__ __forceinline__ void st_tr(LAS bf16* img, const f32x4 v, int tr, int tc, const MmCtx& w) {
    u32x2 o; o.x = pk2(v[0], v[1]); o.y = pk2(v[2], v[3]); *(LAS u32x2*)(img + (16 * tc + w.l15) * IMG_LD + 16 * tr + 4 * w.q) = o;
}
__device__ __forceinline__ void img_to_global(const LAS bf16* img, bf16* g, int tid) { const int row = tid >> 3, ch = tid & 7; *(u32x4*)(g + row * 64 + ch * 8) = *(const LAS u32x4*)(img + row * IMG_LD + ch * 8); }
__device__ __forceinline__ void st_tm8(LAS bf16* img, int t, int cg, const float (&v)[8]) {
    u32x4 o; o.x = pk2(v[0], v[1]); o.y = pk2(v[2], v[3]); o.z = pk2(v[4], v[5]); o.w = pk2(v[6], v[7]); *(LAS u32x4*)(img + t * IMG_LD + 8 * cg) = o;
}
__device__ __forceinline__ void st_cm8(LAS bf16* img, int t, int cg, const float (&v)[8]) {
#pragma unroll
    for (int i = 0; i < 8; i += 2) { const unsigned p = pk2(v[i], v[i + 1]); img[(8 * cg + i) * IMG_LD + t] = (bf16)p; img[(8 * cg + i + 1) * IMG_LD + t] = (bf16)(p >> 16); }
}
__device__ __forceinline__ float red8(float v) { v += __shfl_xor(v, 1); v += __shfl_xor(v, 2); v += __shfl_xor(v, 4); return v; }
__device__ __forceinline__ void unpack8(const u32x4 w, float (&o)[8]) { o[0] = lo16(w.x); o[1] = hi16(w.x); o[2] = lo16(w.y); o[3] = hi16(w.y); o[4] = lo16(w.z); o[5] = hi16(w.z); o[6] = lo16(w.w); o[7] = hi16(w.w); }
__device__ __forceinline__ void ldp8(const float* p, float (&o)[8]) { const f32x4 a = *(const f32x4*)p, b = *(const f32x4*)(p + 4); o[0] = a.x; o[1] = a.y; o[2] = a.z; o[3] = a.w; o[4] = b.x; o[5] = b.y; o[6] = b.z; o[7] = b.w; }

struct RwkvP { const bf16* rkv; const bf16* wag; const float *mu_rkv, *w0, *a0, *k_k, *k_a, *r_k, *ln_w, *ln_b; };
struct RwkvRaw { u32x4 kc, kp, vc, vp, wl, al, rc, rp, gg; };
template <bool PASS3>
__device__ __forceinline__ void rwkv_load(const RwkvP& P, int cidx, int tid, RwkvRaw& R) {
    const int t = tid >> 3, cg = tid & 7, bh = cidx >> 7, c = cidx & 127, b = bh >> 3, h = bh & 7, ch = h * 64 + 8 * cg;
    const size_t tok = (size_t)b * SEQ + c * 64 + t; const bool first = (c == 0 && t == 0);
    const bf16* row = P.rkv + tok * 1536 + ch; const bf16* prow = first ? row : row - 1536;
    R.kc = *(const u32x4*)(row + 512); R.vc = *(const u32x4*)(row + 1024); R.kp = *(const u32x4*)(prow + 512); R.vp = *(const u32x4*)(prow + 1024);
    R.wl = *(const u32x4*)(P.wag + tok * 1536 + ch); R.al = *(const u32x4*)(P.wag + tok * 1536 + 512 + ch);
    if (PASS3) { R.rc = *(const u32x4*)row; R.rp = *(const u32x4*)prow; R.gg = *(const u32x4*)(P.wag + tok * 1536 + 1024 + ch); }
}
struct RwkvC { float mu_r[8], mu_k[8], mu_v[8], w0[8], a0[8], kk[8], ka[8]; };
__device__ __forceinline__ void rwkv_consts(const RwkvP& P, int h, int cg, RwkvC& C) { const int ch = h * 64 + 8 * cg;
    ldp8(P.mu_rkv + ch, C.mu_r); ldp8(P.mu_rkv + 512 + ch, C.mu_k); ldp8(P.mu_rkv + 1024 + ch, C.mu_v); ldp8(P.w0 + ch, C.w0); ldp8(P.a0 + ch, C.a0); ldp8(P.k_k + ch, C.kk); ldp8(P.k_a + ch, C.ka); }
template <bool PASS3>
__device__ __forceinline__ void rwkv_prep(const RwkvRaw& R, const RwkvC& C, bool first, float (&kq)[8], float (&vv)[8], float (&rr)[8], float (&kap)[8], float (&bet)[8], float (&lw)[8]) {
    float kc[8], kp[8], vc[8], vp[8], k[8], wl[8], al[8], a[8];
    unpack8(R.kc, kc); unpack8(R.vc, vc); unpack8(R.kp, kp); unpack8(R.vp, vp); unpack8(R.wl, wl); unpack8(R.al, al);
    const float pm = first ? 0.f : 1.f;
#pragma unroll
    for (int i = 0; i < 8; ++i) { k[i] = kc[i] + (pm * kp[i] - kc[i]) * C.mu_k[i]; vv[i] = vc[i] + (pm * vp[i] - vc[i]) * C.mu_v[i]; }
    if (PASS3) { float rc[8], rp[8]; unpack8(R.rc, rc); unpack8(R.rp, rp);
#pragma unroll
        for (int i = 0; i < 8; ++i) rr[i] = rc[i] + (pm * rp[i] - rc[i]) * C.mu_r[i];
    } else {
#pragma unroll
        for (int i = 0; i < 8; ++i) rr[i] = 0.f;
    }
    float ss = 0.f;
#pragma unroll
    for (int i = 0; i < 8; ++i) { lw[i] = -0.6065306597126334f * fsigmoid(C.w0[i] + wl[i]); a[i] = fsigmoid(C.a0[i] + al[i]); kap[i] = k[i] * C.kk[i]; ss += kap[i] * kap[i]; }
    ss = red8(ss);
    const float inv = 1.0f / fmaxf(sqrtf(ss), 1e-12f);
#pragma unroll
    for (int i = 0; i < 8; ++i) { kap[i] *= inv; bet[i] = kap[i] * a[i]; kq[i] = k[i] * (1.0f + (a[i] - 1.0f) * C.ka[i]); }
}
template <int SEGSLOT>
__device__ __forceinline__ void rwkv_cumsum(LAS unsigned char* lds, int tid, const float (&lw)[8], float (&cum)[8], float (&cumL)[8]) {
    LAS float* LW = (LAS float*)(lds + 12 * IMG_B); LAS float* SEG = (LAS float*)(lds + SEGSLOT * IMG_B);
    const int t = tid >> 3, cg = tid & 7, j = tid & 63, seg = tid >> 6;
#pragma unroll
    for (int i = 0; i < 8; ++i) LW[t * 65 + 8 * cg + i] = lw[i];
    LDS_BARRIER();
    { float run = 0.f;
#pragma unroll
      for (int tt = 0; tt < 8; ++tt) { const int idx = (8 * seg + tt) * 65 + j; run += LW[idx]; LW[idx] = run; }
      SEG[seg * 64 + j] = run; }
    LDS_BARRIER();
    { float pre = 0.f;
#pragma unroll
      for (int s2 = 0; s2 < 8; ++s2) { const float x = SEG[s2 * 64 + j]; pre += (s2 < seg) ? x : 0.f; }
#pragma unroll
      for (int tt = 0; tt < 8; ++tt) LW[(8 * seg + tt) * 65 + j] += pre; }
    LDS_BARRIER();
#pragma unroll
    for (int i = 0; i < 8; ++i) { cum[i] = LW[t * 65 + 8 * cg + i]; cumL[i] = LW[63 * 65 + 8 * cg + i]; }
}
#define Z4 (f32x4){0.f, 0.f, 0.f, 0.f}

__device__ __forceinline__ void rwkv_pass1(LAS unsigned char* lds, const RwkvP& P, int c0, int n, int tid, bf16* QCT, float* HCT, bf16* W1G, bf16* ULG, float* DLG) {
    const int lane = tid & 63, wv = __builtin_amdgcn_readfirstlane(tid >> 6); MmCtx w; w.tr = wv >> 1; w.tc0 = (wv & 1) * 2; w.l15 = lane & 15; w.q = lane >> 4;
    const int t = tid >> 3, cg = tid & 7;
    RwkvC C; rwkv_consts(P, (c0 >> 7) & 7, cg, C);
    RwkvRaw R; rwkv_load<false>(P, c0, tid, R);
    for (int ci = 0; ci < n; ++ci) {
        const int cidx = c0 + ci;
        {
            float kq[8], vv[8], rr[8], kap[8], bet[8], lw[8], cum[8], cumL[8];
            rwkv_prep<false>(R, C, (cidx & 127) == 0 && t == 0, kq, vv, rr, kap, bet, lw);
            if (ci + 1 < n) rwkv_load<false>(P, cidx + 1, tid, R);
            rwkv_cumsum<11>(lds, tid, lw, cum, cumL);
            float x[8], y[8];
#pragma unroll
            for (int i = 0; i < 8; ++i) { const float en = __expf(-cum[i]); x[i] = kq[i] * en; y[i] = bet[i] * en; }
            st_tm8(IMG(0), t, cg, x);
            st_tm8(IMG(1), t, cg, y);
#pragma unroll
            for (int i = 0; i < 8; ++i) x[i] = kap[i] * __expf(cum[i] - lw[i]);
            st_tm8(IMG(2), t, cg, x);
            st_cm8(IMG(3), t, cg, x);
#pragma unroll
            for (int i = 0; i < 8; ++i) { const float eh = __expf(cumL[i] - cum[i]); x[i] = kq[i] * eh; y[i] = bet[i] * eh; }
            st_cm8(IMG(4), t, cg, x);
            st_cm8(IMG(5), t, cg, y);
            st_cm8(IMG(6), t, cg, vv);
            if (t == 0) {
#pragma unroll
                for (int i = 0; i < 8; ++i) DLG[(size_t)cidx * 64 + 8 * cg + i] = __expf(cumL[i]);
            }
        }
        LDS_BARRIER();
        f32x4 accX[2];
        {
            f32x4 a[2] = {Z4, Z4}, kk[2] = {Z4, Z4};
            mm64_2a(IMG(1), IMG(0), IMG(2), a, kk, w);
#pragma unroll
            for (int c = 0; c < 2; ++c) { const int nn = 16 * (w.tc0 + c) + w.l15;
#pragma unroll
                for (int r = 0; r < 4; ++r) { const int m = 16 * w.tr + 4 * w.q + r; a[c][r] = (m < nn) ? a[c][r] : 0.f; kk[c][r] = (m < nn) ? kk[c][r] : 0.f; accX[c][r] = ((m == nn) ? 1.0f : 0.f) - a[c][r]; }
                st_rm(IMG(7), a[c], w.tr, w.tc0 + c, w); st_tr(IMG(8), a[c], w.tr, w.tc0 + c, w); st_rm(IMG(10), accX[c], w.tr, w.tc0 + c, w); st_rm(IMG(9), kk[c], w.tr, w.tc0 + c, w); }
        }
        LDS_BARRIER();
        {
            f32x4 p[2] = {Z4, Z4};
            mm64(IMG(7), IMG(8), p, w);
#pragma unroll
            for (int c = 0; c < 2; ++c) { st_rm(IMG(12), p[c], w.tr, w.tc0 + c, w); st_tr(IMG(13), p[c], w.tr, w.tc0 + c, w); }
        }
        LDS_BARRIER();
#define NEUMANN(XC, XN, PC, PTC, PN, PTN, LASTR) do { if (LASTR) mm64(IMG(XC), IMG(PTC), accX, w); \
            if (!(LASTR)) { f32x4 p[2] = {Z4, Z4}; mm64_2a(IMG(XC), IMG(PC), IMG(PTC), accX, p, w); \
                _Pragma("unroll") for (int c = 0; c < 2; ++c) { st_rm(IMG(PN), p[c], w.tr, w.tc0 + c, w); st_tr(IMG(PTN), p[c], w.tr, w.tc0 + c, w); st_rm(IMG(XN), accX[c], w.tr, w.tc0 + c, w); } } \
            LDS_BARRIER(); } while (0)
        NEUMANN(10, 11, 12, 13, 0, 1, false);
        NEUMANN(11, 10, 0, 1, 12, 13, false);
        NEUMANN(10, 11, 12, 13, 0, 1, false);
        NEUMANN(11, 10, 0, 1, 12, 13, false);
        NEUMANN(10, 11, 12, 13, 0, 1, true);
#undef NEUMANN
#pragma unroll
        for (int c = 0; c < 2; ++c) st_tr(IMG(7), accX[c], w.tr, w.tc0 + c, w);
        LDS_BARRIER();
        {
            f32x4 a[2] = {Z4, Z4}, g[2] = {Z4, Z4};
            mm64_2a(IMG(3), IMG(9), IMG(7), a, g, w);
#pragma unroll
            for (int c = 0; c < 2; ++c) { st_rm(IMG(12), a[c], w.tr, w.tc0 + c, w); st_tr(IMG(2), a[c], w.tr, w.tc0 + c, w); st_tr(IMG(8), g[c], w.tr, w.tc0 + c, w); }
        }
        LDS_BARRIER();
        {
            f32x4 u[2] = {Z4, Z4}, qc[2] = {Z4, Z4};
            mm64(IMG(6), IMG(8), u, w); mm64(IMG(5), IMG(12), qc, w);
#pragma unroll
            for (int c = 0; c < 2; ++c) { st_rm(IMG(13), u[c], w.tr, w.tc0 + c, w);
                const int tc = w.tc0 + c, cp = 32 * (tc >> 1) + 8 * (w.l15 >> 2) + 4 * (tc & 1) + (w.l15 & 3);
                const unsigned p01 = pk2(qc[c][0], qc[c][1]), p23 = pk2(qc[c][2], qc[c][3]); LAS bf16* d = IMG(0) + (16 * w.tr + 4 * w.q) * IMG_LD + cp;
                d[0] = (bf16)p01; d[IMG_LD] = (bf16)(p01 >> 16); d[2 * IMG_LD] = (bf16)p23; d[3 * IMG_LD] = (bf16)(p23 >> 16); }
            img_to_global(IMG(2), W1G + (size_t)cidx * 4096, tid);
        }
        LDS_BARRIER();
        {
            f32x4 hp[2] = {Z4, Z4}, hn[2] = {Z4, Z4};
            mm64(IMG(4), IMG(6), hp, w); mm64(IMG(5), IMG(13), hn, w);
#pragma unroll
            for (int c = 0; c < 2; ++c) *(f32x4*)(HCT + (((size_t)cidx * 16 + w.tr * 4 + w.tc0 + c) * 64 + lane) * 4) = hp[c] - hn[c];
            img_to_global(IMG(13), ULG + (size_t)cidx * 4096, tid);
            img_to_global(IMG(0), QCT + (size_t)cidx * 4096, tid);
        }
        LDS_BARRIER();
    }
}

constexpr int P2_SLOT = 12544, P2_DEPTH = 5;
__device__ __forceinline__ void rwkv_pass2(LAS unsigned char* lds, int bh, int ti, int lane, const bf16* QCT, const float* HCT, const float* DLG, bf16* S0G) {
    const int l15 = lane & 15, q = lane >> 4;
    f32x4 X[4];
#pragma unroll
    for (int tj = 0; tj < 4; ++tj) X[tj] = Z4;
#define P2_DMA(cc) do { const size_t ci_ = (size_t)bh * 128 + (cc); LAS unsigned char* sl_ = lds + ((cc) % P2_DEPTH) * P2_SLOT; \
        _Pragma("unroll") for (int i = 0; i < 8; ++i) { const int row_ = i * 8 + (lane >> 3), pc_ = (lane & 7) ^ (row_ & 7); \
            __builtin_amdgcn_global_load_lds((const unsigned*)((const char*)QCT + (ci_ * 64 + row_) * 128 + pc_ * 16), (LAS unsigned*)(sl_ + i * 1024), 16, 0, 0); } \
        _Pragma("unroll") for (int tj = 0; tj < 4; ++tj) __builtin_amdgcn_global_load_lds((const unsigned*)((const char*)HCT + ((ci_ * 16 + tj * 4 + ti) * 64 + lane) * 16), (LAS unsigned*)(sl_ + 8192 + tj * 1024), 16, 0, 0); \
        __builtin_amdgcn_global_load_lds((const unsigned*)((const char*)DLG + (ci_ * 64 + lane) * 4), (LAS unsigned*)(sl_ + 12288), 4, 0, 0); } while (0)
    P2_DMA(0); P2_DMA(1); P2_DMA(2); P2_DMA(3);
    for (int c = 0; c < 128; ++c) {
        if (c < 124) asm volatile("s_waitcnt vmcnt(39)" ::: "memory"); else asm volatile("s_waitcnt vmcnt(0)" ::: "memory");
        const LAS unsigned char* sl = lds + (c % P2_DEPTH) * P2_SLOT;
        bf16x8 a[4][2]; f32x4 h[4], d[4];
#pragma unroll
        for (int tj = 0; tj < 4; ++tj) { const int row = 16 * tj + l15;
#pragma unroll
            for (int s = 0; s < 2; ++s) a[tj][s] = *(const LAS bf16x8*)(sl + row * 128 + (((4 * s + q) ^ (row & 7)) * 16));
            h[tj] = *(const LAS f32x4*)(sl + 8192 + tj * 1024 + lane * 16); d[tj] = *(const LAS f32x4*)(sl + 12288 + (16 * tj + 4 * q) * 4); }
        asm volatile("s_waitcnt lgkmcnt(0)" ::: "memory");
        if (c + 4 < 128) P2_DMA(c + 4);
        const size_t cidx = (size_t)bh * 128 + c;
#pragma unroll
        for (int tj = 0; tj < 4; ++tj) { u32x2 o; o.x = pk2(X[tj][0], X[tj][1]); o.y = pk2(X[tj][2], X[tj][3]); *(u32x2*)(S0G + (cidx * 64 + 16 * ti + l15) * 64 + 16 * tj + 4 * q) = o; }
        bf16x8 b[2];
#pragma unroll
        for (int s = 0; s < 2; ++s) { u32x4 o; o.x = pk2(X[2 * s][0], X[2 * s][1]); o.y = pk2(X[2 * s][2], X[2 * s][3]); o.z = pk2(X[2 * s + 1][0], X[2 * s + 1][1]); o.w = pk2(X[2 * s + 1][2], X[2 * s + 1][3]); b[s] = __builtin_bit_cast(bf16x8, o); }
#pragma unroll
        for (int tj = 0; tj < 4; ++tj) { f32x4 acc = Z4;
            acc = __builtin_amdgcn_mfma_f32_16x16x32_bf16(a[tj][0], b[0], acc, 0, 0, 0); acc = __builtin_amdgcn_mfma_f32_16x16x32_bf16(a[tj][1], b[1], acc, 0, 0, 0);
            X[tj] = d[tj] * X[tj] + h[tj] - acc; }
    }
    asm volatile("s_waitcnt vmcnt(0)" ::: "memory");
#undef P2_DMA
}

__device__ __forceinline__ void rwkv_pass3(LAS unsigned char* lds, const RwkvP& P, int c0, int n, int tid, const bf16* S0G, const bf16* W1G, const bf16* ULG, bf16* MIX) {
    const int lane = tid & 63, wv = __builtin_amdgcn_readfirstlane(tid >> 6); MmCtx w; w.tr = wv >> 1; w.tc0 = (wv & 1) * 2; w.l15 = lane & 15; w.q = lane >> 4;
    const int t = tid >> 3, cg = tid & 7, bh = c0 >> 7, b = bh >> 3, h = bh & 7, ch = h * 64 + 8 * cg;
    RwkvC C; rwkv_consts(P, h, cg, C);
    RwkvRaw R; rwkv_load<true>(P, c0, tid, R);
    u32x4 gS0, gW1, gUL;
    { const int row = tid >> 3, chk = tid & 7; const size_t o = (size_t)c0 * 4096 + row * 64 + chk * 8; gS0 = *(const u32x4*)(S0G + o); gW1 = *(const u32x4*)(W1G + o); gUL = *(const u32x4*)(ULG + o); }
    for (int ci = 0; ci < n; ++ci) {
        const int cidx = c0 + ci, c = cidx & 127;
        float vv[8], gg[8], bonus;
        {
            float kq[8], rr[8], kap[8], bet[8], lw[8], cum[8], cumL[8];
            rwkv_prep<true>(R, C, c == 0 && t == 0, kq, vv, rr, kap, bet, lw);
            unpack8(R.gg, gg);
            const u32x4 s0v = gS0, w1v = gW1, ulv = gUL;
            if (ci + 1 < n) { rwkv_load<true>(P, cidx + 1, tid, R);
                const int row = tid >> 3, chk = tid & 7; const size_t o = (size_t)(cidx + 1) * 4096 + row * 64 + chk * 8; gS0 = *(const u32x4*)(S0G + o); gW1 = *(const u32x4*)(W1G + o); gUL = *(const u32x4*)(ULG + o); }
            rwkv_cumsum<9>(lds, tid, lw, cum, cumL);
            float bs = 0.f, rk[8]; ldp8(P.r_k + ch, rk);
#pragma unroll
            for (int i = 0; i < 8; ++i) bs += rr[i] * kq[i] * rk[i];
            bonus = red8(bs);
            float x[8], y[8];
#pragma unroll
            for (int i = 0; i < 8; ++i) { const float en = __expf(-cum[i]); x[i] = kq[i] * en; y[i] = bet[i] * en; }
            st_tm8(IMG(1), t, cg, x);
            st_tm8(IMG(2), t, cg, y);
#pragma unroll
            for (int i = 0; i < 8; ++i) x[i] = rr[i] * __expf(cum[i]);
            st_tm8(IMG(0), t, cg, x);
            st_cm8(IMG(3), t, cg, vv);
            { const int row = tid >> 3, chk = tid & 7; *(LAS u32x4*)(IMG(4) + row * IMG_LD + chk * 8) = s0v; *(LAS u32x4*)(IMG(5) + row * IMG_LD + chk * 8) = w1v; *(LAS u32x4*)(IMG(6) + row * IMG_LD + chk * 8) = ulv; }
        }
        LDS_BARRIER();
        {
            f32x4 kr[2] = {Z4, Z4}, br[2] = {Z4, Z4}, u[2] = {Z4, Z4};
            mm64_2b(IMG(0), IMG(1), IMG(2), kr, br, w); mm64(IMG(4), IMG(5), u, w);
#pragma unroll
            for (int cc = 0; cc < 2; ++cc) { const int nn = 16 * (w.tc0 + cc) + w.l15;
#pragma unroll
                for (int r = 0; r < 4; ++r) { const int m = 16 * w.tr + 4 * w.q + r; kr[cc][r] = (nn <= m) ? kr[cc][r] : 0.f; br[cc][r] = (nn <= m) ? br[cc][r] : 0.f; u[cc][r] += bf2f(IMG(6)[m * IMG_LD + nn]); }
                st_rm(IMG(7), kr[cc], w.tr, w.tc0 + cc, w); st_rm(IMG(8), br[cc], w.tr, w.tc0 + cc, w); st_rm(IMG(9), u[cc], w.tr, w.tc0 + cc, w); }
        }
        LDS_BARRIER();
        {
            f32x4 yp[2] = {Z4, Z4}, yn[2] = {Z4, Z4};
            mm64(IMG(0), IMG(4), yp, w); mm64(IMG(7), IMG(3), yp, w); mm64(IMG(8), IMG(9), yn, w);
            LAS float* YF = (LAS float*)(lds + 10 * IMG_B);
#pragma unroll
            for (int cc = 0; cc < 2; ++cc)
#pragma unroll
                for (int r = 0; r < 4; ++r) YF[(16 * w.tr + 4 * w.q + r) * 65 + 16 * (w.tc0 + cc) + w.l15] = yp[cc][r] - yn[cc][r];
        }
        LDS_BARRIER();
        {
            const LAS float* YF = (const LAS float*)(lds + 10 * IMG_B);
            float y[8], s = 0.f;
#pragma unroll
            for (int i = 0; i < 8; ++i) { y[i] = YF[t * 65 + 8 * cg + i]; s += y[i]; }
            const float mean = red8(s) * (1.0f / 64.0f); float qv = 0.f;
#pragma unroll
            for (int i = 0; i < 8; ++i) { y[i] -= mean; qv += y[i] * y[i]; }
            const float rstd = rsqrtf(red8(qv) * (1.0f / 64.0f) + 64e-5f);
            float o[8], lnw[8], lnb[8]; ldp8(P.ln_w + ch, lnw); ldp8(P.ln_b + ch, lnb);
#pragma unroll
            for (int i = 0; i < 8; ++i) o[i] = (y[i] * rstd * lnw[i] + lnb[i] + bonus * vv[i]) * gg[i];
            const size_t tok = (size_t)b * SEQ + c * 64 + t;
            u32x4 ov; ov.x = pk2(o[0], o[1]); ov.y = pk2(o[2], o[3]); ov.z = pk2(o[4], o[5]); ov.w = pk2(o[6], o[7]);
            *(u32x4*)(MIX + tok * 1024 + 512 + ch) = ov;
        }
    }
}

constexpr int RW_LD = 1032;
__device__ __forceinline__ void router_phase(const Ctx& cx, const bf16* X1, const float* gnorm, const float* rw, const float* rb, unsigned char* H2, int* TOPE, float* TOPG, unsigned* HIST) {
    LAS bf16* WH = (LAS bf16*)cx.lds; LAS bf16* WL = WH + 32 * RW_LD;
    LAS unsigned* hcnt = (LAS unsigned*)(cx.lds + 135168);
    const int lane = cx.lane, l15 = lane & 15, q = lane >> 4;
    for (int idx = cx.tid; idx < 32768; idx += NTHR) { const int col = idx >> 5, e = idx & 31; const float v = rw[idx] * gnorm[col];
        const unsigned h = cvt_pk_bf16(v, 0.f) & 0xffffu; const float lo = v - bf2f(h); WH[e * RW_LD + col] = (bf16)h; WL[e * RW_LD + col] = (bf16)(cvt_pk_bf16(lo, 0.f) & 0xffffu); }
    const float b0 = rb[l15], b1 = rb[l15 + 16];
    for (int tb = cx.wg; tb < 256; tb += cx.G) {
        if (cx.tid < 32) hcnt[cx.tid] = 0u;
        __syncthreads();
        const int tok0 = tb * 128 + cx.wave * 16;
        const bf16* xrow = X1 + (size_t)(tok0 + l15) * 1024 + 8 * q;
        f32x4 acc[2] = {(f32x4){0.f, 0.f, 0.f, 0.f}, (f32x4){0.f, 0.f, 0.f, 0.f}}; float ss = 0.f;
#pragma unroll 4
        for (int s = 0; s < 32; ++s) {
            const u32x4 xw = *(const u32x4*)(xrow + 32 * s);
            { const float a0 = lo16(xw.x), a1 = hi16(xw.x), a2 = lo16(xw.y), a3 = hi16(xw.y), a4 = lo16(xw.z), a5 = hi16(xw.z), a6 = lo16(xw.w), a7 = hi16(xw.w);
              ss += (a0 * a0 + a1 * a1) + (a2 * a2 + a3 * a3) + (a4 * a4 + a5 * a5) + (a6 * a6 + a7 * a7); }
            const bf16x8 ah = __builtin_bit_cast(bf16x8, xw);
#pragma unroll
            for (int n = 0; n < 2; ++n) { const bf16x8 bh = *(const LAS bf16x8*)(WH + (l15 + 16 * n) * RW_LD + 32 * s + 8 * q), bl = *(const LAS bf16x8*)(WL + (l15 + 16 * n) * RW_LD + 32 * s + 8 * q);
                acc[n] = __builtin_amdgcn_mfma_f32_16x16x32_bf16(ah, bh, acc[n], 0, 0, 0); acc[n] = __builtin_amdgcn_mfma_f32_16x16x32_bf16(ah, bl, acc[n], 0, 0, 0); }
        }
        ss += __shfl_xor(ss, 16); ss += __shfl_xor(ss, 32);
        const float rinv_l = rsqrtf(ss * (1.f / 1024.f) + 1e-6f);
#pragma unroll
        for (int r = 0; r < 4; ++r) {
            const float ri = __shfl(rinv_l, 4 * q + r);
            float v0 = acc[0][r] * ri + b0, v1 = acc[1][r] * ri + b1; int se[4]; float sv[4];
#pragma unroll
            for (int k = 0; k < 4; ++k) { float bv = (v1 > v0) ? v1 : v0; int be = (v1 > v0) ? (l15 + 16) : l15;
#pragma unroll
                for (int off = 1; off < 16; off <<= 1) { const float ov = __shfl_xor(bv, off); const int oe = __shfl_xor(be, off); const bool take = (ov > bv) || (ov == bv && oe < be); bv = take ? ov : bv; be = take ? oe : be; }
                se[k] = be; sv[k] = bv; if (be == l15) v0 = -INFINITY; if (be == l15 + 16) v1 = -INFINITY; }
            if (l15 == r) { const int tok = tok0 + 4 * q + r;
                const float w1 = __expf(sv[1] - sv[0]), w2 = __expf(sv[2] - sv[0]), w3 = __expf(sv[3] - sv[0]); const float inv = 1.0f / (1.0f + w1 + w2 + w3);
                *(int4*)(TOPE + (size_t)tok * 4) = make_int4(se[0], se[1], se[2], se[3]);
                *(float4*)(TOPG + (size_t)tok * 4) = make_float4(inv, w1 * inv, w2 * inv, w3 * inv);
                atomicAdd((unsigned*)(hcnt + se[0]), 1u); atomicAdd((unsigned*)(hcnt + se[1]), 1u); atomicAdd((unsigned*)(hcnt + se[2]), 1u); atomicAdd((unsigned*)(hcnt + se[3]), 1u); }
        }
        const f32x4* gr = (const f32x4*)gnorm + lane;
#pragma unroll 2
        for (int i = 0; i < 16; ++i) { const float ri = __shfl(rinv_l, i); const u32x2* xr = (const u32x2*)(X1 + (size_t)(tok0 + i) * 1024) + lane; unsigned* o4 = (unsigned*)(H2 + (size_t)(tok0 + i) * 1024) + lane;
#pragma unroll
            for (int j = 0; j < 4; ++j) { const u32x2 v = xr[64 * j]; const f32x4 gg = gr[64 * j]; o4[64 * j] = pk4_fp8(lo16(v.x) * ri * gg.x, hi16(v.x) * ri * gg.y, lo16(v.y) * ri * gg.z, hi16(v.y) * ri * gg.w); } }
        __syncthreads();
        if (cx.tid < 32) HIST[tb * 32 + cx.tid] = hcnt[cx.tid];
        __syncthreads();
    }
}

constexpr int PL_BASE = 1280, PL_WCNT = 1312;
__device__ __forceinline__ void moe_plan(const Ctx& cx, const unsigned* HIST) {
    LAS int* PL = (LAS int*)(cx.lds + LDS_PLAN);
    const int e = cx.tid & 31, part = cx.tid >> 5;
    { int s = 0; for (int w = 16 * part; w < 16 * part + 16; ++w) s += (int)HIST[w * 32 + e]; PL[PL_TMP + part * 32 + e] = s; }
    __syncthreads();
    if (cx.tid < 32) { int c = 0; for (int p = 0; p < 16; ++p) c += PL[PL_TMP + p * 32 + cx.tid]; PL[PL_CNT + cx.tid] = c; }
    __syncthreads();
    if (cx.tid == 0) {
        int ps = 0;
        for (int x = 0; x < 32; ++x) { PL[PL_PSTART + x] = ps; const int pad = (PL[PL_CNT + x] + 255) & ~255; for (int i = 0; i < pad / 256; ++i) PL[PL_TILEE + ps / 256 + i] = x; ps += pad; }
        PL[PL_PSTART + 32] = ps;
        int np = 0, e0 = 0;
        while (e0 < 32 && np < 7) { PL[PL_PE0 + np] = e0; PL[PL_PROW0 + np] = PL[PL_PSTART + e0]; int rows = 0, e1 = e0;
            while (e1 < 32 && e1 - e0 < MAXEPP) { const int pad = PL[PL_PSTART + e1 + 1] - PL[PL_PSTART + e1]; if (rows + pad > RMAX && e1 > e0) break; rows += pad; ++e1; }
            e0 = e1; ++np; }
        PL[PL_PE0 + np] = 32; PL[PL_PROW0 + np] = ps; PL[PL_NPASS] = np;
    }
    __syncthreads();
}
__device__ __forceinline__ void dispatch_phase(const Ctx& cx, const unsigned* HIST, const int* TOPE, int* SLOTTOK, int* TOKSLOT) {
    LAS int* PL = (LAS int*)(cx.lds + LDS_PLAN);
    const int e5 = cx.tid & 31, part = cx.tid >> 5, lane = cx.lane;
    for (int tb = cx.wg; tb < 256; tb += cx.G) {
        { int s = 0; for (int w = 16 * part; w < 16 * part + 16; ++w) s += (w < tb) ? (int)HIST[w * 32 + e5] : 0; PL[PL_TMP + part * 32 + e5] = s; }
        const int tok = tb * 128 + (cx.tid >> 2), k = cx.tid & 3; const int e = TOPE[(size_t)tok * 4 + k];
        int rank = 0;
        for (int ee = 0; ee < 32; ++ee) { const unsigned long long mask = __ballot(e == ee); if (e == ee) rank = __popcll(mask & ((1ull << lane) - 1ull)); if (lane == 0) PL[PL_WCNT + cx.wave * 32 + ee] = __popcll(mask); }
        __syncthreads();
        if (cx.tid < 32) { int c = 0; for (int p = 0; p < 16; ++p) c += PL[PL_TMP + p * 32 + cx.tid]; PL[PL_BASE + cx.tid] = c; }
        __syncthreads();
        int off = 0; for (int w2 = 0; w2 < 8; ++w2) off += (w2 < cx.wave) ? PL[PL_WCNT + w2 * 32 + e] : 0;
        const int slot = PL[PL_PSTART + e] + PL[PL_BASE + e] + off + rank;
        SLOTTOK[slot] = tok; TOKSLOT[(size_t)tok * 4 + k] = slot;
        __syncthreads();
    }
    for (int e = cx.wg; e < 32; e += cx.G) { const int c = PL[PL_CNT + e], ps = PL[PL_PSTART + e], pe = PL[PL_PSTART + e + 1]; for (int r = ps + c + cx.tid; r < pe; r += NTHR) SLOTTOK[r] = 0; }
}
__device__ __forceinline__ void convert_pass(const Ctx& cx, int e0, int e1, const float* wg, const float* wu, const float* wd, unsigned char* WGU, unsigned char* WDN) {
    LAS float* scr = (LAS float*)(cx.lds + cx.wave * 16640);
    const int nitems = (e1 - e0) * 768;
    for (int it = cx.gw; it < nitems; it += cx.NGW) { const int le = it / 768, r = it % 768, mat = r >> 8, kb = (r & 255) >> 4, nb = r & 15, n0 = 64 * nb; const size_t eo = (size_t)(e0 + le) * 1048576;
        if (mat == 2) transpose_item_fp8(wd + eo, 1024, 64 * kb, n0, WDN + (size_t)le * 1048576 + (size_t)n0 * 1024 + 64 * kb, 1024, 32.0f, scr, cx.lane);
        else { const int drow = (n0 >> 7) * 256 + (n0 & 127) + mat * 128; transpose_item_fp8((mat ? wu : wg) + eo, 1024, 64 * kb, n0, WGU + (size_t)le * 2097152 + (size_t)drow * 1024 + 64 * kb, 1024, 32.0f, scr, cx.lane); } }
}
template <bool LAST>
__device__ __forceinline__ void combine_pass(const Ctx& cx, int e0, int e1, int row0, const int* TOPE, const float* TOPG, const int* TOKSLOT, const unsigned char* Y, bf16* X, const float* gnorm, unsigned char* H3) {
    for (int tok = cx.gw; tok < M; tok += cx.NGW) {
        const int4 es = *(const int4*)(TOPE + (size_t)tok * 4); const float4 gs = *(const float4*)(TOPG + (size_t)tok * 4); const int4 sl = *(const int4*)(TOKSLOT + (size_t)tok * 4);
        const int ee[4] = {es.x, es.y, es.z, es.w}; const float gg[4] = {gs.x, gs.y, gs.z, gs.w}; const int ss[4] = {sl.x, sl.y, sl.z, sl.w};
        bool any = false;
#pragma unroll
        for (int k = 0; k < 4; ++k) any |= (ee[k] >= e0 && ee[k] < e1);
        if (!LAST && !any) continue;
        u32x2* xr = (u32x2*)(X + (size_t)tok * 1024) + cx.lane; f32x4 v[4];
#pragma unroll
        for (int j = 0; j < 4; ++j) { const u32x2 w = xr[64 * j]; v[j] = (f32x4){lo16(w.x), hi16(w.x), lo16(w.y), hi16(w.y)}; }
#pragma unroll
        for (int k = 0; k < 4; ++k) if (ee[k] >= e0 && ee[k] < e1) { const unsigned* yr = (const unsigned*)(Y + (size_t)(ss[k] - row0) * 1024) + cx.lane; const float g = gg[k];
#pragma unroll
            for (int j = 0; j < 4; ++j) v[j] += up4_fp8(yr[64 * j]) * g; }
        if (any) {
#pragma unroll
            for (int j = 0; j < 4; ++j) { u32x2 w; w.x = pk2(v[j].x, v[j].y); w.y = pk2(v[j].z, v[j].w); xr[64 * j] = w; }
        }
        if (LAST) { float s = 0.f;
#pragma unroll
            for (int j = 0; j < 4; ++j) s += (v[j].x * v[j].x + v[j].y * v[j].y) + (v[j].z * v[j].z + v[j].w * v[j].w);
            const float rinv = rsqrtf(wave_sum(s) * (1.f / 1024.f) + 1e-6f); const f32x4* gr = (const f32x4*)gnorm + cx.lane; unsigned* o8 = (unsigned*)(H3 + (size_t)tok * 1024) + cx.lane;
#pragma unroll
            for (int j = 0; j < 4; ++j) { const f32x4 gq = gr[64 * j]; o8[64 * j] = pk4_fp8(v[j].x * rinv * gq.x, v[j].y * rinv * gq.y, v[j].z * rinv * gq.z, v[j].w * rinv * gq.w); } }
    }
}

#define HBUF ((bf16*)(ws + WS_R1))
#define RKV ((bf16*)(ws + WS_RKV))
#define WAG ((bf16*)(ws + WS_WAG))
#define AG ((bf16*)(ws + WS_AG))
#define UB ((bf16*)(ws + WS_U))
#define LP ((bf16*)(ws + WS_LP))
#define LACT ((bf16*)(ws + WS_LACT))
#define Y1 ((bf16*)(ws + WS_Y1))
#define MIX ((bf16*)(ws + WS_R1))
#define EBUF ((float*)(ws + WS_LP))
#define S0G ((bf16*)(ws + WS_LP))
#define QCT ((bf16*)(ws + WS_U))
#define HCT ((float*)(ws + WS_R1))
#define W1G ((bf16*)(ws + WS_W1))
#define ULG ((bf16*)(ws + WS_ULOC))
#define DLG ((float*)(ws + WS_DL))
#define ATG ((float*)(ws + WS_AT))
#define WCAT ((bf16*)(ws + WS_WCAT))
#define WL2 ((bf16*)(ws + WS_WL2))
#define WGLU ((bf16*)(ws + WS_WGLU))
#define WPP ((bf16*)(ws + WS_WPP))
#define WOUT ((bf16*)(ws + WS_WOUT))
#define WPG ((unsigned char*)(ws + WS_WPG))
#define S5BT ((bf16*)(ws + WS_S5BT))
#define S5ET ((bf16*)(ws + WS_S5ET))
#define PBF ((bf16*)(ws + WS_PBF))
#define H2 ((unsigned char*)(ws + WS_H2))
#define WGU ((unsigned char*)(ws + WS_WGU))
#define WDN ((unsigned char*)(ws + WS_WDN))
#define ACT ((unsigned char*)(ws + WS_ACT))
#define YB ((unsigned char*)(ws + WS_Y))
#define XB ((bf16*)(ws + WS_XB))
#define PP ((bf16*)(ws + WS_ACT))
#define HIST ((unsigned*)(ws + WS_HIST))
#define TOPE ((int*)(ws + WS_TOPE))
#define TOPG ((float*)(ws + WS_TOPG))
#define TOKSLOT ((int*)(ws + WS_TOKSLOT))
#define SLOTTOK ((int*)(ws + WS_SLOTTOK))
#ifndef MOE_ALIGN
#define MOE_ALIGN true
#endif
#ifndef PROBE_PH
#define PROBE_PH -1
#endif
#ifndef PROBE_N
#define PROBE_N 2
#endif
#define REPS(k) ((((k) >= 10 && (k) < 28) ? 10 + ((k) - 10) % 3 : (k)) == PROBE_PH ? PROBE_N : 1)
#ifndef ONLY_PHASE
#define ONLY_PHASE -1
#endif
constexpr int NPH = 31;
struct Args { const float* in[42]; float* out; unsigned char* ws; int ph_lo, ph_hi; };

__global__ void __launch_bounds__(NTHR, 2) mk_fwd(Args args) {
    extern __shared__ __attribute__((aligned(16))) unsigned char lds_raw[];
    LAS unsigned char* lds = (LAS unsigned char*)lds_raw;
#define CAS __attribute__((address_space(4)))
#define FRESH_CX const CAS char* ka_ = (const CAS char*)__builtin_amdgcn_kernarg_segment_ptr(); asm volatile("" : "+s"(ka_)); const float* const CAS* I = (const float* const CAS*)ka_; unsigned char* ws = *(unsigned char* const CAS*)(ka_ + 344); float* OUTP = *(float* const CAS*)(ka_ + 336); (void)I; (void)ws; (void)OUTP; \
    Ctx cx; { int t_ = threadIdx.x; asm volatile("" : "+v"(t_)); cx.lds = lds; cx.tid = t_; cx.lane = t_ & 63; cx.wave = __builtin_amdgcn_readfirstlane(t_ >> 6); cx.G = gridDim.x; cx.wg = blockIdx.x; cx.gw = cx.wg * NWAVES + cx.wave; cx.NGW = cx.G * NWAVES; }
    unsigned char* ws = args.ws;
    const int lo = args.ph_lo, hi = args.ph_hi;
    volatile LAS unsigned* MISC = (volatile LAS unsigned*)(lds + LDS_MISC);
    if (threadIdx.x < 64) MISC[threadIdx.x] = 0u;
    __syncthreads();
    XcdBarrier bar; bar.bar = (unsigned*)(ws + WS_CTL) + CW_BAR; bar.x = 0; bar.st = nullptr;
    if (hi - lo > 1) bar = xcd_barrier_post((unsigned*)(ws + WS_CTL) + CW_BAR, MISC + 8);

#define IN(k) ((ONLY_PHASE < 0 || ONLY_PHASE == (k) || (ONLY_PHASE >= 10 && ONLY_PHASE < 28 && (k) >= 10 && (k) < 28 && ((k) - 10) % 3 == (ONLY_PHASE - 10) % 3)) && lo <= (k) && (k) < hi)
#ifndef PROBE_BAR
#define PROBE_BAR 1
#endif
#ifndef PROBE_T
#define PROBE_T -1
#endif
#define STAMP() do { if (PROBE_T >= 0 && blockIdx.x == 0 && threadIdx.x == 0) { const unsigned long long t_ = __builtin_amdgcn_s_memrealtime(); MISC[16 + 2 * nst] = (unsigned)t_; MISC[17 + 2 * nst] = (unsigned)(t_ >> 32); } ++nst; } while (0)
#define SEAM(k) do { if (IN(k) && IN((k) + 1)) { for (int b_ = 0; b_ < PROBE_BAR; ++b_) xcd_barrier(bar); STAMP(); } } while (0)
    int nst = 0; STAMP();
#define MAKE_RP RwkvP RP; RP.rkv = RKV; RP.wag = WAG; RP.mu_rkv = I[13]; RP.w0 = I[15]; RP.a0 = I[18]; RP.k_k = I[23]; RP.k_a = I[24]; RP.r_k = I[25]; RP.ln_w = I[26]; RP.ln_b = I[27]
#define OPQ(v) ({ int _k = (v); asm volatile("" : "+s"(_k)); _k; })

    if (IN(0)) for (int rep_ = 0; rep_ < REPS(0); ++rep_) {
        FRESH_CX;
        for (int it = cx.wg; it < 256; it += cx.G) s5_tables_item(cx, it >> 3, it & 7, I[4], I[5], I[6], I[7], I[8], I[9], I[10], S5BT, S5ET, ATG);
        const float* mu = I[14];
        transpose_matrix(cx, I[3], 1024, 2048, WCAT, 0, 1024, 0, nullptr, 0);
        transpose_matrix(cx, I[16], 1024, 64, WCAT, 2048, 1024, 0, mu, 1);          transpose_matrix(cx, I[16], 1024, 64, WCAT, 2304, 1024, 0, mu, 0);
        transpose_matrix(cx, I[19], 1024, 64, WCAT, 2112, 1024, 0, mu + 1024, 1);   transpose_matrix(cx, I[19], 1024, 64, WCAT, 2368, 1024, 0, mu + 1024, 0);
        transpose_matrix(cx, I[21], 1024, 128, WCAT, 2176, 1024, 0, mu + 2048, 1);  transpose_matrix(cx, I[21], 1024, 128, WCAT, 2432, 1024, 0, mu + 2048, 0);
        transpose_matrix(cx, I[17], 64, 512, WL2, 0, 256, 0, nullptr, 0);
        transpose_matrix(cx, I[20], 64, 512, WL2, 512, 256, 64, nullptr, 0);
        transpose_matrix(cx, I[22], 128, 512, WL2, 1024, 256, 128, nullptr, 0);
        for (int idx = cx.wg * NTHR + cx.tid; idx < 1536 * 32; idx += cx.G * NTHR) { const int row = idx >> 5, ch = idx & 31, blk = row >> 9; const int kb = blk == 0 ? 0 : (blk == 1 ? 64 : 128), ke = blk == 0 ? 64 : (blk == 1 ? 128 : 256);
            if (ch * 8 < kb || ch * 8 >= ke) *(u32x4*)(WL2 + (size_t)row * 256 + ch * 8) = (u32x4){0u, 0u, 0u, 0u}; }
        transpose_matrix(cx, I[12], 512, 512, WGLU, 0, 512, 0, nullptr, 0);
        transpose_matrix(cx, I[39], 256, 1024, WPP, 0, 256, 0, nullptr, 0);
        transpose_matrix(cx, I[28], 1024, 1024, WOUT, 0, 1024, 0, nullptr, 0);
        { LAS float* scr = (LAS float*)(cx.lds + cx.wave * 16640);
          for (int it = cx.gw; it < 256; it += cx.NGW) { const int kb = it >> 4, nb = it & 15;
              transpose_item_fp8(I[40], 1024, 64 * kb, 64 * nb, WPG + (size_t)(64 * nb) * 1024 + 64 * kb, 1024, 32.0f, scr, cx.lane); } }
        for (int m = 2 * cx.gw; m < M; m += 2 * cx.NGW) rms_rows2_to_bf16(I[0] + (size_t)m * 1024, I[0] + (size_t)(m + 1) * 1024, I[2], HBUF + (size_t)m * 1024, HBUF + (size_t)(m + 1) * 1024, cx.lane);
        for (int m = 4 * cx.gw; m < M; m += 4 * cx.NGW) { f32x4 v[4];
#pragma unroll
            for (int r = 0; r < 4; ++r) v[r] = *((const f32x4*)(I[1] + (size_t)(m + r) * 256) + cx.lane);
#pragma unroll
            for (int r = 0; r < 4; ++r) { u32x2 w; w.x = pk2(v[r].x, v[r].y); w.y = pk2(v[r].z, v[r].w); *((u32x2*)(PBF + (size_t)(m + r) * 256) + cx.lane) = w; } }
    }
    SEAM(0);
    if (IN(1)) for (int rep_ = 0; rep_ < REPS(1); ++rep_) {
        FRESH_CX;
        SchedPlain S; S.init(128, 10, cx.G, cx.wg); S.A = (const char*)HBUF; S.B = (const char*)WCAT; S.a_tile = 256 * 1024 * 2; S.b_tile = 256 * 1024 * 2;
        EpiProj E{AG, RKV, LP};
        pg8::gemm_phase<EpiProj, SchedPlain, true, true, false>(lds, cx.tid, OPQ(1024), OPQ(1024), OPQ(1024), S, E);
    }
    SEAM(1);
    if (IN(2)) for (int rep_ = 0; rep_ < REPS(2); ++rep_) {
        FRESH_CX;
        for (int m = 2 * cx.gw; m < M; m += 2 * cx.NGW) {
            const int lane = cx.lane; const bool first = (m & (SEQ - 1)) == 0;
            const u32x2 a0 = *((const u32x2*)(LP + (size_t)m * 512) + lane), a1 = *((const u32x2*)(LP + (size_t)(m + 1) * 512) + lane), b1 = *((const u32x2*)(LP + (size_t)m * 512 + 256) + lane);
            u32x2 b0 = (u32x2){0u, 0u}; if (!first) b0 = *((const u32x2*)(LP + (size_t)(m - 1) * 512 + 256) + lane);
            float v[8] = {lo16(a0.x) + lo16(b0.x), hi16(a0.x) + hi16(b0.x), lo16(a0.y) + lo16(b0.y), hi16(a0.y) + hi16(b0.y), lo16(a1.x) + lo16(b1.x), hi16(a1.x) + hi16(b1.x), lo16(a1.y) + lo16(b1.y), hi16(a1.y) + hi16(b1.y)};
#pragma unroll
            for (int i = 0; i < 8; ++i) v[i] = lane < 16 ? ftanh(v[i]) : (lane < 32 ? v[i] : fsigmoid(v[i]));
            u32x2 o; o.x = pk2(v[0], v[1]); o.y = pk2(v[2], v[3]); *((u32x2*)(LACT + (size_t)m * 256) + lane) = o;
            o.x = pk2(v[4], v[5]); o.y = pk2(v[6], v[7]); *((u32x2*)(LACT + (size_t)(m + 1) * 256) + lane) = o;
        }
    }
    SEAM(2);
    if (IN(3)) for (int rep_ = 0; rep_ < REPS(3); ++rep_) {
        FRESH_CX;
        { SchedPlain S; S.init(128, 6, cx.G, cx.wg); S.A = (const char*)LACT; S.B = (const char*)WL2; S.a_tile = 256 * 256 * 2; S.b_tile = 256 * 256 * 2;
          EpiBf16Plain E{WAG, 1536};
          pg8::gemm_phase<EpiBf16Plain, SchedPlain, true, true, false>(lds, cx.tid, OPQ(256), OPQ(256), OPQ(256), S, E); }
        { SchedS5 S; S.init(128, 1, cx.G, cx.wg); S.A = (const char*)AG; S.B = (const char*)S5ET; S.a_tile = 256 * 640 * 2; S.b_tile = 0; S.b_group = 256 * 512 * 2;
          EpiF32 E{EBUF, 256};
          pg8::gemm_phase<EpiF32, SchedS5, true, true, false>(lds, cx.tid, OPQ(512), OPQ(640), OPQ(512), S, E); }
    }
    SEAM(3);
    if (IN(4)) for (int rep_ = 0; rep_ < REPS(4); ++rep_) {
        FRESH_CX;
        if (cx.wave == 0 && cx.lane < 32) {
            for (int idx = cx.wg * 32 + cx.lane; idx < 8192; idx += cx.G * 32) { const int b = idx >> 11, g = (idx >> 6) & 31, p = idx & 63;
                const float ar = ATG[(g * 64 + p) * 2], ai = ATG[(g * 64 + p) * 2 + 1]; float sr = 0.f, si = 0.f;
                const size_t row0 = (size_t)g * 1024 + b * 256;
                for (int k0 = 0; k0 < 256; k0 += 16) { float er[16], ei[16];
#pragma unroll
                    for (int k = 0; k < 16; ++k) { er[k] = EBUF[(row0 + k0 + k) * 256 + p]; ei[k] = EBUF[(row0 + k0 + k) * 256 + 64 + p]; }
#pragma unroll
                    for (int k = 0; k < 16; ++k) { bf16* d = AG + (row0 + k0 + k) * 640 + 512 + p; d[0] = (bf16)(pk2(sr, 0.f) & 0xffffu); d[64] = (bf16)(pk2(si, 0.f) & 0xffffu);
                        const float nr = ar * sr - ai * si + er[k], ni = ar * si + ai * sr + ei[k]; sr = nr; si = ni; } }
            }
        }
        MAKE_RP;
        for (int grp = cx.wg; grp < 256; grp += cx.G) rwkv_pass1(lds, RP, grp * 16, 16, cx.tid, QCT, HCT, W1G, ULG, DLG);
    }
    SEAM(4);
    if (IN(5)) for (int rep_ = 0; rep_ < REPS(5); ++rep_) {
        FRESH_CX;
        { SchedS5 S; S.init(128, 2, cx.G, cx.wg); S.A = (const char*)AG; S.B = (const char*)S5BT; S.a_tile = 256 * 640 * 2; S.b_tile = 256 * 640 * 2; S.b_group = 512 * 640 * 2;
          EpiS5Y E{AG, I[11], Y1};
          pg8::gemm_phase<EpiS5Y, SchedS5, true, true, false>(lds, cx.tid, OPQ(640), OPQ(640), OPQ(640), S, E); }
        if (cx.wave == 0) for (int it = cx.wg; it < 128; it += cx.G) rwkv_pass2(lds, it >> 2, it & 3, cx.lane, QCT, HCT, DLG, S0G);
    }
    SEAM(5);
    if (IN(6)) for (int rep_ = 0; rep_ < REPS(6); ++rep_) {
        FRESH_CX;
        MAKE_RP;
        for (int grp = cx.wg; grp < 256; grp += cx.G) rwkv_pass3(lds, RP, grp * 16, 16, cx.tid, S0G, W1G, ULG, MIX);
        __syncthreads();
        { SchedPlain S; S.init(128, 2, cx.G, cx.wg); S.A = (const char*)Y1; S.B = (const char*)WGLU; S.a_tile = 256 * 512 * 2; S.b_tile = 256 * 512 * 2;
          EpiGlu E{Y1, MIX};
          pg8::gemm_phase<EpiGlu, SchedPlain, true, true, false>(lds, cx.tid, OPQ(512), OPQ(512), OPQ(512), S, E); }
    }
    SEAM(6);
    if (IN(7)) for (int rep_ = 0; rep_ < REPS(7); ++rep_) {
        FRESH_CX;
        SchedPlain S; S.init(128, 4, cx.G, cx.wg); S.A = (const char*)MIX; S.B = (const char*)WOUT; S.a_tile = 256 * 1024 * 2; S.b_tile = 256 * 1024 * 2;
        EpiResid E{I[0], XB};
        pg8::gemm_phase<EpiResid, SchedPlain, true, true, false>(lds, cx.tid, OPQ(1024), OPQ(1024), OPQ(1024), S, E);
    }
    SEAM(7);
    if (IN(8)) for (int rep_ = 0; rep_ < REPS(8); ++rep_) { FRESH_CX; router_phase(cx, XB, I[29], I[30], I[31], H2, TOPE, TOPG, HIST); }
    SEAM(8);
    LAS int* PL = (LAS int*)(lds + LDS_PLAN);
    if (hi > 9 && lo < 28) { FRESH_CX; __syncthreads(); moe_plan(cx, HIST); }
    const int npass = (hi > 9 && lo < 28) ? PL[PL_NPASS] : 0;
    if (IN(9)) for (int rep_ = 0; rep_ < REPS(9); ++rep_) { FRESH_CX; dispatch_phase(cx, HIST, TOPE, SLOTTOK, TOKSLOT); convert_pass(cx, PL[PL_PE0], PL[PL_PE0 + 1], I[32], I[34], I[36], WGU, WDN); }
    SEAM(9);
    for (int p = 0; p < 6; ++p) {
        const bool actv = p < npass;
        const int e0 = actv ? PL[PL_PE0 + p] : 0, e1 = actv ? PL[PL_PE0 + p + 1] : 0, row0 = actv ? PL[PL_PROW0 + p] : 0, rows = actv ? PL[PL_PROW0 + p + 1] - row0 : 0;
        if (IN(10 + 3 * p) && actv) for (int rep_ = 0; rep_ < REPS(10); ++rep_) {
            FRESH_CX;
            SchedMoe<true> S; S.init(rows / 256, 8, cx.G, cx.wg); S.A = (const char*)H2; S.B = (const char*)WGU; S.a_tile = 0; S.b_tile = 256 * 1024; S.b_exp = (size_t)2048 * 1024; S.tile_e = PL + PL_TILEE; S.tile0 = row0 / 256; S.e0 = e0; S.slot_tok = SLOTTOK; S.row0 = row0;
            EpiGU E{ACT, I[33], I[35]};
            pg8::gemm_phase<EpiGU, SchedMoe<true>, MOE_ALIGN, true, true, true>(lds, cx.tid, OPQ(512), OPQ(512), OPQ(512), S, E);
        }
        if (actv) SEAM(10 + 3 * p);
        if (IN(11 + 3 * p) && actv) for (int rep_ = 0; rep_ < REPS(11); ++rep_) {
            FRESH_CX;
            SchedMoe<false> S; S.init(rows / 256, 4, cx.G, cx.wg); S.A = (const char*)ACT; S.B = (const char*)WDN; S.a_tile = 256 * 1024; S.b_tile = 256 * 1024; S.b_exp = (size_t)1024 * 1024; S.tile_e = PL + PL_TILEE; S.tile0 = row0 / 256; S.e0 = e0; S.slot_tok = SLOTTOK; S.row0 = row0;
            EpiDown E{YB, I[37]};
            pg8::gemm_phase<EpiDown, SchedMoe<false>, MOE_ALIGN, true, false, true>(lds, cx.tid, OPQ(512), OPQ(512), OPQ(512), S, E);
        }
        if (actv) SEAM(11 + 3 * p);
        if (IN(12 + 3 * p) && actv) for (int rep_ = 0; rep_ < REPS(12); ++rep_) {
            FRESH_CX;
            if (p + 1 < npass) { combine_pass<false>(cx, e0, e1, row0, TOPE, TOPG, TOKSLOT, YB, XB, nullptr, nullptr); convert_pass(cx, PL[PL_PE0 + p + 1], PL[PL_PE0 + p + 2], I[32], I[34], I[36], WGU, WDN); }
            else {
                combine_pass<true>(cx, e0, e1, row0, TOPE, TOPG, TOKSLOT, YB, XB, I[38], (unsigned char*)(ws + WS_R1));
                SchedPlain S; S.init(128, 4, cx.G, cx.wg); S.A = (const char*)PBF; S.B = (const char*)WPP; S.a_tile = 256 * 256 * 2; S.b_tile = 256 * 256 * 2;
                EpiBf16Plain E{PP, 1024};
                pg8::gemm_phase<EpiBf16Plain, SchedPlain, true, true, false>(lds, cx.tid, OPQ(256), OPQ(256), OPQ(256), S, E);
            }
        }
        if (actv) SEAM(12 + 3 * p);
    }
    if (IN(29)) for (int rep_ = 0; rep_ < REPS(29); ++rep_) {
        FRESH_CX;
        SchedPlain S; S.init(128, 4, cx.G, cx.wg); S.A = (const char*)(ws + WS_R1); S.B = (const char*)WPG; S.a_tile = 256 * 1024; S.b_tile = 256 * 1024;
        EpiPle E{PP, XB};
        pg8::gemm_phase<EpiPle, SchedPlain, true, true, false, true>(lds, cx.tid, OPQ(512), OPQ(512), OPQ(512), S, E);
    }
    SEAM(29);
    if (IN(30)) for (int rep_ = 0; rep_ < REPS(30); ++rep_) {
        FRESH_CX;
        for (int m = 2 * cx.gw; m < M; m += 2 * cx.NGW) {
            const u32x2* ia_ = (const u32x2*)(XB + (size_t)m * 1024) + cx.lane; const u32x2* ib_ = ia_ + 256;
            f32x4* xa = (f32x4*)(OUTP + (size_t)m * 1024) + cx.lane; f32x4* xb = xa + 256; const f32x4* gr = (const f32x4*)I[41] + cx.lane; f32x4 va[4], vb[4]; float sa = 0.f, sb = 0.f;
#pragma unroll
            for (int j = 0; j < 4; ++j) { const u32x2 wa = ia_[64 * j], wb = ib_[64 * j]; va[j] = (f32x4){lo16(wa.x), hi16(wa.x), lo16(wa.y), hi16(wa.y)}; vb[j] = (f32x4){lo16(wb.x), hi16(wb.x), lo16(wb.y), hi16(wb.y)}; }
#pragma unroll
            for (int j = 0; j < 4; ++j) { sa += (va[j].x * va[j].x + va[j].y * va[j].y) + (va[j].z * va[j].z + va[j].w * va[j].w); sb += (vb[j].x * vb[j].x + vb[j].y * vb[j].y) + (vb[j].z * vb[j].z + vb[j].w * vb[j].w); }
#pragma unroll
            for (int o = 1; o < 64; o <<= 1) { sa += __shfl_xor(sa, o); sb += __shfl_xor(sb, o); }
            const float ia = rsqrtf(sa * (1.f / 1024.f) + 1e-6f), ib = rsqrtf(sb * (1.f / 1024.f) + 1e-6f);
#pragma unroll
            for (int j = 0; j < 4; ++j) { const f32x4 gg = gr[64 * j]; xa[64 * j] = (f32x4){va[j].x * ia * gg.x, va[j].y * ia * gg.y, va[j].z * ia * gg.z, va[j].w * ia * gg.w}; xb[64 * j] = (f32x4){vb[j].x * ib * gg.x, vb[j].y * ib * gg.y, vb[j].z * ib * gg.z, vb[j].w * ib * gg.w}; }
        }
    }
    if (PROBE_T >= 0 && blockIdx.x == 0 && threadIdx.x == 0) { STAMP(); asm volatile("s_waitcnt vmcnt(0)" ::: "memory");
        const unsigned long long t0_ = ((unsigned long long)MISC[17 + 2 * PROBE_T] << 32) | MISC[16 + 2 * PROBE_T], t1_ = ((unsigned long long)MISC[19 + 2 * PROBE_T] << 32) | MISC[18 + 2 * PROBE_T];
        (*(float* const CAS*)((const CAS char*)__builtin_amdgcn_kernarg_segment_ptr() + 336))[0] = (float)(t1_ - t0_) * 0.01f; }
#undef IN
#undef SEAM
}

extern "C" void kernel_launch(void* const* d_in, const int* in_sizes, int n_in, void* d_out, int out_size, void* d_ws, size_t ws_size, hipStream_t stream) {
    static int grid = 0;
    if (grid == 0) {
        if (n_in != 42 || out_size != M * DM || ws_size < WS_END) { fprintf(stderr, "kernel_launch: unexpected shapes (n_in %d out %d ws %zu)\n", n_in, out_size, ws_size); grid = -1; return; }
        int dev = 0, cus = 0, per_cu = 0;
        if (hipGetDevice(&dev) != hipSuccess || hipDeviceGetAttribute(&cus, hipDeviceAttributeMultiprocessorCount, dev) != hipSuccess) { grid = -1; return; }
        if (hipFuncSetAttribute((const void*)mk_fwd, hipFuncAttributeMaxDynamicSharedMemorySize, LDS_BYTES) != hipSuccess) { fprintf(stderr, "kernel_launch: hipFuncSetAttribute failed\n"); grid = -1; return; }
        if (hipOccupancyMaxActiveBlocksPerMultiprocessor(&per_cu, (const void*)mk_fwd, NTHR, LDS_BYTES) != hipSuccess || per_cu < 1) fprintf(stderr, "kernel_launch: occupancy query says %d\n", per_cu);
        (void)hipGetLastError();
        grid = cus > 256 ? 256 : cus;
    }
    if (grid < 0) return;
    (void)hipMemsetAsync((char*)d_ws + WS_CTL, 0, CTL_ZERO_BYTES, stream);
    Args a{};
    for (int i = 0; i < 42; ++i) a.in[i] = (const float*)d_in[i];
    a.out = (float*)d_out; a.ws = (unsigned char*)d_ws;
#if MK_PER_PHASE
    for (int ph = 0; ph < NPH; ++ph) { a.ph_lo = ph; a.ph_hi = ph + 1; hipLaunchKernelGGL(mk_fwd, dim3(grid), dim3(NTHR), LDS_BYTES, stream, a); }
#else
    a.ph_lo = 0; a.ph_hi = NPH;
    hipLaunchKernelGGL(mk_fwd, dim3(grid), dim3(NTHR), LDS_BYTES, stream, a);
#endif
}
```

```cpp
#include <hip/hip_runtime.h>
#include <cstdio>
#include <cstdint>

#ifndef MK_PER_PHASE
#define MK_PER_PHASE 0
#endif

#define LAS __attribute__((address_space(3)))
#define GAS __attribute__((address_space(1)))
typedef unsigned short bf16;
typedef short bf16x8 __attribute__((ext_vector_type(8)));
typedef float f32x4 __attribute__((ext_vector_type(4)));
typedef float f32x2 __attribute__((ext_vector_type(2)));
typedef unsigned u32x4 __attribute__((ext_vector_type(4)));
typedef unsigned u32x2 __attribute__((ext_vector_type(2)));
typedef GAS unsigned gu32;

constexpr int NB = 4, SEQ = 8192, DM = 1024, M = NB * SEQ;
constexpr int NEXP = 32, TOPK = 4;
constexpr int NWAVES = 8, NTHR = 512;
constexpr size_t MiB = 1u << 20;

constexpr size_t WS_CTL = 0, CTL_ZERO_BYTES = 1 * MiB;
constexpr size_t WS_HIST = 1 * MiB;
constexpr size_t WS_TOPE = 2 * MiB;
constexpr size_t WS_TOPG = 3 * MiB;
constexpr size_t WS_TOKSLOT = 4 * MiB;
constexpr size_t WS_SLOTTOK = 5 * MiB;
constexpr size_t WS_AT = 6 * MiB;
constexpr size_t WS_DL = 6 * MiB + 65536;
constexpr size_t WS_WCAT = 8 * MiB;
constexpr size_t WS_WL2 = 13 * MiB;
constexpr size_t WS_WGLU = 14 * MiB;
constexpr size_t WS_WPP = 14 * MiB + 524288;
constexpr size_t WS_WOUT = 15 * MiB;
constexpr size_t WS_WPG = 17 * MiB;
constexpr size_t WS_S5BT = 19 * MiB;
constexpr size_t WS_S5ET = 39 * MiB;
constexpr size_t WS_PBF = 48 * MiB;
constexpr size_t WS_R1 = 64 * MiB;
constexpr size_t WS_RKV = 128 * MiB;
constexpr size_t WS_WAG = 224 * MiB;
constexpr size_t WS_AG = 320 * MiB;
constexpr size_t WS_U = 360 * MiB;
constexpr size_t WS_LP = 392 * MiB;
constexpr size_t WS_LACT = 424 * MiB;
constexpr size_t WS_W1 = 440 * MiB;
constexpr size_t WS_ULOC = 472 * MiB;
constexpr size_t WS_Y1 = 504 * MiB;
constexpr size_t WS_H2 = 64 * MiB;
constexpr size_t WS_WDN = 96 * MiB;
constexpr size_t WS_ACT = 128 * MiB;
constexpr size_t WS_Y = 264 * MiB;
constexpr size_t WS_XB = 400 * MiB;
constexpr size_t WS_WGU = 264 * MiB;
constexpr int RMAX = 139264;
constexpr int MAXEPP = 32;
constexpr size_t WS_END = 560 * MiB;
static_assert(WS_Y + (size_t)RMAX * 1024 <= WS_XB && WS_XB + (size_t)M * 2048 <= WS_END && WS_ACT + (size_t)RMAX * 1024 <= WS_Y, "moe map");

constexpr int CW_BAR = 4096;
constexpr int CW_ROWSS = 65536;
constexpr int CW_PCNT = 131072;

constexpr int LDS_PLAN = 147456;
constexpr int LDS_MISC = 155648;
constexpr int LDS_BYTES = 156672;
constexpr int PL_CNT = 0, PL_PSTART = 32, PL_NPASS = 72, PL_PE0 = 80, PL_PROW0 = 88, PL_TILEE = 128, PL_TMP = 768;

#define LDS_WAIT() asm volatile("s_waitcnt lgkmcnt(0)" ::: "memory")
#define VM_WAIT() asm volatile("s_waitcnt vmcnt(0)" ::: "memory")
__device__ __forceinline__ float bf2f(unsigned b) { return __uint_as_float(b << 16); }
typedef __bf16 bf16n2 __attribute__((ext_vector_type(2)));
__device__ __forceinline__ unsigned cvt_pk_bf16(float lo, float hi) { const f32x2 f = {lo, hi}; const bf16n2 v = __builtin_convertvector(f, bf16n2); return __builtin_bit_cast(unsigned, v); }
__device__ __forceinline__ unsigned pk2(float lo, float hi) { return cvt_pk_bf16(lo, hi); }
__device__ __forceinline__ float lo16(unsigned w) { return __uint_as_float(w << 16); }
__device__ __forceinline__ float hi16(unsigned w) { return __uint_as_float(w & 0xffff0000u); }
__device__ __forceinline__ unsigned pk4_fp8(float a, float b, float c, float d) { unsigned w = 0u; w = (unsigned)__builtin_amdgcn_cvt_pk_fp8_f32(a, b, (int)w, false); w = (unsigned)__builtin_amdgcn_cvt_pk_fp8_f32(c, d, (int)w, true); return w; }
__device__ __forceinline__ f32x4 up4_fp8(unsigned w) { const f32x2 lo = __builtin_amdgcn_cvt_pk_f32_fp8((int)w, false), hi = __builtin_amdgcn_cvt_pk_f32_fp8((int)w, true); return (f32x4){lo.x, lo.y, hi.x, hi.y}; }
__device__ __forceinline__ float frcp(float x) { return __builtin_amdgcn_rcpf(x); }
__device__ __forceinline__ float fsigmoid(float x) { return frcp(1.0f + __expf(-x)); }
__device__ __forceinline__ float ftanh(float x) { const float e = __expf(-2.0f * fabsf(x)); const float t = (1.0f - e) * frcp(1.0f + e); return x < 0.f ? -t : t; }
__device__ __forceinline__ float gelu_tanh(float x) { const float u = 0.7978845608f * (x + 0.044715f * x * x * x); return 0.5f * x * (1.0f + ftanh(u)); }
__device__ __forceinline__ float wave_sum(float v) {
#pragma unroll
    for (int o = 1; o < 64; o <<= 1) v += __shfl_xor(v, o);
    return v;
}
__device__ __forceinline__ float wave_max(float v) {
#pragma unroll
    for (int o = 1; o < 64; o <<= 1) v = fmaxf(v, __shfl_xor(v, o));
    return v;
}

#define XB_TMO      128
#define XB_XCNT(j)  (256  + 64 * (j))
#define XB_XSUB(j)  (1280 + 64 * (j))
#define XB_XGEN(j)  (2304 + 64 * (j))
#define XB_TOP      3328
#define XB_TOPGEN   3392
#define XCD_BAR_WORDS 3456
#define XB_SPIN_CAP (1u << 22)

__device__ __forceinline__ unsigned xb_ld(unsigned* p)              { return __hip_atomic_load(p, __ATOMIC_RELAXED, __HIP_MEMORY_SCOPE_AGENT); }
__device__ __forceinline__ unsigned xb_add(unsigned* p, unsigned v) { return __hip_atomic_fetch_add(p, v, __ATOMIC_RELAXED, __HIP_MEMORY_SCOPE_AGENT); }
__device__ __forceinline__ unsigned xb_xcc_id() { return (unsigned)__builtin_amdgcn_s_getreg((3 << 11) | 20) & 0xFu; }
#define XB_SPIN(cond, bar) do { unsigned _sp = 0; while (cond) { __builtin_amdgcn_s_sleep(1); \
    if ((++_sp & 255u) == 0u) { if (xb_ld(&(bar)[XB_TMO])) break; if (_sp > XB_SPIN_CAP) { atomicAdd(&(bar)[XB_TMO], 1u); break; } } } } while (0)

struct XcdBarrier { unsigned* bar; unsigned x; volatile LAS unsigned* st; };

__device__ __forceinline__ XcdBarrier xcd_barrier_post(unsigned* bar, volatile LAS unsigned* st) {
    XcdBarrier b; b.bar = bar; b.x = xb_xcc_id(); b.st = st;
    if (threadIdx.x == 0) (void)xb_add(&bar[XB_XCNT(b.x)], 1u);
    return b;
}
__device__ __forceinline__ void xcd_barrier_complete(unsigned* bar, unsigned x, unsigned& nloc, unsigned& nx) {
    const unsigned G = gridDim.x * gridDim.y * gridDim.z;
    unsigned sum, cnt, mine, sp = 0u;
    for (;;) {
        sum = 0u; cnt = 0u; mine = 0u;
#pragma unroll
        for (unsigned j = 0; j < 16; ++j) { const unsigned c = xb_ld(&bar[XB_XCNT(j)]); sum += c; cnt += (c > 0u) ? 1u : 0u; mine = (j == x) ? c : mine; }
        if (sum == G) break;
        __builtin_amdgcn_s_sleep(1);
        if ((++sp & 255u) == 0u) { if (xb_ld(&bar[XB_TMO])) break; if (sp > XB_SPIN_CAP) { atomicAdd(&bar[XB_TMO], 1u); break; } }
    }
    nloc = mine > 0u ? mine : 1u; nx = cnt > 0u ? cnt : 1u;
}
__device__ __forceinline__ void xcd_barrier(const XcdBarrier& b) {
    asm volatile("s_waitcnt vmcnt(0)" ::: "memory");
    __syncthreads();
    if (threadIdx.x == 0) {
        unsigned* bar = b.bar;
        __builtin_amdgcn_s_waitcnt(0);
        unsigned nloc = b.st[0], nx = b.st[1];
        if (nloc == 0u) { xcd_barrier_complete(bar, b.x, nloc, nx); b.st[0] = nloc; b.st[1] = nx; }
        const unsigned old = xb_add(&bar[XB_XSUB(b.x)], 1u);
        const unsigned gen = old / nloc;
        if (old + 1u == (gen + 1u) * nloc) {
            __builtin_amdgcn_fence(__ATOMIC_RELEASE, "agent");
            asm volatile("s_waitcnt vmcnt(0)" ::: "memory");
            const unsigned og = xb_add(&bar[XB_TOP], 1u);
            const unsigned tg = og / nx;
            if (og + 1u == (tg + 1u) * nx) xb_add(&bar[XB_TOPGEN], 1u);
            else XB_SPIN(xb_ld(&bar[XB_TOPGEN]) == tg, bar);
            __builtin_amdgcn_fence(__ATOMIC_ACQUIRE, "agent");
            xb_add(&bar[XB_XGEN(b.x)], 1u);
            asm volatile("s_waitcnt vmcnt(0)" ::: "memory");
        } else {
            XB_SPIN(xb_ld(&bar[XB_XGEN(b.x)]) == gen, bar);
            __builtin_amdgcn_fence(__ATOMIC_ACQUIRE, "agent");
            asm volatile("s_waitcnt vmcnt(0)" ::: "memory");
        }
    }
    __syncthreads();
}

namespace pg8 {
constexpr int BM = 256, BK = 64, HALF = 128, HTB = HALF * BK * 2, STAGE_BYTES = 8 * HTB, NXCD = 8, WGM = 8;
__host__ __device__ __forceinline__ int lds_byte(int r, int c) { const int st = (r >> 4) * 2 + (c >> 5), rr = r & 15, cc = c & 31, ob = rr * 64 + cc * 2; return st * 1024 + (ob ^ (((ob >> 9) & 1) << 5)); }
__host__ __device__ __forceinline__ void stage_rc(int b, int& R, int& C) { const int st = b / 1024, sb = b % 1024, swz = sb ^ (((sb >> 9) & 1) << 5); R = (st >> 1) * 16 + swz / 64; C = (st & 1) * 32 + (swz % 64) / 2; }
__host__ __device__ __forceinline__ int perm32(int rho) { const int n = rho >> 4, i = rho & 15; return 8 * (i >> 2) + 4 * n + (i & 3); }

struct Unit { int pm, pn, aux; };

struct Order {
    int nM, nN, nwg, G, c;
    __device__ __forceinline__ void init(int nM_, int nN_, int G_, int c_) { nM = nM_; nN = nN_; nwg = nM * nN; G = G_; c = c_; }
    __device__ __forceinline__ bool tile(int i, int& pm, int& pn) const {
        const long L = (long)i * G + c; if (L >= nwg) return false;
        int wgid = (int)L; { const int q = nwg / NXCD, r = nwg % NXCD, xcd = wgid % NXCD, off = wgid / NXCD; wgid = (xcd < r ? xcd * (q + 1) : r * (q + 1) + (xcd - r) * q) + off; }
        const int nig = WGM * nN, gid = wgid / nig, fm = gid * WGM, gsz = (nM - fm) < WGM ? (nM - fm) : WGM;
        pm = fm + ((wgid % nig) % gsz); pn = (wgid % nig) / gsz; return true;
    }
};


template <class Epi, class Sched, bool ALIGN_EPI, bool SP2, bool GATHER, bool FP8 = false>
__device__ __forceinline__ void gemm_phase(LAS unsigned char* lds, const int tid, const int K, const int lda, const int ldb, const Sched& S, const Epi& E) {
    const int wid = __builtin_amdgcn_readfirstlane(tid >> 6), lane = tid & 63, wr = wid >> 2, wc = wid & 3, fr = lane & 15, fq = lane >> 4;
    const int nt = K / BK;
    unsigned voffA[2], voffB[2]; int rA[2], cA2[2];
#pragma unroll
    for (int i = 0; i < 2; ++i) { int R, C; stage_rc(tid * 16 + i * 8192, R, C); const int Rb = Epi::PERM ? ((R & ~31) + perm32(R & 31)) : R;
        voffA[i] = (unsigned)(R * lda + C) * 2u; voffB[i] = (unsigned)(Rb * ldb + C) * 2u; rA[i] = R; cA2[i] = C * 2; }
    const size_t kstep = (size_t)(BK * 2);
    const size_t hstepA = (size_t)HALF * lda * 2, hstepB = (size_t)HALF * ldb * 2;
    const unsigned ldsw = (unsigned)wid * 1024u;
    const int aoff = FP8 ? lds_byte(wr * 64 + fr, fq * 16) : lds_byte(wr * 64 + fr, fq * 8), boff = FP8 ? lds_byte(wc * 32 + fr, fq * 16) : lds_byte(wc * 32 + fr, fq * 8);
    unsigned cv0[2] = {0u, 0u}, cv1[2] = {0u, 0u}, nv0[2] = {0u, 0u}, nv1[2] = {0u, 0u};
#define PG8_SA(b, h) (((b) * 2 + (h)) * HTB)
#define PG8_SB(b, h) ((4 + (b) * 2 + (h)) * HTB)
#define PG8_STAGE(bufoff, gbase, voff) do { _Pragma("unroll") for (int _i = 0; _i < 2; ++_i) \
        __builtin_amdgcn_global_load_lds((const unsigned*)((const char*)(gbase) + (voff)[_i]), (LAS unsigned*)(lds + (bufoff) + ldsw + _i * 8192), 16, 0, 0); } while (0)
#define PG8_STAGE_A(bufoff, ptr, h, nx) do { if constexpr (GATHER) { unsigned _v[2]; _v[0] = (nx) ? ((h) ? nv1[0] : nv0[0]) : ((h) ? cv1[0] : cv0[0]); _v[1] = (nx) ? ((h) ? nv1[1] : nv0[1]) : ((h) ? cv1[1] : cv0[1]); PG8_STAGE(bufoff, ptr, _v); } \
        else { PG8_STAGE(bufoff, (ptr) + (h) * hstepA, voffA); } } while (0)
#define PG8_LDA(dst, b, h) do { if constexpr (FP8) { _Pragma("unroll") for (int m = 0; m < 4; ++m) { dst##8[m].lo = *(const LAS v4i_*)(lds + PG8_SA(b, h) + aoff + m * 2048); dst##8[m].hi = *(const LAS v4i_*)(lds + PG8_SA(b, h) + aoff + m * 2048 + 16); } } \
        else { _Pragma("unroll") for (int m = 0; m < 4; ++m) _Pragma("unroll") for (int k = 0; k < 2; ++k) dst[m][k] = *(const LAS bf16x8*)(lds + PG8_SA(b, h) + aoff + m * 2048 + k * 1024); } } while (0)
#define PG8_LDB(dst, b, h) do { if constexpr (FP8) { _Pragma("unroll") for (int n = 0; n < 2; ++n) { dst##8[n].lo = *(const LAS v4i_*)(lds + PG8_SB(b, h) + boff + n * 2048); dst##8[n].hi = *(const LAS v4i_*)(lds + PG8_SB(b, h) + boff + n * 2048 + 16); } } \
        else { _Pragma("unroll") for (int n = 0; n < 2; ++n) _Pragma("unroll") for (int k = 0; k < 2; ++k) dst[n][k] = *(const LAS bf16x8*)(lds + PG8_SB(b, h) + boff + n * 2048 + k * 1024); } } while (0)
#define PG8_MMA(ai, bj, At, Bt) do { __builtin_amdgcn_s_setprio(1); _Pragma("unroll") for (int m = 0; m < 4; ++m) _Pragma("unroll") for (int n = 0; n < 2; ++n) { \
        if constexpr (FP8) asm volatile("v_mfma_scale_f32_16x16x128_f8f6f4 %0, %1, %2, %0, %3, %4 op_sel_hi:[0,0,0]" : "+v"(acc[ai][bj][m][n]) : "v"(Bt##8[n]), "v"(At##8[m]), "v"(sclW), "v"(sclA));   \
        else { _Pragma("unroll") for (int k = 0; k < 2; ++k) acc[ai][bj][m][n] = __builtin_amdgcn_mfma_f32_16x16x32_bf16(Bt[n][k], At[m][k], acc[ai][bj][m][n], 0, 0, 0); } } \
        __builtin_amdgcn_s_setprio(0); } while (0)
#define PG8_WAIT_V(n) asm volatile("s_waitcnt vmcnt(" #n ")" ::: "memory")
#define PG8_WAIT_L(n) asm volatile("s_waitcnt lgkmcnt(" #n ")" ::: "memory")
#define PG8_BAR __builtin_amdgcn_s_barrier()
#define PG8_SCHED __builtin_amdgcn_sched_barrier(0)
#define PG8_ROWS(u, d0, d1) do { _Pragma("unroll") for (int _i = 0; _i < 2; ++_i) { const int _r0 = S.a_row(u, rA[_i]), _r1 = S.a_row(u, HALF + rA[_i]); \
        d0[_i] = (unsigned)_r0 * (unsigned)(lda * 2) + (unsigned)cA2[_i]; d1[_i] = (unsigned)_r1 * (unsigned)(lda * 2) + (unsigned)cA2[_i]; } } while (0)
    Unit cur, nxt; int ui = 0;
    if (!S.next(0, cur)) return;
    f32x4 acc[2][2][4][2];
#pragma unroll
    for (int a = 0; a < 2; ++a)
#pragma unroll
        for (int b = 0; b < 2; ++b)
#pragma unroll
            for (int m = 0; m < 4; ++m)
#pragma unroll
                for (int n = 0; n < 2; ++n) acc[a][b][m][n] = (f32x4){0.f, 0.f, 0.f, 0.f};
    typedef int v8i_ __attribute__((ext_vector_type(8))); typedef int v4i_ __attribute__((ext_vector_type(4)));
    bf16x8 At[4][2], B0[2][2], B1[2][2]; v8i_ At8[4], B08[2], B18[2];
    const int sclW = 0x7a7a7a7a, sclA = 0x7f7f7f7f;
    const char* cA = S.a_ptr(cur); const char* cB = S.b_ptr(cur);
    if constexpr (GATHER) { PG8_ROWS(cur, cv0, cv1); }
    if constexpr (SP2) {
        PG8_STAGE(PG8_SB(0, 0), cB, voffB); PG8_STAGE(PG8_SB(0, 1), cB + hstepB, voffB); PG8_STAGE_A(PG8_SA(0, 0), cA, 0, false); PG8_STAGE_A(PG8_SA(0, 1), cA, 1, false);
        if (wr == 1) PG8_BAR;
        PG8_WAIT_V(2); PG8_BAR;
        PG8_STAGE(PG8_SB(1, 0), cB + kstep, voffB); PG8_STAGE_A(PG8_SA(1, 0), cA + kstep, 0, false); PG8_STAGE(PG8_SB(1, 1), cB + hstepB + kstep, voffB);
        PG8_WAIT_V(6); PG8_BAR;
    } else {
        PG8_STAGE(PG8_SB(0, 0), cB, voffB); PG8_STAGE_A(PG8_SA(0, 0), cA, 0, false); PG8_STAGE(PG8_SB(0, 1), cB + hstepB, voffB); PG8_STAGE_A(PG8_SA(0, 1), cA, 1, false);
        if (wr == 1) PG8_BAR;
        PG8_WAIT_V(4); PG8_BAR;
        PG8_STAGE(PG8_SB(1, 0), cB + kstep, voffB); PG8_STAGE_A(PG8_SA(1, 0), cA + kstep, 0, false); PG8_STAGE(PG8_SB(1, 1), cB + hstepB + kstep, voffB);
        PG8_WAIT_V(6); PG8_BAR;
    }
    for (;;) {
        const bool has_next = S.next(ui + 1, nxt);
        const char* nA = has_next ? S.a_ptr(nxt) : cA; const char* nB = has_next ? S.b_ptr(nxt) : cB;
        if constexpr (GATHER) { if (has_next) { PG8_ROWS(nxt, nv0, nv1); } else { nv0[0] = cv0[0]; nv0[1] = cv0[1]; nv1[0] = cv1[0]; nv1[1] = cv1[1]; } }
        for (int t = 0; t < nt; t += 2) {
            const bool last = (t == nt - 2);
            const char* a1 = cA + (size_t)(t + 1) * kstep;
            const char* a2 = last ? nA : cA + (size_t)(t + 2) * kstep; const char* b2 = last ? nB : cB + (size_t)(t + 2) * kstep;
            const char* a3 = a2 + kstep; const char* b3 = b2 + kstep;
            if constexpr (SP2) {
            PG8_LDB(B0, 0, 0); PG8_LDB(B1, 0, 1); PG8_SCHED; PG8_LDA(At, 0, 0); PG8_STAGE_A(PG8_SA(1, 1), a1, 1, false);
            PG8_WAIT_V(8); PG8_WAIT_L(0); PG8_BAR; PG8_MMA(0, 0, At, B0); PG8_MMA(0, 1, At, B1); PG8_BAR; PG8_SCHED;
            PG8_LDA(At, 0, 1); PG8_STAGE(PG8_SB(0, 0), b2, voffB); PG8_STAGE(PG8_SB(0, 1), b2 + hstepB, voffB); PG8_STAGE_A(PG8_SA(0, 0), a2, 0, last);
            PG8_WAIT_V(8); PG8_WAIT_L(0); PG8_BAR; PG8_MMA(1, 0, At, B0); PG8_MMA(1, 1, At, B1); PG8_BAR; PG8_SCHED;
            PG8_LDB(B0, 1, 0); PG8_LDB(B1, 1, 1); PG8_SCHED; PG8_LDA(At, 1, 0); PG8_STAGE_A(PG8_SA(0, 1), a2, 1, last);
            PG8_WAIT_V(8); PG8_WAIT_L(0); PG8_BAR; PG8_MMA(0, 0, At, B0); PG8_MMA(0, 1, At, B1); PG8_BAR; PG8_SCHED;
            PG8_LDA(At, 1, 1); PG8_STAGE(PG8_SB(1, 0), b3, voffB); PG8_STAGE(PG8_SB(1, 1), b3 + hstepB, voffB); PG8_STAGE_A(PG8_SA(1, 0), a3, 0, last);
            PG8_WAIT_V(8); PG8_WAIT_L(0); PG8_BAR; PG8_MMA(1, 0, At, B0); PG8_MMA(1, 1, At, B1); PG8_BAR; PG8_SCHED;
            } else {
            PG8_LDB(B0, 0, 0); PG8_SCHED; PG8_LDA(At, 0, 0); PG8_STAGE_A(PG8_SA(1, 1), a1, 1, false);
            PG8_WAIT_L(8); PG8_BAR; PG8_WAIT_L(0); PG8_MMA(0, 0, At, B0); PG8_BAR; PG8_SCHED;
            PG8_LDB(B1, 0, 1); PG8_STAGE(PG8_SB(0, 0), b2, voffB);
            PG8_BAR; PG8_WAIT_L(0); PG8_MMA(0, 1, At, B1); PG8_BAR;
            PG8_LDA(At, 0, 1); PG8_STAGE_A(PG8_SA(0, 0), a2, 0, last);
            PG8_BAR; PG8_WAIT_L(0); PG8_MMA(1, 0, At, B0); PG8_BAR; PG8_SCHED;
            PG8_STAGE(PG8_SB(0, 1), b2 + hstepB, voffB);
            PG8_WAIT_V(6); PG8_BAR; PG8_MMA(1, 1, At, B1); PG8_BAR;
            PG8_LDB(B0, 1, 0); PG8_SCHED; PG8_LDA(At, 1, 0); PG8_STAGE_A(PG8_SA(0, 1), a2, 1, last);
            PG8_WAIT_L(8); PG8_BAR; PG8_WAIT_L(0); PG8_MMA(0, 0, At, B0); PG8_BAR; PG8_SCHED;
            PG8_LDB(B1, 1, 1); PG8_STAGE(PG8_SB(1, 0), b3, voffB);
            PG8_BAR; PG8_WAIT_L(0); PG8_MMA(0, 1, At, B1); PG8_BAR;
            PG8_LDA(At, 1, 1); PG8_STAGE_A(PG8_SA(1, 0), a3, 0, last);
            PG8_BAR; PG8_WAIT_L(0); PG8_MMA(1, 0, At, B0); PG8_BAR; PG8_SCHED;
            PG8_STAGE(PG8_SB(1, 1), b3 + hstepB, voffB);
            PG8_WAIT_V(6); PG8_BAR; PG8_MMA(1, 1, At, B1); PG8_BAR;
            }
        }
        if constexpr (ALIGN_EPI) { if (wr == 0) PG8_BAR; }
        if constexpr (FP8) asm volatile("s_nop 15\n\ts_nop 15" ::: "memory");
        E(acc, cur, wr, wc, fr, fq);
        if (!has_next) break;
#pragma unroll
        for (int a = 0; a < 2; ++a)
#pragma unroll
            for (int b = 0; b < 2; ++b)
#pragma unroll
                for (int m = 0; m < 4; ++m)
#pragma unroll
                    for (int n = 0; n < 2; ++n) acc[a][b][m][n] = (f32x4){0.f, 0.f, 0.f, 0.f};
        cur = nxt; cA = nA; cB = nB; ++ui;
        if constexpr (GATHER) { cv0[0] = nv0[0]; cv0[1] = nv0[1]; cv1[0] = nv1[0]; cv1[1] = nv1[1]; }
        if constexpr (ALIGN_EPI) { if (wr == 1) PG8_BAR; }
    }
    PG8_WAIT_V(0);
    if constexpr (!ALIGN_EPI) { if (wr == 0) PG8_BAR; }
    PG8_BAR;
#undef PG8_SA
#undef PG8_SB
#undef PG8_STAGE
#undef PG8_STAGE_A
#undef PG8_LDA
#undef PG8_LDB
#undef PG8_MMA
#undef PG8_WAIT_V
#undef PG8_WAIT_L
#undef PG8_BAR
#undef PG8_SCHED
#undef PG8_ROWS
}
}

using pg8::Unit;
struct SchedPlain : pg8::Order {
    const char* A; const char* B; size_t a_tile, b_tile;
    __device__ __forceinline__ bool next(int i, Unit& u) const { u.aux = 0; return tile(i, u.pm, u.pn); }
    __device__ __forceinline__ const char* a_ptr(const Unit& u) const { return A + (size_t)u.pm * a_tile; }
    __device__ __forceinline__ const char* b_ptr(const Unit& u) const { return B + (size_t)u.pn * b_tile; }
    __device__ __forceinline__ int a_row(const Unit&, int) const { return 0; }
};
struct SchedS5 : pg8::Order {
    const char* A; const char* B; size_t a_tile, b_tile, b_group;
    __device__ __forceinline__ bool next(int i, Unit& u) const { u.aux = 0; return tile(i, u.pm, u.pn); }
    __device__ __forceinline__ const char* a_ptr(const Unit& u) const { return A + (size_t)u.pm * a_tile; }
    __device__ __forceinline__ const char* b_ptr(const Unit& u) const { return B + (size_t)(u.pm >> 2) * b_group + (size_t)u.pn * b_tile; }
    __device__ __forceinline__ int a_row(const Unit&, int) const { return 0; }
};
template <bool GATHER> struct SchedMoe : pg8::Order {
    const char* A; const char* B; size_t a_tile, b_tile, b_exp; const LAS int* tile_e; int tile0, e0; const int* slot_tok; int row0;
    __device__ __forceinline__ bool next(int i, Unit& u) const { const bool ok = tile(i, u.pm, u.pn); u.aux = ok ? tile_e[tile0 + u.pm] : 0; return ok; }
    __device__ __forceinline__ const char* a_ptr(const Unit& u) const { return GATHER ? A : A + (size_t)u.pm * a_tile; }
    __device__ __forceinline__ const char* b_ptr(const Unit& u) const { return B + (size_t)(u.aux - e0) * b_exp + (size_t)u.pn * b_tile; }
    __device__ __forceinline__ int a_row(const Unit& u, int r) const { return slot_tok[row0 + u.pm * 256 + r]; }
};

__device__ __forceinline__ void st8(bf16* p, const f32x4 v0, const f32x4 v1) {
    u32x4 w; w.x = cvt_pk_bf16(v0[0], v0[1]); w.y = cvt_pk_bf16(v0[2], v0[3]); w.z = cvt_pk_bf16(v1[0], v1[1]); w.w = cvt_pk_bf16(v1[2], v1[3]); *(u32x4*)p = w;
}
__device__ __forceinline__ void ld8(const bf16* p, f32x4& v0, f32x4& v1) {
    const u32x4 w = *(const u32x4*)p; v0 = (f32x4){lo16(w.x), hi16(w.x), lo16(w.y), hi16(w.y)}; v1 = (f32x4){lo16(w.z), hi16(w.z), lo16(w.w), hi16(w.w)};
}
#define EPI_LOOP_AM _Pragma("unroll") for (int ai = 0; ai < 2; ++ai) _Pragma("unroll") for (int m = 0; m < 4; ++m)
#define EPI_ARGS f32x4 (&acc)[2][2][4][2], const Unit& u, int wr, int wc, int fr, int fq

struct EpiProj { static constexpr bool PERM = true; bf16 *AG, *RKV, *LP;
    __device__ __forceinline__ void operator()(EPI_ARGS) const {
        const int row0 = u.pm * 256 + wr * 64 + fr;
        if (u.pn < 2) { const int col0 = u.pn * 256 + wc * 32 + 8 * fq;
            EPI_LOOP_AM { const int row = row0 + ai * 128 + m * 16;
#pragma unroll
                for (int bj = 0; bj < 2; ++bj) { const int c = col0 + bj * 128; st8(AG + ((size_t)((c >> 4) * 1024 + (row >> 5))) * 640 + (row & 31) * 16 + (c & 15), acc[ai][bj][m][0], acc[ai][bj][m][1]); } }
        } else {
            bf16* base; int ldc, c0;
            if (u.pn < 8) { base = RKV; ldc = 1536; c0 = (u.pn - 2) * 256; } else { base = LP; ldc = 512; c0 = (u.pn - 8) * 256; }
            const int col0 = c0 + wc * 32 + 8 * fq;
            EPI_LOOP_AM { bf16* rowp = base + (size_t)(row0 + ai * 128 + m * 16) * ldc + col0;
#pragma unroll
                for (int bj = 0; bj < 2; ++bj) st8(rowp + bj * 128, acc[ai][bj][m][0], acc[ai][bj][m][1]); }
        }
    }
};
struct EpiBf16Plain { static constexpr bool PERM = true; bf16* O; int ldc;
    __device__ __forceinline__ void operator()(EPI_ARGS) const {
        const int row0 = u.pm * 256 + wr * 64 + fr, col0 = u.pn * 256 + wc * 32 + 8 * fq;
        EPI_LOOP_AM { bf16* rowp = O + (size_t)(row0 + ai * 128 + m * 16) * ldc + col0;
#pragma unroll
            for (int bj = 0; bj < 2; ++bj) st8(rowp + bj * 128, acc[ai][bj][m][0], acc[ai][bj][m][1]); }
    }
};
struct EpiF32 { static constexpr bool PERM = false; float* C; int ldc;
    __device__ __forceinline__ void operator()(EPI_ARGS) const {
        const int row0 = u.pm * 256 + wr * 64 + fr, col0 = u.pn * 256 + wc * 32 + 4 * fq;
        EPI_LOOP_AM { float* rowp = C + (size_t)(row0 + ai * 128 + m * 16) * ldc + col0;
#pragma unroll
            for (int bj = 0; bj < 2; ++bj)
#pragma unroll
                for (int n = 0; n < 2; ++n) *(f32x4*)(rowp + bj * 128 + n * 16) = acc[ai][bj][m][n]; }
    }
};
struct EpiS5Y { static constexpr bool PERM = true; const bf16* AG; const float* dskip; bf16* Y1;
    __device__ __forceinline__ void operator()(EPI_ARGS) const {
        const int g = u.pm >> 2, crow0 = (u.pm & 3) * 256 + wr * 64 + fr, col0 = u.pn * 256 + wc * 32 + 8 * fq;
        EPI_LOOP_AM { const int crow = crow0 + ai * 128 + m * 16;
#pragma unroll
            for (int bj = 0; bj < 2; ++bj) { const int col = col0 + bj * 128, t = col >> 4, c = col & 15;
                f32x4 u0, u1; ld8(AG + ((size_t)(g * 1024 + crow)) * 640 + col, u0, u1);
                const f32x4 d0 = *(const f32x4*)(dskip + g * 16 + c), d1 = *(const f32x4*)(dskip + g * 16 + c + 4);
                f32x4 v0 = acc[ai][bj][m][0] + d0 * u0, v1 = acc[ai][bj][m][1] + d1 * u1;
#pragma unroll
                for (int j = 0; j < 4; ++j) { v0[j] = gelu_tanh(v0[j]); v1[j] = gelu_tanh(v1[j]); }
                st8(Y1 + (size_t)(crow * 32 + t) * 512 + g * 16 + c, v0, v1); } }
    }
};
struct EpiGlu { static constexpr bool PERM = true; const bf16* Y1; bf16* MIX;
    __device__ __forceinline__ void operator()(EPI_ARGS) const {
        const int row0 = u.pm * 256 + wr * 64 + fr, col0 = u.pn * 256 + wc * 32 + 8 * fq;
        EPI_LOOP_AM { const int row = row0 + ai * 128 + m * 16;
#pragma unroll
            for (int bj = 0; bj < 2; ++bj) { const int col = col0 + bj * 128; f32x4 y0, y1v; ld8(Y1 + (size_t)row * 512 + col, y0, y1v);
                f32x4 v0, v1;
#pragma unroll
                for (int j = 0; j < 4; ++j) { v0[j] = y0[j] * fsigmoid(acc[ai][bj][m][0][j]); v1[j] = y1v[j] * fsigmoid(acc[ai][bj][m][1][j]); }
                st8(MIX + (size_t)row * 1024 + col, v0, v1); } }
    }
};
struct EpiResid { static constexpr bool PERM = true; const float* X; bf16* O;
    __device__ __forceinline__ void operator()(EPI_ARGS) const {
        const int row0 = u.pm * 256 + wr * 64 + fr, col0 = u.pn * 256 + wc * 32 + 8 * fq;
        EPI_LOOP_AM { const size_t off = (size_t)(row0 + ai * 128 + m * 16) * 1024 + col0;
#pragma unroll
            for (int bj = 0; bj < 2; ++bj) { const f32x4 x0 = *(const f32x4*)(X + off + bj * 128), x1 = *(const f32x4*)(X + off + bj * 128 + 4); st8(O + off + bj * 128, x0 + acc[ai][bj][m][0], x1 + acc[ai][bj][m][1]); } }
    }
};
struct EpiGU { static constexpr bool PERM = true; unsigned char* ACT; const float* bg; const float* bu;
    __device__ __forceinline__ void operator()(EPI_ARGS) const {
        const int row0 = u.pm * 256 + wr * 64 + fr, col = u.pn * 128 + wc * 32 + 8 * fq; const int e = u.aux;
        const f32x4 g0 = *(const f32x4*)(bg + e * 1024 + col), g1 = *(const f32x4*)(bg + e * 1024 + col + 4), u0 = *(const f32x4*)(bu + e * 1024 + col), u1 = *(const f32x4*)(bu + e * 1024 + col + 4);
        EPI_LOOP_AM { f32x4 v0, v1;
#pragma unroll
            for (int j = 0; j < 4; ++j) {
                const float gt0 = fminf(acc[ai][0][m][0][j] + g0[j], 7.0f), up0 = fminf(fmaxf(acc[ai][1][m][0][j] + u0[j], -7.0f), 7.0f);
                const float gt1 = fminf(acc[ai][0][m][1][j] + g1[j], 7.0f), up1 = fminf(fmaxf(acc[ai][1][m][1][j] + u1[j], -7.0f), 7.0f);
                v0[j] = (up0 + 1.0f) * gt0 * fsigmoid(1.702f * gt0); v1[j] = (up1 + 1.0f) * gt1 * fsigmoid(1.702f * gt1); }
            u32x2 w; w.x = pk4_fp8(v0[0], v0[1], v0[2], v0[3]); w.y = pk4_fp8(v1[0], v1[1], v1[2], v1[3]); *(u32x2*)(ACT + (size_t)(row0 + ai * 128 + m * 16) * 1024 + col) = w; }
    }
};
struct EpiDown { static constexpr bool PERM = true; unsigned char* Y; const float* bd;
    __device__ __forceinline__ void operator()(EPI_ARGS) const {
        const int row0 = u.pm * 256 + wr * 64 + fr, col0 = u.pn * 256 + wc * 32 + 8 * fq; const int e = u.aux;
        EPI_LOOP_AM { unsigned char* rowp = Y + (size_t)(row0 + ai * 128 + m * 16) * 1024 + col0;
#pragma unroll
            for (int bj = 0; bj < 2; ++bj) { const f32x4 b0 = *(const f32x4*)(bd + e * 1024 + col0 + bj * 128), b1 = *(const f32x4*)(bd + e * 1024 + col0 + bj * 128 + 4);
                const f32x4 v0 = acc[ai][bj][m][0] + b0, v1 = acc[ai][bj][m][1] + b1; u32x2 w; w.x = pk4_fp8(v0[0], v0[1], v0[2], v0[3]); w.y = pk4_fp8(v1[0], v1[1], v1[2], v1[3]); *(u32x2*)(rowp + bj * 128) = w; } }
    }
};
struct EpiPle { static constexpr bool PERM = true; const bf16* PP; bf16* O;
    __device__ __forceinline__ void operator()(EPI_ARGS) const {
        const int row0 = u.pm * 256 + wr * 64 + fr, col0 = u.pn * 256 + wc * 32 + 8 * fq;
        EPI_LOOP_AM { const size_t off = (size_t)(row0 + ai * 128 + m * 16) * 1024 + col0;
#pragma unroll
            for (int bj = 0; bj < 2; ++bj) { f32x4 p0, p1, x0, x1; ld8(PP + off + bj * 128, p0, p1); ld8(O + off + bj * 128, x0, x1);
#pragma unroll
                for (int j = 0; j < 4; ++j) { x0[j] += p0[j] * fsigmoid(acc[ai][bj][m][0][j]); x1[j] += p1[j] * fsigmoid(acc[ai][bj][m][1][j]); }
                st8(O + off + bj * 128, x0, x1); } }
    }
};

struct EpiPleNorm { static constexpr bool PERM = true; const bf16* PP; const bf16* XIN; float* OUT; const float* gfin; float* rowss; unsigned* pcnt;
    __device__ __forceinline__ void operator()(EPI_ARGS) const {
        const int row0 = u.pm * 256 + wr * 64 + fr, col0 = u.pn * 256 + wc * 32 + 8 * fq;
        EPI_LOOP_AM { const size_t off = (size_t)(row0 + ai * 128 + m * 16) * 1024 + col0; float s = 0.f;
#pragma unroll
            for (int bj = 0; bj < 2; ++bj) { f32x4 p0, p1, x0, x1; ld8(PP + off + bj * 128, p0, p1); ld8(XIN + off + bj * 128, x0, x1);
#pragma unroll
                for (int j = 0; j < 4; ++j) { x0[j] += p0[j] * fsigmoid(acc[ai][bj][m][0][j]); x1[j] += p1[j] * fsigmoid(acc[ai][bj][m][1][j]); s += x0[j] * x0[j] + x1[j] * x1[j]; }
                acc[ai][bj][m][0] = x0; acc[ai][bj][m][1] = x1; }
            s += __shfl_xor(s, 16); s += __shfl_xor(s, 32);
            if (fq == 0) atomicAdd(rowss + row0 + ai * 128 + m * 16, s); }
        asm volatile("s_waitcnt vmcnt(0)" ::: "memory");
        unsigned* cnt = pcnt + 64 * u.pm;
        if ((fr | fq) == 0) __hip_atomic_fetch_add(cnt, 1u, __ATOMIC_RELAXED, __HIP_MEMORY_SCOPE_AGENT);
        { unsigned sp = 0; while (__builtin_amdgcn_readfirstlane(__hip_atomic_load(cnt, __ATOMIC_RELAXED, __HIP_MEMORY_SCOPE_AGENT)) < 32u) { __builtin_amdgcn_s_sleep(2); if (++sp > (1u << 22)) break; } }
        f32x4 gv[2][2];
#pragma unroll
        for (int bj = 0; bj < 2; ++bj) { gv[bj][0] = *(const f32x4*)(gfin + col0 + bj * 128); gv[bj][1] = *(const f32x4*)(gfin + col0 + bj * 128 + 4); }
        EPI_LOOP_AM { const int row = row0 + ai * 128 + m * 16; const float ssr = __hip_atomic_load(rowss + row, __ATOMIC_RELAXED, __HIP_MEMORY_SCOPE_AGENT); const float rinv = rsqrtf(ssr * (1.f / 1024.f) + 1e-6f);
            float* orow = OUT + (size_t)row * 1024 + col0;
#pragma unroll
            for (int bj = 0; bj < 2; ++bj) { *(f32x4*)(orow + bj * 128) = acc[ai][bj][m][0] * rinv * gv[bj][0]; *(f32x4*)(orow + bj * 128 + 4) = acc[ai][bj][m][1] * rinv * gv[bj][1]; } }
    }
};

struct Ctx { LAS unsigned char* lds; int tid, lane, wave, G, wg, gw, NGW; };

template <int NBW>
__device__ __forceinline__ void transpose_item(const float* W, int N, int k0, int n0, bf16* dst, int ldk, const float* scl, int flip, LAS float* scr, int lane) {
    constexpr int LPR = NBW / 4, RPI = 64 / LPR, NI = 64 / RPI;
    const int rr = lane / LPR, cc = (lane % LPR) * 4;
    f32x4 v[NI];
#pragma unroll
    for (int i = 0; i < NI; ++i) v[i] = *(const f32x4*)(W + (size_t)(k0 + i * RPI + rr) * N + n0 + cc);
#pragma unroll
    for (int i = 0; i < NI; ++i) { const int kk = i * RPI + rr; f32x4 x = v[i];
        if (scl) { const float s0 = scl[k0 + kk]; const float f = flip ? (1.0f - s0) : s0; x = x * f; }
        LAS float* d = scr + kk * 65 + cc; d[0] = x.x; d[1] = x.y; d[2] = x.z; d[3] = x.w; }
    LDS_WAIT(); asm volatile("" ::: "memory");
    const int c = lane & 7;
#pragma unroll
    for (int j = 0; j < NBW / 8; ++j) { const int n = (lane >> 3) + 8 * j; const LAS float* s = scr + (8 * c) * 65 + n;
        u32x4 o; o.x = pk2(s[0 * 65], s[1 * 65]); o.y = pk2(s[2 * 65], s[3 * 65]); o.z = pk2(s[4 * 65], s[5 * 65]); o.w = pk2(s[6 * 65], s[7 * 65]);
        *(u32x4*)(dst + (size_t)n * ldk + 8 * c) = o; }
    LDS_WAIT(); asm volatile("" ::: "memory");
}
__device__ __forceinline__ void transpose_item_fp8(const float* W, int N, int k0, int n0, unsigned char* dst, int ldk, float scale, LAS float* scr, int lane) {
    const int rr = lane >> 4, cc = (lane & 15) * 4;
    f32x4 v[16];
#pragma unroll
    for (int i = 0; i < 16; ++i) v[i] = *(const f32x4*)(W + (size_t)(k0 + i * 4 + rr) * N + n0 + cc);
#pragma unroll
    for (int i = 0; i < 16; ++i) { const int kk = i * 4 + rr; LAS float* d = scr + kk * 65 + cc; d[0] = v[i].x * scale; d[1] = v[i].y * scale; d[2] = v[i].z * scale; d[3] = v[i].w * scale; }
    LDS_WAIT(); asm volatile("" ::: "memory");
    const int c = lane & 3;
#pragma unroll
    for (int j = 0; j < 4; ++j) { const int n = (lane >> 2) + 16 * j; const LAS float* s = scr + (16 * c) * 65 + n;
        u32x4 o; o.x = pk4_fp8(s[0 * 65], s[1 * 65], s[2 * 65], s[3 * 65]); o.y = pk4_fp8(s[4 * 65], s[5 * 65], s[6 * 65], s[7 * 65]); o.z = pk4_fp8(s[8 * 65], s[9 * 65], s[10 * 65], s[11 * 65]); o.w = pk4_fp8(s[12 * 65], s[13 * 65], s[14 * 65], s[15 * 65]);
        *(u32x4*)(dst + (size_t)n * ldk + 16 * c) = o; }
    LDS_WAIT(); asm volatile("" ::: "memory");
}
__device__ __forceinline__ void transpose_matrix(const Ctx& cx, const float* W, int K, int N, bf16* WT, int row_off, int ldk, int koff, const float* scl, int flip) {
    LAS float* scr = (LAS float*)(cx.lds + cx.wave * 16640);
    const int nblk = N / 64, nitems = (K / 64) * nblk;
    for (int it = cx.gw; it < nitems; it += cx.NGW) { const int kb = it / nblk, nb = it % nblk;
        transpose_item<64>(W, N, 64 * kb, 64 * nb, WT + (size_t)(row_off + 64 * nb) * ldk + koff + 64 * kb, ldk, scl, flip, scr, cx.lane); }
}
__device__ __forceinline__ void rms_row_to_bf16(const float* xrow, const float* g, bf16* orow, int lane) {
    const f32x4* xr = (const f32x4*)xrow + lane; const f32x4* gr = (const f32x4*)g + lane;
    f32x4 v[4]; float s = 0.f;
#pragma unroll
    for (int j = 0; j < 4; ++j) { v[j] = xr[64 * j]; s += (v[j].x * v[j].x + v[j].y * v[j].y) + (v[j].z * v[j].z + v[j].w * v[j].w); }
    const float rinv = rsqrtf(wave_sum(s) * (1.f / 1024.f) + 1e-6f);
    u32x2* o8 = (u32x2*)orow + lane;
#pragma unroll
    for (int j = 0; j < 4; ++j) { const f32x4 gg = gr[64 * j]; u32x2 w; w.x = pk2(v[j].x * rinv * gg.x, v[j].y * rinv * gg.y); w.y = pk2(v[j].z * rinv * gg.z, v[j].w * rinv * gg.w); o8[64 * j] = w; }
}

__device__ __forceinline__ void rms_rows2_to_bf16(const float* xa, const float* xb, const float* g, bf16* oa, bf16* ob, int lane) {
    const f32x4* ra = (const f32x4*)xa + lane; const f32x4* rb = (const f32x4*)xb + lane; const f32x4* gr = (const f32x4*)g + lane;
    f32x4 va[4], vb[4]; float sa = 0.f, sb = 0.f;
#pragma unroll
    for (int j = 0; j < 4; ++j) { va[j] = ra[64 * j]; vb[j] = rb[64 * j]; }
#pragma unroll
    for (int j = 0; j < 4; ++j) { sa += (va[j].x * va[j].x + va[j].y * va[j].y) + (va[j].z * va[j].z + va[j].w * va[j].w); sb += (vb[j].x * vb[j].x + vb[j].y * vb[j].y) + (vb[j].z * vb[j].z + vb[j].w * vb[j].w); }
#pragma unroll
    for (int o = 1; o < 64; o <<= 1) { sa += __shfl_xor(sa, o); sb += __shfl_xor(sb, o); }
    const float ia = rsqrtf(sa * (1.f / 1024.f) + 1e-6f), ib = rsqrtf(sb * (1.f / 1024.f) + 1e-6f);
    u32x2* pa = (u32x2*)oa + lane; u32x2* pb = (u32x2*)ob + lane;
#pragma unroll
    for (int j = 0; j < 4; ++j) { const f32x4 gg = gr[64 * j]; u32x2 w; w.x = pk2(va[j].x * ia * gg.x, va[j].y * ia * gg.y); w.y = pk2(va[j].z * ia * gg.z, va[j].w * ia * gg.w); pa[64 * j] = w;
        w.x = pk2(vb[j].x * ib * gg.x, vb[j].y * ib * gg.y); w.y = pk2(vb[j].z * ib * gg.z, vb[j].w * ib * gg.w); pb[64 * j] = w; }
}

__device__ __forceinline__ void s5_tables_item(const Ctx& cx, int g, int part, const float* lam_re, const float* lam_im, const float* log_dt, const float* b_re, const float* b_im, const float* c_re, const float* c_im,
                                               bf16* BT, bf16* ET, float* AT) {
    LAS float* apr = (LAS float*)cx.lds; LAS float* api = apr + 33 * 64; LAS float* bbr = api + 33 * 64; LAS float* bbi = bbr + 1024; LAS float* cr = bbi + 1024; LAS float* ci = cr + 1024; LAS float* kt = ci + 1024;
    const int tid = cx.tid;
    const float dt = __expf(log_dt[g]);
    for (int idx = tid; idx < 33 * 64; idx += NTHR) { const int j = idx >> 6, p = idx & 63;
        const float lre = fminf(lam_re[g * 64 + p], -1e-4f), lim = lam_im[g * 64 + p];
        const float mag = expf(lre * dt * (float)j), ang = lim * dt * (float)j; float sn, cs; sincosf(ang, &sn, &cs);
        apr[idx] = mag * cs; api[idx] = mag * sn; }
    for (int idx = tid; idx < 1024; idx += NTHR) { const int p = idx >> 4;
        const float lre = fminf(lam_re[g * 64 + p], -1e-4f), lim = lam_im[g * 64 + p];
        const float mag = expf(lre * dt); float sn, cs; sincosf(lim * dt, &sn, &cs); const float lbr = mag * cs, lbi = mag * sn;
        const float den = lre * lre + lim * lim, zr = lbr - 1.0f; const float cor = (zr * lre + lbi * lim) / den, coi = (lbi * lre - zr * lim) / den;
        const float br = b_re[g * 1024 + idx], bi = b_im[g * 1024 + idx];
        bbr[idx] = cor * br - coi * bi; bbi[idx] = cor * bi + coi * br;
        cr[idx] = c_re[g * 1024 + idx]; ci[idx] = c_im[g * 1024 + idx]; }
    __syncthreads();
    if (tid < 64) { const int jl = tid >> 4, c = tid & 15, j = 4 * part + jl; float acc[16];
#pragma unroll
        for (int i = 0; i < 16; ++i) acc[i] = 0.f;
        for (int p = 0; p < 64; ++p) { const float ar = apr[j * 64 + p], ai = api[j * 64 + p], xr = cr[c * 64 + p], xi = ci[c * 64 + p];
            const float car = xr * ar - xi * ai, cai = xr * ai + xi * ar;
#pragma unroll
            for (int v4 = 0; v4 < 4; ++v4) { const f32x4 br = *(const LAS f32x4*)(bbr + p * 16 + 4 * v4), bi = *(const LAS f32x4*)(bbi + p * 16 + 4 * v4);
                acc[4 * v4 + 0] += car * br.x - cai * bi.x; acc[4 * v4 + 1] += car * br.y - cai * bi.y; acc[4 * v4 + 2] += car * br.z - cai * bi.z; acc[4 * v4 + 3] += car * br.w - cai * bi.w; } }
#pragma unroll
        for (int i = 0; i < 16; ++i) kt[jl * 256 + c * 16 + i] = acc[i]; }
    __syncthreads();
    bf16* BTg = BT + (size_t)g * 512 * 640; bf16* ETg = ET + (size_t)g * 256 * 512;
    for (int idx = tid; idx < 4096; idx += NTHR) { const int hf = idx & 1, c = (idx >> 1) & 15, t = (idx >> 5) & 31, jl = idx >> 10, j = 4 * part + jl;
        if (t >= j) { const LAS float* s = kt + jl * 256 + c * 16 + hf * 8; u32x4 o; o.x = pk2(s[0], s[1]); o.y = pk2(s[2], s[3]); o.z = pk2(s[4], s[5]); o.w = pk2(s[6], s[7]);
            *(u32x4*)(BTg + (size_t)(t * 16 + c) * 640 + (t - j) * 16 + hf * 8) = o; } }
    for (int idx = tid; idx < 4096; idx += NTHR) { const int hf = idx & 1, c = (idx >> 1) & 15, s = (idx >> 5) & 31, t = 4 * part + (idx >> 10);
        if (s > t) *(u32x4*)(BTg + (size_t)(t * 16 + c) * 640 + s * 16 + hf * 8) = (u32x4){0u, 0u, 0u, 0u}; }
    for (int idx = tid; idx < 1024; idx += NTHR) { const int ch = idx & 15, c = (idx >> 4) & 15, t = 4 * part + (idx >> 8); const int im = ch >> 3, p0 = (ch & 7) * 8; float v[8];
#pragma unroll
        for (int q = 0; q < 8; ++q) { const int p = p0 + q; const float ar = apr[(t + 1) * 64 + p], ai = api[(t + 1) * 64 + p], xr = cr[c * 64 + p], xi = ci[c * 64 + p];
            v[q] = im ? -(xr * ai + xi * ar) : (xr * ar - xi * ai); }
        u32x4 o; o.x = pk2(v[0], v[1]); o.y = pk2(v[2], v[3]); o.z = pk2(v[4], v[5]); o.w = pk2(v[6], v[7]);
        *(u32x4*)(BTg + (size_t)(t * 16 + c) * 640 + 512 + im * 64 + p0) = o; }
    for (int idx = tid; idx < 1024; idx += NTHR) { const int hf = idx & 1, sl = (idx >> 1) & 3, n = idx >> 3, s = 4 * part + sl, p = n & 63, im = n >> 6; float v[8];
        const float ar = apr[(31 - s) * 64 + p], ai = api[(31 - s) * 64 + p];
#pragma unroll
        for (int q = 0; q < 8; ++q) { const float br = bbr[p * 16 + hf * 8 + q], bi = bbi[p * 16 + hf * 8 + q]; v[q] = im ? (ar * bi + ai * br) : (ar * br - ai * bi); }
        u32x4 o; o.x = pk2(v[0], v[1]); o.y = pk2(v[2], v[3]); o.z = pk2(v[4], v[5]); o.w = pk2(v[6], v[7]);
        *(u32x4*)(ETg + (size_t)n * 512 + s * 16 + hf * 8) = o; }
    for (int idx = tid; idx < 1024; idx += NTHR) { const int ch = idx & 63, r = 128 + 16 * part + (idx >> 6); *(u32x4*)(ETg + (size_t)r * 512 + ch * 8) = (u32x4){0u, 0u, 0u, 0u}; }
    if (part == 0 && tid < 64) { AT[(g * 64 + tid) * 2] = apr[32 * 64 + tid]; AT[(g * 64 + tid) * 2 + 1] = api[32 * 64 + tid]; }
    __syncthreads();
}

constexpr int IMG_LD = 80, IMG_B = 64 * IMG_LD * 2;
#define IMG(k) ((LAS bf16*)(lds + (k) * IMG_B))
#define LDS_BARRIER() do { asm volatile("s_waitcnt lgkmcnt(0)" ::: "memory"); __builtin_amdgcn_s_barrier(); asm volatile("" ::: "memory"); } while (0)
struct MmCtx { int tr, tc0, l15, q; };
__device__ __forceinline__ void mm64(const LAS bf16* A, const LAS bf16* Bt, f32x4 (&acc)[2], const MmCtx& w) {
#pragma unroll
    for (int s = 0; s < 2; ++s) {
        const bf16x8 a = *(const LAS bf16x8*)(A + (16 * w.tr + w.l15) * IMG_LD + 32 * s + 8 * w.q);
#pragma unroll
        for (int c = 0; c < 2; ++c) { const bf16x8 b = *(const LAS bf16x8*)(Bt + (16 * (w.tc0 + c) + w.l15) * IMG_LD + 32 * s + 8 * w.q);
            acc[c] = __builtin_amdgcn_mfma_f32_16x16x32_bf16(a, b, acc[c], 0, 0, 0); }
    }
}
__device__ __forceinline__ void mm64_2a(const LAS bf16* A1, const LAS bf16* A2, const LAS bf16* Bt, f32x4 (&acc1)[2], f32x4 (&acc2)[2], const MmCtx& w) {
#pragma unroll
    for (int s = 0; s < 2; ++s) {
        const bf16x8 a1 = *(const LAS bf16x8*)(A1 + (16 * w.tr + w.l15) * IMG_LD + 32 * s + 8 * w.q), a2 = *(const LAS bf16x8*)(A2 + (16 * w.tr + w.l15) * IMG_LD + 32 * s + 8 * w.q);
#pragma unroll
        for (int c = 0; c < 2; ++c) { const bf16x8 b = *(const LAS bf16x8*)(Bt + (16 * (w.tc0 + c) + w.l15) * IMG_LD + 32 * s + 8 * w.q);
            acc1[c] = __builtin_amdgcn_mfma_f32_16x16x32_bf16(a1, b, acc1[c], 0, 0, 0); acc2[c] = __builtin_amdgcn_mfma_f32_16x16x32_bf16(a2, b, acc2[c], 0, 0, 0); }
    }
}
__device__ __forceinline__ void mm64_2b(const LAS bf16* A, const LAS bf16* Bt1, const LAS bf16* Bt2, f32x4 (&acc1)[2], f32x4 (&acc2)[2], const MmCtx& w) {
#pragma unroll
    for (int s = 0; s < 2; ++s) {
        const bf16x8 a = *(const LAS bf16x8*)(A + (16 * w.tr + w.l15) * IMG_LD + 32 * s + 8 * w.q);
#pragma unroll
        for (int c = 0; c < 2; ++c) { const bf16x8 b1 = *(const LAS bf16x8*)(Bt1 + (16 * (w.tc0 + c) + w.l15) * IMG_LD + 32 * s + 8 * w.q), b2 = *(const LAS bf16x8*)(Bt2 + (16 * (w.tc0 + c) + w.l15) * IMG_LD + 32 * s + 8 * w.q);
            acc1[c] = __builtin_amdgcn_mfma_f32_16x16x32_bf16(a, b1, acc1[c], 0, 0, 0); acc2[c] = __builtin_amdgcn_mfma_f32_16x16x32_bf16(a, b2, acc2[c], 0, 0, 0); }
    }
}
__device__ __forceinline__ float dpp_x1(float v) { return __int_as_float(__builtin_amdgcn_update_dpp(0, __float_as_int(v), 0xB1, 0xF, 0xF, true)); }
__device__ __forceinline__ float dpp_x2(float v) { return __int_as_float(__builtin_amdgcn_update_dpp(0, __float_as_int(v), 0x4E, 0xF, 0xF, true)); }
__device__ __forceinline__ f32x4 quad_transpose(const f32x4 v, int b) {
    const bool odd = (b & 1) != 0, hi = (b & 2) != 0;
    const float r0 = dpp_x1(odd ? v[0] : v[1]), r1 = dpp_x1(odd ? v[2] : v[3]);
    const float p0a = odd ? r0 : v[0], p0b = odd ? v[1] : r0, p1a = odd ? r1 : v[2], p1b = odd ? v[3] : r1;
    const float ra = dpp_x2(hi ? p0a : p1a), rb = dpp_x2(hi ? p0b : p1b);
    return hi ? (f32x4){ra, rb, p1a, p1b} : (f32x4){p0a, p0b, ra, rb};
}
__device__ __forceinline__ void st_rm(LAS bf16* img, const f32x4 v, int tr, int tc, const MmCtx& w) {
    const unsigned p01 = pk2(v[0], v[1]), p23 = pk2(v[2], v[3]); LAS bf16* d = img + (16 * tr + 4 * w.q) * IMG_LD + 16 * tc + w.l15;
    d[0] = (bf16)p01; d[IMG_LD] = (bf16)(p01 >> 16); d[2 * IMG_LD] = (bf16)p23; d[3 * IMG_LD] = (bf16)(p23 >> 16);
}
__device__ __forceinline__ void st_tr(LAS bf16* img, const f32x4 v, int tr, int tc, const MmCtx& w) {
    u32x2 o; o.x = pk2(v[0], v[1]); o.y = pk2(v[2], v[3]); *(LAS u32x2*)(img + (16 * tc + w.l15) * IMG_LD + 16 * tr + 4 * w.q) = o;
}
__device__ __forceinline__ void img_to_global(const LAS bf16* img, bf16* g, int tid) { const int row = tid >> 3, ch = tid & 7; *(u32x4*)(g + row * 64 + ch * 8) = *(const LAS u32x4*)(img + row * IMG_LD + ch * 8); }
__device__ __forceinline__ void st_tm8(LAS bf16* img, int t, int cg, const float (&v)[8]) {
    u32x4 o; o.x = pk2(v[0], v[1]); o.y = pk2(v[2], v[3]); o.z = pk2(v[4], v[5]); o.w = pk2(v[6], v[7]); *(LAS u32x4*)(img + t * IMG_LD + 8 * cg) = o;
}
__device__ __forceinline__ void st_cm8(LAS bf16* img, int t, int cg, const float (&v)[8]) {
#pragma unroll
    for (int i = 0; i < 8; i += 2) { const unsigned p = pk2(v[i], v[i + 1]); img[(8 * cg + i) * IMG_LD + t] = (bf16)p; img[(8 * cg + i + 1) * IMG_LD + t] = (bf16)(p >> 16); }
}
__device__ __forceinline__ float red8(float v) { v += __shfl_xor(v, 1); v += __shfl_xor(v, 2); v += __shfl_xor(v, 4); return v; }
__device__ __forceinline__ void unpack8(const u32x4 w, float (&o)[8]) { o[0] = lo16(w.x); o[1] = hi16(w.x); o[2] = lo16(w.y); o[3] = hi16(w.y); o[4] = lo16(w.z); o[5] = hi16(w.z); o[6] = lo16(w.w); o[7] = hi16(w.w); }
__device__ __forceinline__ void ldp8(const float* p, float (&o)[8]) { const f32x4 a = *(const f32x4*)p, b = *(const f32x4*)(p + 4); o[0] = a.x; o[1] = a.y; o[2] = a.z; o[3] = a.w; o[4] = b.x; o[5] = b.y; o[6] = b.z; o[7] = b.w; }

struct RwkvP { const bf16* rkv; const bf16* wag; const float *mu_rkv, *w0, *a0, *k_k, *k_a, *r_k, *ln_w, *ln_b; };
struct RwkvRaw { u32x4 kc, kp, vc, vp, wl, al, rc, rp, gg; };
template <bool PASS3>
__device__ __forceinline__ void rwkv_load(const RwkvP& P, int cidx, int tid, RwkvRaw& R) {
    const int t = tid >> 3, cg = tid & 7, bh = cidx >> 7, c = cidx & 127, b = bh >> 3, h = bh & 7, ch = h * 64 + 8 * cg;
    const size_t tok = (size_t)b * SEQ + c * 64 + t; const bool first = (c == 0 && t == 0);
    const bf16* row = P.rkv + tok * 1536 + ch; const bf16* prow = first ? row : row - 1536;
    R.kc = *(const u32x4*)(row + 512); R.vc = *(const u32x4*)(row + 1024); R.kp = *(const u32x4*)(prow + 512); R.vp = *(const u32x4*)(prow + 1024);
    R.wl = *(const u32x4*)(P.wag + tok * 1536 + ch); R.al = *(const u32x4*)(P.wag + tok * 1536 + 512 + ch);
    if (PASS3) { R.rc = *(const u32x4*)row; R.rp = *(const u32x4*)prow; R.gg = *(const u32x4*)(P.wag + tok * 1536 + 1024 + ch); }
}
struct RwkvC { float mu_r[8], mu_k[8], mu_v[8], w0[8], a0[8], kk[8], ka[8]; };
__device__ __forceinline__ void rwkv_consts(const RwkvP& P, int h, int cg, RwkvC& C) { const int ch = h * 64 + 8 * cg;
    ldp8(P.mu_rkv + ch, C.mu_r); ldp8(P.mu_rkv + 512 + ch, C.mu_k); ldp8(P.mu_rkv + 1024 + ch, C.mu_v); ldp8(P.w0 + ch, C.w0); ldp8(P.a0 + ch, C.a0); ldp8(P.k_k + ch, C.kk); ldp8(P.k_a + ch, C.ka); }
template <bool PASS3>
__device__ __forceinline__ void rwkv_prep(const RwkvRaw& R, const RwkvC& C, bool first, float (&kq)[8], float (&vv)[8], float (&rr)[8], float (&kap)[8], float (&bet)[8], float (&lw)[8]) {
    float kc[8], kp[8], vc[8], vp[8], k[8], wl[8], al[8], a[8];
    unpack8(R.kc, kc); unpack8(R.vc, vc); unpack8(R.kp, kp); unpack8(R.vp, vp); unpack8(R.wl, wl); unpack8(R.al, al);
    const float pm = first ? 0.f : 1.f;
#pragma unroll
    for (int i = 0; i < 8; ++i) { k[i] = kc[i] + (pm * kp[i] - kc[i]) * C.mu_k[i]; vv[i] = vc[i] + (pm * vp[i] - vc[i]) * C.mu_v[i]; }
    if (PASS3) { float rc[8], rp[8]; unpack8(R.rc, rc); unpack8(R.rp, rp);
#pragma unroll
        for (int i = 0; i < 8; ++i) rr[i] = rc[i] + (pm * rp[i] - rc[i]) * C.mu_r[i];
    } else {
#pragma unroll
        for (int i = 0; i < 8; ++i) rr[i] = 0.f;
    }
    float ss = 0.f;
#pragma unroll
    for (int i = 0; i < 8; ++i) { lw[i] = -0.6065306597126334f * fsigmoid(C.w0[i] + wl[i]); a[i] = fsigmoid(C.a0[i] + al[i]); kap[i] = k[i] * C.kk[i]; ss += kap[i] * kap[i]; }
    ss = red8(ss);
    const float inv = 1.0f / fmaxf(sqrtf(ss), 1e-12f);
#pragma unroll
    for (int i = 0; i < 8; ++i) { kap[i] *= inv; bet[i] = kap[i] * a[i]; kq[i] = k[i] * (1.0f + (a[i] - 1.0f) * C.ka[i]); }
}
template <int SEGSLOT>
__device__ __forceinline__ void rwkv_cumsum(LAS unsigned char* lds, int tid, const float (&lw)[8], float (&cum)[8], float (&cumL)[8]) {
    LAS float* LW = (LAS float*)(lds + 12 * IMG_B); LAS float* SEG = (LAS float*)(lds + SEGSLOT * IMG_B);
    const int t = tid >> 3, cg = tid & 7, j = tid & 63, seg = tid >> 6;
#pragma unroll
    for (int i = 0; i < 8; ++i) LW[t * 65 + 8 * cg + i] = lw[i];
    LDS_BARRIER();
    { float run = 0.f;
#pragma unroll
      for (int tt = 0; tt < 8; ++tt) { const int idx = (8 * seg + tt) * 65 + j; run += LW[idx]; LW[idx] = run; }
      SEG[seg * 64 + j] = run; }
    LDS_BARRIER();
    { float pre = 0.f;
#pragma unroll
      for (int s2 = 0; s2 < 8; ++s2) { const float x = SEG[s2 * 64 + j]; pre += (s2 < seg) ? x : 0.f; }
#pragma unroll
      for (int tt = 0; tt < 8; ++tt) LW[(8 * seg + tt) * 65 + j] += pre; }
    LDS_BARRIER();
#pragma unroll
    for (int i = 0; i < 8; ++i) { cum[i] = LW[t * 65 + 8 * cg + i]; cumL[i] = LW[63 * 65 + 8 * cg + i]; }
}
#define Z4 (f32x4){0.f, 0.f, 0.f, 0.f}

__device__ __forceinline__ void rwkv_pass1(LAS unsigned char* lds, const RwkvP& P, int c0, int n, int tid, bf16* QCT, float* HCT, bf16* W1G, bf16* ULG, float* DLG) {
    const int lane = tid & 63, wv = __builtin_amdgcn_readfirstlane(tid >> 6); MmCtx w; w.tr = wv >> 1; w.tc0 = (wv & 1) * 2; w.l15 = lane & 15; w.q = lane >> 4;
    const int t = tid >> 3, cg = tid & 7;
    RwkvC C; rwkv_consts(P, (c0 >> 7) & 7, cg, C);
    RwkvRaw R; rwkv_load<false>(P, c0, tid, R);
    for (int ci = 0; ci < n; ++ci) {
        const int cidx = c0 + ci;
        {
            float kq[8], vv[8], rr[8], kap[8], bet[8], lw[8], cum[8], cumL[8];
            rwkv_prep<false>(R, C, (cidx & 127) == 0 && t == 0, kq, vv, rr, kap, bet, lw);
            if (ci + 1 < n) rwkv_load<false>(P, cidx + 1, tid, R);
            rwkv_cumsum<11>(lds, tid, lw, cum, cumL);
            float x[8], y[8];
#pragma unroll
            for (int i = 0; i < 8; ++i) { const float en = __expf(-cum[i]); x[i] = kq[i] * en; y[i] = bet[i] * en; }
            st_tm8(IMG(0), t, cg, x);
            st_tm8(IMG(1), t, cg, y);
#pragma unroll
            for (int i = 0; i < 8; ++i) x[i] = kap[i] * __expf(cum[i] - lw[i]);
            st_tm8(IMG(2), t, cg, x);
            st_cm8(IMG(3), t, cg, x);
#pragma unroll
            for (int i = 0; i < 8; ++i) { const float eh = __expf(cumL[i] - cum[i]); x[i] = kq[i] * eh; y[i] = bet[i] * eh; }
            st_cm8(IMG(4), t, cg, x);
            st_cm8(IMG(5), t, cg, y);
            st_cm8(IMG(6), t, cg, vv);
            if (t == 0) {
#pragma unroll
                for (int i = 0; i < 8; ++i) DLG[(size_t)cidx * 64 + 8 * cg + i] = __expf(cumL[i]);
            }
        }
        LDS_BARRIER();
        f32x4 accX[2];
        {
            f32x4 a[2] = {Z4, Z4}, kk[2] = {Z4, Z4};
            mm64_2a(IMG(1), IMG(0), IMG(2), a, kk, w);
#pragma unroll
            for (int c = 0; c < 2; ++c) { const int nn = 16 * (w.tc0 + c) + w.l15;
#pragma unroll
                for (int r = 0; r < 4; ++r) { const int m = 16 * w.tr + 4 * w.q + r; a[c][r] = (m < nn) ? a[c][r] : 0.f; kk[c][r] = (m < nn) ? kk[c][r] : 0.f; accX[c][r] = ((m == nn) ? 1.0f : 0.f) - a[c][r]; }
                st_rm(IMG(7), a[c], w.tr, w.tc0 + c, w); st_tr(IMG(8), a[c], w.tr, w.tc0 + c, w); st_rm(IMG(10), accX[c], w.tr, w.tc0 + c, w); st_rm(IMG(9), kk[c], w.tr, w.tc0 + c, w); }
        }
        LDS_BARRIER();
        {
            f32x4 p[2] = {Z4, Z4};
            mm64(IMG(7), IMG(8), p, w);
#pragma unroll
            for (int c = 0; c < 2; ++c) { st_rm(IMG(12), p[c], w.tr, w.tc0 + c, w); st_tr(IMG(13), p[c], w.tr, w.tc0 + c, w); }
        }
        LDS_BARRIER();
#define NEUMANN(XC, XN, PC, PTC, PN, PTN, LASTR) do { if (LASTR) mm64(IMG(XC), IMG(PTC), accX, w); \
            if (!(LASTR)) { f32x4 p[2] = {Z4, Z4}; mm64_2a(IMG(XC), IMG(PC), IMG(PTC), accX, p, w); \
                _Pragma("unroll") for (int c = 0; c < 2; ++c) { st_rm(IMG(PN), p[c], w.tr, w.tc0 + c, w); st_tr(IMG(PTN), p[c], w.tr, w.tc0 + c, w); st_rm(IMG(XN), accX[c], w.tr, w.tc0 + c, w); } } \
            LDS_BARRIER(); } while (0)
        NEUMANN(10, 11, 12, 13, 0, 1, false);
        NEUMANN(11, 10, 0, 1, 12, 13, false);
        NEUMANN(10, 11, 12, 13, 0, 1, false);
        NEUMANN(11, 10, 0, 1, 12, 13, false);
        NEUMANN(10, 11, 12, 13, 0, 1, true);
#undef NEUMANN
#pragma unroll
        for (int c = 0; c < 2; ++c) st_tr(IMG(7), accX[c], w.tr, w.tc0 + c, w);
        LDS_BARRIER();
        {
            f32x4 a[2] = {Z4, Z4}, g[2] = {Z4, Z4};
            mm64_2a(IMG(3), IMG(9), IMG(7), a, g, w);
#pragma unroll
            for (int c = 0; c < 2; ++c) { st_rm(IMG(12), a[c], w.tr, w.tc0 + c, w); st_tr(IMG(2), a[c], w.tr, w.tc0 + c, w); st_tr(IMG(8), g[c], w.tr, w.tc0 + c, w); }
        }
        LDS_BARRIER();
        {
            f32x4 u[2] = {Z4, Z4}, qc[2] = {Z4, Z4};
            mm64(IMG(6), IMG(8), u, w); mm64(IMG(5), IMG(12), qc, w);
#pragma unroll
            for (int c = 0; c < 2; ++c) { st_rm(IMG(13), u[c], w.tr, w.tc0 + c, w);
                const int tc = w.tc0 + c, cp = 32 * (tc >> 1) + 8 * (w.l15 >> 2) + 4 * (tc & 1) + (w.l15 & 3);
                const unsigned p01 = pk2(qc[c][0], qc[c][1]), p23 = pk2(qc[c][2], qc[c][3]); LAS bf16* d = IMG(0) + (16 * w.tr + 4 * w.q) * IMG_LD + cp;
                d[0] = (bf16)p01; d[IMG_LD] = (bf16)(p01 >> 16); d[2 * IMG_LD] = (bf16)p23; d[3 * IMG_LD] = (bf16)(p23 >> 16); }
            img_to_global(IMG(2), W1G + (size_t)cidx * 4096, tid);
        }
        LDS_BARRIER();
        {
            f32x4 hp[2] = {Z4, Z4}, hn[2] = {Z4, Z4};
            mm64(IMG(4), IMG(6), hp, w); mm64(IMG(5), IMG(13), hn, w);
#pragma unroll
            for (int c = 0; c < 2; ++c) *(f32x4*)(HCT + (((size_t)cidx * 16 + w.tr * 4 + w.tc0 + c) * 64 + lane) * 4) = hp[c] - hn[c];
            img_to_global(IMG(13), ULG + (size_t)cidx * 4096, tid);
            img_to_global(IMG(0), QCT + (size_t)cidx * 4096, tid);
        }
        LDS_BARRIER();
    }
}

constexpr int P2_SLOT = 12544, P2_DEPTH = 5;
__device__ __forceinline__ void rwkv_pass2(LAS unsigned char* lds, int bh, int ti, int lane, const bf16* QCT, const float* HCT, const float* DLG, bf16* S0G) {
    const int l15 = lane & 15, q = lane >> 4;
    f32x4 X[4];
#pragma unroll
    for (int tj = 0; tj < 4; ++tj) X[tj] = Z4;
#define P2_DMA(cc) do { const size_t ci_ = (size_t)bh * 128 + (cc); LAS unsigned char* sl_ = lds + ((cc) % P2_DEPTH) * P2_SLOT; \
        _Pragma("unroll") for (int i = 0; i < 8; ++i) { const int row_ = i * 8 + (lane >> 3), pc_ = (lane & 7) ^ (row_ & 7); \
            __builtin_amdgcn_global_load_lds((const unsigned*)((const char*)QCT + (ci_ * 64 + row_) * 128 + pc_ * 16), (LAS unsigned*)(sl_ + i * 1024), 16, 0, 0); } \
        _Pragma("unroll") for (int tj = 0; tj < 4; ++tj) __builtin_amdgcn_global_load_lds((const unsigned*)((const char*)HCT + ((ci_ * 16 + tj * 4 + ti) * 64 + lane) * 16), (LAS unsigned*)(sl_ + 8192 + tj * 1024), 16, 0, 0); \
        __builtin_amdgcn_global_load_lds((const unsigned*)((const char*)DLG + (ci_ * 64 + lane) * 4), (LAS unsigned*)(sl_ + 12288), 4, 0, 0); } while (0)
    P2_DMA(0); P2_DMA(1); P2_DMA(2); P2_DMA(3);
    for (int c = 0; c < 128; ++c) {
        if (c < 124) asm volatile("s_waitcnt vmcnt(39)" ::: "memory"); else asm volatile("s_waitcnt vmcnt(0)" ::: "memory");
        const LAS unsigned char* sl = lds + (c % P2_DEPTH) * P2_SLOT;
        bf16x8 a[4][2]; f32x4 h[4], d[4];
#pragma unroll
        for (int tj = 0; tj < 4; ++tj) { const int row = 16 * tj + l15;
#pragma unroll
            for (int s = 0; s < 2; ++s) a[tj][s] = *(const LAS bf16x8*)(sl + row * 128 + (((4 * s + q) ^ (row & 7)) * 16));
            h[tj] = *(const LAS f32x4*)(sl + 8192 + tj * 1024 + lane * 16); d[tj] = *(const LAS f32x4*)(sl + 12288 + (16 * tj + 4 * q) * 4); }
        asm volatile("s_waitcnt lgkmcnt(0)" ::: "memory");
        if (c + 4 < 128) P2_DMA(c + 4);
        const size_t cidx = (size_t)bh * 128 + c;
#pragma unroll
        for (int tj = 0; tj < 4; ++tj) { u32x2 o; o.x = pk2(X[tj][0], X[tj][1]); o.y = pk2(X[tj][2], X[tj][3]); *(u32x2*)(S0G + (cidx * 64 + 16 * ti + l15) * 64 + 16 * tj + 4 * q) = o; }
        bf16x8 b[2];
#pragma unroll
        for (int s = 0; s < 2; ++s) { u32x4 o; o.x = pk2(X[2 * s][0], X[2 * s][1]); o.y = pk2(X[2 * s][2], X[2 * s][3]); o.z = pk2(X[2 * s + 1][0], X[2 * s + 1][1]); o.w = pk2(X[2 * s + 1][2], X[2 * s + 1][3]); b[s] = __builtin_bit_cast(bf16x8, o); }
#pragma unroll
        for (int tj = 0; tj < 4; ++tj) { f32x4 acc = Z4;
            acc = __builtin_amdgcn_mfma_f32_16x16x32_bf16(a[tj][0], b[0], acc, 0, 0, 0); acc = __builtin_amdgcn_mfma_f32_16x16x32_bf16(a[tj][1], b[1], acc, 0, 0, 0);
            X[tj] = d[tj] * X[tj] + h[tj] - acc; }
    }
    asm volatile("s_waitcnt vmcnt(0)" ::: "memory");
#undef P2_DMA
}

__device__ __forceinline__ void rwkv_pass3(LAS unsigned char* lds, const RwkvP& P, int c0, int n, int tid, const bf16* S0G, const bf16* W1G, const bf16* ULG, bf16* MIX) {
    const int lane = tid & 63, wv = __builtin_amdgcn_readfirstlane(tid >> 6); MmCtx w; w.tr = wv >> 1; w.tc0 = (wv & 1) * 2; w.l15 = lane & 15; w.q = lane >> 4;
    const int t = tid >> 3, cg = tid & 7, bh = c0 >> 7, b = bh >> 3, h = bh & 7, ch = h * 64 + 8 * cg;
    RwkvC C; rwkv_consts(P, h, cg, C);
    RwkvRaw R; rwkv_load<true>(P, c0, tid, R);
    u32x4 gS0, gW1, gUL;
    { const int row = tid >> 3, chk = tid & 7; const size_t o = (size_t)c0 * 4096 + row * 64 + chk * 8; gS0 = *(const u32x4*)(S0G + o); gW1 = *(const u32x4*)(W1G + o); gUL = *(const u32x4*)(ULG + o); }
    for (int ci = 0; ci < n; ++ci) {
        const int cidx = c0 + ci, c = cidx & 127;
        float vv[8], gg[8], bonus;
        {
            float kq[8], rr[8], kap[8], bet[8], lw[8], cum[8], cumL[8];
            rwkv_prep<true>(R, C, c == 0 && t == 0, kq, vv, rr, kap, bet, lw);
            unpack8(R.gg, gg);
            const u32x4 s0v = gS0, w1v = gW1, ulv = gUL;
            if (ci + 1 < n) { rwkv_load<true>(P, cidx + 1, tid, R);
                const int row = tid >> 3, chk = tid & 7; const size_t o = (size_t)(cidx + 1) * 4096 + row * 64 + chk * 8; gS0 = *(const u32x4*)(S0G + o); gW1 = *(const u32x4*)(W1G + o); gUL = *(const u32x4*)(ULG + o); }
            rwkv_cumsum<9>(lds, tid, lw, cum, cumL);
            float bs = 0.f, rk[8]; ldp8(P.r_k + ch, rk);
#pragma unroll
            for (int i = 0; i < 8; ++i) bs += rr[i] * kq[i] * rk[i];
            bonus = red8(bs);
            float x[8], y[8];
#pragma unroll
            for (int i = 0; i < 8; ++i) { const float en = __expf(-cum[i]); x[i] = kq[i] * en; y[i] = bet[i] * en; }
            st_tm8(IMG(1), t, cg, x);
            st_tm8(IMG(2), t, cg, y);
#pragma unroll
            for (int i = 0; i < 8; ++i) x[i] = rr[i] * __expf(cum[i]);
            st_tm8(IMG(0), t, cg, x);
            st_cm8(IMG(3), t, cg, vv);
            { const int row = tid >> 3, chk = tid & 7; *(LAS u32x4*)(IMG(4) + row * IMG_LD + chk * 8) = s0v; *(LAS u32x4*)(IMG(5) + row * IMG_LD + chk * 8) = w1v; *(LAS u32x4*)(IMG(6) + row * IMG_LD + chk * 8) = ulv; }
        }
        LDS_BARRIER();
        {
            f32x4 kr[2] = {Z4, Z4}, br[2] = {Z4, Z4}, u[2] = {Z4, Z4};
            mm64_2b(IMG(0), IMG(1), IMG(2), kr, br, w); mm64(IMG(4), IMG(5), u, w);
#pragma unroll
            for (int cc = 0; cc < 2; ++cc) { const int nn = 16 * (w.tc0 + cc) + w.l15;
#pragma unroll
                for (int r = 0; r < 4; ++r) { const int m = 16 * w.tr + 4 * w.q + r; kr[cc][r] = (nn <= m) ? kr[cc][r] : 0.f; br[cc][r] = (nn <= m) ? br[cc][r] : 0.f; u[cc][r] += bf2f(IMG(6)[m * IMG_LD + nn]); }
                st_rm(IMG(7), kr[cc], w.tr, w.tc0 + cc, w); st_rm(IMG(8), br[cc], w.tr, w.tc0 + cc, w); st_rm(IMG(9), u[cc], w.tr, w.tc0 + cc, w); }
        }
        LDS_BARRIER();
        {
            f32x4 yp[2] = {Z4, Z4}, yn[2] = {Z4, Z4};
            mm64(IMG(0), IMG(4), yp, w); mm64(IMG(7), IMG(3), yp, w); mm64(IMG(8), IMG(9), yn, w);
            LAS float* YF = (LAS float*)(lds + 10 * IMG_B);
#pragma unroll
            for (int cc = 0; cc < 2; ++cc)
#pragma unroll
                for (int r = 0; r < 4; ++r) YF[(16 * w.tr + 4 * w.q + r) * 65 + 16 * (w.tc0 + cc) + w.l15] = yp[cc][r] - yn[cc][r];
        }
        LDS_BARRIER();
        {
            const LAS float* YF = (const LAS float*)(lds + 10 * IMG_B);
            float y[8], s = 0.f;
#pragma unroll
            for (int i = 0; i < 8; ++i) { y[i] = YF[t * 65 + 8 * cg + i]; s += y[i]; }
            const float mean = red8(s) * (1.0f / 64.0f); float qv = 0.f;
#pragma unroll
            for (int i = 0; i < 8; ++i) { y[i] -= mean; qv += y[i] * y[i]; }
            const float rstd = rsqrtf(red8(qv) * (1.0f / 64.0f) + 64e-5f);
            float o[8], lnw[8], lnb[8]; ldp8(P.ln_w + ch, lnw); ldp8(P.ln_b + ch, lnb);
#pragma unroll
            for (int i = 0; i < 8; ++i) o[i] = (y[i] * rstd * lnw[i] + lnb[i] + bonus * vv[i]) * gg[i];
            const size_t tok = (size_t)b * SEQ + c * 64 + t;
            u32x4 ov; ov.x = pk2(o[0], o[1]); ov.y = pk2(o[2], o[3]); ov.z = pk2(o[4], o[5]); ov.w = pk2(o[6], o[7]);
            *(u32x4*)(MIX + tok * 1024 + 512 + ch) = ov;
        }
    }
}

constexpr int RW_LD = 1032;
__device__ __forceinline__ void router_phase(const Ctx& cx, const bf16* X1, const float* gnorm, const float* rw, const float* rb, unsigned char* H2, int* TOPE, float* TOPG, unsigned* HIST) {
    LAS bf16* WH = (LAS bf16*)cx.lds; LAS bf16* WL = WH + 32 * RW_LD;
    LAS unsigned* hcnt = (LAS unsigned*)(cx.lds + 135168);
    const int lane = cx.lane, l15 = lane & 15, q = lane >> 4;
    for (int idx = cx.tid; idx < 32768; idx += NTHR) { const int col = idx >> 5, e = idx & 31; const float v = rw[idx] * gnorm[col];
        const unsigned h = cvt_pk_bf16(v, 0.f) & 0xffffu; const float lo = v - bf2f(h); WH[e * RW_LD + col] = (bf16)h; WL[e * RW_LD + col] = (bf16)(cvt_pk_bf16(lo, 0.f) & 0xffffu); }
    const float b0 = rb[l15], b1 = rb[l15 + 16];
    for (int tb = cx.wg; tb < 256; tb += cx.G) {
        if (cx.tid < 32) hcnt[cx.tid] = 0u;
        __syncthreads();
        const int tok0 = tb * 128 + cx.wave * 16;
        const bf16* xrow = X1 + (size_t)(tok0 + l15) * 1024 + 8 * q;
        f32x4 acc[2] = {(f32x4){0.f, 0.f, 0.f, 0.f}, (f32x4){0.f, 0.f, 0.f, 0.f}}; float ss = 0.f;
#pragma unroll 4
        for (int s = 0; s < 32; ++s) {
            const u32x4 xw = *(const u32x4*)(xrow + 32 * s);
            { const float a0 = lo16(xw.x), a1 = hi16(xw.x), a2 = lo16(xw.y), a3 = hi16(xw.y), a4 = lo16(xw.z), a5 = hi16(xw.z), a6 = lo16(xw.w), a7 = hi16(xw.w);
              ss += (a0 * a0 + a1 * a1) + (a2 * a2 + a3 * a3) + (a4 * a4 + a5 * a5) + (a6 * a6 + a7 * a7); }
            const bf16x8 ah = __builtin_bit_cast(bf16x8, xw);
#pragma unroll
            for (int n = 0; n < 2; ++n) { const bf16x8 bh = *(const LAS bf16x8*)(WH + (l15 + 16 * n) * RW_LD + 32 * s + 8 * q), bl = *(const LAS bf16x8*)(WL + (l15 + 16 * n) * RW_LD + 32 * s + 8 * q);
                acc[n] = __builtin_amdgcn_mfma_f32_16x16x32_bf16(ah, bh, acc[n], 0, 0, 0); acc[n] = __builtin_amdgcn_mfma_f32_16x16x32_bf16(ah, bl, acc[n], 0, 0, 0); }
        }
        ss += __shfl_xor(ss, 16); ss += __shfl_xor(ss, 32);
        const float rinv_l = rsqrtf(ss * (1.f / 1024.f) + 1e-6f);
#pragma unroll
        for (int r = 0; r < 4; ++r) {
            const float ri = __shfl(rinv_l, 4 * q + r);
            float v0 = acc[0][r] * ri + b0, v1 = acc[1][r] * ri + b1; int se[4]; float sv[4];
#pragma unroll
            for (int k = 0; k < 4; ++k) { float bv = (v1 > v0) ? v1 : v0; int be = (v1 > v0) ? (l15 + 16) : l15;
#pragma unroll
                for (int off = 1; off < 16; off <<= 1) { const float ov = __shfl_xor(bv, off); const int oe = __shfl_xor(be, off); const bool take = (ov > bv) || (ov == bv && oe < be); bv = take ? ov : bv; be = take ? oe : be; }
                se[k] = be; sv[k] = bv; if (be == l15) v0 = -INFINITY; if (be == l15 + 16) v1 = -INFINITY; }
            if (l15 == r) { const int tok = tok0 + 4 * q + r;
                const float w1 = __expf(sv[1] - sv[0]), w2 = __expf(sv[2] - sv[0]), w3 = __expf(sv[3] - sv[0]); const float inv = 1.0f / (1.0f + w1 + w2 + w3);
                *(int4*)(TOPE + (size_t)tok * 4) = make_int4(se[0], se[1], se[2], se[3]);
                *(float4*)(TOPG + (size_t)tok * 4) = make_float4(inv, w1 * inv, w2 * inv, w3 * inv);
                atomicAdd((unsigned*)(hcnt + se[0]), 1u); atomicAdd((unsigned*)(hcnt + se[1]), 1u); atomicAdd((unsigned*)(hcnt + se[2]), 1u); atomicAdd((unsigned*)(hcnt + se[3]), 1u); }
        }
        const f32x4* gr = (const f32x4*)gnorm + lane;
#pragma unroll 2
        for (int i = 0; i < 16; ++i) { const float ri = __shfl(rinv_l, i); const u32x2* xr = (const u32x2*)(X1 + (size_t)(tok0 + i) * 1024) + lane; unsigned* o4 = (unsigned*)(H2 + (size_t)(tok0 + i) * 1024) + lane;
#pragma unroll
            for (int j = 0; j < 4; ++j) { const u32x2 v = xr[64 * j]; const f32x4 gg = gr[64 * j]; o4[64 * j] = pk4_fp8(lo16(v.x) * ri * gg.x, hi16(v.x) * ri * gg.y, lo16(v.y) * ri * gg.z, hi16(v.y) * ri * gg.w); } }
        __syncthreads();
        if (cx.tid < 32) HIST[tb * 32 + cx.tid] = hcnt[cx.tid];
        __syncthreads();
    }
}

constexpr int PL_BASE = 1280, PL_WCNT = 1312;
__device__ __forceinline__ void moe_plan(const Ctx& cx, const unsigned* HIST) {
    LAS int* PL = (LAS int*)(cx.lds + LDS_PLAN);
    const int e = cx.tid & 31, part = cx.tid >> 5;
    { int s = 0; for (int w = 16 * part; w < 16 * part + 16; ++w) s += (int)HIST[w * 32 + e]; PL[PL_TMP + part * 32 + e] = s; }
    __syncthreads();
    if (cx.tid < 32) { int c = 0; for (int p = 0; p < 16; ++p) c += PL[PL_TMP + p * 32 + cx.tid]; PL[PL_CNT + cx.tid] = c; }
    __syncthreads();
    if (cx.tid == 0) {
        int ps = 0;
        for (int x = 0; x < 32; ++x) { PL[PL_PSTART + x] = ps; const int pad = (PL[PL_CNT + x] + 255) & ~255; for (int i = 0; i < pad / 256; ++i) PL[PL_TILEE + ps / 256 + i] = x; ps += pad; }
        PL[PL_PSTART + 32] = ps;
        int np = 0, e0 = 0;
        while (e0 < 32 && np < 7) { PL[PL_PE0 + np] = e0; PL[PL_PROW0 + np] = PL[PL_PSTART + e0]; int rows = 0, e1 = e0;
            while (e1 < 32 && e1 - e0 < MAXEPP) { const int pad = PL[PL_PSTART + e1 + 1] - PL[PL_PSTART + e1]; if (rows + pad > RMAX && e1 > e0) break; rows += pad; ++e1; }
            e0 = e1; ++np; }
        PL[PL_PE0 + np] = 32; PL[PL_PROW0 + np] = ps; PL[PL_NPASS] = np;
    }
    __syncthreads();
}
__device__ __forceinline__ void dispatch_phase(const Ctx& cx, const unsigned* HIST, const int* TOPE, int* SLOTTOK, int* TOKSLOT) {
    LAS int* PL = (LAS int*)(cx.lds + LDS_PLAN);
    const int e5 = cx.tid & 31, part = cx.tid >> 5, lane = cx.lane;
    for (int tb = cx.wg; tb < 256; tb += cx.G) {
        { int s = 0; for (int w = 16 * part; w < 16 * part + 16; ++w) s += (w < tb) ? (int)HIST[w * 32 + e5] : 0; PL[PL_TMP + part * 32 + e5] = s; }
        const int tok = tb * 128 + (cx.tid >> 2), k = cx.tid & 3; const int e = TOPE[(size_t)tok * 4 + k];
        int rank = 0;
        for (int ee = 0; ee < 32; ++ee) { const unsigned long long mask = __ballot(e == ee); if (e == ee) rank = __popcll(mask & ((1ull << lane) - 1ull)); if (lane == 0) PL[PL_WCNT + cx.wave * 32 + ee] = __popcll(mask); }
        __syncthreads();
        if (cx.tid < 32) { int c = 0; for (int p = 0; p < 16; ++p) c += PL[PL_TMP + p * 32 + cx.tid]; PL[PL_BASE + cx.tid] = c; }
        __syncthreads();
        int off = 0; for (int w2 = 0; w2 < 8; ++w2) off += (w2 < cx.wave) ? PL[PL_WCNT + w2 * 32 + e] : 0;
        const int slot = PL[PL_PSTART + e] + PL[PL_BASE + e] + off + rank;
        SLOTTOK[slot] = tok; TOKSLOT[(size_t)tok * 4 + k] = slot;
        __syncthreads();
    }
    for (int e = cx.wg; e < 32; e += cx.G) { const int c = PL[PL_CNT + e], ps = PL[PL_PSTART + e], pe = PL[PL_PSTART + e + 1]; for (int r = ps + c + cx.tid; r < pe; r += NTHR) SLOTTOK[r] = 0; }
}
__device__ __forceinline__ void convert_pass(const Ctx& cx, int e0, int e1, const float* wg, const float* wu, const float* wd, unsigned char* WGU, unsigned char* WDN) {
    LAS float* scr = (LAS float*)(cx.lds + cx.wave * 16640);
    const int nitems = (e1 - e0) * 768;
    for (int it = cx.gw; it < nitems; it += cx.NGW) { const int le = it / 768, r = it % 768, mat = r >> 8, kb = (r & 255) >> 4, nb = r & 15, n0 = 64 * nb; const size_t eo = (size_t)(e0 + le) * 1048576;
        if (mat == 2) transpose_item_fp8(wd + eo, 1024, 64 * kb, n0, WDN + (size_t)le * 1048576 + (size_t)n0 * 1024 + 64 * kb, 1024, 32.0f, scr, cx.lane);
        else { const int drow = (n0 >> 7) * 256 + (n0 & 127) + mat * 128; transpose_item_fp8((mat ? wu : wg) + eo, 1024, 64 * kb, n0, WGU + (size_t)le * 2097152 + (size_t)drow * 1024 + 64 * kb, 1024, 32.0f, scr, cx.lane); } }
}
template <bool LAST>
__device__ __forceinline__ void combine_pass(const Ctx& cx, int e0, int e1, int row0, const int* TOPE, const float* TOPG, const int* TOKSLOT, const unsigned char* Y, bf16* X, const float* gnorm, unsigned char* H3) {
    for (int tok = cx.gw; tok < M; tok += cx.NGW) {
        const int4 es = *(const int4*)(TOPE + (size_t)tok * 4); const float4 gs = *(const float4*)(TOPG + (size_t)tok * 4); const int4 sl = *(const int4*)(TOKSLOT + (size_t)tok * 4);
        const int ee[4] = {es.x, es.y, es.z, es.w}; const float gg[4] = {gs.x, gs.y, gs.z, gs.w}; const int ss[4] = {sl.x, sl.y, sl.z, sl.w};
        bool any = false;
#pragma unroll
        for (int k = 0; k < 4; ++k) any |= (ee[k] >= e0 && ee[k] < e1);
        if (!LAST && !any) continue;
        u32x2* xr = (u32x2*)(X + (size_t)tok * 1024) + cx.lane; f32x4 v[4];
#pragma unroll
        for (int j = 0; j < 4; ++j) { const u32x2 w = xr[64 * j]; v[j] = (f32x4){lo16(w.x), hi16(w.x), lo16(w.y), hi16(w.y)}; }
#pragma unroll
        for (int k = 0; k < 4; ++k) if (ee[k] >= e0 && ee[k] < e1) { const unsigned* yr = (const unsigned*)(Y + (size_t)(ss[k] - row0) * 1024) + cx.lane; const float g = gg[k];
#pragma unroll
            for (int j = 0; j < 4; ++j) v[j] += up4_fp8(yr[64 * j]) * g; }
        if (any) {
#pragma unroll
            for (int j = 0; j < 4; ++j) { u32x2 w; w.x = pk2(v[j].x, v[j].y); w.y = pk2(v[j].z, v[j].w); xr[64 * j] = w; }
        }
        if (LAST) { float s = 0.f;
#pragma unroll
            for (int j = 0; j < 4; ++j) s += (v[j].x * v[j].x + v[j].y * v[j].y) + (v[j].z * v[j].z + v[j].w * v[j].w);
            const float rinv = rsqrtf(wave_sum(s) * (1.f / 1024.f) + 1e-6f); const f32x4* gr = (const f32x4*)gnorm + cx.lane; unsigned* o8 = (unsigned*)(H3 + (size_t)tok * 1024) + cx.lane;
#pragma unroll
            for (int j = 0; j < 4; ++j) { const f32x4 gq = gr[64 * j]; o8[64 * j] = pk4_fp8(v[j].x * rinv * gq.x, v[j].y * rinv * gq.y, v[j].z * rinv * gq.z, v[j].w * rinv * gq.w); } }
    }
}

#define HBUF ((bf16*)(ws + WS_R1))
#define RKV ((bf16*)(ws + WS_RKV))
#define WAG ((bf16*)(ws + WS_WAG))
#define AG ((bf16*)(ws + WS_AG))
#define UB ((bf16*)(ws + WS_U))
#define LP ((bf16*)(ws + WS_LP))
#define LACT ((bf16*)(ws + WS_LACT))
#define Y1 ((bf16*)(ws + WS_Y1))
#define MIX ((bf16*)(ws + WS_R1))
#define EBUF ((float*)(ws + WS_LP))
#define S0G ((bf16*)(ws + WS_LP))
#define QCT ((bf16*)(ws + WS_U))
#define HCT ((float*)(ws + WS_R1))
#define W1G ((bf16*)(ws + WS_W1))
#define ULG ((bf16*)(ws + WS_ULOC))
#define DLG ((float*)(ws + WS_DL))
#define ATG ((float*)(ws + WS_AT))
#define WCAT ((bf16*)(ws + WS_WCAT))
#define WL2 ((bf16*)(ws + WS_WL2))
#define WGLU ((bf16*)(ws + WS_WGLU))
#define WPP ((bf16*)(ws + WS_WPP))
#define WOUT ((bf16*)(ws + WS_WOUT))
#define WPG ((unsigned char*)(ws + WS_WPG))
#define S5BT ((bf16*)(ws + WS_S5BT))
#define S5ET ((bf16*)(ws + WS_S5ET))
#define PBF ((bf16*)(ws + WS_PBF))
#define H2 ((unsigned char*)(ws + WS_H2))
#define WGU ((unsigned char*)(ws + WS_WGU))
#define WDN ((unsigned char*)(ws + WS_WDN))
#define ACT ((unsigned char*)(ws + WS_ACT))
#define YB ((unsigned char*)(ws + WS_Y))
#define XB ((bf16*)(ws + WS_XB))
#define PP ((bf16*)(ws + WS_ACT))
#define HIST ((unsigned*)(ws + WS_HIST))
#define TOPE ((int*)(ws + WS_TOPE))
#define TOPG ((float*)(ws + WS_TOPG))
#define TOKSLOT ((int*)(ws + WS_TOKSLOT))
#define SLOTTOK ((int*)(ws + WS_SLOTTOK))
#ifndef FUSE_FNORM
#define FUSE_FNORM 1
#endif
#ifndef SPLIT_P5
#define SPLIT_P5 1
#endif
#ifndef MOE_ALIGN
#define MOE_ALIGN true
#endif
#ifndef PROBE_PH
#define PROBE_PH -1
#endif
#ifndef PROBE_N
#define PROBE_N 2
#endif
#define REPS(k) ((((k) >= 10 && (k) < 28) ? 10 + ((k) - 10) % 3 : (k)) == PROBE_PH ? PROBE_N : 1)
#ifndef ONLY_PHASE
#define ONLY_PHASE -1
#endif
constexpr int NPH = 31;
struct Args { const float* in[42]; float* out; unsigned char* ws; int ph_lo, ph_hi; };

__global__ void __launch_bounds__(NTHR, 2) mk_fwd(Args args) {
    extern __shared__ __attribute__((aligned(16))) unsigned char lds_raw[];
    LAS unsigned char* lds = (LAS unsigned char*)lds_raw;
#define CAS __attribute__((address_space(4)))
#define FRESH_CX const CAS char* ka_ = (const CAS char*)__builtin_amdgcn_kernarg_segment_ptr(); asm volatile("" : "+s"(ka_)); const float* const CAS* I = (const float* const CAS*)ka_; unsigned char* ws = *(unsigned char* const CAS*)(ka_ + 344); float* OUTP = *(float* const CAS*)(ka_ + 336); (void)I; (void)ws; (void)OUTP; \
    Ctx cx; { int t_ = threadIdx.x; asm volatile("" : "+v"(t_)); cx.lds = lds; cx.tid = t_; cx.lane = t_ & 63; cx.wave = __builtin_amdgcn_readfirstlane(t_ >> 6); cx.G = gridDim.x; cx.wg = blockIdx.x; cx.gw = cx.wg * NWAVES + cx.wave; cx.NGW = cx.G * NWAVES; }
    unsigned char* ws = args.ws;
    const int lo = args.ph_lo, hi = args.ph_hi;
    volatile LAS unsigned* MISC = (volatile LAS unsigned*)(lds + LDS_MISC);
    if (threadIdx.x < 64) MISC[threadIdx.x] = 0u;
    __syncthreads();
    XcdBarrier bar; bar.bar = (unsigned*)(ws + WS_CTL) + CW_BAR; bar.x = 0; bar.st = nullptr;
    if (hi - lo > 1) bar = xcd_barrier_post((unsigned*)(ws + WS_CTL) + CW_BAR, MISC + 8);

#define IN(k) ((ONLY_PHASE < 0 || ONLY_PHASE == (k) || (ONLY_PHASE >= 10 && ONLY_PHASE < 28 && (k) >= 10 && (k) < 28 && ((k) - 10) % 3 == (ONLY_PHASE - 10) % 3)) && lo <= (k) && (k) < hi)
#ifndef PROBE_BAR
#define PROBE_BAR 1
#endif
#ifndef PROBE_T
#define PROBE_T -1
#endif
#define STAMP() do { if (PROBE_T >= 0 && blockIdx.x == 0 && threadIdx.x == 0) { const unsigned long long t_ = __builtin_amdgcn_s_memrealtime(); MISC[16 + 2 * nst] = (unsigned)t_; MISC[17 + 2 * nst] = (unsigned)(t_ >> 32); } ++nst; } while (0)
#define SEAM(k) do { if (IN(k) && IN((k) + 1)) { for (int b_ = 0; b_ < PROBE_BAR; ++b_) xcd_barrier(bar); STAMP(); } } while (0)
    int nst = 0; STAMP();
#define MAKE_RP RwkvP RP; RP.rkv = RKV; RP.wag = WAG; RP.mu_rkv = I[13]; RP.w0 = I[15]; RP.a0 = I[18]; RP.k_k = I[23]; RP.k_a = I[24]; RP.r_k = I[25]; RP.ln_w = I[26]; RP.ln_b = I[27]
#define OPQ(v) ({ int _k = (v); asm volatile("" : "+s"(_k)); _k; })

    if (IN(0)) for (int rep_ = 0; rep_ < REPS(0); ++rep_) {
        FRESH_CX;
        for (int it = cx.wg; it < 256; it += cx.G) s5_tables_item(cx, it >> 3, it & 7, I[4], I[5], I[6], I[7], I[8], I[9], I[10], S5BT, S5ET, ATG);
        const float* mu = I[14];
        transpose_matrix(cx, I[3], 1024, 2048, WCAT, 0, 1024, 0, nullptr, 0);
        transpose_matrix(cx, I[16], 1024, 64, WCAT, 2048, 1024, 0, mu, 1);          transpose_matrix(cx, I[16], 1024, 64, WCAT, 2304, 1024, 0, mu, 0);
        transpose_matrix(cx, I[19], 1024, 64, WCAT, 2112, 1024, 0, mu + 1024, 1);   transpose_matrix(cx, I[19], 1024, 64, WCAT, 2368, 1024, 0, mu + 1024, 0);
        transpose_matrix(cx, I[21], 1024, 128, WCAT, 2176, 1024, 0, mu + 2048, 1);  transpose_matrix(cx, I[21], 1024, 128, WCAT, 2432, 1024, 0, mu + 2048, 0);
        transpose_matrix(cx, I[17], 64, 512, WL2, 0, 256, 0, nullptr, 0);
        transpose_matrix(cx, I[20], 64, 512, WL2, 512, 256, 64, nullptr, 0);
        transpose_matrix(cx, I[22], 128, 512, WL2, 1024, 256, 128, nullptr, 0);
        for (int idx = cx.wg * NTHR + cx.tid; idx < 1536 * 32; idx += cx.G * NTHR) { const int row = idx >> 5, ch = idx & 31, blk = row >> 9; const int kb = blk == 0 ? 0 : (blk == 1 ? 64 : 128), ke = blk == 0 ? 64 : (blk == 1 ? 128 : 256);
            if (ch * 8 < kb || ch * 8 >= ke) *(u32x4*)(WL2 + (size_t)row * 256 + ch * 8) = (u32x4){0u, 0u, 0u, 0u}; }
        transpose_matrix(cx, I[12], 512, 512, WGLU, 0, 512, 0, nullptr, 0);
        transpose_matrix(cx, I[39], 256, 1024, WPP, 0, 256, 0, nullptr, 0);
        transpose_matrix(cx, I[28], 1024, 1024, WOUT, 0, 1024, 0, nullptr, 0);
        { LAS float* scr = (LAS float*)(cx.lds + cx.wave * 16640);
          for (int it = cx.gw; it < 256; it += cx.NGW) { const int kb = it >> 4, nb = it & 15;
              transpose_item_fp8(I[40], 1024, 64 * kb, 64 * nb, WPG + (size_t)(64 * nb) * 1024 + 64 * kb, 1024, 32.0f, scr, cx.lane); } }
        for (int m = 2 * cx.gw; m < M; m += 2 * cx.NGW) rms_rows2_to_bf16(I[0] + (size_t)m * 1024, I[0] + (size_t)(m + 1) * 1024, I[2], HBUF + (size_t)m * 1024, HBUF + (size_t)(m + 1) * 1024, cx.lane);
        for (int m = 4 * cx.gw; m < M; m += 4 * cx.NGW) { f32x4 v[4];
#pragma unroll
            for (int r = 0; r < 4; ++r) v[r] = *((const f32x4*)(I[1] + (size_t)(m + r) * 256) + cx.lane);
#pragma unroll
            for (int r = 0; r < 4; ++r) { u32x2 w; w.x = pk2(v[r].x, v[r].y); w.y = pk2(v[r].z, v[r].w); *((u32x2*)(PBF + (size_t)(m + r) * 256) + cx.lane) = w; } }
    }
    SEAM(0);
    if (IN(1)) for (int rep_ = 0; rep_ < REPS(1); ++rep_) {
        FRESH_CX;
        SchedPlain S; S.init(128, 10, cx.G, cx.wg); S.A = (const char*)HBUF; S.B = (const char*)WCAT; S.a_tile = 256 * 1024 * 2; S.b_tile = 256 * 1024 * 2;
        EpiProj E{AG, RKV, LP};
        pg8::gemm_phase<EpiProj, SchedPlain, true, true, false>(lds, cx.tid, OPQ(1024), OPQ(1024), OPQ(1024), S, E);
    }
    SEAM(1);
    if (IN(2)) for (int rep_ = 0; rep_ < REPS(2); ++rep_) {
        FRESH_CX;
        for (int m = 2 * cx.gw; m < M; m += 2 * cx.NGW) {
            const int lane = cx.lane; const bool first = (m & (SEQ - 1)) == 0;
            const u32x2 a0 = *((const u32x2*)(LP + (size_t)m * 512) + lane), a1 = *((const u32x2*)(LP + (size_t)(m + 1) * 512) + lane), b1 = *((const u32x2*)(LP + (size_t)m * 512 + 256) + lane);
            u32x2 b0 = (u32x2){0u, 0u}; if (!first) b0 = *((const u32x2*)(LP + (size_t)(m - 1) * 512 + 256) + lane);
            float v[8] = {lo16(a0.x) + lo16(b0.x), hi16(a0.x) + hi16(b0.x), lo16(a0.y) + lo16(b0.y), hi16(a0.y) + hi16(b0.y), lo16(a1.x) + lo16(b1.x), hi16(a1.x) + hi16(b1.x), lo16(a1.y) + lo16(b1.y), hi16(a1.y) + hi16(b1.y)};
#pragma unroll
            for (int i = 0; i < 8; ++i) v[i] = lane < 16 ? ftanh(v[i]) : (lane < 32 ? v[i] : fsigmoid(v[i]));
            u32x2 o; o.x = pk2(v[0], v[1]); o.y = pk2(v[2], v[3]); *((u32x2*)(LACT + (size_t)m * 256) + lane) = o;
            o.x = pk2(v[4], v[5]); o.y = pk2(v[6], v[7]); *((u32x2*)(LACT + (size_t)(m + 1) * 256) + lane) = o;
        }
    }
    SEAM(2);
    if (IN(3)) for (int rep_ = 0; rep_ < REPS(3); ++rep_) {
        FRESH_CX;
        { SchedPlain S; S.init(128, 6, cx.G, cx.wg); S.A = (const char*)LACT; S.B = (const char*)WL2; S.a_tile = 256 * 256 * 2; S.b_tile = 256 * 256 * 2;
          EpiBf16Plain E{WAG, 1536};
          pg8::gemm_phase<EpiBf16Plain, SchedPlain, true, true, false>(lds, cx.tid, OPQ(256), OPQ(256), OPQ(256), S, E); }
        { SchedS5 S; S.init(128, 1, cx.G, cx.wg); S.A = (const char*)AG; S.B = (const char*)S5ET; S.a_tile = 256 * 640 * 2; S.b_tile = 0; S.b_group = 256 * 512 * 2;
          EpiF32 E{EBUF, 256};
          pg8::gemm_phase<EpiF32, SchedS5, true, true, false>(lds, cx.tid, OPQ(512), OPQ(640), OPQ(512), S, E); }
    }
    SEAM(3);
    if (IN(4)) for (int rep_ = 0; rep_ < REPS(4); ++rep_) {
        FRESH_CX;
        if (cx.wave == 0 && cx.lane < 32) {
            for (int idx = cx.wg * 32 + cx.lane; idx < 8192; idx += cx.G * 32) { const int b = idx >> 11, g = (idx >> 6) & 31, p = idx & 63;
                const float ar = ATG[(g * 64 + p) * 2], ai = ATG[(g * 64 + p) * 2 + 1]; float sr = 0.f, si = 0.f;
                const size_t row0 = (size_t)g * 1024 + b * 256;
                for (int k0 = 0; k0 < 256; k0 += 16) { float er[16], ei[16];
#pragma unroll
                    for (int k = 0; k < 16; ++k) { er[k] = EBUF[(row0 + k0 + k) * 256 + p]; ei[k] = EBUF[(row0 + k0 + k) * 256 + 64 + p]; }
#pragma unroll
                    for (int k = 0; k < 16; ++k) { bf16* d = AG + (row0 + k0 + k) * 640 + 512 + p; d[0] = (bf16)(pk2(sr, 0.f) & 0xffffu); d[64] = (bf16)(pk2(si, 0.f) & 0xffffu);
                        const float nr = ar * sr - ai * si + er[k], ni = ar * si + ai * sr + ei[k]; sr = nr; si = ni; } }
            }
        }
        MAKE_RP;
        for (int grp = cx.wg; grp < 256; grp += cx.G) rwkv_pass1(lds, RP, grp * 16, 16, cx.tid, QCT, HCT, W1G, ULG, DLG);
    }
    SEAM(4);
    if (IN(5)) for (int rep_ = 0; rep_ < REPS(5); ++rep_) {
        FRESH_CX;
        if (SPLIT_P5 && cx.G == 256) {
            if (cx.wg < 128) { if (cx.wave == 0) rwkv_pass2(lds, cx.wg >> 2, cx.wg & 3, cx.lane, QCT, HCT, DLG, S0G); }
            else { SchedS5 S; S.init(128, 2, 128, cx.wg - 128); S.A = (const char*)AG; S.B = (const char*)S5BT; S.a_tile = 256 * 640 * 2; S.b_tile = 256 * 640 * 2; S.b_group = 512 * 640 * 2;
                EpiS5Y E{AG, I[11], Y1};
                pg8::gemm_phase<EpiS5Y, SchedS5, true, true, false>(lds, cx.tid, OPQ(640), OPQ(640), OPQ(640), S, E); }
        } else {
            { SchedS5 S; S.init(128, 2, cx.G, cx.wg); S.A = (const char*)AG; S.B = (const char*)S5BT; S.a_tile = 256 * 640 * 2; S.b_tile = 256 * 640 * 2; S.b_group = 512 * 640 * 2;
              EpiS5Y E{AG, I[11], Y1};
              pg8::gemm_phase<EpiS5Y, SchedS5, true, true, false>(lds, cx.tid, OPQ(640), OPQ(640), OPQ(640), S, E); }
            if (cx.wave == 0) for (int it = cx.wg; it < 128; it += cx.G) rwkv_pass2(lds, it >> 2, it & 3, cx.lane, QCT, HCT, DLG, S0G);
        }
    }
    SEAM(5);
    if (IN(6)) for (int rep_ = 0; rep_ < REPS(6); ++rep_) {
        FRESH_CX;
        MAKE_RP;
        for (int grp = cx.wg; grp < 256; grp += cx.G) rwkv_pass3(lds, RP, grp * 16, 16, cx.tid, S0G, W1G, ULG, MIX);
        __syncthreads();
        { SchedPlain S; S.init(128, 2, cx.G, cx.wg); S.A = (const char*)Y1; S.B = (const char*)WGLU; S.a_tile = 256 * 512 * 2; S.b_tile = 256 * 512 * 2;
          EpiGlu E{Y1, MIX};
          pg8::gemm_phase<EpiGlu, SchedPlain, true, true, false>(lds, cx.tid, OPQ(512), OPQ(512), OPQ(512), S, E); }
    }
    SEAM(6);
    if (IN(7)) for (int rep_ = 0; rep_ < REPS(7); ++rep_) {
        FRESH_CX;
        SchedPlain S; S.init(128, 4, cx.G, cx.wg); S.A = (const char*)MIX; S.B = (const char*)WOUT; S.a_tile = 256 * 1024 * 2; S.b_tile = 256 * 1024 * 2;
        EpiResid E{I[0], XB};
        pg8::gemm_phase<EpiResid, SchedPlain, true, true, false>(lds, cx.tid, OPQ(1024), OPQ(1024), OPQ(1024), S, E);
    }
    SEAM(7);
    if (IN(8)) for (int rep_ = 0; rep_ < REPS(8); ++rep_) { FRESH_CX; router_phase(cx, XB, I[29], I[30], I[31], H2, TOPE, TOPG, HIST); }
    SEAM(8);
    LAS int* PL = (LAS int*)(lds + LDS_PLAN);
    if (hi > 9 && lo < 28) { FRESH_CX; __syncthreads(); moe_plan(cx, HIST); }
    const int npass = (hi > 9 && lo < 28) ? PL[PL_NPASS] : 0;
    if (IN(9)) for (int rep_ = 0; rep_ < REPS(9); ++rep_) { FRESH_CX; dispatch_phase(cx, HIST, TOPE, SLOTTOK, TOKSLOT); convert_pass(cx, PL[PL_PE0], PL[PL_PE0 + 1], I[32], I[34], I[36], WGU, WDN); }
    SEAM(9);
    for (int p = 0; p < 6; ++p) {
        const bool actv = p < npass;
        const int e0 = actv ? PL[PL_PE0 + p] : 0, e1 = actv ? PL[PL_PE0 + p + 1] : 0, row0 = actv ? PL[PL_PROW0 + p] : 0, rows = actv ? PL[PL_PROW0 + p + 1] - row0 : 0;
        if (IN(10 + 3 * p) && actv) for (int rep_ = 0; rep_ < REPS(10); ++rep_) {
            FRESH_CX;
            SchedMoe<true> S; S.init(rows / 256, 8, cx.G, cx.wg); S.A = (const char*)H2; S.B = (const char*)WGU; S.a_tile = 0; S.b_tile = 256 * 1024; S.b_exp = (size_t)2048 * 1024; S.tile_e = PL + PL_TILEE; S.tile0 = row0 / 256; S.e0 = e0; S.slot_tok = SLOTTOK; S.row0 = row0;
            EpiGU E{ACT, I[33], I[35]};
            pg8::gemm_phase<EpiGU, SchedMoe<true>, MOE_ALIGN, true, true, true>(lds, cx.tid, OPQ(512), OPQ(512), OPQ(512), S, E);
        }
        if (actv) SEAM(10 + 3 * p);
        if (IN(11 + 3 * p) && actv) for (int rep_ = 0; rep_ < REPS(11); ++rep_) {
            FRESH_CX;
            SchedMoe<false> S; S.init(rows / 256, 4, cx.G, cx.wg); S.A = (const char*)ACT; S.B = (const char*)WDN; S.a_tile = 256 * 1024; S.b_tile = 256 * 1024; S.b_exp = (size_t)1024 * 1024; S.tile_e = PL + PL_TILEE; S.tile0 = row0 / 256; S.e0 = e0; S.slot_tok = SLOTTOK; S.row0 = row0;
            EpiDown E{YB, I[37]};
            pg8::gemm_phase<EpiDown, SchedMoe<false>, MOE_ALIGN, true, false, true>(lds, cx.tid, OPQ(512), OPQ(512), OPQ(512), S, E);
        }
        if (actv) SEAM(11 + 3 * p);
        if (IN(12 + 3 * p) && actv) for (int rep_ = 0; rep_ < REPS(12); ++rep_) {
            FRESH_CX;
            if (p + 1 < npass) { combine_pass<false>(cx, e0, e1, row0, TOPE, TOPG, TOKSLOT, YB, XB, nullptr, nullptr); convert_pass(cx, PL[PL_PE0 + p + 1], PL[PL_PE0 + p + 2], I[32], I[34], I[36], WGU, WDN); }
            else {
                combine_pass<true>(cx, e0, e1, row0, TOPE, TOPG, TOKSLOT, YB, XB, I[38], (unsigned char*)(ws + WS_R1));
                SchedPlain S; S.init(128, 4, cx.G, cx.wg); S.A = (const char*)PBF; S.B = (const char*)WPP; S.a_tile = 256 * 256 * 2; S.b_tile = 256 * 256 * 2;
                EpiBf16Plain E{PP, 1024};
                pg8::gemm_phase<EpiBf16Plain, SchedPlain, true, true, false>(lds, cx.tid, OPQ(256), OPQ(256), OPQ(256), S, E);
            }
        }
        if (actv) SEAM(12 + 3 * p);
    }
    if (IN(29)) for (int rep_ = 0; rep_ < REPS(29); ++rep_) {
        FRESH_CX;
        SchedPlain S; S.init(128, 4, cx.G, cx.wg); S.A = (const char*)(ws + WS_R1); S.B = (const char*)WPG; S.a_tile = 256 * 1024; S.b_tile = 256 * 1024;
        if (FUSE_FNORM && cx.G == 256) { EpiPleNorm E{PP, XB, OUTP, I[41], (float*)(ws + WS_CTL) + CW_ROWSS, (unsigned*)(ws + WS_CTL) + CW_PCNT};
            pg8::gemm_phase<EpiPleNorm, SchedPlain, true, true, false, true>(lds, cx.tid, OPQ(512), OPQ(512), OPQ(512), S, E); }
        else { EpiPle E{PP, XB};
            pg8::gemm_phase<EpiPle, SchedPlain, true, true, false, true>(lds, cx.tid, OPQ(512), OPQ(512), OPQ(512), S, E); }
    }
    SEAM(29);
    if (IN(30) && !(FUSE_FNORM && gridDim.x == 256)) for (int rep_ = 0; rep_ < REPS(30); ++rep_) {
        FRESH_CX;
        for (int m = 2 * cx.gw; m < M; m += 2 * cx.NGW) {
            const u32x2* ia_ = (const u32x2*)(XB + (size_t)m * 1024) + cx.lane; const u32x2* ib_ = ia_ + 256;
            f32x4* xa = (f32x4*)(OUTP + (size_t)m * 1024) + cx.lane; f32x4* xb = xa + 256; const f32x4* gr = (const f32x4*)I[41] + cx.lane; f32x4 va[4], vb[4]; float sa = 0.f, sb = 0.f;
#pragma unroll
            for (int j = 0; j < 4; ++j) { const u32x2 wa = ia_[64 * j], wb = ib_[64 * j]; va[j] = (f32x4){lo16(wa.x), hi16(wa.x), lo16(wa.y), hi16(wa.y)}; vb[j] = (f32x4){lo16(wb.x), hi16(wb.x), lo16(wb.y), hi16(wb.y)}; }
#pragma unroll
            for (int j = 0; j < 4; ++j) { sa += (va[j].x * va[j].x + va[j].y * va[j].y) + (va[j].z * va[j].z + va[j].w * va[j].w); sb += (vb[j].x * vb[j].x + vb[j].y * vb[j].y) + (vb[j].z * vb[j].z + vb[j].w * vb[j].w); }
#pragma unroll
            for (int o = 1; o < 64; o <<= 1) { sa += __shfl_xor(sa, o); sb += __shfl_xor(sb, o); }
            const float ia = rsqrtf(sa * (1.f / 1024.f) + 1e-6f), ib = rsqrtf(sb * (1.f / 1024.f) + 1e-6f);
#pragma unroll
            for (int j = 0; j < 4; ++j) { const f32x4 gg = gr[64 * j]; xa[64 * j] = (f32x4){va[j].x * ia * gg.x, va[j].y * ia * gg.y, va[j].z * ia * gg.z, va[j].w * ia * gg.w}; xb[64 * j] = (f32x4){vb[j].x * ib * gg.x, vb[j].y * ib * gg.y, vb[j].z * ib * gg.z, vb[j].w * ib * gg.w}; }
        }
    }
    if (PROBE_T >= 0 && blockIdx.x == 0 && threadIdx.x == 0) { STAMP(); asm volatile("s_waitcnt vmcnt(0)" ::: "memory");
        const unsigned long long t0_ = ((unsigned long long)MISC[17 + 2 * PROBE_T] << 32) | MISC[16 + 2 * PROBE_T], t1_ = ((unsigned long long)MISC[19 + 2 * PROBE_T] << 32) | MISC[18 + 2 * PROBE_T];
        (*(float* const CAS*)((const CAS char*)__builtin_amdgcn_kernarg_segment_ptr() + 336))[0] = (float)(t1_ - t0_) * 0.01f; }
#undef IN
#undef SEAM
}

extern "C" void kernel_launch(void* const* d_in, const int* in_sizes, int n_in, void* d_out, int out_size, void* d_ws, size_t ws_size, hipStream_t stream) {
    static int grid = 0;
    if (grid == 0) {
        if (n_in != 42 || out_size != M * DM || ws_size < WS_END) { fprintf(stderr, "kernel_launch: unexpected shapes (n_in %d out %d ws %zu)\n", n_in, out_size, ws_size); grid = -1; return; }
        int dev = 0, cus = 0, per_cu = 0;
        if (hipGetDevice(&dev) != hipSuccess || hipDeviceGetAttribute(&cus, hipDeviceAttributeMultiprocessorCount, dev) != hipSuccess) { grid = -1; return; }
        if (hipFuncSetAttribute((const void*)mk_fwd, hipFuncAttributeMaxDynamicSharedMemorySize, LDS_BYTES) != hipSuccess) { fprintf(stderr, "kernel_launch: hipFuncSetAttribute failed\n"); grid = -1; return; }
        if (hipOccupancyMaxActiveBlocksPerMultiprocessor(&per_cu, (const void*)mk_fwd, NTHR, LDS_BYTES) != hipSuccess || per_cu < 1) fprintf(stderr, "kernel_launch: occupancy query says %d\n", per_cu);
        (void)hipGetLastError();
        grid = cus > 256 ? 256 : cus;
    }
    if (grid < 0) return;
    (void)hipMemsetAsync((char*)d_ws + WS_CTL, 0, CTL_ZERO_BYTES, stream);
    Args a{};
    for (int i = 0; i < 42; ++i) a.in[i] = (const float*)d_in[i];
    a.out = (float*)d_out; a.ws = (unsigned char*)d_ws;
#if MK_PER_PHASE
    for (int ph = 0; ph < NPH; ++ph) { a.ph_lo = ph; a.ph_hi = ph + 1; hipLaunchKernelGGL(mk_fwd, dim3(grid), dim3(NTHR), LDS_BYTES, stream, a); }
#else
    a.ph_lo = 0; a.ph_hi = NPH;
    hipLaunchKernelGGL(mk_fwd, dim3(grid), dim3(NTHR), LDS_BYTES, stream, a);
#endif
}
```

```cpp
#include <hip/hip_runtime.h>
#include <cstdio>
#include <cstdint>

#ifndef MK_PER_PHASE
#define MK_PER_PHASE 0
#endif

#define LAS __attribute__((address_space(3)))
#define GAS __attribute__((address_space(1)))
typedef unsigned short bf16;
typedef short bf16x8 __attribute__((ext_vector_type(8)));
typedef float f32x4 __attribute__((ext_vector_type(4)));
typedef float f32x2 __attribute__((ext_vector_type(2)));
typedef unsigned u32x4 __attribute__((ext_vector_type(4)));
typedef unsigned u32x2 __attribute__((ext_vector_type(2)));
typedef GAS unsigned gu32;

constexpr int NB = 4, SEQ = 8192, DM = 1024, M = NB * SEQ;
constexpr int NEXP = 32, TOPK = 4;
constexpr int NWAVES = 8, NTHR = 512;
constexpr size_t MiB = 1u << 20;

constexpr size_t WS_CTL = 0, CTL_ZERO_BYTES = 1 * MiB;
constexpr size_t WS_HIST = 1 * MiB;
constexpr size_t WS_TOPE = 2 * MiB;
constexpr size_t WS_TOPG = 3 * MiB;
constexpr size_t WS_TOKSLOT = 4 * MiB;
constexpr size_t WS_SLOTTOK = 5 * MiB;
constexpr size_t WS_AT = 6 * MiB;
constexpr size_t WS_DL = 6 * MiB + 65536;
constexpr size_t WS_WCAT = 8 * MiB;
constexpr size_t WS_WL2 = 13 * MiB;
constexpr size_t WS_WGLU = 14 * MiB;
constexpr size_t WS_WPP = 14 * MiB + 524288;
constexpr size_t WS_WOUT = 15 * MiB;
constexpr size_t WS_WPG = 17 * MiB;
constexpr size_t WS_S5BT = 19 * MiB;
constexpr size_t WS_S5ET = 39 * MiB;
constexpr size_t WS_PBF = 48 * MiB;
constexpr size_t WS_R1 = 64 * MiB;
constexpr size_t WS_RKV = 128 * MiB;
constexpr size_t WS_WAG = 224 * MiB;
constexpr size_t WS_AG = 320 * MiB;
constexpr size_t WS_U = 360 * MiB;
constexpr size_t WS_LP = 392 * MiB;
constexpr size_t WS_LACT = 424 * MiB;
constexpr size_t WS_W1 = 440 * MiB;
constexpr size_t WS_ULOC = 472 * MiB;
constexpr size_t WS_Y1 = 504 * MiB;
constexpr size_t WS_H2 = 64 * MiB;
constexpr size_t WS_WDN = 96 * MiB;
constexpr size_t WS_ACT = 128 * MiB;
constexpr size_t WS_Y = 264 * MiB;
constexpr size_t WS_XB = 400 * MiB;
constexpr size_t WS_WGU = 264 * MiB;
constexpr int RMAX = 139264;
constexpr int MAXEPP = 32;
constexpr size_t WS_END = 560 * MiB;
static_assert(WS_Y + (size_t)RMAX * 1024 <= WS_XB && WS_XB + (size_t)M * 2048 <= WS_END && WS_ACT + (size_t)RMAX * 1024 <= WS_Y, "moe map");

constexpr int CW_BAR = 4096;
constexpr int CW_ROWSS = 65536;
constexpr int CW_PCNT = 131072;

constexpr int LDS_PLAN = 147456;
constexpr int LDS_MISC = 155648;
constexpr int LDS_BYTES = 156672;
constexpr int PL_CNT = 0, PL_PSTART = 32, PL_NPASS = 72, PL_PE0 = 80, PL_PROW0 = 88, PL_TILEE = 128, PL_TMP = 768;

#define LDS_WAIT() asm volatile("s_waitcnt lgkmcnt(0)" ::: "memory")
#define VM_WAIT() asm volatile("s_waitcnt vmcnt(0)" ::: "memory")
__device__ __forceinline__ float bf2f(unsigned b) { return __uint_as_float(b << 16); }
typedef __bf16 bf16n2 __attribute__((ext_vector_type(2)));
__device__ __forceinline__ unsigned cvt_pk_bf16(float lo, float hi) { const f32x2 f = {lo, hi}; const bf16n2 v = __builtin_convertvector(f, bf16n2); return __builtin_bit_cast(unsigned, v); }
__device__ __forceinline__ unsigned pk2(float lo, float hi) { return cvt_pk_bf16(lo, hi); }
__device__ __forceinline__ float lo16(unsigned w) { return __uint_as_float(w << 16); }
__device__ __forceinline__ float hi16(unsigned w) { return __uint_as_float(w & 0xffff0000u); }
__device__ __forceinline__ unsigned pk4_fp8(float a, float b, float c, float d) { unsigned w = 0u; w = (unsigned)__builtin_amdgcn_cvt_pk_fp8_f32(a, b, (int)w, false); w = (unsigned)__builtin_amdgcn_cvt_pk_fp8_f32(c, d, (int)w, true); return w; }
__device__ __forceinline__ f32x4 up4_fp8(unsigned w) { const f32x2 lo = __builtin_amdgcn_cvt_pk_f32_fp8((int)w, false), hi = __builtin_amdgcn_cvt_pk_f32_fp8((int)w, true); return (f32x4){lo.x, lo.y, hi.x, hi.y}; }
__device__ __forceinline__ float frcp(float x) { return __builtin_amdgcn_rcpf(x); }
__device__ __forceinline__ float fsigmoid(float x) { return frcp(1.0f + __expf(-x)); }
__device__ __forceinline__ float ftanh(float x) { const float e = __expf(-2.0f * fabsf(x)); const float t = (1.0f - e) * frcp(1.0f + e); return x < 0.f ? -t : t; }
__device__ __forceinline__ float gelu_tanh(float x) { const float u = 0.7978845608f * (x + 0.044715f * x * x * x); return 0.5f * x * (1.0f + ftanh(u)); }
__device__ __forceinline__ float wave_sum(float v) {
#pragma unroll
    for (int o = 1; o < 64; o <<= 1) v += __shfl_xor(v, o);
    return v;
}
__device__ __forceinline__ float wave_max(float v) {
#pragma unroll
    for (int o = 1; o < 64; o <<= 1) v = fmaxf(v, __shfl_xor(v, o));
    return v;
}

#define XB_TMO      128
#define XB_XCNT(j)  (256  + 64 * (j))
#define XB_XSUB(j)  (1280 + 64 * (j))
#define XB_XGEN(j)  (2304 + 64 * (j))
#define XB_TOP      3328
#define XB_TOPGEN   3392
#define XCD_BAR_WORDS 3456
#define XB_SPIN_CAP (1u << 22)

__device__ __forceinline__ unsigned xb_ld(unsigned* p)              { return __hip_atomic_load(p, __ATOMIC_RELAXED, __HIP_MEMORY_SCOPE_AGENT); }
__device__ __forceinline__ unsigned xb_add(unsigned* p, unsigned v) { return __hip_atomic_fetch_add(p, v, __ATOMIC_RELAXED, __HIP_MEMORY_SCOPE_AGENT); }
__device__ __forceinline__ unsigned xb_xcc_id() { return (unsigned)__builtin_amdgcn_s_getreg((3 << 11) | 20) & 0xFu; }
#define XB_SPIN(cond, bar) do { unsigned _sp = 0; while (cond) { __builtin_amdgcn_s_sleep(1); \
    if ((++_sp & 255u) == 0u) { if (xb_ld(&(bar)[XB_TMO])) break; if (_sp > XB_SPIN_CAP) { atomicAdd(&(bar)[XB_TMO], 1u); break; } } } } while (0)

struct XcdBarrier { unsigned* bar; unsigned x; volatile LAS unsigned* st; };

__device__ __forceinline__ XcdBarrier xcd_barrier_post(unsigned* bar, volatile LAS unsigned* st) {
    XcdBarrier b; b.bar = bar; b.x = xb_xcc_id(); b.st = st;
    if (threadIdx.x == 0) (void)xb_add(&bar[XB_XCNT(b.x)], 1u);
    return b;
}
__device__ __forceinline__ void xcd_barrier_complete(unsigned* bar, unsigned x, unsigned& nloc, unsigned& nx) {
    const unsigned G = gridDim.x * gridDim.y * gridDim.z;
    unsigned sum, cnt, mine, sp = 0u;
    for (;;) {
        sum = 0u; cnt = 0u; mine = 0u;
#pragma unroll
        for (unsigned j = 0; j < 16; ++j) { const unsigned c = xb_ld(&bar[XB_XCNT(j)]); sum += c; cnt += (c > 0u) ? 1u : 0u; mine = (j == x) ? c : mine; }
        if (sum == G) break;
        __builtin_amdgcn_s_sleep(1);
        if ((++sp & 255u) == 0u) { if (xb_ld(&bar[XB_TMO])) break; if (sp > XB_SPIN_CAP) { atomicAdd(&bar[XB_TMO], 1u); break; } }
    }
    nloc = mine > 0u ? mine : 1u; nx = cnt > 0u ? cnt : 1u;
}
__device__ __forceinline__ void xcd_barrier(const XcdBarrier& b) {
    asm volatile("s_waitcnt vmcnt(0)" ::: "memory");
    __syncthreads();
    if (threadIdx.x == 0) {
        unsigned* bar = b.bar;
        __builtin_amdgcn_s_waitcnt(0);
        unsigned nloc = b.st[0], nx = b.st[1];
        if (nloc == 0u) { xcd_barrier_complete(bar, b.x, nloc, nx); b.st[0] = nloc; b.st[1] = nx; }
        const unsigned old = xb_add(&bar[XB_XSUB(b.x)], 1u);
        const unsigned gen = old / nloc;
        if (old + 1u == (gen + 1u) * nloc) {
            __builtin_amdgcn_fence(__ATOMIC_RELEASE, "agent");
            asm volatile("s_waitcnt vmcnt(0)" ::: "memory");
            const unsigned og = xb_add(&bar[XB_TOP], 1u);
            const unsigned tg = og / nx;
            if (og + 1u == (tg + 1u) * nx) xb_add(&bar[XB_TOPGEN], 1u);
            else XB_SPIN(xb_ld(&bar[XB_TOPGEN]) == tg, bar);
            __builtin_amdgcn_fence(__ATOMIC_ACQUIRE, "agent");
            xb_add(&bar[XB_XGEN(b.x)], 1u);
            asm volatile("s_waitcnt vmcnt(0)" ::: "memory");
        } else {
            XB_SPIN(xb_ld(&bar[XB_XGEN(b.x)]) == gen, bar);
            __builtin_amdgcn_fence(__ATOMIC_ACQUIRE, "agent");
            asm volatile("s_waitcnt vmcnt(0)" ::: "memory");
        }
    }
    __syncthreads();
}

namespace pg8 {
constexpr int BM = 256, BK = 64, HALF = 128, HTB = HALF * BK * 2, STAGE_BYTES = 8 * HTB, NXCD = 8, WGM = 8;
__host__ __device__ __forceinline__ int lds_byte(int r, int c) { const int st = (r >> 4) * 2 + (c >> 5), rr = r & 15, cc = c & 31, ob = rr * 64 + cc * 2; return st * 1024 + (ob ^ (((ob >> 9) & 1) << 5)); }
__host__ __device__ __forceinline__ void stage_rc(int b, int& R, int& C) { const int st = b / 1024, sb = b % 1024, swz = sb ^ (((sb >> 9) & 1) << 5); R = (st >> 1) * 16 + swz / 64; C = (st & 1) * 32 + (swz % 64) / 2; }
__host__ __device__ __forceinline__ int perm32(int rho) { const int n = rho >> 4, i = rho & 15; return 8 * (i >> 2) + 4 * n + (i & 3); }

struct Unit { int pm, pn, aux; };

struct Order {
    int nM, nN, nwg, G, c;
    __device__ __forceinline__ void init(int nM_, int nN_, int G_, int c_) { nM = nM_; nN = nN_; nwg = nM * nN; G = G_; c = c_; }
    __device__ __forceinline__ bool tile(int i, int& pm, int& pn) const {
        const long L = (long)i * G + c; if (L >= nwg) return false;
        int wgid = (int)L; { const int q = nwg / NXCD, r = nwg % NXCD, xcd = wgid % NXCD, off = wgid / NXCD; wgid = (xcd < r ? xcd * (q + 1) : r * (q + 1) + (xcd - r) * q) + off; }
        const int nig = WGM * nN, gid = wgid / nig, fm = gid * WGM, gsz = (nM - fm) < WGM ? (nM - fm) : WGM;
        pm = fm + ((wgid % nig) % gsz); pn = (wgid % nig) / gsz; return true;
    }
};


template <class Epi, class Sched, bool ALIGN_EPI, bool SP2, bool GATHER, bool FP8 = false>
__device__ __forceinline__ void gemm_phase(LAS unsigned char* lds, const int tid, const int K, const int lda, const int ldb, const Sched& S, const Epi& E) {
    const int wid = __builtin_amdgcn_readfirstlane(tid >> 6), lane = tid & 63, wr = wid >> 2, wc = wid & 3, fr = lane & 15, fq = lane >> 4;
    const int nt = K / BK;
    unsigned voffA[2], voffB[2]; int rA[2], cA2[2];
#pragma unroll
    for (int i = 0; i < 2; ++i) { int R, C; stage_rc(tid * 16 + i * 8192, R, C); const int Rb = Epi::PERM ? ((R & ~31) + perm32(R & 31)) : R;
        voffA[i] = (unsigned)(R * lda + C) * 2u; voffB[i] = (unsigned)(Rb * ldb + C) * 2u; rA[i] = R; cA2[i] = C * 2; }
    const size_t kstep = (size_t)(BK * 2);
    const size_t hstepA = (size_t)HALF * lda * 2, hstepB = (size_t)HALF * ldb * 2;
    const unsigned ldsw = (unsigned)wid * 1024u;
    const int aoff = FP8 ? lds_byte(wr * 64 + fr, fq * 16) : lds_byte(wr * 64 + fr, fq * 8), boff = FP8 ? lds_byte(wc * 32 + fr, fq * 16) : lds_byte(wc * 32 + fr, fq * 8);
    unsigned cv0[2] = {0u, 0u}, cv1[2] = {0u, 0u};
#define PG8_SA(b, h) (((b) * 2 + (h)) * HTB)
#define PG8_SB(b, h) ((4 + (b) * 2 + (h)) * HTB)
#define PG8_STAGE(bufoff, gbase, voff) do { _Pragma("unroll") for (int _i = 0; _i < 2; ++_i) \
        __builtin_amdgcn_global_load_lds((const unsigned*)((const char*)(gbase) + (voff)[_i]), (LAS unsigned*)(lds + (bufoff) + ldsw + _i * 8192), 16, 0, 0); } while (0)
#define PG8_NROW(h, i) ((has_next ? *(const LAS unsigned*)(pf_rows + (i) * 512 + (h) * 256 + lane * 4) * (unsigned)(lda * 2) + (unsigned)cA2[i] : ((h) ? cv1[i] : cv0[i])))
#define PG8_STAGE_A(bufoff, ptr, h, nx) do { if constexpr (GATHER) { unsigned _v[2]; if (nx) { asm volatile("" ::: "memory"); _v[0] = PG8_NROW(h, 0); _v[1] = PG8_NROW(h, 1); } else { _v[0] = (h) ? cv1[0] : cv0[0]; _v[1] = (h) ? cv1[1] : cv0[1]; } PG8_STAGE(bufoff, ptr, _v); } \
        else { PG8_STAGE(bufoff, (ptr) + (h) * hstepA, voffA); } } while (0)
#define PG8_LDA(dst, b, h) do { if constexpr (FP8) { _Pragma("unroll") for (int m = 0; m < 4; ++m) { dst##8[m].lo = *(const LAS v4i_*)(lds + PG8_SA(b, h) + aoff + m * 2048); dst##8[m].hi = *(const LAS v4i_*)(lds + PG8_SA(b, h) + aoff + m * 2048 + 16); } } \
        else { _Pragma("unroll") for (int m = 0; m < 4; ++m) _Pragma("unroll") for (int k = 0; k < 2; ++k) dst[m][k] = *(const LAS bf16x8*)(lds + PG8_SA(b, h) + aoff + m * 2048 + k * 1024); } } while (0)
#define PG8_LDB(dst, b, h) do { if constexpr (FP8) { _Pragma("unroll") for (int n = 0; n < 2; ++n) { dst##8[n].lo = *(const LAS v4i_*)(lds + PG8_SB(b, h) + boff + n * 2048); dst##8[n].hi = *(const LAS v4i_*)(lds + PG8_SB(b, h) + boff + n * 2048 + 16); } } \
        else { _Pragma("unroll") for (int n = 0; n < 2; ++n) _Pragma("unroll") for (int k = 0; k < 2; ++k) dst[n][k] = *(const LAS bf16x8*)(lds + PG8_SB(b, h) + boff + n * 2048 + k * 1024); } } while (0)
#define PG8_MMA(ai, bj, At, Bt) do { __builtin_amdgcn_s_setprio(1); _Pragma("unroll") for (int m = 0; m < 4; ++m) _Pragma("unroll") for (int n = 0; n < 2; ++n) { \
        if constexpr (FP8) asm volatile("v_mfma_scale_f32_16x16x128_f8f6f4 %0, %1, %2, %0, %3, %4 op_sel_hi:[0,0,0]" : "+v"(acc[ai][bj][m][n]) : "v"(Bt##8[n]), "v"(At##8[m]), "v"(sclW), "v"(sclA));   \
        else { _Pragma("unroll") for (int k = 0; k < 2; ++k) acc[ai][bj][m][n] = __builtin_amdgcn_mfma_f32_16x16x32_bf16(Bt[n][k], At[m][k], acc[ai][bj][m][n], 0, 0, 0); } } \
        __builtin_amdgcn_s_setprio(0); } while (0)
#define PG8_WAIT_V(n) asm volatile("s_waitcnt vmcnt(" #n ")" ::: "memory")
#define PG8_WAIT_L(n) asm volatile("s_waitcnt lgkmcnt(" #n ")" ::: "memory")
#define PG8_BAR __builtin_amdgcn_s_barrier()
#define PG8_SCHED __builtin_amdgcn_sched_barrier(0)
#define PG8_ROWS(u, d0, d1) do { _Pragma("unroll") for (int _i = 0; _i < 2; ++_i) { const int _r0 = S.a_row(u, rA[_i]), _r1 = S.a_row(u, HALF + rA[_i]); \
        d0[_i] = (unsigned)_r0 * (unsigned)(lda * 2) + (unsigned)cA2[_i]; d1[_i] = (unsigned)_r1 * (unsigned)(lda * 2) + (unsigned)cA2[_i]; } } while (0)
    constexpr int PF_OFF = STAGE_BYTES;
    LAS unsigned char* pf_bias = lds + PF_OFF + wid * 256; LAS unsigned char* pf_rows = lds + PF_OFF + 2048 + wid * 1024;
    Unit cur, nxt; int ui = 0; bool has_next = false;
    if (!S.next(0, cur)) return;
    f32x4 acc[2][2][4][2];
#pragma unroll
    for (int a = 0; a < 2; ++a)
#pragma unroll
        for (int b = 0; b < 2; ++b)
#pragma unroll
            for (int m = 0; m < 4; ++m)
#pragma unroll
                for (int n = 0; n < 2; ++n) acc[a][b][m][n] = (f32x4){0.f, 0.f, 0.f, 0.f};
    typedef int v8i_ __attribute__((ext_vector_type(8))); typedef int v4i_ __attribute__((ext_vector_type(4)));
    bf16x8 At[4][2], B0[2][2], B1[2][2]; v8i_ At8[4], B08[2], B18[2];
    const int sclW = 0x7a7a7a7a, sclA = 0x7f7f7f7f;
    const char* cA = S.a_ptr(cur); const char* cB = S.b_ptr(cur);
    if constexpr (GATHER) { PG8_ROWS(cur, cv0, cv1); }
    if constexpr (SP2) {
        PG8_STAGE(PG8_SB(0, 0), cB, voffB); PG8_STAGE(PG8_SB(0, 1), cB + hstepB, voffB); PG8_STAGE_A(PG8_SA(0, 0), cA, 0, false); PG8_STAGE_A(PG8_SA(0, 1), cA, 1, false);
        if (wr == 1) PG8_BAR;
        PG8_WAIT_V(2); PG8_BAR;
        PG8_STAGE(PG8_SB(1, 0), cB + kstep, voffB); PG8_STAGE_A(PG8_SA(1, 0), cA + kstep, 0, false); PG8_STAGE(PG8_SB(1, 1), cB + hstepB + kstep, voffB);
        PG8_WAIT_V(6); PG8_BAR;
    } else {
        PG8_STAGE(PG8_SB(0, 0), cB, voffB); PG8_STAGE_A(PG8_SA(0, 0), cA, 0, false); PG8_STAGE(PG8_SB(0, 1), cB + hstepB, voffB); PG8_STAGE_A(PG8_SA(0, 1), cA, 1, false);
        if (wr == 1) PG8_BAR;
        PG8_WAIT_V(4); PG8_BAR;
        PG8_STAGE(PG8_SB(1, 0), cB + kstep, voffB); PG8_STAGE_A(PG8_SA(1, 0), cA + kstep, 0, false); PG8_STAGE(PG8_SB(1, 1), cB + hstepB + kstep, voffB);
        PG8_WAIT_V(6); PG8_BAR;
    }
    for (;;) {
        has_next = S.next(ui + 1, nxt);
        const char* nA = has_next ? S.a_ptr(nxt) : cA; const char* nB = has_next ? S.b_ptr(nxt) : cB;
        if constexpr (Epi::PREF) E.pref(pf_bias, cur, wc, lane);
        if constexpr (GATHER) { if (has_next) {
#pragma unroll
                for (int _i = 0; _i < 2; ++_i) { __builtin_amdgcn_global_load_lds((const unsigned*)S.a_row_ptr(nxt, rA[_i]), (LAS unsigned*)(pf_rows + _i * 512), 4, 0, 0);
                                                 __builtin_amdgcn_global_load_lds((const unsigned*)S.a_row_ptr(nxt, HALF + rA[_i]), (LAS unsigned*)(pf_rows + _i * 512 + 256), 4, 0, 0); } }
            }
        for (int t = 0; t < nt; t += 2) {
            const bool last = (t == nt - 2);
            const char* a1 = cA + (size_t)(t + 1) * kstep;
            const char* a2 = last ? nA : cA + (size_t)(t + 2) * kstep; const char* b2 = last ? nB : cB + (size_t)(t + 2) * kstep;
            const char* a3 = a2 + kstep; const char* b3 = b2 + kstep;
            if constexpr (SP2) {
            PG8_LDB(B0, 0, 0); PG8_LDB(B1, 0, 1); PG8_SCHED; PG8_LDA(At, 0, 0); PG8_STAGE_A(PG8_SA(1, 1), a1, 1, false);
            PG8_WAIT_V(8); PG8_WAIT_L(0); PG8_BAR; PG8_MMA(0, 0, At, B0); PG8_MMA(0, 1, At, B1); PG8_BAR; PG8_SCHED;
            PG8_LDA(At, 0, 1); PG8_STAGE(PG8_SB(0, 0), b2, voffB); PG8_STAGE(PG8_SB(0, 1), b2 + hstepB, voffB); PG8_STAGE_A(PG8_SA(0, 0), a2, 0, last);
            PG8_WAIT_V(8); PG8_WAIT_L(0); PG8_BAR; PG8_MMA(1, 0, At, B0); PG8_MMA(1, 1, At, B1); PG8_BAR; PG8_SCHED;
            PG8_LDB(B0, 1, 0); PG8_LDB(B1, 1, 1); PG8_SCHED; PG8_LDA(At, 1, 0); PG8_STAGE_A(PG8_SA(0, 1), a2, 1, last);
            PG8_WAIT_V(8); PG8_WAIT_L(0); PG8_BAR; PG8_MMA(0, 0, At, B0); PG8_MMA(0, 1, At, B1); PG8_BAR; PG8_SCHED;
            PG8_LDA(At, 1, 1); PG8_STAGE(PG8_SB(1, 0), b3, voffB); PG8_STAGE(PG8_SB(1, 1), b3 + hstepB, voffB); PG8_STAGE_A(PG8_SA(1, 0), a3, 0, last);
            PG8_WAIT_V(8); PG8_WAIT_L(0); PG8_BAR; PG8_MMA(1, 0, At, B0); PG8_MMA(1, 1, At, B1); PG8_BAR; PG8_SCHED;
            } else {
            PG8_LDB(B0, 0, 0); PG8_SCHED; PG8_LDA(At, 0, 0); PG8_STAGE_A(PG8_SA(1, 1), a1, 1, false);
            PG8_WAIT_L(8); PG8_BAR; PG8_WAIT_L(0); PG8_MMA(0, 0, At, B0); PG8_BAR; PG8_SCHED;
            PG8_LDB(B1, 0, 1); PG8_STAGE(PG8_SB(0, 0), b2, voffB);
            PG8_BAR; PG8_WAIT_L(0); PG8_MMA(0, 1, At, B1); PG8_BAR;
            PG8_LDA(At, 0, 1); PG8_STAGE_A(PG8_SA(0, 0), a2, 0, last);
            PG8_BAR; PG8_WAIT_L(0); PG8_MMA(1, 0, At, B0); PG8_BAR; PG8_SCHED;
            PG8_STAGE(PG8_SB(0, 1), b2 + hstepB, voffB);
            PG8_WAIT_V(6); PG8_BAR; PG8_MMA(1, 1, At, B1); PG8_BAR;
            PG8_LDB(B0, 1, 0); PG8_SCHED; PG8_LDA(At, 1, 0); PG8_STAGE_A(PG8_SA(0, 1), a2, 1, last);
            PG8_WAIT_L(8); PG8_BAR; PG8_WAIT_L(0); PG8_MMA(0, 0, At, B0); PG8_BAR; PG8_SCHED;
            PG8_LDB(B1, 1, 1); PG8_STAGE(PG8_SB(1, 0), b3, voffB);
            PG8_BAR; PG8_WAIT_L(0); PG8_MMA(0, 1, At, B1); PG8_BAR;
            PG8_LDA(At, 1, 1); PG8_STAGE_A(PG8_SA(1, 0), a3, 0, last);
            PG8_BAR; PG8_WAIT_L(0); PG8_MMA(1, 0, At, B0); PG8_BAR; PG8_SCHED;
            PG8_STAGE(PG8_SB(1, 1), b3 + hstepB, voffB);
            PG8_WAIT_V(6); PG8_BAR; PG8_MMA(1, 1, At, B1); PG8_BAR;
            }
        }
        if constexpr (ALIGN_EPI) { if (wr == 0) PG8_BAR; }
        if constexpr (FP8) asm volatile("s_nop 15\n\ts_nop 15" ::: "memory");
        E(acc, cur, wr, wc, fr, fq, pf_bias);
        if (!has_next) break;
#pragma unroll
        for (int a = 0; a < 2; ++a)
#pragma unroll
            for (int b = 0; b < 2; ++b)
#pragma unroll
                for (int m = 0; m < 4; ++m)
#pragma unroll
                    for (int n = 0; n < 2; ++n) acc[a][b][m][n] = (f32x4){0.f, 0.f, 0.f, 0.f};
        cur = nxt; cA = nA; cB = nB; ++ui;
        if constexpr (GATHER) { asm volatile("" ::: "memory"); cv0[0] = PG8_NROW(0, 0); cv0[1] = PG8_NROW(0, 1); cv1[0] = PG8_NROW(1, 0); cv1[1] = PG8_NROW(1, 1); }
        if constexpr (ALIGN_EPI) { if (wr == 1) PG8_BAR; }
    }
    PG8_WAIT_V(0);
    if constexpr (!ALIGN_EPI) { if (wr == 0) PG8_BAR; }
    PG8_BAR;
#undef PG8_SA
#undef PG8_SB
#undef PG8_STAGE
#undef PG8_STAGE_A
#undef PG8_NROW
#undef PG8_LDA
#undef PG8_LDB
#undef PG8_MMA
#undef PG8_WAIT_V
#undef PG8_WAIT_L
#undef PG8_BAR
#undef PG8_SCHED
#undef PG8_ROWS
}
}

using pg8::Unit;
struct SchedPlain : pg8::Order {
    const char* A; const char* B; size_t a_tile, b_tile;
    __device__ __forceinline__ bool next(int i, Unit& u) const { u.aux = 0; return tile(i, u.pm, u.pn); }
    __device__ __forceinline__ const char* a_ptr(const Unit& u) const { return A + (size_t)u.pm * a_tile; }
    __device__ __forceinline__ const char* b_ptr(const Unit& u) const { return B + (size_t)u.pn * b_tile; }
    __device__ __forceinline__ int a_row(const Unit&, int) const { return 0; }
    __device__ __forceinline__ const int* a_row_ptr(const Unit&, int) const { return nullptr; }
};
struct SchedS5 : pg8::Order {
    const char* A; const char* B; size_t a_tile, b_tile, b_group;
    __device__ __forceinline__ bool next(int i, Unit& u) const { u.aux = 0; return tile(i, u.pm, u.pn); }
    __device__ __forceinline__ const char* a_ptr(const Unit& u) const { return A + (size_t)u.pm * a_tile; }
    __device__ __forceinline__ const char* b_ptr(const Unit& u) const { return B + (size_t)(u.pm >> 2) * b_group + (size_t)u.pn * b_tile; }
    __device__ __forceinline__ int a_row(const Unit&, int) const { return 0; }
    __device__ __forceinline__ const int* a_row_ptr(const Unit&, int) const { return nullptr; }
};
template <bool GATHER> struct SchedMoe : pg8::Order {
    const char* A; const char* B; size_t a_tile, b_tile, b_exp; const LAS int* tile_e; int tile0, e0; const int* slot_tok; int row0;
    __device__ __forceinline__ bool next(int i, Unit& u) const { const bool ok = tile(i, u.pm, u.pn); u.aux = ok ? tile_e[tile0 + u.pm] : 0; return ok; }
    __device__ __forceinline__ const char* a_ptr(const Unit& u) const { return GATHER ? A : A + (size_t)u.pm * a_tile; }
    __device__ __forceinline__ const char* b_ptr(const Unit& u) const { return B + (size_t)(u.aux - e0) * b_exp + (size_t)u.pn * b_tile; }
    __device__ __forceinline__ int a_row(const Unit& u, int r) const { return slot_tok[row0 + u.pm * 256 + r]; }
    __device__ __forceinline__ const int* a_row_ptr(const Unit& u, int r) const { return slot_tok + row0 + u.pm * 256 + r; }
};

__device__ __forceinline__ void st8(bf16* p, const f32x4 v0, const f32x4 v1) {
    u32x4 w; w.x = cvt_pk_bf16(v0[0], v0[1]); w.y = cvt_pk_bf16(v0[2], v0[3]); w.z = cvt_pk_bf16(v1[0], v1[1]); w.w = cvt_pk_bf16(v1[2], v1[3]); *(u32x4*)p = w;
}
__device__ __forceinline__ void ld8(const bf16* p, f32x4& v0, f32x4& v1) {
    const u32x4 w = *(const u32x4*)p; v0 = (f32x4){lo16(w.x), hi16(w.x), lo16(w.y), hi16(w.y)}; v1 = (f32x4){lo16(w.z), hi16(w.z), lo16(w.w), hi16(w.w)};
}
#define EPI_LOOP_AM _Pragma("unroll") for (int ai = 0; ai < 2; ++ai) _Pragma("unroll") for (int m = 0; m < 4; ++m)
#define EPI_ARGS f32x4 (&acc)[2][2][4][2], const Unit& u, int wr, int wc, int fr, int fq, const LAS unsigned char* pf

struct EpiProj { static constexpr bool PERM = true, PREF = false; bf16 *AG, *RKV, *LP;
    __device__ __forceinline__ void operator()(EPI_ARGS) const {
        const int row0 = u.pm * 256 + wr * 64 + fr;
        if (u.pn < 2) { const int col0 = u.pn * 256 + wc * 32 + 8 * fq;
            EPI_LOOP_AM { const int row = row0 + ai * 128 + m * 16;
#pragma unroll
                for (int bj = 0; bj < 2; ++bj) { const int c = col0 + bj * 128; st8(AG + ((size_t)((c >> 4) * 1024 + (row >> 5))) * 640 + (row & 31) * 16 + (c & 15), acc[ai][bj][m][0], acc[ai][bj][m][1]); } }
        } else {
            bf16* base; int ldc, c0;
            if (u.pn < 8) { base = RKV; ldc = 1536; c0 = (u.pn - 2) * 256; } else { base = LP; ldc = 512; c0 = (u.pn - 8) * 256; }
            const int col0 = c0 + wc * 32 + 8 * fq;
            EPI_LOOP_AM { bf16* rowp = base + (size_t)(row0 + ai * 128 + m * 16) * ldc + col0;
#pragma unroll
                for (int bj = 0; bj < 2; ++bj) st8(rowp + bj * 128, acc[ai][bj][m][0], acc[ai][bj][m][1]); }
        }
    }
};
struct EpiBf16Plain { static constexpr bool PERM = true, PREF = false; bf16* O; int ldc;
    __device__ __forceinline__ void operator()(EPI_ARGS) const {
        const int row0 = u.pm * 256 + wr * 64 + fr, col0 = u.pn * 256 + wc * 32 + 8 * fq;
        EPI_LOOP_AM { bf16* rowp = O + (size_t)(row0 + ai * 128 + m * 16) * ldc + col0;
#pragma unroll
            for (int bj = 0; bj < 2; ++bj) st8(rowp + bj * 128, acc[ai][bj][m][0], acc[ai][bj][m][1]); }
    }
};
struct EpiF32 { static constexpr bool PERM = false, PREF = false; float* C; int ldc;
    __device__ __forceinline__ void operator()(EPI_ARGS) const {
        const int row0 = u.pm * 256 + wr * 64 + fr, col0 = u.pn * 256 + wc * 32 + 4 * fq;
        EPI_LOOP_AM { float* rowp = C + (size_t)(row0 + ai * 128 + m * 16) * ldc + col0;
#pragma unroll
            for (int bj = 0; bj < 2; ++bj)
#pragma unroll
                for (int n = 0; n < 2; ++n) *(f32x4*)(rowp + bj * 128 + n * 16) = acc[ai][bj][m][n]; }
    }
};
struct EpiS5Y { static constexpr bool PERM = true, PREF = false; const bf16* AG; const float* dskip; bf16* Y1;
    __device__ __forceinline__ void operator()(EPI_ARGS) const {
        const int g = u.pm >> 2, crow0 = (u.pm & 3) * 256 + wr * 64 + fr, col0 = u.pn * 256 + wc * 32 + 8 * fq;
        EPI_LOOP_AM { const int crow = crow0 + ai * 128 + m * 16;
#pragma unroll
            for (int bj = 0; bj < 2; ++bj) { const int col = col0 + bj * 128, t = col >> 4, c = col & 15;
                f32x4 u0, u1; ld8(AG + ((size_t)(g * 1024 + crow)) * 640 + col, u0, u1);
                const f32x4 d0 = *(const f32x4*)(dskip + g * 16 + c), d1 = *(const f32x4*)(dskip + g * 16 + c + 4);
                f32x4 v0 = acc[ai][bj][m][0] + d0 * u0, v1 = acc[ai][bj][m][1] + d1 * u1;
#pragma unroll
                for (int j = 0; j < 4; ++j) { v0[j] = gelu_tanh(v0[j]); v1[j] = gelu_tanh(v1[j]); }
                st8(Y1 + (size_t)(crow * 32 + t) * 512 + g * 16 + c, v0, v1); } }
    }
};
struct EpiGlu { static constexpr bool PERM = true, PREF = false; const bf16* Y1; bf16* MIX;
    __device__ __forceinline__ void operator()(EPI_ARGS) const {
        const int row0 = u.pm * 256 + wr * 64 + fr, col0 = u.pn * 256 + wc * 32 + 8 * fq;
        EPI_LOOP_AM { const int row = row0 + ai * 128 + m * 16;
#pragma unroll
            for (int bj = 0; bj < 2; ++bj) { const int col = col0 + bj * 128; f32x4 y0, y1v; ld8(Y1 + (size_t)row * 512 + col, y0, y1v);
                f32x4 v0, v1;
#pragma unroll
                for (int j = 0; j < 4; ++j) { v0[j] = y0[j] * fsigmoid(acc[ai][bj][m][0][j]); v1[j] = y1v[j] * fsigmoid(acc[ai][bj][m][1][j]); }
                st8(MIX + (size_t)row * 1024 + col, v0, v1); } }
    }
};
struct EpiResid { static constexpr bool PERM = true, PREF = false; const float* X; bf16* O;
    __device__ __forceinline__ void operator()(EPI_ARGS) const {
        const int row0 = u.pm * 256 + wr * 64 + fr, col0 = u.pn * 256 + wc * 32 + 8 * fq;
        EPI_LOOP_AM { const size_t off = (size_t)(row0 + ai * 128 + m * 16) * 1024 + col0;
#pragma unroll
            for (int bj = 0; bj < 2; ++bj) { const f32x4 x0 = __builtin_nontemporal_load((const f32x4*)(X + off + bj * 128)), x1 = __builtin_nontemporal_load((const f32x4*)(X + off + bj * 128 + 4)); st8(O + off + bj * 128, x0 + acc[ai][bj][m][0], x1 + acc[ai][bj][m][1]); } }
    }
};
struct EpiGU { static constexpr bool PERM = true, PREF = true; unsigned char* ACT; const float* bg; const float* bu;
    __device__ __forceinline__ void pref(LAS unsigned char* pf, const Unit& u, int wc, int lane) const {
        const float* src = ((lane & 32) ? bu : bg) + u.aux * 1024 + u.pn * 128 + wc * 32 + (lane & 31);
        __builtin_amdgcn_global_load_lds((const unsigned*)src, (LAS unsigned*)pf, 4, 0, 0); }
    __device__ __forceinline__ void operator()(EPI_ARGS) const {
        const int row0 = u.pm * 256 + wr * 64 + fr, col = u.pn * 128 + wc * 32 + 8 * fq;
        const f32x4 g0 = *(const LAS f32x4*)(pf + 32 * fq), g1 = *(const LAS f32x4*)(pf + 32 * fq + 16), u0 = *(const LAS f32x4*)(pf + 128 + 32 * fq), u1 = *(const LAS f32x4*)(pf + 128 + 32 * fq + 16);
        EPI_LOOP_AM { f32x4 v0, v1;
#pragma unroll
            for (int j = 0; j < 4; ++j) {
                const float gt0 = fminf(acc[ai][0][m][0][j] + g0[j], 7.0f), up0 = fminf(fmaxf(acc[ai][1][m][0][j] + u0[j], -7.0f), 7.0f);
                const float gt1 = fminf(acc[ai][0][m][1][j] + g1[j], 7.0f), up1 = fminf(fmaxf(acc[ai][1][m][1][j] + u1[j], -7.0f), 7.0f);
                v0[j] = (up0 + 1.0f) * gt0 * fsigmoid(1.702f * gt0); v1[j] = (up1 + 1.0f) * gt1 * fsigmoid(1.702f * gt1); }
            u32x2 w; w.x = pk4_fp8(v0[0], v0[1], v0[2], v0[3]); w.y = pk4_fp8(v1[0], v1[1], v1[2], v1[3]); *(u32x2*)(ACT + (size_t)(row0 + ai * 128 + m * 16) * 1024 + col) = w; }
    }
};
struct EpiDown { static constexpr bool PERM = true, PREF = true; unsigned char* Y; const float* bd;
    __device__ __forceinline__ void pref(LAS unsigned char* pf, const Unit& u, int wc, int lane) const {
        const float* src = bd + u.aux * 1024 + u.pn * 256 + (lane >> 5) * 128 + wc * 32 + (lane & 31);
        __builtin_amdgcn_global_load_lds((const unsigned*)src, (LAS unsigned*)pf, 4, 0, 0); }
    __device__ __forceinline__ void operator()(EPI_ARGS) const {
        const int row0 = u.pm * 256 + wr * 64 + fr, col0 = u.pn * 256 + wc * 32 + 8 * fq;
        EPI_LOOP_AM { unsigned char* rowp = Y + (size_t)(row0 + ai * 128 + m * 16) * 1024 + col0;
#pragma unroll
            for (int bj = 0; bj < 2; ++bj) { const f32x4 b0 = *(const LAS f32x4*)(pf + 128 * bj + 32 * fq), b1 = *(const LAS f32x4*)(pf + 128 * bj + 32 * fq + 16);
                const f32x4 v0 = acc[ai][bj][m][0] + b0, v1 = acc[ai][bj][m][1] + b1; u32x2 w; w.x = pk4_fp8(v0[0], v0[1], v0[2], v0[3]); w.y = pk4_fp8(v1[0], v1[1], v1[2], v1[3]); *(u32x2*)(rowp + bj * 128) = w; } }
    }
};
struct EpiPle { static constexpr bool PERM = true, PREF = false; const bf16* PP; bf16* O;
    __device__ __forceinline__ void operator()(EPI_ARGS) const {
        const int row0 = u.pm * 256 + wr * 64 + fr, col0 = u.pn * 256 + wc * 32 + 8 * fq;
        EPI_LOOP_AM { const size_t off = (size_t)(row0 + ai * 128 + m * 16) * 1024 + col0;
#pragma unroll
            for (int bj = 0; bj < 2; ++bj) { f32x4 p0, p1, x0, x1; ld8(PP + off + bj * 128, p0, p1); ld8(O + off + bj * 128, x0, x1);
#pragma unroll
                for (int j = 0; j < 4; ++j) { x0[j] += p0[j] * fsigmoid(acc[ai][bj][m][0][j]); x1[j] += p1[j] * fsigmoid(acc[ai][bj][m][1][j]); }
                st8(O + off + bj * 128, x0, x1); } }
    }
};

struct EpiPleNorm { static constexpr bool PERM = true, PREF = false; const bf16* PP; const bf16* XIN; float* OUT; const float* gfin; float* rowss; unsigned* pcnt;
    __device__ __forceinline__ void operator()(EPI_ARGS) const {
        const int row0 = u.pm * 256 + wr * 64 + fr, col0 = u.pn * 256 + wc * 32 + 8 * fq;
        EPI_LOOP_AM { const size_t off = (size_t)(row0 + ai * 128 + m * 16) * 1024 + col0; float s = 0.f;
#pragma unroll
            for (int bj = 0; bj < 2; ++bj) { f32x4 p0, p1, x0, x1; ld8(PP + off + bj * 128, p0, p1); ld8(XIN + off + bj * 128, x0, x1);
#pragma unroll
                for (int j = 0; j < 4; ++j) { x0[j] += p0[j] * fsigmoid(acc[ai][bj][m][0][j]); x1[j] += p1[j] * fsigmoid(acc[ai][bj][m][1][j]); s += x0[j] * x0[j] + x1[j] * x1[j]; }
                acc[ai][bj][m][0] = x0; acc[ai][bj][m][1] = x1; }
            s += __shfl_xor(s, 16); s += __shfl_xor(s, 32);
            if (fq == 0) atomicAdd(rowss + row0 + ai * 128 + m * 16, s); }
        asm volatile("s_waitcnt vmcnt(0)" ::: "memory");
        unsigned* cnt = pcnt + 64 * u.pm;
        if ((fr | fq) == 0) __hip_atomic_fetch_add(cnt, 1u, __ATOMIC_RELAXED, __HIP_MEMORY_SCOPE_AGENT);
        { unsigned sp = 0; while (__builtin_amdgcn_readfirstlane(__hip_atomic_load(cnt, __ATOMIC_RELAXED, __HIP_MEMORY_SCOPE_AGENT)) < 32u) { __builtin_amdgcn_s_sleep(2); if (++sp > (1u << 22)) break; } }
        f32x4 gv[2][2];
#pragma unroll
        for (int bj = 0; bj < 2; ++bj) { gv[bj][0] = *(const f32x4*)(gfin + col0 + bj * 128); gv[bj][1] = *(const f32x4*)(gfin + col0 + bj * 128 + 4); }
        EPI_LOOP_AM { const int row = row0 + ai * 128 + m * 16; const float ssr = __hip_atomic_load(rowss + row, __ATOMIC_RELAXED, __HIP_MEMORY_SCOPE_AGENT); const float rinv = rsqrtf(ssr * (1.f / 1024.f) + 1e-6f);
            float* orow = OUT + (size_t)row * 1024 + col0;
#pragma unroll
            for (int bj = 0; bj < 2; ++bj) { __builtin_nontemporal_store(acc[ai][bj][m][0] * rinv * gv[bj][0], (f32x4*)(orow + bj * 128)); __builtin_nontemporal_store(acc[ai][bj][m][1] * rinv * gv[bj][1], (f32x4*)(orow + bj * 128 + 4)); } }
    }
};

struct Ctx { LAS unsigned char* lds; int tid, lane, wave, G, wg, gw, NGW; };

template <int NBW>
__device__ __forceinline__ void transpose_item(const float* W, int N, int k0, int n0, bf16* dst, int ldk, const float* scl, int flip, LAS float* scr, int lane) {
    constexpr int LPR = NBW / 4, RPI = 64 / LPR, NI = 64 / RPI;
    const int rr = lane / LPR, cc = (lane % LPR) * 4;
    f32x4 v[NI];
#pragma unroll
    for (int i = 0; i < NI; ++i) v[i] = *(const f32x4*)(W + (size_t)(k0 + i * RPI + rr) * N + n0 + cc);
#pragma unroll
    for (int i = 0; i < NI; ++i) { const int kk = i * RPI + rr; f32x4 x = v[i];
        if (scl) { const float s0 = scl[k0 + kk]; const float f = flip ? (1.0f - s0) : s0; x = x * f; }
        LAS float* d = scr + kk * 65 + cc; d[0] = x.x; d[1] = x.y; d[2] = x.z; d[3] = x.w; }
    LDS_WAIT(); asm volatile("" ::: "memory");
    const int c = lane & 7;
#pragma unroll
    for (int j = 0; j < NBW / 8; ++j) { const int n = (lane >> 3) + 8 * j; const LAS float* s = scr + (8 * c) * 65 + n;
        u32x4 o; o.x = pk2(s[0 * 65], s[1 * 65]); o.y = pk2(s[2 * 65], s[3 * 65]); o.z = pk2(s[4 * 65], s[5 * 65]); o.w = pk2(s[6 * 65], s[7 * 65]);
        *(u32x4*)(dst + (size_t)n * ldk + 8 * c) = o; }
    LDS_WAIT(); asm volatile("" ::: "memory");
}
struct F8Item { f32x4 v[16]; };
__device__ __forceinline__ void f8_issue(const float* W, int N, int k0, int n0, int lane, F8Item& it) {
    const int rr = lane >> 4, cc = (lane & 15) * 4;
#pragma unroll
    for (int i = 0; i < 16; ++i) it.v[i] = __builtin_nontemporal_load((const f32x4*)(W + (size_t)(k0 + i * 4 + rr) * N + n0 + cc));
}
__device__ __forceinline__ void f8_finish(const F8Item& it, unsigned char* dst, int ldk, float scale, LAS float* scr, int lane) {
    const int rr = lane >> 4, cc = (lane & 15) * 4;
#pragma unroll
    for (int i = 0; i < 16; ++i) { const int kk = i * 4 + rr; LAS float* d = scr + kk * 65 + cc; d[0] = it.v[i].x * scale; d[1] = it.v[i].y * scale; d[2] = it.v[i].z * scale; d[3] = it.v[i].w * scale; }
    LDS_WAIT(); asm volatile("" ::: "memory");
    const int c = lane & 3;
#pragma unroll
    for (int j = 0; j < 4; ++j) { const int n = (lane >> 2) + 16 * j; const LAS float* s = scr + (16 * c) * 65 + n;
        u32x4 o; o.x = pk4_fp8(s[0 * 65], s[1 * 65], s[2 * 65], s[3 * 65]); o.y = pk4_fp8(s[4 * 65], s[5 * 65], s[6 * 65], s[7 * 65]); o.z = pk4_fp8(s[8 * 65], s[9 * 65], s[10 * 65], s[11 * 65]); o.w = pk4_fp8(s[12 * 65], s[13 * 65], s[14 * 65], s[15 * 65]);
        *(u32x4*)(dst + (size_t)n * ldk + 16 * c) = o; }
    LDS_WAIT(); asm volatile("" ::: "memory");
}
__device__ __forceinline__ void transpose_item_fp8(const float* W, int N, int k0, int n0, unsigned char* dst, int ldk, float scale, LAS float* scr, int lane) {
    F8Item it; f8_issue(W, N, k0, n0, lane, it); f8_finish(it, dst, ldk, scale, scr, lane);
}
__device__ __forceinline__ void transpose_matrix(const Ctx& cx, const float* W, int K, int N, bf16* WT, int row_off, int ldk, int koff, const float* scl, int flip) {
    LAS float* scr = (LAS float*)(cx.lds + cx.wave * 16640);
    const int nblk = N / 64, nitems = (K / 64) * nblk;
    for (int it = cx.gw; it < nitems; it += cx.NGW) { const int kb = it / nblk, nb = it % nblk;
        transpose_item<64>(W, N, 64 * kb, 64 * nb, WT + (size_t)(row_off + 64 * nb) * ldk + koff + 64 * kb, ldk, scl, flip, scr, cx.lane); }
}
__device__ __forceinline__ void rms_row_to_bf16(const float* xrow, const float* g, bf16* orow, int lane) {
    const f32x4* xr = (const f32x4*)xrow + lane; const f32x4* gr = (const f32x4*)g + lane;
    f32x4 v[4]; float s = 0.f;
#pragma unroll
    for (int j = 0; j < 4; ++j) { v[j] = xr[64 * j]; s += (v[j].x * v[j].x + v[j].y * v[j].y) + (v[j].z * v[j].z + v[j].w * v[j].w); }
    const float rinv = rsqrtf(wave_sum(s) * (1.f / 1024.f) + 1e-6f);
    u32x2* o8 = (u32x2*)orow + lane;
#pragma unroll
    for (int j = 0; j < 4; ++j) { const f32x4 gg = gr[64 * j]; u32x2 w; w.x = pk2(v[j].x * rinv * gg.x, v[j].y * rinv * gg.y); w.y = pk2(v[j].z * rinv * gg.z, v[j].w * rinv * gg.w); o8[64 * j] = w; }
}

__device__ __forceinline__ void rms_rows2_to_bf16(const float* xa, const float* xb, const float* g, bf16* oa, bf16* ob, int lane) {
    const f32x4* ra = (const f32x4*)xa + lane; const f32x4* rb = (const f32x4*)xb + lane; const f32x4* gr = (const f32x4*)g + lane;
    f32x4 va[4], vb[4]; float sa = 0.f, sb = 0.f;
#pragma unroll
    for (int j = 0; j < 4; ++j) { va[j] = __builtin_nontemporal_load(ra + 64 * j); vb[j] = __builtin_nontemporal_load(rb + 64 * j); }
#pragma unroll
    for (int j = 0; j < 4; ++j) { sa += (va[j].x * va[j].x + va[j].y * va[j].y) + (va[j].z * va[j].z + va[j].w * va[j].w); sb += (vb[j].x * vb[j].x + vb[j].y * vb[j].y) + (vb[j].z * vb[j].z + vb[j].w * vb[j].w); }
#pragma unroll
    for (int o = 1; o < 64; o <<= 1) { sa += __shfl_xor(sa, o); sb += __shfl_xor(sb, o); }
    const float ia = rsqrtf(sa * (1.f / 1024.f) + 1e-6f), ib = rsqrtf(sb * (1.f / 1024.f) + 1e-6f);
    u32x2* pa = (u32x2*)oa + lane; u32x2* pb = (u32x2*)ob + lane;
#pragma unroll
    for (int j = 0; j < 4; ++j) { const f32x4 gg = gr[64 * j]; u32x2 w; w.x = pk2(va[j].x * ia * gg.x, va[j].y * ia * gg.y); w.y = pk2(va[j].z * ia * gg.z, va[j].w * ia * gg.w); pa[64 * j] = w;
        w.x = pk2(vb[j].x * ib * gg.x, vb[j].y * ib * gg.y); w.y = pk2(vb[j].z * ib * gg.z, vb[j].w * ib * gg.w); pb[64 * j] = w; }
}

__device__ __forceinline__ void s5_tables_item(const Ctx& cx, int g, int part, const float* lam_re, const float* lam_im, const float* log_dt, const float* b_re, const float* b_im, const float* c_re, const float* c_im,
                                               bf16* BT, bf16* ET, float* AT) {
    LAS float* apr = (LAS float*)cx.lds; LAS float* api = apr + 33 * 64; LAS float* bbr = api + 33 * 64; LAS float* bbi = bbr + 1024; LAS float* cr = bbi + 1024; LAS float* ci = cr + 1024; LAS float* kt = ci + 1024;
    const int tid = cx.tid;
    const float dt = __expf(log_dt[g]);
    for (int idx = tid; idx < 33 * 64; idx += NTHR) { const int j = idx >> 6, p = idx & 63;
        const float lre = fminf(lam_re[g * 64 + p], -1e-4f), lim = lam_im[g * 64 + p];
        const float mag = expf(lre * dt * (float)j), ang = lim * dt * (float)j; float sn, cs; sincosf(ang, &sn, &cs);
        apr[idx] = mag * cs; api[idx] = mag * sn; }
    for (int idx = tid; idx < 1024; idx += NTHR) { const int p = idx >> 4;
        const float lre = fminf(lam_re[g * 64 + p], -1e-4f), lim = lam_im[g * 64 + p];
        const float mag = expf(lre * dt); float sn, cs; sincosf(lim * dt, &sn, &cs); const float lbr = mag * cs, lbi = mag * sn;
        const float den = lre * lre + lim * lim, zr = lbr - 1.0f; const float cor = (zr * lre + lbi * lim) / den, coi = (lbi * lre - zr * lim) / den;
        const float br = b_re[g * 1024 + idx], bi = b_im[g * 1024 + idx];
        bbr[idx] = cor * br - coi * bi; bbi[idx] = cor * bi + coi * br;
        cr[idx] = c_re[g * 1024 + idx]; ci[idx] = c_im[g * 1024 + idx]; }
    __syncthreads();
    if (tid < 64) { const int jl = tid >> 4, c = tid & 15, j = 4 * part + jl; float acc[16];
#pragma unroll
        for (int i = 0; i < 16; ++i) acc[i] = 0.f;
        for (int p = 0; p < 64; ++p) { const float ar = apr[j * 64 + p], ai = api[j * 64 + p], xr = cr[c * 64 + p], xi = ci[c * 64 + p];
            const float car = xr * ar - xi * ai, cai = xr * ai + xi * ar;
#pragma unroll
            for (int v4 = 0; v4 < 4; ++v4) { const f32x4 br = *(const LAS f32x4*)(bbr + p * 16 + 4 * v4), bi = *(const LAS f32x4*)(bbi + p * 16 + 4 * v4);
                acc[4 * v4 + 0] += car * br.x - cai * bi.x; acc[4 * v4 + 1] += car * br.y - cai * bi.y; acc[4 * v4 + 2] += car * br.z - cai * bi.z; acc[4 * v4 + 3] += car * br.w - cai * bi.w; } }
#pragma unroll
        for (int i = 0; i < 16; ++i) kt[jl * 256 + c * 16 + i] = acc[i]; }
    __syncthreads();
    bf16* BTg = BT + (size_t)g * 512 * 640; bf16* ETg = ET + (size_t)g * 256 * 512;
    for (int idx = tid; idx < 4096; idx += NTHR) { const int hf = idx & 1, c = (idx >> 1) & 15, t = (idx >> 5) & 31, jl = idx >> 10, j = 4 * part + jl;
        if (t >= j) { const LAS float* s = kt + jl * 256 + c * 16 + hf * 8; u32x4 o; o.x = pk2(s[0], s[1]); o.y = pk2(s[2], s[3]); o.z = pk2(s[4], s[5]); o.w = pk2(s[6], s[7]);
            *(u32x4*)(BTg + (size_t)(t * 16 + c) * 640 + (t - j) * 16 + hf * 8) = o; } }
    for (int idx = tid; idx < 4096; idx += NTHR) { const int hf = idx & 1, c = (idx >> 1) & 15, s = (idx >> 5) & 31, t = 4 * part + (idx >> 10);
        if (s > t) *(u32x4*)(BTg + (size_t)(t * 16 + c) * 640 + s * 16 + hf * 8) = (u32x4){0u, 0u, 0u, 0u}; }
    for (int idx = tid; idx < 1024; idx += NTHR) { const int ch = idx & 15, c = (idx >> 4) & 15, t = 4 * part + (idx >> 8); const int im = ch >> 3, p0 = (ch & 7) * 8; float v[8];
#pragma unroll
        for (int q = 0; q < 8; ++q) { const int p = p0 + q; const float ar = apr[(t + 1) * 64 + p], ai = api[(t + 1) * 64 + p], xr = cr[c * 64 + p], xi = ci[c * 64 + p];
            v[q] = im ? -(xr * ai + xi * ar) : (xr * ar - xi * ai); }
        u32x4 o; o.x = pk2(v[0], v[1]); o.y = pk2(v[2], v[3]); o.z = pk2(v[4], v[5]); o.w = pk2(v[6], v[7]);
        *(u32x4*)(BTg + (size_t)(t * 16 + c) * 640 + 512 + im * 64 + p0) = o; }
    for (int idx = tid; idx < 1024; idx += NTHR) { const int hf = idx & 1, sl = (idx >> 1) & 3, n = idx >> 3, s = 4 * part + sl, p = n & 63, im = n >> 6; float v[8];
        const float ar = apr[(31 - s) * 64 + p], ai = api[(31 - s) * 64 + p];
#pragma unroll
        for (int q = 0; q < 8; ++q) { const float br = bbr[p * 16 + hf * 8 + q], bi = bbi[p * 16 + hf * 8 + q]; v[q] = im ? (ar * bi + ai * br) : (ar * br - ai * bi); }
        u32x4 o; o.x = pk2(v[0], v[1]); o.y = pk2(v[2], v[3]); o.z = pk2(v[4], v[5]); o.w = pk2(v[6], v[7]);
        *(u32x4*)(ETg + (size_t)n * 512 + s * 16 + hf * 8) = o; }
    for (int idx = tid; idx < 1024; idx += NTHR) { const int ch = idx & 63, r = 128 + 16 * part + (idx >> 6); *(u32x4*)(ETg + (size_t)r * 512 + ch * 8) = (u32x4){0u, 0u, 0u, 0u}; }
    if (part == 0 && tid < 64) { AT[(g * 64 + tid) * 2] = apr[32 * 64 + tid]; AT[(g * 64 + tid) * 2 + 1] = api[32 * 64 + tid]; }
    __syncthreads();
}

constexpr int IMG_LD = 80, IMG_B = 64 * IMG_LD * 2;
#define IMG(k) ((LAS bf16*)(lds + (k) * IMG_B))
#define LDS_BARRIER() do { asm volatile("s_waitcnt lgkmcnt(0)" ::: "memory"); __builtin_amdgcn_s_barrier(); asm volatile("" ::: "memory"); } while (0)
struct MmCtx { int tr, tc0, l15, q; };
__device__ __forceinline__ void mm64(const LAS bf16* A, const LAS bf16* Bt, f32x4 (&acc)[2], const MmCtx& w) {
#pragma unroll
    for (int s = 0; s < 2; ++s) {
        const bf16x8 a = *(const LAS bf16x8*)(A + (16 * w.tr + w.l15) * IMG_LD + 32 * s + 8 * w.q);
#pragma unroll
        for (int c = 0; c < 2; ++c) { const bf16x8 b = *(const LAS bf16x8*)(Bt + (16 * (w.tc0 + c) + w.l15) * IMG_LD + 32 * s + 8 * w.q);
            acc[c] = __builtin_amdgcn_mfma_f32_16x16x32_bf16(a, b, acc[c], 0, 0, 0); }
    }
}
__device__ __forceinline__ void mm64_2a(const LAS bf16* A1, const LAS bf16* A2, const LAS bf16* Bt, f32x4 (&acc1)[2], f32x4 (&acc2)[2], const MmCtx& w) {
#pragma unroll
    for (int s = 0; s < 2; ++s) {
        const bf16x8 a1 = *(const LAS bf16x8*)(A1 + (16 * w.tr + w.l15) * IMG_LD + 32 * s + 8 * w.q), a2 = *(const LAS bf16x8*)(A2 + (16 * w.tr + w.l15) * IMG_LD + 32 * s + 8 * w.q);
#pragma unroll
        for (int c = 0; c < 2; ++c) { const bf16x8 b = *(const LAS bf16x8*)(Bt + (16 * (w.tc0 + c) + w.l15) * IMG_LD + 32 * s + 8 * w.q);
            acc1[c] = __builtin_amdgcn_mfma_f32_16x16x32_bf16(a1, b, acc1[c], 0, 0, 0); acc2[c] = __builtin_amdgcn_mfma_f32_16x16x32_bf16(a2, b, acc2[c], 0, 0, 0); }
    }
}
__device__ __forceinline__ void mm64_2b(const LAS bf16* A, const LAS bf16* Bt1, const LAS bf16* Bt2, f32x4 (&acc1)[2], f32x4 (&acc2)[2], const MmCtx& w) {
#pragma unroll
    for (int s = 0; s < 2; ++s) {
        const bf16x8 a = *(const LAS bf16x8*)(A + (16 * w.tr + w.l15) * IMG_LD + 32 * s + 8 * w.q);
#pragma unroll
        for (int c = 0; c < 2; ++c) { const bf16x8 b1 = *(const LAS bf16x8*)(Bt1 + (16 * (w.tc0 + c) + w.l15) * IMG_LD + 32 * s + 8 * w.q), b2 = *(const LAS bf16x8*)(Bt2 + (16 * (w.tc0 + c) + w.l15) * IMG_LD + 32 * s + 8 * w.q);
            acc1[c] = __builtin_amdgcn_mfma_f32_16x16x32_bf16(a, b1, acc1[c], 0, 0, 0); acc2[c] = __builtin_amdgcn_mfma_f32_16x16x32_bf16(a, b2, acc2[c], 0, 0, 0); }
    }
}
__device__ __forceinline__ float dpp_x1(float v) { return __int_as_float(__builtin_amdgcn_update_dpp(0, __float_as_int(v), 0xB1, 0xF, 0xF, true)); }
__device__ __forceinline__ float dpp_x2(float v) { return __int_as_float(__builtin_amdgcn_update_dpp(0, __float_as_int(v), 0x4E, 0xF, 0xF, true)); }
__device__ __forceinline__ f32x4 quad_transpose(const f32x4 v, int b) {
    const bool odd = (b & 1) != 0, hi = (b & 2) != 0;
    const float r0 = dpp_x1(odd ? v[0] : v[1]), r1 = dpp_x1(odd ? v[2] : v[3]);
    const float p0a = odd ? r0 : v[0], p0b = odd ? v[1] : r0, p1a = odd ? r1 : v[2], p1b = odd ? v[3] : r1;
    const float ra = dpp_x2(hi ? p0a : p1a), rb = dpp_x2(hi ? p0b : p1b);
    return hi ? (f32x4){ra, rb, p1a, p1b} : (f32x4){p0a, p0b, ra, rb};
}
__device__ __forceinline__ void st_rm(LAS bf16* img, const f32x4 v, int tr, int tc, const MmCtx& w) {
    const unsigned p01 = pk2(v[0], v[1]), p23 = pk2(v[2], v[3]); LAS bf16* d = img + (16 * tr + 4 * w.q) * IMG_LD + 16 * tc + w.l15;
    d[0] = (bf16)p01; d[IMG_LD] = (bf16)(p01 >> 16); d[2 * IMG_LD] = (bf16)p23; d[3 * IMG_LD] = (bf16)(p23 >> 16);
}
__device__ __forceinline__ void st_tr(LAS bf16* img, const f32x4 v, int tr, int tc, const MmCtx& w) {
    u32x2 o; o.x = pk2(v[0], v[1]); o.y = pk2(v[2], v[3]); *(LAS u32x2*)(img + (16 * tc + w.l15) * IMG_LD + 16 * tr + 4 * w.q) = o;
}
__device__ __forceinline__ void img_to_global(const LAS bf16* img, bf16* g, int tid) { const int row = tid >> 3, ch = tid & 7; *(u32x4*)(g + row * 64 + ch * 8) = *(const LAS u32x4*)(img + row * IMG_LD + ch * 8); }
__device__ __forceinline__ void st_tm8(LAS bf16* img, int t, int cg, const float (&v)[8]) {
    u32x4 o; o.x = pk2(v[0], v[1]); o.y = pk2(v[2], v[3]); o.z = pk2(v[4], v[5]); o.w = pk2(v[6], v[7]); *(LAS u32x4*)(img + t * IMG_LD + 8 * cg) = o;
}
__device__ __forceinline__ void st_cm8(LAS bf16* img, int t, int cg, const float (&v)[8]) {
#pragma unroll
    for (int i = 0; i < 8; i += 2) { const unsigned p = pk2(v[i], v[i + 1]); img[(8 * cg + i) * IMG_LD + t] = (bf16)p; img[(8 * cg + i + 1) * IMG_LD + t] = (bf16)(p >> 16); }
}
__device__ __forceinline__ float red8(float v) { v += __shfl_xor(v, 1); v += __shfl_xor(v, 2); v += __shfl_xor(v, 4); return v; }
__device__ __forceinline__ void unpack8(const u32x4 w, float (&o)[8]) { o[0] = lo16(w.x); o[1] = hi16(w.x); o[2] = lo16(w.y); o[3] = hi16(w.y); o[4] = lo16(w.z); o[5] = hi16(w.z); o[6] = lo16(w.w); o[7] = hi16(w.w); }
__device__ __forceinline__ void ldp8(const float* p, float (&o)[8]) { const f32x4 a = *(const f32x4*)p, b = *(const f32x4*)(p + 4); o[0] = a.x; o[1] = a.y; o[2] = a.z; o[3] = a.w; o[4] = b.x; o[5] = b.y; o[6] = b.z; o[7] = b.w; }

struct RwkvP { const bf16* rkv; const bf16* wag; const float *mu_rkv, *w0, *a0, *k_k, *k_a, *r_k, *ln_w, *ln_b; };
struct RwkvRaw { u32x4 kc, kp, vc, vp, wl, al, rc, rp, gg; };
template <bool PASS3>
__device__ __forceinline__ void rwkv_load(const RwkvP& P, int cidx, int tid, RwkvRaw& R) {
    const int t = tid >> 3, cg = tid & 7, bh = cidx >> 7, c = cidx & 127, b = bh >> 3, h = bh & 7, ch = h * 64 + 8 * cg;
    const size_t tok = (size_t)b * SEQ + c * 64 + t; const bool first = (c == 0 && t == 0);
    const bf16* row = P.rkv + tok * 1536 + ch; const bf16* prow = first ? row : row - 1536;
    R.kc = *(const u32x4*)(row + 512); R.vc = *(const u32x4*)(row + 1024); R.kp = *(const u32x4*)(prow + 512); R.vp = *(const u32x4*)(prow + 1024);
    R.wl = *(const u32x4*)(P.wag + tok * 1536 + ch); R.al = *(const u32x4*)(P.wag + tok * 1536 + 512 + ch);
    if (PASS3) { R.rc = *(const u32x4*)row; R.rp = *(const u32x4*)prow; R.gg = *(const u32x4*)(P.wag + tok * 1536 + 1024 + ch); }
}
struct RwkvC { float mu_r[8], mu_k[8], mu_v[8], w0[8], a0[8], kk[8], ka[8]; };
__device__ __forceinline__ void rwkv_consts(const RwkvP& P, int h, int cg, RwkvC& C) { const int ch = h * 64 + 8 * cg;
    ldp8(P.mu_rkv + ch, C.mu_r); ldp8(P.mu_rkv + 512 + ch, C.mu_k); ldp8(P.mu_rkv + 1024 + ch, C.mu_v); ldp8(P.w0 + ch, C.w0); ldp8(P.a0 + ch, C.a0); ldp8(P.k_k + ch, C.kk); ldp8(P.k_a + ch, C.ka); }
template <bool PASS3>
__device__ __forceinline__ void rwkv_prep(const RwkvRaw& R, const RwkvC& C, bool first, float (&kq)[8], float (&vv)[8], float (&rr)[8], float (&kap)[8], float (&bet)[8], float (&lw)[8]) {
    float kc[8], kp[8], vc[8], vp[8], k[8], wl[8], al[8], a[8];
    unpack8(R.kc, kc); unpack8(R.vc, vc); unpack8(R.kp, kp); unpack8(R.vp, vp); unpack8(R.wl, wl); unpack8(R.al, al);
    const float pm = first ? 0.f : 1.f;
#pragma unroll
    for (int i = 0; i < 8; ++i) { k[i] = kc[i] + (pm * kp[i] - kc[i]) * C.mu_k[i]; vv[i] = vc[i] + (pm * vp[i] - vc[i]) * C.mu_v[i]; }
    if (PASS3) { float rc[8], rp[8]; unpack8(R.rc, rc); unpack8(R.rp, rp);
#pragma unroll
        for (int i = 0; i < 8; ++i) rr[i] = rc[i] + (pm * rp[i] - rc[i]) * C.mu_r[i];
    } else {
#pragma unroll
        for (int i = 0; i < 8; ++i) rr[i] = 0.f;
    }
    float ss = 0.f;
#pragma unroll
    for (int i = 0; i < 8; ++i) { lw[i] = -0.6065306597126334f * fsigmoid(C.w0[i] + wl[i]); a[i] = fsigmoid(C.a0[i] + al[i]); kap[i] = k[i] * C.kk[i]; ss += kap[i] * kap[i]; }
    ss = red8(ss);
    const float inv = 1.0f / fmaxf(sqrtf(ss), 1e-12f);
#pragma unroll
    for (int i = 0; i < 8; ++i) { kap[i] *= inv; bet[i] = kap[i] * a[i]; kq[i] = k[i] * (1.0f + (a[i] - 1.0f) * C.ka[i]); }
}
template <int SEGSLOT>
__device__ __forceinline__ void rwkv_cumsum(LAS unsigned char* lds, int tid, const float (&lw)[8], float (&cum)[8], float (&cumL)[8]) {
    LAS float* LW = (LAS float*)(lds + 12 * IMG_B); LAS float* SEG = (LAS float*)(lds + SEGSLOT * IMG_B);
    const int t = tid >> 3, cg = tid & 7, j = tid & 63, seg = tid >> 6;
#pragma unroll
    for (int i = 0; i < 8; ++i) LW[t * 65 + 8 * cg + i] = lw[i];
    LDS_BARRIER();
    { float run = 0.f;
#pragma unroll
      for (int tt = 0; tt < 8; ++tt) { const int idx = (8 * seg + tt) * 65 + j; run += LW[idx]; LW[idx] = run; }
      SEG[seg * 64 + j] = run; }
    LDS_BARRIER();
    { float pre = 0.f;
#pragma unroll
      for (int s2 = 0; s2 < 8; ++s2) { const float x = SEG[s2 * 64 + j]; pre += (s2 < seg) ? x : 0.f; }
#pragma unroll
      for (int tt = 0; tt < 8; ++tt) LW[(8 * seg + tt) * 65 + j] += pre; }
    LDS_BARRIER();
#pragma unroll
    for (int i = 0; i < 8; ++i) { cum[i] = LW[t * 65 + 8 * cg + i]; cumL[i] = LW[63 * 65 + 8 * cg + i]; }
}
#define Z4 (f32x4){0.f, 0.f, 0.f, 0.f}

__device__ __forceinline__ void rwkv_pass1(LAS unsigned char* lds, const RwkvP& P, int c0, int n, int tid, bf16* QCT, float* HCT, bf16* W1G, bf16* ULG, float* DLG) {
    const int lane = tid & 63, wv = __builtin_amdgcn_readfirstlane(tid >> 6); MmCtx w; w.tr = wv >> 1; w.tc0 = (wv & 1) * 2; w.l15 = lane & 15; w.q = lane >> 4;
    const int t = tid >> 3, cg = tid & 7;
    RwkvC C; rwkv_consts(P, (c0 >> 7) & 7, cg, C);
    RwkvRaw R; rwkv_load<false>(P, c0, tid, R);
    for (int ci = 0; ci < n; ++ci) {
        const int cidx = c0 + ci;
        {
            float kq[8], vv[8], rr[8], kap[8], bet[8], lw[8], cum[8], cumL[8];
            rwkv_prep<false>(R, C, (cidx & 127) == 0 && t == 0, kq, vv, rr, kap, bet, lw);
            if (ci + 1 < n) rwkv_load<false>(P, cidx + 1, tid, R);
            rwkv_cumsum<11>(lds, tid, lw, cum, cumL);
            float x[8], y[8];
#pragma unroll
            for (int i = 0; i < 8; ++i) { const float en = __expf(-cum[i]); x[i] = kq[i] * en; y[i] = bet[i] * en; }
            st_tm8(IMG(0), t, cg, x);
            st_tm8(IMG(1), t, cg, y);
#pragma unroll
            for (int i = 0; i < 8; ++i) x[i] = kap[i] * __expf(cum[i] - lw[i]);
            st_tm8(IMG(2), t, cg, x);
            st_cm8(IMG(3), t, cg, x);
#pragma unroll
            for (int i = 0; i < 8; ++i) { const float eh = __expf(cumL[i] - cum[i]); x[i] = kq[i] * eh; y[i] = bet[i] * eh; }
            st_cm8(IMG(4), t, cg, x);
            st_cm8(IMG(5), t, cg, y);
            st_cm8(IMG(6), t, cg, vv);
            if (t == 0) {
#pragma unroll
                for (int i = 0; i < 8; ++i) DLG[(size_t)cidx * 64 + 8 * cg + i] = __expf(cumL[i]);
            }
        }
        LDS_BARRIER();
        f32x4 accX[2];
        {
            f32x4 a[2] = {Z4, Z4}, kk[2] = {Z4, Z4};
            mm64_2a(IMG(1), IMG(0), IMG(2), a, kk, w);
#pragma unroll
            for (int c = 0; c < 2; ++c) { const int nn = 16 * (w.tc0 + c) + w.l15;
#pragma unroll
                for (int r = 0; r < 4; ++r) { const int m = 16 * w.tr + 4 * w.q + r; a[c][r] = (m < nn) ? a[c][r] : 0.f; kk[c][r] = (m < nn) ? kk[c][r] : 0.f; accX[c][r] = ((m == nn) ? 1.0f : 0.f) - a[c][r]; }
                st_rm(IMG(7), a[c], w.tr, w.tc0 + c, w); st_tr(IMG(8), a[c], w.tr, w.tc0 + c, w); st_rm(IMG(10), accX[c], w.tr, w.tc0 + c, w); st_rm(IMG(9), kk[c], w.tr, w.tc0 + c, w); }
        }
        LDS_BARRIER();
        {
            f32x4 p[2] = {Z4, Z4};
            mm64(IMG(7), IMG(8), p, w);
#pragma unroll
            for (int c = 0; c < 2; ++c) { st_rm(IMG(12), p[c], w.tr, w.tc0 + c, w); st_tr(IMG(13), p[c], w.tr, w.tc0 + c, w); }
        }
        LDS_BARRIER();
#define NEUMANN(XC, XN, PC, PTC, PN, PTN, LASTR) do { if (LASTR) mm64(IMG(XC), IMG(PTC), accX, w); \
            if (!(LASTR)) { f32x4 p[2] = {Z4, Z4}; mm64_2a(IMG(XC), IMG(PC), IMG(PTC), accX, p, w); \
                _Pragma("unroll") for (int c = 0; c < 2; ++c) { st_rm(IMG(PN), p[c], w.tr, w.tc0 + c, w); st_tr(IMG(PTN), p[c], w.tr, w.tc0 + c, w); st_rm(IMG(XN), accX[c], w.tr, w.tc0 + c, w); } } \
            LDS_BARRIER(); } while (0)
        NEUMANN(10, 11, 12, 13, 0, 1, false);
        NEUMANN(11, 10, 0, 1, 12, 13, false);
        NEUMANN(10, 11, 12, 13, 0, 1, false);
        NEUMANN(11, 10, 0, 1, 12, 13, false);
        NEUMANN(10, 11, 12, 13, 0, 1, true);
#undef NEUMANN
#pragma unroll
        for (int c = 0; c < 2; ++c) st_tr(IMG(7), accX[c], w.tr, w.tc0 + c, w);
        LDS_BARRIER();
        {
            f32x4 a[2] = {Z4, Z4}, g[2] = {Z4, Z4};
            mm64_2a(IMG(3), IMG(9), IMG(7), a, g, w);
#pragma unroll
            for (int c = 0; c < 2; ++c) { st_rm(IMG(12), a[c], w.tr, w.tc0 + c, w); st_tr(IMG(2), a[c], w.tr, w.tc0 + c, w); st_tr(IMG(8), g[c], w.tr, w.tc0 + c, w); }
        }
        LDS_BARRIER();
        {
            f32x4 u[2] = {Z4, Z4}, qc[2] = {Z4, Z4};
            mm64(IMG(6), IMG(8), u, w); mm64(IMG(5), IMG(12), qc, w);
#pragma unroll
            for (int c = 0; c < 2; ++c) { st_rm(IMG(13), u[c], w.tr, w.tc0 + c, w);
                const int tc = w.tc0 + c, cp = 32 * (tc >> 1) + 8 * (w.l15 >> 2) + 4 * (tc & 1) + (w.l15 & 3);
                const unsigned p01 = pk2(qc[c][0], qc[c][1]), p23 = pk2(qc[c][2], qc[c][3]); LAS bf16* d = IMG(0) + (16 * w.tr + 4 * w.q) * IMG_LD + cp;
                d[0] = (bf16)p01; d[IMG_LD] = (bf16)(p01 >> 16); d[2 * IMG_LD] = (bf16)p23; d[3 * IMG_LD] = (bf16)(p23 >> 16); }
            img_to_global(IMG(2), W1G + (size_t)cidx * 4096, tid);
        }
        LDS_BARRIER();
        {
            f32x4 hp[2] = {Z4, Z4}, hn[2] = {Z4, Z4};
            mm64(IMG(4), IMG(6), hp, w); mm64(IMG(5), IMG(13), hn, w);
#pragma unroll
            for (int c = 0; c < 2; ++c) *(f32x4*)(HCT + (((size_t)cidx * 16 + w.tr * 4 + w.tc0 + c) * 64 + lane) * 4) = hp[c] - hn[c];
            img_to_global(IMG(13), ULG + (size_t)cidx * 4096, tid);
            img_to_global(IMG(0), QCT + (size_t)cidx * 4096, tid);
        }
        LDS_BARRIER();
    }
}

constexpr int P2_SLOT = 12544, P2_DEPTH = 5;
__device__ __forceinline__ void rwkv_pass2(LAS unsigned char* lds, int bh, int ti, int lane, const bf16* QCT, const float* HCT, const float* DLG, bf16* S0G) {
    const int l15 = lane & 15, q = lane >> 4;
    f32x4 X[4];
#pragma unroll
    for (int tj = 0; tj < 4; ++tj) X[tj] = Z4;
#define P2_DMA(cc) do { const size_t ci_ = (size_t)bh * 128 + (cc); LAS unsigned char* sl_ = lds + ((cc) % P2_DEPTH) * P2_SLOT; \
        _Pragma("unroll") for (int i = 0; i < 8; ++i) { const int row_ = i * 8 + (lane >> 3), pc_ = (lane & 7) ^ (row_ & 7); \
            __builtin_amdgcn_global_load_lds((const unsigned*)((const char*)QCT + (ci_ * 64 + row_) * 128 + pc_ * 16), (LAS unsigned*)(sl_ + i * 1024), 16, 0, 0); } \
        _Pragma("unroll") for (int tj = 0; tj < 4; ++tj) __builtin_amdgcn_global_load_lds((const unsigned*)((const char*)HCT + ((ci_ * 16 + tj * 4 + ti) * 64 + lane) * 16), (LAS unsigned*)(sl_ + 8192 + tj * 1024), 16, 0, 0); \
        __builtin_amdgcn_global_load_lds((const unsigned*)((const char*)DLG + (ci_ * 64 + lane) * 4), (LAS unsigned*)(sl_ + 12288), 4, 0, 0); } while (0)
    P2_DMA(0); P2_DMA(1); P2_DMA(2); P2_DMA(3);
    for (int c = 0; c < 128; ++c) {
        if (c < 124) asm volatile("s_waitcnt vmcnt(39)" ::: "memory"); else asm volatile("s_waitcnt vmcnt(0)" ::: "memory");
        const LAS unsigned char* sl = lds + (c % P2_DEPTH) * P2_SLOT;
        bf16x8 a[4][2]; f32x4 h[4], d[4];
#pragma unroll
        for (int tj = 0; tj < 4; ++tj) { const int row = 16 * tj + l15;
#pragma unroll
            for (int s = 0; s < 2; ++s) a[tj][s] = *(const LAS bf16x8*)(sl + row * 128 + (((4 * s + q) ^ (row & 7)) * 16));
            h[tj] = *(const LAS f32x4*)(sl + 8192 + tj * 1024 + lane * 16); d[tj] = *(const LAS f32x4*)(sl + 12288 + (16 * tj + 4 * q) * 4); }
        asm volatile("s_waitcnt lgkmcnt(0)" ::: "memory");
        if (c + 4 < 128) P2_DMA(c + 4);
        const size_t cidx = (size_t)bh * 128 + c;
#pragma unroll
        for (int tj = 0; tj < 4; ++tj) { u32x2 o; o.x = pk2(X[tj][0], X[tj][1]); o.y = pk2(X[tj][2], X[tj][3]); *(u32x2*)(S0G + (cidx * 64 + 16 * ti + l15) * 64 + 16 * tj + 4 * q) = o; }
        bf16x8 b[2];
#pragma unroll
        for (int s = 0; s < 2; ++s) { u32x4 o; o.x = pk2(X[2 * s][0], X[2 * s][1]); o.y = pk2(X[2 * s][2], X[2 * s][3]); o.z = pk2(X[2 * s + 1][0], X[2 * s + 1][1]); o.w = pk2(X[2 * s + 1][2], X[2 * s + 1][3]); b[s] = __builtin_bit_cast(bf16x8, o); }
#pragma unroll
        for (int tj = 0; tj < 4; ++tj) { f32x4 acc = Z4;
            acc = __builtin_amdgcn_mfma_f32_16x16x32_bf16(a[tj][0], b[0], acc, 0, 0, 0); acc = __builtin_amdgcn_mfma_f32_16x16x32_bf16(a[tj][1], b[1], acc, 0, 0, 0);
            X[tj] = d[tj] * X[tj] + h[tj] - acc; }
    }
    asm volatile("s_waitcnt vmcnt(0)" ::: "memory");
#undef P2_DMA
}

__device__ __forceinline__ void rwkv_pass3(LAS unsigned char* lds, const RwkvP& P, int c0, int n, int tid, const bf16* S0G, const bf16* W1G, const bf16* ULG, bf16* MIX) {
    const int lane = tid & 63, wv = __builtin_amdgcn_readfirstlane(tid >> 6); MmCtx w; w.tr = wv >> 1; w.tc0 = (wv & 1) * 2; w.l15 = lane & 15; w.q = lane >> 4;
    const int t = tid >> 3, cg = tid & 7, bh = c0 >> 7, b = bh >> 3, h = bh & 7, ch = h * 64 + 8 * cg;
    RwkvC C; rwkv_consts(P, h, cg, C);
    RwkvRaw R; rwkv_load<true>(P, c0, tid, R);
    u32x4 gS0, gW1, gUL;
    { const int row = tid >> 3, chk = tid & 7; const size_t o = (size_t)c0 * 4096 + row * 64 + chk * 8; gS0 = *(const u32x4*)(S0G + o); gW1 = *(const u32x4*)(W1G + o); gUL = *(const u32x4*)(ULG + o); }
    for (int ci = 0; ci < n; ++ci) {
        const int cidx = c0 + ci, c = cidx & 127;
        float vv[8], gg[8], bonus;
        {
            float kq[8], rr[8], kap[8], bet[8], lw[8], cum[8], cumL[8];
            rwkv_prep<true>(R, C, c == 0 && t == 0, kq, vv, rr, kap, bet, lw);
            unpack8(R.gg, gg);
            const u32x4 s0v = gS0, w1v = gW1, ulv = gUL;
            if (ci + 1 < n) { rwkv_load<true>(P, cidx + 1, tid, R);
                const int row = tid >> 3, chk = tid & 7; const size_t o = (size_t)(cidx + 1) * 4096 + row * 64 + chk * 8; gS0 = *(const u32x4*)(S0G + o); gW1 = *(const u32x4*)(W1G + o); gUL = *(const u32x4*)(ULG + o); }
            rwkv_cumsum<9>(lds, tid, lw, cum, cumL);
            float bs = 0.f, rk[8]; ldp8(P.r_k + ch, rk);
#pragma unroll
            for (int i = 0; i < 8; ++i) bs += rr[i] * kq[i] * rk[i];
            bonus = red8(bs);
            float x[8], y[8];
#pragma unroll
            for (int i = 0; i < 8; ++i) { const float en = __expf(-cum[i]); x[i] = kq[i] * en; y[i] = bet[i] * en; }
            st_tm8(IMG(1), t, cg, x);
            st_tm8(IMG(2), t, cg, y);
#pragma unroll
            for (int i = 0; i < 8; ++i) x[i] = rr[i] * __expf(cum[i]);
            st_tm8(IMG(0), t, cg, x);
            st_cm8(IMG(3), t, cg, vv);
            { const int row = tid >> 3, chk = tid & 7; *(LAS u32x4*)(IMG(4) + row * IMG_LD + chk * 8) = s0v; *(LAS u32x4*)(IMG(5) + row * IMG_LD + chk * 8) = w1v; *(LAS u32x4*)(IMG(6) + row * IMG_LD + chk * 8) = ulv; }
        }
        LDS_BARRIER();
        {
            f32x4 kr[2] = {Z4, Z4}, br[2] = {Z4, Z4}, u[2] = {Z4, Z4};
            mm64_2b(IMG(0), IMG(1), IMG(2), kr, br, w); mm64(IMG(4), IMG(5), u, w);
#pragma unroll
            for (int cc = 0; cc < 2; ++cc) { const int nn = 16 * (w.tc0 + cc) + w.l15;
#pragma unroll
                for (int r = 0; r < 4; ++r) { const int m = 16 * w.tr + 4 * w.q + r; kr[cc][r] = (nn <= m) ? kr[cc][r] : 0.f; br[cc][r] = (nn <= m) ? br[cc][r] : 0.f; u[cc][r] += bf2f(IMG(6)[m * IMG_LD + nn]); }
                st_rm(IMG(7), kr[cc], w.tr, w.tc0 + cc, w); st_rm(IMG(8), br[cc], w.tr, w.tc0 + cc, w); st_rm(IMG(9), u[cc], w.tr, w.tc0 + cc, w); }
        }
        LDS_BARRIER();
        {
            f32x4 yp[2] = {Z4, Z4}, yn[2] = {Z4, Z4};
            mm64(IMG(0), IMG(4), yp, w); mm64(IMG(7), IMG(3), yp, w); mm64(IMG(8), IMG(9), yn, w);
            LAS float* YF = (LAS float*)(lds + 10 * IMG_B);
#pragma unroll
            for (int cc = 0; cc < 2; ++cc)
#pragma unroll
                for (int r = 0; r < 4; ++r) YF[(16 * w.tr + 4 * w.q + r) * 65 + 16 * (w.tc0 + cc) + w.l15] = yp[cc][r] - yn[cc][r];
        }
        LDS_BARRIER();
        {
            const LAS float* YF = (const LAS float*)(lds + 10 * IMG_B);
            float y[8], s = 0.f;
#pragma unroll
            for (int i = 0; i < 8; ++i) { y[i] = YF[t * 65 + 8 * cg + i]; s += y[i]; }
            const float mean = red8(s) * (1.0f / 64.0f); float qv = 0.f;
#pragma unroll
            for (int i = 0; i < 8; ++i) { y[i] -= mean; qv += y[i] * y[i]; }
            const float rstd = rsqrtf(red8(qv) * (1.0f / 64.0f) + 64e-5f);
            float o[8], lnw[8], lnb[8]; ldp8(P.ln_w + ch, lnw); ldp8(P.ln_b + ch, lnb);
#pragma unroll
            for (int i = 0; i < 8; ++i) o[i] = (y[i] * rstd * lnw[i] + lnb[i] + bonus * vv[i]) * gg[i];
            const size_t tok = (size_t)b * SEQ + c * 64 + t;
            u32x4 ov; ov.x = pk2(o[0], o[1]); ov.y = pk2(o[2], o[3]); ov.z = pk2(o[4], o[5]); ov.w = pk2(o[6], o[7]);
            *(u32x4*)(MIX + tok * 1024 + 512 + ch) = ov;
        }
    }
}

constexpr int RW_LD = 1032;
__device__ __forceinline__ void router_phase(const Ctx& cx, const bf16* X1, const float* gnorm, const float* rw, const float* rb, unsigned char* H2, int* TOPE, float* TOPG, unsigned* HIST) {
    LAS bf16* WH = (LAS bf16*)cx.lds; LAS bf16* WL = WH + 32 * RW_LD;
    LAS unsigned* hcnt = (LAS unsigned*)(cx.lds + 135168);
    const int lane = cx.lane, l15 = lane & 15, q = lane >> 4;
    for (int idx = cx.tid; idx < 32768; idx += NTHR) { const int col = idx >> 5, e = idx & 31; const float v = rw[idx] * gnorm[col];
        const unsigned h = cvt_pk_bf16(v, 0.f) & 0xffffu; const float lo = v - bf2f(h); WH[e * RW_LD + col] = (bf16)h; WL[e * RW_LD + col] = (bf16)(cvt_pk_bf16(lo, 0.f) & 0xffffu); }
    const float b0 = rb[l15], b1 = rb[l15 + 16];
    for (int tb = cx.wg; tb < 256; tb += cx.G) {
        if (cx.tid < 32) hcnt[cx.tid] = 0u;
        __syncthreads();
        const int tok0 = tb * 128 + cx.wave * 16;
        const bf16* xrow = X1 + (size_t)(tok0 + l15) * 1024 + 8 * q;
        f32x4 acc[2] = {(f32x4){0.f, 0.f, 0.f, 0.f}, (f32x4){0.f, 0.f, 0.f, 0.f}}; float ss = 0.f;
#pragma unroll 8
        for (int s = 0; s < 32; ++s) {
            const u32x4 xw = *(const u32x4*)(xrow + 32 * s);
            { const float a0 = lo16(xw.x), a1 = hi16(xw.x), a2 = lo16(xw.y), a3 = hi16(xw.y), a4 = lo16(xw.z), a5 = hi16(xw.z), a6 = lo16(xw.w), a7 = hi16(xw.w);
              ss += (a0 * a0 + a1 * a1) + (a2 * a2 + a3 * a3) + (a4 * a4 + a5 * a5) + (a6 * a6 + a7 * a7); }
            const bf16x8 ah = __builtin_bit_cast(bf16x8, xw);
#pragma unroll
            for (int n = 0; n < 2; ++n) { const bf16x8 bh = *(const LAS bf16x8*)(WH + (l15 + 16 * n) * RW_LD + 32 * s + 8 * q), bl = *(const LAS bf16x8*)(WL + (l15 + 16 * n) * RW_LD + 32 * s + 8 * q);
                acc[n] = __builtin_amdgcn_mfma_f32_16x16x32_bf16(ah, bh, acc[n], 0, 0, 0); acc[n] = __builtin_amdgcn_mfma_f32_16x16x32_bf16(ah, bl, acc[n], 0, 0, 0); }
        }
        ss += __shfl_xor(ss, 16); ss += __shfl_xor(ss, 32);
        const float rinv_l = rsqrtf(ss * (1.f / 1024.f) + 1e-6f);
#pragma unroll
        for (int r = 0; r < 4; ++r) {
            const float ri = __shfl(rinv_l, 4 * q + r);
            float v0 = acc[0][r] * ri + b0, v1 = acc[1][r] * ri + b1; int se[4]; float sv[4];
#pragma unroll
            for (int k = 0; k < 4; ++k) { float bv = (v1 > v0) ? v1 : v0; int be = (v1 > v0) ? (l15 + 16) : l15;
#pragma unroll
                for (int off = 1; off < 16; off <<= 1) { const float ov = __shfl_xor(bv, off); const int oe = __shfl_xor(be, off); const bool take = (ov > bv) || (ov == bv && oe < be); bv = take ? ov : bv; be = take ? oe : be; }
                se[k] = be; sv[k] = bv; if (be == l15) v0 = -INFINITY; if (be == l15 + 16) v1 = -INFINITY; }
            if (l15 == r) { const int tok = tok0 + 4 * q + r;
                const float w1 = __expf(sv[1] - sv[0]), w2 = __expf(sv[2] - sv[0]), w3 = __expf(sv[3] - sv[0]); const float inv = 1.0f / (1.0f + w1 + w2 + w3);
                *(int4*)(TOPE + (size_t)tok * 4) = make_int4(se[0], se[1], se[2], se[3]);
                *(float4*)(TOPG + (size_t)tok * 4) = make_float4(inv, w1 * inv, w2 * inv, w3 * inv);
                atomicAdd((unsigned*)(hcnt + se[0]), 1u); atomicAdd((unsigned*)(hcnt + se[1]), 1u); atomicAdd((unsigned*)(hcnt + se[2]), 1u); atomicAdd((unsigned*)(hcnt + se[3]), 1u); }
        }
        const f32x4* gr = (const f32x4*)gnorm + lane;
#pragma unroll 4
        for (int i = 0; i < 16; ++i) { const float ri = __shfl(rinv_l, i); const u32x2* xr = (const u32x2*)(X1 + (size_t)(tok0 + i) * 1024) + lane; unsigned* o4 = (unsigned*)(H2 + (size_t)(tok0 + i) * 1024) + lane;
#pragma unroll
            for (int j = 0; j < 4; ++j) { const u32x2 v = xr[64 * j]; const f32x4 gg = gr[64 * j]; o4[64 * j] = pk4_fp8(lo16(v.x) * ri * gg.x, hi16(v.x) * ri * gg.y, lo16(v.y) * ri * gg.z, hi16(v.y) * ri * gg.w); } }
        __syncthreads();
        if (cx.tid < 32) HIST[tb * 32 + cx.tid] = hcnt[cx.tid];
        __syncthreads();
    }
}

constexpr int PL_BASE = 1280, PL_WCNT = 1312;
__device__ __forceinline__ void moe_plan(const Ctx& cx, const unsigned* HIST) {
    LAS int* PL = (LAS int*)(cx.lds + LDS_PLAN);
    const int e = cx.tid & 31, part = cx.tid >> 5;
    { int s = 0; for (int w = 16 * part; w < 16 * part + 16; ++w) s += (int)HIST[w * 32 + e]; PL[PL_TMP + part * 32 + e] = s; }
    __syncthreads();
    if (cx.tid < 32) { int c = 0; for (int p = 0; p < 16; ++p) c += PL[PL_TMP + p * 32 + cx.tid]; PL[PL_CNT + cx.tid] = c; }
    __syncthreads();
    if (cx.tid == 0) {
        int ps = 0;
        for (int x = 0; x < 32; ++x) { PL[PL_PSTART + x] = ps; const int pad = (PL[PL_CNT + x] + 255) & ~255; for (int i = 0; i < pad / 256; ++i) PL[PL_TILEE + ps / 256 + i] = x; ps += pad; }
        PL[PL_PSTART + 32] = ps;
        int np = 0, e0 = 0;
        while (e0 < 32 && np < 7) { PL[PL_PE0 + np] = e0; PL[PL_PROW0 + np] = PL[PL_PSTART + e0]; int rows = 0, e1 = e0;
            while (e1 < 32 && e1 - e0 < MAXEPP) { const int pad = PL[PL_PSTART + e1 + 1] - PL[PL_PSTART + e1]; if (rows + pad > RMAX && e1 > e0) break; rows += pad; ++e1; }
            e0 = e1; ++np; }
        PL[PL_PE0 + np] = 32; PL[PL_PROW0 + np] = ps; PL[PL_NPASS] = np;
    }
    __syncthreads();
}
__device__ __forceinline__ void dispatch_phase(const Ctx& cx, const unsigned* HIST, const int* TOPE, int* SLOTTOK, int* TOKSLOT) {
    LAS int* PL = (LAS int*)(cx.lds + LDS_PLAN);
    const int e5 = cx.tid & 31, part = cx.tid >> 5, lane = cx.lane;
    for (int tb = cx.wg; tb < 256; tb += cx.G) {
        { int s = 0; for (int w = 16 * part; w < 16 * part + 16; ++w) s += (w < tb) ? (int)HIST[w * 32 + e5] : 0; PL[PL_TMP + part * 32 + e5] = s; }
        const int tok = tb * 128 + (cx.tid >> 2), k = cx.tid & 3; const int e = TOPE[(size_t)tok * 4 + k];
        int rank = 0;
        for (int ee = 0; ee < 32; ++ee) { const unsigned long long mask = __ballot(e == ee); if (e == ee) rank = __popcll(mask & ((1ull << lane) - 1ull)); if (lane == 0) PL[PL_WCNT + cx.wave * 32 + ee] = __popcll(mask); }
        __syncthreads();
        if (cx.tid < 32) { int c = 0; for (int p = 0; p < 16; ++p) c += PL[PL_TMP + p * 32 + cx.tid]; PL[PL_BASE + cx.tid] = c; }
        __syncthreads();
        int off = 0; for (int w2 = 0; w2 < 8; ++w2) off += (w2 < cx.wave) ? PL[PL_WCNT + w2 * 32 + e] : 0;
        const int slot = PL[PL_PSTART + e] + PL[PL_BASE + e] + off + rank;
        SLOTTOK[slot] = tok; TOKSLOT[(size_t)tok * 4 + k] = slot;
        __syncthreads();
    }
    for (int e = cx.wg; e < 32; e += cx.G) { const int c = PL[PL_CNT + e], ps = PL[PL_PSTART + e], pe = PL[PL_PSTART + e + 1]; for (int r = ps + c + cx.tid; r < pe; r += NTHR) SLOTTOK[r] = 0; }
}
__device__ __forceinline__ void convert_pass(const Ctx& cx, int e0, int e1, const float* wg, const float* wu, const float* wd, unsigned char* WGU, unsigned char* WDN) {
    LAS float* scr = (LAS float*)(cx.lds + cx.wave * 16640);
    const int nitems = (e1 - e0) * 768;
#define CV_SRC(it_) ((((it_) % 768) >> 8) == 2 ? wd : ((((it_) % 768) >> 8) ? wu : wg)) + (size_t)(e0 + (it_) / 768) * 1048576
    int it = cx.gw; if (it >= nitems) return;
    F8Item cur; f8_issue(CV_SRC(it), 1024, 64 * (((it % 768) & 255) >> 4), 64 * ((it % 768) & 15), cx.lane, cur);
    for (;;) {
        const int nx = it + cx.NGW; const bool has = nx < nitems;
        F8Item nxt;
        if (has) f8_issue(CV_SRC(nx), 1024, 64 * (((nx % 768) & 255) >> 4), 64 * ((nx % 768) & 15), cx.lane, nxt);
        const int le = it / 768, r = it % 768, mat = r >> 8, kb = (r & 255) >> 4, nb = r & 15, n0 = 64 * nb;
        if (mat == 2) f8_finish(cur, WDN + (size_t)le * 1048576 + (size_t)n0 * 1024 + 64 * kb, 1024, 32.0f, scr, cx.lane);
        else { const int drow = (n0 >> 7) * 256 + (n0 & 127) + mat * 128; f8_finish(cur, WGU + (size_t)le * 2097152 + (size_t)drow * 1024 + 64 * kb, 1024, 32.0f, scr, cx.lane); }
        if (!has) break;
        it = nx;
#pragma unroll
        for (int i = 0; i < 16; ++i) cur.v[i] = nxt.v[i];
    }
#undef CV_SRC
}
__device__ __forceinline__ void combine_all(const Ctx& cx, const float* TOPG, const int* TOKSLOT, const unsigned char* Y, bf16* X, const float* gnorm, unsigned char* H3) {
    const int lane = cx.lane, step = cx.NGW;
    int tok = cx.gw; if (tok >= M) return;
    int4 sl = *(const int4*)(TOKSLOT + (size_t)tok * 4); float4 gs = *(const float4*)(TOPG + (size_t)tok * 4);
    u32x2 xw[4]; unsigned yw[4][4];
#define CMB_ISSUE(T, SL, XW, YW) do { const u32x2* xr_ = (const u32x2*)(X + (size_t)(T) * 1024) + lane; const int s_[4] = {SL.x, SL.y, SL.z, SL.w}; \
        _Pragma("unroll") for (int j = 0; j < 4; ++j) XW[j] = xr_[64 * j]; \
        _Pragma("unroll") for (int k = 0; k < 4; ++k) { const unsigned* yr_ = (const unsigned*)(Y + (size_t)s_[k] * 1024) + lane; _Pragma("unroll") for (int j = 0; j < 4; ++j) YW[k][j] = yr_[64 * j]; } } while (0)
    CMB_ISSUE(tok, sl, xw, yw);
    int4 sl1 = sl; float4 gs1 = gs; { const int t1 = tok + step; if (t1 < M) { sl1 = *(const int4*)(TOKSLOT + (size_t)t1 * 4); gs1 = *(const float4*)(TOPG + (size_t)t1 * 4); } }
    const f32x4* gr = (const f32x4*)gnorm + lane;
    for (;;) {
        const int t1 = tok + step, t2 = tok + 2 * step; const bool has1 = t1 < M;
        u32x2 nxw[4]; unsigned nyw[4][4];
        if (has1) CMB_ISSUE(t1, sl1, nxw, nyw);
        int4 sl2 = sl1; float4 gs2 = gs1; if (t2 < M) { sl2 = *(const int4*)(TOKSLOT + (size_t)t2 * 4); gs2 = *(const float4*)(TOPG + (size_t)t2 * 4); }
        f32x4 v[4]; const float gk[4] = {gs.x, gs.y, gs.z, gs.w};
#pragma unroll
        for (int j = 0; j < 4; ++j) v[j] = (f32x4){lo16(xw[j].x), hi16(xw[j].x), lo16(xw[j].y), hi16(xw[j].y)};
#pragma unroll
        for (int k = 0; k < 4; ++k)
#pragma unroll
            for (int j = 0; j < 4; ++j) v[j] += up4_fp8(yw[k][j]) * gk[k];
        u32x2* xo = (u32x2*)(X + (size_t)tok * 1024) + lane; float s = 0.f;
#pragma unroll
        for (int j = 0; j < 4; ++j) { u32x2 w; w.x = pk2(v[j].x, v[j].y); w.y = pk2(v[j].z, v[j].w); xo[64 * j] = w; s += (v[j].x * v[j].x + v[j].y * v[j].y) + (v[j].z * v[j].z + v[j].w * v[j].w); }
        const float rinv = rsqrtf(wave_sum(s) * (1.f / 1024.f) + 1e-6f); unsigned* o8 = (unsigned*)(H3 + (size_t)tok * 1024) + lane;
#pragma unroll
        for (int j = 0; j < 4; ++j) { const f32x4 gq = gr[64 * j]; o8[64 * j] = pk4_fp8(v[j].x * rinv * gq.x, v[j].y * rinv * gq.y, v[j].z * rinv * gq.z, v[j].w * rinv * gq.w); }
        if (!has1) break;
        tok = t1; gs = gs1; sl1 = sl2; gs1 = gs2;
#pragma unroll
        for (int j = 0; j < 4; ++j) { xw[j] = nxw[j];
#pragma unroll
            for (int k = 0; k < 4; ++k) yw[k][j] = nyw[k][j]; }
    }
#undef CMB_ISSUE
}
template <bool LAST>
__device__ __forceinline__ void combine_pass(const Ctx& cx, int e0, int e1, int row0, const int* TOPE, const float* TOPG, const int* TOKSLOT, const unsigned char* Y, bf16* X, const float* gnorm, unsigned char* H3) {
    for (int tok = cx.gw; tok < M; tok += cx.NGW) {
        const int4 es = *(const int4*)(TOPE + (size_t)tok * 4); const float4 gs = *(const float4*)(TOPG + (size_t)tok * 4); const int4 sl = *(const int4*)(TOKSLOT + (size_t)tok * 4);
        const int ee[4] = {es.x, es.y, es.z, es.w}; const float gg[4] = {gs.x, gs.y, gs.z, gs.w}; const int ss[4] = {sl.x, sl.y, sl.z, sl.w};
        bool any = false;
#pragma unroll
        for (int k = 0; k < 4; ++k) any |= (ee[k] >= e0 && ee[k] < e1);
        if (!LAST && !any) continue;
        u32x2* xr = (u32x2*)(X + (size_t)tok * 1024) + cx.lane; f32x4 v[4];
#pragma unroll
        for (int j = 0; j < 4; ++j) { const u32x2 w = xr[64 * j]; v[j] = (f32x4){lo16(w.x), hi16(w.x), lo16(w.y), hi16(w.y)}; }
#pragma unroll
        for (int k = 0; k < 4; ++k) if (ee[k] >= e0 && ee[k] < e1) { const unsigned* yr = (const unsigned*)(Y + (size_t)(ss[k] - row0) * 1024) + cx.lane; const float g = gg[k];
#pragma unroll
            for (int j = 0; j < 4; ++j) v[j] += up4_fp8(yr[64 * j]) * g; }
        if (any) {
#pragma unroll
            for (int j = 0; j < 4; ++j) { u32x2 w; w.x = pk2(v[j].x, v[j].y); w.y = pk2(v[j].z, v[j].w); xr[64 * j] = w; }
        }
        if (LAST) { float s = 0.f;
#pragma unroll
            for (int j = 0; j < 4; ++j) s += (v[j].x * v[j].x + v[j].y * v[j].y) + (v[j].z * v[j].z + v[j].w * v[j].w);
            const float rinv = rsqrtf(wave_sum(s) * (1.f / 1024.f) + 1e-6f); const f32x4* gr = (const f32x4*)gnorm + cx.lane; unsigned* o8 = (unsigned*)(H3 + (size_t)tok * 1024) + cx.lane;
#pragma unroll
            for (int j = 0; j < 4; ++j) { const f32x4 gq = gr[64 * j]; o8[64 * j] = pk4_fp8(v[j].x * rinv * gq.x, v[j].y * rinv * gq.y, v[j].z * rinv * gq.z, v[j].w * rinv * gq.w); } }
    }
}

#define HBUF ((bf16*)(ws + WS_R1))
#define RKV ((bf16*)(ws + WS_RKV))
#define WAG ((bf16*)(ws + WS_WAG))
#define AG ((bf16*)(ws + WS_AG))
#define UB ((bf16*)(ws + WS_U))
#define LP ((bf16*)(ws + WS_LP))
#define LACT ((bf16*)(ws + WS_LACT))
#define Y1 ((bf16*)(ws + WS_Y1))
#define MIX ((bf16*)(ws + WS_R1))
#define EBUF ((float*)(ws + WS_LP))
#define S0G ((bf16*)(ws + WS_LP))
#define QCT ((bf16*)(ws + WS_U))
#define HCT ((float*)(ws + WS_R1))
#define W1G ((bf16*)(ws + WS_W1))
#define ULG ((bf16*)(ws + WS_ULOC))
#define DLG ((float*)(ws + WS_DL))
#define ATG ((float*)(ws + WS_AT))
#define WCAT ((bf16*)(ws + WS_WCAT))
#define WL2 ((bf16*)(ws + WS_WL2))
#define WGLU ((bf16*)(ws + WS_WGLU))
#define WPP ((bf16*)(ws + WS_WPP))
#define WOUT ((bf16*)(ws + WS_WOUT))
#define WPG ((unsigned char*)(ws + WS_WPG))
#define S5BT ((bf16*)(ws + WS_S5BT))
#define S5ET ((bf16*)(ws + WS_S5ET))
#define PBF ((bf16*)(ws + WS_PBF))
#define H2 ((unsigned char*)(ws + WS_H2))
#define WGU ((unsigned char*)(ws + WS_WGU))
#define WDN ((unsigned char*)(ws + WS_WDN))
#define ACT ((unsigned char*)(ws + WS_ACT))
#define YB ((unsigned char*)(ws + WS_Y))
#define XB ((bf16*)(ws + WS_XB))
#define PP ((bf16*)(ws + WS_ACT))
#define HIST ((unsigned*)(ws + WS_HIST))
#define TOPE ((int*)(ws + WS_TOPE))
#define TOPG ((float*)(ws + WS_TOPG))
#define TOKSLOT ((int*)(ws + WS_TOKSLOT))
#define SLOTTOK ((int*)(ws + WS_SLOTTOK))
#ifndef FUSE_FNORM
#define FUSE_FNORM 1
#endif
#ifndef SPLIT_P5
#define SPLIT_P5 1
#endif
#ifndef MOE_SP2
#define MOE_SP2 true
#endif
#ifndef MOE_ALIGN
#define MOE_ALIGN true
#endif
#ifndef PROBE_PH
#define PROBE_PH -1
#endif
#ifndef PROBE_N
#define PROBE_N 2
#endif
#define REPS(k) ((((k) >= 10 && (k) < 28) ? 10 + ((k) - 10) % 3 : (k)) == PROBE_PH ? PROBE_N : 1)
#ifndef ONLY_PHASE
#define ONLY_PHASE -1
#endif
constexpr int NPH = 31;
struct Args { const float* in[42]; float* out; unsigned char* ws; int ph_lo, ph_hi; };

__global__ void __launch_bounds__(NTHR, 2) mk_fwd(Args args) {
    extern __shared__ __attribute__((aligned(16))) unsigned char lds_raw[];
    LAS unsigned char* lds = (LAS unsigned char*)lds_raw;
#define CAS __attribute__((address_space(4)))
#define FRESH_CX const CAS char* ka_ = (const CAS char*)__builtin_amdgcn_kernarg_segment_ptr(); asm volatile("" : "+s"(ka_)); const float* const CAS* I = (const float* const CAS*)ka_; unsigned char* ws = *(unsigned char* const CAS*)(ka_ + 344); float* OUTP = *(float* const CAS*)(ka_ + 336); (void)I; (void)ws; (void)OUTP; \
    Ctx cx; { int t_ = threadIdx.x; asm volatile("" : "+v"(t_)); cx.lds = lds; cx.tid = t_; cx.lane = t_ & 63; cx.wave = __builtin_amdgcn_readfirstlane(t_ >> 6); cx.G = gridDim.x; cx.wg = blockIdx.x; cx.gw = cx.wg * NWAVES + cx.wave; cx.NGW = cx.G * NWAVES; }
    unsigned char* ws = args.ws;
    const int lo = args.ph_lo, hi = args.ph_hi;
    volatile LAS unsigned* MISC = (volatile LAS unsigned*)(lds + LDS_MISC);
    if (threadIdx.x < 64) MISC[threadIdx.x] = 0u;
    __syncthreads();
    XcdBarrier bar; bar.bar = (unsigned*)(ws + WS_CTL) + CW_BAR; bar.x = 0; bar.st = nullptr;
    if (hi - lo > 1) bar = xcd_barrier_post((unsigned*)(ws + WS_CTL) + CW_BAR, MISC + 8);

#define IN(k) ((ONLY_PHASE < 0 || ONLY_PHASE == (k) || (ONLY_PHASE >= 10 && ONLY_PHASE < 28 && (k) >= 10 && (k) < 28 && ((k) - 10) % 3 == (ONLY_PHASE - 10) % 3)) && lo <= (k) && (k) < hi)
#ifndef PROBE_BAR
#define PROBE_BAR 1
#endif
#ifndef PROBE_T
#define PROBE_T -1
#endif
#define STAMP() do { if (PROBE_T >= 0 && blockIdx.x == 0 && threadIdx.x == 0) { const unsigned long long t_ = __builtin_amdgcn_s_memrealtime(); MISC[16 + 2 * nst] = (unsigned)t_; MISC[17 + 2 * nst] = (unsigned)(t_ >> 32); } ++nst; } while (0)
#define SEAM(k) do { if (IN(k) && IN((k) + 1)) { for (int b_ = 0; b_ < PROBE_BAR; ++b_) xcd_barrier(bar); STAMP(); } } while (0)
    int nst = 0; STAMP();
#define MAKE_RP RwkvP RP; RP.rkv = RKV; RP.wag = WAG; RP.mu_rkv = I[13]; RP.w0 = I[15]; RP.a0 = I[18]; RP.k_k = I[23]; RP.k_a = I[24]; RP.r_k = I[25]; RP.ln_w = I[26]; RP.ln_b = I[27]
#define OPQ(v) ({ int _k = (v); asm volatile("" : "+s"(_k)); _k; })

    if (IN(0)) for (int rep_ = 0; rep_ < REPS(0); ++rep_) {
        FRESH_CX;
        for (int it = cx.wg; it < 256; it += cx.G) s5_tables_item(cx, it >> 3, it & 7, I[4], I[5], I[6], I[7], I[8], I[9], I[10], S5BT, S5ET, ATG);
        const float* mu = I[14];
        transpose_matrix(cx, I[3], 1024, 2048, WCAT, 0, 1024, 0, nullptr, 0);
        transpose_matrix(cx, I[16], 1024, 64, WCAT, 2048, 1024, 0, mu, 1);          transpose_matrix(cx, I[16], 1024, 64, WCAT, 2304, 1024, 0, mu, 0);
        transpose_matrix(cx, I[19], 1024, 64, WCAT, 2112, 1024, 0, mu + 1024, 1);   transpose_matrix(cx, I[19], 1024, 64, WCAT, 2368, 1024, 0, mu + 1024, 0);
        transpose_matrix(cx, I[21], 1024, 128, WCAT, 2176, 1024, 0, mu + 2048, 1);  transpose_matrix(cx, I[21], 1024, 128, WCAT, 2432, 1024, 0, mu + 2048, 0);
        transpose_matrix(cx, I[17], 64, 512, WL2, 0, 256, 0, nullptr, 0);
        transpose_matrix(cx, I[20], 64, 512, WL2, 512, 256, 64, nullptr, 0);
        transpose_matrix(cx, I[22], 128, 512, WL2, 1024, 256, 128, nullptr, 0);
        for (int idx = cx.wg * NTHR + cx.tid; idx < 1536 * 32; idx += cx.G * NTHR) { const int row = idx >> 5, ch = idx & 31, blk = row >> 9; const int kb = blk == 0 ? 0 : (blk == 1 ? 64 : 128), ke = blk == 0 ? 64 : (blk == 1 ? 128 : 256);
            if (ch * 8 < kb || ch * 8 >= ke) *(u32x4*)(WL2 + (size_t)row * 256 + ch * 8) = (u32x4){0u, 0u, 0u, 0u}; }
        transpose_matrix(cx, I[12], 512, 512, WGLU, 0, 512, 0, nullptr, 0);
        transpose_matrix(cx, I[39], 256, 1024, WPP, 0, 256, 0, nullptr, 0);
        transpose_matrix(cx, I[28], 1024, 1024, WOUT, 0, 1024, 0, nullptr, 0);
        { LAS float* scr = (LAS float*)(cx.lds + cx.wave * 16640);
          for (int it = cx.gw; it < 256; it += cx.NGW) { const int kb = it >> 4, nb = it & 15;
              transpose_item_fp8(I[40], 1024, 64 * kb, 64 * nb, WPG + (size_t)(64 * nb) * 1024 + 64 * kb, 1024, 32.0f, scr, cx.lane); } }
        for (int m = 2 * cx.gw; m < M; m += 2 * cx.NGW) rms_rows2_to_bf16(I[0] + (size_t)m * 1024, I[0] + (size_t)(m + 1) * 1024, I[2], HBUF + (size_t)m * 1024, HBUF + (size_t)(m + 1) * 1024, cx.lane);
        for (int m = 4 * cx.gw; m < M; m += 4 * cx.NGW) { f32x4 v[4];
#pragma unroll
            for (int r = 0; r < 4; ++r) v[r] = __builtin_nontemporal_load((const f32x4*)(I[1] + (size_t)(m + r) * 256) + cx.lane);
#pragma unroll
            for (int r = 0; r < 4; ++r) { u32x2 w; w.x = pk2(v[r].x, v[r].y); w.y = pk2(v[r].z, v[r].w); *((u32x2*)(PBF + (size_t)(m + r) * 256) + cx.lane) = w; } }
    }
    SEAM(0);
    if (IN(1)) for (int rep_ = 0; rep_ < REPS(1); ++rep_) {
        FRESH_CX;
        SchedPlain S; S.init(128, 10, cx.G, cx.wg); S.A = (const char*)HBUF; S.B = (const char*)WCAT; S.a_tile = 256 * 1024 * 2; S.b_tile = 256 * 1024 * 2;
        EpiProj E{AG, RKV, LP};
        pg8::gemm_phase<EpiProj, SchedPlain, true, true, false>(lds, cx.tid, OPQ(1024), OPQ(1024), OPQ(1024), S, E);
    }
    SEAM(1);
    if (IN(2)) for (int rep_ = 0; rep_ < REPS(2); ++rep_) {
        FRESH_CX;
        for (int m = 2 * cx.gw; m < M; m += 2 * cx.NGW) {
            const int lane = cx.lane; const bool first = (m & (SEQ - 1)) == 0;
            const u32x2 a0 = *((const u32x2*)(LP + (size_t)m * 512) + lane), a1 = *((const u32x2*)(LP + (size_t)(m + 1) * 512) + lane), b1 = *((const u32x2*)(LP + (size_t)m * 512 + 256) + lane);
            u32x2 b0 = (u32x2){0u, 0u}; if (!first) b0 = *((const u32x2*)(LP + (size_t)(m - 1) * 512 + 256) + lane);
            float v[8] = {lo16(a0.x) + lo16(b0.x), hi16(a0.x) + hi16(b0.x), lo16(a0.y) + lo16(b0.y), hi16(a0.y) + hi16(b0.y), lo16(a1.x) + lo16(b1.x), hi16(a1.x) + hi16(b1.x), lo16(a1.y) + lo16(b1.y), hi16(a1.y) + hi16(b1.y)};
#pragma unroll
            for (int i = 0; i < 8; ++i) v[i] = lane < 16 ? ftanh(v[i]) : (lane < 32 ? v[i] : fsigmoid(v[i]));
            u32x2 o; o.x = pk2(v[0], v[1]); o.y = pk2(v[2], v[3]); *((u32x2*)(LACT + (size_t)m * 256) + lane) = o;
            o.x = pk2(v[4], v[5]); o.y = pk2(v[6], v[7]); *((u32x2*)(LACT + (size_t)(m + 1) * 256) + lane) = o;
        }
    }
    SEAM(2);
    if (IN(3)) for (int rep_ = 0; rep_ < REPS(3); ++rep_) {
        FRESH_CX;
        { SchedPlain S; S.init(128, 6, cx.G, cx.wg); S.A = (const char*)LACT; S.B = (const char*)WL2; S.a_tile = 256 * 256 * 2; S.b_tile = 256 * 256 * 2;
          EpiBf16Plain E{WAG, 1536};
          pg8::gemm_phase<EpiBf16Plain, SchedPlain, true, true, false>(lds, cx.tid, OPQ(256), OPQ(256), OPQ(256), S, E); }
        { SchedS5 S; S.init(128, 1, cx.G, cx.wg); S.A = (const char*)AG; S.B = (const char*)S5ET; S.a_tile = 256 * 640 * 2; S.b_tile = 0; S.b_group = 256 * 512 * 2;
          EpiF32 E{EBUF, 256};
          pg8::gemm_phase<EpiF32, SchedS5, true, true, false>(lds, cx.tid, OPQ(512), OPQ(640), OPQ(512), S, E); }
    }
    SEAM(3);
    if (IN(4)) for (int rep_ = 0; rep_ < REPS(4); ++rep_) {
        FRESH_CX;
        for (int base = cx.wg * 32; base < 8192; base += cx.G * 32) { const int idx = base + (cx.lane & 31), b = idx >> 11, g = (idx >> 6) & 31, p = idx & 63, w8 = cx.wave;
            LAS float* CE = (LAS float*)lds;
            const float ar = ATG[(g * 64 + p) * 2], ai = ATG[(g * 64 + p) * 2 + 1];
            const size_t row0 = (size_t)g * 1024 + b * 256 + 32 * w8;
            float er[32], ei[32];
            if (cx.lane < 32) {
#pragma unroll
                for (int k = 0; k < 32; ++k) { er[k] = EBUF[(row0 + k) * 256 + p]; ei[k] = EBUF[(row0 + k) * 256 + 64 + p]; }
                float sr = 0.f, si = 0.f;
#pragma unroll
                for (int k = 0; k < 32; ++k) { const float nr = ar * sr - ai * si + er[k], ni = ar * si + ai * sr + ei[k]; sr = nr; si = ni; }
                CE[(w8 * 32 + cx.lane) * 2] = sr; CE[(w8 * 32 + cx.lane) * 2 + 1] = si; }
            __syncthreads();
            if (cx.lane < 32) {
                float pr = 1.f, pi = 0.f;
                { float qr = ar, qi = ai;
#pragma unroll
                  for (int i = 0; i < 5; ++i) { const float tr_ = qr * qr - qi * qi, ti_ = 2.f * qr * qi; qr = tr_; qi = ti_; } pr = qr; pi = qi; }
                float cr = 0.f, ci = 0.f;
                for (int w2 = 0; w2 < w8; ++w2) { const float e0 = CE[(w2 * 32 + cx.lane) * 2], e1 = CE[(w2 * 32 + cx.lane) * 2 + 1]; const float nr = pr * cr - pi * ci + e0, ni = pr * ci + pi * cr + e1; cr = nr; ci = ni; }
                float sr = cr, si = ci;
#pragma unroll
                for (int k = 0; k < 32; ++k) { bf16* d = AG + (row0 + k) * 640 + 512 + p; d[0] = (bf16)(pk2(sr, 0.f) & 0xffffu); d[64] = (bf16)(pk2(si, 0.f) & 0xffffu);
                    const float nr = ar * sr - ai * si + er[k], ni = ar * si + ai * sr + ei[k]; sr = nr; si = ni; } }
            __syncthreads();
        }
        MAKE_RP;
        for (int grp = cx.wg; grp < 256; grp += cx.G) rwkv_pass1(lds, RP, grp * 16, 16, cx.tid, QCT, HCT, W1G, ULG, DLG);
    }
    SEAM(4);
    if (IN(5)) for (int rep_ = 0; rep_ < REPS(5); ++rep_) {
        FRESH_CX;
        if (SPLIT_P5 && cx.G == 256) {
            if (cx.wg < 128) { if (cx.wave == 0) rwkv_pass2(lds, cx.wg >> 2, cx.wg & 3, cx.lane, QCT, HCT, DLG, S0G); }
            else { SchedS5 S; S.init(128, 2, 128, cx.wg - 128); S.A = (const char*)AG; S.B = (const char*)S5BT; S.a_tile = 256 * 640 * 2; S.b_tile = 256 * 640 * 2; S.b_group = 512 * 640 * 2;
                EpiS5Y E{AG, I[11], Y1};
                pg8::gemm_phase<EpiS5Y, SchedS5, true, true, false>(lds, cx.tid, OPQ(640), OPQ(640), OPQ(640), S, E); }
        } else {
            { SchedS5 S; S.init(128, 2, cx.G, cx.wg); S.A = (const char*)AG; S.B = (const char*)S5BT; S.a_tile = 256 * 640 * 2; S.b_tile = 256 * 640 * 2; S.b_group = 512 * 640 * 2;
              EpiS5Y E{AG, I[11], Y1};
              pg8::gemm_phase<EpiS5Y, SchedS5, true, true, false>(lds, cx.tid, OPQ(640), OPQ(640), OPQ(640), S, E); }
            if (cx.wave == 0) for (int it = cx.wg; it < 128; it += cx.G) rwkv_pass2(lds, it >> 2, it & 3, cx.lane, QCT, HCT, DLG, S0G);
        }
    }
    SEAM(5);
    if (IN(6)) for (int rep_ = 0; rep_ < REPS(6); ++rep_) {
        FRESH_CX;
        MAKE_RP;
        for (int grp = cx.wg; grp < 256; grp += cx.G) rwkv_pass3(lds, RP, grp * 16, 16, cx.tid, S0G, W1G, ULG, MIX);
        __syncthreads();
        { SchedPlain S; S.init(128, 2, cx.G, cx.wg); S.A = (const char*)Y1; S.B = (const char*)WGLU; S.a_tile = 256 * 512 * 2; S.b_tile = 256 * 512 * 2;
          EpiGlu E{Y1, MIX};
          pg8::gemm_phase<EpiGlu, SchedPlain, true, true, false>(lds, cx.tid, OPQ(512), OPQ(512), OPQ(512), S, E); }
    }
    SEAM(6);
    if (IN(7)) for (int rep_ = 0; rep_ < REPS(7); ++rep_) {
        FRESH_CX;
        SchedPlain S; S.init(128, 4, cx.G, cx.wg); S.A = (const char*)MIX; S.B = (const char*)WOUT; S.a_tile = 256 * 1024 * 2; S.b_tile = 256 * 1024 * 2;
        EpiResid E{I[0], XB};
        pg8::gemm_phase<EpiResid, SchedPlain, true, true, false>(lds, cx.tid, OPQ(1024), OPQ(1024), OPQ(1024), S, E);
    }
    SEAM(7);
    if (IN(8)) for (int rep_ = 0; rep_ < REPS(8); ++rep_) { FRESH_CX; router_phase(cx, XB, I[29], I[30], I[31], H2, TOPE, TOPG, HIST); }
    SEAM(8);
    LAS int* PL = (LAS int*)(lds + LDS_PLAN);
    if (hi > 9 && lo < 28) { FRESH_CX; __syncthreads(); moe_plan(cx, HIST); }
    const int npass = (hi > 9 && lo < 28) ? PL[PL_NPASS] : 0;
    if (IN(9)) for (int rep_ = 0; rep_ < REPS(9); ++rep_) { FRESH_CX; dispatch_phase(cx, HIST, TOPE, SLOTTOK, TOKSLOT); convert_pass(cx, PL[PL_PE0], PL[PL_PE0 + 1], I[32], I[34], I[36], WGU, WDN); }
    SEAM(9);
    for (int p = 0; p < 6; ++p) {
        const bool actv = p < npass;
        const int e0 = actv ? PL[PL_PE0 + p] : 0, e1 = actv ? PL[PL_PE0 + p + 1] : 0, row0 = actv ? PL[PL_PROW0 + p] : 0, rows = actv ? PL[PL_PROW0 + p + 1] - row0 : 0;
        if (IN(10 + 3 * p) && actv) for (int rep_ = 0; rep_ < REPS(10); ++rep_) {
            FRESH_CX;
            SchedMoe<true> S; S.init(rows / 256, 8, cx.G, cx.wg); S.A = (const char*)H2; S.B = (const char*)WGU; S.a_tile = 0; S.b_tile = 256 * 1024; S.b_exp = (size_t)2048 * 1024; S.tile_e = PL + PL_TILEE; S.tile0 = row0 / 256; S.e0 = e0; S.slot_tok = SLOTTOK; S.row0 = row0;
            EpiGU E{ACT, I[33], I[35]};
            pg8::gemm_phase<EpiGU, SchedMoe<true>, MOE_ALIGN, MOE_SP2, true, true>(lds, cx.tid, OPQ(512), OPQ(512), OPQ(512), S, E);
        }
        if (actv) SEAM(10 + 3 * p);
        if (IN(11 + 3 * p) && actv) for (int rep_ = 0; rep_ < REPS(11); ++rep_) {
            FRESH_CX;
            SchedMoe<false> S; S.init(rows / 256, 4, cx.G, cx.wg); S.A = (const char*)ACT; S.B = (const char*)WDN; S.a_tile = 256 * 1024; S.b_tile = 256 * 1024; S.b_exp = (size_t)1024 * 1024; S.tile_e = PL + PL_TILEE; S.tile0 = row0 / 256; S.e0 = e0; S.slot_tok = SLOTTOK; S.row0 = row0;
            EpiDown E{YB, I[37]};
            pg8::gemm_phase<EpiDown, SchedMoe<false>, MOE_ALIGN, MOE_SP2, false, true>(lds, cx.tid, OPQ(512), OPQ(512), OPQ(512), S, E);
        }
        if (actv) SEAM(11 + 3 * p);
        if (IN(12 + 3 * p) && actv) for (int rep_ = 0; rep_ < REPS(12); ++rep_) {
            FRESH_CX;
            if (p + 1 < npass) { combine_pass<false>(cx, e0, e1, row0, TOPE, TOPG, TOKSLOT, YB, XB, nullptr, nullptr); convert_pass(cx, PL[PL_PE0 + p + 1], PL[PL_PE0 + p + 2], I[32], I[34], I[36], WGU, WDN); }
            else {
                if (e0 == 0 && e1 == 32 && row0 == 0) combine_all(cx, TOPG, TOKSLOT, YB, XB, I[38], (unsigned char*)(ws + WS_R1));
                else combine_pass<true>(cx, e0, e1, row0, TOPE, TOPG, TOKSLOT, YB, XB, I[38], (unsigned char*)(ws + WS_R1));
                SchedPlain S; S.init(128, 4, cx.G, cx.wg); S.A = (const char*)PBF; S.B = (const char*)WPP; S.a_tile = 256 * 256 * 2; S.b_tile = 256 * 256 * 2;
                EpiBf16Plain E{PP, 1024};
                pg8::gemm_phase<EpiBf16Plain, SchedPlain, true, true, false>(lds, cx.tid, OPQ(256), OPQ(256), OPQ(256), S, E);
            }
        }
        if (actv) SEAM(12 + 3 * p);
    }
    if (IN(29)) for (int rep_ = 0; rep_ < REPS(29); ++rep_) {
        FRESH_CX;
        SchedPlain S; S.init(128, 4, cx.G, cx.wg); S.A = (const char*)(ws + WS_R1); S.B = (const char*)WPG; S.a_tile = 256 * 1024; S.b_tile = 256 * 1024;
        if (FUSE_FNORM && cx.G == 256) { EpiPleNorm E{PP, XB, OUTP, I[41], (float*)(ws + WS_CTL) + CW_ROWSS, (unsigned*)(ws + WS_CTL) + CW_PCNT};
            pg8::gemm_phase<EpiPleNorm, SchedPlain, true, true, false, true>(lds, cx.tid, OPQ(512), OPQ(512), OPQ(512), S, E); }
        else { EpiPle E{PP, XB};
            pg8::gemm_phase<EpiPle, SchedPlain, true, true, false, true>(lds, cx.tid, OPQ(512), OPQ(512), OPQ(512), S, E); }
    }
    SEAM(29);
    if (IN(30) && !(FUSE_FNORM && gridDim.x == 256)) for (int rep_ = 0; rep_ < REPS(30); ++rep_) {
        FRESH_CX;
        for (int m = 2 * cx.gw; m < M; m += 2 * cx.NGW) {
            const u32x2* ia_ = (const u32x2*)(XB + (size_t)m * 1024) + cx.lane; const u32x2* ib_ = ia_ + 256;
            f32x4* xa = (f32x4*)(OUTP + (size_t)m * 1024) + cx.lane; f32x4* xb = xa + 256; const f32x4* gr = (const f32x4*)I[41] + cx.lane; f32x4 va[4], vb[4]; float sa = 0.f, sb = 0.f;
#pragma unroll
            for (int j = 0; j < 4; ++j) { const u32x2 wa = ia_[64 * j], wb = ib_[64 * j]; va[j] = (f32x4){lo16(wa.x), hi16(wa.x), lo16(wa.y), hi16(wa.y)}; vb[j] = (f32x4){lo16(wb.x), hi16(wb.x), lo16(wb.y), hi16(wb.y)}; }
#pragma unroll
            for (int j = 0; j < 4; ++j) { sa += (va[j].x * va[j].x + va[j].y * va[j].y) + (va[j].z * va[j].z + va[j].w * va[j].w); sb += (vb[j].x * vb[j].x + vb[j].y * vb[j].y) + (vb[j].z * vb[j].z + vb[j].w * vb[j].w); }
#pragma unroll
            for (int o = 1; o < 64; o <<= 1) { sa += __shfl_xor(sa, o); sb += __shfl_xor(sb, o); }
            const float ia = rsqrtf(sa * (1.f / 1024.f) + 1e-6f), ib = rsqrtf(sb * (1.f / 1024.f) + 1e-6f);
#pragma unroll
            for (int j = 0; j < 4; ++j) { const f32x4 gg = gr[64 * j]; xa[64 * j] = (f32x4){va[j].x * ia * gg.x, va[j].y * ia * gg.y, va[j].z * ia * gg.z, va[j].w * ia * gg.w}; xb[64 * j] = (f32x4){vb[j].x * ib * gg.x, vb[j].y * ib * gg.y, vb[j].z * ib * gg.z, vb[j].w * ib * gg.w}; }
        }
    }
    if (PROBE_T >= 0 && blockIdx.x == 0 && threadIdx.x == 0) { STAMP(); asm volatile("s_waitcnt vmcnt(0)" ::: "memory");
        const unsigned long long t0_ = ((unsigned long long)MISC[17 + 2 * PROBE_T] << 32) | MISC[16 + 2 * PROBE_T], t1_ = ((unsigned long long)MISC[19 + 2 * PROBE_T] << 32) | MISC[18 + 2 * PROBE_T];
        (*(float* const CAS*)((const CAS char*)__builtin_amdgcn_kernarg_segment_ptr() + 336))[0] = (float)(t1_ - t0_) * 0.01f; }
#undef IN
#undef SEAM
}

extern "C" void kernel_launch(void* const* d_in, const int* in_sizes, int n_in, void* d_out, int out_size, void* d_ws, size_t ws_size, hipStream_t stream) {
    static int grid = 0;
    if (grid == 0) {
        if (n_in != 42 || out_size != M * DM || ws_size < WS_END) { fprintf(stderr, "kernel_launch: unexpected shapes (n_in %d out %d ws %zu)\n", n_in, out_size, ws_size); grid = -1; return; }
        int dev = 0, cus = 0, per_cu = 0;
        if (hipGetDevice(&dev) != hipSuccess || hipDeviceGetAttribute(&cus, hipDeviceAttributeMultiprocessorCount, dev) != hipSuccess) { grid = -1; return; }
        if (hipFuncSetAttribute((const void*)mk_fwd, hipFuncAttributeMaxDynamicSharedMemorySize, LDS_BYTES) != hipSuccess) { fprintf(stderr, "kernel_launch: hipFuncSetAttribute failed\n"); grid = -1; return; }
        if (hipOccupancyMaxActiveBlocksPerMultiprocessor(&per_cu, (const void*)mk_fwd, NTHR, LDS_BYTES) != hipSuccess || per_cu < 1) fprintf(stderr, "kernel_launch: occupancy query says %d\n", per_cu);
        (void)hipGetLastError();
        grid = cus > 256 ? 256 : cus;
    }
    if (grid < 0) return;
    (void)hipMemsetAsync((char*)d_ws + WS_CTL, 0, CTL_ZERO_BYTES, stream);
    Args a{};
    for (int i = 0; i < 42; ++i) a.in[i] = (const float*)d_in[i];
    a.out = (float*)d_out; a.ws = (unsigned char*)d_ws;
#if MK_PER_PHASE
    for (int ph = 0; ph < NPH; ++ph) { a.ph_lo = ph; a.ph_hi = ph + 1; hipLaunchKernelGGL(mk_fwd, dim3(grid), dim3(NTHR), LDS_BYTES, stream, a); }
#else
    a.ph_lo = 0; a.ph_hi = NPH;
    hipLaunchKernelGGL(mk_fwd, dim3(grid), dim3(NTHR), LDS_BYTES, stream, a);
#endif
}
```

```cpp
#include <hip/hip_runtime.h>
#include <cstdio>
#include <cstdint>

#ifndef MK_PER_PHASE
#define MK_PER_PHASE 0
#endif

#define LAS __attribute__((address_space(3)))
#define GAS __attribute__((address_space(1)))
typedef unsigned short bf16;
typedef short bf16x8 __attribute__((ext_vector_type(8)));
typedef float f32x4 __attribute__((ext_vector_type(4)));
typedef float f32x2 __attribute__((ext_vector_type(2)));
typedef unsigned u32x4 __attribute__((ext_vector_type(4)));
typedef unsigned u32x2 __attribute__((ext_vector_type(2)));
typedef GAS unsigned gu32;

constexpr int NB = 4, SEQ = 8192, DM = 1024, M = NB * SEQ;
constexpr int NEXP = 32, TOPK = 4;
constexpr int NWAVES = 8, NTHR = 512;
constexpr size_t MiB = 1u << 20;

constexpr size_t WS_CTL = 0, CTL_ZERO_BYTES = 1 * MiB;
constexpr size_t WS_HIST = 1 * MiB;
constexpr size_t WS_TOPE = 2 * MiB;
constexpr size_t WS_TOPG = 3 * MiB;
constexpr size_t WS_TOKSLOT = 4 * MiB;
constexpr size_t WS_SLOTTOK = 5 * MiB;
constexpr size_t WS_AT = 6 * MiB;
constexpr size_t WS_DL = 6 * MiB + 65536;
constexpr size_t WS_WCAT = 8 * MiB;
constexpr size_t WS_WL2 = 13 * MiB;
constexpr size_t WS_WGLU = 14 * MiB;
constexpr size_t WS_WPP = 14 * MiB + 524288;
constexpr size_t WS_WOUT = 15 * MiB;
constexpr size_t WS_WPG = 17 * MiB;
constexpr size_t WS_S5BT = 19 * MiB;
constexpr size_t WS_S5ET = 39 * MiB;
constexpr size_t WS_PBF = 48 * MiB;
constexpr size_t WS_R1 = 64 * MiB;
constexpr size_t WS_RKV = 128 * MiB;
constexpr size_t WS_WAG = 224 * MiB;
constexpr size_t WS_AG = 320 * MiB;
constexpr size_t WS_U = 360 * MiB;
constexpr size_t WS_LP = 392 * MiB;
constexpr size_t WS_LACT = 424 * MiB;
constexpr size_t WS_W1 = 440 * MiB;
constexpr size_t WS_ULOC = 472 * MiB;
constexpr size_t WS_Y1 = 504 * MiB;
constexpr size_t WS_H2 = 64 * MiB;
constexpr size_t WS_WDN = 96 * MiB;
constexpr size_t WS_ACT = 128 * MiB;
constexpr size_t WS_Y = 264 * MiB;
constexpr size_t WS_XB = 400 * MiB;
constexpr size_t WS_WGU = 264 * MiB;
constexpr int RMAX = 139264;
constexpr int MAXEPP = 32;
constexpr size_t WS_END = 560 * MiB;
static_assert(WS_Y + (size_t)RMAX * 1024 <= WS_XB && WS_XB + (size_t)M * 2048 <= WS_END && WS_ACT + (size_t)RMAX * 1024 <= WS_Y, "moe map");

constexpr int CW_BAR = 4096;
constexpr int CW_ROWSS = 65536;
constexpr int CW_PCNT = 131072;

constexpr int LDS_PLAN = 147456;
constexpr int LDS_MISC = 155648;
constexpr int LDS_BYTES = 156672;
constexpr int PL_CNT = 0, PL_PSTART = 32, PL_NPASS = 72, PL_PE0 = 80, PL_PROW0 = 88, PL_TILEE = 128, PL_TMP = 768;

#define LDS_WAIT() asm volatile("s_waitcnt lgkmcnt(0)" ::: "memory")
#define VM_WAIT() asm volatile("s_waitcnt vmcnt(0)" ::: "memory")
__device__ __forceinline__ float bf2f(unsigned b) { return __uint_as_float(b << 16); }
typedef __bf16 bf16n2 __attribute__((ext_vector_type(2)));
__device__ __forceinline__ unsigned cvt_pk_bf16(float lo, float hi) { const f32x2 f = {lo, hi}; const bf16n2 v = __builtin_convertvector(f, bf16n2); return __builtin_bit_cast(unsigned, v); }
__device__ __forceinline__ unsigned pk2(float lo, float hi) { return cvt_pk_bf16(lo, hi); }
__device__ __forceinline__ float lo16(unsigned w) { return __uint_as_float(w << 16); }
__device__ __forceinline__ float hi16(unsigned w) { return __uint_as_float(w & 0xffff0000u); }
__device__ __forceinline__ unsigned pk4_fp8(float a, float b, float c, float d) { unsigned w = 0u; w = (unsigned)__builtin_amdgcn_cvt_pk_fp8_f32(a, b, (int)w, false); w = (unsigned)__builtin_amdgcn_cvt_pk_fp8_f32(c, d, (int)w, true); return w; }
__device__ __forceinline__ f32x4 up4_fp8(unsigned w) { const f32x2 lo = __builtin_amdgcn_cvt_pk_f32_fp8((int)w, false), hi = __builtin_amdgcn_cvt_pk_f32_fp8((int)w, true); return (f32x4){lo.x, lo.y, hi.x, hi.y}; }
__device__ __forceinline__ float frcp(float x) { return __builtin_amdgcn_rcpf(x); }
__device__ __forceinline__ float fsigmoid(float x) { return frcp(1.0f + __expf(-x)); }
__device__ __forceinline__ float ftanh(float x) { const float e = __expf(-2.0f * fabsf(x)); const float t = (1.0f - e) * frcp(1.0f + e); return x < 0.f ? -t : t; }
__device__ __forceinline__ float gelu_tanh(float x) { const float u = 0.7978845608f * (x + 0.044715f * x * x * x); return 0.5f * x * (1.0f + ftanh(u)); }
__device__ __forceinline__ float wave_sum(float v) {
#pragma unroll
    for (int o = 1; o < 64; o <<= 1) v += __shfl_xor(v, o);
    return v;
}
__device__ __forceinline__ float wave_max(float v) {
#pragma unroll
    for (int o = 1; o < 64; o <<= 1) v = fmaxf(v, __shfl_xor(v, o));
    return v;
}

#define XB_TMO      128
#define XB_XCNT(j)  (256  + 64 * (j))
#define XB_XSUB(j)  (1280 + 64 * (j))
#define XB_XGEN(j)  (2304 + 64 * (j))
#define XB_TOP      3328
#define XB_TOPGEN   3392
#define XCD_BAR_WORDS 3456
#define XB_SPIN_CAP (1u << 22)

__device__ __forceinline__ unsigned xb_ld(unsigned* p)              { return __hip_atomic_load(p, __ATOMIC_RELAXED, __HIP_MEMORY_SCOPE_AGENT); }
__device__ __forceinline__ unsigned xb_add(unsigned* p, unsigned v) { return __hip_atomic_fetch_add(p, v, __ATOMIC_RELAXED, __HIP_MEMORY_SCOPE_AGENT); }
__device__ __forceinline__ unsigned xb_xcc_id() { return (unsigned)__builtin_amdgcn_s_getreg((3 << 11) | 20) & 0xFu; }
#define XB_SPIN(cond, bar) do { unsigned _sp = 0; while (cond) { __builtin_amdgcn_s_sleep(1); \
    if ((++_sp & 255u) == 0u) { if (xb_ld(&(bar)[XB_TMO])) break; if (_sp > XB_SPIN_CAP) { atomicAdd(&(bar)[XB_TMO], 1u); break; } } } } while (0)

struct XcdBarrier { unsigned* bar; unsigned x; volatile LAS unsigned* st; };

__device__ __forceinline__ XcdBarrier xcd_barrier_post(unsigned* bar, volatile LAS unsigned* st) {
    XcdBarrier b; b.bar = bar; b.x = xb_xcc_id(); b.st = st;
    if (threadIdx.x == 0) (void)xb_add(&bar[XB_XCNT(b.x)], 1u);
    return b;
}
__device__ __forceinline__ void xcd_barrier_complete(unsigned* bar, unsigned x, unsigned& nloc, unsigned& nx) {
    const unsigned G = gridDim.x * gridDim.y * gridDim.z;
    unsigned sum, cnt, mine, sp = 0u;
    for (;;) {
        sum = 0u; cnt = 0u; mine = 0u;
#pragma unroll
        for (unsigned j = 0; j < 16; ++j) { const unsigned c = xb_ld(&bar[XB_XCNT(j)]); sum += c; cnt += (c > 0u) ? 1u : 0u; mine = (j == x) ? c : mine; }
        if (sum == G) break;
        __builtin_amdgcn_s_sleep(1);
        if ((++sp & 255u) == 0u) { if (xb_ld(&bar[XB_TMO])) break; if (sp > XB_SPIN_CAP) { atomicAdd(&bar[XB_TMO], 1u); break; } }
    }
    nloc = mine > 0u ? mine : 1u; nx = cnt > 0u ? cnt : 1u;
}
__device__ __forceinline__ void xcd_barrier(const XcdBarrier& b) {
    asm volatile("s_waitcnt vmcnt(0)" ::: "memory");
    __syncthreads();
    if (threadIdx.x == 0) {
        unsigned* bar = b.bar;
        __builtin_amdgcn_s_waitcnt(0);
        unsigned nloc = b.st[0], nx = b.st[1];
        if (nloc == 0u) { xcd_barrier_complete(bar, b.x, nloc, nx); b.st[0] = nloc; b.st[1] = nx; }
        const unsigned old = xb_add(&bar[XB_XSUB(b.x)], 1u);
        const unsigned gen = old / nloc;
        if (old + 1u == (gen + 1u) * nloc) {
            __builtin_amdgcn_fence(__ATOMIC_RELEASE, "agent");
            asm volatile("s_waitcnt vmcnt(0)" ::: "memory");
            const unsigned og = xb_add(&bar[XB_TOP], 1u);
            const unsigned tg = og / nx;
            if (og + 1u == (tg + 1u) * nx) xb_add(&bar[XB_TOPGEN], 1u);
            else XB_SPIN(xb_ld(&bar[XB_TOPGEN]) == tg, bar);
            __builtin_amdgcn_fence(__ATOMIC_ACQUIRE, "agent");
            xb_add(&bar[XB_XGEN(b.x)], 1u);
            asm volatile("s_waitcnt vmcnt(0)" ::: "memory");
        } else {
            XB_SPIN(xb_ld(&bar[XB_XGEN(b.x)]) == gen, bar);
            __builtin_amdgcn_fence(__ATOMIC_ACQUIRE, "agent");
            asm volatile("s_waitcnt vmcnt(0)" ::: "memory");
        }
    }
    __syncthreads();
}

namespace pg8 {
constexpr int BM = 256, BK = 64, HALF = 128, HTB = HALF * BK * 2, STAGE_BYTES = 8 * HTB, NXCD = 8, WGM = 8;
__host__ __device__ __forceinline__ int lds_byte(int r, int c) { const int st = (r >> 4) * 2 + (c >> 5), rr = r & 15, cc = c & 31, ob = rr * 64 + cc * 2; return st * 1024 + (ob ^ (((ob >> 9) & 1) << 5)); }
__host__ __device__ __forceinline__ void stage_rc(int b, int& R, int& C) { const int st = b / 1024, sb = b % 1024, swz = sb ^ (((sb >> 9) & 1) << 5); R = (st >> 1) * 16 + swz / 64; C = (st & 1) * 32 + (swz % 64) / 2; }
__host__ __device__ __forceinline__ int perm32(int rho) { const int n = rho >> 4, i = rho & 15; return 8 * (i >> 2) + 4 * n + (i & 3); }

struct Unit { int pm, pn, aux; };

struct Order {
    int nM, nN, nwg, G, c;
    __device__ __forceinline__ void init(int nM_, int nN_, int G_, int c_) { nM = nM_; nN = nN_; nwg = nM * nN; G = G_; c = c_; }
    __device__ __forceinline__ bool tile(int i, int& pm, int& pn) const {
        const long L = (long)i * G + c; if (L >= nwg) return false;
        int wgid = (int)L; { const int q = nwg / NXCD, r = nwg % NXCD, xcd = wgid % NXCD, off = wgid / NXCD; wgid = (xcd < r ? xcd * (q + 1) : r * (q + 1) + (xcd - r) * q) + off; }
        const int nig = WGM * nN, gid = wgid / nig, fm = gid * WGM, gsz = (nM - fm) < WGM ? (nM - fm) : WGM;
        pm = fm + ((wgid % nig) % gsz); pn = (wgid % nig) / gsz; return true;
    }
};


template <class Epi, class Sched, bool ALIGN_EPI, bool SP2, bool GATHER, bool FP8 = false>
__device__ __forceinline__ void gemm_phase(LAS unsigned char* lds, const int tid, const int K, const int lda, const int ldb, const Sched& S, const Epi& E) {
    const int wid = __builtin_amdgcn_readfirstlane(tid >> 6), lane = tid & 63, wr = wid >> 2, wc = wid & 3, fr = lane & 15, fq = lane >> 4;
    const int nt = K / BK;
    unsigned voffA[2], voffB[2]; int rA[2], cA2[2];
#pragma unroll
    for (int i = 0; i < 2; ++i) { int R, C; stage_rc(tid * 16 + i * 8192, R, C); const int Rb = Epi::PERM ? ((R & ~31) + perm32(R & 31)) : R;
        voffA[i] = (unsigned)(R * lda + C) * 2u; voffB[i] = (unsigned)(Rb * ldb + C) * 2u; rA[i] = R; cA2[i] = C * 2; }
    const size_t kstep = (size_t)(BK * 2);
    const size_t hstepA = (size_t)HALF * lda * 2, hstepB = (size_t)HALF * ldb * 2;
    const unsigned ldsw = (unsigned)wid * 1024u;
    const int aoff = FP8 ? lds_byte(wr * 64 + fr, fq * 16) : lds_byte(wr * 64 + fr, fq * 8), boff = FP8 ? lds_byte(wc * 32 + fr, fq * 16) : lds_byte(wc * 32 + fr, fq * 8);
    unsigned cv0[2] = {0u, 0u}, cv1[2] = {0u, 0u};
#define PG8_SA(b, h) (((b) * 2 + (h)) * HTB)
#define PG8_SB(b, h) ((4 + (b) * 2 + (h)) * HTB)
#define PG8_STAGE(bufoff, gbase, voff) do { _Pragma("unroll") for (int _i = 0; _i < 2; ++_i) \
        __builtin_amdgcn_global_load_lds((const unsigned*)((const char*)(gbase) + (voff)[_i]), (LAS unsigned*)(lds + (bufoff) + ldsw + _i * 8192), 16, 0, 0); } while (0)
#define PG8_NROW(h, i) ((has_next ? *(const LAS unsigned*)(pf_rows + (i) * 512 + (h) * 256 + lane * 4) * (unsigned)(lda * 2) + (unsigned)cA2[i] : ((h) ? cv1[i] : cv0[i])))
#define PG8_STAGE_A(bufoff, ptr, h, nx) do { if constexpr (GATHER) { unsigned _v[2]; if (nx) { asm volatile("" ::: "memory"); _v[0] = PG8_NROW(h, 0); _v[1] = PG8_NROW(h, 1); } else { _v[0] = (h) ? cv1[0] : cv0[0]; _v[1] = (h) ? cv1[1] : cv0[1]; } PG8_STAGE(bufoff, ptr, _v); } \
        else { PG8_STAGE(bufoff, (ptr) + (h) * hstepA, voffA); } } while (0)
#define PG8_LDA(dst, b, h) do { if constexpr (FP8) { _Pragma("unroll") for (int m = 0; m < 4; ++m) { dst##8[m].lo = *(const LAS v4i_*)(lds + PG8_SA(b, h) + aoff + m * 2048); dst##8[m].hi = *(const LAS v4i_*)(lds + PG8_SA(b, h) + aoff + m * 2048 + 16); } } \
        else { _Pragma("unroll") for (int m = 0; m < 4; ++m) _Pragma("unroll") for (int k = 0; k < 2; ++k) dst[m][k] = *(const LAS bf16x8*)(lds + PG8_SA(b, h) + aoff + m * 2048 + k * 1024); } } while (0)
#define PG8_LDB(dst, b, h) do { if constexpr (FP8) { _Pragma("unroll") for (int n = 0; n < 2; ++n) { dst##8[n].lo = *(const LAS v4i_*)(lds + PG8_SB(b, h) + boff + n * 2048); dst##8[n].hi = *(const LAS v4i_*)(lds + PG8_SB(b, h) + boff + n * 2048 + 16); } } \
        else { _Pragma("unroll") for (int n = 0; n < 2; ++n) _Pragma("unroll") for (int k = 0; k < 2; ++k) dst[n][k] = *(const LAS bf16x8*)(lds + PG8_SB(b, h) + boff + n * 2048 + k * 1024); } } while (0)
#define PG8_MMA(ai, bj, At, Bt) do { __builtin_amdgcn_s_setprio(1); _Pragma("unroll") for (int m = 0; m < 4; ++m) _Pragma("unroll") for (int n = 0; n < 2; ++n) { \
        if constexpr (FP8) asm volatile("v_mfma_scale_f32_16x16x128_f8f6f4 %0, %1, %2, %0, %3, %4 op_sel_hi:[0,0,0]" : "+v"(acc[ai][bj][m][n]) : "v"(Bt##8[n]), "v"(At##8[m]), "v"(sclW), "v"(sclA));   \
        else { _Pragma("unroll") for (int k = 0; k < 2; ++k) acc[ai][bj][m][n] = __builtin_amdgcn_mfma_f32_16x16x32_bf16(Bt[n][k], At[m][k], acc[ai][bj][m][n], 0, 0, 0); } } \
        __builtin_amdgcn_s_setprio(0); } while (0)
#define PG8_WAIT_V(n) asm volatile("s_waitcnt vmcnt(" #n ")" ::: "memory")
#define PG8_WAIT_L(n) asm volatile("s_waitcnt lgkmcnt(" #n ")" ::: "memory")
#define PG8_BAR __builtin_amdgcn_s_barrier()
#define PG8_SCHED __builtin_amdgcn_sched_barrier(0)
#define PG8_ROWS(u, d0, d1) do { _Pragma("unroll") for (int _i = 0; _i < 2; ++_i) { const int _r0 = S.a_row(u, rA[_i]), _r1 = S.a_row(u, HALF + rA[_i]); \
        d0[_i] = (unsigned)_r0 * (unsigned)(lda * 2) + (unsigned)cA2[_i]; d1[_i] = (unsigned)_r1 * (unsigned)(lda * 2) + (unsigned)cA2[_i]; } } while (0)
    constexpr int PF_OFF = STAGE_BYTES;
    LAS unsigned char* pf_bias = lds + PF_OFF + wid * 256; LAS unsigned char* pf_rows = lds + PF_OFF + 2048 + wid * 1024;
    Unit cur, nxt; int ui = 0; bool has_next = false;
    if (!S.next(0, cur)) return;
    f32x4 acc[2][2][4][2];
#pragma unroll
    for (int a = 0; a < 2; ++a)
#pragma unroll
        for (int b = 0; b < 2; ++b)
#pragma unroll
            for (int m = 0; m < 4; ++m)
#pragma unroll
                for (int n = 0; n < 2; ++n) acc[a][b][m][n] = (f32x4){0.f, 0.f, 0.f, 0.f};
    typedef int v8i_ __attribute__((ext_vector_type(8))); typedef int v4i_ __attribute__((ext_vector_type(4)));
    bf16x8 At[4][2], B0[2][2], B1[2][2]; v8i_ At8[4], B08[2], B18[2];
    const int sclW = 0x7a7a7a7a, sclA = 0x7f7f7f7f;
    const char* cA = S.a_ptr(cur); const char* cB = S.b_ptr(cur);
    if constexpr (GATHER) { PG8_ROWS(cur, cv0, cv1); }
    if constexpr (SP2) {
        PG8_STAGE(PG8_SB(0, 0), cB, voffB); PG8_STAGE(PG8_SB(0, 1), cB + hstepB, voffB); PG8_STAGE_A(PG8_SA(0, 0), cA, 0, false); PG8_STAGE_A(PG8_SA(0, 1), cA, 1, false);
        if (wr == 1) PG8_BAR;
        PG8_WAIT_V(2); PG8_BAR;
        PG8_STAGE(PG8_SB(1, 0), cB + kstep, voffB); PG8_STAGE_A(PG8_SA(1, 0), cA + kstep, 0, false); PG8_STAGE(PG8_SB(1, 1), cB + hstepB + kstep, voffB);
        PG8_WAIT_V(6); PG8_BAR;
    } else {
        PG8_STAGE(PG8_SB(0, 0), cB, voffB); PG8_STAGE_A(PG8_SA(0, 0), cA, 0, false); PG8_STAGE(PG8_SB(0, 1), cB + hstepB, voffB); PG8_STAGE_A(PG8_SA(0, 1), cA, 1, false);
        if (wr == 1) PG8_BAR;
        PG8_WAIT_V(4); PG8_BAR;
        PG8_STAGE(PG8_SB(1, 0), cB + kstep, voffB); PG8_STAGE_A(PG8_SA(1, 0), cA + kstep, 0, false); PG8_STAGE(PG8_SB(1, 1), cB + hstepB + kstep, voffB);
        PG8_WAIT_V(6); PG8_BAR;
    }
    for (;;) {
        has_next = S.next(ui + 1, nxt);
        const char* nA = has_next ? S.a_ptr(nxt) : cA; const char* nB = has_next ? S.b_ptr(nxt) : cB;
        if constexpr (Epi::PREF) E.pref(pf_bias, cur, wc, lane);
        if constexpr (GATHER) { if (has_next) {
#pragma unroll
                for (int _i = 0; _i < 2; ++_i) { __builtin_amdgcn_global_load_lds((const unsigned*)S.a_row_ptr(nxt, rA[_i]), (LAS unsigned*)(pf_rows + _i * 512), 4, 0, 0);
                                                 __builtin_amdgcn_global_load_lds((const unsigned*)S.a_row_ptr(nxt, HALF + rA[_i]), (LAS unsigned*)(pf_rows + _i * 512 + 256), 4, 0, 0); } }
            }
        for (int t = 0; t < nt; t += 2) {
            const bool last = (t == nt - 2);
            const char* a1 = cA + (size_t)(t + 1) * kstep;
            const char* a2 = last ? nA : cA + (size_t)(t + 2) * kstep; const char* b2 = last ? nB : cB + (size_t)(t + 2) * kstep;
            const char* a3 = a2 + kstep; const char* b3 = b2 + kstep;
            if constexpr (SP2) {
            PG8_LDB(B0, 0, 0); PG8_LDB(B1, 0, 1); PG8_SCHED; PG8_LDA(At, 0, 0); PG8_STAGE_A(PG8_SA(1, 1), a1, 1, false);
            PG8_WAIT_V(8); PG8_WAIT_L(0); PG8_BAR; PG8_MMA(0, 0, At, B0); PG8_MMA(0, 1, At, B1); PG8_BAR; PG8_SCHED;
            PG8_LDA(At, 0, 1); PG8_STAGE(PG8_SB(0, 0), b2, voffB); PG8_STAGE(PG8_SB(0, 1), b2 + hstepB, voffB); PG8_STAGE_A(PG8_SA(0, 0), a2, 0, last);
            PG8_WAIT_V(8); PG8_WAIT_L(0); PG8_BAR; PG8_MMA(1, 0, At, B0); PG8_MMA(1, 1, At, B1); PG8_BAR; PG8_SCHED;
            PG8_LDB(B0, 1, 0); PG8_LDB(B1, 1, 1); PG8_SCHED; PG8_LDA(At, 1, 0); PG8_STAGE_A(PG8_SA(0, 1), a2, 1, last);
            PG8_WAIT_V(8); PG8_WAIT_L(0); PG8_BAR; PG8_MMA(0, 0, At, B0); PG8_MMA(0, 1, At, B1); PG8_BAR; PG8_SCHED;
            PG8_LDA(At, 1, 1); PG8_STAGE(PG8_SB(1, 0), b3, voffB); PG8_STAGE(PG8_SB(1, 1), b3 + hstepB, voffB); PG8_STAGE_A(PG8_SA(1, 0), a3, 0, last);
            PG8_WAIT_V(8); PG8_WAIT_L(0); PG8_BAR; PG8_MMA(1, 0, At, B0); PG8_MMA(1, 1, At, B1); PG8_BAR; PG8_SCHED;
            } else {
            PG8_LDB(B0, 0, 0); PG8_SCHED; PG8_LDA(At, 0, 0); PG8_STAGE_A(PG8_SA(1, 1), a1, 1, false);
            PG8_WAIT_L(8); PG8_BAR; PG8_WAIT_L(0); PG8_MMA(0, 0, At, B0); PG8_BAR; PG8_SCHED;
            PG8_LDB(B1, 0, 1); PG8_STAGE(PG8_SB(0, 0), b2, voffB);
            PG8_BAR; PG8_WAIT_L(0); PG8_MMA(0, 1, At, B1); PG8_BAR;
            PG8_LDA(At, 0, 1); PG8_STAGE_A(PG8_SA(0, 0), a2, 0, last);
            PG8_BAR; PG8_WAIT_L(0); PG8_MMA(1, 0, At, B0); PG8_BAR; PG8_SCHED;
            PG8_STAGE(PG8_SB(0, 1), b2 + hstepB, voffB);
            PG8_WAIT_V(6); PG8_BAR; PG8_MMA(1, 1, At, B1); PG8_BAR;
            PG8_LDB(B0, 1, 0); PG8_SCHED; PG8_LDA(At, 1, 0); PG8_STAGE_A(PG8_SA(0, 1), a2, 1, last);
            PG8_WAIT_L(8); PG8_BAR; PG8_WAIT_L(0); PG8_MMA(0, 0, At, B0); PG8_BAR; PG8_SCHED;
            PG8_LDB(B1, 1, 1); PG8_STAGE(PG8_SB(1, 0), b3, voffB);
            PG8_BAR; PG8_WAIT_L(0); PG8_MMA(0, 1, At, B1); PG8_BAR;
            PG8_LDA(At, 1, 1); PG8_STAGE_A(PG8_SA(1, 0), a3, 0, last);
            PG8_BAR; PG8_WAIT_L(0); PG8_MMA(1, 0, At, B0); PG8_BAR; PG8_SCHED;
            PG8_STAGE(PG8_SB(1, 1), b3 + hstepB, voffB);
            PG8_WAIT_V(6); PG8_BAR; PG8_MMA(1, 1, At, B1); PG8_BAR;
            }
        }
        if constexpr (ALIGN_EPI) { if (wr == 0) PG8_BAR; }
        if constexpr (FP8) asm volatile("s_nop 15\n\ts_nop 15" ::: "memory");
        E(acc, cur, wr, wc, fr, fq, pf_bias);
        if (!has_next) break;
#pragma unroll
        for (int a = 0; a < 2; ++a)
#pragma unroll
            for (int b = 0; b < 2; ++b)
#pragma unroll
                for (int m = 0; m < 4; ++m)
#pragma unroll
                    for (int n = 0; n < 2; ++n) acc[a][b][m][n] = (f32x4){0.f, 0.f, 0.f, 0.f};
        cur = nxt; cA = nA; cB = nB; ++ui;
        if constexpr (GATHER) { asm volatile("" ::: "memory"); cv0[0] = PG8_NROW(0, 0); cv0[1] = PG8_NROW(0, 1); cv1[0] = PG8_NROW(1, 0); cv1[1] = PG8_NROW(1, 1); }
        if constexpr (ALIGN_EPI) { if (wr == 1) PG8_BAR; }
    }
    PG8_WAIT_V(0);
    if constexpr (!ALIGN_EPI) { if (wr == 0) PG8_BAR; }
    PG8_BAR;
#undef PG8_SA
#undef PG8_SB
#undef PG8_STAGE
#undef PG8_STAGE_A
#undef PG8_NROW
#undef PG8_LDA
#undef PG8_LDB
#undef PG8_MMA
#undef PG8_WAIT_V
#undef PG8_WAIT_L
#undef PG8_BAR
#undef PG8_SCHED
#undef PG8_ROWS
}
}

using pg8::Unit;
struct SchedPlain : pg8::Order {
    const char* A; const char* B; size_t a_tile, b_tile;
    __device__ __forceinline__ bool next(int i, Unit& u) const { u.aux = 0; return tile(i, u.pm, u.pn); }
    __device__ __forceinline__ const char* a_ptr(const Unit& u) const { return A + (size_t)u.pm * a_tile; }
    __device__ __forceinline__ const char* b_ptr(const Unit& u) const { return B + (size_t)u.pn * b_tile; }
    __device__ __forceinline__ int a_row(const Unit&, int) const { return 0; }
    __device__ __forceinline__ const int* a_row_ptr(const Unit&, int) const { return nullptr; }
};
struct SchedS5 : pg8::Order {
    const char* A; const char* B; size_t a_tile, b_tile, b_group;
    __device__ __forceinline__ bool next(int i, Unit& u) const { u.aux = 0; return tile(i, u.pm, u.pn); }
    __device__ __forceinline__ const char* a_ptr(const Unit& u) const { return A + (size_t)u.pm * a_tile; }
    __device__ __forceinline__ const char* b_ptr(const Unit& u) const { return B + (size_t)(u.pm >> 2) * b_group + (size_t)u.pn * b_tile; }
    __device__ __forceinline__ int a_row(const Unit&, int) const { return 0; }
    __device__ __forceinline__ const int* a_row_ptr(const Unit&, int) const { return nullptr; }
};
template <bool GATHER> struct SchedMoe : pg8::Order {
    const char* A; const char* B; size_t a_tile, b_tile, b_exp; const LAS int* tile_e; int tile0, e0; const int* slot_tok; int row0;
    __device__ __forceinline__ bool next(int i, Unit& u) const { const bool ok = tile(i, u.pm, u.pn); u.aux = ok ? tile_e[tile0 + u.pm] : 0; return ok; }
    __device__ __forceinline__ const char* a_ptr(const Unit& u) const { return GATHER ? A : A + (size_t)u.pm * a_tile; }
    __device__ __forceinline__ const char* b_ptr(const Unit& u) const { return B + (size_t)(u.aux - e0) * b_exp + (size_t)u.pn * b_tile; }
    __device__ __forceinline__ int a_row(const Unit& u, int r) const { return slot_tok[row0 + u.pm * 256 + r]; }
    __device__ __forceinline__ const int* a_row_ptr(const Unit& u, int r) const { return slot_tok + row0 + u.pm * 256 + r; }
};

__device__ __forceinline__ void st8(bf16* p, const f32x4 v0, const f32x4 v1) {
    u32x4 w; w.x = cvt_pk_bf16(v0[0], v0[1]); w.y = cvt_pk_bf16(v0[2], v0[3]); w.z = cvt_pk_bf16(v1[0], v1[1]); w.w = cvt_pk_bf16(v1[2], v1[3]); *(u32x4*)p = w;
}
__device__ __forceinline__ void ld8(const bf16* p, f32x4& v0, f32x4& v1) {
    const u32x4 w = *(const u32x4*)p; v0 = (f32x4){lo16(w.x), hi16(w.x), lo16(w.y), hi16(w.y)}; v1 = (f32x4){lo16(w.z), hi16(w.z), lo16(w.w), hi16(w.w)};
}
#define EPI_LOOP_AM _Pragma("unroll") for (int ai = 0; ai < 2; ++ai) _Pragma("unroll") for (int m = 0; m < 4; ++m)
#define EPI_ARGS f32x4 (&acc)[2][2][4][2], const Unit& u, int wr, int wc, int fr, int fq, const LAS unsigned char* pf

struct EpiProj { static constexpr bool PERM = true, PREF = false; bf16 *AG, *RKV, *LP;
    __device__ __forceinline__ void operator()(EPI_ARGS) const {
        const int row0 = u.pm * 256 + wr * 64 + fr;
        if (u.pn < 2) { const int col0 = u.pn * 256 + wc * 32 + 8 * fq;
            EPI_LOOP_AM { const int row = row0 + ai * 128 + m * 16;
#pragma unroll
                for (int bj = 0; bj < 2; ++bj) { const int c = col0 + bj * 128; st8(AG + ((size_t)((c >> 4) * 1024 + (row >> 5))) * 640 + (row & 31) * 16 + (c & 15), acc[ai][bj][m][0], acc[ai][bj][m][1]); } }
        } else {
            bf16* base; int ldc, c0;
            if (u.pn < 8) { base = RKV; ldc = 1536; c0 = (u.pn - 2) * 256; } else { base = LP; ldc = 512; c0 = (u.pn - 8) * 256; }
            const int col0 = c0 + wc * 32 + 8 * fq;
            EPI_LOOP_AM { bf16* rowp = base + (size_t)(row0 + ai * 128 + m * 16) * ldc + col0;
#pragma unroll
                for (int bj = 0; bj < 2; ++bj) st8(rowp + bj * 128, acc[ai][bj][m][0], acc[ai][bj][m][1]); }
        }
    }
};
struct EpiBf16Plain { static constexpr bool PERM = true, PREF = false; bf16* O; int ldc;
    __device__ __forceinline__ void operator()(EPI_ARGS) const {
        const int row0 = u.pm * 256 + wr * 64 + fr, col0 = u.pn * 256 + wc * 32 + 8 * fq;
        EPI_LOOP_AM { bf16* rowp = O + (size_t)(row0 + ai * 128 + m * 16) * ldc + col0;
#pragma unroll
            for (int bj = 0; bj < 2; ++bj) st8(rowp + bj * 128, acc[ai][bj][m][0], acc[ai][bj][m][1]); }
    }
};
struct EpiF32 { static constexpr bool PERM = false, PREF = false; float* C; int ldc;
    __device__ __forceinline__ void operator()(EPI_ARGS) const {
        const int row0 = u.pm * 256 + wr * 64 + fr, col0 = u.pn * 256 + wc * 32 + 4 * fq;
        EPI_LOOP_AM { float* rowp = C + (size_t)(row0 + ai * 128 + m * 16) * ldc + col0;
#pragma unroll
            for (int bj = 0; bj < 2; ++bj)
#pragma unroll
                for (int n = 0; n < 2; ++n) *(f32x4*)(rowp + bj * 128 + n * 16) = acc[ai][bj][m][n]; }
    }
};
struct EpiS5Y { static constexpr bool PERM = true, PREF = false; const bf16* AG; const float* dskip; bf16* Y1;
    __device__ __forceinline__ void operator()(EPI_ARGS) const {
        const int g = u.pm >> 2, crow0 = (u.pm & 3) * 256 + wr * 64 + fr, col0 = u.pn * 256 + wc * 32 + 8 * fq;
        EPI_LOOP_AM { const int crow = crow0 + ai * 128 + m * 16;
#pragma unroll
            for (int bj = 0; bj < 2; ++bj) { const int col = col0 + bj * 128, t = col >> 4, c = col & 15;
                f32x4 u0, u1; ld8(AG + ((size_t)(g * 1024 + crow)) * 640 + col, u0, u1);
                const f32x4 d0 = *(const f32x4*)(dskip + g * 16 + c), d1 = *(const f32x4*)(dskip + g * 16 + c + 4);
                f32x4 v0 = acc[ai][bj][m][0] + d0 * u0, v1 = acc[ai][bj][m][1] + d1 * u1;
#pragma unroll
                for (int j = 0; j < 4; ++j) { v0[j] = gelu_tanh(v0[j]); v1[j] = gelu_tanh(v1[j]); }
                st8(Y1 + (size_t)(crow * 32 + t) * 512 + g * 16 + c, v0, v1); } }
    }
};
struct EpiGlu { static constexpr bool PERM = true, PREF = false; const bf16* Y1; bf16* MIX;
    __device__ __forceinline__ void operator()(EPI_ARGS) const {
        const int row0 = u.pm * 256 + wr * 64 + fr, col0 = u.pn * 256 + wc * 32 + 8 * fq;
        EPI_LOOP_AM { const int row = row0 + ai * 128 + m * 16;
#pragma unroll
            for (int bj = 0; bj < 2; ++bj) { const int col = col0 + bj * 128; f32x4 y0, y1v; ld8(Y1 + (size_t)row * 512 + col, y0, y1v);
                f32x4 v0, v1;
#pragma unroll
                for (int j = 0; j < 4; ++j) { v0[j] = y0[j] * fsigmoid(acc[ai][bj][m][0][j]); v1[j] = y1v[j] * fsigmoid(acc[ai][bj][m][1][j]); }
                st8(MIX + (size_t)row * 1024 + col, v0, v1); } }
    }
};
struct EpiResid { static constexpr bool PERM = true, PREF = false; const float* X; bf16* O;
    __device__ __forceinline__ void operator()(EPI_ARGS) const {
        const int row0 = u.pm * 256 + wr * 64 + fr, col0 = u.pn * 256 + wc * 32 + 8 * fq;
        EPI_LOOP_AM { const size_t off = (size_t)(row0 + ai * 128 + m * 16) * 1024 + col0;
#pragma unroll
            for (int bj = 0; bj < 2; ++bj) { const f32x4 x0 = __builtin_nontemporal_load((const f32x4*)(X + off + bj * 128)), x1 = __builtin_nontemporal_load((const f32x4*)(X + off + bj * 128 + 4)); st8(O + off + bj * 128, x0 + acc[ai][bj][m][0], x1 + acc[ai][bj][m][1]); } }
    }
};
struct EpiGU { static constexpr bool PERM = true, PREF = true; unsigned char* ACT; const float* bg; const float* bu;
    __device__ __forceinline__ void pref(LAS unsigned char* pf, const Unit& u, int wc, int lane) const {
        const float* src = ((lane & 32) ? bu : bg) + u.aux * 1024 + u.pn * 128 + wc * 32 + (lane & 31);
        __builtin_amdgcn_global_load_lds((const unsigned*)src, (LAS unsigned*)pf, 4, 0, 0); }
    __device__ __forceinline__ void operator()(EPI_ARGS) const {
        const int row0 = u.pm * 256 + wr * 64 + fr, col = u.pn * 128 + wc * 32 + 8 * fq;
        const f32x4 g0 = *(const LAS f32x4*)(pf + 32 * fq), g1 = *(const LAS f32x4*)(pf + 32 * fq + 16), u0 = *(const LAS f32x4*)(pf + 128 + 32 * fq), u1 = *(const LAS f32x4*)(pf + 128 + 32 * fq + 16);
        EPI_LOOP_AM { f32x4 v0, v1;
#pragma unroll
            for (int j = 0; j < 4; ++j) {
                const float gt0 = fminf(acc[ai][0][m][0][j] + g0[j], 7.0f), up0 = fminf(fmaxf(acc[ai][1][m][0][j] + u0[j], -7.0f), 7.0f);
                const float gt1 = fminf(acc[ai][0][m][1][j] + g1[j], 7.0f), up1 = fminf(fmaxf(acc[ai][1][m][1][j] + u1[j], -7.0f), 7.0f);
                v0[j] = (up0 + 1.0f) * gt0 * fsigmoid(1.702f * gt0); v1[j] = (up1 + 1.0f) * gt1 * fsigmoid(1.702f * gt1); }
            u32x2 w; w.x = pk4_fp8(v0[0], v0[1], v0[2], v0[3]); w.y = pk4_fp8(v1[0], v1[1], v1[2], v1[3]); *(u32x2*)(ACT + (size_t)(row0 + ai * 128 + m * 16) * 1024 + col) = w; }
    }
};
struct EpiDown { static constexpr bool PERM = true, PREF = true; unsigned char* Y; const float* bd;
    __device__ __forceinline__ void pref(LAS unsigned char* pf, const Unit& u, int wc, int lane) const {
        const float* src = bd + u.aux * 1024 + u.pn * 256 + (lane >> 5) * 128 + wc * 32 + (lane & 31);
        __builtin_amdgcn_global_load_lds((const unsigned*)src, (LAS unsigned*)pf, 4, 0, 0); }
    __device__ __forceinline__ void operator()(EPI_ARGS) const {
        const int row0 = u.pm * 256 + wr * 64 + fr, col0 = u.pn * 256 + wc * 32 + 8 * fq;
        EPI_LOOP_AM { unsigned char* rowp = Y + (size_t)(row0 + ai * 128 + m * 16) * 1024 + col0;
#pragma unroll
            for (int bj = 0; bj < 2; ++bj) { const f32x4 b0 = *(const LAS f32x4*)(pf + 128 * bj + 32 * fq), b1 = *(const LAS f32x4*)(pf + 128 * bj + 32 * fq + 16);
                const f32x4 v0 = acc[ai][bj][m][0] + b0, v1 = acc[ai][bj][m][1] + b1; u32x2 w; w.x = pk4_fp8(v0[0], v0[1], v0[2], v0[3]); w.y = pk4_fp8(v1[0], v1[1], v1[2], v1[3]); *(u32x2*)(rowp + bj * 128) = w; } }
    }
};
struct EpiPle { static constexpr bool PERM = true, PREF = false; const bf16* PP; bf16* O;
    __device__ __forceinline__ void operator()(EPI_ARGS) const {
        const int row0 = u.pm * 256 + wr * 64 + fr, col0 = u.pn * 256 + wc * 32 + 8 * fq;
        EPI_LOOP_AM { const size_t off = (size_t)(row0 + ai * 128 + m * 16) * 1024 + col0;
#pragma unroll
            for (int bj = 0; bj < 2; ++bj) { f32x4 p0, p1, x0, x1; ld8(PP + off + bj * 128, p0, p1); ld8(O + off + bj * 128, x0, x1);
#pragma unroll
                for (int j = 0; j < 4; ++j) { x0[j] += p0[j] * fsigmoid(acc[ai][bj][m][0][j]); x1[j] += p1[j] * fsigmoid(acc[ai][bj][m][1][j]); }
                st8(O + off + bj * 128, x0, x1); } }
    }
};

struct EpiPleNorm { static constexpr bool PERM = true, PREF = false; const bf16* PP; const bf16* XIN; float* OUT; const float* gfin; float* rowss; unsigned* pcnt;
    __device__ __forceinline__ void operator()(EPI_ARGS) const {
        const int row0 = u.pm * 256 + wr * 64 + fr, col0 = u.pn * 256 + wc * 32 + 8 * fq;
        EPI_LOOP_AM { const size_t off = (size_t)(row0 + ai * 128 + m * 16) * 1024 + col0; float s = 0.f;
#pragma unroll
            for (int bj = 0; bj < 2; ++bj) { f32x4 p0, p1, x0, x1; ld8(PP + off + bj * 128, p0, p1); ld8(XIN + off + bj * 128, x0, x1);
#pragma unroll
                for (int j = 0; j < 4; ++j) { x0[j] += p0[j] * fsigmoid(acc[ai][bj][m][0][j]); x1[j] += p1[j] * fsigmoid(acc[ai][bj][m][1][j]); s += x0[j] * x0[j] + x1[j] * x1[j]; }
                acc[ai][bj][m][0] = x0; acc[ai][bj][m][1] = x1; }
            s += __shfl_xor(s, 16); s += __shfl_xor(s, 32);
            if (fq == 0) atomicAdd(rowss + row0 + ai * 128 + m * 16, s); }
        asm volatile("s_waitcnt vmcnt(0)" ::: "memory");
        unsigned* cnt = pcnt + 64 * u.pm;
        if ((fr | fq) == 0) __hip_atomic_fetch_add(cnt, 1u, __ATOMIC_RELAXED, __HIP_MEMORY_SCOPE_AGENT);
        { unsigned sp = 0; while (__builtin_amdgcn_readfirstlane(__hip_atomic_load(cnt, __ATOMIC_RELAXED, __HIP_MEMORY_SCOPE_AGENT)) < 32u) { __builtin_amdgcn_s_sleep(2); if (++sp > (1u << 22)) break; } }
        f32x4 gv[2][2];
#pragma unroll
        for (int bj = 0; bj < 2; ++bj) { gv[bj][0] = *(const f32x4*)(gfin + col0 + bj * 128); gv[bj][1] = *(const f32x4*)(gfin + col0 + bj * 128 + 4); }
        EPI_LOOP_AM { const int row = row0 + ai * 128 + m * 16; const float ssr = __hip_atomic_load(rowss + row, __ATOMIC_RELAXED, __HIP_MEMORY_SCOPE_AGENT); const float rinv = rsqrtf(ssr * (1.f / 1024.f) + 1e-6f);
            float* orow = OUT + (size_t)row * 1024 + col0;
#pragma unroll
            for (int bj = 0; bj < 2; ++bj) { __builtin_nontemporal_store(acc[ai][bj][m][0] * rinv * gv[bj][0], (f32x4*)(orow + bj * 128)); __builtin_nontemporal_store(acc[ai][bj][m][1] * rinv * gv[bj][1], (f32x4*)(orow + bj * 128 + 4)); } }
    }
};

struct Ctx { LAS unsigned char* lds; int tid, lane, wave, G, wg, gw, NGW; };

template <int NBW>
__device__ __forceinline__ void transpose_item(const float* W, int N, int k0, int n0, bf16* dst, int ldk, const float* scl, int flip, LAS float* scr, int lane) {
    constexpr int LPR = NBW / 4, RPI = 64 / LPR, NI = 64 / RPI;
    const int rr = lane / LPR, cc = (lane % LPR) * 4;
    f32x4 v[NI];
#pragma unroll
    for (int i = 0; i < NI; ++i) v[i] = *(const f32x4*)(W + (size_t)(k0 + i * RPI + rr) * N + n0 + cc);
#pragma unroll
    for (int i = 0; i < NI; ++i) { const int kk = i * RPI + rr; f32x4 x = v[i];
        if (scl) { const float s0 = scl[k0 + kk]; const float f = flip ? (1.0f - s0) : s0; x = x * f; }
        LAS float* d = scr + kk * 65 + cc; d[0] = x.x; d[1] = x.y; d[2] = x.z; d[3] = x.w; }
    LDS_WAIT(); asm volatile("" ::: "memory");
    const int c = lane & 7;
#pragma unroll
    for (int j = 0; j < NBW / 8; ++j) { const int n = (lane >> 3) + 8 * j; const LAS float* s = scr + (8 * c) * 65 + n;
        u32x4 o; o.x = pk2(s[0 * 65], s[1 * 65]); o.y = pk2(s[2 * 65], s[3 * 65]); o.z = pk2(s[4 * 65], s[5 * 65]); o.w = pk2(s[6 * 65], s[7 * 65]);
        *(u32x4*)(dst + (size_t)n * ldk + 8 * c) = o; }
    LDS_WAIT(); asm volatile("" ::: "memory");
}
struct F8Item { f32x4 v[16]; };
__device__ __forceinline__ void f8_issue(const float* W, int N, int k0, int n0, int lane, F8Item& it) {
    const int rr = lane >> 4, cc = (lane & 15) * 4;
#pragma unroll
    for (int i = 0; i < 16; ++i) it.v[i] = __builtin_nontemporal_load((const f32x4*)(W + (size_t)(k0 + i * 4 + rr) * N + n0 + cc));
}
__device__ __forceinline__ void f8_finish(const F8Item& it, unsigned char* dst, int ldk, float scale, LAS float* scr, int lane) {
    const int rr = lane >> 4, cc = (lane & 15) * 4;
#pragma unroll
    for (int i = 0; i < 16; ++i) { const int kk = i * 4 + rr; LAS float* d = scr + kk * 65 + cc; d[0] = it.v[i].x * scale; d[1] = it.v[i].y * scale; d[2] = it.v[i].z * scale; d[3] = it.v[i].w * scale; }
    LDS_WAIT(); asm volatile("" ::: "memory");
    const int c = lane & 3;
#pragma unroll
    for (int j = 0; j < 4; ++j) { const int n = (lane >> 2) + 16 * j; const LAS float* s = scr + (16 * c) * 65 + n;
        u32x4 o; o.x = pk4_fp8(s[0 * 65], s[1 * 65], s[2 * 65], s[3 * 65]); o.y = pk4_fp8(s[4 * 65], s[5 * 65], s[6 * 65], s[7 * 65]); o.z = pk4_fp8(s[8 * 65], s[9 * 65], s[10 * 65], s[11 * 65]); o.w = pk4_fp8(s[12 * 65], s[13 * 65], s[14 * 65], s[15 * 65]);
        *(u32x4*)(dst + (size_t)n * ldk + 16 * c) = o; }
    LDS_WAIT(); asm volatile("" ::: "memory");
}
__device__ __forceinline__ void transpose_item_fp8(const float* W, int N, int k0, int n0, unsigned char* dst, int ldk, float scale, LAS float* scr, int lane) {
    F8Item it; f8_issue(W, N, k0, n0, lane, it); f8_finish(it, dst, ldk, scale, scr, lane);
}
__device__ __forceinline__ void transpose_matrix(const Ctx& cx, const float* W, int K, int N, bf16* WT, int row_off, int ldk, int koff, const float* scl, int flip) {
    LAS float* scr = (LAS float*)(cx.lds + cx.wave * 16640);
    const int nblk = N / 64, nitems = (K / 64) * nblk;
    for (int it = cx.gw; it < nitems; it += cx.NGW) { const int kb = it / nblk, nb = it % nblk;
        transpose_item<64>(W, N, 64 * kb, 64 * nb, WT + (size_t)(row_off + 64 * nb) * ldk + koff + 64 * kb, ldk, scl, flip, scr, cx.lane); }
}
__device__ __forceinline__ void rms_row_to_bf16(const float* xrow, const float* g, bf16* orow, int lane) {
    const f32x4* xr = (const f32x4*)xrow + lane; const f32x4* gr = (const f32x4*)g + lane;
    f32x4 v[4]; float s = 0.f;
#pragma unroll
    for (int j = 0; j < 4; ++j) { v[j] = xr[64 * j]; s += (v[j].x * v[j].x + v[j].y * v[j].y) + (v[j].z * v[j].z + v[j].w * v[j].w); }
    const float rinv = rsqrtf(wave_sum(s) * (1.f / 1024.f) + 1e-6f);
    u32x2* o8 = (u32x2*)orow + lane;
#pragma unroll
    for (int j = 0; j < 4; ++j) { const f32x4 gg = gr[64 * j]; u32x2 w; w.x = pk2(v[j].x * rinv * gg.x, v[j].y * rinv * gg.y); w.y = pk2(v[j].z * rinv * gg.z, v[j].w * rinv * gg.w); o8[64 * j] = w; }
}

__device__ __forceinline__ void rms_rows2_to_bf16(const float* xa, const float* xb, const float* g, bf16* oa, bf16* ob, int lane) {
    const f32x4* ra = (const f32x4*)xa + lane; const f32x4* rb = (const f32x4*)xb + lane; const f32x4* gr = (const f32x4*)g + lane;
    f32x4 va[4], vb[4]; float sa = 0.f, sb = 0.f;
#pragma unroll
    for (int j = 0; j < 4; ++j) { va[j] = __builtin_nontemporal_load(ra + 64 * j); vb[j] = __builtin_nontemporal_load(rb + 64 * j); }
#pragma unroll
    for (int j = 0; j < 4; ++j) { sa += (va[j].x * va[j].x + va[j].y * va[j].y) + (va[j].z * va[j].z + va[j].w * va[j].w); sb += (vb[j].x * vb[j].x + vb[j].y * vb[j].y) + (vb[j].z * vb[j].z + vb[j].w * vb[j].w); }
#pragma unroll
    for (int o = 1; o < 64; o <<= 1) { sa += __shfl_xor(sa, o); sb += __shfl_xor(sb, o); }
    const float ia = rsqrtf(sa * (1.f / 1024.f) + 1e-6f), ib = rsqrtf(sb * (1.f / 1024.f) + 1e-6f);
    u32x2* pa = (u32x2*)oa + lane; u32x2* pb = (u32x2*)ob + lane;
#pragma unroll
    for (int j = 0; j < 4; ++j) { const f32x4 gg = gr[64 * j]; u32x2 w; w.x = pk2(va[j].x * ia * gg.x, va[j].y * ia * gg.y); w.y = pk2(va[j].z * ia * gg.z, va[j].w * ia * gg.w); pa[64 * j] = w;
        w.x = pk2(vb[j].x * ib * gg.x, vb[j].y * ib * gg.y); w.y = pk2(vb[j].z * ib * gg.z, vb[j].w * ib * gg.w); pb[64 * j] = w; }
}

__device__ __forceinline__ void s5_tables_item(const Ctx& cx, int g, int part, const float* lam_re, const float* lam_im, const float* log_dt, const float* b_re, const float* b_im, const float* c_re, const float* c_im,
                                               bf16* BT, bf16* ET, float* AT) {
    LAS float* apr = (LAS float*)cx.lds; LAS float* api = apr + 33 * 64; LAS float* bbr = api + 33 * 64; LAS float* bbi = bbr + 1024; LAS float* cr = bbi + 1024; LAS float* ci = cr + 1024; LAS float* kt = ci + 1024;
    const int tid = cx.tid;
    const float dt = __expf(log_dt[g]);
    for (int idx = tid; idx < 33 * 64; idx += NTHR) { const int j = idx >> 6, p = idx & 63;
        const float lre = fminf(lam_re[g * 64 + p], -1e-4f), lim = lam_im[g * 64 + p];
        const float mag = expf(lre * dt * (float)j), ang = lim * dt * (float)j; float sn, cs; sincosf(ang, &sn, &cs);
        apr[idx] = mag * cs; api[idx] = mag * sn; }
    for (int idx = tid; idx < 1024; idx += NTHR) { const int p = idx >> 4;
        const float lre = fminf(lam_re[g * 64 + p], -1e-4f), lim = lam_im[g * 64 + p];
        const float mag = expf(lre * dt); float sn, cs; sincosf(lim * dt, &sn, &cs); const float lbr = mag * cs, lbi = mag * sn;
        const float den = lre * lre + lim * lim, zr = lbr - 1.0f; const float cor = (zr * lre + lbi * lim) / den, coi = (lbi * lre - zr * lim) / den;
        const float br = b_re[g * 1024 + idx], bi = b_im[g * 1024 + idx];
        bbr[idx] = cor * br - coi * bi; bbi[idx] = cor * bi + coi * br;
        cr[idx] = c_re[g * 1024 + idx]; ci[idx] = c_im[g * 1024 + idx]; }
    __syncthreads();
    if (tid < 64) { const int jl = tid >> 4, c = tid & 15, j = 4 * part + jl; float acc[16];
#pragma unroll
        for (int i = 0; i < 16; ++i) acc[i] = 0.f;
        for (int p = 0; p < 64; ++p) { const float ar = apr[j * 64 + p], ai = api[j * 64 + p], xr = cr[c * 64 + p], xi = ci[c * 64 + p];
            const float car = xr * ar - xi * ai, cai = xr * ai + xi * ar;
#pragma unroll
            for (int v4 = 0; v4 < 4; ++v4) { const f32x4 br = *(const LAS f32x4*)(bbr + p * 16 + 4 * v4), bi = *(const LAS f32x4*)(bbi + p * 16 + 4 * v4);
                acc[4 * v4 + 0] += car * br.x - cai * bi.x; acc[4 * v4 + 1] += car * br.y - cai * bi.y; acc[4 * v4 + 2] += car * br.z - cai * bi.z; acc[4 * v4 + 3] += car * br.w - cai * bi.w; } }
#pragma unroll
        for (int i = 0; i < 16; ++i) kt[jl * 256 + c * 16 + i] = acc[i]; }
    __syncthreads();
    bf16* BTg = BT + (size_t)g * 512 * 640; bf16* ETg = ET + (size_t)g * 256 * 512;
    for (int idx = tid; idx < 4096; idx += NTHR) { const int hf = idx & 1, c = (idx >> 1) & 15, t = (idx >> 5) & 31, jl = idx >> 10, j = 4 * part + jl;
        if (t >= j) { const LAS float* s = kt + jl * 256 + c * 16 + hf * 8; u32x4 o; o.x = pk2(s[0], s[1]); o.y = pk2(s[2], s[3]); o.z = pk2(s[4], s[5]); o.w = pk2(s[6], s[7]);
            *(u32x4*)(BTg + (size_t)(t * 16 + c) * 640 + (t - j) * 16 + hf * 8) = o; } }
    for (int idx = tid; idx < 4096; idx += NTHR) { const int hf = idx & 1, c = (idx >> 1) & 15, s = (idx >> 5) & 31, t = 4 * part + (idx >> 10);
        if (s > t) *(u32x4*)(BTg + (size_t)(t * 16 + c) * 640 + s * 16 + hf * 8) = (u32x4){0u, 0u, 0u, 0u}; }
    for (int idx = tid; idx < 1024; idx += NTHR) { const int ch = idx & 15, c = (idx >> 4) & 15, t = 4 * part + (idx >> 8); const int im = ch >> 3, p0 = (ch & 7) * 8; float v[8];
#pragma unroll
        for (int q = 0; q < 8; ++q) { const int p = p0 + q; const float ar = apr[(t + 1) * 64 + p], ai = api[(t + 1) * 64 + p], xr = cr[c * 64 + p], xi = ci[c * 64 + p];
            v[q] = im ? -(xr * ai + xi * ar) : (xr * ar - xi * ai); }
        u32x4 o; o.x = pk2(v[0], v[1]); o.y = pk2(v[2], v[3]); o.z = pk2(v[4], v[5]); o.w = pk2(v[6], v[7]);
        *(u32x4*)(BTg + (size_t)(t * 16 + c) * 640 + 512 + im * 64 + p0) = o; }
    for (int idx = tid; idx < 1024; idx += NTHR) { const int hf = idx & 1, sl = (idx >> 1) & 3, n = idx >> 3, s = 4 * part + sl, p = n & 63, im = n >> 6; float v[8];
        const float ar = apr[(31 - s) * 64 + p], ai = api[(31 - s) * 64 + p];
#pragma unroll
        for (int q = 0; q < 8; ++q) { const float br = bbr[p * 16 + hf * 8 + q], bi = bbi[p * 16 + hf * 8 + q]; v[q] = im ? (ar * bi + ai * br) : (ar * br - ai * bi); }
        u32x4 o; o.x = pk2(v[0], v[1]); o.y = pk2(v[2], v[3]); o.z = pk2(v[4], v[5]); o.w = pk2(v[6], v[7]);
        *(u32x4*)(ETg + (size_t)n * 512 + s * 16 + hf * 8) = o; }
    for (int idx = tid; idx < 1024; idx += NTHR) { const int ch = idx & 63, r = 128 + 16 * part + (idx >> 6); *(u32x4*)(ETg + (size_t)r * 512 + ch * 8) = (u32x4){0u, 0u, 0u, 0u}; }
    if (part == 0 && tid < 64) { AT[(g * 64 + tid) * 2] = apr[32 * 64 + tid]; AT[(g * 64 + tid) * 2 + 1] = api[32 * 64 + tid]; }
    __syncthreads();
}

constexpr int IMG_LD = 80, IMG_B = 64 * IMG_LD * 2;
#define IMG(k) ((LAS bf16*)(lds + (k) * IMG_B))
#define LDS_BARRIER() do { asm volatile("s_waitcnt lgkmcnt(0)" ::: "memory"); __builtin_amdgcn_s_barrier(); asm volatile("" ::: "memory"); } while (0)
struct MmCtx { int tr, tc0, l15, q; };
__device__ __forceinline__ void mm64(const LAS bf16* A, const LAS bf16* Bt, f32x4 (&acc)[2], const MmCtx& w) {
#pragma unroll
    for (int s = 0; s < 2; ++s) {
        const bf16x8 a = *(const LAS bf16x8*)(A + (16 * w.tr + w.l15) * IMG_LD + 32 * s + 8 * w.q);
#pragma unroll
        for (int c = 0; c < 2; ++c) { const bf16x8 b = *(const LAS bf16x8*)(Bt + (16 * (w.tc0 + c) + w.l15) * IMG_LD + 32 * s + 8 * w.q);
            acc[c] = __builtin_amdgcn_mfma_f32_16x16x32_bf16(a, b, acc[c], 0, 0, 0); }
    }
}
__device__ __forceinline__ void mm64_2a(const LAS bf16* A1, const LAS bf16* A2, const LAS bf16* Bt, f32x4 (&acc1)[2], f32x4 (&acc2)[2], const MmCtx& w) {
#pragma unroll
    for (int s = 0; s < 2; ++s) {
        const bf16x8 a1 = *(const LAS bf16x8*)(A1 + (16 * w.tr + w.l15) * IMG_LD + 32 * s + 8 * w.q), a2 = *(const LAS bf16x8*)(A2 + (16 * w.tr + w.l15) * IMG_LD + 32 * s + 8 * w.q);
#pragma unroll
        for (int c = 0; c < 2; ++c) { const bf16x8 b = *(const LAS bf16x8*)(Bt + (16 * (w.tc0 + c) + w.l15) * IMG_LD + 32 * s + 8 * w.q);
            acc1[c] = __builtin_amdgcn_mfma_f32_16x16x32_bf16(a1, b, acc1[c], 0, 0, 0); acc2[c] = __builtin_amdgcn_mfma_f32_16x16x32_bf16(a2, b, acc2[c], 0, 0, 0); }
    }
}
__device__ __forceinline__ void mm64_2b(const LAS bf16* A, const LAS bf16* Bt1, const LAS bf16* Bt2, f32x4 (&acc1)[2], f32x4 (&acc2)[2], const MmCtx& w) {
#pragma unroll
    for (int s = 0; s < 2; ++s) {
        const bf16x8 a = *(const LAS bf16x8*)(A + (16 * w.tr + w.l15) * IMG_LD + 32 * s + 8 * w.q);
#pragma unroll
        for (int c = 0; c < 2; ++c) { const bf16x8 b1 = *(const LAS bf16x8*)(Bt1 + (16 * (w.tc0 + c) + w.l15) * IMG_LD + 32 * s + 8 * w.q), b2 = *(const LAS bf16x8*)(Bt2 + (16 * (w.tc0 + c) + w.l15) * IMG_LD + 32 * s + 8 * w.q);
            acc1[c] = __builtin_amdgcn_mfma_f32_16x16x32_bf16(a, b1, acc1[c], 0, 0, 0); acc2[c] = __builtin_amdgcn_mfma_f32_16x16x32_bf16(a, b2, acc2[c], 0, 0, 0); }
    }
}
__device__ __forceinline__ float dpp_x1(float v) { return __int_as_float(__builtin_amdgcn_update_dpp(0, __float_as_int(v), 0xB1, 0xF, 0xF, true)); }
__device__ __forceinline__ float dpp_x2(float v) { return __int_as_float(__builtin_amdgcn_update_dpp(0, __float_as_int(v), 0x4E, 0xF, 0xF, true)); }
__device__ __forceinline__ f32x4 quad_transpose(const f32x4 v, int b) {
    const bool odd = (b & 1) != 0, hi = (b & 2) != 0;
    const float r0 = dpp_x1(odd ? v[0] : v[1]), r1 = dpp_x1(odd ? v[2] : v[3]);
    const float p0a = odd ? r0 : v[0], p0b = odd ? v[1] : r0, p1a = odd ? r1 : v[2], p1b = odd ? v[3] : r1;
    const float ra = dpp_x2(hi ? p0a : p1a), rb = dpp_x2(hi ? p0b : p1b);
    return hi ? (f32x4){ra, rb, p1a, p1b} : (f32x4){p0a, p0b, ra, rb};
}
__device__ __forceinline__ void st_rm(LAS bf16* img, const f32x4 v, int tr, int tc, const MmCtx& w) {
    const unsigned p01 = pk2(v[0], v[1]), p23 = pk2(v[2], v[3]); LAS bf16* d = img + (16 * tr + 4 * w.q) * IMG_LD + 16 * tc + w.l15;
    d[0] = (bf16)p01; d[IMG_LD] = (bf16)(p01 >> 16); d[2 * IMG_LD] = (bf16)p23; d[3 * IMG_LD] = (bf16)(p23 >> 16);
}
__device__ __forceinline__ void st_tr(LAS bf16* img, const f32x4 v, int tr, int tc, const MmCtx& w) {
    u32x2 o; o.x = pk2(v[0], v[1]); o.y = pk2(v[2], v[3]); *(LAS u32x2*)(img + (16 * tc + w.l15) * IMG_LD + 16 * tr + 4 * w.q) = o;
}
__device__ __forceinline__ void img_to_global(const LAS bf16* img, bf16* g, int tid) { const int row = tid >> 3, ch = tid & 7; *(u32x4*)(g + row * 64 + ch * 8) = *(const LAS u32x4*)(img + row * IMG_LD + ch * 8); }
__device__ __forceinline__ void st_tm8(LAS bf16* img, int t, int cg, const float (&v)[8]) {
    u32x4 o; o.x = pk2(v[0], v[1]); o.y = pk2(v[2], v[3]); o.z = pk2(v[4], v[5]); o.w = pk2(v[6], v[7]); *(LAS u32x4*)(img + t * IMG_LD + 8 * cg) = o;
}
__device__ __forceinline__ void st_cm8(LAS bf16* img, int t, int cg, const float (&v)[8]) {
#pragma unroll
    for (int i = 0; i < 8; i += 2) { const unsigned p = pk2(v[i], v[i + 1]); img[(8 * cg + i) * IMG_LD + t] = (bf16)p; img[(8 * cg + i + 1) * IMG_LD + t] = (bf16)(p >> 16); }
}
__device__ __forceinline__ float red8(float v) { v += __shfl_xor(v, 1); v += __shfl_xor(v, 2); v += __shfl_xor(v, 4); return v; }
__device__ __forceinline__ void unpack8(const u32x4 w, float (&o)[8]) { o[0] = lo16(w.x); o[1] = hi16(w.x); o[2] = lo16(w.y); o[3] = hi16(w.y); o[4] = lo16(w.z); o[5] = hi16(w.z); o[6] = lo16(w.w); o[7] = hi16(w.w); }
__device__ __forceinline__ void ldp8(const float* p, float (&o)[8]) { const f32x4 a = *(const f32x4*)p, b = *(const f32x4*)(p + 4); o[0] = a.x; o[1] = a.y; o[2] = a.z; o[3] = a.w; o[4] = b.x; o[5] = b.y; o[6] = b.z; o[7] = b.w; }

struct RwkvP { const bf16* rkv; const bf16* wag; const float *mu_rkv, *w0, *a0, *k_k, *k_a, *r_k, *ln_w, *ln_b; };
struct RwkvRaw { u32x4 kc, kp, vc, vp, wl, al, rc, rp, gg; };
template <bool PASS3>
__device__ __forceinline__ void rwkv_load(const RwkvP& P, int cidx, int tid, RwkvRaw& R) {
    const int t = tid >> 3, cg = tid & 7, bh = cidx >> 7, c = cidx & 127, b = bh >> 3, h = bh & 7, ch = h * 64 + 8 * cg;
    const size_t tok = (size_t)b * SEQ + c * 64 + t; const bool first = (c == 0 && t == 0);
    const bf16* row = P.rkv + tok * 1536 + ch; const bf16* prow = first ? row : row - 1536;
    R.kc = *(const u32x4*)(row + 512); R.vc = *(const u32x4*)(row + 1024); R.kp = *(const u32x4*)(prow + 512); R.vp = *(const u32x4*)(prow + 1024);
    R.wl = *(const u32x4*)(P.wag + tok * 1536 + ch); R.al = *(const u32x4*)(P.wag + tok * 1536 + 512 + ch);
    if (PASS3) { R.rc = *(const u32x4*)row; R.rp = *(const u32x4*)prow; R.gg = *(const u32x4*)(P.wag + tok * 1536 + 1024 + ch); }
}
constexpr int RC_OFF = 14 * IMG_B;
struct RwkvC { const LAS float* p; };
__device__ __forceinline__ void ldl8(const LAS float* p, float (&o)[8]) { const f32x4 a = *(const LAS f32x4*)p, b = *(const LAS f32x4*)(p + 4); o[0] = a.x; o[1] = a.y; o[2] = a.z; o[3] = a.w; o[4] = b.x; o[5] = b.y; o[6] = b.z; o[7] = b.w; }
__device__ __forceinline__ void rwkv_consts(LAS unsigned char* lds, const RwkvP& P, int h, int tid, RwkvC& C) {
    LAS float* base = (LAS float*)(lds + RC_OFF);
    if (tid < 64) { const int cg = tid >> 3, k = tid & 7, ch = h * 64 + 8 * cg; const float* src = k == 0 ? P.mu_rkv + ch : k == 1 ? P.mu_rkv + 512 + ch : k == 2 ? P.mu_rkv + 1024 + ch : k == 3 ? P.w0 + ch : k == 4 ? P.a0 + ch : k == 5 ? P.k_k + ch : P.k_a + ch;
        if (k < 7) { const f32x4 a = *(const f32x4*)src, b = *(const f32x4*)(src + 4); *(LAS f32x4*)(base + cg * 64 + k * 8) = a; *(LAS f32x4*)(base + cg * 64 + k * 8 + 4) = b; } }
    LDS_BARRIER();
    C.p = base + (tid & 7) * 64;
}
template <bool PASS3>
__device__ __forceinline__ void rwkv_prep(const RwkvRaw& R, const RwkvC& C, bool first, float (&kq)[8], float (&vv)[8], float (&rr)[8], float (&kap)[8], float (&bet)[8], float (&lw)[8]) {
    float kc[8], kp[8], vc[8], vp[8], k[8], wl[8], al[8], a[8], m[8];
    unpack8(R.kc, kc); unpack8(R.vc, vc); unpack8(R.kp, kp); unpack8(R.vp, vp); unpack8(R.wl, wl); unpack8(R.al, al);
    const float pm = first ? 0.f : 1.f;
    ldl8(C.p + 8, m);
#pragma unroll
    for (int i = 0; i < 8; ++i) k[i] = kc[i] + (pm * kp[i] - kc[i]) * m[i];
    ldl8(C.p + 16, m);
#pragma unroll
    for (int i = 0; i < 8; ++i) vv[i] = vc[i] + (pm * vp[i] - vc[i]) * m[i];
    if (PASS3) { float rc[8], rp[8]; unpack8(R.rc, rc); unpack8(R.rp, rp); ldl8(C.p, m);
#pragma unroll
        for (int i = 0; i < 8; ++i) rr[i] = rc[i] + (pm * rp[i] - rc[i]) * m[i];
    } else {
#pragma unroll
        for (int i = 0; i < 8; ++i) rr[i] = 0.f;
    }
    float ss = 0.f;
    ldl8(C.p + 24, m);
#pragma unroll
    for (int i = 0; i < 8; ++i) lw[i] = -0.6065306597126334f * fsigmoid(m[i] + wl[i]);
    ldl8(C.p + 32, m);
#pragma unroll
    for (int i = 0; i < 8; ++i) a[i] = fsigmoid(m[i] + al[i]);
    ldl8(C.p + 40, m);
#pragma unroll
    for (int i = 0; i < 8; ++i) { kap[i] = k[i] * m[i]; ss += kap[i] * kap[i]; }
    ss = red8(ss);
    const float inv = 1.0f / fmaxf(sqrtf(ss), 1e-12f);
    ldl8(C.p + 48, m);
#pragma unroll
    for (int i = 0; i < 8; ++i) { kap[i] *= inv; bet[i] = kap[i] * a[i]; kq[i] = k[i] * (1.0f + (a[i] - 1.0f) * m[i]); }
}
template <int SEGSLOT>
__device__ __forceinline__ void rwkv_cumsum(LAS unsigned char* lds, int tid, const float (&lw)[8], float (&cum)[8], float (&cumL)[8]) {
    LAS float* LW = (LAS float*)(lds + 12 * IMG_B); LAS float* SEG = (LAS float*)(lds + SEGSLOT * IMG_B);
    const int t = tid >> 3, cg = tid & 7, j = tid & 63, seg = tid >> 6;
#pragma unroll
    for (int i = 0; i < 8; ++i) LW[t * 65 + 8 * cg + i] = lw[i];
    LDS_BARRIER();
    { float run = 0.f;
#pragma unroll
      for (int tt = 0; tt < 8; ++tt) { const int idx = (8 * seg + tt) * 65 + j; run += LW[idx]; LW[idx] = run; }
      SEG[seg * 64 + j] = run; }
    LDS_BARRIER();
    { float pre = 0.f;
#pragma unroll
      for (int s2 = 0; s2 < 8; ++s2) { const float x = SEG[s2 * 64 + j]; pre += (s2 < seg) ? x : 0.f; }
#pragma unroll
      for (int tt = 0; tt < 8; ++tt) LW[(8 * seg + tt) * 65 + j] += pre; }
    LDS_BARRIER();
#pragma unroll
    for (int i = 0; i < 8; ++i) { cum[i] = LW[t * 65 + 8 * cg + i]; cumL[i] = LW[63 * 65 + 8 * cg + i]; }
}
#define Z4 (f32x4){0.f, 0.f, 0.f, 0.f}

__device__ __forceinline__ void rwkv_pass1(LAS unsigned char* lds, const RwkvP& P, int c0, int n, int tid, bf16* QCT, float* HCT, bf16* M1G, bf16* YLG, float* DLG, float* BONUS) {
    const int lane = tid & 63, wv = __builtin_amdgcn_readfirstlane(tid >> 6); MmCtx w; w.tr = wv >> 1; w.tc0 = (wv & 1) * 2; w.l15 = lane & 15; w.q = lane >> 4;
    const int t = tid >> 3, cg = tid & 7, ch = ((c0 >> 7) & 7) * 64 + 8 * cg;
    RwkvC C; rwkv_consts(lds, P, (c0 >> 7) & 7, tid, C);
    RwkvRaw R; rwkv_load<true>(P, c0, tid, R);
    for (int ci = 0; ci < n; ++ci) {
        const int cidx = c0 + ci;
        {
            float kq[8], vv[8], rr[8], kap[8], bet[8], lw[8], cum[8], cumL[8];
            rwkv_prep<true>(R, C, (cidx & 127) == 0 && t == 0, kq, vv, rr, kap, bet, lw);
            if (ci + 1 < n) rwkv_load<true>(P, cidx + 1, tid, R);
            rwkv_cumsum<10>(lds, tid, lw, cum, cumL);
            { float bs = 0.f, rk[8]; ldp8(P.r_k + ch, rk);
#pragma unroll
              for (int i = 0; i < 8; ++i) bs += rr[i] * kq[i] * rk[i];
              bs = red8(bs); if (cg == 0) BONUS[(size_t)cidx * 64 + t] = bs; }
            float x[8], y[8];
#pragma unroll
            for (int i = 0; i < 8; ++i) { const float en = __expf(-cum[i]); x[i] = kq[i] * en; y[i] = bet[i] * en; }
            st_tm8(IMG(0), t, cg, x);
            st_tm8(IMG(1), t, cg, y);
#pragma unroll
            for (int i = 0; i < 8; ++i) x[i] = kap[i] * __expf(cum[i] - lw[i]);
            st_tm8(IMG(2), t, cg, x);
            st_cm8(IMG(3), t, cg, x);
#pragma unroll
            for (int i = 0; i < 8; ++i) x[i] = rr[i] * __expf(cum[i]);
            st_tm8(IMG(11), t, cg, x);
#pragma unroll
            for (int i = 0; i < 8; ++i) { const float eh = __expf(cumL[i] - cum[i]); x[i] = kq[i] * eh; y[i] = bet[i] * eh; }
            st_cm8(IMG(4), t, cg, x);
            st_cm8(IMG(5), t, cg, y);
            st_cm8(IMG(6), t, cg, vv);
            if (t == 0) {
#pragma unroll
                for (int i = 0; i < 8; ++i) DLG[(size_t)cidx * 64 + 8 * cg + i] = __expf(cumL[i]);
            }
        }
        LDS_BARRIER();
        f32x4 accX[2];
        {
            f32x4 a[2] = {Z4, Z4}, kk[2] = {Z4, Z4};
            mm64_2a(IMG(1), IMG(0), IMG(2), a, kk, w);
#pragma unroll
            for (int c = 0; c < 2; ++c) { const int nn = 16 * (w.tc0 + c) + w.l15;
#pragma unroll
                for (int r = 0; r < 4; ++r) { const int m = 16 * w.tr + 4 * w.q + r; a[c][r] = (m < nn) ? a[c][r] : 0.f; kk[c][r] = (m < nn) ? kk[c][r] : 0.f; accX[c][r] = ((m == nn) ? 1.0f : 0.f) - a[c][r]; }
                st_rm(IMG(7), a[c], w.tr, w.tc0 + c, w); st_tr(IMG(8), a[c], w.tr, w.tc0 + c, w); st_rm(IMG(10), accX[c], w.tr, w.tc0 + c, w); st_rm(IMG(9), kk[c], w.tr, w.tc0 + c, w); }
        }
        LDS_BARRIER();
        {
            f32x4 p[2] = {Z4, Z4};
            mm64(IMG(7), IMG(8), p, w);
#pragma unroll
            for (int c = 0; c < 2; ++c) { st_rm(IMG(12), p[c], w.tr, w.tc0 + c, w); st_tr(IMG(13), p[c], w.tr, w.tc0 + c, w); }
        }
        LDS_BARRIER();
#define NEUMANN(XC, XN, PC, PTC, PN, PTN, LASTR) do { if (LASTR) mm64(IMG(XC), IMG(PTC), accX, w); \
            if (!(LASTR)) { f32x4 p[2] = {Z4, Z4}; mm64_2a(IMG(XC), IMG(PC), IMG(PTC), accX, p, w); \
                _Pragma("unroll") for (int c = 0; c < 2; ++c) { st_rm(IMG(PN), p[c], w.tr, w.tc0 + c, w); st_tr(IMG(PTN), p[c], w.tr, w.tc0 + c, w); st_rm(IMG(XN), accX[c], w.tr, w.tc0 + c, w); } } \
            LDS_BARRIER(); } while (0)
        NEUMANN(10, 2, 12, 13, 7, 8, false);
        NEUMANN(2, 10, 7, 8, 12, 13, false);
        NEUMANN(10, 2, 12, 13, 7, 8, false);
        NEUMANN(2, 10, 7, 8, 12, 13, false);
        NEUMANN(10, 2, 12, 13, 7, 8, true);
#undef NEUMANN
#pragma unroll
        for (int c = 0; c < 2; ++c) st_tr(IMG(7), accX[c], w.tr, w.tc0 + c, w);
        LDS_BARRIER();
        {
            f32x4 a[2] = {Z4, Z4}, g[2] = {Z4, Z4}, kr[2] = {Z4, Z4}, br[2] = {Z4, Z4};
            mm64_2a(IMG(3), IMG(9), IMG(7), a, g, w); mm64_2b(IMG(11), IMG(0), IMG(1), kr, br, w);
#pragma unroll
            for (int c = 0; c < 2; ++c) { const int nn = 16 * (w.tc0 + c) + w.l15;
#pragma unroll
                for (int r = 0; r < 4; ++r) { const int m = 16 * w.tr + 4 * w.q + r; kr[c][r] = (nn <= m) ? kr[c][r] : 0.f; br[c][r] = (nn <= m) ? br[c][r] : 0.f; }
                st_rm(IMG(12), a[c], w.tr, w.tc0 + c, w); st_tr(IMG(8), g[c], w.tr, w.tc0 + c, w); st_rm(IMG(2), kr[c], w.tr, w.tc0 + c, w); st_rm(IMG(10), br[c], w.tr, w.tc0 + c, w); }
        }
        LDS_BARRIER();
        {
            f32x4 u[2] = {Z4, Z4}, qc[2] = {Z4, Z4}, m1[2] = {Z4, Z4};
            mm64(IMG(6), IMG(8), u, w); mm64(IMG(5), IMG(12), qc, w); mm64(IMG(10), IMG(12), m1, w);
#pragma unroll
            for (int c = 0; c < 2; ++c) { st_rm(IMG(13), u[c], w.tr, w.tc0 + c, w);
                const int tc = w.tc0 + c, cp = 32 * (tc >> 1) + 8 * (w.l15 >> 2) + 4 * (tc & 1) + (w.l15 & 3);
                const unsigned p01 = pk2(qc[c][0], qc[c][1]), p23 = pk2(qc[c][2], qc[c][3]); LAS bf16* d = IMG(0) + (16 * w.tr + 4 * w.q) * IMG_LD + cp;
                d[0] = (bf16)p01; d[IMG_LD] = (bf16)(p01 >> 16); d[2 * IMG_LD] = (bf16)p23; d[3 * IMG_LD] = (bf16)(p23 >> 16);
                f32x4 mv;
#pragma unroll
                for (int r = 0; r < 4; ++r) mv[r] = bf2f(IMG(11)[(16 * w.tr + 4 * w.q + r) * IMG_LD + 16 * tc + w.l15]) - m1[c][r];
                st_rm(IMG(1), mv, w.tr, tc, w); }
        }
        LDS_BARRIER();
        {
            f32x4 hp[2] = {Z4, Z4}, hn[2] = {Z4, Z4}, yp[2] = {Z4, Z4}, yn[2] = {Z4, Z4};
            mm64(IMG(4), IMG(6), hp, w); mm64(IMG(5), IMG(13), hn, w); mm64(IMG(2), IMG(6), yp, w); mm64(IMG(10), IMG(13), yn, w);
#pragma unroll
            for (int c = 0; c < 2; ++c) { *(f32x4*)(HCT + (((size_t)cidx * 16 + w.tr * 4 + w.tc0 + c) * 64 + lane) * 4) = hp[c] - hn[c]; st_rm(IMG(3), yp[c] - yn[c], w.tr, w.tc0 + c, w); }
            img_to_global(IMG(1), M1G + (size_t)cidx * 4096, tid);
            img_to_global(IMG(0), QCT + (size_t)cidx * 4096, tid);
        }
        LDS_BARRIER();
        img_to_global(IMG(3), YLG + (size_t)cidx * 4096, tid);
    }
}

constexpr int P2_SLOT = 12544, P2_DEPTH = 5;
__device__ __forceinline__ void rwkv_pass2(LAS unsigned char* lds, int bh, int ti, int lane, const bf16* QCT, const float* HCT, const float* DLG, bf16* S0G) {
    const int l15 = lane & 15, q = lane >> 4;
    f32x4 X[4];
#pragma unroll
    for (int tj = 0; tj < 4; ++tj) X[tj] = Z4;
#define P2_DMA(cc) do { const size_t ci_ = (size_t)bh * 128 + (cc); LAS unsigned char* sl_ = lds + ((cc) % P2_DEPTH) * P2_SLOT; \
        _Pragma("unroll") for (int i = 0; i < 8; ++i) { const int row_ = i * 8 + (lane >> 3), pc_ = (lane & 7) ^ (row_ & 7); \
            __builtin_amdgcn_global_load_lds((const unsigned*)((const char*)QCT + (ci_ * 64 + row_) * 128 + pc_ * 16), (LAS unsigned*)(sl_ + i * 1024), 16, 0, 0); } \
        _Pragma("unroll") for (int tj = 0; tj < 4; ++tj) __builtin_amdgcn_global_load_lds((const unsigned*)((const char*)HCT + ((ci_ * 16 + tj * 4 + ti) * 64 + lane) * 16), (LAS unsigned*)(sl_ + 8192 + tj * 1024), 16, 0, 0); \
        __builtin_amdgcn_global_load_lds((const unsigned*)((const char*)DLG + (ci_ * 64 + lane) * 4), (LAS unsigned*)(sl_ + 12288), 4, 0, 0); } while (0)
    P2_DMA(0); P2_DMA(1); P2_DMA(2); P2_DMA(3);
    for (int c = 0; c < 128; ++c) {
        if (c < 124) asm volatile("s_waitcnt vmcnt(39)" ::: "memory"); else asm volatile("s_waitcnt vmcnt(0)" ::: "memory");
        const LAS unsigned char* sl = lds + (c % P2_DEPTH) * P2_SLOT;
        bf16x8 a[4][2]; f32x4 h[4], d[4];
#pragma unroll
        for (int tj = 0; tj < 4; ++tj) { const int row = 16 * tj + l15;
#pragma unroll
            for (int s = 0; s < 2; ++s) a[tj][s] = *(const LAS bf16x8*)(sl + row * 128 + (((4 * s + q) ^ (row & 7)) * 16));
            h[tj] = *(const LAS f32x4*)(sl + 8192 + tj * 1024 + lane * 16); d[tj] = *(const LAS f32x4*)(sl + 12288 + (16 * tj + 4 * q) * 4); }
        asm volatile("s_waitcnt lgkmcnt(0)" ::: "memory");
        if (c + 4 < 128) P2_DMA(c + 4);
        const size_t cidx = (size_t)bh * 128 + c;
#pragma unroll
        for (int tj = 0; tj < 4; ++tj) { u32x2 o; o.x = pk2(X[tj][0], X[tj][1]); o.y = pk2(X[tj][2], X[tj][3]); *(u32x2*)(S0G + (cidx * 64 + 16 * ti + l15) * 64 + 16 * tj + 4 * q) = o; }
        bf16x8 b[2];
#pragma unroll
        for (int s = 0; s < 2; ++s) { u32x4 o; o.x = pk2(X[2 * s][0], X[2 * s][1]); o.y = pk2(X[2 * s][2], X[2 * s][3]); o.z = pk2(X[2 * s + 1][0], X[2 * s + 1][1]); o.w = pk2(X[2 * s + 1][2], X[2 * s + 1][3]); b[s] = __builtin_bit_cast(bf16x8, o); }
#pragma unroll
        for (int tj = 0; tj < 4; ++tj) { f32x4 acc = Z4;
            acc = __builtin_amdgcn_mfma_f32_16x16x32_bf16(a[tj][0], b[0], acc, 0, 0, 0); acc = __builtin_amdgcn_mfma_f32_16x16x32_bf16(a[tj][1], b[1], acc, 0, 0, 0);
            X[tj] = d[tj] * X[tj] + h[tj] - acc; }
    }
    asm volatile("s_waitcnt vmcnt(0)" ::: "memory");
#undef P2_DMA
}

__device__ __forceinline__ void rwkv_pass3(LAS unsigned char* lds, const RwkvP& P, int c0, int n, int tid, const bf16* S0G, const bf16* M1G, const bf16* YLG, const float* BONUS, bf16* MIX) {
    const int lane = tid & 63, wv = __builtin_amdgcn_readfirstlane(tid >> 6); MmCtx w; w.tr = wv >> 1; w.tc0 = (wv & 1) * 2; w.l15 = lane & 15; w.q = lane >> 4;
    const int t = tid >> 3, cg = tid & 7, bh = c0 >> 7, b = bh >> 3, h = bh & 7, ch = h * 64 + 8 * cg;
    float muv[8], lnw[8], lnb[8]; ldp8(P.mu_rkv + 1024 + ch, muv); ldp8(P.ln_w + ch, lnw); ldp8(P.ln_b + ch, lnb);
    u32x4 gS0, gM1, gYL, gvc, gvp, ggg; float gbo;
#define P3_LOAD(cc) do { const int cidx_ = (cc), c_ = cidx_ & 127; const size_t o_ = (size_t)cidx_ * 4096 + (tid >> 3) * 64 + (tid & 7) * 8; gS0 = *(const u32x4*)(S0G + o_); gM1 = *(const u32x4*)(M1G + o_); gYL = *(const u32x4*)(YLG + o_); \
        const size_t tok_ = (size_t)b * SEQ + c_ * 64 + t; const bool first_ = (c_ == 0 && t == 0); const bf16* row_ = P.rkv + tok_ * 1536 + 1024 + ch; \
        gvc = *(const u32x4*)row_; gvp = *(const u32x4*)(first_ ? row_ : row_ - 1536); ggg = *(const u32x4*)(P.wag + tok_ * 1536 + 1024 + ch); gbo = BONUS[(size_t)cidx_ * 64 + t]; } while (0)
    P3_LOAD(c0);
    for (int ci = 0; ci < n; ++ci) {
        const int cidx = c0 + ci, c = cidx & 127;
        float vv[8], gg[8]; const float bonus = gbo;
        { float vc[8], vp[8]; unpack8(gvc, vc); unpack8(gvp, vp); unpack8(ggg, gg); const float pm = (c == 0 && t == 0) ? 0.f : 1.f;
#pragma unroll
          for (int i = 0; i < 8; ++i) vv[i] = vc[i] + (pm * vp[i] - vc[i]) * muv[i];
          const int row = tid >> 3, chk = tid & 7; *(LAS u32x4*)(IMG(0) + row * IMG_LD + chk * 8) = gM1; *(LAS u32x4*)(IMG(1) + row * IMG_LD + chk * 8) = gS0; *(LAS u32x4*)(IMG(2) + row * IMG_LD + chk * 8) = gYL; }
        if (ci + 1 < n) P3_LOAD(cidx + 1);
        LDS_BARRIER();
        {
            f32x4 y[2] = {Z4, Z4};
            mm64(IMG(0), IMG(1), y, w);
            LAS float* YF = (LAS float*)(lds + 10 * IMG_B);
#pragma unroll
            for (int cc = 0; cc < 2; ++cc)
#pragma unroll
                for (int r = 0; r < 4; ++r) { const int m = 16 * w.tr + 4 * w.q + r, nn = 16 * (w.tc0 + cc) + w.l15; YF[m * 65 + nn] = y[cc][r] + bf2f(IMG(2)[m * IMG_LD + nn]); }
        }
        LDS_BARRIER();
        {
            const LAS float* YF = (const LAS float*)(lds + 10 * IMG_B);
            float y[8], s = 0.f;
#pragma unroll
            for (int i = 0; i < 8; ++i) { y[i] = YF[t * 65 + 8 * cg + i]; s += y[i]; }
            const float mean = red8(s) * (1.0f / 64.0f); float qv = 0.f;
#pragma unroll
            for (int i = 0; i < 8; ++i) { y[i] -= mean; qv += y[i] * y[i]; }
            const float rstd = rsqrtf(red8(qv) * (1.0f / 64.0f) + 64e-5f);
            float o[8];
#pragma unroll
            for (int i = 0; i < 8; ++i) o[i] = (y[i] * rstd * lnw[i] + lnb[i] + bonus * vv[i]) * gg[i];
            const size_t tok = (size_t)b * SEQ + c * 64 + t;
            u32x4 ov; ov.x = pk2(o[0], o[1]); ov.y = pk2(o[2], o[3]); ov.z = pk2(o[4], o[5]); ov.w = pk2(o[6], o[7]);
            *(u32x4*)(MIX + tok * 1024 + 512 + ch) = ov;
        }
        LDS_BARRIER();
    }
#undef P3_LOAD
}

constexpr int RW_LD = 1032;
__device__ __forceinline__ void router_phase(const Ctx& cx, const bf16* X1, const float* gnorm, const float* rw, const float* rb, unsigned char* H2, int* TOPE, float* TOPG, unsigned* HIST) {
    LAS bf16* WH = (LAS bf16*)cx.lds; LAS bf16* WL = WH + 32 * RW_LD;
    LAS unsigned* hcnt = (LAS unsigned*)(cx.lds + 135168);
    const int lane = cx.lane, l15 = lane & 15, q = lane >> 4;
    for (int idx = cx.tid; idx < 32768; idx += NTHR) { const int col = idx >> 5, e = idx & 31; const float v = rw[idx] * gnorm[col];
        const unsigned h = cvt_pk_bf16(v, 0.f) & 0xffffu; const float lo = v - bf2f(h); WH[e * RW_LD + col] = (bf16)h; WL[e * RW_LD + col] = (bf16)(cvt_pk_bf16(lo, 0.f) & 0xffffu); }
    const float b0 = rb[l15], b1 = rb[l15 + 16];
    for (int tb = cx.wg; tb < 256; tb += cx.G) {
        if (cx.tid < 32) hcnt[cx.tid] = 0u;
        __syncthreads();
        const int tok0 = tb * 128 + cx.wave * 16;
        const bf16* xrow = X1 + (size_t)(tok0 + l15) * 1024 + 8 * q;
        f32x4 acc[2] = {(f32x4){0.f, 0.f, 0.f, 0.f}, (f32x4){0.f, 0.f, 0.f, 0.f}}; float ss = 0.f;
#pragma unroll 8
        for (int s = 0; s < 32; ++s) {
            const u32x4 xw = *(const u32x4*)(xrow + 32 * s);
            { const float a0 = lo16(xw.x), a1 = hi16(xw.x), a2 = lo16(xw.y), a3 = hi16(xw.y), a4 = lo16(xw.z), a5 = hi16(xw.z), a6 = lo16(xw.w), a7 = hi16(xw.w);
              ss += (a0 * a0 + a1 * a1) + (a2 * a2 + a3 * a3) + (a4 * a4 + a5 * a5) + (a6 * a6 + a7 * a7); }
            const bf16x8 ah = __builtin_bit_cast(bf16x8, xw);
#pragma unroll
            for (int n = 0; n < 2; ++n) { const bf16x8 bh = *(const LAS bf16x8*)(WH + (l15 + 16 * n) * RW_LD + 32 * s + 8 * q), bl = *(const LAS bf16x8*)(WL + (l15 + 16 * n) * RW_LD + 32 * s + 8 * q);
                acc[n] = __builtin_amdgcn_mfma_f32_16x16x32_bf16(ah, bh, acc[n], 0, 0, 0); acc[n] = __builtin_amdgcn_mfma_f32_16x16x32_bf16(ah, bl, acc[n], 0, 0, 0); }
        }
        ss += __shfl_xor(ss, 16); ss += __shfl_xor(ss, 32);
        const float rinv_l = rsqrtf(ss * (1.f / 1024.f) + 1e-6f);
#pragma unroll
        for (int r = 0; r < 4; ++r) {
            const float ri = __shfl(rinv_l, 4 * q + r);
            float v0 = acc[0][r] * ri + b0, v1 = acc[1][r] * ri + b1; int se[4]; float sv[4];
#pragma unroll
            for (int k = 0; k < 4; ++k) { float bv = (v1 > v0) ? v1 : v0; int be = (v1 > v0) ? (l15 + 16) : l15;
#pragma unroll
                for (int off = 1; off < 16; off <<= 1) { const float ov = __shfl_xor(bv, off); const int oe = __shfl_xor(be, off); const bool take = (ov > bv) || (ov == bv && oe < be); bv = take ? ov : bv; be = take ? oe : be; }
                se[k] = be; sv[k] = bv; if (be == l15) v0 = -INFINITY; if (be == l15 + 16) v1 = -INFINITY; }
            if (l15 == r) { const int tok = tok0 + 4 * q + r;
                const float w1 = __expf(sv[1] - sv[0]), w2 = __expf(sv[2] - sv[0]), w3 = __expf(sv[3] - sv[0]); const float inv = 1.0f / (1.0f + w1 + w2 + w3);
                *(int4*)(TOPE + (size_t)tok * 4) = make_int4(se[0], se[1], se[2], se[3]);
                *(float4*)(TOPG + (size_t)tok * 4) = make_float4(inv, w1 * inv, w2 * inv, w3 * inv);
                atomicAdd((unsigned*)(hcnt + se[0]), 1u); atomicAdd((unsigned*)(hcnt + se[1]), 1u); atomicAdd((unsigned*)(hcnt + se[2]), 1u); atomicAdd((unsigned*)(hcnt + se[3]), 1u); }
        }
        const f32x4* gr = (const f32x4*)gnorm + lane;
#pragma unroll 4
        for (int i = 0; i < 16; ++i) { const float ri = __shfl(rinv_l, i); const u32x2* xr = (const u32x2*)(X1 + (size_t)(tok0 + i) * 1024) + lane; unsigned* o4 = (unsigned*)(H2 + (size_t)(tok0 + i) * 1024) + lane;
#pragma unroll
            for (int j = 0; j < 4; ++j) { const u32x2 v = xr[64 * j]; const f32x4 gg = gr[64 * j]; o4[64 * j] = pk4_fp8(lo16(v.x) * ri * gg.x, hi16(v.x) * ri * gg.y, lo16(v.y) * ri * gg.z, hi16(v.y) * ri * gg.w); } }
        __syncthreads();
        if (cx.tid < 32) HIST[tb * 32 + cx.tid] = hcnt[cx.tid];
        __syncthreads();
    }
}

constexpr int PL_BASE = 1280, PL_WCNT = 1312;
__device__ __forceinline__ void moe_plan(const Ctx& cx, const unsigned* HIST) {
    LAS int* PL = (LAS int*)(cx.lds + LDS_PLAN);
    const int e = cx.tid & 31, part = cx.tid >> 5;
    { int s = 0; for (int w = 16 * part; w < 16 * part + 16; ++w) s += (int)HIST[w * 32 + e]; PL[PL_TMP + part * 32 + e] = s; }
    __syncthreads();
    if (cx.tid < 32) { int c = 0; for (int p = 0; p < 16; ++p) c += PL[PL_TMP + p * 32 + cx.tid]; PL[PL_CNT + cx.tid] = c; }
    __syncthreads();
    if (cx.tid == 0) {
        int ps = 0;
        for (int x = 0; x < 32; ++x) { PL[PL_PSTART + x] = ps; const int pad = (PL[PL_CNT + x] + 255) & ~255; for (int i = 0; i < pad / 256; ++i) PL[PL_TILEE + ps / 256 + i] = x; ps += pad; }
        PL[PL_PSTART + 32] = ps;
        int np = 0, e0 = 0;
        while (e0 < 32 && np < 7) { PL[PL_PE0 + np] = e0; PL[PL_PROW0 + np] = PL[PL_PSTART + e0]; int rows = 0, e1 = e0;
            while (e1 < 32 && e1 - e0 < MAXEPP) { const int pad = PL[PL_PSTART + e1 + 1] - PL[PL_PSTART + e1]; if (rows + pad > RMAX && e1 > e0) break; rows += pad; ++e1; }
            e0 = e1; ++np; }
        PL[PL_PE0 + np] = 32; PL[PL_PROW0 + np] = ps; PL[PL_NPASS] = np;
    }
    __syncthreads();
}
__device__ __forceinline__ void dispatch_phase(const Ctx& cx, const unsigned* HIST, const int* TOPE, int* SLOTTOK, int* TOKSLOT) {
    LAS int* PL = (LAS int*)(cx.lds + LDS_PLAN);
    const int e5 = cx.tid & 31, part = cx.tid >> 5, lane = cx.lane;
    for (int tb = cx.wg; tb < 256; tb += cx.G) {
        { int s = 0; for (int w = 16 * part; w < 16 * part + 16; ++w) s += (w < tb) ? (int)HIST[w * 32 + e5] : 0; PL[PL_TMP + part * 32 + e5] = s; }
        const int tok = tb * 128 + (cx.tid >> 2), k = cx.tid & 3; const int e = TOPE[(size_t)tok * 4 + k];
        int rank = 0;
        for (int ee = 0; ee < 32; ++ee) { const unsigned long long mask = __ballot(e == ee); if (e == ee) rank = __popcll(mask & ((1ull << lane) - 1ull)); if (lane == 0) PL[PL_WCNT + cx.wave * 32 + ee] = __popcll(mask); }
        __syncthreads();
        if (cx.tid < 32) { int c = 0; for (int p = 0; p < 16; ++p) c += PL[PL_TMP + p * 32 + cx.tid]; PL[PL_BASE + cx.tid] = c; }
        __syncthreads();
        int off = 0; for (int w2 = 0; w2 < 8; ++w2) off += (w2 < cx.wave) ? PL[PL_WCNT + w2 * 32 + e] : 0;
        const int slot = PL[PL_PSTART + e] + PL[PL_BASE + e] + off + rank;
        SLOTTOK[slot] = tok; TOKSLOT[(size_t)tok * 4 + k] = slot;
        __syncthreads();
    }
    for (int e = cx.wg; e < 32; e += cx.G) { const int c = PL[PL_CNT + e], ps = PL[PL_PSTART + e], pe = PL[PL_PSTART + e + 1]; for (int r = ps + c + cx.tid; r < pe; r += NTHR) SLOTTOK[r] = 0; }
}
__device__ __forceinline__ void convert_pass(const Ctx& cx, int e0, int e1, const float* wg, const float* wu, const float* wd, unsigned char* WGU, unsigned char* WDN) {
    LAS float* scr = (LAS float*)(cx.lds + cx.wave * 16640);
    const int nitems = (e1 - e0) * 768;
#define CV_SRC(it_) ((((it_) % 768) >> 8) == 2 ? wd : ((((it_) % 768) >> 8) ? wu : wg)) + (size_t)(e0 + (it_) / 768) * 1048576
    int it = cx.gw; if (it >= nitems) return;
    F8Item cur; f8_issue(CV_SRC(it), 1024, 64 * (((it % 768) & 255) >> 4), 64 * ((it % 768) & 15), cx.lane, cur);
    for (;;) {
        const int nx = it + cx.NGW; const bool has = nx < nitems;
        F8Item nxt;
        if (has) f8_issue(CV_SRC(nx), 1024, 64 * (((nx % 768) & 255) >> 4), 64 * ((nx % 768) & 15), cx.lane, nxt);
        const int le = it / 768, r = it % 768, mat = r >> 8, kb = (r & 255) >> 4, nb = r & 15, n0 = 64 * nb;
        if (mat == 2) f8_finish(cur, WDN + (size_t)le * 1048576 + (size_t)n0 * 1024 + 64 * kb, 1024, 32.0f, scr, cx.lane);
        else { const int drow = (n0 >> 7) * 256 + (n0 & 127) + mat * 128; f8_finish(cur, WGU + (size_t)le * 2097152 + (size_t)drow * 1024 + 64 * kb, 1024, 32.0f, scr, cx.lane); }
        if (!has) break;
        it = nx;
#pragma unroll
        for (int i = 0; i < 16; ++i) cur.v[i] = nxt.v[i];
    }
#undef CV_SRC
}
__device__ __forceinline__ void combine_all(const Ctx& cx, const float* TOPG, const int* TOKSLOT, const unsigned char* Y, bf16* X, const float* gnorm, unsigned char* H3) {
    const int lane = cx.lane, step = cx.NGW;
    int tok = cx.gw; if (tok >= M) return;
    int4 sl = *(const int4*)(TOKSLOT + (size_t)tok * 4); float4 gs = *(const float4*)(TOPG + (size_t)tok * 4);
    u32x2 xw[4]; unsigned yw[4][4];
#define CMB_ISSUE(T, SL, XW, YW) do { const u32x2* xr_ = (const u32x2*)(X + (size_t)(T) * 1024) + lane; const int s_[4] = {SL.x, SL.y, SL.z, SL.w}; \
        _Pragma("unroll") for (int j = 0; j < 4; ++j) XW[j] = xr_[64 * j]; \
        _Pragma("unroll") for (int k = 0; k < 4; ++k) { const unsigned* yr_ = (const unsigned*)(Y + (size_t)s_[k] * 1024) + lane; _Pragma("unroll") for (int j = 0; j < 4; ++j) YW[k][j] = yr_[64 * j]; } } while (0)
    CMB_ISSUE(tok, sl, xw, yw);
    int4 sl1 = sl; float4 gs1 = gs; { const int t1 = tok + step; if (t1 < M) { sl1 = *(const int4*)(TOKSLOT + (size_t)t1 * 4); gs1 = *(const float4*)(TOPG + (size_t)t1 * 4); } }
    const f32x4* gr = (const f32x4*)gnorm + lane;
    for (;;) {
        const int t1 = tok + step, t2 = tok + 2 * step; const bool has1 = t1 < M;
        u32x2 nxw[4]; unsigned nyw[4][4];
        if (has1) CMB_ISSUE(t1, sl1, nxw, nyw);
        int4 sl2 = sl1; float4 gs2 = gs1; if (t2 < M) { sl2 = *(const int4*)(TOKSLOT + (size_t)t2 * 4); gs2 = *(const float4*)(TOPG + (size_t)t2 * 4); }
        f32x4 v[4]; const float gk[4] = {gs.x, gs.y, gs.z, gs.w};
#pragma unroll
        for (int j = 0; j < 4; ++j) v[j] = (f32x4){lo16(xw[j].x), hi16(xw[j].x), lo16(xw[j].y), hi16(xw[j].y)};
#pragma unroll
        for (int k = 0; k < 4; ++k)
#pragma unroll
            for (int j = 0; j < 4; ++j) v[j] += up4_fp8(yw[k][j]) * gk[k];
        u32x2* xo = (u32x2*)(X + (size_t)tok * 1024) + lane; float s = 0.f;
#pragma unroll
        for (int j = 0; j < 4; ++j) { u32x2 w; w.x = pk2(v[j].x, v[j].y); w.y = pk2(v[j].z, v[j].w); xo[64 * j] = w; s += (v[j].x * v[j].x + v[j].y * v[j].y) + (v[j].z * v[j].z + v[j].w * v[j].w); }
        const float rinv = rsqrtf(wave_sum(s) * (1.f / 1024.f) + 1e-6f); unsigned* o8 = (unsigned*)(H3 + (size_t)tok * 1024) + lane;
#pragma unroll
        for (int j = 0; j < 4; ++j) { const f32x4 gq = gr[64 * j]; o8[64 * j] = pk4_fp8(v[j].x * rinv * gq.x, v[j].y * rinv * gq.y, v[j].z * rinv * gq.z, v[j].w * rinv * gq.w); }
        if (!has1) break;
        tok = t1; gs = gs1; sl1 = sl2; gs1 = gs2;
#pragma unroll
        for (int j = 0; j < 4; ++j) { xw[j] = nxw[j];
#pragma unroll
            for (int k = 0; k < 4; ++k) yw[k][j] = nyw[k][j]; }
    }
#undef CMB_ISSUE
}
template <bool LAST>
__device__ __forceinline__ void combine_pass(const Ctx& cx, int e0, int e1, int row0, const int* TOPE, const float* TOPG, const int* TOKSLOT, const unsigned char* Y, bf16* X, const float* gnorm, unsigned char* H3) {
    for (int tok = cx.gw; tok < M; tok += cx.NGW) {
        const int4 es = *(const int4*)(TOPE + (size_t)tok * 4); const float4 gs = *(const float4*)(TOPG + (size_t)tok * 4); const int4 sl = *(const int4*)(TOKSLOT + (size_t)tok * 4);
        const int ee[4] = {es.x, es.y, es.z, es.w}; const float gg[4] = {gs.x, gs.y, gs.z, gs.w}; const int ss[4] = {sl.x, sl.y, sl.z, sl.w};
        bool any = false;
#pragma unroll
        for (int k = 0; k < 4; ++k) any |= (ee[k] >= e0 && ee[k] < e1);
        if (!LAST && !any) continue;
        u32x2* xr = (u32x2*)(X + (size_t)tok * 1024) + cx.lane; f32x4 v[4];
#pragma unroll
        for (int j = 0; j < 4; ++j) { const u32x2 w = xr[64 * j]; v[j] = (f32x4){lo16(w.x), hi16(w.x), lo16(w.y), hi16(w.y)}; }
#pragma unroll
        for (int k = 0; k < 4; ++k) if (ee[k] >= e0 && ee[k] < e1) { const unsigned* yr = (const unsigned*)(Y + (size_t)(ss[k] - row0) * 1024) + cx.lane; const float g = gg[k];
#pragma unroll
            for (int j = 0; j < 4; ++j) v[j] += up4_fp8(yr[64 * j]) * g; }
        if (any) {
#pragma unroll
            for (int j = 0; j < 4; ++j) { u32x2 w; w.x = pk2(v[j].x, v[j].y); w.y = pk2(v[j].z, v[j].w); xr[64 * j] = w; }
        }
        if (LAST) { float s = 0.f;
#pragma unroll
            for (int j = 0; j < 4; ++j) s += (v[j].x * v[j].x + v[j].y * v[j].y) + (v[j].z * v[j].z + v[j].w * v[j].w);
            const float rinv = rsqrtf(wave_sum(s) * (1.f / 1024.f) + 1e-6f); const f32x4* gr = (const f32x4*)gnorm + cx.lane; unsigned* o8 = (unsigned*)(H3 + (size_t)tok * 1024) + cx.lane;
#pragma unroll
            for (int j = 0; j < 4; ++j) { const f32x4 gq = gr[64 * j]; o8[64 * j] = pk4_fp8(v[j].x * rinv * gq.x, v[j].y * rinv * gq.y, v[j].z * rinv * gq.z, v[j].w * rinv * gq.w); } }
    }
}

#define HBUF ((bf16*)(ws + WS_R1))
#define RKV ((bf16*)(ws + WS_RKV))
#define WAG ((bf16*)(ws + WS_WAG))
#define AG ((bf16*)(ws + WS_AG))
#define UB ((bf16*)(ws + WS_U))
#define LP ((bf16*)(ws + WS_LP))
#define LACT ((bf16*)(ws + WS_LACT))
#define Y1 ((bf16*)(ws + WS_Y1))
#define MIX ((bf16*)(ws + WS_R1))
#define EBUF ((float*)(ws + WS_LP))
#define S0G ((bf16*)(ws + WS_LP))
#define QCT ((bf16*)(ws + WS_U))
#define HCT ((float*)(ws + WS_R1))
#define W1G ((bf16*)(ws + WS_W1))
#define ULG ((bf16*)(ws + WS_ULOC))
#define DLG ((float*)(ws + WS_DL))
#define ATG ((float*)(ws + WS_AT))
#define WCAT ((bf16*)(ws + WS_WCAT))
#define WL2 ((bf16*)(ws + WS_WL2))
#define WGLU ((bf16*)(ws + WS_WGLU))
#define WPP ((bf16*)(ws + WS_WPP))
#define WOUT ((bf16*)(ws + WS_WOUT))
#define WPG ((unsigned char*)(ws + WS_WPG))
#define S5BT ((bf16*)(ws + WS_S5BT))
#define S5ET ((bf16*)(ws + WS_S5ET))
#define PBF ((bf16*)(ws + WS_PBF))
#define H2 ((unsigned char*)(ws + WS_H2))
#define WGU ((unsigned char*)(ws + WS_WGU))
#define WDN ((unsigned char*)(ws + WS_WDN))
#define ACT ((unsigned char*)(ws + WS_ACT))
#define YB ((unsigned char*)(ws + WS_Y))
#define XB ((bf16*)(ws + WS_XB))
#define PP ((bf16*)(ws + WS_ACT))
#define HIST ((unsigned*)(ws + WS_HIST))
#define TOPE ((int*)(ws + WS_TOPE))
#define TOPG ((float*)(ws + WS_TOPG))
#define TOKSLOT ((int*)(ws + WS_TOKSLOT))
#define SLOTTOK ((int*)(ws + WS_SLOTTOK))
#ifndef FUSE_FNORM
#define FUSE_FNORM 1
#endif
#ifndef SPLIT_P5
#define SPLIT_P5 1
#endif
#ifndef MOE_SP2
#define MOE_SP2 true
#endif
#ifndef MOE_ALIGN
#define MOE_ALIGN true
#endif
#ifndef PROBE_PH
#define PROBE_PH -1
#endif
#ifndef PROBE_N
#define PROBE_N 2
#endif
#define REPS(k) ((((k) >= 10 && (k) < 28) ? 10 + ((k) - 10) % 3 : (k)) == PROBE_PH ? PROBE_N : 1)
#ifndef ONLY_PHASE
#define ONLY_PHASE -1
#endif
constexpr int NPH = 31;
struct Args { const float* in[42]; float* out; unsigned char* ws; int ph_lo, ph_hi; };

__global__ void __launch_bounds__(NTHR, 2) mk_fwd(Args args) {
    extern __shared__ __attribute__((aligned(16))) unsigned char lds_raw[];
    LAS unsigned char* lds = (LAS unsigned char*)lds_raw;
#define CAS __attribute__((address_space(4)))
#define FRESH_CX const CAS char* ka_ = (const CAS char*)__builtin_amdgcn_kernarg_segment_ptr(); asm volatile("" : "+s"(ka_)); const float* const CAS* I = (const float* const CAS*)ka_; unsigned char* ws = *(unsigned char* const CAS*)(ka_ + 344); float* OUTP = *(float* const CAS*)(ka_ + 336); (void)I; (void)ws; (void)OUTP; \
    Ctx cx; { int t_ = threadIdx.x; asm volatile("" : "+v"(t_)); cx.lds = lds; cx.tid = t_; cx.lane = t_ & 63; cx.wave = __builtin_amdgcn_readfirstlane(t_ >> 6); cx.G = gridDim.x; cx.wg = blockIdx.x; cx.gw = cx.wg * NWAVES + cx.wave; cx.NGW = cx.G * NWAVES; }
    unsigned char* ws = args.ws;
    const int lo = args.ph_lo, hi = args.ph_hi;
    volatile LAS unsigned* MISC = (volatile LAS unsigned*)(lds + LDS_MISC);
    if (threadIdx.x < 64) MISC[threadIdx.x] = 0u;
    __syncthreads();
    XcdBarrier bar; bar.bar = (unsigned*)(ws + WS_CTL) + CW_BAR; bar.x = 0; bar.st = nullptr;
    if (hi - lo > 1) bar = xcd_barrier_post((unsigned*)(ws + WS_CTL) + CW_BAR, MISC + 8);

#define IN(k) ((ONLY_PHASE < 0 || ONLY_PHASE == (k) || (ONLY_PHASE >= 10 && ONLY_PHASE < 28 && (k) >= 10 && (k) < 28 && ((k) - 10) % 3 == (ONLY_PHASE - 10) % 3)) && lo <= (k) && (k) < hi)
#ifndef PROBE_BAR
#define PROBE_BAR 1
#endif
#ifndef PROBE_T
#define PROBE_T -1
#endif
#define STAMP() do { if (PROBE_T >= 0 && blockIdx.x == 0 && threadIdx.x == 0) { const unsigned long long t_ = __builtin_amdgcn_s_memrealtime(); MISC[16 + 2 * nst] = (unsigned)t_; MISC[17 + 2 * nst] = (unsigned)(t_ >> 32); } ++nst; } while (0)
#define SEAM(k) do { if (IN(k) && IN((k) + 1)) { for (int b_ = 0; b_ < PROBE_BAR; ++b_) xcd_barrier(bar); STAMP(); } } while (0)
    int nst = 0; STAMP();
#define MAKE_RP RwkvP RP; RP.rkv = RKV; RP.wag = WAG; RP.mu_rkv = I[13]; RP.w0 = I[15]; RP.a0 = I[18]; RP.k_k = I[23]; RP.k_a = I[24]; RP.r_k = I[25]; RP.ln_w = I[26]; RP.ln_b = I[27]
#define OPQ(v) ({ int _k = (v); asm volatile("" : "+s"(_k)); _k; })

    if (IN(0)) for (int rep_ = 0; rep_ < REPS(0); ++rep_) {
        FRESH_CX;
        for (int it = cx.wg; it < 256; it += cx.G) s5_tables_item(cx, it >> 3, it & 7, I[4], I[5], I[6], I[7], I[8], I[9], I[10], S5BT, S5ET, ATG);
        const float* mu = I[14];
        transpose_matrix(cx, I[3], 1024, 2048, WCAT, 0, 1024, 0, nullptr, 0);
        transpose_matrix(cx, I[16], 1024, 64, WCAT, 2048, 1024, 0, mu, 1);          transpose_matrix(cx, I[16], 1024, 64, WCAT, 2304, 1024, 0, mu, 0);
        transpose_matrix(cx, I[19], 1024, 64, WCAT, 2112, 1024, 0, mu + 1024, 1);   transpose_matrix(cx, I[19], 1024, 64, WCAT, 2368, 1024, 0, mu + 1024, 0);
        transpose_matrix(cx, I[21], 1024, 128, WCAT, 2176, 1024, 0, mu + 2048, 1);  transpose_matrix(cx, I[21], 1024, 128, WCAT, 2432, 1024, 0, mu + 2048, 0);
        transpose_matrix(cx, I[17], 64, 512, WL2, 0, 256, 0, nullptr, 0);
        transpose_matrix(cx, I[20], 64, 512, WL2, 512, 256, 64, nullptr, 0);
        transpose_matrix(cx, I[22], 128, 512, WL2, 1024, 256, 128, nullptr, 0);
        for (int idx = cx.wg * NTHR + cx.tid; idx < 1536 * 32; idx += cx.G * NTHR) { const int row = idx >> 5, ch = idx & 31, blk = row >> 9; const int kb = blk == 0 ? 0 : (blk == 1 ? 64 : 128), ke = blk == 0 ? 64 : (blk == 1 ? 128 : 256);
            if (ch * 8 < kb || ch * 8 >= ke) *(u32x4*)(WL2 + (size_t)row * 256 + ch * 8) = (u32x4){0u, 0u, 0u, 0u}; }
        transpose_matrix(cx, I[12], 512, 512, WGLU, 0, 512, 0, nullptr, 0);
        transpose_matrix(cx, I[39], 256, 1024, WPP, 0, 256, 0, nullptr, 0);
        transpose_matrix(cx, I[28], 1024, 1024, WOUT, 0, 1024, 0, nullptr, 0);
        { LAS float* scr = (LAS float*)(cx.lds + cx.wave * 16640);
          for (int it = cx.gw; it < 256; it += cx.NGW) { const int kb = it >> 4, nb = it & 15;
              transpose_item_fp8(I[40], 1024, 64 * kb, 64 * nb, WPG + (size_t)(64 * nb) * 1024 + 64 * kb, 1024, 32.0f, scr, cx.lane); } }
        for (int m = 2 * cx.gw; m < M; m += 2 * cx.NGW) rms_rows2_to_bf16(I[0] + (size_t)m * 1024, I[0] + (size_t)(m + 1) * 1024, I[2], HBUF + (size_t)m * 1024, HBUF + (size_t)(m + 1) * 1024, cx.lane);
        for (int m = 4 * cx.gw; m < M; m += 4 * cx.NGW) { f32x4 v[4];
#pragma unroll
            for (int r = 0; r < 4; ++r) v[r] = __builtin_nontemporal_load((const f32x4*)(I[1] + (size_t)(m + r) * 256) + cx.lane);
#pragma unroll
            for (int r = 0; r < 4; ++r) { u32x2 w; w.x = pk2(v[r].x, v[r].y); w.y = pk2(v[r].z, v[r].w); *((u32x2*)(PBF + (size_t)(m + r) * 256) + cx.lane) = w; } }
    }
    SEAM(0);
    if (IN(1)) for (int rep_ = 0; rep_ < REPS(1); ++rep_) {
        FRESH_CX;
        SchedPlain S; S.init(128, 10, cx.G, cx.wg); S.A = (const char*)HBUF; S.B = (const char*)WCAT; S.a_tile = 256 * 1024 * 2; S.b_tile = 256 * 1024 * 2;
        EpiProj E{AG, RKV, LP};
        pg8::gemm_phase<EpiProj, SchedPlain, true, true, false>(lds, cx.tid, OPQ(1024), OPQ(1024), OPQ(1024), S, E);
    }
    SEAM(1);
    if (IN(2)) for (int rep_ = 0; rep_ < REPS(2); ++rep_) {
        FRESH_CX;
        for (int m = 2 * cx.gw; m < M; m += 2 * cx.NGW) {
            const int lane = cx.lane; const bool first = (m & (SEQ - 1)) == 0;
            const u32x2 a0 = *((const u32x2*)(LP + (size_t)m * 512) + lane), a1 = *((const u32x2*)(LP + (size_t)(m + 1) * 512) + lane), b1 = *((const u32x2*)(LP + (size_t)m * 512 + 256) + lane);
            u32x2 b0 = (u32x2){0u, 0u}; if (!first) b0 = *((const u32x2*)(LP + (size_t)(m - 1) * 512 + 256) + lane);
            float v[8] = {lo16(a0.x) + lo16(b0.x), hi16(a0.x) + hi16(b0.x), lo16(a0.y) + lo16(b0.y), hi16(a0.y) + hi16(b0.y), lo16(a1.x) + lo16(b1.x), hi16(a1.x) + hi16(b1.x), lo16(a1.y) + lo16(b1.y), hi16(a1.y) + hi16(b1.y)};
#pragma unroll
            for (int i = 0; i < 8; ++i) v[i] = lane < 16 ? ftanh(v[i]) : (lane < 32 ? v[i] : fsigmoid(v[i]));
            u32x2 o; o.x = pk2(v[0], v[1]); o.y = pk2(v[2], v[3]); *((u32x2*)(LACT + (size_t)m * 256) + lane) = o;
            o.x = pk2(v[4], v[5]); o.y = pk2(v[6], v[7]); *((u32x2*)(LACT + (size_t)(m + 1) * 256) + lane) = o;
        }
    }
    SEAM(2);
    if (IN(3)) for (int rep_ = 0; rep_ < REPS(3); ++rep_) {
        FRESH_CX;
        { SchedPlain S; S.init(128, 6, cx.G, cx.wg); S.A = (const char*)LACT; S.B = (const char*)WL2; S.a_tile = 256 * 256 * 2; S.b_tile = 256 * 256 * 2;
          EpiBf16Plain E{WAG, 1536};
          pg8::gemm_phase<EpiBf16Plain, SchedPlain, true, true, false>(lds, cx.tid, OPQ(256), OPQ(256), OPQ(256), S, E); }
        { SchedS5 S; S.init(128, 1, cx.G, cx.wg); S.A = (const char*)AG; S.B = (const char*)S5ET; S.a_tile = 256 * 640 * 2; S.b_tile = 0; S.b_group = 256 * 512 * 2;
          EpiF32 E{EBUF, 256};
          pg8::gemm_phase<EpiF32, SchedS5, true, true, false>(lds, cx.tid, OPQ(512), OPQ(640), OPQ(512), S, E); }
    }
    SEAM(3);
    if (IN(4)) for (int rep_ = 0; rep_ < REPS(4); ++rep_) {
        FRESH_CX;
        for (int base = cx.wg * 32; base < 8192; base += cx.G * 32) { const int idx = base + (cx.lane & 31), b = idx >> 11, g = (idx >> 6) & 31, p = idx & 63, w8 = cx.wave;
            LAS float* CE = (LAS float*)lds;
            const float ar = ATG[(g * 64 + p) * 2], ai = ATG[(g * 64 + p) * 2 + 1];
            const size_t row0 = (size_t)g * 1024 + b * 256 + 32 * w8;
            float er[32], ei[32];
            if (cx.lane < 32) {
#pragma unroll
                for (int k = 0; k < 32; ++k) { er[k] = EBUF[(row0 + k) * 256 + p]; ei[k] = EBUF[(row0 + k) * 256 + 64 + p]; }
                float sr = 0.f, si = 0.f;
#pragma unroll
                for (int k = 0; k < 32; ++k) { const float nr = ar * sr - ai * si + er[k], ni = ar * si + ai * sr + ei[k]; sr = nr; si = ni; }
                CE[(w8 * 32 + cx.lane) * 2] = sr; CE[(w8 * 32 + cx.lane) * 2 + 1] = si; }
            __syncthreads();
            if (cx.lane < 32) {
                float pr = 1.f, pi = 0.f;
                { float qr = ar, qi = ai;
#pragma unroll
                  for (int i = 0; i < 5; ++i) { const float tr_ = qr * qr - qi * qi, ti_ = 2.f * qr * qi; qr = tr_; qi = ti_; } pr = qr; pi = qi; }
                float cr = 0.f, ci = 0.f;
                for (int w2 = 0; w2 < w8; ++w2) { const float e0 = CE[(w2 * 32 + cx.lane) * 2], e1 = CE[(w2 * 32 + cx.lane) * 2 + 1]; const float nr = pr * cr - pi * ci + e0, ni = pr * ci + pi * cr + e1; cr = nr; ci = ni; }
                float sr = cr, si = ci;
#pragma unroll
                for (int k = 0; k < 32; ++k) { bf16* d = AG + (row0 + k) * 640 + 512 + p; d[0] = (bf16)(pk2(sr, 0.f) & 0xffffu); d[64] = (bf16)(pk2(si, 0.f) & 0xffffu);
                    const float nr = ar * sr - ai * si + er[k], ni = ar * si + ai * sr + ei[k]; sr = nr; si = ni; } }
            __syncthreads();
        }
        MAKE_RP;
        for (int grp = cx.wg; grp < 256; grp += cx.G) rwkv_pass1(lds, RP, grp * 16, 16, cx.tid, QCT, HCT, W1G, ULG, DLG, (float*)(ws + WS_TOKSLOT));
    }
    SEAM(4);
    if (IN(5)) for (int rep_ = 0; rep_ < REPS(5); ++rep_) {
        FRESH_CX;
        if (SPLIT_P5 && cx.G == 256) {
            if (cx.wg < 128) { if (cx.wave == 0) rwkv_pass2(lds, cx.wg >> 2, cx.wg & 3, cx.lane, QCT, HCT, DLG, S0G); }
            else { SchedS5 S; S.init(128, 2, 128, cx.wg - 128); S.A = (const char*)AG; S.B = (const char*)S5BT; S.a_tile = 256 * 640 * 2; S.b_tile = 256 * 640 * 2; S.b_group = 512 * 640 * 2;
                EpiS5Y E{AG, I[11], Y1};
                pg8::gemm_phase<EpiS5Y, SchedS5, true, true, false>(lds, cx.tid, OPQ(640), OPQ(640), OPQ(640), S, E); }
        } else {
            { SchedS5 S; S.init(128, 2, cx.G, cx.wg); S.A = (const char*)AG; S.B = (const char*)S5BT; S.a_tile = 256 * 640 * 2; S.b_tile = 256 * 640 * 2; S.b_group = 512 * 640 * 2;
              EpiS5Y E{AG, I[11], Y1};
              pg8::gemm_phase<EpiS5Y, SchedS5, true, true, false>(lds, cx.tid, OPQ(640), OPQ(640), OPQ(640), S, E); }
            if (cx.wave == 0) for (int it = cx.wg; it < 128; it += cx.G) rwkv_pass2(lds, it >> 2, it & 3, cx.lane, QCT, HCT, DLG, S0G);
        }
    }
    SEAM(5);
    if (IN(6)) for (int rep_ = 0; rep_ < REPS(6); ++rep_) {
        FRESH_CX;
        MAKE_RP;
        for (int grp = cx.wg; grp < 256; grp += cx.G) rwkv_pass3(lds, RP, grp * 16, 16, cx.tid, S0G, W1G, ULG, (const float*)(ws + WS_TOKSLOT), MIX);
        __syncthreads();
        { SchedPlain S; S.init(128, 2, cx.G, cx.wg); S.A = (const char*)Y1; S.B = (const char*)WGLU; S.a_tile = 256 * 512 * 2; S.b_tile = 256 * 512 * 2;
          EpiGlu E{Y1, MIX};
          pg8::gemm_phase<EpiGlu, SchedPlain, true, true, false>(lds, cx.tid, OPQ(512), OPQ(512), OPQ(512), S, E); }
    }
    SEAM(6);
    if (IN(7)) for (int rep_ = 0; rep_ < REPS(7); ++rep_) {
        FRESH_CX;
        SchedPlain S; S.init(128, 4, cx.G, cx.wg); S.A = (const char*)MIX; S.B = (const char*)WOUT; S.a_tile = 256 * 1024 * 2; S.b_tile = 256 * 1024 * 2;
        EpiResid E{I[0], XB};
        pg8::gemm_phase<EpiResid, SchedPlain, true, true, false>(lds, cx.tid, OPQ(1024), OPQ(1024), OPQ(1024), S, E);
    }
    SEAM(7);
    if (IN(8)) for (int rep_ = 0; rep_ < REPS(8); ++rep_) { FRESH_CX; router_phase(cx, XB, I[29], I[30], I[31], H2, TOPE, TOPG, HIST); }
    SEAM(8);
    LAS int* PL = (LAS int*)(lds + LDS_PLAN);
    if (hi > 9 && lo < 28) { FRESH_CX; __syncthreads(); moe_plan(cx, HIST); }
    const int npass = (hi > 9 && lo < 28) ? PL[PL_NPASS] : 0;
    if (IN(9)) for (int rep_ = 0; rep_ < REPS(9); ++rep_) { FRESH_CX; dispatch_phase(cx, HIST, TOPE, SLOTTOK, TOKSLOT); convert_pass(cx, PL[PL_PE0], PL[PL_PE0 + 1], I[32], I[34], I[36], WGU, WDN); }
    SEAM(9);
    for (int p = 0; p < 6; ++p) {
        const bool actv = p < npass;
        const int e0 = actv ? PL[PL_PE0 + p] : 0, e1 = actv ? PL[PL_PE0 + p + 1] : 0, row0 = actv ? PL[PL_PROW0 + p] : 0, rows = actv ? PL[PL_PROW0 + p + 1] - row0 : 0;
        if (IN(10 + 3 * p) && actv) for (int rep_ = 0; rep_ < REPS(10); ++rep_) {
            FRESH_CX;
            SchedMoe<true> S; S.init(rows / 256, 8, cx.G, cx.wg); S.A = (const char*)H2; S.B = (const char*)WGU; S.a_tile = 0; S.b_tile = 256 * 1024; S.b_exp = (size_t)2048 * 1024; S.tile_e = PL + PL_TILEE; S.tile0 = row0 / 256; S.e0 = e0; S.slot_tok = SLOTTOK; S.row0 = row0;
            EpiGU E{ACT, I[33], I[35]};
            pg8::gemm_phase<EpiGU, SchedMoe<true>, MOE_ALIGN, MOE_SP2, true, true>(lds, cx.tid, OPQ(512), OPQ(512), OPQ(512), S, E);
        }
        if (actv) SEAM(10 + 3 * p);
        if (IN(11 + 3 * p) && actv) for (int rep_ = 0; rep_ < REPS(11); ++rep_) {
            FRESH_CX;
            SchedMoe<false> S; S.init(rows / 256, 4, cx.G, cx.wg); S.A = (const char*)ACT; S.B = (const char*)WDN; S.a_tile = 256 * 1024; S.b_tile = 256 * 1024; S.b_exp = (size_t)1024 * 1024; S.tile_e = PL + PL_TILEE; S.tile0 = row0 / 256; S.e0 = e0; S.slot_tok = SLOTTOK; S.row0 = row0;
            EpiDown E{YB, I[37]};
            pg8::gemm_phase<EpiDown, SchedMoe<false>, MOE_ALIGN, MOE_SP2, false, true>(lds, cx.tid, OPQ(512), OPQ(512), OPQ(512), S, E);
        }
        if (actv) SEAM(11 + 3 * p);
        if (IN(12 + 3 * p) && actv) for (int rep_ = 0; rep_ < REPS(12); ++rep_) {
            FRESH_CX;
            if (p + 1 < npass) { combine_pass<false>(cx, e0, e1, row0, TOPE, TOPG, TOKSLOT, YB, XB, nullptr, nullptr); convert_pass(cx, PL[PL_PE0 + p + 1], PL[PL_PE0 + p + 2], I[32], I[34], I[36], WGU, WDN); }
            else {
                if (e0 == 0 && e1 == 32 && row0 == 0) combine_all(cx, TOPG, TOKSLOT, YB, XB, I[38], (unsigned char*)(ws + WS_R1));
                else combine_pass<true>(cx, e0, e1, row0, TOPE, TOPG, TOKSLOT, YB, XB, I[38], (unsigned char*)(ws + WS_R1));
                SchedPlain S; S.init(128, 4, cx.G, cx.wg); S.A = (const char*)PBF; S.B = (const char*)WPP; S.a_tile = 256 * 256 * 2; S.b_tile = 256 * 256 * 2;
                EpiBf16Plain E{PP, 1024};
                pg8::gemm_phase<EpiBf16Plain, SchedPlain, true, true, false>(lds, cx.tid, OPQ(256), OPQ(256), OPQ(256), S, E);
            }
        }
        if (actv) SEAM(12 + 3 * p);
    }
    if (IN(29)) for (int rep_ = 0; rep_ < REPS(29); ++rep_) {
        FRESH_CX;
        SchedPlain S; S.init(128, 4, cx.G, cx.wg); S.A = (const char*)(ws + WS_R1); S.B = (const char*)WPG; S.a_tile = 256 * 1024; S.b_tile = 256 * 1024;
        if (FUSE_FNORM && cx.G == 256) { EpiPleNorm E{PP, XB, OUTP, I[41], (float*)(ws + WS_CTL) + CW_ROWSS, (unsigned*)(ws + WS_CTL) + CW_PCNT};
            pg8::gemm_phase<EpiPleNorm, SchedPlain, true, true, false, true>(lds, cx.tid, OPQ(512), OPQ(512), OPQ(512), S, E); }
        else { EpiPle E{PP, XB};
            pg8::gemm_phase<EpiPle, SchedPlain, true, true, false, true>(lds, cx.tid, OPQ(512), OPQ(512), OPQ(512), S, E); }
    }
    SEAM(29);
    if (IN(30) && !(FUSE_FNORM && gridDim.x == 256)) for (int rep_ = 0; rep_ < REPS(30); ++rep_) {
        FRESH_CX;
        for (int m = 2 * cx.gw; m < M; m += 2 * cx.NGW) {
            const u32x2* ia_ = (const u32x2*)(XB + (size_t)m * 1024) + cx.lane; const u32x2* ib_ = ia_ + 256;
            f32x4* xa = (f32x4*)(OUTP + (size_t)m * 1024) + cx.lane; f32x4* xb = xa + 256; const f32x4* gr = (const f32x4*)I[41] + cx.lane; f32x4 va[4], vb[4]; float sa = 0.f, sb = 0.f;
#pragma unroll
            for (int j = 0; j < 4; ++j) { const u32x2 wa = ia_[64 * j], wb = ib_[64 * j]; va[j] = (f32x4){lo16(wa.x), hi16(wa.x), lo16(wa.y), hi16(wa.y)}; vb[j] = (f32x4){lo16(wb.x), hi16(wb.x), lo16(wb.y), hi16(wb.y)}; }
#pragma unroll
            for (int j = 0; j < 4; ++j) { sa += (va[j].x * va[j].x + va[j].y * va[j].y) + (va[j].z * va[j].z + va[j].w * va[j].w); sb += (vb[j].x * vb[j].x + vb[j].y * vb[j].y) + (vb[j].z * vb[j].z + vb[j].w * vb[j].w); }
#pragma unroll
            for (int o = 1; o < 64; o <<= 1) { sa += __shfl_xor(sa, o); sb += __shfl_xor(sb, o); }
            const float ia = rsqrtf(sa * (1.f / 1024.f) + 1e-6f), ib = rsqrtf(sb * (1.f / 1024.f) + 1e-6f);
#pragma unroll
            for (int j = 0; j < 4; ++j) { const f32x4 gg = gr[64 * j]; xa[64 * j] = (f32x4){va[j].x * ia * gg.x, va[j].y * ia * gg.y, va[j].z * ia * gg.z, va[j].w * ia * gg.w}; xb[64 * j] = (f32x4){vb[j].x * ib * gg.x, vb[j].y * ib * gg.y, vb[j].z * ib * gg.z, vb[j].w * ib * gg.w}; }
        }
    }
    if (PROBE_T >= 0 && blockIdx.x == 0 && threadIdx.x == 0) { STAMP(); asm volatile("s_waitcnt vmcnt(0)" ::: "memory");
        const unsigned long long t0_ = ((unsigned long long)MISC[17 + 2 * PROBE_T] << 32) | MISC[16 + 2 * PROBE_T], t1_ = ((unsigned long long)MISC[19 + 2 * PROBE_T] << 32) | MISC[18 + 2 * PROBE_T];
        (*(float* const CAS*)((const CAS char*)__builtin_amdgcn_kernarg_segment_ptr() + 336))[0] = (float)(t1_ - t0_) * 0.01f; }
#undef IN
#undef SEAM
}

extern "C" void kernel_launch(void* const* d_in, const int* in_sizes, int n_in, void* d_out, int out_size, void* d_ws, size_t ws_size, hipStream_t stream) {
    static int grid = 0;
    if (grid == 0) {
        if (n_in != 42 || out_size != M * DM || ws_size < WS_END) { fprintf(stderr, "kernel_launch: unexpected shapes (n_in %d out %d ws %zu)\n", n_in, out_size, ws_size); grid = -1; return; }
        int dev = 0, cus = 0, per_cu = 0;
        if (hipGetDevice(&dev) != hipSuccess || hipDeviceGetAttribute(&cus, hipDeviceAttributeMultiprocessorCount, dev) != hipSuccess) { grid = -1; return; }
        if (hipFuncSetAttribute((const void*)mk_fwd, hipFuncAttributeMaxDynamicSharedMemorySize, LDS_BYTES) != hipSuccess) { fprintf(stderr, "kernel_launch: hipFuncSetAttribute failed\n"); grid = -1; return; }
        if (hipOccupancyMaxActiveBlocksPerMultiprocessor(&per_cu, (const void*)mk_fwd, NTHR, LDS_BYTES) != hipSuccess || per_cu < 1) fprintf(stderr, "kernel_launch: occupancy query says %d\n", per_cu);
        (void)hipGetLastError();
        grid = cus > 256 ? 256 : cus;
    }
    if (grid < 0) return;
    (void)hipMemsetAsync((char*)d_ws + WS_CTL, 0, CTL_ZERO_BYTES, stream);
    Args a{};
    for (int i = 0; i < 42; ++i) a.in[i] = (const float*)d_in[i];
    a.out = (float*)d_out; a.ws = (unsigned char*)d_ws;
#if MK_PER_PHASE
    for (int ph = 0; ph < NPH; ++ph) { a.ph_lo = ph; a.ph_hi = ph + 1; hipLaunchKernelGGL(mk_fwd, dim3(grid), dim3(NTHR), LDS_BYTES, stream, a); }
#else
    a.ph_lo = 0; a.ph_hi = NPH;
    hipLaunchKernelGGL(mk_fwd, dim3(grid), dim3(NTHR), LDS_BYTES, stream, a);
#endif
}
```

```cpp
#include <hip/hip_runtime.h>
#include <cstdio>
#include <cstdint>

#ifndef MK_PER_PHASE
#define MK_PER_PHASE 0
#endif

#define LAS __attribute__((address_space(3)))
#define GAS __attribute__((address_space(1)))
typedef unsigned short bf16;
typedef short bf16x8 __attribute__((ext_vector_type(8)));
typedef float f32x4 __attribute__((ext_vector_type(4)));
typedef float f32x2 __attribute__((ext_vector_type(2)));
typedef unsigned u32x4 __attribute__((ext_vector_type(4)));
typedef unsigned u32x2 __attribute__((ext_vector_type(2)));
typedef GAS unsigned gu32;

constexpr int NB = 4, SEQ = 8192, DM = 1024, M = NB * SEQ;
constexpr int NEXP = 32, TOPK = 4;
constexpr int NWAVES = 8, NTHR = 512;
constexpr size_t MiB = 1u << 20;

constexpr size_t WS_CTL = 0, CTL_ZERO_BYTES = 1 * MiB;
constexpr size_t WS_HIST = 1 * MiB;
constexpr size_t WS_TOPE = 2 * MiB;
constexpr size_t WS_TOPG = 3 * MiB;
constexpr size_t WS_TOKSLOT = 4 * MiB;
constexpr size_t WS_SLOTTOK = 5 * MiB;
constexpr size_t WS_AT = 6 * MiB;
constexpr size_t WS_DL = 6 * MiB + 65536;
constexpr size_t WS_WCAT = 8 * MiB;
constexpr size_t WS_WL2 = 13 * MiB;
constexpr size_t WS_WGLU = 14 * MiB;
constexpr size_t WS_WPP = 14 * MiB + 524288;
constexpr size_t WS_WOUT = 15 * MiB;
constexpr size_t WS_WPG = 17 * MiB;
constexpr size_t WS_S5BT = 19 * MiB;
constexpr size_t WS_S5ET = 39 * MiB;
constexpr size_t WS_PBF = 48 * MiB;
constexpr size_t WS_R1 = 64 * MiB;
constexpr size_t WS_RKV = 128 * MiB;
constexpr size_t WS_WAG = 224 * MiB;
constexpr size_t WS_AG = 320 * MiB;
constexpr size_t WS_U = 360 * MiB;
constexpr size_t WS_LP = 392 * MiB;
constexpr size_t WS_LACT = 424 * MiB;
constexpr size_t WS_W1 = 440 * MiB;
constexpr size_t WS_ULOC = 472 * MiB;
constexpr size_t WS_Y1 = 504 * MiB;
constexpr size_t WS_H2 = 64 * MiB;
constexpr size_t WS_WDN = 96 * MiB;
constexpr size_t WS_ACT = 128 * MiB;
constexpr size_t WS_Y = 264 * MiB;
constexpr size_t WS_XB = 400 * MiB;
constexpr size_t WS_WGU = 264 * MiB;
constexpr int RMAX = 139264;
constexpr int MAXEPP = 32;
constexpr size_t WS_END = 560 * MiB;
static_assert(WS_Y + (size_t)RMAX * 1024 <= WS_XB && WS_XB + (size_t)M * 2048 <= WS_END && WS_ACT + (size_t)RMAX * 1024 <= WS_Y, "moe map");

constexpr int CW_BAR = 4096;
constexpr int CW_ROWSS = 65536;
constexpr int CW_PCNT = 131072;

constexpr int LDS_PLAN = 147456;
constexpr int LDS_MISC = 155648;
constexpr int LDS_BYTES = 156672;
constexpr int PL_CNT = 0, PL_PSTART = 32, PL_NPASS = 72, PL_PE0 = 80, PL_PROW0 = 88, PL_TILEE = 128, PL_TMP = 768;

#define LDS_WAIT() asm volatile("s_waitcnt lgkmcnt(0)" ::: "memory")
#define VM_WAIT() asm volatile("s_waitcnt vmcnt(0)" ::: "memory")
__device__ __forceinline__ float bf2f(unsigned b) { return __uint_as_float(b << 16); }
typedef __bf16 bf16n2 __attribute__((ext_vector_type(2)));
__device__ __forceinline__ unsigned cvt_pk_bf16(float lo, float hi) { const f32x2 f = {lo, hi}; const bf16n2 v = __builtin_convertvector(f, bf16n2); return __builtin_bit_cast(unsigned, v); }
__device__ __forceinline__ unsigned pk2(float lo, float hi) { return cvt_pk_bf16(lo, hi); }
__device__ __forceinline__ float lo16(unsigned w) { return __uint_as_float(w << 16); }
__device__ __forceinline__ float hi16(unsigned w) { return __uint_as_float(w & 0xffff0000u); }
__device__ __forceinline__ unsigned pk4_fp8(float a, float b, float c, float d) { unsigned w = 0u; w = (unsigned)__builtin_amdgcn_cvt_pk_fp8_f32(a, b, (int)w, false); w = (unsigned)__builtin_amdgcn_cvt_pk_fp8_f32(c, d, (int)w, true); return w; }
__device__ __forceinline__ f32x4 up4_fp8(unsigned w) { const f32x2 lo = __builtin_amdgcn_cvt_pk_f32_fp8((int)w, false), hi = __builtin_amdgcn_cvt_pk_f32_fp8((int)w, true); return (f32x4){lo.x, lo.y, hi.x, hi.y}; }
__device__ __forceinline__ float frcp(float x) { return __builtin_amdgcn_rcpf(x); }
__device__ __forceinline__ float fsigmoid(float x) { return frcp(1.0f + __expf(-x)); }
__device__ __forceinline__ float ftanh(float x) { const float e = __expf(-2.0f * fabsf(x)); const float t = (1.0f - e) * frcp(1.0f + e); return x < 0.f ? -t : t; }
__device__ __forceinline__ float gelu_tanh(float x) { const float u = 0.7978845608f * (x + 0.044715f * x * x * x); return 0.5f * x * (1.0f + ftanh(u)); }
__device__ __forceinline__ float wave_sum(float v) {
#pragma unroll
    for (int o = 1; o < 64; o <<= 1) v += __shfl_xor(v, o);
    return v;
}
__device__ __forceinline__ float wave_max(float v) {
#pragma unroll
    for (int o = 1; o < 64; o <<= 1) v = fmaxf(v, __shfl_xor(v, o));
    return v;
}

#define XB_TMO      128
#define XB_XCNT(j)  (256  + 64 * (j))
#define XB_XSUB(j)  (1280 + 64 * (j))
#define XB_XGEN(j)  (2304 + 64 * (j))
#define XB_TOP      3328
#define XB_TOPGEN   3392
#define XCD_BAR_WORDS 3456
#define XB_SPIN_CAP (1u << 22)

__device__ __forceinline__ unsigned xb_ld(unsigned* p)              { return __hip_atomic_load(p, __ATOMIC_RELAXED, __HIP_MEMORY_SCOPE_AGENT); }
__device__ __forceinline__ unsigned xb_add(unsigned* p, unsigned v) { return __hip_atomic_fetch_add(p, v, __ATOMIC_RELAXED, __HIP_MEMORY_SCOPE_AGENT); }
__device__ __forceinline__ unsigned xb_xcc_id() { return (unsigned)__builtin_amdgcn_s_getreg((3 << 11) | 20) & 0xFu; }
#define XB_SPIN(cond, bar) do { unsigned _sp = 0; while (cond) { __builtin_amdgcn_s_sleep(1); \
    if ((++_sp & 255u) == 0u) { if (xb_ld(&(bar)[XB_TMO])) break; if (_sp > XB_SPIN_CAP) { atomicAdd(&(bar)[XB_TMO], 1u); break; } } } } while (0)

struct XcdBarrier { unsigned* bar; unsigned x; volatile LAS unsigned* st; };

__device__ __forceinline__ XcdBarrier xcd_barrier_post(unsigned* bar, volatile LAS unsigned* st) {
    XcdBarrier b; b.bar = bar; b.x = xb_xcc_id(); b.st = st;
    if (threadIdx.x == 0) (void)xb_add(&bar[XB_XCNT(b.x)], 1u);
    return b;
}
__device__ __forceinline__ void xcd_barrier_complete(unsigned* bar, unsigned x, unsigned& nloc, unsigned& nx) {
    const unsigned G = gridDim.x * gridDim.y * gridDim.z;
    unsigned sum, cnt, mine, sp = 0u;
    for (;;) {
        sum = 0u; cnt = 0u; mine = 0u;
#pragma unroll
        for (unsigned j = 0; j < 16; ++j) { const unsigned c = xb_ld(&bar[XB_XCNT(j)]); sum += c; cnt += (c > 0u) ? 1u : 0u; mine = (j == x) ? c : mine; }
        if (sum == G) break;
        __builtin_amdgcn_s_sleep(1);
        if ((++sp & 255u) == 0u) { if (xb_ld(&bar[XB_TMO])) break; if (sp > XB_SPIN_CAP) { atomicAdd(&bar[XB_TMO], 1u); break; } }
    }
    nloc = mine > 0u ? mine : 1u; nx = cnt > 0u ? cnt : 1u;
}
__device__ __forceinline__ void xcd_barrier(const XcdBarrier& b) {
    asm volatile("s_waitcnt vmcnt(0)" ::: "memory");
    __syncthreads();
    if (threadIdx.x == 0) {
        unsigned* bar = b.bar;
        __builtin_amdgcn_s_waitcnt(0);
        unsigned nloc = b.st[0], nx = b.st[1];
        if (nloc == 0u) { xcd_barrier_complete(bar, b.x, nloc, nx); b.st[0] = nloc; b.st[1] = nx; }
        const unsigned old = xb_add(&bar[XB_XSUB(b.x)], 1u);
        const unsigned gen = old / nloc;
        if (old + 1u == (gen + 1u) * nloc) {
            __builtin_amdgcn_fence(__ATOMIC_RELEASE, "agent");
            asm volatile("s_waitcnt vmcnt(0)" ::: "memory");
            const unsigned og = xb_add(&bar[XB_TOP], 1u);
            const unsigned tg = og / nx;
            if (og + 1u == (tg + 1u) * nx) xb_add(&bar[XB_TOPGEN], 1u);
            else XB_SPIN(xb_ld(&bar[XB_TOPGEN]) == tg, bar);
            __builtin_amdgcn_fence(__ATOMIC_ACQUIRE, "agent");
            xb_add(&bar[XB_XGEN(b.x)], 1u);
            asm volatile("s_waitcnt vmcnt(0)" ::: "memory");
        } else {
            XB_SPIN(xb_ld(&bar[XB_XGEN(b.x)]) == gen, bar);
            __builtin_amdgcn_fence(__ATOMIC_ACQUIRE, "agent");
            asm volatile("s_waitcnt vmcnt(0)" ::: "memory");
        }
    }
    __syncthreads();
}

namespace pg8 {
constexpr int BM = 256, BK = 64, HALF = 128, HTB = HALF * BK * 2, STAGE_BYTES = 8 * HTB, NXCD = 8, WGM = 8;
__host__ __device__ __forceinline__ int lds_byte(int r, int c) { const int st = (r >> 4) * 2 + (c >> 5), rr = r & 15, cc = c & 31, ob = rr * 64 + cc * 2; return st * 1024 + (ob ^ (((ob >> 9) & 1) << 5)); }
__host__ __device__ __forceinline__ void stage_rc(int b, int& R, int& C) { const int st = b / 1024, sb = b % 1024, swz = sb ^ (((sb >> 9) & 1) << 5); R = (st >> 1) * 16 + swz / 64; C = (st & 1) * 32 + (swz % 64) / 2; }
__host__ __device__ __forceinline__ int perm32(int rho) { const int n = rho >> 4, i = rho & 15; return 8 * (i >> 2) + 4 * n + (i & 3); }

struct Unit { int pm, pn, aux; };

struct Order {
    int nM, nN, nwg, G, c;
    __device__ __forceinline__ void init(int nM_, int nN_, int G_, int c_) { nM = nM_; nN = nN_; nwg = nM * nN; G = G_; c = c_; }
    __device__ __forceinline__ bool tile(int i, int& pm, int& pn) const {
        const long L = (long)i * G + c; if (L >= nwg) return false;
        int wgid = (int)L; { const int q = nwg / NXCD, r = nwg % NXCD, xcd = wgid % NXCD, off = wgid / NXCD; wgid = (xcd < r ? xcd * (q + 1) : r * (q + 1) + (xcd - r) * q) + off; }
        const int nig = WGM * nN, gid = wgid / nig, fm = gid * WGM, gsz = (nM - fm) < WGM ? (nM - fm) : WGM;
        pm = fm + ((wgid % nig) % gsz); pn = (wgid % nig) / gsz; return true;
    }
};


template <class Epi, class Sched, bool ALIGN_EPI, bool SP2, bool GATHER, bool FP8 = false>
__device__ __forceinline__ void gemm_phase(LAS unsigned char* lds, const int tid, const int K, const int lda, const int ldb, const Sched& S, const Epi& E) {
    const int wid = __builtin_amdgcn_readfirstlane(tid >> 6), lane = tid & 63, wr = wid >> 2, wc = wid & 3, fr = lane & 15, fq = lane >> 4;
    const int nt = K / BK;
    unsigned voffA[2], voffB[2]; int rA[2], cA2[2];
#pragma unroll
    for (int i = 0; i < 2; ++i) { int R, C; stage_rc(tid * 16 + i * 8192, R, C); const int Rb = Epi::PERM ? ((R & ~31) + perm32(R & 31)) : R;
        voffA[i] = (unsigned)(R * lda + C) * 2u; voffB[i] = (unsigned)(Rb * ldb + C) * 2u; rA[i] = R; cA2[i] = C * 2; }
    const size_t kstep = (size_t)(BK * 2);
    const size_t hstepA = (size_t)HALF * lda * 2, hstepB = (size_t)HALF * ldb * 2;
    const unsigned ldsw = (unsigned)wid * 1024u;
    const int aoff = FP8 ? lds_byte(wr * 64 + fr, fq * 16) : lds_byte(wr * 64 + fr, fq * 8), boff = FP8 ? lds_byte(wc * 32 + fr, fq * 16) : lds_byte(wc * 32 + fr, fq * 8);
    unsigned cv0[2] = {0u, 0u}, cv1[2] = {0u, 0u};
#define PG8_SA(b, h) (((b) * 2 + (h)) * HTB)
#define PG8_SB(b, h) ((4 + (b) * 2 + (h)) * HTB)
#define PG8_STAGE(bufoff, gbase, voff) do { _Pragma("unroll") for (int _i = 0; _i < 2; ++_i) \
        __builtin_amdgcn_global_load_lds((const unsigned*)((const char*)(gbase) + (voff)[_i]), (LAS unsigned*)(lds + (bufoff) + ldsw + _i * 8192), 16, 0, 0); } while (0)
#define PG8_NROW(h, i) ((has_next ? *(const LAS unsigned*)(pf_rows + (i) * 512 + (h) * 256 + lane * 4) * (unsigned)(lda * 2) + (unsigned)cA2[i] : ((h) ? cv1[i] : cv0[i])))
#define PG8_STAGE_A(bufoff, ptr, h, nx) do { if constexpr (GATHER) { unsigned _v[2]; if (nx) { asm volatile("" ::: "memory"); _v[0] = PG8_NROW(h, 0); _v[1] = PG8_NROW(h, 1); } else { _v[0] = (h) ? cv1[0] : cv0[0]; _v[1] = (h) ? cv1[1] : cv0[1]; } PG8_STAGE(bufoff, ptr, _v); } \
        else { PG8_STAGE(bufoff, (ptr) + (h) * hstepA, voffA); } } while (0)
#define PG8_LDA(dst, b, h) do { if constexpr (FP8) { _Pragma("unroll") for (int m = 0; m < 4; ++m) { dst##8[m].lo = *(const LAS v4i_*)(lds + PG8_SA(b, h) + aoff + m * 2048); dst##8[m].hi = *(const LAS v4i_*)(lds + PG8_SA(b, h) + aoff + m * 2048 + 16); } } \
        else { _Pragma("unroll") for (int m = 0; m < 4; ++m) _Pragma("unroll") for (int k = 0; k < 2; ++k) dst[m][k] = *(const LAS bf16x8*)(lds + PG8_SA(b, h) + aoff + m * 2048 + k * 1024); } } while (0)
#define PG8_LDB(dst, b, h) do { if constexpr (FP8) { _Pragma("unroll") for (int n = 0; n < 2; ++n) { dst##8[n].lo = *(const LAS v4i_*)(lds + PG8_SB(b, h) + boff + n * 2048); dst##8[n].hi = *(const LAS v4i_*)(lds + PG8_SB(b, h) + boff + n * 2048 + 16); } } \
        else { _Pragma("unroll") for (int n = 0; n < 2; ++n) _Pragma("unroll") for (int k = 0; k < 2; ++k) dst[n][k] = *(const LAS bf16x8*)(lds + PG8_SB(b, h) + boff + n * 2048 + k * 1024); } } while (0)
#define PG8_MMA(ai, bj, At, Bt) do { __builtin_amdgcn_s_setprio(1); _Pragma("unroll") for (int m = 0; m < 4; ++m) _Pragma("unroll") for (int n = 0; n < 2; ++n) { \
        if constexpr (FP8) asm volatile("v_mfma_scale_f32_16x16x128_f8f6f4 %0, %1, %2, %0, %3, %4 op_sel_hi:[0,0,0]" : "+v"(acc[ai][bj][m][n]) : "v"(Bt##8[n]), "v"(At##8[m]), "v"(sclW), "v"(sclA));   \
        else { _Pragma("unroll") for (int k = 0; k < 2; ++k) acc[ai][bj][m][n] = __builtin_amdgcn_mfma_f32_16x16x32_bf16(Bt[n][k], At[m][k], acc[ai][bj][m][n], 0, 0, 0); } } \
        __builtin_amdgcn_s_setprio(0); } while (0)
#define PG8_WAIT_V(n) asm volatile("s_waitcnt vmcnt(" #n ")" ::: "memory")
#define PG8_WAIT_L(n) asm volatile("s_waitcnt lgkmcnt(" #n ")" ::: "memory")
#define PG8_BAR __builtin_amdgcn_s_barrier()
#define PG8_SCHED __builtin_amdgcn_sched_barrier(0)
#define PG8_ROWS(u, d0, d1) do { _Pragma("unroll") for (int _i = 0; _i < 2; ++_i) { const int _r0 = S.a_row(u, rA[_i]), _r1 = S.a_row(u, HALF + rA[_i]); \
        d0[_i] = (unsigned)_r0 * (unsigned)(lda * 2) + (unsigned)cA2[_i]; d1[_i] = (unsigned)_r1 * (unsigned)(lda * 2) + (unsigned)cA2[_i]; } } while (0)
    constexpr int PF_OFF = STAGE_BYTES;
    LAS unsigned char* pf_bias = lds + PF_OFF + wid * 256; LAS unsigned char* pf_rows = lds + PF_OFF + 2048 + wid * 1024;
    Unit cur, nxt; int ui = 0; bool has_next = false;
    if (!S.next(0, cur)) return;
    f32x4 acc[2][2][4][2];
#pragma unroll
    for (int a = 0; a < 2; ++a)
#pragma unroll
        for (int b = 0; b < 2; ++b)
#pragma unroll
            for (int m = 0; m < 4; ++m)
#pragma unroll
                for (int n = 0; n < 2; ++n) acc[a][b][m][n] = (f32x4){0.f, 0.f, 0.f, 0.f};
    typedef int v8i_ __attribute__((ext_vector_type(8))); typedef int v4i_ __attribute__((ext_vector_type(4)));
    bf16x8 At[4][2], B0[2][2], B1[2][2]; v8i_ At8[4], B08[2], B18[2];
    const int sclW = 0x7a7a7a7a, sclA = 0x7f7f7f7f;
    const char* cA = S.a_ptr(cur); const char* cB = S.b_ptr(cur);
    if constexpr (GATHER) { PG8_ROWS(cur, cv0, cv1); }
    if constexpr (SP2) {
        PG8_STAGE(PG8_SB(0, 0), cB, voffB); PG8_STAGE(PG8_SB(0, 1), cB + hstepB, voffB); PG8_STAGE_A(PG8_SA(0, 0), cA, 0, false); PG8_STAGE_A(PG8_SA(0, 1), cA, 1, false);
        if (wr == 1) PG8_BAR;
        PG8_WAIT_V(2); PG8_BAR;
        PG8_STAGE(PG8_SB(1, 0), cB + kstep, voffB); PG8_STAGE_A(PG8_SA(1, 0), cA + kstep, 0, false); PG8_STAGE(PG8_SB(1, 1), cB + hstepB + kstep, voffB);
        PG8_WAIT_V(6); PG8_BAR;
    } else {
        PG8_STAGE(PG8_SB(0, 0), cB, voffB); PG8_STAGE_A(PG8_SA(0, 0), cA, 0, false); PG8_STAGE(PG8_SB(0, 1), cB + hstepB, voffB); PG8_STAGE_A(PG8_SA(0, 1), cA, 1, false);
        if (wr == 1) PG8_BAR;
        PG8_WAIT_V(4); PG8_BAR;
        PG8_STAGE(PG8_SB(1, 0), cB + kstep, voffB); PG8_STAGE_A(PG8_SA(1, 0), cA + kstep, 0, false); PG8_STAGE(PG8_SB(1, 1), cB + hstepB + kstep, voffB);
        PG8_WAIT_V(6); PG8_BAR;
    }
    for (;;) {
        has_next = S.next(ui + 1, nxt);
        const char* nA = has_next ? S.a_ptr(nxt) : cA; const char* nB = has_next ? S.b_ptr(nxt) : cB;
        if constexpr (Epi::PREF) E.pref(pf_bias, cur, wc, lane);
        if constexpr (GATHER) { if (has_next) {
#pragma unroll
                for (int _i = 0; _i < 2; ++_i) { __builtin_amdgcn_global_load_lds((const unsigned*)S.a_row_ptr(nxt, rA[_i]), (LAS unsigned*)(pf_rows + _i * 512), 4, 0, 0);
                                                 __builtin_amdgcn_global_load_lds((const unsigned*)S.a_row_ptr(nxt, HALF + rA[_i]), (LAS unsigned*)(pf_rows + _i * 512 + 256), 4, 0, 0); } }
            }
        for (int t = 0; t < nt; t += 2) {
            const bool last = (t == nt - 2);
            const char* a1 = cA + (size_t)(t + 1) * kstep;
            const char* a2 = last ? nA : cA + (size_t)(t + 2) * kstep; const char* b2 = last ? nB : cB + (size_t)(t + 2) * kstep;
            const char* a3 = a2 + kstep; const char* b3 = b2 + kstep;
            if constexpr (SP2) {
            PG8_LDB(B0, 0, 0); PG8_LDB(B1, 0, 1); PG8_SCHED; PG8_LDA(At, 0, 0); PG8_STAGE_A(PG8_SA(1, 1), a1, 1, false);
            PG8_WAIT_V(8); PG8_WAIT_L(0); PG8_BAR; PG8_MMA(0, 0, At, B0); PG8_MMA(0, 1, At, B1); PG8_BAR; PG8_SCHED;
            PG8_LDA(At, 0, 1); PG8_STAGE(PG8_SB(0, 0), b2, voffB); PG8_STAGE(PG8_SB(0, 1), b2 + hstepB, voffB); PG8_STAGE_A(PG8_SA(0, 0), a2, 0, last);
            PG8_WAIT_V(8); PG8_WAIT_L(0); PG8_BAR; PG8_MMA(1, 0, At, B0); PG8_MMA(1, 1, At, B1); PG8_BAR; PG8_SCHED;
            PG8_LDB(B0, 1, 0); PG8_LDB(B1, 1, 1); PG8_SCHED; PG8_LDA(At, 1, 0); PG8_STAGE_A(PG8_SA(0, 1), a2, 1, last);
            PG8_WAIT_V(8); PG8_WAIT_L(0); PG8_BAR; PG8_MMA(0, 0, At, B0); PG8_MMA(0, 1, At, B1); PG8_BAR; PG8_SCHED;
            PG8_LDA(At, 1, 1); PG8_STAGE(PG8_SB(1, 0), b3, voffB); PG8_STAGE(PG8_SB(1, 1), b3 + hstepB, voffB); PG8_STAGE_A(PG8_SA(1, 0), a3, 0, last);
            PG8_WAIT_V(8); PG8_WAIT_L(0); PG8_BAR; PG8_MMA(1, 0, At, B0); PG8_MMA(1, 1, At, B1); PG8_BAR; PG8_SCHED;
            } else {
            PG8_LDB(B0, 0, 0); PG8_SCHED; PG8_LDA(At, 0, 0); PG8_STAGE_A(PG8_SA(1, 1), a1, 1, false);
            PG8_WAIT_L(8); PG8_BAR; PG8_WAIT_L(0); PG8_MMA(0, 0, At, B0); PG8_BAR; PG8_SCHED;
            PG8_LDB(B1, 0, 1); PG8_STAGE(PG8_SB(0, 0), b2, voffB);
            PG8_BAR; PG8_WAIT_L(0); PG8_MMA(0, 1, At, B1); PG8_BAR;
            PG8_LDA(At, 0, 1); PG8_STAGE_A(PG8_SA(0, 0), a2, 0, last);
            PG8_BAR; PG8_WAIT_L(0); PG8_MMA(1, 0, At, B0); PG8_BAR; PG8_SCHED;
            PG8_STAGE(PG8_SB(0, 1), b2 + hstepB, voffB);
            PG8_WAIT_V(6); PG8_BAR; PG8_MMA(1, 1, At, B1); PG8_BAR;
            PG8_LDB(B0, 1, 0); PG8_SCHED; PG8_LDA(At, 1, 0); PG8_STAGE_A(PG8_SA(0, 1), a2, 1, last);
            PG8_WAIT_L(8); PG8_BAR; PG8_WAIT_L(0); PG8_MMA(0, 0, At, B0); PG8_BAR; PG8_SCHED;
            PG8_LDB(B1, 1, 1); PG8_STAGE(PG8_SB(1, 0), b3, voffB);
            PG8_BAR; PG8_WAIT_L(0); PG8_MMA(0, 1, At, B1); PG8_BAR;
            PG8_LDA(At, 1, 1); PG8_STAGE_A(PG8_SA(1, 0), a3, 0, last);
            PG8_BAR; PG8_WAIT_L(0); PG8_MMA(1, 0, At, B0); PG8_BAR; PG8_SCHED;
            PG8_STAGE(PG8_SB(1, 1), b3 + hstepB, voffB);
            PG8_WAIT_V(6); PG8_BAR; PG8_MMA(1, 1, At, B1); PG8_BAR;
            }
        }
        if constexpr (ALIGN_EPI) { if (wr == 0) PG8_BAR; }
        if constexpr (FP8) asm volatile("s_nop 15\n\ts_nop 15" ::: "memory");
        E(acc, cur, wr, wc, fr, fq, pf_bias);
        if (!has_next) break;
#pragma unroll
        for (int a = 0; a < 2; ++a)
#pragma unroll
            for (int b = 0; b < 2; ++b)
#pragma unroll
                for (int m = 0; m < 4; ++m)
#pragma unroll
                    for (int n = 0; n < 2; ++n) acc[a][b][m][n] = (f32x4){0.f, 0.f, 0.f, 0.f};
        cur = nxt; cA = nA; cB = nB; ++ui;
        if constexpr (GATHER) { asm volatile("" ::: "memory"); cv0[0] = PG8_NROW(0, 0); cv0[1] = PG8_NROW(0, 1); cv1[0] = PG8_NROW(1, 0); cv1[1] = PG8_NROW(1, 1); }
        if constexpr (ALIGN_EPI) { if (wr == 1) PG8_BAR; }
    }
    PG8_WAIT_V(0);
    if constexpr (!ALIGN_EPI) { if (wr == 0) PG8_BAR; }
    PG8_BAR;
#undef PG8_SA
#undef PG8_SB
#undef PG8_STAGE
#undef PG8_STAGE_A
#undef PG8_NROW
#undef PG8_LDA
#undef PG8_LDB
#undef PG8_MMA
#undef PG8_WAIT_V
#undef PG8_WAIT_L
#undef PG8_BAR
#undef PG8_SCHED
#undef PG8_ROWS
}
}

using pg8::Unit;
struct SchedPlain : pg8::Order {
    const char* A; const char* B; size_t a_tile, b_tile;
    __device__ __forceinline__ bool next(int i, Unit& u) const { u.aux = 0; return tile(i, u.pm, u.pn); }
    __device__ __forceinline__ const char* a_ptr(const Unit& u) const { return A + (size_t)u.pm * a_tile; }
    __device__ __forceinline__ const char* b_ptr(const Unit& u) const { return B + (size_t)u.pn * b_tile; }
    __device__ __forceinline__ int a_row(const Unit&, int) const { return 0; }
    __device__ __forceinline__ const int* a_row_ptr(const Unit&, int) const { return nullptr; }
};
struct SchedS5 : pg8::Order {
    const char* A; const char* B; size_t a_tile, b_tile, b_group;
    __device__ __forceinline__ bool next(int i, Unit& u) const { u.aux = 0; return tile(i, u.pm, u.pn); }
    __device__ __forceinline__ const char* a_ptr(const Unit& u) const { return A + (size_t)u.pm * a_tile; }
    __device__ __forceinline__ const char* b_ptr(const Unit& u) const { return B + (size_t)(u.pm >> 2) * b_group + (size_t)u.pn * b_tile; }
    __device__ __forceinline__ int a_row(const Unit&, int) const { return 0; }
    __device__ __forceinline__ const int* a_row_ptr(const Unit&, int) const { return nullptr; }
};
template <bool GATHER> struct SchedMoe : pg8::Order {
    const char* A; const char* B; size_t a_tile, b_tile, b_exp; const LAS int* tile_e; int tile0, e0; const int* slot_tok; int row0;
    __device__ __forceinline__ bool next(int i, Unit& u) const { const bool ok = tile(i, u.pm, u.pn); u.aux = ok ? tile_e[tile0 + u.pm] : 0; return ok; }
    __device__ __forceinline__ const char* a_ptr(const Unit& u) const { return GATHER ? A : A + (size_t)u.pm * a_tile; }
    __device__ __forceinline__ const char* b_ptr(const Unit& u) const { return B + (size_t)(u.aux - e0) * b_exp + (size_t)u.pn * b_tile; }
    __device__ __forceinline__ int a_row(const Unit& u, int r) const { return slot_tok[row0 + u.pm * 256 + r]; }
    __device__ __forceinline__ const int* a_row_ptr(const Unit& u, int r) const { return slot_tok + row0 + u.pm * 256 + r; }
};

__device__ __forceinline__ void st8(bf16* p, const f32x4 v0, const f32x4 v1) {
    u32x4 w; w.x = cvt_pk_bf16(v0[0], v0[1]); w.y = cvt_pk_bf16(v0[2], v0[3]); w.z = cvt_pk_bf16(v1[0], v1[1]); w.w = cvt_pk_bf16(v1[2], v1[3]); *(u32x4*)p = w;
}
__device__ __forceinline__ void ld8(const bf16* p, f32x4& v0, f32x4& v1) {
    const u32x4 w = *(const u32x4*)p; v0 = (f32x4){lo16(w.x), hi16(w.x), lo16(w.y), hi16(w.y)}; v1 = (f32x4){lo16(w.z), hi16(w.z), lo16(w.w), hi16(w.w)};
}
#define EPI_LOOP_AM _Pragma("unroll") for (int ai = 0; ai < 2; ++ai) _Pragma("unroll") for (int m = 0; m < 4; ++m)
#define EPI_ARGS f32x4 (&acc)[2][2][4][2], const Unit& u, int wr, int wc, int fr, int fq, const LAS unsigned char* pf

struct EpiProj { static constexpr bool PERM = true, PREF = false; bf16 *AG, *RKV, *LP;
    __device__ __forceinline__ void operator()(EPI_ARGS) const {
        const int row0 = u.pm * 256 + wr * 64 + fr;
        if (u.pn < 2) { const int col0 = u.pn * 256 + wc * 32 + 8 * fq;
            EPI_LOOP_AM { const int row = row0 + ai * 128 + m * 16;
#pragma unroll
                for (int bj = 0; bj < 2; ++bj) { const int c = col0 + bj * 128; st8(AG + ((size_t)((c >> 4) * 1024 + (row >> 5))) * 640 + (row & 31) * 16 + (c & 15), acc[ai][bj][m][0], acc[ai][bj][m][1]); } }
        } else {
            bf16* base; int ldc, c0;
            if (u.pn < 8) { base = RKV; ldc = 1536; c0 = (u.pn - 2) * 256; } else { base = LP; ldc = 512; c0 = (u.pn - 8) * 256; }
            const int col0 = c0 + wc * 32 + 8 * fq;
            EPI_LOOP_AM { bf16* rowp = base + (size_t)(row0 + ai * 128 + m * 16) * ldc + col0;
#pragma unroll
                for (int bj = 0; bj < 2; ++bj) st8(rowp + bj * 128, acc[ai][bj][m][0], acc[ai][bj][m][1]); }
        }
    }
};
struct EpiBf16Plain { static constexpr bool PERM = true, PREF = false; bf16* O; int ldc;
    __device__ __forceinline__ void operator()(EPI_ARGS) const {
        const int row0 = u.pm * 256 + wr * 64 + fr, col0 = u.pn * 256 + wc * 32 + 8 * fq;
        EPI_LOOP_AM { bf16* rowp = O + (size_t)(row0 + ai * 128 + m * 16) * ldc + col0;
#pragma unroll
            for (int bj = 0; bj < 2; ++bj) st8(rowp + bj * 128, acc[ai][bj][m][0], acc[ai][bj][m][1]); }
    }
};
struct EpiF32 { static constexpr bool PERM = false, PREF = false; float* C; int ldc;
    __device__ __forceinline__ void operator()(EPI_ARGS) const {
        const int row0 = u.pm * 256 + wr * 64 + fr, col0 = u.pn * 256 + wc * 32 + 4 * fq;
        EPI_LOOP_AM { float* rowp = C + (size_t)(row0 + ai * 128 + m * 16) * ldc + col0;
#pragma unroll
            for (int bj = 0; bj < 2; ++bj)
#pragma unroll
                for (int n = 0; n < 2; ++n) *(f32x4*)(rowp + bj * 128 + n * 16) = acc[ai][bj][m][n]; }
    }
};
struct EpiS5Y { static constexpr bool PERM = true, PREF = false; const bf16* AG; const float* dskip; bf16* Y1;
    __device__ __forceinline__ void operator()(EPI_ARGS) const {
        const int g = u.pm >> 2, crow0 = (u.pm & 3) * 256 + wr * 64 + fr, col0 = u.pn * 256 + wc * 32 + 8 * fq;
        EPI_LOOP_AM { const int crow = crow0 + ai * 128 + m * 16;
#pragma unroll
            for (int bj = 0; bj < 2; ++bj) { const int col = col0 + bj * 128, t = col >> 4, c = col & 15;
                f32x4 u0, u1; ld8(AG + ((size_t)(g * 1024 + crow)) * 640 + col, u0, u1);
                const f32x4 d0 = *(const f32x4*)(dskip + g * 16 + c), d1 = *(const f32x4*)(dskip + g * 16 + c + 4);
                f32x4 v0 = acc[ai][bj][m][0] + d0 * u0, v1 = acc[ai][bj][m][1] + d1 * u1;
#pragma unroll
                for (int j = 0; j < 4; ++j) { v0[j] = gelu_tanh(v0[j]); v1[j] = gelu_tanh(v1[j]); }
                st8(Y1 + (size_t)(crow * 32 + t) * 512 + g * 16 + c, v0, v1); } }
    }
};
struct EpiGlu { static constexpr bool PERM = true, PREF = false; const bf16* Y1; bf16* MIX;
    __device__ __forceinline__ void operator()(EPI_ARGS) const {
        const int row0 = u.pm * 256 + wr * 64 + fr, col0 = u.pn * 256 + wc * 32 + 8 * fq;
        EPI_LOOP_AM { const int row = row0 + ai * 128 + m * 16;
#pragma unroll
            for (int bj = 0; bj < 2; ++bj) { const int col = col0 + bj * 128; f32x4 y0, y1v; ld8(Y1 + (size_t)row * 512 + col, y0, y1v);
                f32x4 v0, v1;
#pragma unroll
                for (int j = 0; j < 4; ++j) { v0[j] = y0[j] * fsigmoid(acc[ai][bj][m][0][j]); v1[j] = y1v[j] * fsigmoid(acc[ai][bj][m][1][j]); }
                st8(MIX + (size_t)row * 1024 + col, v0, v1); } }
    }
};
struct EpiResid { static constexpr bool PERM = true, PREF = false; const float* X; bf16* O;
    __device__ __forceinline__ void operator()(EPI_ARGS) const {
        const int row0 = u.pm * 256 + wr * 64 + fr, col0 = u.pn * 256 + wc * 32 + 8 * fq;
        EPI_LOOP_AM { const size_t off = (size_t)(row0 + ai * 128 + m * 16) * 1024 + col0;
#pragma unroll
            for (int bj = 0; bj < 2; ++bj) { const f32x4 x0 = __builtin_nontemporal_load((const f32x4*)(X + off + bj * 128)), x1 = __builtin_nontemporal_load((const f32x4*)(X + off + bj * 128 + 4)); st8(O + off + bj * 128, x0 + acc[ai][bj][m][0], x1 + acc[ai][bj][m][1]); } }
    }
};
struct EpiGU { static constexpr bool PERM = true, PREF = true; unsigned char* ACT; const float* bg; const float* bu;
    __device__ __forceinline__ void pref(LAS unsigned char* pf, const Unit& u, int wc, int lane) const {
        const float* src = ((lane & 32) ? bu : bg) + u.aux * 1024 + u.pn * 128 + wc * 32 + (lane & 31);
        __builtin_amdgcn_global_load_lds((const unsigned*)src, (LAS unsigned*)pf, 4, 0, 0); }
    __device__ __forceinline__ void operator()(EPI_ARGS) const {
        const int row0 = u.pm * 256 + wr * 64 + fr, col = u.pn * 128 + wc * 32 + 8 * fq;
        const f32x4 g0 = *(const LAS f32x4*)(pf + 32 * fq), g1 = *(const LAS f32x4*)(pf + 32 * fq + 16), u0 = *(const LAS f32x4*)(pf + 128 + 32 * fq), u1 = *(const LAS f32x4*)(pf + 128 + 32 * fq + 16);
        EPI_LOOP_AM { f32x4 v0, v1;
#pragma unroll
            for (int j = 0; j < 4; ++j) {
                const float gt0 = fminf(acc[ai][0][m][0][j] + g0[j], 7.0f), up0 = fminf(fmaxf(acc[ai][1][m][0][j] + u0[j], -7.0f), 7.0f);
                const float gt1 = fminf(acc[ai][0][m][1][j] + g1[j], 7.0f), up1 = fminf(fmaxf(acc[ai][1][m][1][j] + u1[j], -7.0f), 7.0f);
                v0[j] = (up0 + 1.0f) * gt0 * fsigmoid(1.702f * gt0); v1[j] = (up1 + 1.0f) * gt1 * fsigmoid(1.702f * gt1); }
            u32x2 w; w.x = pk4_fp8(v0[0], v0[1], v0[2], v0[3]); w.y = pk4_fp8(v1[0], v1[1], v1[2], v1[3]); *(u32x2*)(ACT + (size_t)(row0 + ai * 128 + m * 16) * 1024 + col) = w; }
    }
};
struct EpiDown { static constexpr bool PERM = true, PREF = true; unsigned char* Y; const float* bd;
    __device__ __forceinline__ void pref(LAS unsigned char* pf, const Unit& u, int wc, int lane) const {
        const float* src = bd + u.aux * 1024 + u.pn * 256 + (lane >> 5) * 128 + wc * 32 + (lane & 31);
        __builtin_amdgcn_global_load_lds((const unsigned*)src, (LAS unsigned*)pf, 4, 0, 0); }
    __device__ __forceinline__ void operator()(EPI_ARGS) const {
        const int row0 = u.pm * 256 + wr * 64 + fr, col0 = u.pn * 256 + wc * 32 + 8 * fq;
        EPI_LOOP_AM { unsigned char* rowp = Y + (size_t)(row0 + ai * 128 + m * 16) * 1024 + col0;
#pragma unroll
            for (int bj = 0; bj < 2; ++bj) { const f32x4 b0 = *(const LAS f32x4*)(pf + 128 * bj + 32 * fq), b1 = *(const LAS f32x4*)(pf + 128 * bj + 32 * fq + 16);
                const f32x4 v0 = acc[ai][bj][m][0] + b0, v1 = acc[ai][bj][m][1] + b1; u32x2 w; w.x = pk4_fp8(v0[0], v0[1], v0[2], v0[3]); w.y = pk4_fp8(v1[0], v1[1], v1[2], v1[3]); *(u32x2*)(rowp + bj * 128) = w; } }
    }
};
struct EpiPle { static constexpr bool PERM = true, PREF = false; const bf16* PP; bf16* O;
    __device__ __forceinline__ void operator()(EPI_ARGS) const {
        const int row0 = u.pm * 256 + wr * 64 + fr, col0 = u.pn * 256 + wc * 32 + 8 * fq;
        EPI_LOOP_AM { const size_t off = (size_t)(row0 + ai * 128 + m * 16) * 1024 + col0;
#pragma unroll
            for (int bj = 0; bj < 2; ++bj) { f32x4 p0, p1, x0, x1; ld8(PP + off + bj * 128, p0, p1); ld8(O + off + bj * 128, x0, x1);
#pragma unroll
                for (int j = 0; j < 4; ++j) { x0[j] += p0[j] * fsigmoid(acc[ai][bj][m][0][j]); x1[j] += p1[j] * fsigmoid(acc[ai][bj][m][1][j]); }
                st8(O + off + bj * 128, x0, x1); } }
    }
};

struct EpiPleNorm { static constexpr bool PERM = true, PREF = false; const bf16* PP; const bf16* XIN; float* OUT; const float* gfin; float* rowss; unsigned* pcnt;
    __device__ __forceinline__ void operator()(EPI_ARGS) const {
        const int row0 = u.pm * 256 + wr * 64 + fr, col0 = u.pn * 256 + wc * 32 + 8 * fq;
        EPI_LOOP_AM { const size_t off = (size_t)(row0 + ai * 128 + m * 16) * 1024 + col0; float s = 0.f;
#pragma unroll
            for (int bj = 0; bj < 2; ++bj) { f32x4 p0, p1, x0, x1; ld8(PP + off + bj * 128, p0, p1); ld8(XIN + off + bj * 128, x0, x1);
#pragma unroll
                for (int j = 0; j < 4; ++j) { x0[j] += p0[j] * fsigmoid(acc[ai][bj][m][0][j]); x1[j] += p1[j] * fsigmoid(acc[ai][bj][m][1][j]); s += x0[j] * x0[j] + x1[j] * x1[j]; }
                acc[ai][bj][m][0] = x0; acc[ai][bj][m][1] = x1; }
            s += __shfl_xor(s, 16); s += __shfl_xor(s, 32);
            if (fq == 0) atomicAdd(rowss + row0 + ai * 128 + m * 16, s); }
        asm volatile("s_waitcnt vmcnt(0)" ::: "memory");
        unsigned* cnt = pcnt + 64 * u.pm;
        if ((fr | fq) == 0) __hip_atomic_fetch_add(cnt, 1u, __ATOMIC_RELAXED, __HIP_MEMORY_SCOPE_AGENT);
        { unsigned sp = 0; while (__builtin_amdgcn_readfirstlane(__hip_atomic_load(cnt, __ATOMIC_RELAXED, __HIP_MEMORY_SCOPE_AGENT)) < 32u) { __builtin_amdgcn_s_sleep(2); if (++sp > (1u << 22)) break; } }
        f32x4 gv[2][2];
#pragma unroll
        for (int bj = 0; bj < 2; ++bj) { gv[bj][0] = *(const f32x4*)(gfin + col0 + bj * 128); gv[bj][1] = *(const f32x4*)(gfin + col0 + bj * 128 + 4); }
        EPI_LOOP_AM { const int row = row0 + ai * 128 + m * 16; const float ssr = __hip_atomic_load(rowss + row, __ATOMIC_RELAXED, __HIP_MEMORY_SCOPE_AGENT); const float rinv = rsqrtf(ssr * (1.f / 1024.f) + 1e-6f);
            float* orow = OUT + (size_t)row * 1024 + col0;
#pragma unroll
            for (int bj = 0; bj < 2; ++bj) { __builtin_nontemporal_store(acc[ai][bj][m][0] * rinv * gv[bj][0], (f32x4*)(orow + bj * 128)); __builtin_nontemporal_store(acc[ai][bj][m][1] * rinv * gv[bj][1], (f32x4*)(orow + bj * 128 + 4)); } }
    }
};

struct Ctx { LAS unsigned char* lds; int tid, lane, wave, G, wg, gw, NGW; };

template <int NBW>
__device__ __forceinline__ void transpose_item(const float* W, int N, int k0, int n0, bf16* dst, int ldk, const float* scl, int flip, LAS float* scr, int lane) {
    constexpr int LPR = NBW / 4, RPI = 64 / LPR, NI = 64 / RPI;
    const int rr = lane / LPR, cc = (lane % LPR) * 4;
    f32x4 v[NI];
#pragma unroll
    for (int i = 0; i < NI; ++i) v[i] = *(const f32x4*)(W + (size_t)(k0 + i * RPI + rr) * N + n0 + cc);
#pragma unroll
    for (int i = 0; i < NI; ++i) { const int kk = i * RPI + rr; f32x4 x = v[i];
        if (scl) { const float s0 = scl[k0 + kk]; const float f = flip ? (1.0f - s0) : s0; x = x * f; }
        LAS float* d = scr + kk * 65 + cc; d[0] = x.x; d[1] = x.y; d[2] = x.z; d[3] = x.w; }
    LDS_WAIT(); asm volatile("" ::: "memory");
    const int c = lane & 7;
#pragma unroll
    for (int j = 0; j < NBW / 8; ++j) { const int n = (lane >> 3) + 8 * j; const LAS float* s = scr + (8 * c) * 65 + n;
        u32x4 o; o.x = pk2(s[0 * 65], s[1 * 65]); o.y = pk2(s[2 * 65], s[3 * 65]); o.z = pk2(s[4 * 65], s[5 * 65]); o.w = pk2(s[6 * 65], s[7 * 65]);
        *(u32x4*)(dst + (size_t)n * ldk + 8 * c) = o; }
    LDS_WAIT(); asm volatile("" ::: "memory");
}
struct F8Item { f32x4 v[16]; };
__device__ __forceinline__ void f8_issue(const float* W, int N, int k0, int n0, int lane, F8Item& it) {
    const int rr = lane >> 4, cc = (lane & 15) * 4;
#pragma unroll
    for (int i = 0; i < 16; ++i) it.v[i] = __builtin_nontemporal_load((const f32x4*)(W + (size_t)(k0 + i * 4 + rr) * N + n0 + cc));
}
__device__ __forceinline__ void f8_finish(const F8Item& it, unsigned char* dst, int ldk, float scale, LAS float* scr, int lane) {
    const int rr = lane >> 4, cc = (lane & 15) * 4;
#pragma unroll
    for (int i = 0; i < 16; ++i) { const int kk = i * 4 + rr; LAS float* d = scr + kk * 65 + cc; d[0] = it.v[i].x * scale; d[1] = it.v[i].y * scale; d[2] = it.v[i].z * scale; d[3] = it.v[i].w * scale; }
    LDS_WAIT(); asm volatile("" ::: "memory");
    const int c = lane & 3;
#pragma unroll
    for (int j = 0; j < 4; ++j) { const int n = (lane >> 2) + 16 * j; const LAS float* s = scr + (16 * c) * 65 + n;
        u32x4 o; o.x = pk4_fp8(s[0 * 65], s[1 * 65], s[2 * 65], s[3 * 65]); o.y = pk4_fp8(s[4 * 65], s[5 * 65], s[6 * 65], s[7 * 65]); o.z = pk4_fp8(s[8 * 65], s[9 * 65], s[10 * 65], s[11 * 65]); o.w = pk4_fp8(s[12 * 65], s[13 * 65], s[14 * 65], s[15 * 65]);
        *(u32x4*)(dst + (size_t)n * ldk + 16 * c) = o; }
    LDS_WAIT(); asm volatile("" ::: "memory");
}
__device__ __forceinline__ void transpose_item_fp8(const float* W, int N, int k0, int n0, unsigned char* dst, int ldk, float scale, LAS float* scr, int lane) {
    F8Item it; f8_issue(W, N, k0, n0, lane, it); f8_finish(it, dst, ldk, scale, scr, lane);
}
__device__ __forceinline__ void transpose_matrix(const Ctx& cx, const float* W, int K, int N, bf16* WT, int row_off, int ldk, int koff, const float* scl, int flip) {
    LAS float* scr = (LAS float*)(cx.lds + cx.wave * 16640);
    const int nblk = N / 64, nitems = (K / 64) * nblk;
    for (int it = cx.gw; it < nitems; it += cx.NGW) { const int kb = it / nblk, nb = it % nblk;
        transpose_item<64>(W, N, 64 * kb, 64 * nb, WT + (size_t)(row_off + 64 * nb) * ldk + koff + 64 * kb, ldk, scl, flip, scr, cx.lane); }
}
__device__ __forceinline__ void rms_row_to_bf16(const float* xrow, const float* g, bf16* orow, int lane) {
    const f32x4* xr = (const f32x4*)xrow + lane; const f32x4* gr = (const f32x4*)g + lane;
    f32x4 v[4]; float s = 0.f;
#pragma unroll
    for (int j = 0; j < 4; ++j) { v[j] = xr[64 * j]; s += (v[j].x * v[j].x + v[j].y * v[j].y) + (v[j].z * v[j].z + v[j].w * v[j].w); }
    const float rinv = rsqrtf(wave_sum(s) * (1.f / 1024.f) + 1e-6f);
    u32x2* o8 = (u32x2*)orow + lane;
#pragma unroll
    for (int j = 0; j < 4; ++j) { const f32x4 gg = gr[64 * j]; u32x2 w; w.x = pk2(v[j].x * rinv * gg.x, v[j].y * rinv * gg.y); w.y = pk2(v[j].z * rinv * gg.z, v[j].w * rinv * gg.w); o8[64 * j] = w; }
}

__device__ __forceinline__ void rms_rows2_to_bf16(const float* xa, const float* xb, const float* g, bf16* oa, bf16* ob, int lane) {
    const f32x4* ra = (const f32x4*)xa + lane; const f32x4* rb = (const f32x4*)xb + lane; const f32x4* gr = (const f32x4*)g + lane;
    f32x4 va[4], vb[4]; float sa = 0.f, sb = 0.f;
#pragma unroll
    for (int j = 0; j < 4; ++j) { va[j] = __builtin_nontemporal_load(ra + 64 * j); vb[j] = __builtin_nontemporal_load(rb + 64 * j); }
#pragma unroll
    for (int j = 0; j < 4; ++j) { sa += (va[j].x * va[j].x + va[j].y * va[j].y) + (va[j].z * va[j].z + va[j].w * va[j].w); sb += (vb[j].x * vb[j].x + vb[j].y * vb[j].y) + (vb[j].z * vb[j].z + vb[j].w * vb[j].w); }
#pragma unroll
    for (int o = 1; o < 64; o <<= 1) { sa += __shfl_xor(sa, o); sb += __shfl_xor(sb, o); }
    const float ia = rsqrtf(sa * (1.f / 1024.f) + 1e-6f), ib = rsqrtf(sb * (1.f / 1024.f) + 1e-6f);
    u32x2* pa = (u32x2*)oa + lane; u32x2* pb = (u32x2*)ob + lane;
#pragma unroll
    for (int j = 0; j < 4; ++j) { const f32x4 gg = gr[64 * j]; u32x2 w; w.x = pk2(va[j].x * ia * gg.x, va[j].y * ia * gg.y); w.y = pk2(va[j].z * ia * gg.z, va[j].w * ia * gg.w); pa[64 * j] = w;
        w.x = pk2(vb[j].x * ib * gg.x, vb[j].y * ib * gg.y); w.y = pk2(vb[j].z * ib * gg.z, vb[j].w * ib * gg.w); pb[64 * j] = w; }
}

__device__ __forceinline__ void s5_tables_item(const Ctx& cx, int g, int part, const float* lam_re, const float* lam_im, const float* log_dt, const float* b_re, const float* b_im, const float* c_re, const float* c_im,
                                               bf16* BT, bf16* ET, float* AT) {
    LAS float* apr = (LAS float*)cx.lds; LAS float* api = apr + 33 * 64; LAS float* bbr = api + 33 * 64; LAS float* bbi = bbr + 1024; LAS float* cr = bbi + 1024; LAS float* ci = cr + 1024; LAS float* kt = ci + 1024;
    const int tid = cx.tid;
    const float dt = __expf(log_dt[g]);
    for (int idx = tid; idx < 33 * 64; idx += NTHR) { const int j = idx >> 6, p = idx & 63;
        const float lre = fminf(lam_re[g * 64 + p], -1e-4f), lim = lam_im[g * 64 + p];
        const float mag = expf(lre * dt * (float)j), ang = lim * dt * (float)j; float sn, cs; sincosf(ang, &sn, &cs);
        apr[idx] = mag * cs; api[idx] = mag * sn; }
    for (int idx = tid; idx < 1024; idx += NTHR) { const int p = idx >> 4;
        const float lre = fminf(lam_re[g * 64 + p], -1e-4f), lim = lam_im[g * 64 + p];
        const float mag = expf(lre * dt); float sn, cs; sincosf(lim * dt, &sn, &cs); const float lbr = mag * cs, lbi = mag * sn;
        const float den = lre * lre + lim * lim, zr = lbr - 1.0f; const float cor = (zr * lre + lbi * lim) / den, coi = (lbi * lre - zr * lim) / den;
        const float br = b_re[g * 1024 + idx], bi = b_im[g * 1024 + idx];
        bbr[idx] = cor * br - coi * bi; bbi[idx] = cor * bi + coi * br;
        cr[idx] = c_re[g * 1024 + idx]; ci[idx] = c_im[g * 1024 + idx]; }
    __syncthreads();
    if (tid < 64) { const int jl = tid >> 4, c = tid & 15, j = 4 * part + jl; float acc[16];
#pragma unroll
        for (int i = 0; i < 16; ++i) acc[i] = 0.f;
        for (int p = 0; p < 64; ++p) { const float ar = apr[j * 64 + p], ai = api[j * 64 + p], xr = cr[c * 64 + p], xi = ci[c * 64 + p];
            const float car = xr * ar - xi * ai, cai = xr * ai + xi * ar;
#pragma unroll
            for (int v4 = 0; v4 < 4; ++v4) { const f32x4 br = *(const LAS f32x4*)(bbr + p * 16 + 4 * v4), bi = *(const LAS f32x4*)(bbi + p * 16 + 4 * v4);
                acc[4 * v4 + 0] += car * br.x - cai * bi.x; acc[4 * v4 + 1] += car * br.y - cai * bi.y; acc[4 * v4 + 2] += car * br.z - cai * bi.z; acc[4 * v4 + 3] += car * br.w - cai * bi.w; } }
#pragma unroll
        for (int i = 0; i < 16; ++i) kt[jl * 256 + c * 16 + i] = acc[i]; }
    __syncthreads();
    bf16* BTg = BT + (size_t)g * 512 * 640; bf16* ETg = ET + (size_t)g * 256 * 512;
    for (int idx = tid; idx < 4096; idx += NTHR) { const int hf = idx & 1, c = (idx >> 1) & 15, t = (idx >> 5) & 31, jl = idx >> 10, j = 4 * part + jl;
        if (t >= j) { const LAS float* s = kt + jl * 256 + c * 16 + hf * 8; u32x4 o; o.x = pk2(s[0], s[1]); o.y = pk2(s[2], s[3]); o.z = pk2(s[4], s[5]); o.w = pk2(s[6], s[7]);
            *(u32x4*)(BTg + (size_t)(t * 16 + c) * 640 + (t - j) * 16 + hf * 8) = o; } }
    for (int idx = tid; idx < 4096; idx += NTHR) { const int hf = idx & 1, c = (idx >> 1) & 15, s = (idx >> 5) & 31, t = 4 * part + (idx >> 10);
        if (s > t) *(u32x4*)(BTg + (size_t)(t * 16 + c) * 640 + s * 16 + hf * 8) = (u32x4){0u, 0u, 0u, 0u}; }
    for (int idx = tid; idx < 1024; idx += NTHR) { const int ch = idx & 15, c = (idx >> 4) & 15, t = 4 * part + (idx >> 8); const int im = ch >> 3, p0 = (ch & 7) * 8; float v[8];
#pragma unroll
        for (int q = 0; q < 8; ++q) { const int p = p0 + q; const float ar = apr[(t + 1) * 64 + p], ai = api[(t + 1) * 64 + p], xr = cr[c * 64 + p], xi = ci[c * 64 + p];
            v[q] = im ? -(xr * ai + xi * ar) : (xr * ar - xi * ai); }
        u32x4 o; o.x = pk2(v[0], v[1]); o.y = pk2(v[2], v[3]); o.z = pk2(v[4], v[5]); o.w = pk2(v[6], v[7]);
        *(u32x4*)(BTg + (size_t)(t * 16 + c) * 640 + 512 + im * 64 + p0) = o; }
    for (int idx = tid; idx < 1024; idx += NTHR) { const int hf = idx & 1, sl = (idx >> 1) & 3, n = idx >> 3, s = 4 * part + sl, p = n & 63, im = n >> 6; float v[8];
        const float ar = apr[(31 - s) * 64 + p], ai = api[(31 - s) * 64 + p];
#pragma unroll
        for (int q = 0; q < 8; ++q) { const float br = bbr[p * 16 + hf * 8 + q], bi = bbi[p * 16 + hf * 8 + q]; v[q] = im ? (ar * bi + ai * br) : (ar * br - ai * bi); }
        u32x4 o; o.x = pk2(v[0], v[1]); o.y = pk2(v[2], v[3]); o.z = pk2(v[4], v[5]); o.w = pk2(v[6], v[7]);
        *(u32x4*)(ETg + (size_t)n * 512 + s * 16 + hf * 8) = o; }
    for (int idx = tid; idx < 1024; idx += NTHR) { const int ch = idx & 63, r = 128 + 16 * part + (idx >> 6); *(u32x4*)(ETg + (size_t)r * 512 + ch * 8) = (u32x4){0u, 0u, 0u, 0u}; }
    if (part == 0 && tid < 64) { AT[(g * 64 + tid) * 2] = apr[32 * 64 + tid]; AT[(g * 64 + tid) * 2 + 1] = api[32 * 64 + tid]; }
    __syncthreads();
}

constexpr int IMG_LD = 80, IMG_B = 64 * IMG_LD * 2;
#define IMG(k) ((LAS bf16*)(lds + (k) * IMG_B))
#define LDS_BARRIER() do { asm volatile("s_waitcnt lgkmcnt(0)" ::: "memory"); __builtin_amdgcn_s_barrier(); asm volatile("" ::: "memory"); } while (0)
struct MmCtx { int tr, tc0, l15, q; };
__device__ __forceinline__ void mm64(const LAS bf16* A, const LAS bf16* Bt, f32x4 (&acc)[2], const MmCtx& w) {
#pragma unroll
    for (int s = 0; s < 2; ++s) {
        const bf16x8 a = *(const LAS bf16x8*)(A + (16 * w.tr + w.l15) * IMG_LD + 32 * s + 8 * w.q);
#pragma unroll
        for (int c = 0; c < 2; ++c) { const bf16x8 b = *(const LAS bf16x8*)(Bt + (16 * (w.tc0 + c) + w.l15) * IMG_LD + 32 * s + 8 * w.q);
            acc[c] = __builtin_amdgcn_mfma_f32_16x16x32_bf16(a, b, acc[c], 0, 0, 0); }
    }
}
__device__ __forceinline__ void mm64_2a(const LAS bf16* A1, const LAS bf16* A2, const LAS bf16* Bt, f32x4 (&acc1)[2], f32x4 (&acc2)[2], const MmCtx& w) {
#pragma unroll
    for (int s = 0; s < 2; ++s) {
        const bf16x8 a1 = *(const LAS bf16x8*)(A1 + (16 * w.tr + w.l15) * IMG_LD + 32 * s + 8 * w.q), a2 = *(const LAS bf16x8*)(A2 + (16 * w.tr + w.l15) * IMG_LD + 32 * s + 8 * w.q);
#pragma unroll
        for (int c = 0; c < 2; ++c) { const bf16x8 b = *(const LAS bf16x8*)(Bt + (16 * (w.tc0 + c) + w.l15) * IMG_LD + 32 * s + 8 * w.q);
            acc1[c] = __builtin_amdgcn_mfma_f32_16x16x32_bf16(a1, b, acc1[c], 0, 0, 0); acc2[c] = __builtin_amdgcn_mfma_f32_16x16x32_bf16(a2, b, acc2[c], 0, 0, 0); }
    }
}
__device__ __forceinline__ void mm64_2b(const LAS bf16* A, const LAS bf16* Bt1, const LAS bf16* Bt2, f32x4 (&acc1)[2], f32x4 (&acc2)[2], const MmCtx& w) {
#pragma unroll
    for (int s = 0; s < 2; ++s) {
        const bf16x8 a = *(const LAS bf16x8*)(A + (16 * w.tr + w.l15) * IMG_LD + 32 * s + 8 * w.q);
#pragma unroll
        for (int c = 0; c < 2; ++c) { const bf16x8 b1 = *(const LAS bf16x8*)(Bt1 + (16 * (w.tc0 + c) + w.l15) * IMG_LD + 32 * s + 8 * w.q), b2 = *(const LAS bf16x8*)(Bt2 + (16 * (w.tc0 + c) + w.l15) * IMG_LD + 32 * s + 8 * w.q);
            acc1[c] = __builtin_amdgcn_mfma_f32_16x16x32_bf16(a, b1, acc1[c], 0, 0, 0); acc2[c] = __builtin_amdgcn_mfma_f32_16x16x32_bf16(a, b2, acc2[c], 0, 0, 0); }
    }
}
__device__ __forceinline__ float dpp_x1(float v) { return __int_as_float(__builtin_amdgcn_update_dpp(0, __float_as_int(v), 0xB1, 0xF, 0xF, true)); }
__device__ __forceinline__ float dpp_x2(float v) { return __int_as_float(__builtin_amdgcn_update_dpp(0, __float_as_int(v), 0x4E, 0xF, 0xF, true)); }
__device__ __forceinline__ f32x4 quad_transpose(const f32x4 v, int b) {
    const bool odd = (b & 1) != 0, hi = (b & 2) != 0;
    const float r0 = dpp_x1(odd ? v[0] : v[1]), r1 = dpp_x1(odd ? v[2] : v[3]);
    const float p0a = odd ? r0 : v[0], p0b = odd ? v[1] : r0, p1a = odd ? r1 : v[2], p1b = odd ? v[3] : r1;
    const float ra = dpp_x2(hi ? p0a : p1a), rb = dpp_x2(hi ? p0b : p1b);
    return hi ? (f32x4){ra, rb, p1a, p1b} : (f32x4){p0a, p0b, ra, rb};
}
__device__ __forceinline__ void st_rm(LAS bf16* img, const f32x4 v, int tr, int tc, const MmCtx& w) {
    const unsigned p01 = pk2(v[0], v[1]), p23 = pk2(v[2], v[3]); LAS bf16* d = img + (16 * tr + 4 * w.q) * IMG_LD + 16 * tc + w.l15;
    d[0] = (bf16)p01; d[IMG_LD] = (bf16)(p01 >> 16); d[2 * IMG_LD] = (bf16)p23; d[3 * IMG_LD] = (bf16)(p23 >> 16);
}
__device__ __forceinline__ void st_tr(LAS bf16* img, const f32x4 v, int tr, int tc, const MmCtx& w) {
    u32x2 o; o.x = pk2(v[0], v[1]); o.y = pk2(v[2], v[3]); *(LAS u32x2*)(img + (16 * tc + w.l15) * IMG_LD + 16 * tr + 4 * w.q) = o;
}
__device__ __forceinline__ void img_to_global(const LAS bf16* img, bf16* g, int tid) { const int row = tid >> 3, ch = tid & 7; *(u32x4*)(g + row * 64 + ch * 8) = *(const LAS u32x4*)(img + row * IMG_LD + ch * 8); }
__device__ __forceinline__ void st_tm8(LAS bf16* img, int t, int cg, const float (&v)[8]) {
    u32x4 o; o.x = pk2(v[0], v[1]); o.y = pk2(v[2], v[3]); o.z = pk2(v[4], v[5]); o.w = pk2(v[6], v[7]); *(LAS u32x4*)(img + t * IMG_LD + 8 * cg) = o;
}
__device__ __forceinline__ void st_cm8(LAS bf16* img, int t, int cg, const float (&v)[8]) {
#pragma unroll
    for (int i = 0; i < 8; i += 2) { const unsigned p = pk2(v[i], v[i + 1]); img[(8 * cg + i) * IMG_LD + t] = (bf16)p; img[(8 * cg + i + 1) * IMG_LD + t] = (bf16)(p >> 16); }
}
__device__ __forceinline__ float red8(float v) { v += __shfl_xor(v, 1); v += __shfl_xor(v, 2); v += __shfl_xor(v, 4); return v; }
__device__ __forceinline__ void unpack8(const u32x4 w, float (&o)[8]) { o[0] = lo16(w.x); o[1] = hi16(w.x); o[2] = lo16(w.y); o[3] = hi16(w.y); o[4] = lo16(w.z); o[5] = hi16(w.z); o[6] = lo16(w.w); o[7] = hi16(w.w); }
__device__ __forceinline__ void ldp8(const float* p, float (&o)[8]) { const f32x4 a = *(const f32x4*)p, b = *(const f32x4*)(p + 4); o[0] = a.x; o[1] = a.y; o[2] = a.z; o[3] = a.w; o[4] = b.x; o[5] = b.y; o[6] = b.z; o[7] = b.w; }

struct RwkvP { const bf16* rkv; const bf16* wag; const float *mu_rkv, *w0, *a0, *k_k, *k_a, *r_k, *ln_w, *ln_b; };
struct RwkvRaw { u32x4 kc, kp, vc, vp, wl, al, rc, rp, gg; };
template <bool PASS3>
__device__ __forceinline__ void rwkv_load(const RwkvP& P, int cidx, int tid, RwkvRaw& R) {
    const int t = tid >> 3, cg = tid & 7, bh = cidx >> 7, c = cidx & 127, b = bh >> 3, h = bh & 7, ch = h * 64 + 8 * cg;
    const size_t tok = (size_t)b * SEQ + c * 64 + t; const bool first = (c == 0 && t == 0);
    const bf16* row = P.rkv + tok * 1536 + ch; const bf16* prow = first ? row : row - 1536;
    R.kc = *(const u32x4*)(row + 512); R.vc = *(const u32x4*)(row + 1024); R.kp = *(const u32x4*)(prow + 512); R.vp = *(const u32x4*)(prow + 1024);
    R.wl = *(const u32x4*)(P.wag + tok * 1536 + ch); R.al = *(const u32x4*)(P.wag + tok * 1536 + 512 + ch);
    if (PASS3) { R.rc = *(const u32x4*)row; R.rp = *(const u32x4*)prow; R.gg = *(const u32x4*)(P.wag + tok * 1536 + 1024 + ch); }
}
constexpr int RC_OFF = 14 * IMG_B;
struct RwkvC { const LAS float* p; };
__device__ __forceinline__ void ldl8(const LAS float* p, float (&o)[8]) { const f32x4 a = *(const LAS f32x4*)p, b = *(const LAS f32x4*)(p + 4); o[0] = a.x; o[1] = a.y; o[2] = a.z; o[3] = a.w; o[4] = b.x; o[5] = b.y; o[6] = b.z; o[7] = b.w; }
__device__ __forceinline__ void rwkv_consts(LAS unsigned char* lds, const RwkvP& P, int h, int tid, RwkvC& C) {
    LAS float* base = (LAS float*)(lds + RC_OFF);
    if (tid < 64) { const int cg = tid >> 3, k = tid & 7, ch = h * 64 + 8 * cg; const float* src = k == 0 ? P.mu_rkv + ch : k == 1 ? P.mu_rkv + 512 + ch : k == 2 ? P.mu_rkv + 1024 + ch : k == 3 ? P.w0 + ch : k == 4 ? P.a0 + ch : k == 5 ? P.k_k + ch : P.k_a + ch;
        if (k < 7) { const f32x4 a = *(const f32x4*)src, b = *(const f32x4*)(src + 4); *(LAS f32x4*)(base + cg * 64 + k * 8) = a; *(LAS f32x4*)(base + cg * 64 + k * 8 + 4) = b; } }
    LDS_BARRIER();
    C.p = base + (tid & 7) * 64;
}
template <bool PASS3>
__device__ __forceinline__ void rwkv_prep(const RwkvRaw& R, const RwkvC& C, bool first, float (&kq)[8], float (&vv)[8], float (&rr)[8], float (&kap)[8], float (&bet)[8], float (&lw)[8]) {
    float kc[8], kp[8], vc[8], vp[8], k[8], wl[8], al[8], a[8], m[8];
    unpack8(R.kc, kc); unpack8(R.vc, vc); unpack8(R.kp, kp); unpack8(R.vp, vp); unpack8(R.wl, wl); unpack8(R.al, al);
    const float pm = first ? 0.f : 1.f;
    ldl8(C.p + 8, m);
#pragma unroll
    for (int i = 0; i < 8; ++i) k[i] = kc[i] + (pm * kp[i] - kc[i]) * m[i];
    ldl8(C.p + 16, m);
#pragma unroll
    for (int i = 0; i < 8; ++i) vv[i] = vc[i] + (pm * vp[i] - vc[i]) * m[i];
    if (PASS3) { float rc[8], rp[8]; unpack8(R.rc, rc); unpack8(R.rp, rp); ldl8(C.p, m);
#pragma unroll
        for (int i = 0; i < 8; ++i) rr[i] = rc[i] + (pm * rp[i] - rc[i]) * m[i];
    } else {
#pragma unroll
        for (int i = 0; i < 8; ++i) rr[i] = 0.f;
    }
    float ss = 0.f;
    ldl8(C.p + 24, m);
#pragma unroll
    for (int i = 0; i < 8; ++i) lw[i] = -0.6065306597126334f * fsigmoid(m[i] + wl[i]);
    ldl8(C.p + 32, m);
#pragma unroll
    for (int i = 0; i < 8; ++i) a[i] = fsigmoid(m[i] + al[i]);
    ldl8(C.p + 40, m);
#pragma unroll
    for (int i = 0; i < 8; ++i) { kap[i] = k[i] * m[i]; ss += kap[i] * kap[i]; }
    ss = red8(ss);
    const float inv = 1.0f / fmaxf(sqrtf(ss), 1e-12f);
    ldl8(C.p + 48, m);
#pragma unroll
    for (int i = 0; i < 8; ++i) { kap[i] *= inv; bet[i] = kap[i] * a[i]; kq[i] = k[i] * (1.0f + (a[i] - 1.0f) * m[i]); }
}
template <int SEGSLOT>
__device__ __forceinline__ void rwkv_cumsum(LAS unsigned char* lds, int tid, const float (&lw)[8], float (&cum)[8], float (&cumL)[8]) {
    LAS float* SEG = (LAS float*)(lds + SEGSLOT * IMG_B);
    const int lane = tid & 63, wv = tid >> 6, cg = tid & 7, tl = lane >> 3;
#pragma unroll
    for (int i = 0; i < 8; ++i) { float v = lw[i];
        { const float u = __shfl_up(v, 8); v += (tl >= 1) ? u : 0.f; }
        { const float u = __shfl_up(v, 16); v += (tl >= 2) ? u : 0.f; }
        { const float u = __shfl_up(v, 32); v += (tl >= 4) ? u : 0.f; }
        cum[i] = v; }
    if (tl == 7) {
#pragma unroll
        for (int i = 0; i < 8; ++i) SEG[wv * 64 + 8 * cg + i] = cum[i]; }
    LDS_BARRIER();
    float pre[8], tot[8];
#pragma unroll
    for (int i = 0; i < 8; ++i) { pre[i] = 0.f; tot[i] = 0.f; }
#pragma unroll 1
    for (int s2 = 0; s2 < 8; ++s2) { const f32x4 a = *(const LAS f32x4*)(SEG + s2 * 64 + 8 * cg), b = *(const LAS f32x4*)(SEG + s2 * 64 + 8 * cg + 4); const float m = (s2 < wv) ? 1.f : 0.f;
        tot[0] += a.x; tot[1] += a.y; tot[2] += a.z; tot[3] += a.w; tot[4] += b.x; tot[5] += b.y; tot[6] += b.z; tot[7] += b.w;
        pre[0] += m * a.x; pre[1] += m * a.y; pre[2] += m * a.z; pre[3] += m * a.w; pre[4] += m * b.x; pre[5] += m * b.y; pre[6] += m * b.z; pre[7] += m * b.w; }
#pragma unroll
    for (int i = 0; i < 8; ++i) { cum[i] += pre[i]; cumL[i] = tot[i]; }
}
#define Z4 (f32x4){0.f, 0.f, 0.f, 0.f}

__device__ __forceinline__ void rwkv_pass1(LAS unsigned char* lds, const RwkvP& P, int c0, int n, int tid, bf16* QCT, float* HCT, bf16* M1G, bf16* YLG, float* DLG, float* BONUS) {
    const int lane = tid & 63, wv = __builtin_amdgcn_readfirstlane(tid >> 6); MmCtx w; w.tr = wv >> 1; w.tc0 = (wv & 1) * 2; w.l15 = lane & 15; w.q = lane >> 4;
    const int t = tid >> 3, cg = tid & 7, ch = ((c0 >> 7) & 7) * 64 + 8 * cg;
    RwkvC C; rwkv_consts(lds, P, (c0 >> 7) & 7, tid, C);
    RwkvRaw R; rwkv_load<true>(P, c0, tid, R);
    for (int ci = 0; ci < n; ++ci) {
        const int cidx = c0 + ci;
        {
            float kq[8], vv[8], rr[8], kap[8], bet[8], lw[8], cum[8], cumL[8];
            rwkv_prep<true>(R, C, (cidx & 127) == 0 && t == 0, kq, vv, rr, kap, bet, lw);
            rwkv_cumsum<10>(lds, tid, lw, cum, cumL);
            { float bs = 0.f, rk[8]; ldp8(P.r_k + ch, rk);
#pragma unroll
              for (int i = 0; i < 8; ++i) bs += rr[i] * kq[i] * rk[i];
              bs = red8(bs); if (cg == 0) BONUS[(size_t)cidx * 64 + t] = bs; }
            float x[8], y[8];
#pragma unroll
            for (int i = 0; i < 8; ++i) { const float en = __expf(-cum[i]); x[i] = kq[i] * en; y[i] = bet[i] * en; }
            st_tm8(IMG(0), t, cg, x);
            st_tm8(IMG(1), t, cg, y);
#pragma unroll
            for (int i = 0; i < 8; ++i) x[i] = kap[i] * __expf(cum[i] - lw[i]);
            st_tm8(IMG(2), t, cg, x);
            st_cm8(IMG(3), t, cg, x);
#pragma unroll
            for (int i = 0; i < 8; ++i) x[i] = rr[i] * __expf(cum[i]);
            st_tm8(IMG(11), t, cg, x);
#pragma unroll
            for (int i = 0; i < 8; ++i) { const float eh = __expf(cumL[i] - cum[i]); x[i] = kq[i] * eh; y[i] = bet[i] * eh; }
            st_cm8(IMG(4), t, cg, x);
            st_cm8(IMG(5), t, cg, y);
            st_cm8(IMG(6), t, cg, vv);
            if (t == 0) {
#pragma unroll
                for (int i = 0; i < 8; ++i) DLG[(size_t)cidx * 64 + 8 * cg + i] = __expf(cumL[i]);
            }
        }
        if (ci + 1 < n) rwkv_load<true>(P, cidx + 1, tid, R);
        LDS_BARRIER();
        f32x4 accX[2];
        {
            f32x4 a[2] = {Z4, Z4}, kk[2] = {Z4, Z4};
            mm64_2a(IMG(1), IMG(0), IMG(2), a, kk, w);
#pragma unroll
            for (int c = 0; c < 2; ++c) { const int nn = 16 * (w.tc0 + c) + w.l15;
#pragma unroll
                for (int r = 0; r < 4; ++r) { const int m = 16 * w.tr + 4 * w.q + r; a[c][r] = (m < nn) ? a[c][r] : 0.f; kk[c][r] = (m < nn) ? kk[c][r] : 0.f; accX[c][r] = ((m == nn) ? 1.0f : 0.f) - a[c][r]; }
                st_rm(IMG(7), a[c], w.tr, w.tc0 + c, w); st_tr(IMG(8), a[c], w.tr, w.tc0 + c, w); st_rm(IMG(10), accX[c], w.tr, w.tc0 + c, w); st_rm(IMG(9), kk[c], w.tr, w.tc0 + c, w); }
        }
        LDS_BARRIER();
        {
            f32x4 p[2] = {Z4, Z4};
            mm64(IMG(7), IMG(8), p, w);
#pragma unroll
            for (int c = 0; c < 2; ++c) { st_rm(IMG(12), p[c], w.tr, w.tc0 + c, w); st_tr(IMG(13), p[c], w.tr, w.tc0 + c, w); }
        }
        LDS_BARRIER();
#define NEUMANN(XC, XN, PC, PTC, PN, PTN, LASTR) do { if (LASTR) { mm64(IMG(XC), IMG(PTC), accX, w); _Pragma("unroll") for (int c = 0; c < 2; ++c) st_tr(IMG(7), accX[c], w.tr, w.tc0 + c, w); }   \
            if (!(LASTR)) { f32x4 p[2] = {Z4, Z4}; mm64_2a(IMG(XC), IMG(PC), IMG(PTC), accX, p, w); \
                _Pragma("unroll") for (int c = 0; c < 2; ++c) { st_rm(IMG(PN), p[c], w.tr, w.tc0 + c, w); st_tr(IMG(PTN), p[c], w.tr, w.tc0 + c, w); st_rm(IMG(XN), accX[c], w.tr, w.tc0 + c, w); } } \
            LDS_BARRIER(); } while (0)
        NEUMANN(10, 2, 12, 13, 7, 8, false);
        NEUMANN(2, 10, 7, 8, 12, 13, false);
        NEUMANN(10, 2, 12, 13, 7, 8, false);
        NEUMANN(2, 10, 7, 8, 12, 13, false);
        NEUMANN(10, 2, 12, 13, 7, 8, true);
#undef NEUMANN
        {
            f32x4 a[2] = {Z4, Z4}, g[2] = {Z4, Z4}, kr[2] = {Z4, Z4}, br[2] = {Z4, Z4};
            mm64_2a(IMG(3), IMG(9), IMG(7), a, g, w); mm64_2b(IMG(11), IMG(0), IMG(1), kr, br, w);
#pragma unroll
            for (int c = 0; c < 2; ++c) { const int nn = 16 * (w.tc0 + c) + w.l15;
#pragma unroll
                for (int r = 0; r < 4; ++r) { const int m = 16 * w.tr + 4 * w.q + r; kr[c][r] = (nn <= m) ? kr[c][r] : 0.f; br[c][r] = (nn <= m) ? br[c][r] : 0.f; }
                st_rm(IMG(12), a[c], w.tr, w.tc0 + c, w); st_tr(IMG(8), g[c], w.tr, w.tc0 + c, w); st_rm(IMG(2), kr[c], w.tr, w.tc0 + c, w); st_rm(IMG(10), br[c], w.tr, w.tc0 + c, w); }
        }
        LDS_BARRIER();
        {
            f32x4 u[2] = {Z4, Z4}, qc[2] = {Z4, Z4}, m1[2] = {Z4, Z4};
            mm64(IMG(6), IMG(8), u, w); mm64(IMG(5), IMG(12), qc, w); mm64(IMG(10), IMG(12), m1, w);
#pragma unroll
            for (int c = 0; c < 2; ++c) { st_rm(IMG(13), u[c], w.tr, w.tc0 + c, w);
                const int tc = w.tc0 + c, cp = 32 * (tc >> 1) + 8 * (w.l15 >> 2) + 4 * (tc & 1) + (w.l15 & 3);
                const unsigned p01 = pk2(qc[c][0], qc[c][1]), p23 = pk2(qc[c][2], qc[c][3]); LAS bf16* d = IMG(0) + (16 * w.tr + 4 * w.q) * IMG_LD + cp;
                d[0] = (bf16)p01; d[IMG_LD] = (bf16)(p01 >> 16); d[2 * IMG_LD] = (bf16)p23; d[3 * IMG_LD] = (bf16)(p23 >> 16);
                f32x4 mv;
#pragma unroll
                for (int r = 0; r < 4; ++r) mv[r] = bf2f(IMG(11)[(16 * w.tr + 4 * w.q + r) * IMG_LD + 16 * tc + w.l15]) - m1[c][r];
                st_rm(IMG(1), mv, w.tr, tc, w); }
        }
        LDS_BARRIER();
        {
            f32x4 hp[2] = {Z4, Z4}, hn[2] = {Z4, Z4}, yp[2] = {Z4, Z4}, yn[2] = {Z4, Z4};
            mm64(IMG(4), IMG(6), hp, w); mm64(IMG(5), IMG(13), hn, w); mm64(IMG(2), IMG(6), yp, w); mm64(IMG(10), IMG(13), yn, w);
#pragma unroll
            for (int c = 0; c < 2; ++c) { *(f32x4*)(HCT + (((size_t)cidx * 16 + w.tr * 4 + w.tc0 + c) * 64 + lane) * 4) = hp[c] - hn[c]; st_rm(IMG(3), yp[c] - yn[c], w.tr, w.tc0 + c, w); }
            img_to_global(IMG(1), M1G + (size_t)cidx * 4096, tid);
            img_to_global(IMG(0), QCT + (size_t)cidx * 4096, tid);
        }
        LDS_BARRIER();
        img_to_global(IMG(3), YLG + (size_t)cidx * 4096, tid);
    }
}

constexpr int P2_SLOT = 12544, P2_DEPTH = 5;
__device__ __forceinline__ void rwkv_pass2(LAS unsigned char* lds, int bh, int ti, int lane, const bf16* QCT, const float* HCT, const float* DLG, bf16* S0G) {
    const int l15 = lane & 15, q = lane >> 4;
    f32x4 X[4];
#pragma unroll
    for (int tj = 0; tj < 4; ++tj) X[tj] = Z4;
#define P2_DMA(cc) do { const size_t ci_ = (size_t)bh * 128 + (cc); LAS unsigned char* sl_ = lds + ((cc) % P2_DEPTH) * P2_SLOT; \
        _Pragma("unroll") for (int i = 0; i < 8; ++i) { const int row_ = i * 8 + (lane >> 3), pc_ = (lane & 7) ^ (row_ & 7); \
            __builtin_amdgcn_global_load_lds((const unsigned*)((const char*)QCT + (ci_ * 64 + row_) * 128 + pc_ * 16), (LAS unsigned*)(sl_ + i * 1024), 16, 0, 0); } \
        _Pragma("unroll") for (int tj = 0; tj < 4; ++tj) __builtin_amdgcn_global_load_lds((const unsigned*)((const char*)HCT + ((ci_ * 16 + tj * 4 + ti) * 64 + lane) * 16), (LAS unsigned*)(sl_ + 8192 + tj * 1024), 16, 0, 0); \
        __builtin_amdgcn_global_load_lds((const unsigned*)((const char*)DLG + (ci_ * 64 + lane) * 4), (LAS unsigned*)(sl_ + 12288), 4, 0, 0); } while (0)
    P2_DMA(0); P2_DMA(1); P2_DMA(2); P2_DMA(3);
    for (int c = 0; c < 128; ++c) {
        if (c < 124) asm volatile("s_waitcnt vmcnt(39)" ::: "memory"); else asm volatile("s_waitcnt vmcnt(0)" ::: "memory");
        const LAS unsigned char* sl = lds + (c % P2_DEPTH) * P2_SLOT;
        bf16x8 a[4][2]; f32x4 h[4], d[4];
#pragma unroll
        for (int tj = 0; tj < 4; ++tj) { const int row = 16 * tj + l15;
#pragma unroll
            for (int s = 0; s < 2; ++s) a[tj][s] = *(const LAS bf16x8*)(sl + row * 128 + (((4 * s + q) ^ (row & 7)) * 16));
            h[tj] = *(const LAS f32x4*)(sl + 8192 + tj * 1024 + lane * 16); d[tj] = *(const LAS f32x4*)(sl + 12288 + (16 * tj + 4 * q) * 4); }
        asm volatile("s_waitcnt lgkmcnt(0)" ::: "memory");
        if (c + 4 < 128) P2_DMA(c + 4);
        const size_t cidx = (size_t)bh * 128 + c;
#pragma unroll
        for (int tj = 0; tj < 4; ++tj) { u32x2 o; o.x = pk2(X[tj][0], X[tj][1]); o.y = pk2(X[tj][2], X[tj][3]); *(u32x2*)(S0G + (cidx * 64 + 16 * ti + l15) * 64 + 16 * tj + 4 * q) = o; }
        bf16x8 b[2];
#pragma unroll
        for (int s = 0; s < 2; ++s) { u32x4 o; o.x = pk2(X[2 * s][0], X[2 * s][1]); o.y = pk2(X[2 * s][2], X[2 * s][3]); o.z = pk2(X[2 * s + 1][0], X[2 * s + 1][1]); o.w = pk2(X[2 * s + 1][2], X[2 * s + 1][3]); b[s] = __builtin_bit_cast(bf16x8, o); }
#pragma unroll
        for (int tj = 0; tj < 4; ++tj) { f32x4 acc = Z4;
            acc = __builtin_amdgcn_mfma_f32_16x16x32_bf16(a[tj][0], b[0], acc, 0, 0, 0); acc = __builtin_amdgcn_mfma_f32_16x16x32_bf16(a[tj][1], b[1], acc, 0, 0, 0);
            X[tj] = d[tj] * X[tj] + h[tj] - acc; }
    }
    asm volatile("s_waitcnt vmcnt(0)" ::: "memory");
#undef P2_DMA
}

__device__ __forceinline__ void rwkv_pass3(LAS unsigned char* lds, const RwkvP& P, int c0, int n, int tid, const bf16* S0G, const bf16* M1G, const bf16* YLG, const float* BONUS, bf16* MIX) {
    const int lane = tid & 63, wv = __builtin_amdgcn_readfirstlane(tid >> 6); MmCtx w; w.tr = wv >> 1; w.tc0 = (wv & 1) * 2; w.l15 = lane & 15; w.q = lane >> 4;
    const int t = tid >> 3, cg = tid & 7, bh = c0 >> 7, b = bh >> 3, h = bh & 7, ch = h * 64 + 8 * cg;
    float muv[8], lnw[8], lnb[8]; ldp8(P.mu_rkv + 1024 + ch, muv); ldp8(P.ln_w + ch, lnw); ldp8(P.ln_b + ch, lnb);
    u32x4 gS0, gM1, gYL, gvc, gvp, ggg; float gbo;
#define P3_LOAD(cc) do { const int cidx_ = (cc), c_ = cidx_ & 127; const size_t o_ = (size_t)cidx_ * 4096 + (tid >> 3) * 64 + (tid & 7) * 8; gS0 = *(const u32x4*)(S0G + o_); gM1 = *(const u32x4*)(M1G + o_); gYL = *(const u32x4*)(YLG + o_); \
        const size_t tok_ = (size_t)b * SEQ + c_ * 64 + t; const bool first_ = (c_ == 0 && t == 0); const bf16* row_ = P.rkv + tok_ * 1536 + 1024 + ch; \
        gvc = *(const u32x4*)row_; gvp = *(const u32x4*)(first_ ? row_ : row_ - 1536); ggg = *(const u32x4*)(P.wag + tok_ * 1536 + 1024 + ch); gbo = BONUS[(size_t)cidx_ * 64 + t]; } while (0)
    P3_LOAD(c0);
    for (int ci = 0; ci < n; ++ci) {
        const int cidx = c0 + ci, c = cidx & 127;
        float vv[8], gg[8]; const float bonus = gbo;
        { float vc[8], vp[8]; unpack8(gvc, vc); unpack8(gvp, vp); unpack8(ggg, gg); const float pm = (c == 0 && t == 0) ? 0.f : 1.f;
#pragma unroll
          for (int i = 0; i < 8; ++i) vv[i] = vc[i] + (pm * vp[i] - vc[i]) * muv[i];
          const int row = tid >> 3, chk = tid & 7; *(LAS u32x4*)(IMG(0) + row * IMG_LD + chk * 8) = gM1; *(LAS u32x4*)(IMG(1) + row * IMG_LD + chk * 8) = gS0; *(LAS u32x4*)(IMG(2) + row * IMG_LD + chk * 8) = gYL; }
        if (ci + 1 < n) P3_LOAD(cidx + 1);
        LDS_BARRIER();
        {
            f32x4 y[2] = {Z4, Z4};
            mm64(IMG(0), IMG(1), y, w);
            LAS float* YF = (LAS float*)(lds + 10 * IMG_B);
#pragma unroll
            for (int cc = 0; cc < 2; ++cc)
#pragma unroll
                for (int r = 0; r < 4; ++r) { const int m = 16 * w.tr + 4 * w.q + r, nn = 16 * (w.tc0 + cc) + w.l15; YF[m * 65 + nn] = y[cc][r] + bf2f(IMG(2)[m * IMG_LD + nn]); }
        }
        LDS_BARRIER();
        {
            const LAS float* YF = (const LAS float*)(lds + 10 * IMG_B);
            float y[8], s = 0.f;
#pragma unroll
            for (int i = 0; i < 8; ++i) { y[i] = YF[t * 65 + 8 * cg + i]; s += y[i]; }
            const float mean = red8(s) * (1.0f / 64.0f); float qv = 0.f;
#pragma unroll
            for (int i = 0; i < 8; ++i) { y[i] -= mean; qv += y[i] * y[i]; }
            const float rstd = rsqrtf(red8(qv) * (1.0f / 64.0f) + 64e-5f);
            float o[8];
#pragma unroll
            for (int i = 0; i < 8; ++i) o[i] = (y[i] * rstd * lnw[i] + lnb[i] + bonus * vv[i]) * gg[i];
            const size_t tok = (size_t)b * SEQ + c * 64 + t;
            u32x4 ov; ov.x = pk2(o[0], o[1]); ov.y = pk2(o[2], o[3]); ov.z = pk2(o[4], o[5]); ov.w = pk2(o[6], o[7]);
            *(u32x4*)(MIX + tok * 1024 + 512 + ch) = ov;
        }
        LDS_BARRIER();
    }
#undef P3_LOAD
}

constexpr int RW_LD = 1032;
__device__ __forceinline__ void router_phase(const Ctx& cx, const bf16* X1, const float* gnorm, const float* rw, const float* rb, unsigned char* H2, int* TOPE, float* TOPG, unsigned* HIST) {
    LAS bf16* WH = (LAS bf16*)cx.lds; LAS bf16* WL = WH + 32 * RW_LD;
    LAS unsigned* hcnt = (LAS unsigned*)(cx.lds + 135168);
    const int lane = cx.lane, l15 = lane & 15, q = lane >> 4;
    for (int idx = cx.tid; idx < 32768; idx += NTHR) { const int col = idx >> 5, e = idx & 31; const float v = rw[idx] * gnorm[col];
        const unsigned h = cvt_pk_bf16(v, 0.f) & 0xffffu; const float lo = v - bf2f(h); WH[e * RW_LD + col] = (bf16)h; WL[e * RW_LD + col] = (bf16)(cvt_pk_bf16(lo, 0.f) & 0xffffu); }
    const float b0 = rb[l15], b1 = rb[l15 + 16];
    for (int tb = cx.wg; tb < 256; tb += cx.G) {
        if (cx.tid < 32) hcnt[cx.tid] = 0u;
        __syncthreads();
        const int tok0 = tb * 128 + cx.wave * 16;
        const bf16* xrow = X1 + (size_t)(tok0 + l15) * 1024 + 8 * q;
        f32x4 acc[2] = {(f32x4){0.f, 0.f, 0.f, 0.f}, (f32x4){0.f, 0.f, 0.f, 0.f}}; float ss = 0.f;
#pragma unroll 8
        for (int s = 0; s < 32; ++s) {
            const u32x4 xw = *(const u32x4*)(xrow + 32 * s);
            { const float a0 = lo16(xw.x), a1 = hi16(xw.x), a2 = lo16(xw.y), a3 = hi16(xw.y), a4 = lo16(xw.z), a5 = hi16(xw.z), a6 = lo16(xw.w), a7 = hi16(xw.w);
              ss += (a0 * a0 + a1 * a1) + (a2 * a2 + a3 * a3) + (a4 * a4 + a5 * a5) + (a6 * a6 + a7 * a7); }
            const bf16x8 ah = __builtin_bit_cast(bf16x8, xw);
#pragma unroll
            for (int n = 0; n < 2; ++n) { const bf16x8 bh = *(const LAS bf16x8*)(WH + (l15 + 16 * n) * RW_LD + 32 * s + 8 * q), bl = *(const LAS bf16x8*)(WL + (l15 + 16 * n) * RW_LD + 32 * s + 8 * q);
                acc[n] = __builtin_amdgcn_mfma_f32_16x16x32_bf16(ah, bh, acc[n], 0, 0, 0); acc[n] = __builtin_amdgcn_mfma_f32_16x16x32_bf16(ah, bl, acc[n], 0, 0, 0); }
        }
        ss += __shfl_xor(ss, 16); ss += __shfl_xor(ss, 32);
        const float rinv_l = rsqrtf(ss * (1.f / 1024.f) + 1e-6f);
#pragma unroll
        for (int r = 0; r < 4; ++r) {
            const float ri = __shfl(rinv_l, 4 * q + r);
            float v0 = acc[0][r] * ri + b0, v1 = acc[1][r] * ri + b1; int se[4]; float sv[4];
#pragma unroll
            for (int k = 0; k < 4; ++k) { float bv = (v1 > v0) ? v1 : v0; int be = (v1 > v0) ? (l15 + 16) : l15;
#pragma unroll
                for (int off = 1; off < 16; off <<= 1) { const float ov = __shfl_xor(bv, off); const int oe = __shfl_xor(be, off); const bool take = (ov > bv) || (ov == bv && oe < be); bv = take ? ov : bv; be = take ? oe : be; }
                se[k] = be; sv[k] = bv; if (be == l15) v0 = -INFINITY; if (be == l15 + 16) v1 = -INFINITY; }
            if (l15 == r) { const int tok = tok0 + 4 * q + r;
                const float w1 = __expf(sv[1] - sv[0]), w2 = __expf(sv[2] - sv[0]), w3 = __expf(sv[3] - sv[0]); const float inv = 1.0f / (1.0f + w1 + w2 + w3);
                *(int4*)(TOPE + (size_t)tok * 4) = make_int4(se[0], se[1], se[2], se[3]);
                *(float4*)(TOPG + (size_t)tok * 4) = make_float4(inv, w1 * inv, w2 * inv, w3 * inv);
                atomicAdd((unsigned*)(hcnt + se[0]), 1u); atomicAdd((unsigned*)(hcnt + se[1]), 1u); atomicAdd((unsigned*)(hcnt + se[2]), 1u); atomicAdd((unsigned*)(hcnt + se[3]), 1u); }
        }
        const f32x4* gr = (const f32x4*)gnorm + lane;
#pragma unroll 4
        for (int i = 0; i < 16; ++i) { const float ri = __shfl(rinv_l, i); const u32x2* xr = (const u32x2*)(X1 + (size_t)(tok0 + i) * 1024) + lane; unsigned* o4 = (unsigned*)(H2 + (size_t)(tok0 + i) * 1024) + lane;
#pragma unroll
            for (int j = 0; j < 4; ++j) { const u32x2 v = xr[64 * j]; const f32x4 gg = gr[64 * j]; o4[64 * j] = pk4_fp8(lo16(v.x) * ri * gg.x, hi16(v.x) * ri * gg.y, lo16(v.y) * ri * gg.z, hi16(v.y) * ri * gg.w); } }
        __syncthreads();
        if (cx.tid < 32) HIST[tb * 32 + cx.tid] = hcnt[cx.tid];
        __syncthreads();
    }
}

constexpr int PL_BASE = 1280, PL_WCNT = 1312;
__device__ __forceinline__ void moe_plan(const Ctx& cx, const unsigned* HIST) {
    LAS int* PL = (LAS int*)(cx.lds + LDS_PLAN);
    const int e = cx.tid & 31, part = cx.tid >> 5;
    { int s = 0; for (int w = 16 * part; w < 16 * part + 16; ++w) s += (int)HIST[w * 32 + e]; PL[PL_TMP + part * 32 + e] = s; }
    __syncthreads();
    if (cx.tid < 32) { int c = 0; for (int p = 0; p < 16; ++p) c += PL[PL_TMP + p * 32 + cx.tid]; PL[PL_CNT + cx.tid] = c; }
    __syncthreads();
    if (cx.tid == 0) {
        int ps = 0;
        for (int x = 0; x < 32; ++x) { PL[PL_PSTART + x] = ps; const int pad = (PL[PL_CNT + x] + 255) & ~255; for (int i = 0; i < pad / 256; ++i) PL[PL_TILEE + ps / 256 + i] = x; ps += pad; }
        PL[PL_PSTART + 32] = ps;
        int np = 0, e0 = 0;
        while (e0 < 32 && np < 7) { PL[PL_PE0 + np] = e0; PL[PL_PROW0 + np] = PL[PL_PSTART + e0]; int rows = 0, e1 = e0;
            while (e1 < 32 && e1 - e0 < MAXEPP) { const int pad = PL[PL_PSTART + e1 + 1] - PL[PL_PSTART + e1]; if (rows + pad > RMAX && e1 > e0) break; rows += pad; ++e1; }
            e0 = e1; ++np; }
        PL[PL_PE0 + np] = 32; PL[PL_PROW0 + np] = ps; PL[PL_NPASS] = np;
    }
    __syncthreads();
}
__device__ __forceinline__ void dispatch_phase(const Ctx& cx, const unsigned* HIST, const int* TOPE, int* SLOTTOK, int* TOKSLOT) {
    LAS int* PL = (LAS int*)(cx.lds + LDS_PLAN);
    const int e5 = cx.tid & 31, part = cx.tid >> 5, lane = cx.lane;
    for (int tb = cx.wg; tb < 256; tb += cx.G) {
        { int s = 0; for (int w = 16 * part; w < 16 * part + 16; ++w) s += (w < tb) ? (int)HIST[w * 32 + e5] : 0; PL[PL_TMP + part * 32 + e5] = s; }
        const int tok = tb * 128 + (cx.tid >> 2), k = cx.tid & 3; const int e = TOPE[(size_t)tok * 4 + k];
        int rank = 0;
        for (int ee = 0; ee < 32; ++ee) { const unsigned long long mask = __ballot(e == ee); if (e == ee) rank = __popcll(mask & ((1ull << lane) - 1ull)); if (lane == 0) PL[PL_WCNT + cx.wave * 32 + ee] = __popcll(mask); }
        __syncthreads();
        if (cx.tid < 32) { int c = 0; for (int p = 0; p < 16; ++p) c += PL[PL_TMP + p * 32 + cx.tid]; PL[PL_BASE + cx.tid] = c; }
        __syncthreads();
        int off = 0; for (int w2 = 0; w2 < 8; ++w2) off += (w2 < cx.wave) ? PL[PL_WCNT + w2 * 32 + e] : 0;
        const int slot = PL[PL_PSTART + e] + PL[PL_BASE + e] + off + rank;
        SLOTTOK[slot] = tok; TOKSLOT[(size_t)tok * 4 + k] = slot;
        __syncthreads();
    }
    for (int e = cx.wg; e < 32; e += cx.G) { const int c = PL[PL_CNT + e], ps = PL[PL_PSTART + e], pe = PL[PL_PSTART + e + 1]; for (int r = ps + c + cx.tid; r < pe; r += NTHR) SLOTTOK[r] = 0; }
}
__device__ __forceinline__ void convert_pass(const Ctx& cx, int e0, int e1, const float* wg, const float* wu, const float* wd, unsigned char* WGU, unsigned char* WDN) {
    LAS float* scr = (LAS float*)(cx.lds + cx.wave * 16640);
    const int nitems = (e1 - e0) * 768;
#define CV_SRC(it_) ((((it_) % 768) >> 8) == 2 ? wd : ((((it_) % 768) >> 8) ? wu : wg)) + (size_t)(e0 + (it_) / 768) * 1048576
    int it = cx.gw; if (it >= nitems) return;
    F8Item cur; f8_issue(CV_SRC(it), 1024, 64 * (((it % 768) & 255) >> 4), 64 * ((it % 768) & 15), cx.lane, cur);
    for (;;) {
        const int nx = it + cx.NGW; const bool has = nx < nitems;
        F8Item nxt;
        if (has) f8_issue(CV_SRC(nx), 1024, 64 * (((nx % 768) & 255) >> 4), 64 * ((nx % 768) & 15), cx.lane, nxt);
        const int le = it / 768, r = it % 768, mat = r >> 8, kb = (r & 255) >> 4, nb = r & 15, n0 = 64 * nb;
        if (mat == 2) f8_finish(cur, WDN + (size_t)le * 1048576 + (size_t)n0 * 1024 + 64 * kb, 1024, 32.0f, scr, cx.lane);
        else { const int drow = (n0 >> 7) * 256 + (n0 & 127) + mat * 128; f8_finish(cur, WGU + (size_t)le * 2097152 + (size_t)drow * 1024 + 64 * kb, 1024, 32.0f, scr, cx.lane); }
        if (!has) break;
        it = nx;
#pragma unroll
        for (int i = 0; i < 16; ++i) cur.v[i] = nxt.v[i];
    }
#undef CV_SRC
}
__device__ __forceinline__ void combine_all(const Ctx& cx, const float* TOPG, const int* TOKSLOT, const unsigned char* Y, bf16* X, const float* gnorm, unsigned char* H3) {
    const int lane = cx.lane, step = cx.NGW;
    int tok = cx.gw; if (tok >= M) return;
    int4 sl = *(const int4*)(TOKSLOT + (size_t)tok * 4); float4 gs = *(const float4*)(TOPG + (size_t)tok * 4);
    u32x2 xw[4]; unsigned yw[4][4];
#define CMB_ISSUE(T, SL, XW, YW) do { const u32x2* xr_ = (const u32x2*)(X + (size_t)(T) * 1024) + lane; const int s_[4] = {SL.x, SL.y, SL.z, SL.w}; \
        _Pragma("unroll") for (int j = 0; j < 4; ++j) XW[j] = xr_[64 * j]; \
        _Pragma("unroll") for (int k = 0; k < 4; ++k) { const unsigned* yr_ = (const unsigned*)(Y + (size_t)s_[k] * 1024) + lane; _Pragma("unroll") for (int j = 0; j < 4; ++j) YW[k][j] = yr_[64 * j]; } } while (0)
    CMB_ISSUE(tok, sl, xw, yw);
    int4 sl1 = sl; float4 gs1 = gs; { const int t1 = tok + step; if (t1 < M) { sl1 = *(const int4*)(TOKSLOT + (size_t)t1 * 4); gs1 = *(const float4*)(TOPG + (size_t)t1 * 4); } }
    const f32x4* gr = (const f32x4*)gnorm + lane;
    for (;;) {
        const int t1 = tok + step, t2 = tok + 2 * step; const bool has1 = t1 < M;
        u32x2 nxw[4]; unsigned nyw[4][4];
        if (has1) CMB_ISSUE(t1, sl1, nxw, nyw);
        int4 sl2 = sl1; float4 gs2 = gs1; if (t2 < M) { sl2 = *(const int4*)(TOKSLOT + (size_t)t2 * 4); gs2 = *(const float4*)(TOPG + (size_t)t2 * 4); }
        f32x4 v[4]; const float gk[4] = {gs.x, gs.y, gs.z, gs.w};
#pragma unroll
        for (int j = 0; j < 4; ++j) v[j] = (f32x4){lo16(xw[j].x), hi16(xw[j].x), lo16(xw[j].y), hi16(xw[j].y)};
#pragma unroll
        for (int k = 0; k < 4; ++k)
#pragma unroll
            for (int j = 0; j < 4; ++j) v[j] += up4_fp8(yw[k][j]) * gk[k];
        u32x2* xo = (u32x2*)(X + (size_t)tok * 1024) + lane; float s = 0.f;
#pragma unroll
        for (int j = 0; j < 4; ++j) { u32x2 w; w.x = pk2(v[j].x, v[j].y); w.y = pk2(v[j].z, v[j].w); xo[64 * j] = w; s += (v[j].x * v[j].x + v[j].y * v[j].y) + (v[j].z * v[j].z + v[j].w * v[j].w); }
        const float rinv = rsqrtf(wave_sum(s) * (1.f / 1024.f) + 1e-6f); unsigned* o8 = (unsigned*)(H3 + (size_t)tok * 1024) + lane;
#pragma unroll
        for (int j = 0; j < 4; ++j) { const f32x4 gq = gr[64 * j]; o8[64 * j] = pk4_fp8(v[j].x * rinv * gq.x, v[j].y * rinv * gq.y, v[j].z * rinv * gq.z, v[j].w * rinv * gq.w); }
        if (!has1) break;
        tok = t1; gs = gs1; sl1 = sl2; gs1 = gs2;
#pragma unroll
        for (int j = 0; j < 4; ++j) { xw[j] = nxw[j];
#pragma unroll
            for (int k = 0; k < 4; ++k) yw[k][j] = nyw[k][j]; }
    }
#undef CMB_ISSUE
}
template <bool LAST>
__device__ __forceinline__ void combine_pass(const Ctx& cx, int e0, int e1, int row0, const int* TOPE, const float* TOPG, const int* TOKSLOT, const unsigned char* Y, bf16* X, const float* gnorm, unsigned char* H3) {
    for (int tok = cx.gw; tok < M; tok += cx.NGW) {
        const int4 es = *(const int4*)(TOPE + (size_t)tok * 4); const float4 gs = *(const float4*)(TOPG + (size_t)tok * 4); const int4 sl = *(const int4*)(TOKSLOT + (size_t)tok * 4);
        const int ee[4] = {es.x, es.y, es.z, es.w}; const float gg[4] = {gs.x, gs.y, gs.z, gs.w}; const int ss[4] = {sl.x, sl.y, sl.z, sl.w};
        bool any = false;
#pragma unroll
        for (int k = 0; k < 4; ++k) any |= (ee[k] >= e0 && ee[k] < e1);
        if (!LAST && !any) continue;
        u32x2* xr = (u32x2*)(X + (size_t)tok * 1024) + cx.lane; f32x4 v[4];
#pragma unroll
        for (int j = 0; j < 4; ++j) { const u32x2 w = xr[64 * j]; v[j] = (f32x4){lo16(w.x), hi16(w.x), lo16(w.y), hi16(w.y)}; }
#pragma unroll
        for (int k = 0; k < 4; ++k) if (ee[k] >= e0 && ee[k] < e1) { const unsigned* yr = (const unsigned*)(Y + (size_t)(ss[k] - row0) * 1024) + cx.lane; const float g = gg[k];
#pragma unroll
            for (int j = 0; j < 4; ++j) v[j] += up4_fp8(yr[64 * j]) * g; }
        if (any) {
#pragma unroll
            for (int j = 0; j < 4; ++j) { u32x2 w; w.x = pk2(v[j].x, v[j].y); w.y = pk2(v[j].z, v[j].w); xr[64 * j] = w; }
        }
        if (LAST) { float s = 0.f;
#pragma unroll
            for (int j = 0; j < 4; ++j) s += (v[j].x * v[j].x + v[j].y * v[j].y) + (v[j].z * v[j].z + v[j].w * v[j].w);
            const float rinv = rsqrtf(wave_sum(s) * (1.f / 1024.f) + 1e-6f); const f32x4* gr = (const f32x4*)gnorm + cx.lane; unsigned* o8 = (unsigned*)(H3 + (size_t)tok * 1024) + cx.lane;
#pragma unroll
            for (int j = 0; j < 4; ++j) { const f32x4 gq = gr[64 * j]; o8[64 * j] = pk4_fp8(v[j].x * rinv * gq.x, v[j].y * rinv * gq.y, v[j].z * rinv * gq.z, v[j].w * rinv * gq.w); } }
    }
}

#define HBUF ((bf16*)(ws + WS_R1))
#define RKV ((bf16*)(ws + WS_RKV))
#define WAG ((bf16*)(ws + WS_WAG))
#define AG ((bf16*)(ws + WS_AG))
#define UB ((bf16*)(ws + WS_U))
#define LP ((bf16*)(ws + WS_LP))
#define LACT ((bf16*)(ws + WS_LACT))
#define Y1 ((bf16*)(ws + WS_Y1))
#define MIX ((bf16*)(ws + WS_R1))
#define EBUF ((float*)(ws + WS_LP))
#define S0G ((bf16*)(ws + WS_LP))
#define QCT ((bf16*)(ws + WS_U))
#define HCT ((float*)(ws + WS_R1))
#define W1G ((bf16*)(ws + WS_W1))
#define ULG ((bf16*)(ws + WS_ULOC))
#define DLG ((float*)(ws + WS_DL))
#define ATG ((float*)(ws + WS_AT))
#define WCAT ((bf16*)(ws + WS_WCAT))
#define WL2 ((bf16*)(ws + WS_WL2))
#define WGLU ((bf16*)(ws + WS_WGLU))
#define WPP ((bf16*)(ws + WS_WPP))
#define WOUT ((bf16*)(ws + WS_WOUT))
#define WPG ((unsigned char*)(ws + WS_WPG))
#define S5BT ((bf16*)(ws + WS_S5BT))
#define S5ET ((bf16*)(ws + WS_S5ET))
#define PBF ((bf16*)(ws + WS_PBF))
#define H2 ((unsigned char*)(ws + WS_H2))
#define WGU ((unsigned char*)(ws + WS_WGU))
#define WDN ((unsigned char*)(ws + WS_WDN))
#define ACT ((unsigned char*)(ws + WS_ACT))
#define YB ((unsigned char*)(ws + WS_Y))
#define XB ((bf16*)(ws + WS_XB))
#define PP ((bf16*)(ws + WS_ACT))
#define HIST ((unsigned*)(ws + WS_HIST))
#define TOPE ((int*)(ws + WS_TOPE))
#define TOPG ((float*)(ws + WS_TOPG))
#define TOKSLOT ((int*)(ws + WS_TOKSLOT))
#define SLOTTOK ((int*)(ws + WS_SLOTTOK))
#ifndef FUSE_FNORM
#define FUSE_FNORM 1
#endif
#ifndef SPLIT_P5
#define SPLIT_P5 1
#endif
#ifndef MOE_SP2
#define MOE_SP2 true
#endif
#ifndef MOE_ALIGN
#define MOE_ALIGN true
#endif
#ifndef PROBE_PH
#define PROBE_PH -1
#endif
#ifndef PROBE_N
#define PROBE_N 2
#endif
#define REPS(k) ((((k) >= 10 && (k) < 28) ? 10 + ((k) - 10) % 3 : (k)) == PROBE_PH ? PROBE_N : 1)
#ifndef ONLY_PHASE
#define ONLY_PHASE -1
#endif
constexpr int NPH = 31;
struct Args { const float* in[42]; float* out; unsigned char* ws; int ph_lo, ph_hi; };

__global__ void __launch_bounds__(NTHR, 2) mk_fwd(Args args) {
    extern __shared__ __attribute__((aligned(16))) unsigned char lds_raw[];
    LAS unsigned char* lds = (LAS unsigned char*)lds_raw;
#define CAS __attribute__((address_space(4)))
#define FRESH_CX const CAS char* ka_ = (const CAS char*)__builtin_amdgcn_kernarg_segment_ptr(); asm volatile("" : "+s"(ka_)); const float* const CAS* I = (const float* const CAS*)ka_; unsigned char* ws = *(unsigned char* const CAS*)(ka_ + 344); float* OUTP = *(float* const CAS*)(ka_ + 336); (void)I; (void)ws; (void)OUTP; \
    Ctx cx; { int t_ = threadIdx.x; asm volatile("" : "+v"(t_)); cx.lds = lds; cx.tid = t_; cx.lane = t_ & 63; cx.wave = __builtin_amdgcn_readfirstlane(t_ >> 6); cx.G = gridDim.x; cx.wg = blockIdx.x; cx.gw = cx.wg * NWAVES + cx.wave; cx.NGW = cx.G * NWAVES; }
    unsigned char* ws = args.ws;
    const int lo = args.ph_lo, hi = args.ph_hi;
    volatile LAS unsigned* MISC = (volatile LAS unsigned*)(lds + LDS_MISC);
    if (threadIdx.x < 64) MISC[threadIdx.x] = 0u;
    __syncthreads();
    XcdBarrier bar; bar.bar = (unsigned*)(ws + WS_CTL) + CW_BAR; bar.x = 0; bar.st = nullptr;
    if (hi - lo > 1) bar = xcd_barrier_post((unsigned*)(ws + WS_CTL) + CW_BAR, MISC + 8);

#define IN(k) ((ONLY_PHASE < 0 || ONLY_PHASE == (k) || (ONLY_PHASE >= 10 && ONLY_PHASE < 28 && (k) >= 10 && (k) < 28 && ((k) - 10) % 3 == (ONLY_PHASE - 10) % 3)) && lo <= (k) && (k) < hi)
#ifndef PROBE_BAR
#define PROBE_BAR 1
#endif
#ifndef PROBE_T
#define PROBE_T -1
#endif
#define STAMP() do { if (PROBE_T >= 0 && blockIdx.x == 0 && threadIdx.x == 0) { const unsigned long long t_ = __builtin_amdgcn_s_memrealtime(); MISC[16 + 2 * nst] = (unsigned)t_; MISC[17 + 2 * nst] = (unsigned)(t_ >> 32); } ++nst; } while (0)
#define SEAM(k) do { if (IN(k) && IN((k) + 1)) { for (int b_ = 0; b_ < PROBE_BAR; ++b_) xcd_barrier(bar); STAMP(); } } while (0)
    int nst = 0; STAMP();
#define MAKE_RP RwkvP RP; RP.rkv = RKV; RP.wag = WAG; RP.mu_rkv = I[13]; RP.w0 = I[15]; RP.a0 = I[18]; RP.k_k = I[23]; RP.k_a = I[24]; RP.r_k = I[25]; RP.ln_w = I[26]; RP.ln_b = I[27]
#define OPQ(v) ({ int _k = (v); asm volatile("" : "+s"(_k)); _k; })

    if (IN(0)) for (int rep_ = 0; rep_ < REPS(0); ++rep_) {
        FRESH_CX;
        for (int it = cx.wg; it < 256; it += cx.G) s5_tables_item(cx, it >> 3, it & 7, I[4], I[5], I[6], I[7], I[8], I[9], I[10], S5BT, S5ET, ATG);
        const float* mu = I[14];
        transpose_matrix(cx, I[3], 1024, 2048, WCAT, 0, 1024, 0, nullptr, 0);
        transpose_matrix(cx, I[16], 1024, 64, WCAT, 2048, 1024, 0, mu, 1);          transpose_matrix(cx, I[16], 1024, 64, WCAT, 2304, 1024, 0, mu, 0);
        transpose_matrix(cx, I[19], 1024, 64, WCAT, 2112, 1024, 0, mu + 1024, 1);   transpose_matrix(cx, I[19], 1024, 64, WCAT, 2368, 1024, 0, mu + 1024, 0);
        transpose_matrix(cx, I[21], 1024, 128, WCAT, 2176, 1024, 0, mu + 2048, 1);  transpose_matrix(cx, I[21], 1024, 128, WCAT, 2432, 1024, 0, mu + 2048, 0);
        transpose_matrix(cx, I[17], 64, 512, WL2, 0, 256, 0, nullptr, 0);
        transpose_matrix(cx, I[20], 64, 512, WL2, 512, 256, 64, nullptr, 0);
        transpose_matrix(cx, I[22], 128, 512, WL2, 1024, 256, 128, nullptr, 0);
        for (int idx = cx.wg * NTHR + cx.tid; idx < 1536 * 32; idx += cx.G * NTHR) { const int row = idx >> 5, ch = idx & 31, blk = row >> 9; const int kb = blk == 0 ? 0 : (blk == 1 ? 64 : 128), ke = blk == 0 ? 64 : (blk == 1 ? 128 : 256);
            if (ch * 8 < kb || ch * 8 >= ke) *(u32x4*)(WL2 + (size_t)row * 256 + ch * 8) = (u32x4){0u, 0u, 0u, 0u}; }
        transpose_matrix(cx, I[12], 512, 512, WGLU, 0, 512, 0, nullptr, 0);
        transpose_matrix(cx, I[39], 256, 1024, WPP, 0, 256, 0, nullptr, 0);
        transpose_matrix(cx, I[28], 1024, 1024, WOUT, 0, 1024, 0, nullptr, 0);
        { LAS float* scr = (LAS float*)(cx.lds + cx.wave * 16640);
          for (int it = cx.gw; it < 256; it += cx.NGW) { const int kb = it >> 4, nb = it & 15;
              transpose_item_fp8(I[40], 1024, 64 * kb, 64 * nb, WPG + (size_t)(64 * nb) * 1024 + 64 * kb, 1024, 32.0f, scr, cx.lane); } }
        for (int m = 2 * cx.gw; m < M; m += 2 * cx.NGW) rms_rows2_to_bf16(I[0] + (size_t)m * 1024, I[0] + (size_t)(m + 1) * 1024, I[2], HBUF + (size_t)m * 1024, HBUF + (size_t)(m + 1) * 1024, cx.lane);
        for (int m = 4 * cx.gw; m < M; m += 4 * cx.NGW) { f32x4 v[4];
#pragma unroll
            for (int r = 0; r < 4; ++r) v[r] = __builtin_nontemporal_load((const f32x4*)(I[1] + (size_t)(m + r) * 256) + cx.lane);
#pragma unroll
            for (int r = 0; r < 4; ++r) { u32x2 w; w.x = pk2(v[r].x, v[r].y); w.y = pk2(v[r].z, v[r].w); *((u32x2*)(PBF + (size_t)(m + r) * 256) + cx.lane) = w; } }
    }
    SEAM(0);
    if (IN(1)) for (int rep_ = 0; rep_ < REPS(1); ++rep_) {
        FRESH_CX;
        SchedPlain S; S.init(128, 10, cx.G, cx.wg); S.A = (const char*)HBUF; S.B = (const char*)WCAT; S.a_tile = 256 * 1024 * 2; S.b_tile = 256 * 1024 * 2;
        EpiProj E{AG, RKV, LP};
        pg8::gemm_phase<EpiProj, SchedPlain, true, true, false>(lds, cx.tid, OPQ(1024), OPQ(1024), OPQ(1024), S, E);
    }
    SEAM(1);
    if (IN(2)) for (int rep_ = 0; rep_ < REPS(2); ++rep_) {
        FRESH_CX;
        for (int m = 2 * cx.gw; m < M; m += 2 * cx.NGW) {
            const int lane = cx.lane; const bool first = (m & (SEQ - 1)) == 0;
            const u32x2 a0 = *((const u32x2*)(LP + (size_t)m * 512) + lane), a1 = *((const u32x2*)(LP + (size_t)(m + 1) * 512) + lane), b1 = *((const u32x2*)(LP + (size_t)m * 512 + 256) + lane);
            u32x2 b0 = (u32x2){0u, 0u}; if (!first) b0 = *((const u32x2*)(LP + (size_t)(m - 1) * 512 + 256) + lane);
            float v[8] = {lo16(a0.x) + lo16(b0.x), hi16(a0.x) + hi16(b0.x), lo16(a0.y) + lo16(b0.y), hi16(a0.y) + hi16(b0.y), lo16(a1.x) + lo16(b1.x), hi16(a1.x) + hi16(b1.x), lo16(a1.y) + lo16(b1.y), hi16(a1.y) + hi16(b1.y)};
#pragma unroll
            for (int i = 0; i < 8; ++i) v[i] = lane < 16 ? ftanh(v[i]) : (lane < 32 ? v[i] : fsigmoid(v[i]));
            u32x2 o; o.x = pk2(v[0], v[1]); o.y = pk2(v[2], v[3]); *((u32x2*)(LACT + (size_t)m * 256) + lane) = o;
            o.x = pk2(v[4], v[5]); o.y = pk2(v[6], v[7]); *((u32x2*)(LACT + (size_t)(m + 1) * 256) + lane) = o;
        }
    }
    SEAM(2);
    if (IN(3)) for (int rep_ = 0; rep_ < REPS(3); ++rep_) {
        FRESH_CX;
        { SchedPlain S; S.init(128, 6, cx.G, cx.wg); S.A = (const char*)LACT; S.B = (const char*)WL2; S.a_tile = 256 * 256 * 2; S.b_tile = 256 * 256 * 2;
          EpiBf16Plain E{WAG, 1536};
          pg8::gemm_phase<EpiBf16Plain, SchedPlain, true, true, false>(lds, cx.tid, OPQ(256), OPQ(256), OPQ(256), S, E); }
        { SchedS5 S; S.init(128, 1, cx.G, cx.wg); S.A = (const char*)AG; S.B = (const char*)S5ET; S.a_tile = 256 * 640 * 2; S.b_tile = 0; S.b_group = 256 * 512 * 2;
          EpiF32 E{EBUF, 256};
          pg8::gemm_phase<EpiF32, SchedS5, true, true, false>(lds, cx.tid, OPQ(512), OPQ(640), OPQ(512), S, E); }
    }
    SEAM(3);
    if (IN(4)) for (int rep_ = 0; rep_ < REPS(4); ++rep_) {
        FRESH_CX;
        for (int base = cx.wg * 32; base < 8192; base += cx.G * 32) { const int idx = base + (cx.lane & 31), b = idx >> 11, g = (idx >> 6) & 31, p = idx & 63, w8 = cx.wave;
            LAS float* CE = (LAS float*)lds;
            const float ar = ATG[(g * 64 + p) * 2], ai = ATG[(g * 64 + p) * 2 + 1];
            const size_t row0 = (size_t)g * 1024 + b * 256 + 32 * w8;
            float er[32], ei[32];
            if (cx.lane < 32) {
#pragma unroll
                for (int k = 0; k < 32; ++k) { er[k] = EBUF[(row0 + k) * 256 + p]; ei[k] = EBUF[(row0 + k) * 256 + 64 + p]; }
                float sr = 0.f, si = 0.f;
#pragma unroll
                for (int k = 0; k < 32; ++k) { const float nr = ar * sr - ai * si + er[k], ni = ar * si + ai * sr + ei[k]; sr = nr; si = ni; }
                CE[(w8 * 32 + cx.lane) * 2] = sr; CE[(w8 * 32 + cx.lane) * 2 + 1] = si; }
            __syncthreads();
            if (cx.lane < 32) {
                float pr = 1.f, pi = 0.f;
                { float qr = ar, qi = ai;
#pragma unroll
                  for (int i = 0; i < 5; ++i) { const float tr_ = qr * qr - qi * qi, ti_ = 2.f * qr * qi; qr = tr_; qi = ti_; } pr = qr; pi = qi; }
                float cr = 0.f, ci = 0.f;
                for (int w2 = 0; w2 < w8; ++w2) { const float e0 = CE[(w2 * 32 + cx.lane) * 2], e1 = CE[(w2 * 32 + cx.lane) * 2 + 1]; const float nr = pr * cr - pi * ci + e0, ni = pr * ci + pi * cr + e1; cr = nr; ci = ni; }
                float sr = cr, si = ci;
#pragma unroll
                for (int k = 0; k < 32; ++k) { bf16* d = AG + (row0 + k) * 640 + 512 + p; d[0] = (bf16)(pk2(sr, 0.f) & 0xffffu); d[64] = (bf16)(pk2(si, 0.f) & 0xffffu);
                    const float nr = ar * sr - ai * si + er[k], ni = ar * si + ai * sr + ei[k]; sr = nr; si = ni; } }
            __syncthreads();
        }
        MAKE_RP;
        for (int grp = cx.wg; grp < 256; grp += cx.G) rwkv_pass1(lds, RP, grp * 16, 16, cx.tid, QCT, HCT, W1G, ULG, DLG, (float*)(ws + WS_TOKSLOT));
    }
    SEAM(4);
    if (IN(5)) for (int rep_ = 0; rep_ < REPS(5); ++rep_) {
        FRESH_CX;
        if (SPLIT_P5 && cx.G == 256) {
            if (cx.wg < 128) { if (cx.wave == 0) rwkv_pass2(lds, cx.wg >> 2, cx.wg & 3, cx.lane, QCT, HCT, DLG, S0G); }
            else { SchedS5 S; S.init(128, 2, 128, cx.wg - 128); S.A = (const char*)AG; S.B = (const char*)S5BT; S.a_tile = 256 * 640 * 2; S.b_tile = 256 * 640 * 2; S.b_group = 512 * 640 * 2;
                EpiS5Y E{AG, I[11], Y1};
                pg8::gemm_phase<EpiS5Y, SchedS5, true, true, false>(lds, cx.tid, OPQ(640), OPQ(640), OPQ(640), S, E); }
        } else {
            { SchedS5 S; S.init(128, 2, cx.G, cx.wg); S.A = (const char*)AG; S.B = (const char*)S5BT; S.a_tile = 256 * 640 * 2; S.b_tile = 256 * 640 * 2; S.b_group = 512 * 640 * 2;
              EpiS5Y E{AG, I[11], Y1};
              pg8::gemm_phase<EpiS5Y, SchedS5, true, true, false>(lds, cx.tid, OPQ(640), OPQ(640), OPQ(640), S, E); }
            if (cx.wave == 0) for (int it = cx.wg; it < 128; it += cx.G) rwkv_pass2(lds, it >> 2, it & 3, cx.lane, QCT, HCT, DLG, S0G);
        }
    }
    SEAM(5);
    if (IN(6)) for (int rep_ = 0; rep_ < REPS(6); ++rep_) {
        FRESH_CX;
        MAKE_RP;
        for (int grp = cx.wg; grp < 256; grp += cx.G) rwkv_pass3(lds, RP, grp * 16, 16, cx.tid, S0G, W1G, ULG, (const float*)(ws + WS_TOKSLOT), MIX);
        __syncthreads();
        { SchedPlain S; S.init(128, 2, cx.G, cx.wg); S.A = (const char*)Y1; S.B = (const char*)WGLU; S.a_tile = 256 * 512 * 2; S.b_tile = 256 * 512 * 2;
          EpiGlu E{Y1, MIX};
          pg8::gemm_phase<EpiGlu, SchedPlain, true, true, false>(lds, cx.tid, OPQ(512), OPQ(512), OPQ(512), S, E); }
    }
    SEAM(6);
    if (IN(7)) for (int rep_ = 0; rep_ < REPS(7); ++rep_) {
        FRESH_CX;
        SchedPlain S; S.init(128, 4, cx.G, cx.wg); S.A = (const char*)MIX; S.B = (const char*)WOUT; S.a_tile = 256 * 1024 * 2; S.b_tile = 256 * 1024 * 2;
        EpiResid E{I[0], XB};
        pg8::gemm_phase<EpiResid, SchedPlain, true, true, false>(lds, cx.tid, OPQ(1024), OPQ(1024), OPQ(1024), S, E);
    }
    SEAM(7);
    if (IN(8)) for (int rep_ = 0; rep_ < REPS(8); ++rep_) { FRESH_CX; router_phase(cx, XB, I[29], I[30], I[31], H2, TOPE, TOPG, HIST); }
    SEAM(8);
    LAS int* PL = (LAS int*)(lds + LDS_PLAN);
    if (hi > 9 && lo < 28) { FRESH_CX; __syncthreads(); moe_plan(cx, HIST); }
    const int npass = (hi > 9 && lo < 28) ? PL[PL_NPASS] : 0;
    if (IN(9)) for (int rep_ = 0; rep_ < REPS(9); ++rep_) { FRESH_CX; dispatch_phase(cx, HIST, TOPE, SLOTTOK, TOKSLOT); convert_pass(cx, PL[PL_PE0], PL[PL_PE0 + 1], I[32], I[34], I[36], WGU, WDN); }
    SEAM(9);
    for (int p = 0; p < 6; ++p) {
        const bool actv = p < npass;
        const int e0 = actv ? PL[PL_PE0 + p] : 0, e1 = actv ? PL[PL_PE0 + p + 1] : 0, row0 = actv ? PL[PL_PROW0 + p] : 0, rows = actv ? PL[PL_PROW0 + p + 1] - row0 : 0;
        if (IN(10 + 3 * p) && actv) for (int rep_ = 0; rep_ < REPS(10); ++rep_) {
            FRESH_CX;
            SchedMoe<true> S; S.init(rows / 256, 8, cx.G, cx.wg); S.A = (const char*)H2; S.B = (const char*)WGU; S.a_tile = 0; S.b_tile = 256 * 1024; S.b_exp = (size_t)2048 * 1024; S.tile_e = PL + PL_TILEE; S.tile0 = row0 / 256; S.e0 = e0; S.slot_tok = SLOTTOK; S.row0 = row0;
            EpiGU E{ACT, I[33], I[35]};
            pg8::gemm_phase<EpiGU, SchedMoe<true>, MOE_ALIGN, MOE_SP2, true, true>(lds, cx.tid, OPQ(512), OPQ(512), OPQ(512), S, E);
        }
        if (actv) SEAM(10 + 3 * p);
        if (IN(11 + 3 * p) && actv) for (int rep_ = 0; rep_ < REPS(11); ++rep_) {
            FRESH_CX;
            SchedMoe<false> S; S.init(rows / 256, 4, cx.G, cx.wg); S.A = (const char*)ACT; S.B = (const char*)WDN; S.a_tile = 256 * 1024; S.b_tile = 256 * 1024; S.b_exp = (size_t)1024 * 1024; S.tile_e = PL + PL_TILEE; S.tile0 = row0 / 256; S.e0 = e0; S.slot_tok = SLOTTOK; S.row0 = row0;
            EpiDown E{YB, I[37]};
            pg8::gemm_phase<EpiDown, SchedMoe<false>, MOE_ALIGN, MOE_SP2, false, true>(lds, cx.tid, OPQ(512), OPQ(512), OPQ(512), S, E);
        }
        if (actv) SEAM(11 + 3 * p);
        if (IN(12 + 3 * p) && actv) for (int rep_ = 0; rep_ < REPS(12); ++rep_) {
            FRESH_CX;
            if (p + 1 < npass) { combine_pass<false>(cx, e0, e1, row0, TOPE, TOPG, TOKSLOT, YB, XB, nullptr, nullptr); convert_pass(cx, PL[PL_PE0 + p + 1], PL[PL_PE0 + p + 2], I[32], I[34], I[36], WGU, WDN); }
            else {
                if (e0 == 0 && e1 == 32 && row0 == 0) combine_all(cx, TOPG, TOKSLOT, YB, XB, I[38], (unsigned char*)(ws + WS_R1));
                else combine_pass<true>(cx, e0, e1, row0, TOPE, TOPG, TOKSLOT, YB, XB, I[38], (unsigned char*)(ws + WS_R1));
                SchedPlain S; S.init(128, 4, cx.G, cx.wg); S.A = (const char*)PBF; S.B = (const char*)WPP; S.a_tile = 256 * 256 * 2; S.b_tile = 256 * 256 * 2;
                EpiBf16Plain E{PP, 1024};
                pg8::gemm_phase<EpiBf16Plain, SchedPlain, true, true, false>(lds, cx.tid, OPQ(256), OPQ(256), OPQ(256), S, E);
            }
        }
        if (actv) SEAM(12 + 3 * p);
    }
    if (IN(29)) for (int rep_ = 0; rep_ < REPS(29); ++rep_) {
        FRESH_CX;
        SchedPlain S; S.init(128, 4, cx.G, cx.wg); S.A = (const char*)(ws + WS_R1); S.B = (const char*)WPG; S.a_tile = 256 * 1024; S.b_tile = 256 * 1024;
        if (FUSE_FNORM && cx.G == 256) { EpiPleNorm E{PP, XB, OUTP, I[41], (float*)(ws + WS_CTL) + CW_ROWSS, (unsigned*)(ws + WS_CTL) + CW_PCNT};
            pg8::gemm_phase<EpiPleNorm, SchedPlain, true, true, false, true>(lds, cx.tid, OPQ(512), OPQ(512), OPQ(512), S, E); }
        else { EpiPle E{PP, XB};
            pg8::gemm_phase<EpiPle, SchedPlain, true, true, false, true>(lds, cx.tid, OPQ(512), OPQ(512), OPQ(512), S, E); }
    }
    SEAM(29);
    if (IN(30) && !(FUSE_FNORM && gridDim.x == 256)) for (int rep_ = 0; rep_ < REPS(30); ++rep_) {
        FRESH_CX;
        for (int m = 2 * cx.gw; m < M; m += 2 * cx.NGW) {
            const u32x2* ia_ = (const u32x2*)(XB + (size_t)m * 1024) + cx.lane; const u32x2* ib_ = ia_ + 256;
            f32x4* xa = (f32x4*)(OUTP + (size_t)m * 1024) + cx.lane; f32x4* xb = xa + 256; const f32x4* gr = (const f32x4*)I[41] + cx.lane; f32x4 va[4], vb[4]; float sa = 0.f, sb = 0.f;
#pragma unroll
            for (int j = 0; j < 4; ++j) { const u32x2 wa = ia_[64 * j], wb = ib_[64 * j]; va[j] = (f32x4){lo16(wa.x), hi16(wa.x), lo16(wa.y), hi16(wa.y)}; vb[j] = (f32x4){lo16(wb.x), hi16(wb.x), lo16(wb.y), hi16(wb.y)}; }
#pragma unroll
            for (int j = 0; j < 4; ++j) { sa += (va[j].x * va[j].x + va[j].y * va[j].y) + (va[j].z * va[j].z + va[j].w * va[j].w); sb += (vb[j].x * vb[j].x + vb[j].y * vb[j].y) + (vb[j].z * vb[j].z + vb[j].w * vb[j].w); }
#pragma unroll
            for (int o = 1; o < 64; o <<= 1) { sa += __shfl_xor(sa, o); sb += __shfl_xor(sb, o); }
            const float ia = rsqrtf(sa * (1.f / 1024.f) + 1e-6f), ib = rsqrtf(sb * (1.f / 1024.f) + 1e-6f);
#pragma unroll
            for (int j = 0; j < 4; ++j) { const f32x4 gg = gr[64 * j]; xa[64 * j] = (f32x4){va[j].x * ia * gg.x, va[j].y * ia * gg.y, va[j].z * ia * gg.z, va[j].w * ia * gg.w}; xb[64 * j] = (f32x4){vb[j].x * ib * gg.x, vb[j].y * ib * gg.y, vb[j].z * ib * gg.z, vb[j].w * ib * gg.w}; }
        }
    }
    if (PROBE_T >= 0 && blockIdx.x == 0 && threadIdx.x == 0) { STAMP(); asm volatile("s_waitcnt vmcnt(0)" ::: "memory");
        const unsigned long long t0_ = ((unsigned long long)MISC[17 + 2 * PROBE_T] << 32) | MISC[16 + 2 * PROBE_T], t1_ = ((unsigned long long)MISC[19 + 2 * PROBE_T] << 32) | MISC[18 + 2 * PROBE_T];
        (*(float* const CAS*)((const CAS char*)__builtin_amdgcn_kernarg_segment_ptr() + 336))[0] = (float)(t1_ - t0_) * 0.01f; }
#undef IN
#undef SEAM
}

extern "C" void kernel_launch(void* const* d_in, const int* in_sizes, int n_in, void* d_out, int out_size, void* d_ws, size_t ws_size, hipStream_t stream) {
    static int grid = 0;
    if (grid == 0) {
        if (n_in != 42 || out_size != M * DM || ws_size < WS_END) { fprintf(stderr, "kernel_launch: unexpected shapes (n_in %d out %d ws %zu)\n", n_in, out_size, ws_size); grid = -1; return; }
        int dev = 0, cus = 0, per_cu = 0;
        if (hipGetDevice(&dev) != hipSuccess || hipDeviceGetAttribute(&cus, hipDeviceAttributeMultiprocessorCount, dev) != hipSuccess) { grid = -1; return; }
        if (hipFuncSetAttribute((const void*)mk_fwd, hipFuncAttributeMaxDynamicSharedMemorySize, LDS_BYTES) != hipSuccess) { fprintf(stderr, "kernel_launch: hipFuncSetAttribute failed\n"); grid = -1; return; }
        if (hipOccupancyMaxActiveBlocksPerMultiprocessor(&per_cu, (const void*)mk_fwd, NTHR, LDS_BYTES) != hipSuccess || per_cu < 1) fprintf(stderr, "kernel_launch: occupancy query says %d\n", per_cu);
        (void)hipGetLastError();
        grid = cus > 256 ? 256 : cus;
    }
    if (grid < 0) return;
    (void)hipMemsetAsync((char*)d_ws + WS_CTL, 0, CTL_ZERO_BYTES, stream);
    Args a{};
    for (int i = 0; i < 42; ++i) a.in[i] = (const float*)d_in[i];
    a.out = (float*)d_out; a.ws = (unsigned char*)d_ws;
#if MK_PER_PHASE
    for (int ph = 0; ph < NPH; ++ph) { a.ph_lo = ph; a.ph_hi = ph + 1; hipLaunchKernelGGL(mk_fwd, dim3(grid), dim3(NTHR), LDS_BYTES, stream, a); }
#else
    a.ph_lo = 0; a.ph_hi = NPH;
    hipLaunchKernelGGL(mk_fwd, dim3(grid), dim3(NTHR), LDS_BYTES, stream, a);
#endif
}
```

```cpp
#include <hip/hip_runtime.h>
#include <cstdio>
#include <cstdint>

#ifndef MK_PER_PHASE
#define MK_PER_PHASE 0
#endif

#define LAS __attribute__((address_space(3)))
#define GAS __attribute__((address_space(1)))
typedef unsigned short bf16;
typedef short bf16x8 __attribute__((ext_vector_type(8)));
typedef float f32x4 __attribute__((ext_vector_type(4)));
typedef float f32x2 __attribute__((ext_vector_type(2)));
typedef unsigned u32x4 __attribute__((ext_vector_type(4)));
typedef unsigned u32x2 __attribute__((ext_vector_type(2)));
typedef GAS unsigned gu32;

constexpr int NB = 4, SEQ = 8192, DM = 1024, M = NB * SEQ;
constexpr int NEXP = 32, TOPK = 4;
constexpr int NWAVES = 8, NTHR = 512;
constexpr size_t MiB = 1u << 20;

constexpr size_t WS_CTL = 0, CTL_ZERO_BYTES = 1 * MiB;
constexpr size_t WS_HIST = 1 * MiB;
constexpr size_t WS_TOPE = 2 * MiB;
constexpr size_t WS_TOPG = 3 * MiB;
constexpr size_t WS_TOKSLOT = 4 * MiB;
constexpr size_t WS_SLOTTOK = 5 * MiB;
constexpr size_t WS_AT = 6 * MiB;
constexpr size_t WS_DL = 6 * MiB + 65536;
constexpr size_t WS_WCAT = 8 * MiB;
constexpr size_t WS_WL2 = 13 * MiB;
constexpr size_t WS_WGLU = 14 * MiB;
constexpr size_t WS_WPP = 14 * MiB + 524288;
constexpr size_t WS_WOUT = 15 * MiB;
constexpr size_t WS_WPG = 17 * MiB;
constexpr size_t WS_S5BT = 19 * MiB;
constexpr size_t WS_S5ET = 39 * MiB;
constexpr size_t WS_PBF = 48 * MiB;
constexpr size_t WS_R1 = 64 * MiB;
constexpr size_t WS_RKV = 128 * MiB;
constexpr size_t WS_WAG = 224 * MiB;
constexpr size_t WS_AG = 320 * MiB;
constexpr size_t WS_U = 360 * MiB;
constexpr size_t WS_LP = 392 * MiB;
constexpr size_t WS_LACT = 424 * MiB;
constexpr size_t WS_W1 = 440 * MiB;
constexpr size_t WS_ULOC = 472 * MiB;
constexpr size_t WS_Y1 = 504 * MiB;
constexpr size_t WS_H2 = 64 * MiB;
constexpr size_t WS_WDN = 96 * MiB;
constexpr size_t WS_ACT = 128 * MiB;
constexpr size_t WS_Y = 264 * MiB;
constexpr size_t WS_XB = 400 * MiB;
constexpr size_t WS_WGU = 264 * MiB;
constexpr int RMAX = 139264;
constexpr int MAXEPP = 32;
constexpr size_t WS_END = 560 * MiB;
static_assert(WS_Y + (size_t)RMAX * 1024 <= WS_XB && WS_XB + (size_t)M * 2048 <= WS_END && WS_ACT + (size_t)RMAX * 1024 <= WS_Y, "moe map");

constexpr int CW_BAR = 4096;
constexpr int CW_ROWSS = 65536;
constexpr int CW_PCNT = 131072;

constexpr int LDS_PLAN = 147456;
constexpr int LDS_MISC = 155648;
constexpr int LDS_BYTES = 156672;
constexpr int PL_CNT = 0, PL_PSTART = 32, PL_NPASS = 72, PL_PE0 = 80, PL_PROW0 = 88, PL_TILEE = 128, PL_TMP = 768;

#define LDS_WAIT() asm volatile("s_waitcnt lgkmcnt(0)" ::: "memory")
#define VM_WAIT() asm volatile("s_waitcnt vmcnt(0)" ::: "memory")
__device__ __forceinline__ float bf2f(unsigned b) { return __uint_as_float(b << 16); }
typedef __bf16 bf16n2 __attribute__((ext_vector_type(2)));
__device__ __forceinline__ unsigned cvt_pk_bf16(float lo, float hi) { const f32x2 f = {lo, hi}; const bf16n2 v = __builtin_convertvector(f, bf16n2); return __builtin_bit_cast(unsigned, v); }
__device__ __forceinline__ unsigned pk2(float lo, float hi) { return cvt_pk_bf16(lo, hi); }
__device__ __forceinline__ float lo16(unsigned w) { return __uint_as_float(w << 16); }
__device__ __forceinline__ float hi16(unsigned w) { return __uint_as_float(w & 0xffff0000u); }
__device__ __forceinline__ unsigned pk4_fp8(float a, float b, float c, float d) { unsigned w = 0u; w = (unsigned)__builtin_amdgcn_cvt_pk_fp8_f32(a, b, (int)w, false); w = (unsigned)__builtin_amdgcn_cvt_pk_fp8_f32(c, d, (int)w, true); return w; }
__device__ __forceinline__ f32x4 up4_fp8(unsigned w) { const f32x2 lo = __builtin_amdgcn_cvt_pk_f32_fp8((int)w, false), hi = __builtin_amdgcn_cvt_pk_f32_fp8((int)w, true); return (f32x4){lo.x, lo.y, hi.x, hi.y}; }
__device__ __forceinline__ float frcp(float x) { return __builtin_amdgcn_rcpf(x); }
__device__ __forceinline__ float fsigmoid(float x) { return frcp(1.0f + __expf(-x)); }
__device__ __forceinline__ float ftanh(float x) { const float e = __expf(-2.0f * fabsf(x)); const float t = (1.0f - e) * frcp(1.0f + e); return x < 0.f ? -t : t; }
__device__ __forceinline__ float gelu_tanh(float x) { const float u = 0.7978845608f * (x + 0.044715f * x * x * x); return 0.5f * x * (1.0f + ftanh(u)); }
__device__ __forceinline__ float wave_sum(float v) {
#pragma unroll
    for (int o = 1; o < 64; o <<= 1) v += __shfl_xor(v, o);
    return v;
}
__device__ __forceinline__ float wave_max(float v) {
#pragma unroll
    for (int o = 1; o < 64; o <<= 1) v = fmaxf(v, __shfl_xor(v, o));
    return v;
}

#define XB_TMO      128
#define XB_XCNT(j)  (256  + 64 * (j))
#define XB_XSUB(j)  (1280 + 64 * (j))
#define XB_XGEN(j)  (2304 + 64 * (j))
#define XB_TOP      3328
#define XB_TOPGEN   3392
#define XCD_BAR_WORDS 3456
#define XB_SPIN_CAP (1u << 22)

__device__ __forceinline__ unsigned xb_ld(unsigned* p)              { return __hip_atomic_load(p, __ATOMIC_RELAXED, __HIP_MEMORY_SCOPE_AGENT); }
__device__ __forceinline__ unsigned xb_add(unsigned* p, unsigned v) { return __hip_atomic_fetch_add(p, v, __ATOMIC_RELAXED, __HIP_MEMORY_SCOPE_AGENT); }
__device__ __forceinline__ unsigned xb_xcc_id() { return (unsigned)__builtin_amdgcn_s_getreg((3 << 11) | 20) & 0xFu; }
#define XB_SPIN(cond, bar) do { unsigned _sp = 0; while (cond) { __builtin_amdgcn_s_sleep(1); \
    if ((++_sp & 255u) == 0u) { if (xb_ld(&(bar)[XB_TMO])) break; if (_sp > XB_SPIN_CAP) { atomicAdd(&(bar)[XB_TMO], 1u); break; } } } } while (0)

struct XcdBarrier { unsigned* bar; unsigned x; volatile LAS unsigned* st; int wv; };
__device__ __forceinline__ bool xb_first(int wv) { return wv == 0 && __builtin_amdgcn_mbcnt_hi(~0u, __builtin_amdgcn_mbcnt_lo(~0u, 0u)) == 0u; }

__device__ __forceinline__ XcdBarrier xcd_barrier_post(unsigned* bar, volatile LAS unsigned* st, int wv) {
    XcdBarrier b; b.bar = bar; b.x = xb_xcc_id(); b.st = st; b.wv = wv;
    if (xb_first(wv)) (void)xb_add(&bar[XB_XCNT(b.x)], 1u);
    return b;
}
__device__ __forceinline__ void xcd_barrier_complete(unsigned* bar, unsigned x, unsigned& nloc, unsigned& nx) {
    const unsigned G = gridDim.x * gridDim.y * gridDim.z;
    unsigned sum, cnt, mine, sp = 0u;
    for (;;) {
        sum = 0u; cnt = 0u; mine = 0u;
#pragma unroll
        for (unsigned j = 0; j < 16; ++j) { const unsigned c = xb_ld(&bar[XB_XCNT(j)]); sum += c; cnt += (c > 0u) ? 1u : 0u; mine = (j == x) ? c : mine; }
        if (sum == G) break;
        __builtin_amdgcn_s_sleep(1);
        if ((++sp & 255u) == 0u) { if (xb_ld(&bar[XB_TMO])) break; if (sp > XB_SPIN_CAP) { atomicAdd(&bar[XB_TMO], 1u); break; } }
    }
    nloc = mine > 0u ? mine : 1u; nx = cnt > 0u ? cnt : 1u;
}
__device__ __forceinline__ void xcd_barrier(const XcdBarrier& b) {
    asm volatile("s_waitcnt vmcnt(0)" ::: "memory");
    __syncthreads();
    if (xb_first(b.wv)) {
        unsigned* bar = b.bar;
        __builtin_amdgcn_s_waitcnt(0);
        unsigned nloc = b.st[0], nx = b.st[1];
        if (nloc == 0u) { xcd_barrier_complete(bar, b.x, nloc, nx); b.st[0] = nloc; b.st[1] = nx; }
        const unsigned old = xb_add(&bar[XB_XSUB(b.x)], 1u);
        const unsigned gen = old / nloc;
        if (old + 1u == (gen + 1u) * nloc) {
            __builtin_amdgcn_fence(__ATOMIC_RELEASE, "agent");
            asm volatile("s_waitcnt vmcnt(0)" ::: "memory");
            const unsigned og = xb_add(&bar[XB_TOP], 1u);
            const unsigned tg = og / nx;
            if (og + 1u == (tg + 1u) * nx) xb_add(&bar[XB_TOPGEN], 1u);
            else XB_SPIN(xb_ld(&bar[XB_TOPGEN]) == tg, bar);
            __builtin_amdgcn_fence(__ATOMIC_ACQUIRE, "agent");
            xb_add(&bar[XB_XGEN(b.x)], 1u);
            asm volatile("s_waitcnt vmcnt(0)" ::: "memory");
        } else {
            XB_SPIN(xb_ld(&bar[XB_XGEN(b.x)]) == gen, bar);
            __builtin_amdgcn_fence(__ATOMIC_ACQUIRE, "agent");
            asm volatile("s_waitcnt vmcnt(0)" ::: "memory");
        }
    }
    __syncthreads();
}

#ifndef PG8_WGM
#define PG8_WGM 8
#endif
namespace pg8 {
constexpr int BM = 256, BK = 64, HALF = 128, HTB = HALF * BK * 2, STAGE_BYTES = 8 * HTB, NXCD = 8, WGM = PG8_WGM;
__host__ __device__ __forceinline__ int lds_byte(int r, int c) { const int st = (r >> 4) * 2 + (c >> 5), rr = r & 15, cc = c & 31, ob = rr * 64 + cc * 2; return st * 1024 + (ob ^ (((ob >> 9) & 1) << 5)); }
__host__ __device__ __forceinline__ void stage_rc(int b, int& R, int& C) { const int st = b / 1024, sb = b % 1024, swz = sb ^ (((sb >> 9) & 1) << 5); R = (st >> 1) * 16 + swz / 64; C = (st & 1) * 32 + (swz % 64) / 2; }
__host__ __device__ __forceinline__ int perm32(int rho) { const int n = rho >> 4, i = rho & 15; return 8 * (i >> 2) + 4 * n + (i & 3); }

struct Unit { int pm, pn, aux; };

struct Order {
    int nM, nN, nwg, G, c;
    __device__ __forceinline__ void init(int nM_, int nN_, int G_, int c_) { nM = nM_; nN = nN_; nwg = nM * nN; G = G_; c = c_; }
    __device__ __forceinline__ bool tile(int i, int& pm, int& pn) const {
        const long L = (long)i * G + c; if (L >= nwg) return false;
        int wgid = (int)L; { const int q = nwg / NXCD, r = nwg % NXCD, xcd = wgid % NXCD, off = wgid / NXCD; wgid = (xcd < r ? xcd * (q + 1) : r * (q + 1) + (xcd - r) * q) + off; }
        const int nig = WGM * nN, gid = wgid / nig, fm = gid * WGM, gsz = (nM - fm) < WGM ? (nM - fm) : WGM;
        pm = fm + ((wgid % nig) % gsz); pn = (wgid % nig) / gsz; return true;
    }
};


template <class Epi, class Sched, bool ALIGN_EPI, bool SP2, bool GATHER, bool FP8 = false>
__device__ __forceinline__ void gemm_phase(LAS unsigned char* lds, const int tid, const int K, const int lda, const int ldb, const Sched& S, const Epi& E) {
    const int wid = __builtin_amdgcn_readfirstlane(tid >> 6), lane = tid & 63, wr = wid >> 2, wc = wid & 3, fr = lane & 15, fq = lane >> 4;
    const int nt = K / BK;
    unsigned voffA[2], voffB[2]; int rA[2], cA2[2];
#pragma unroll
    for (int i = 0; i < 2; ++i) { int R, C; stage_rc(tid * 16 + i * 8192, R, C); const int Rb = Epi::PERM ? ((R & ~31) + perm32(R & 31)) : R;
        voffA[i] = (unsigned)(R * lda + C) * 2u; voffB[i] = (unsigned)(Rb * ldb + C) * 2u; rA[i] = R; cA2[i] = C * 2; }
    const size_t kstep = (size_t)(BK * 2);
    const size_t hstepA = (size_t)HALF * lda * 2, hstepB = (size_t)HALF * ldb * 2;
    const unsigned ldsw = (unsigned)wid * 1024u;
    const int aoff = FP8 ? lds_byte(wr * 64 + fr, fq * 16) : lds_byte(wr * 64 + fr, fq * 8), boff = FP8 ? lds_byte(wc * 32 + fr, fq * 16) : lds_byte(wc * 32 + fr, fq * 8);
    unsigned cv0[2] = {0u, 0u}, cv1[2] = {0u, 0u};
#define PG8_SA(b, h) (((b) * 2 + (h)) * HTB)
#define PG8_SB(b, h) ((4 + (b) * 2 + (h)) * HTB)
#define PG8_STAGE(bufoff, gbase, voff) do { _Pragma("unroll") for (int _i = 0; _i < 2; ++_i) \
        __builtin_amdgcn_global_load_lds((const unsigned*)((const char*)(gbase) + (voff)[_i]), (LAS unsigned*)(lds + (bufoff) + ldsw + _i * 8192), 16, 0, 0); } while (0)
#define PG8_NROW(h, i) ((has_next ? *(const LAS unsigned*)(pf_rows + (i) * 512 + (h) * 256 + lane * 4) * (unsigned)(lda * 2) + (unsigned)cA2[i] : ((h) ? cv1[i] : cv0[i])))
#define PG8_STAGE_A(bufoff, ptr, h, nx) do { if constexpr (GATHER) { unsigned _v[2]; if (nx) { asm volatile("" ::: "memory"); _v[0] = PG8_NROW(h, 0); _v[1] = PG8_NROW(h, 1); } else { _v[0] = (h) ? cv1[0] : cv0[0]; _v[1] = (h) ? cv1[1] : cv0[1]; } PG8_STAGE(bufoff, ptr, _v); } \
        else { PG8_STAGE(bufoff, (ptr) + (h) * hstepA, voffA); } } while (0)
#define PG8_LDA(dst, b, h) do { if constexpr (FP8) { _Pragma("unroll") for (int m = 0; m < 4; ++m) { dst##8[m].lo = *(const LAS v4i_*)(lds + PG8_SA(b, h) + aoff + m * 2048); dst##8[m].hi = *(const LAS v4i_*)(lds + PG8_SA(b, h) + aoff + m * 2048 + 16); } } \
        else { _Pragma("unroll") for (int m = 0; m < 4; ++m) _Pragma("unroll") for (int k = 0; k < 2; ++k) dst[m][k] = *(const LAS bf16x8*)(lds + PG8_SA(b, h) + aoff + m * 2048 + k * 1024); } } while (0)
#define PG8_LDB(dst, b, h) do { if constexpr (FP8) { _Pragma("unroll") for (int n = 0; n < 2; ++n) { dst##8[n].lo = *(const LAS v4i_*)(lds + PG8_SB(b, h) + boff + n * 2048); dst##8[n].hi = *(const LAS v4i_*)(lds + PG8_SB(b, h) + boff + n * 2048 + 16); } } \
        else { _Pragma("unroll") for (int n = 0; n < 2; ++n) _Pragma("unroll") for (int k = 0; k < 2; ++k) dst[n][k] = *(const LAS bf16x8*)(lds + PG8_SB(b, h) + boff + n * 2048 + k * 1024); } } while (0)
#define PG8_MMA(ai, bj, At, Bt) do { __builtin_amdgcn_s_setprio(1); _Pragma("unroll") for (int m = 0; m < 4; ++m) _Pragma("unroll") for (int n = 0; n < 2; ++n) { \
        if constexpr (FP8) asm volatile("v_mfma_scale_f32_16x16x128_f8f6f4 %0, %1, %2, %0, %3, %4 op_sel_hi:[0,0,0]" : "+v"(acc[ai][bj][m][n]) : "v"(Bt##8[n]), "v"(At##8[m]), "v"(sclW), "v"(sclA));   \
        else { _Pragma("unroll") for (int k = 0; k < 2; ++k) acc[ai][bj][m][n] = __builtin_amdgcn_mfma_f32_16x16x32_bf16(Bt[n][k], At[m][k], acc[ai][bj][m][n], 0, 0, 0); } } \
        __builtin_amdgcn_s_setprio(0); } while (0)
#define PG8_WAIT_V(n) asm volatile("s_waitcnt vmcnt(" #n ")" ::: "memory")
#define PG8_WAIT_L(n) asm volatile("s_waitcnt lgkmcnt(" #n ")" ::: "memory")
#define PG8_BAR __builtin_amdgcn_s_barrier()
#define PG8_SCHED __builtin_amdgcn_sched_barrier(0)
#define PG8_ROWS(u, d0, d1) do { _Pragma("unroll") for (int _i = 0; _i < 2; ++_i) { const int _r0 = S.a_row(u, rA[_i]), _r1 = S.a_row(u, HALF + rA[_i]); \
        d0[_i] = (unsigned)_r0 * (unsigned)(lda * 2) + (unsigned)cA2[_i]; d1[_i] = (unsigned)_r1 * (unsigned)(lda * 2) + (unsigned)cA2[_i]; } } while (0)
    constexpr int PF_OFF = STAGE_BYTES;
    LAS unsigned char* pf_bias = lds + PF_OFF + wid * 256; LAS unsigned char* pf_rows = lds + PF_OFF + 2048 + wid * 1024;
    Unit cur, nxt; int ui = 0; bool has_next = false;
    if (!S.next(0, cur)) return;
    f32x4 acc[2][2][4][2];
#pragma unroll
    for (int a = 0; a < 2; ++a)
#pragma unroll
        for (int b = 0; b < 2; ++b)
#pragma unroll
            for (int m = 0; m < 4; ++m)
#pragma unroll
                for (int n = 0; n < 2; ++n) acc[a][b][m][n] = (f32x4){0.f, 0.f, 0.f, 0.f};
    typedef int v8i_ __attribute__((ext_vector_type(8))); typedef int v4i_ __attribute__((ext_vector_type(4)));
    bf16x8 At[4][2], B0[2][2], B1[2][2]; v8i_ At8[4], B08[2], B18[2];
    const int sclW = 0x7a7a7a7a, sclA = 0x7f7f7f7f;
    const char* cA = S.a_ptr(cur); const char* cB = S.b_ptr(cur);
    if constexpr (GATHER) { PG8_ROWS(cur, cv0, cv1); }
    if constexpr (SP2) {
        PG8_STAGE(PG8_SB(0, 0), cB, voffB); PG8_STAGE(PG8_SB(0, 1), cB + hstepB, voffB); PG8_STAGE_A(PG8_SA(0, 0), cA, 0, false); PG8_STAGE_A(PG8_SA(0, 1), cA, 1, false);
        if (wr == 1) PG8_BAR;
        PG8_WAIT_V(2); PG8_BAR;
        PG8_STAGE(PG8_SB(1, 0), cB + kstep, voffB); PG8_STAGE_A(PG8_SA(1, 0), cA + kstep, 0, false); PG8_STAGE(PG8_SB(1, 1), cB + hstepB + kstep, voffB);
        PG8_WAIT_V(6); PG8_BAR;
    } else {
        PG8_STAGE(PG8_SB(0, 0), cB, voffB); PG8_STAGE_A(PG8_SA(0, 0), cA, 0, false); PG8_STAGE(PG8_SB(0, 1), cB + hstepB, voffB); PG8_STAGE_A(PG8_SA(0, 1), cA, 1, false);
        if (wr == 1) PG8_BAR;
        PG8_WAIT_V(4); PG8_BAR;
        PG8_STAGE(PG8_SB(1, 0), cB + kstep, voffB); PG8_STAGE_A(PG8_SA(1, 0), cA + kstep, 0, false); PG8_STAGE(PG8_SB(1, 1), cB + hstepB + kstep, voffB);
        PG8_WAIT_V(6); PG8_BAR;
    }
    for (;;) {
        has_next = S.next(ui + 1, nxt);
        const char* nA = has_next ? S.a_ptr(nxt) : cA; const char* nB = has_next ? S.b_ptr(nxt) : cB;
        if constexpr (Epi::PREF) E.pref(pf_bias, cur, wc, lane);
        if constexpr (GATHER) { if (has_next) {
#pragma unroll
                for (int _i = 0; _i < 2; ++_i) { __builtin_amdgcn_global_load_lds((const unsigned*)S.a_row_ptr(nxt, rA[_i]), (LAS unsigned*)(pf_rows + _i * 512), 4, 0, 0);
                                                 __builtin_amdgcn_global_load_lds((const unsigned*)S.a_row_ptr(nxt, HALF + rA[_i]), (LAS unsigned*)(pf_rows + _i * 512 + 256), 4, 0, 0); } }
            }
        for (int t = 0; t < nt; t += 2) {
            const bool last = (t == nt - 2);
            const char* a1 = cA + (size_t)(t + 1) * kstep;
            const char* a2 = last ? nA : cA + (size_t)(t + 2) * kstep; const char* b2 = last ? nB : cB + (size_t)(t + 2) * kstep;
            const char* a3 = a2 + kstep; const char* b3 = b2 + kstep;
            if constexpr (SP2) {
            PG8_LDB(B0, 0, 0); PG8_LDB(B1, 0, 1); PG8_SCHED; PG8_LDA(At, 0, 0); PG8_STAGE_A(PG8_SA(1, 1), a1, 1, false);
            PG8_WAIT_V(8); PG8_WAIT_L(0); PG8_BAR; PG8_MMA(0, 0, At, B0); PG8_MMA(0, 1, At, B1); PG8_BAR; PG8_SCHED;
            PG8_LDA(At, 0, 1); PG8_STAGE(PG8_SB(0, 0), b2, voffB); PG8_STAGE(PG8_SB(0, 1), b2 + hstepB, voffB); PG8_STAGE_A(PG8_SA(0, 0), a2, 0, last);
            PG8_WAIT_V(8); PG8_WAIT_L(0); PG8_BAR; PG8_MMA(1, 0, At, B0); PG8_MMA(1, 1, At, B1); PG8_BAR; PG8_SCHED;
            PG8_LDB(B0, 1, 0); PG8_LDB(B1, 1, 1); PG8_SCHED; PG8_LDA(At, 1, 0); PG8_STAGE_A(PG8_SA(0, 1), a2, 1, last);
            PG8_WAIT_V(8); PG8_WAIT_L(0); PG8_BAR; PG8_MMA(0, 0, At, B0); PG8_MMA(0, 1, At, B1); PG8_BAR; PG8_SCHED;
            PG8_LDA(At, 1, 1); PG8_STAGE(PG8_SB(1, 0), b3, voffB); PG8_STAGE(PG8_SB(1, 1), b3 + hstepB, voffB); PG8_STAGE_A(PG8_SA(1, 0), a3, 0, last);
            PG8_WAIT_V(8); PG8_WAIT_L(0); PG8_BAR; PG8_MMA(1, 0, At, B0); PG8_MMA(1, 1, At, B1); PG8_BAR; PG8_SCHED;
            } else {
            PG8_LDB(B0, 0, 0); PG8_SCHED; PG8_LDA(At, 0, 0); PG8_STAGE_A(PG8_SA(1, 1), a1, 1, false);
            PG8_WAIT_L(8); PG8_BAR; PG8_WAIT_L(0); PG8_MMA(0, 0, At, B0); PG8_BAR; PG8_SCHED;
            PG8_LDB(B1, 0, 1); PG8_STAGE(PG8_SB(0, 0), b2, voffB);
            PG8_BAR; PG8_WAIT_L(0); PG8_MMA(0, 1, At, B1); PG8_BAR;
            PG8_LDA(At, 0, 1); PG8_STAGE_A(PG8_SA(0, 0), a2, 0, last);
            PG8_BAR; PG8_WAIT_L(0); PG8_MMA(1, 0, At, B0); PG8_BAR; PG8_SCHED;
            PG8_STAGE(PG8_SB(0, 1), b2 + hstepB, voffB);
            PG8_WAIT_V(6); PG8_BAR; PG8_MMA(1, 1, At, B1); PG8_BAR;
            PG8_LDB(B0, 1, 0); PG8_SCHED; PG8_LDA(At, 1, 0); PG8_STAGE_A(PG8_SA(0, 1), a2, 1, last);
            PG8_WAIT_L(8); PG8_BAR; PG8_WAIT_L(0); PG8_MMA(0, 0, At, B0); PG8_BAR; PG8_SCHED;
            PG8_LDB(B1, 1, 1); PG8_STAGE(PG8_SB(1, 0), b3, voffB);
            PG8_BAR; PG8_WAIT_L(0); PG8_MMA(0, 1, At, B1); PG8_BAR;
            PG8_LDA(At, 1, 1); PG8_STAGE_A(PG8_SA(1, 0), a3, 0, last);
            PG8_BAR; PG8_WAIT_L(0); PG8_MMA(1, 0, At, B0); PG8_BAR; PG8_SCHED;
            PG8_STAGE(PG8_SB(1, 1), b3 + hstepB, voffB);
            PG8_WAIT_V(6); PG8_BAR; PG8_MMA(1, 1, At, B1); PG8_BAR;
            }
        }
        if constexpr (ALIGN_EPI) { if (wr == 0) PG8_BAR; }
        if constexpr (FP8) asm volatile("s_nop 15\n\ts_nop 15" ::: "memory");
        E(acc, cur, wr, wc, fr, fq, pf_bias);
        if (!has_next) break;
#pragma unroll
        for (int a = 0; a < 2; ++a)
#pragma unroll
            for (int b = 0; b < 2; ++b)
#pragma unroll
                for (int m = 0; m < 4; ++m)
#pragma unroll
                    for (int n = 0; n < 2; ++n) acc[a][b][m][n] = (f32x4){0.f, 0.f, 0.f, 0.f};
        cur = nxt; cA = nA; cB = nB; ++ui;
        if constexpr (GATHER) { asm volatile("" ::: "memory"); cv0[0] = PG8_NROW(0, 0); cv0[1] = PG8_NROW(0, 1); cv1[0] = PG8_NROW(1, 0); cv1[1] = PG8_NROW(1, 1); }
        if constexpr (ALIGN_EPI) { if (wr == 1) PG8_BAR; }
    }
    PG8_WAIT_V(0);
    if constexpr (!ALIGN_EPI) { if (wr == 0) PG8_BAR; }
    PG8_BAR;
#undef PG8_SA
#undef PG8_SB
#undef PG8_STAGE
#undef PG8_STAGE_A
#undef PG8_NROW
#undef PG8_LDA
#undef PG8_LDB
#undef PG8_MMA
#undef PG8_WAIT_V
#undef PG8_WAIT_L
#undef PG8_BAR
#undef PG8_SCHED
#undef PG8_ROWS
}
}

using pg8::Unit;
struct SchedPlain : pg8::Order {
    const char* A; const char* B; size_t a_tile, b_tile;
    __device__ __forceinline__ bool next(int i, Unit& u) const { u.aux = 0; return tile(i, u.pm, u.pn); }
    __device__ __forceinline__ const char* a_ptr(const Unit& u) const { return A + (size_t)u.pm * a_tile; }
    __device__ __forceinline__ const char* b_ptr(const Unit& u) const { return B + (size_t)u.pn * b_tile; }
    __device__ __forceinline__ int a_row(const Unit&, int) const { return 0; }
    __device__ __forceinline__ const int* a_row_ptr(const Unit&, int) const { return nullptr; }
};
struct SchedS5 : pg8::Order {
    const char* A; const char* B; size_t a_tile, b_tile, b_group;
    __device__ __forceinline__ bool next(int i, Unit& u) const { u.aux = 0; return tile(i, u.pm, u.pn); }
    __device__ __forceinline__ const char* a_ptr(const Unit& u) const { return A + (size_t)u.pm * a_tile; }
    __device__ __forceinline__ const char* b_ptr(const Unit& u) const { return B + (size_t)(u.pm >> 2) * b_group + (size_t)u.pn * b_tile; }
    __device__ __forceinline__ int a_row(const Unit&, int) const { return 0; }
    __device__ __forceinline__ const int* a_row_ptr(const Unit&, int) const { return nullptr; }
};
template <bool GATHER> struct SchedMoe : pg8::Order {
    const char* A; const char* B; size_t a_tile, b_tile, b_exp; const LAS int* tile_e; int tile0, e0; const int* slot_tok; int row0;
    __device__ __forceinline__ bool next(int i, Unit& u) const { const bool ok = tile(i, u.pm, u.pn); u.aux = ok ? tile_e[tile0 + u.pm] : 0; return ok; }
    __device__ __forceinline__ const char* a_ptr(const Unit& u) const { return GATHER ? A : A + (size_t)u.pm * a_tile; }
    __device__ __forceinline__ const char* b_ptr(const Unit& u) const { return B + (size_t)(u.aux - e0) * b_exp + (size_t)u.pn * b_tile; }
    __device__ __forceinline__ int a_row(const Unit& u, int r) const { return slot_tok[row0 + u.pm * 256 + r]; }
    __device__ __forceinline__ const int* a_row_ptr(const Unit& u, int r) const { return slot_tok + row0 + u.pm * 256 + r; }
};

__device__ __forceinline__ void st8(bf16* p, const f32x4 v0, const f32x4 v1) {
    u32x4 w; w.x = cvt_pk_bf16(v0[0], v0[1]); w.y = cvt_pk_bf16(v0[2], v0[3]); w.z = cvt_pk_bf16(v1[0], v1[1]); w.w = cvt_pk_bf16(v1[2], v1[3]); *(u32x4*)p = w;
}
__device__ __forceinline__ void ld8(const bf16* p, f32x4& v0, f32x4& v1) {
    const u32x4 w = *(const u32x4*)p; v0 = (f32x4){lo16(w.x), hi16(w.x), lo16(w.y), hi16(w.y)}; v1 = (f32x4){lo16(w.z), hi16(w.z), lo16(w.w), hi16(w.w)};
}
#define EPI_LOOP_AM _Pragma("unroll") for (int ai = 0; ai < 2; ++ai) _Pragma("unroll") for (int m = 0; m < 4; ++m)
#define EPI_ARGS f32x4 (&acc)[2][2][4][2], const Unit& u, int wr, int wc, int fr, int fq, const LAS unsigned char* pf

struct EpiProj { static constexpr bool PERM = true, PREF = false; bf16 *AG, *RKV, *LP;
    __device__ __forceinline__ void operator()(EPI_ARGS) const {
        const int row0 = u.pm * 256 + wr * 64 + fr;
        if (u.pn < 2) { const int col0 = u.pn * 256 + wc * 32 + 8 * fq;
            EPI_LOOP_AM { const int row = row0 + ai * 128 + m * 16;
#pragma unroll
                for (int bj = 0; bj < 2; ++bj) { const int c = col0 + bj * 128; st8(AG + ((size_t)((c >> 4) * 1024 + (row >> 5))) * 640 + (row & 31) * 16 + (c & 15), acc[ai][bj][m][0], acc[ai][bj][m][1]); } }
        } else {
            bf16* base; int ldc, c0;
            if (u.pn < 8) { base = RKV; ldc = 1536; c0 = (u.pn - 2) * 256; } else { base = LP; ldc = 512; c0 = (u.pn - 8) * 256; }
            const int col0 = c0 + wc * 32 + 8 * fq;
            EPI_LOOP_AM { bf16* rowp = base + (size_t)(row0 + ai * 128 + m * 16) * ldc + col0;
#pragma unroll
                for (int bj = 0; bj < 2; ++bj) st8(rowp + bj * 128, acc[ai][bj][m][0], acc[ai][bj][m][1]); }
        }
    }
};
struct EpiBf16Plain { static constexpr bool PERM = true, PREF = false; bf16* O; int ldc;
    __device__ __forceinline__ void operator()(EPI_ARGS) const {
        const int row0 = u.pm * 256 + wr * 64 + fr, col0 = u.pn * 256 + wc * 32 + 8 * fq;
        EPI_LOOP_AM { bf16* rowp = O + (size_t)(row0 + ai * 128 + m * 16) * ldc + col0;
#pragma unroll
            for (int bj = 0; bj < 2; ++bj) st8(rowp + bj * 128, acc[ai][bj][m][0], acc[ai][bj][m][1]); }
    }
};
struct EpiF32 { static constexpr bool PERM = false, PREF = false; float* C; int ldc;
    __device__ __forceinline__ void operator()(EPI_ARGS) const {
        const int row0 = u.pm * 256 + wr * 64 + fr, col0 = u.pn * 256 + wc * 32 + 4 * fq;
        EPI_LOOP_AM { float* rowp = C + (size_t)(row0 + ai * 128 + m * 16) * ldc + col0;
#pragma unroll
            for (int bj = 0; bj < 2; ++bj)
#pragma unroll
                for (int n = 0; n < 2; ++n) *(f32x4*)(rowp + bj * 128 + n * 16) = acc[ai][bj][m][n]; }
    }
};
struct EpiS5Y { static constexpr bool PERM = true, PREF = false; const bf16* AG; const float* dskip; bf16* Y1;
    __device__ __forceinline__ void operator()(EPI_ARGS) const {
        const int g = u.pm >> 2, crow0 = (u.pm & 3) * 256 + wr * 64 + fr, col0 = u.pn * 256 + wc * 32 + 8 * fq;
        EPI_LOOP_AM { const int crow = crow0 + ai * 128 + m * 16;
#pragma unroll
            for (int bj = 0; bj < 2; ++bj) { const int col = col0 + bj * 128, t = col >> 4, c = col & 15;
                f32x4 u0, u1; ld8(AG + ((size_t)(g * 1024 + crow)) * 640 + col, u0, u1);
                const f32x4 d0 = *(const f32x4*)(dskip + g * 16 + c), d1 = *(const f32x4*)(dskip + g * 16 + c + 4);
                f32x4 v0 = acc[ai][bj][m][0] + d0 * u0, v1 = acc[ai][bj][m][1] + d1 * u1;
#pragma unroll
                for (int j = 0; j < 4; ++j) { v0[j] = gelu_tanh(v0[j]); v1[j] = gelu_tanh(v1[j]); }
                st8(Y1 + (size_t)(crow * 32 + t) * 512 + g * 16 + c, v0, v1); } }
    }
};
struct EpiGlu { static constexpr bool PERM = true, PREF = false; const bf16* Y1; bf16* MIX;
    __device__ __forceinline__ void operator()(EPI_ARGS) const {
        const int row0 = u.pm * 256 + wr * 64 + fr, col0 = u.pn * 256 + wc * 32 + 8 * fq;
        EPI_LOOP_AM { const int row = row0 + ai * 128 + m * 16;
#pragma unroll
            for (int bj = 0; bj < 2; ++bj) { const int col = col0 + bj * 128; f32x4 y0, y1v; ld8(Y1 + (size_t)row * 512 + col, y0, y1v);
                f32x4 v0, v1;
#pragma unroll
                for (int j = 0; j < 4; ++j) { v0[j] = y0[j] * fsigmoid(acc[ai][bj][m][0][j]); v1[j] = y1v[j] * fsigmoid(acc[ai][bj][m][1][j]); }
                st8(MIX + (size_t)row * 1024 + col, v0, v1); } }
    }
};
struct EpiResid { static constexpr bool PERM = true, PREF = false; const float* X; bf16* O;
    __device__ __forceinline__ void operator()(EPI_ARGS) const {
        const int row0 = u.pm * 256 + wr * 64 + fr, col0 = u.pn * 256 + wc * 32 + 8 * fq;
        EPI_LOOP_AM { const size_t off = (size_t)(row0 + ai * 128 + m * 16) * 1024 + col0;
#pragma unroll
            for (int bj = 0; bj < 2; ++bj) { const f32x4 x0 = __builtin_nontemporal_load((const f32x4*)(X + off + bj * 128)), x1 = __builtin_nontemporal_load((const f32x4*)(X + off + bj * 128 + 4)); st8(O + off + bj * 128, x0 + acc[ai][bj][m][0], x1 + acc[ai][bj][m][1]); } }
    }
};
struct EpiGU { static constexpr bool PERM = true, PREF = true; unsigned char* ACT; const float* bg; const float* bu;
    __device__ __forceinline__ void pref(LAS unsigned char* pf, const Unit& u, int wc, int lane) const {
        const float* src = ((lane & 32) ? bu : bg) + u.aux * 1024 + u.pn * 128 + wc * 32 + (lane & 31);
        __builtin_amdgcn_global_load_lds((const unsigned*)src, (LAS unsigned*)pf, 4, 0, 0); }
    __device__ __forceinline__ void operator()(EPI_ARGS) const {
        const int row0 = u.pm * 256 + wr * 64 + fr + (fq & 1) * 16, col = u.pn * 128 + wc * 32 + (fq >> 1) * 16;
        const f32x4 g0 = *(const LAS f32x4*)(pf + 32 * fq), g1 = *(const LAS f32x4*)(pf + 32 * fq + 16), u0 = *(const LAS f32x4*)(pf + 128 + 32 * fq), u1 = *(const LAS f32x4*)(pf + 128 + 32 * fq + 16);
#pragma unroll
        for (int ai = 0; ai < 2; ++ai)
#pragma unroll
            for (int mp = 0; mp < 2; ++mp) { u32x2 w[2];
#pragma unroll
                for (int q = 0; q < 2; ++q) { const int m = 2 * mp + q; f32x4 v0, v1;
#pragma unroll
                    for (int j = 0; j < 4; ++j) {
                        const float gt0 = fminf(acc[ai][0][m][0][j] + g0[j], 7.0f), up0 = fminf(fmaxf(acc[ai][1][m][0][j] + u0[j], -7.0f), 7.0f);
                        const float gt1 = fminf(acc[ai][0][m][1][j] + g1[j], 7.0f), up1 = fminf(fmaxf(acc[ai][1][m][1][j] + u1[j], -7.0f), 7.0f);
                        v0[j] = (up0 + 1.0f) * gt0 * fsigmoid(1.702f * gt0); v1[j] = (up1 + 1.0f) * gt1 * fsigmoid(1.702f * gt1); }
                    w[q].x = pk4_fp8(v0[0], v0[1], v0[2], v0[3]); w[q].y = pk4_fp8(v1[0], v1[1], v1[2], v1[3]); }
                const auto rx = __builtin_amdgcn_permlane16_swap(w[0].x, w[1].x, false, false), ry = __builtin_amdgcn_permlane16_swap(w[0].y, w[1].y, false, false);
                *(u32x4*)(ACT + (size_t)(row0 + ai * 128 + mp * 32) * 1024 + col) = (u32x4){rx[0], ry[0], rx[1], ry[1]}; }
    }
};
struct EpiDown { static constexpr bool PERM = true, PREF = true; unsigned char* Y; const float* bd;
    __device__ __forceinline__ void pref(LAS unsigned char* pf, const Unit& u, int wc, int lane) const {
        const float* src = bd + u.aux * 1024 + u.pn * 256 + (lane >> 5) * 128 + wc * 32 + (lane & 31);
        __builtin_amdgcn_global_load_lds((const unsigned*)src, (LAS unsigned*)pf, 4, 0, 0); }
    __device__ __forceinline__ void operator()(EPI_ARGS) const {
        const int row0 = u.pm * 256 + wr * 64 + fr, col0 = u.pn * 256 + wc * 32 + (fq >> 1) * 16 + (fq & 1) * 128;
        EPI_LOOP_AM { unsigned char* rowp = Y + (size_t)(row0 + ai * 128 + m * 16) * 1024 + col0; u32x2 w[2];
#pragma unroll
            for (int bj = 0; bj < 2; ++bj) { const f32x4 b0 = *(const LAS f32x4*)(pf + 128 * bj + 32 * fq), b1 = *(const LAS f32x4*)(pf + 128 * bj + 32 * fq + 16);
                const f32x4 v0 = acc[ai][bj][m][0] + b0, v1 = acc[ai][bj][m][1] + b1; w[bj].x = pk4_fp8(v0[0], v0[1], v0[2], v0[3]); w[bj].y = pk4_fp8(v1[0], v1[1], v1[2], v1[3]); }
            const auto rx = __builtin_amdgcn_permlane16_swap(w[0].x, w[1].x, false, false), ry = __builtin_amdgcn_permlane16_swap(w[0].y, w[1].y, false, false);
            *(u32x4*)rowp = (u32x4){rx[0], ry[0], rx[1], ry[1]}; }
    }
};
struct EpiPle { static constexpr bool PERM = true, PREF = false; const bf16* PP; bf16* O;
    __device__ __forceinline__ void operator()(EPI_ARGS) const {
        const int row0 = u.pm * 256 + wr * 64 + fr, col0 = u.pn * 256 + wc * 32 + 8 * fq;
        EPI_LOOP_AM { const size_t off = (size_t)(row0 + ai * 128 + m * 16) * 1024 + col0;
#pragma unroll
            for (int bj = 0; bj < 2; ++bj) { f32x4 p0, p1, x0, x1; ld8(PP + off + bj * 128, p0, p1); ld8(O + off + bj * 128, x0, x1);
#pragma unroll
                for (int j = 0; j < 4; ++j) { x0[j] += p0[j] * fsigmoid(acc[ai][bj][m][0][j]); x1[j] += p1[j] * fsigmoid(acc[ai][bj][m][1][j]); }
                st8(O + off + bj * 128, x0, x1); } }
    }
};

#ifndef XMODE
#define XMODE 1
#endif
struct EpiDownX { static constexpr bool PERM = true, PREF = true; unsigned char* Y; const float* bd;
    __device__ __forceinline__ void pref(LAS unsigned char* pf, const Unit& u, int wc, int lane) const {
        const float* src = bd + u.aux * 1024 + u.pn * 256 + (lane >> 5) * 128 + wc * 32 + (lane & 31);
        __builtin_amdgcn_global_load_lds((const unsigned*)src, (LAS unsigned*)pf, 4, 0, 0); }
    __device__ __forceinline__ void operator()(EPI_ARGS) const {
        unsigned char* base = Y + (size_t)(u.pm * 256 + (wr * 4 + wc) * 32) * 1024 + u.pn * 256; const int lane = fq * 16 + fr; int k = 0;
        EPI_LOOP_AM {
            u32x2 w[2];
#pragma unroll
            for (int bj = 0; bj < 2; ++bj) { const f32x4 b0 = *(const LAS f32x4*)(pf + 128 * bj + 32 * fq), b1 = *(const LAS f32x4*)(pf + 128 * bj + 32 * fq + 16);
                const f32x4 v0 = acc[ai][bj][m][0] + b0, v1 = acc[ai][bj][m][1] + b1; w[bj].x = pk4_fp8(v0[0], v0[1], v0[2], v0[3]); w[bj].y = pk4_fp8(v1[0], v1[1], v1[2], v1[3]); }
            if (XMODE == 1) { *(u32x2*)(base + (size_t)(k * 4 + (lane >> 5)) * 1024 + (lane & 31) * 8) = w[0]; *(u32x2*)(base + (size_t)(k * 4 + 2 + (lane >> 5)) * 1024 + (lane & 31) * 8) = w[1]; }
            else { *(u32x4*)(base + (size_t)(k * 4 + (lane >> 4)) * 1024 + (lane & 15) * 16) = (u32x4){w[0].x, w[0].y, w[1].x, w[1].y}; }
            ++k; }
    }
};
struct EpiNull { static constexpr bool PERM = true, PREF = false; __device__ __forceinline__ void operator()(EPI_ARGS) const { } };
struct EpiPleNorm { static constexpr bool PERM = true, PREF = false; const bf16* PP; const bf16* XIN; float* OUT; const float* gfin; float* rowss; unsigned* pcnt;
    __device__ __forceinline__ void operator()(EPI_ARGS) const {
        const int row0 = u.pm * 256 + wr * 64 + fr, col0 = u.pn * 256 + wc * 32 + 8 * fq;
        EPI_LOOP_AM { const size_t off = (size_t)(row0 + ai * 128 + m * 16) * 1024 + col0; float s = 0.f;
#pragma unroll
            for (int bj = 0; bj < 2; ++bj) { f32x4 p0, p1, x0, x1; ld8(PP + off + bj * 128, p0, p1); ld8(XIN + off + bj * 128, x0, x1);
#pragma unroll
                for (int j = 0; j < 4; ++j) { x0[j] += p0[j] * fsigmoid(acc[ai][bj][m][0][j]); x1[j] += p1[j] * fsigmoid(acc[ai][bj][m][1][j]); s += x0[j] * x0[j] + x1[j] * x1[j]; }
                acc[ai][bj][m][0] = x0; acc[ai][bj][m][1] = x1; }
            s += __shfl_xor(s, 16); s += __shfl_xor(s, 32);
            if (fq == 0) atomicAdd(rowss + row0 + ai * 128 + m * 16, s); }
        asm volatile("s_waitcnt vmcnt(0)" ::: "memory");
        unsigned* cnt = pcnt + 64 * u.pm;
        if ((fr | fq) == 0) __hip_atomic_fetch_add(cnt, 1u, __ATOMIC_RELAXED, __HIP_MEMORY_SCOPE_AGENT);
        { unsigned sp = 0; while (__builtin_amdgcn_readfirstlane(__hip_atomic_load(cnt, __ATOMIC_RELAXED, __HIP_MEMORY_SCOPE_AGENT)) < 32u) { __builtin_amdgcn_s_sleep(2); if (++sp > (1u << 22)) break; } }
        f32x4 gv[2][2];
#pragma unroll
        for (int bj = 0; bj < 2; ++bj) { gv[bj][0] = *(const f32x4*)(gfin + col0 + bj * 128); gv[bj][1] = *(const f32x4*)(gfin + col0 + bj * 128 + 4); }
        EPI_LOOP_AM { const int row = row0 + ai * 128 + m * 16; const float ssr = __hip_atomic_load(rowss + row, __ATOMIC_RELAXED, __HIP_MEMORY_SCOPE_AGENT); const float rinv = rsqrtf(ssr * (1.f / 1024.f) + 1e-6f);
            float* orow = OUT + (size_t)row * 1024 + col0;
#pragma unroll
            for (int bj = 0; bj < 2; ++bj) { __builtin_nontemporal_store(acc[ai][bj][m][0] * rinv * gv[bj][0], (f32x4*)(orow + bj * 128)); __builtin_nontemporal_store(acc[ai][bj][m][1] * rinv * gv[bj][1], (f32x4*)(orow + bj * 128 + 4)); } }
    }
};

struct Ctx { LAS unsigned char* lds; int tid, lane, wave, G, wg, gw, NGW; };

template <int NBW>
__device__ __forceinline__ void transpose_item(const float* W, int N, int k0, int n0, bf16* dst, int ldk, const float* scl, int flip, LAS float* scr, int lane) {
    constexpr int LPR = NBW / 4, RPI = 64 / LPR, NI = 64 / RPI;
    const int rr = lane / LPR, cc = (lane % LPR) * 4;
    f32x4 v[NI];
#pragma unroll
    for (int i = 0; i < NI; ++i) v[i] = *(const f32x4*)(W + (size_t)(k0 + i * RPI + rr) * N + n0 + cc);
#pragma unroll
    for (int i = 0; i < NI; ++i) { const int kk = i * RPI + rr; f32x4 x = v[i];
        if (scl) { const float s0 = scl[k0 + kk]; const float f = flip ? (1.0f - s0) : s0; x = x * f; }
        LAS float* d = scr + kk * 65 + cc; d[0] = x.x; d[1] = x.y; d[2] = x.z; d[3] = x.w; }
    LDS_WAIT(); asm volatile("" ::: "memory");
    const int c = lane & 7;
#pragma unroll
    for (int j = 0; j < NBW / 8; ++j) { const int n = (lane >> 3) + 8 * j; const LAS float* s = scr + (8 * c) * 65 + n;
        u32x4 o; o.x = pk2(s[0 * 65], s[1 * 65]); o.y = pk2(s[2 * 65], s[3 * 65]); o.z = pk2(s[4 * 65], s[5 * 65]); o.w = pk2(s[6 * 65], s[7 * 65]);
        *(u32x4*)(dst + (size_t)n * ldk + 8 * c) = o; }
    LDS_WAIT(); asm volatile("" ::: "memory");
}
struct F8Item { f32x4 v[16]; };
__device__ __forceinline__ void f8_issue(const float* W, int N, int k0, int n0, int lane, F8Item& it) {
    const int rr = lane >> 4, cc = (lane & 15) * 4;
#pragma unroll
    for (int i = 0; i < 16; ++i) it.v[i] = __builtin_nontemporal_load((const f32x4*)(W + (size_t)(k0 + i * 4 + rr) * N + n0 + cc));
}
__device__ __forceinline__ void f8_finish(const F8Item& it, unsigned char* dst, int ldk, float scale, LAS float* scr, int lane) {
    const int rr = lane >> 4, cc = (lane & 15) * 4;
#pragma unroll
    for (int i = 0; i < 16; ++i) { const int kk = i * 4 + rr; LAS float* d = scr + kk * 65 + cc; d[0] = it.v[i].x * scale; d[1] = it.v[i].y * scale; d[2] = it.v[i].z * scale; d[3] = it.v[i].w * scale; }
    LDS_WAIT(); asm volatile("" ::: "memory");
    const int c = lane & 3;
#pragma unroll
    for (int j = 0; j < 4; ++j) { const int n = (lane >> 2) + 16 * j; const LAS float* s = scr + (16 * c) * 65 + n;
        u32x4 o; o.x = pk4_fp8(s[0 * 65], s[1 * 65], s[2 * 65], s[3 * 65]); o.y = pk4_fp8(s[4 * 65], s[5 * 65], s[6 * 65], s[7 * 65]); o.z = pk4_fp8(s[8 * 65], s[9 * 65], s[10 * 65], s[11 * 65]); o.w = pk4_fp8(s[12 * 65], s[13 * 65], s[14 * 65], s[15 * 65]);
        *(u32x4*)(dst + (size_t)n * ldk + 16 * c) = o; }
    LDS_WAIT(); asm volatile("" ::: "memory");
}
__device__ __forceinline__ void transpose_item_fp8(const float* W, int N, int k0, int n0, unsigned char* dst, int ldk, float scale, LAS float* scr, int lane) {
    F8Item it; f8_issue(W, N, k0, n0, lane, it); f8_finish(it, dst, ldk, scale, scr, lane);
}
__device__ __forceinline__ void transpose_matrix(const Ctx& cx, const float* W, int K, int N, bf16* WT, int row_off, int ldk, int koff, const float* scl, int flip) {
    LAS float* scr = (LAS float*)(cx.lds + cx.wave * 16640);
    const int nblk = N / 64, nitems = (K / 64) * nblk;
    for (int it = cx.gw; it < nitems; it += cx.NGW) { const int kb = it / nblk, nb = it % nblk;
        transpose_item<64>(W, N, 64 * kb, 64 * nb, WT + (size_t)(row_off + 64 * nb) * ldk + koff + 64 * kb, ldk, scl, flip, scr, cx.lane); }
}
__device__ __forceinline__ void rms_row_to_bf16(const float* xrow, const float* g, bf16* orow, int lane) {
    const f32x4* xr = (const f32x4*)xrow + lane; const f32x4* gr = (const f32x4*)g + lane;
    f32x4 v[4]; float s = 0.f;
#pragma unroll
    for (int j = 0; j < 4; ++j) { v[j] = xr[64 * j]; s += (v[j].x * v[j].x + v[j].y * v[j].y) + (v[j].z * v[j].z + v[j].w * v[j].w); }
    const float rinv = rsqrtf(wave_sum(s) * (1.f / 1024.f) + 1e-6f);
    u32x2* o8 = (u32x2*)orow + lane;
#pragma unroll
    for (int j = 0; j < 4; ++j) { const f32x4 gg = gr[64 * j]; u32x2 w; w.x = pk2(v[j].x * rinv * gg.x, v[j].y * rinv * gg.y); w.y = pk2(v[j].z * rinv * gg.z, v[j].w * rinv * gg.w); o8[64 * j] = w; }
}

__device__ __forceinline__ void rms_rows2_to_bf16(const float* xa, const float* xb, const float* g, bf16* oa, bf16* ob, int lane) {
    const f32x4* ra = (const f32x4*)xa + lane; const f32x4* rb = (const f32x4*)xb + lane; const f32x4* gr = (const f32x4*)g + lane;
    f32x4 va[4], vb[4]; float sa = 0.f, sb = 0.f;
#pragma unroll
    for (int j = 0; j < 4; ++j) { va[j] = __builtin_nontemporal_load(ra + 64 * j); vb[j] = __builtin_nontemporal_load(rb + 64 * j); }
#pragma unroll
    for (int j = 0; j < 4; ++j) { sa += (va[j].x * va[j].x + va[j].y * va[j].y) + (va[j].z * va[j].z + va[j].w * va[j].w); sb += (vb[j].x * vb[j].x + vb[j].y * vb[j].y) + (vb[j].z * vb[j].z + vb[j].w * vb[j].w); }
#pragma unroll
    for (int o = 1; o < 64; o <<= 1) { sa += __shfl_xor(sa, o); sb += __shfl_xor(sb, o); }
    const float ia = rsqrtf(sa * (1.f / 1024.f) + 1e-6f), ib = rsqrtf(sb * (1.f / 1024.f) + 1e-6f);
    u32x2* pa = (u32x2*)oa + lane; u32x2* pb = (u32x2*)ob + lane;
#pragma unroll
    for (int j = 0; j < 4; ++j) { const f32x4 gg = gr[64 * j]; u32x2 w; w.x = pk2(va[j].x * ia * gg.x, va[j].y * ia * gg.y); w.y = pk2(va[j].z * ia * gg.z, va[j].w * ia * gg.w); pa[64 * j] = w;
        w.x = pk2(vb[j].x * ib * gg.x, vb[j].y * ib * gg.y); w.y = pk2(vb[j].z * ib * gg.z, vb[j].w * ib * gg.w); pb[64 * j] = w; }
}

__device__ __forceinline__ void s5_tables_item(const Ctx& cx, int g, int part, const float* lam_re, const float* lam_im, const float* log_dt, const float* b_re, const float* b_im, const float* c_re, const float* c_im,
                                               bf16* BT, bf16* ET, float* AT) {
    LAS float* apr = (LAS float*)cx.lds; LAS float* api = apr + 33 * 64; LAS float* bbr = api + 33 * 64; LAS float* bbi = bbr + 1024; LAS float* cr = bbi + 1024; LAS float* ci = cr + 1024; LAS float* kt = ci + 1024;
    const int tid = cx.tid;
    const float dt = __expf(log_dt[g]);
    for (int idx = tid; idx < 33 * 64; idx += NTHR) { const int j = idx >> 6, p = idx & 63;
        const float lre = fminf(lam_re[g * 64 + p], -1e-4f), lim = lam_im[g * 64 + p];
        const float mag = expf(lre * dt * (float)j), ang = lim * dt * (float)j; float sn, cs; sincosf(ang, &sn, &cs);
        apr[idx] = mag * cs; api[idx] = mag * sn; }
    for (int idx = tid; idx < 1024; idx += NTHR) { const int p = idx >> 4;
        const float lre = fminf(lam_re[g * 64 + p], -1e-4f), lim = lam_im[g * 64 + p];
        const float mag = expf(lre * dt); float sn, cs; sincosf(lim * dt, &sn, &cs); const float lbr = mag * cs, lbi = mag * sn;
        const float den = lre * lre + lim * lim, zr = lbr - 1.0f; const float cor = (zr * lre + lbi * lim) / den, coi = (lbi * lre - zr * lim) / den;
        const float br = b_re[g * 1024 + idx], bi = b_im[g * 1024 + idx];
        bbr[idx] = cor * br - coi * bi; bbi[idx] = cor * bi + coi * br;
        cr[idx] = c_re[g * 1024 + idx]; ci[idx] = c_im[g * 1024 + idx]; }
    __syncthreads();
    if (tid < 64) { const int jl = tid >> 4, c = tid & 15, j = 4 * part + jl; float acc[16];
#pragma unroll
        for (int i = 0; i < 16; ++i) acc[i] = 0.f;
        for (int p = 0; p < 64; ++p) { const float ar = apr[j * 64 + p], ai = api[j * 64 + p], xr = cr[c * 64 + p], xi = ci[c * 64 + p];
            const float car = xr * ar - xi * ai, cai = xr * ai + xi * ar;
#pragma unroll
            for (int v4 = 0; v4 < 4; ++v4) { const f32x4 br = *(const LAS f32x4*)(bbr + p * 16 + 4 * v4), bi = *(const LAS f32x4*)(bbi + p * 16 + 4 * v4);
                acc[4 * v4 + 0] += car * br.x - cai * bi.x; acc[4 * v4 + 1] += car * br.y - cai * bi.y; acc[4 * v4 + 2] += car * br.z - cai * bi.z; acc[4 * v4 + 3] += car * br.w - cai * bi.w; } }
#pragma unroll
        for (int i = 0; i < 16; ++i) kt[jl * 256 + c * 16 + i] = acc[i]; }
    __syncthreads();
    bf16* BTg = BT + (size_t)g * 512 * 640; bf16* ETg = ET + (size_t)g * 256 * 512;
    for (int idx = tid; idx < 4096; idx += NTHR) { const int hf = idx & 1, c = (idx >> 1) & 15, t = (idx >> 5) & 31, jl = idx >> 10, j = 4 * part + jl;
        if (t >= j) { const LAS float* s = kt + jl * 256 + c * 16 + hf * 8; u32x4 o; o.x = pk2(s[0], s[1]); o.y = pk2(s[2], s[3]); o.z = pk2(s[4], s[5]); o.w = pk2(s[6], s[7]);
            *(u32x4*)(BTg + (size_t)(t * 16 + c) * 640 + (t - j) * 16 + hf * 8) = o; } }
    for (int idx = tid; idx < 4096; idx += NTHR) { const int hf = idx & 1, c = (idx >> 1) & 15, s = (idx >> 5) & 31, t = 4 * part + (idx >> 10);
        if (s > t) *(u32x4*)(BTg + (size_t)(t * 16 + c) * 640 + s * 16 + hf * 8) = (u32x4){0u, 0u, 0u, 0u}; }
    for (int idx = tid; idx < 1024; idx += NTHR) { const int ch = idx & 15, c = (idx >> 4) & 15, t = 4 * part + (idx >> 8); const int im = ch >> 3, p0 = (ch & 7) * 8; float v[8];
#pragma unroll
        for (int q = 0; q < 8; ++q) { const int p = p0 + q; const float ar = apr[(t + 1) * 64 + p], ai = api[(t + 1) * 64 + p], xr = cr[c * 64 + p], xi = ci[c * 64 + p];
            v[q] = im ? -(xr * ai + xi * ar) : (xr * ar - xi * ai); }
        u32x4 o; o.x = pk2(v[0], v[1]); o.y = pk2(v[2], v[3]); o.z = pk2(v[4], v[5]); o.w = pk2(v[6], v[7]);
        *(u32x4*)(BTg + (size_t)(t * 16 + c) * 640 + 512 + im * 64 + p0) = o; }
    for (int idx = tid; idx < 1024; idx += NTHR) { const int hf = idx & 1, sl = (idx >> 1) & 3, n = idx >> 3, s = 4 * part + sl, p = n & 63, im = n >> 6; float v[8];
        const float ar = apr[(31 - s) * 64 + p], ai = api[(31 - s) * 64 + p];
#pragma unroll
        for (int q = 0; q < 8; ++q) { const float br = bbr[p * 16 + hf * 8 + q], bi = bbi[p * 16 + hf * 8 + q]; v[q] = im ? (ar * bi + ai * br) : (ar * br - ai * bi); }
        u32x4 o; o.x = pk2(v[0], v[1]); o.y = pk2(v[2], v[3]); o.z = pk2(v[4], v[5]); o.w = pk2(v[6], v[7]);
        *(u32x4*)(ETg + (size_t)n * 512 + s * 16 + hf * 8) = o; }
    for (int idx = tid; idx < 1024; idx += NTHR) { const int ch = idx & 63, r = 128 + 16 * part + (idx >> 6); *(u32x4*)(ETg + (size_t)r * 512 + ch * 8) = (u32x4){0u, 0u, 0u, 0u}; }
    if (part == 0 && tid < 64) { AT[(g * 64 + tid) * 2] = apr[32 * 64 + tid]; AT[(g * 64 + tid) * 2 + 1] = api[32 * 64 + tid]; }
    __syncthreads();
}

constexpr int IMG_LD = 80, IMG_B = 64 * IMG_LD * 2;
#define IMG(k) ((LAS bf16*)(lds + (k) * IMG_B))
#define LDS_BARRIER() do { asm volatile("s_waitcnt lgkmcnt(0)" ::: "memory"); __builtin_amdgcn_s_barrier(); asm volatile("" ::: "memory"); } while (0)
struct MmCtx { int tr, tc0, l15, q; };
__device__ __forceinline__ void mm64(const LAS bf16* A, const LAS bf16* Bt, f32x4 (&acc)[2], const MmCtx& w) {
#pragma unroll
    for (int s = 0; s < 2; ++s) {
        const bf16x8 a = *(const LAS bf16x8*)(A + (16 * w.tr + w.l15) * IMG_LD + 32 * s + 8 * w.q);
#pragma unroll
        for (int c = 0; c < 2; ++c) { const bf16x8 b = *(const LAS bf16x8*)(Bt + (16 * (w.tc0 + c) + w.l15) * IMG_LD + 32 * s + 8 * w.q);
            acc[c] = __builtin_amdgcn_mfma_f32_16x16x32_bf16(a, b, acc[c], 0, 0, 0); }
    }
}
__device__ __forceinline__ void mm64_2a(const LAS bf16* A1, const LAS bf16* A2, const LAS bf16* Bt, f32x4 (&acc1)[2], f32x4 (&acc2)[2], const MmCtx& w) {
#pragma unroll
    for (int s = 0; s < 2; ++s) {
        const bf16x8 a1 = *(const LAS bf16x8*)(A1 + (16 * w.tr + w.l15) * IMG_LD + 32 * s + 8 * w.q), a2 = *(const LAS bf16x8*)(A2 + (16 * w.tr + w.l15) * IMG_LD + 32 * s + 8 * w.q);
#pragma unroll
        for (int c = 0; c < 2; ++c) { const bf16x8 b = *(const LAS bf16x8*)(Bt + (16 * (w.tc0 + c) + w.l15) * IMG_LD + 32 * s + 8 * w.q);
            acc1[c] = __builtin_amdgcn_mfma_f32_16x16x32_bf16(a1, b, acc1[c], 0, 0, 0); acc2[c] = __builtin_amdgcn_mfma_f32_16x16x32_bf16(a2, b, acc2[c], 0, 0, 0); }
    }
}
__device__ __forceinline__ void mm64_2b(const LAS bf16* A, const LAS bf16* Bt1, const LAS bf16* Bt2, f32x4 (&acc1)[2], f32x4 (&acc2)[2], const MmCtx& w) {
#pragma unroll
    for (int s = 0; s < 2; ++s) {
        const bf16x8 a = *(const LAS bf16x8*)(A + (16 * w.tr + w.l15) * IMG_LD + 32 * s + 8 * w.q);
#pragma unroll
        for (int c = 0; c < 2; ++c) { const bf16x8 b1 = *(const LAS bf16x8*)(Bt1 + (16 * (w.tc0 + c) + w.l15) * IMG_LD + 32 * s + 8 * w.q), b2 = *(const LAS bf16x8*)(Bt2 + (16 * (w.tc0 + c) + w.l15) * IMG_LD + 32 * s + 8 * w.q);
            acc1[c] = __builtin_amdgcn_mfma_f32_16x16x32_bf16(a, b1, acc1[c], 0, 0, 0); acc2[c] = __builtin_amdgcn_mfma_f32_16x16x32_bf16(a, b2, acc2[c], 0, 0, 0); }
    }
}
__device__ __forceinline__ float dpp_x1(float v) { return __int_as_float(__builtin_amdgcn_update_dpp(0, __float_as_int(v), 0xB1, 0xF, 0xF, true)); }
__device__ __forceinline__ float dpp_x2(float v) { return __int_as_float(__builtin_amdgcn_update_dpp(0, __float_as_int(v), 0x4E, 0xF, 0xF, true)); }
__device__ __forceinline__ f32x4 quad_transpose(const f32x4 v, int b) {
    const bool odd = (b & 1) != 0, hi = (b & 2) != 0;
    const float r0 = dpp_x1(odd ? v[0] : v[1]), r1 = dpp_x1(odd ? v[2] : v[3]);
    const float p0a = odd ? r0 : v[0], p0b = odd ? v[1] : r0, p1a = odd ? r1 : v[2], p1b = odd ? v[3] : r1;
    const float ra = dpp_x2(hi ? p0a : p1a), rb = dpp_x2(hi ? p0b : p1b);
    return hi ? (f32x4){ra, rb, p1a, p1b} : (f32x4){p0a, p0b, ra, rb};
}
__device__ __forceinline__ void st_rm(LAS bf16* img, const f32x4 v, int tr, int tc, const MmCtx& w) {
    const unsigned p01 = pk2(v[0], v[1]), p23 = pk2(v[2], v[3]); LAS bf16* d = img + (16 * tr + 4 * w.q) * IMG_LD + 16 * tc + w.l15;
    d[0] = (bf16)p01; d[IMG_LD] = (bf16)(p01 >> 16); d[2 * IMG_LD] = (bf16)p23; d[3 * IMG_LD] = (bf16)(p23 >> 16);
}
__device__ __forceinline__ void st_tr(LAS bf16* img, const f32x4 v, int tr, int tc, const MmCtx& w) {
    u32x2 o; o.x = pk2(v[0], v[1]); o.y = pk2(v[2], v[3]); *(LAS u32x2*)(img + (16 * tc + w.l15) * IMG_LD + 16 * tr + 4 * w.q) = o;
}
__device__ __forceinline__ void img_to_global(const LAS bf16* img, bf16* g, int tid) { const int row = tid >> 3, ch = tid & 7; *(u32x4*)(g + row * 64 + ch * 8) = *(const LAS u32x4*)(img + row * IMG_LD + ch * 8); }
__device__ __forceinline__ void st_tm8(LAS bf16* img, int t, int cg, const float (&v)[8]) {
    u32x4 o; o.x = pk2(v[0], v[1]); o.y = pk2(v[2], v[3]); o.z = pk2(v[4], v[5]); o.w = pk2(v[6], v[7]); *(LAS u32x4*)(img + t * IMG_LD + 8 * cg) = o;
}
__device__ __forceinline__ void st_cm8(LAS bf16* img, int t, int cg, const float (&v)[8]) {
#pragma unroll
    for (int i = 0; i < 8; i += 2) { const unsigned p = pk2(v[i], v[i + 1]); img[(8 * cg + i) * IMG_LD + t] = (bf16)p; img[(8 * cg + i + 1) * IMG_LD + t] = (bf16)(p >> 16); }
}
__device__ __forceinline__ float red8(float v) { v += __shfl_xor(v, 1); v += __shfl_xor(v, 2); v += __shfl_xor(v, 4); return v; }
__device__ __forceinline__ void unpack8(const u32x4 w, float (&o)[8]) { o[0] = lo16(w.x); o[1] = hi16(w.x); o[2] = lo16(w.y); o[3] = hi16(w.y); o[4] = lo16(w.z); o[5] = hi16(w.z); o[6] = lo16(w.w); o[7] = hi16(w.w); }
__device__ __forceinline__ void ldp8(const float* p, float (&o)[8]) { const f32x4 a = *(const f32x4*)p, b = *(const f32x4*)(p + 4); o[0] = a.x; o[1] = a.y; o[2] = a.z; o[3] = a.w; o[4] = b.x; o[5] = b.y; o[6] = b.z; o[7] = b.w; }

struct RwkvP { const bf16* rkv; const bf16* wag; const float *mu_rkv, *w0, *a0, *k_k, *k_a, *r_k, *ln_w, *ln_b; };
struct RwkvRaw { u32x4 kc, kp, vc, vp, wl, al, rc, rp, gg; };
template <bool PASS3>
__device__ __forceinline__ void rwkv_load(const RwkvP& P, int cidx, int tid, RwkvRaw& R) {
    const int t = tid >> 3, cg = tid & 7, bh = cidx >> 7, c = cidx & 127, b = bh >> 3, h = bh & 7, ch = h * 64 + 8 * cg;
    const size_t tok = (size_t)b * SEQ + c * 64 + t; const bool first = (c == 0 && t == 0);
    const bf16* row = P.rkv + tok * 1536 + ch; const bf16* prow = first ? row : row - 1536;
    R.kc = *(const u32x4*)(row + 512); R.vc = *(const u32x4*)(row + 1024); R.kp = *(const u32x4*)(prow + 512); R.vp = *(const u32x4*)(prow + 1024);
    R.wl = *(const u32x4*)(P.wag + tok * 1536 + ch); R.al = *(const u32x4*)(P.wag + tok * 1536 + 512 + ch);
    if (PASS3) { R.rc = *(const u32x4*)row; R.rp = *(const u32x4*)prow; R.gg = *(const u32x4*)(P.wag + tok * 1536 + 1024 + ch); }
}
constexpr int RC_OFF = 14 * IMG_B;
struct RwkvC { const LAS float* p; };
__device__ __forceinline__ void ldl8(const LAS float* p, float (&o)[8]) { const f32x4 a = *(const LAS f32x4*)p, b = *(const LAS f32x4*)(p + 4); o[0] = a.x; o[1] = a.y; o[2] = a.z; o[3] = a.w; o[4] = b.x; o[5] = b.y; o[6] = b.z; o[7] = b.w; }
__device__ __forceinline__ void rwkv_consts(LAS unsigned char* lds, const RwkvP& P, int h, int tid, RwkvC& C) {
    LAS float* base = (LAS float*)(lds + RC_OFF);
    if (tid < 64) { const int cg = tid >> 3, k = tid & 7, ch = h * 64 + 8 * cg; const float* src = k == 0 ? P.mu_rkv + ch : k == 1 ? P.mu_rkv + 512 + ch : k == 2 ? P.mu_rkv + 1024 + ch : k == 3 ? P.w0 + ch : k == 4 ? P.a0 + ch : k == 5 ? P.k_k + ch : P.k_a + ch;
        if (k < 7) { const f32x4 a = *(const f32x4*)src, b = *(const f32x4*)(src + 4); *(LAS f32x4*)(base + cg * 64 + k * 8) = a; *(LAS f32x4*)(base + cg * 64 + k * 8 + 4) = b; } }
    LDS_BARRIER();
    C.p = base + (tid & 7) * 64;
}
template <bool PASS3>
__device__ __forceinline__ void rwkv_prep(const RwkvRaw& R, const RwkvC& C, bool first, float (&kq)[8], float (&vv)[8], float (&rr)[8], float (&kap)[8], float (&bet)[8], float (&lw)[8]) {
    float kc[8], kp[8], vc[8], vp[8], k[8], wl[8], al[8], a[8], m[8];
    unpack8(R.kc, kc); unpack8(R.vc, vc); unpack8(R.kp, kp); unpack8(R.vp, vp); unpack8(R.wl, wl); unpack8(R.al, al);
    const float pm = first ? 0.f : 1.f;
    ldl8(C.p + 8, m);
#pragma unroll
    for (int i = 0; i < 8; ++i) k[i] = kc[i] + (pm * kp[i] - kc[i]) * m[i];
    ldl8(C.p + 16, m);
#pragma unroll
    for (int i = 0; i < 8; ++i) vv[i] = vc[i] + (pm * vp[i] - vc[i]) * m[i];
    if (PASS3) { float rc[8], rp[8]; unpack8(R.rc, rc); unpack8(R.rp, rp); ldl8(C.p, m);
#pragma unroll
        for (int i = 0; i < 8; ++i) rr[i] = rc[i] + (pm * rp[i] - rc[i]) * m[i];
    } else {
#pragma unroll
        for (int i = 0; i < 8; ++i) rr[i] = 0.f;
    }
    float ss = 0.f;
    ldl8(C.p + 24, m);
#pragma unroll
    for (int i = 0; i < 8; ++i) lw[i] = -0.6065306597126334f * fsigmoid(m[i] + wl[i]);
    ldl8(C.p + 32, m);
#pragma unroll
    for (int i = 0; i < 8; ++i) a[i] = fsigmoid(m[i] + al[i]);
    ldl8(C.p + 40, m);
#pragma unroll
    for (int i = 0; i < 8; ++i) { kap[i] = k[i] * m[i]; ss += kap[i] * kap[i]; }
    ss = red8(ss);
    const float inv = 1.0f / fmaxf(sqrtf(ss), 1e-12f);
    ldl8(C.p + 48, m);
#pragma unroll
    for (int i = 0; i < 8; ++i) { kap[i] *= inv; bet[i] = kap[i] * a[i]; kq[i] = k[i] * (1.0f + (a[i] - 1.0f) * m[i]); }
}
template <int SEGSLOT>
__device__ __forceinline__ void rwkv_cumsum(LAS unsigned char* lds, int tid, const float (&lw)[8], float (&cum)[8], float (&cumL)[8]) {
    LAS float* SEG = (LAS float*)(lds + SEGSLOT * IMG_B);
    const int lane = tid & 63, wv = tid >> 6, cg = tid & 7, tl = lane >> 3;
#pragma unroll
    for (int i = 0; i < 8; ++i) { float v = lw[i];
        { const float u = __shfl_up(v, 8); v += (tl >= 1) ? u : 0.f; }
        { const float u = __shfl_up(v, 16); v += (tl >= 2) ? u : 0.f; }
        { const float u = __shfl_up(v, 32); v += (tl >= 4) ? u : 0.f; }
        cum[i] = v; }
    if (tl == 7) {
#pragma unroll
        for (int i = 0; i < 8; ++i) SEG[wv * 64 + 8 * cg + i] = cum[i]; }
    LDS_BARRIER();
    float pre[8], tot[8];
#pragma unroll
    for (int i = 0; i < 8; ++i) { pre[i] = 0.f; tot[i] = 0.f; }
#pragma unroll 1
    for (int s2 = 0; s2 < 8; ++s2) { const f32x4 a = *(const LAS f32x4*)(SEG + s2 * 64 + 8 * cg), b = *(const LAS f32x4*)(SEG + s2 * 64 + 8 * cg + 4); const float m = (s2 < wv) ? 1.f : 0.f;
        tot[0] += a.x; tot[1] += a.y; tot[2] += a.z; tot[3] += a.w; tot[4] += b.x; tot[5] += b.y; tot[6] += b.z; tot[7] += b.w;
        pre[0] += m * a.x; pre[1] += m * a.y; pre[2] += m * a.z; pre[3] += m * a.w; pre[4] += m * b.x; pre[5] += m * b.y; pre[6] += m * b.z; pre[7] += m * b.w; }
#pragma unroll
    for (int i = 0; i < 8; ++i) { cum[i] += pre[i]; cumL[i] = tot[i]; }
}
#define Z4 (f32x4){0.f, 0.f, 0.f, 0.f}

__device__ __forceinline__ void rwkv_pass1(LAS unsigned char* lds, const RwkvP& P, int c0, int n, int tid, bf16* QCT, float* HCT, bf16* M1G, bf16* YLG, float* DLG, float* BONUS) {
    const int lane = tid & 63, wv = __builtin_amdgcn_readfirstlane(tid >> 6); MmCtx w; w.tr = wv >> 1; w.tc0 = (wv & 1) * 2; w.l15 = lane & 15; w.q = lane >> 4;
    const int t = tid >> 3, cg = tid & 7, ch = ((c0 >> 7) & 7) * 64 + 8 * cg;
    RwkvC C; rwkv_consts(lds, P, (c0 >> 7) & 7, tid, C);
    RwkvRaw R; rwkv_load<true>(P, c0, tid, R);
    for (int ci = 0; ci < n; ++ci) {
        const int cidx = c0 + ci;
        {
            float kq[8], vv[8], rr[8], kap[8], bet[8], lw[8], cum[8], cumL[8];
            rwkv_prep<true>(R, C, (cidx & 127) == 0 && t == 0, kq, vv, rr, kap, bet, lw);
            rwkv_cumsum<10>(lds, tid, lw, cum, cumL);
            { float bs = 0.f, rk[8]; ldp8(P.r_k + ch, rk);
#pragma unroll
              for (int i = 0; i < 8; ++i) bs += rr[i] * kq[i] * rk[i];
              bs = red8(bs); if (cg == 0) BONUS[(size_t)cidx * 64 + t] = bs; }
            float x[8], y[8];
#pragma unroll
            for (int i = 0; i < 8; ++i) { const float en = __expf(-cum[i]); x[i] = kq[i] * en; y[i] = bet[i] * en; }
            st_tm8(IMG(0), t, cg, x);
            st_tm8(IMG(1), t, cg, y);
#pragma unroll
            for (int i = 0; i < 8; ++i) x[i] = kap[i] * __expf(cum[i] - lw[i]);
            st_tm8(IMG(2), t, cg, x);
            st_cm8(IMG(3), t, cg, x);
#pragma unroll
            for (int i = 0; i < 8; ++i) x[i] = rr[i] * __expf(cum[i]);
            st_tm8(IMG(11), t, cg, x);
#pragma unroll
            for (int i = 0; i < 8; ++i) { const float eh = __expf(cumL[i] - cum[i]); x[i] = kq[i] * eh; y[i] = bet[i] * eh; }
            st_cm8(IMG(4), t, cg, x);
            st_cm8(IMG(5), t, cg, y);
            st_cm8(IMG(6), t, cg, vv);
            if (t == 0) {
#pragma unroll
                for (int i = 0; i < 8; ++i) DLG[(size_t)cidx * 64 + 8 * cg + i] = __expf(cumL[i]);
            }
        }
        if (ci + 1 < n) rwkv_load<true>(P, cidx + 1, tid, R);
        LDS_BARRIER();
        f32x4 accX[2];
        {
            f32x4 a[2] = {Z4, Z4}, kk[2] = {Z4, Z4};
            mm64_2a(IMG(1), IMG(0), IMG(2), a, kk, w);
#pragma unroll
            for (int c = 0; c < 2; ++c) { const int nn = 16 * (w.tc0 + c) + w.l15;
#pragma unroll
                for (int r = 0; r < 4; ++r) { const int m = 16 * w.tr + 4 * w.q + r; a[c][r] = (m < nn) ? a[c][r] : 0.f; kk[c][r] = (m < nn) ? kk[c][r] : 0.f; accX[c][r] = ((m == nn) ? 1.0f : 0.f) - a[c][r]; }
                st_rm(IMG(7), a[c], w.tr, w.tc0 + c, w); st_tr(IMG(8), a[c], w.tr, w.tc0 + c, w); st_rm(IMG(10), accX[c], w.tr, w.tc0 + c, w); st_rm(IMG(9), kk[c], w.tr, w.tc0 + c, w); }
        }
        LDS_BARRIER();
        {
            f32x4 p[2] = {Z4, Z4};
            mm64(IMG(7), IMG(8), p, w);
#pragma unroll
            for (int c = 0; c < 2; ++c) { st_rm(IMG(12), p[c], w.tr, w.tc0 + c, w); st_tr(IMG(13), p[c], w.tr, w.tc0 + c, w); }
        }
        LDS_BARRIER();
#define NEUMANN(XC, XN, PC, PTC, PN, PTN, LASTR) do { if (LASTR) { mm64(IMG(XC), IMG(PTC), accX, w); _Pragma("unroll") for (int c = 0; c < 2; ++c) st_tr(IMG(7), accX[c], w.tr, w.tc0 + c, w); }   \
            if (!(LASTR)) { f32x4 p[2] = {Z4, Z4}; mm64_2a(IMG(XC), IMG(PC), IMG(PTC), accX, p, w); \
                _Pragma("unroll") for (int c = 0; c < 2; ++c) { st_rm(IMG(PN), p[c], w.tr, w.tc0 + c, w); st_tr(IMG(PTN), p[c], w.tr, w.tc0 + c, w); st_rm(IMG(XN), accX[c], w.tr, w.tc0 + c, w); } } \
            LDS_BARRIER(); } while (0)
        NEUMANN(10, 2, 12, 13, 7, 8, false);
        NEUMANN(2, 10, 7, 8, 12, 13, false);
        NEUMANN(10, 2, 12, 13, 7, 8, false);
        NEUMANN(2, 10, 7, 8, 12, 13, false);
        NEUMANN(10, 2, 12, 13, 7, 8, true);
#undef NEUMANN
        {
            f32x4 a[2] = {Z4, Z4}, g[2] = {Z4, Z4}, kr[2] = {Z4, Z4}, br[2] = {Z4, Z4};
            mm64_2a(IMG(3), IMG(9), IMG(7), a, g, w); mm64_2b(IMG(11), IMG(0), IMG(1), kr, br, w);
#pragma unroll
            for (int c = 0; c < 2; ++c) { const int nn = 16 * (w.tc0 + c) + w.l15;
#pragma unroll
                for (int r = 0; r < 4; ++r) { const int m = 16 * w.tr + 4 * w.q + r; kr[c][r] = (nn <= m) ? kr[c][r] : 0.f; br[c][r] = (nn <= m) ? br[c][r] : 0.f; }
                st_rm(IMG(12), a[c], w.tr, w.tc0 + c, w); st_tr(IMG(8), g[c], w.tr, w.tc0 + c, w); st_rm(IMG(2), kr[c], w.tr, w.tc0 + c, w); st_rm(IMG(10), br[c], w.tr, w.tc0 + c, w); }
        }
        LDS_BARRIER();
        {
            f32x4 u[2] = {Z4, Z4}, qc[2] = {Z4, Z4}, m1[2] = {Z4, Z4};
            mm64(IMG(6), IMG(8), u, w); mm64(IMG(5), IMG(12), qc, w); mm64(IMG(10), IMG(12), m1, w);
#pragma unroll
            for (int c = 0; c < 2; ++c) { st_rm(IMG(13), u[c], w.tr, w.tc0 + c, w);
                const int tc = w.tc0 + c, cp = 32 * (tc >> 1) + 8 * (w.l15 >> 2) + 4 * (tc & 1) + (w.l15 & 3);
                const unsigned p01 = pk2(qc[c][0], qc[c][1]), p23 = pk2(qc[c][2], qc[c][3]); LAS bf16* d = IMG(0) + (16 * w.tr + 4 * w.q) * IMG_LD + cp;
                d[0] = (bf16)p01; d[IMG_LD] = (bf16)(p01 >> 16); d[2 * IMG_LD] = (bf16)p23; d[3 * IMG_LD] = (bf16)(p23 >> 16);
                f32x4 mv;
#pragma unroll
                for (int r = 0; r < 4; ++r) mv[r] = bf2f(IMG(11)[(16 * w.tr + 4 * w.q + r) * IMG_LD + 16 * tc + w.l15]) - m1[c][r];
                st_rm(IMG(1), mv, w.tr, tc, w); }
        }
        LDS_BARRIER();
        {
            f32x4 hp[2] = {Z4, Z4}, hn[2] = {Z4, Z4}, yp[2] = {Z4, Z4}, yn[2] = {Z4, Z4};
            mm64(IMG(4), IMG(6), hp, w); mm64(IMG(5), IMG(13), hn, w); mm64(IMG(2), IMG(6), yp, w); mm64(IMG(10), IMG(13), yn, w);
#pragma unroll
            for (int c = 0; c < 2; ++c) { *(f32x4*)(HCT + (((size_t)cidx * 16 + w.tr * 4 + w.tc0 + c) * 64 + lane) * 4) = hp[c] - hn[c]; st_rm(IMG(3), yp[c] - yn[c], w.tr, w.tc0 + c, w); }
            img_to_global(IMG(1), M1G + (size_t)cidx * 4096, tid);
            img_to_global(IMG(0), QCT + (size_t)cidx * 4096, tid);
        }
        LDS_BARRIER();
        img_to_global(IMG(3), YLG + (size_t)cidx * 4096, tid);
    }
}

constexpr int P2_SLOT = 12544, P2_DEPTH = 5;
__device__ __forceinline__ void rwkv_pass2(LAS unsigned char* lds, int bh, int ti, int lane, const bf16* QCT, const float* HCT, const float* DLG, bf16* S0G) {
    const int l15 = lane & 15, q = lane >> 4;
    f32x4 X[4];
#pragma unroll
    for (int tj = 0; tj < 4; ++tj) X[tj] = Z4;
#define P2_DMA(cc) do { const size_t ci_ = (size_t)bh * 128 + (cc); LAS unsigned char* sl_ = lds + ((cc) % P2_DEPTH) * P2_SLOT; \
        _Pragma("unroll") for (int i = 0; i < 8; ++i) { const int row_ = i * 8 + (lane >> 3), pc_ = (lane & 7) ^ (row_ & 7); \
            __builtin_amdgcn_global_load_lds((const unsigned*)((const char*)QCT + (ci_ * 64 + row_) * 128 + pc_ * 16), (LAS unsigned*)(sl_ + i * 1024), 16, 0, 0); } \
        _Pragma("unroll") for (int tj = 0; tj < 4; ++tj) __builtin_amdgcn_global_load_lds((const unsigned*)((const char*)HCT + ((ci_ * 16 + tj * 4 + ti) * 64 + lane) * 16), (LAS unsigned*)(sl_ + 8192 + tj * 1024), 16, 0, 0); \
        __builtin_amdgcn_global_load_lds((const unsigned*)((const char*)DLG + (ci_ * 64 + lane) * 4), (LAS unsigned*)(sl_ + 12288), 4, 0, 0); } while (0)
    P2_DMA(0); P2_DMA(1); P2_DMA(2); P2_DMA(3);
    for (int c = 0; c < 128; ++c) {
        if (c < 124) asm volatile("s_waitcnt vmcnt(39)" ::: "memory"); else asm volatile("s_waitcnt vmcnt(0)" ::: "memory");
        const LAS unsigned char* sl = lds + (c % P2_DEPTH) * P2_SLOT;
        bf16x8 a[4][2]; f32x4 h[4], d[4];
#pragma unroll
        for (int tj = 0; tj < 4; ++tj) { const int row = 16 * tj + l15;
#pragma unroll
            for (int s = 0; s < 2; ++s) a[tj][s] = *(const LAS bf16x8*)(sl + row * 128 + (((4 * s + q) ^ (row & 7)) * 16));
            h[tj] = *(const LAS f32x4*)(sl + 8192 + tj * 1024 + lane * 16); d[tj] = *(const LAS f32x4*)(sl + 12288 + (16 * tj + 4 * q) * 4); }
        asm volatile("s_waitcnt lgkmcnt(0)" ::: "memory");
        if (c + 4 < 128) P2_DMA(c + 4);
        const size_t cidx = (size_t)bh * 128 + c;
#pragma unroll
        for (int tj = 0; tj < 4; ++tj) { u32x2 o; o.x = pk2(X[tj][0], X[tj][1]); o.y = pk2(X[tj][2], X[tj][3]); *(u32x2*)(S0G + (cidx * 64 + 16 * ti + l15) * 64 + 16 * tj + 4 * q) = o; }
        bf16x8 b[2];
#pragma unroll
        for (int s = 0; s < 2; ++s) { u32x4 o; o.x = pk2(X[2 * s][0], X[2 * s][1]); o.y = pk2(X[2 * s][2], X[2 * s][3]); o.z = pk2(X[2 * s + 1][0], X[2 * s + 1][1]); o.w = pk2(X[2 * s + 1][2], X[2 * s + 1][3]); b[s] = __builtin_bit_cast(bf16x8, o); }
#pragma unroll
        for (int tj = 0; tj < 4; ++tj) { f32x4 acc = Z4;
            acc = __builtin_amdgcn_mfma_f32_16x16x32_bf16(a[tj][0], b[0], acc, 0, 0, 0); acc = __builtin_amdgcn_mfma_f32_16x16x32_bf16(a[tj][1], b[1], acc, 0, 0, 0);
            X[tj] = d[tj] * X[tj] + h[tj] - acc; }
    }
    asm volatile("s_waitcnt vmcnt(0)" ::: "memory");
#undef P2_DMA
}

__device__ __forceinline__ void rwkv_pass3(LAS unsigned char* lds, const RwkvP& P, int c0, int n, int tid, const bf16* S0G, const bf16* M1G, const bf16* YLG, const float* BONUS, bf16* MIX) {
    const int lane = tid & 63, wv = __builtin_amdgcn_readfirstlane(tid >> 6); MmCtx w; w.tr = wv >> 1; w.tc0 = (wv & 1) * 2; w.l15 = lane & 15; w.q = lane >> 4;
    const int t = tid >> 3, cg = tid & 7, bh = c0 >> 7, b = bh >> 3, h = bh & 7, ch = h * 64 + 8 * cg;
    float muv[8], lnw[8], lnb[8]; ldp8(P.mu_rkv + 1024 + ch, muv); ldp8(P.ln_w + ch, lnw); ldp8(P.ln_b + ch, lnb);
    u32x4 gS0, gM1, gYL, gvc, gvp, ggg; float gbo;
#define P3_LOAD(cc) do { const int cidx_ = (cc), c_ = cidx_ & 127; const size_t o_ = (size_t)cidx_ * 4096 + (tid >> 3) * 64 + (tid & 7) * 8; gS0 = *(const u32x4*)(S0G + o_); gM1 = *(const u32x4*)(M1G + o_); gYL = *(const u32x4*)(YLG + o_); \
        const size_t tok_ = (size_t)b * SEQ + c_ * 64 + t; const bool first_ = (c_ == 0 && t == 0); const bf16* row_ = P.rkv + tok_ * 1536 + 1024 + ch; \
        gvc = *(const u32x4*)row_; gvp = *(const u32x4*)(first_ ? row_ : row_ - 1536); ggg = *(const u32x4*)(P.wag + tok_ * 1536 + 1024 + ch); gbo = BONUS[(size_t)cidx_ * 64 + t]; } while (0)
    P3_LOAD(c0);
    for (int ci = 0; ci < n; ++ci) {
        const int cidx = c0 + ci, c = cidx & 127;
        float vv[8], gg[8]; const float bonus = gbo;
        { float vc[8], vp[8]; unpack8(gvc, vc); unpack8(gvp, vp); unpack8(ggg, gg); const float pm = (c == 0 && t == 0) ? 0.f : 1.f;
#pragma unroll
          for (int i = 0; i < 8; ++i) vv[i] = vc[i] + (pm * vp[i] - vc[i]) * muv[i];
          const int row = tid >> 3, chk = tid & 7; *(LAS u32x4*)(IMG(0) + row * IMG_LD + chk * 8) = gM1; *(LAS u32x4*)(IMG(1) + row * IMG_LD + chk * 8) = gS0; *(LAS u32x4*)(IMG(2) + row * IMG_LD + chk * 8) = gYL; }
        if (ci + 1 < n) P3_LOAD(cidx + 1);
        LDS_BARRIER();
        {
            f32x4 y[2] = {Z4, Z4};
            mm64(IMG(0), IMG(1), y, w);
            LAS float* YF = (LAS float*)(lds + 10 * IMG_B);
#pragma unroll
            for (int cc = 0; cc < 2; ++cc)
#pragma unroll
                for (int r = 0; r < 4; ++r) { const int m = 16 * w.tr + 4 * w.q + r, nn = 16 * (w.tc0 + cc) + w.l15; YF[m * 65 + nn] = y[cc][r] + bf2f(IMG(2)[m * IMG_LD + nn]); }
        }
        LDS_BARRIER();
        {
            const LAS float* YF = (const LAS float*)(lds + 10 * IMG_B);
            float y[8], s = 0.f;
#pragma unroll
            for (int i = 0; i < 8; ++i) { y[i] = YF[t * 65 + 8 * cg + i]; s += y[i]; }
            const float mean = red8(s) * (1.0f / 64.0f); float qv = 0.f;
#pragma unroll
            for (int i = 0; i < 8; ++i) { y[i] -= mean; qv += y[i] * y[i]; }
            const float rstd = rsqrtf(red8(qv) * (1.0f / 64.0f) + 64e-5f);
            float o[8];
#pragma unroll
            for (int i = 0; i < 8; ++i) o[i] = (y[i] * rstd * lnw[i] + lnb[i] + bonus * vv[i]) * gg[i];
            const size_t tok = (size_t)b * SEQ + c * 64 + t;
            u32x4 ov; ov.x = pk2(o[0], o[1]); ov.y = pk2(o[2], o[3]); ov.z = pk2(o[4], o[5]); ov.w = pk2(o[6], o[7]);
            *(u32x4*)(MIX + tok * 1024 + 512 + ch) = ov;
        }
        LDS_BARRIER();
    }
#undef P3_LOAD
}

constexpr int RW_LD = 1032;
__device__ __forceinline__ void router_phase(const Ctx& cx, const bf16* X1, const float* gnorm, const float* rw, const float* rb, unsigned char* H2, int* TOPE, float* TOPG, unsigned* HIST) {
    LAS bf16* WH = (LAS bf16*)cx.lds; LAS bf16* WL = WH + 32 * RW_LD;
    LAS unsigned* hcnt = (LAS unsigned*)(cx.lds + 135168);
    const int lane = cx.lane, l15 = lane & 15, q = lane >> 4;
    for (int idx = cx.tid; idx < 32768; idx += NTHR) { const int col = idx >> 5, e = idx & 31; const float v = rw[idx] * gnorm[col];
        const unsigned h = cvt_pk_bf16(v, 0.f) & 0xffffu; const float lo = v - bf2f(h); WH[e * RW_LD + col] = (bf16)h; WL[e * RW_LD + col] = (bf16)(cvt_pk_bf16(lo, 0.f) & 0xffffu); }
    const float b0 = rb[l15], b1 = rb[l15 + 16];
    for (int tb = cx.wg; tb < 256; tb += cx.G) {
        if (cx.tid < 32) hcnt[cx.tid] = 0u;
        __syncthreads();
        const int tok0 = tb * 128 + cx.wave * 16;
        const bf16* xrow = X1 + (size_t)(tok0 + l15) * 1024 + 8 * q;
        f32x4 acc[2] = {(f32x4){0.f, 0.f, 0.f, 0.f}, (f32x4){0.f, 0.f, 0.f, 0.f}}; float ss = 0.f;
#pragma unroll 8
        for (int s = 0; s < 32; ++s) {
            const u32x4 xw = *(const u32x4*)(xrow + 32 * s);
            { const float a0 = lo16(xw.x), a1 = hi16(xw.x), a2 = lo16(xw.y), a3 = hi16(xw.y), a4 = lo16(xw.z), a5 = hi16(xw.z), a6 = lo16(xw.w), a7 = hi16(xw.w);
              ss += (a0 * a0 + a1 * a1) + (a2 * a2 + a3 * a3) + (a4 * a4 + a5 * a5) + (a6 * a6 + a7 * a7); }
            const bf16x8 ah = __builtin_bit_cast(bf16x8, xw);
#pragma unroll
            for (int n = 0; n < 2; ++n) { const bf16x8 bh = *(const LAS bf16x8*)(WH + (l15 + 16 * n) * RW_LD + 32 * s + 8 * q), bl = *(const LAS bf16x8*)(WL + (l15 + 16 * n) * RW_LD + 32 * s + 8 * q);
                acc[n] = __builtin_amdgcn_mfma_f32_16x16x32_bf16(ah, bh, acc[n], 0, 0, 0); acc[n] = __builtin_amdgcn_mfma_f32_16x16x32_bf16(ah, bl, acc[n], 0, 0, 0); }
        }
        ss += __shfl_xor(ss, 16); ss += __shfl_xor(ss, 32);
        const float rinv_l = rsqrtf(ss * (1.f / 1024.f) + 1e-6f);
#pragma unroll
        for (int r = 0; r < 4; ++r) {
            const float ri = __shfl(rinv_l, 4 * q + r);
            float v0 = acc[0][r] * ri + b0, v1 = acc[1][r] * ri + b1; int se[4]; float sv[4];
#pragma unroll
            for (int k = 0; k < 4; ++k) { float bv = (v1 > v0) ? v1 : v0; int be = (v1 > v0) ? (l15 + 16) : l15;
#pragma unroll
                for (int off = 1; off < 16; off <<= 1) { const float ov = __shfl_xor(bv, off); const int oe = __shfl_xor(be, off); const bool take = (ov > bv) || (ov == bv && oe < be); bv = take ? ov : bv; be = take ? oe : be; }
                se[k] = be; sv[k] = bv; if (be == l15) v0 = -INFINITY; if (be == l15 + 16) v1 = -INFINITY; }
            if (l15 == r) { const int tok = tok0 + 4 * q + r;
                const float w1 = __expf(sv[1] - sv[0]), w2 = __expf(sv[2] - sv[0]), w3 = __expf(sv[3] - sv[0]); const float inv = 1.0f / (1.0f + w1 + w2 + w3);
                *(int4*)(TOPE + (size_t)tok * 4) = make_int4(se[0], se[1], se[2], se[3]);
                *(float4*)(TOPG + (size_t)tok * 4) = make_float4(inv, w1 * inv, w2 * inv, w3 * inv);
                atomicAdd((unsigned*)(hcnt + se[0]), 1u); atomicAdd((unsigned*)(hcnt + se[1]), 1u); atomicAdd((unsigned*)(hcnt + se[2]), 1u); atomicAdd((unsigned*)(hcnt + se[3]), 1u); }
        }
        const f32x4* gr = (const f32x4*)gnorm + lane;
#pragma unroll 4
        for (int i = 0; i < 16; ++i) { const float ri = __shfl(rinv_l, i); const u32x2* xr = (const u32x2*)(X1 + (size_t)(tok0 + i) * 1024) + lane; unsigned* o4 = (unsigned*)(H2 + (size_t)(tok0 + i) * 1024) + lane;
#pragma unroll
            for (int j = 0; j < 4; ++j) { const u32x2 v = xr[64 * j]; const f32x4 gg = gr[64 * j]; o4[64 * j] = pk4_fp8(lo16(v.x) * ri * gg.x, hi16(v.x) * ri * gg.y, lo16(v.y) * ri * gg.z, hi16(v.y) * ri * gg.w); } }
        __syncthreads();
        if (cx.tid < 32) HIST[tb * 32 + cx.tid] = hcnt[cx.tid];
        __syncthreads();
    }
}

constexpr int PL_BASE = 1280, PL_WCNT = 1312;
__device__ __forceinline__ void moe_plan(const Ctx& cx, const unsigned* HIST) {
    LAS int* PL = (LAS int*)(cx.lds + LDS_PLAN);
    const int e = cx.tid & 31, part = cx.tid >> 5;
    { int s = 0; for (int w = 16 * part; w < 16 * part + 16; ++w) s += (int)HIST[w * 32 + e]; PL[PL_TMP + part * 32 + e] = s; }
    __syncthreads();
    if (cx.tid < 32) { int c = 0; for (int p = 0; p < 16; ++p) c += PL[PL_TMP + p * 32 + cx.tid]; PL[PL_CNT + cx.tid] = c; }
    __syncthreads();
    if (cx.tid == 0) {
        int ps = 0;
        for (int x = 0; x < 32; ++x) { PL[PL_PSTART + x] = ps; const int pad = (PL[PL_CNT + x] + 255) & ~255; for (int i = 0; i < pad / 256; ++i) PL[PL_TILEE + ps / 256 + i] = x; ps += pad; }
        PL[PL_PSTART + 32] = ps;
        int np = 0, e0 = 0;
        while (e0 < 32 && np < 7) { PL[PL_PE0 + np] = e0; PL[PL_PROW0 + np] = PL[PL_PSTART + e0]; int rows = 0, e1 = e0;
            while (e1 < 32 && e1 - e0 < MAXEPP) { const int pad = PL[PL_PSTART + e1 + 1] - PL[PL_PSTART + e1]; if (rows + pad > RMAX && e1 > e0) break; rows += pad; ++e1; }
            e0 = e1; ++np; }
        PL[PL_PE0 + np] = 32; PL[PL_PROW0 + np] = ps; PL[PL_NPASS] = np;
    }
    __syncthreads();
}
__device__ __forceinline__ void dispatch_phase(const Ctx& cx, const unsigned* HIST, const int* TOPE, int* SLOTTOK, int* TOKSLOT) {
    LAS int* PL = (LAS int*)(cx.lds + LDS_PLAN);
    const int e5 = cx.tid & 31, part = cx.tid >> 5, lane = cx.lane;
    for (int tb = cx.wg; tb < 256; tb += cx.G) {
        { int s = 0; for (int w = 16 * part; w < 16 * part + 16; ++w) s += (w < tb) ? (int)HIST[w * 32 + e5] : 0; PL[PL_TMP + part * 32 + e5] = s; }
        const int tok = tb * 128 + (cx.tid >> 2), k = cx.tid & 3; const int e = TOPE[(size_t)tok * 4 + k];
        int rank = 0;
        for (int ee = 0; ee < 32; ++ee) { const unsigned long long mask = __ballot(e == ee); if (e == ee) rank = __popcll(mask & ((1ull << lane) - 1ull)); if (lane == 0) PL[PL_WCNT + cx.wave * 32 + ee] = __popcll(mask); }
        __syncthreads();
        if (cx.tid < 32) { int c = 0; for (int p = 0; p < 16; ++p) c += PL[PL_TMP + p * 32 + cx.tid]; PL[PL_BASE + cx.tid] = c; }
        __syncthreads();
        int off = 0; for (int w2 = 0; w2 < 8; ++w2) off += (w2 < cx.wave) ? PL[PL_WCNT + w2 * 32 + e] : 0;
        const int slot = PL[PL_PSTART + e] + PL[PL_BASE + e] + off + rank;
        SLOTTOK[slot] = tok; TOKSLOT[(size_t)tok * 4 + k] = slot;
        __syncthreads();
    }
    for (int e = cx.wg; e < 32; e += cx.G) { const int c = PL[PL_CNT + e], ps = PL[PL_PSTART + e], pe = PL[PL_PSTART + e + 1]; for (int r = ps + c + cx.tid; r < pe; r += NTHR) SLOTTOK[r] = 0; }
}
__device__ __forceinline__ void convert_pass(const Ctx& cx, int e0, int e1, const float* wg, const float* wu, const float* wd, unsigned char* WGU, unsigned char* WDN) {
    LAS float* scr = (LAS float*)(cx.lds + cx.wave * 16640);
    const int nitems = (e1 - e0) * 768;
#define CV_SRC(it_) ((((it_) % 768) >> 8) == 2 ? wd : ((((it_) % 768) >> 8) ? wu : wg)) + (size_t)(e0 + (it_) / 768) * 1048576
    int it = cx.gw; if (it >= nitems) return;
    F8Item cur; f8_issue(CV_SRC(it), 1024, 64 * (((it % 768) & 255) >> 4), 64 * ((it % 768) & 15), cx.lane, cur);
    for (;;) {
        const int nx = it + cx.NGW; const bool has = nx < nitems;
        F8Item nxt;
        if (has) f8_issue(CV_SRC(nx), 1024, 64 * (((nx % 768) & 255) >> 4), 64 * ((nx % 768) & 15), cx.lane, nxt);
        const int le = it / 768, r = it % 768, mat = r >> 8, kb = (r & 255) >> 4, nb = r & 15, n0 = 64 * nb;
        if (mat == 2) f8_finish(cur, WDN + (size_t)le * 1048576 + (size_t)n0 * 1024 + 64 * kb, 1024, 32.0f, scr, cx.lane);
        else { const int drow = (n0 >> 7) * 256 + (n0 & 127) + mat * 128; f8_finish(cur, WGU + (size_t)le * 2097152 + (size_t)drow * 1024 + 64 * kb, 1024, 32.0f, scr, cx.lane); }
        if (!has) break;
        it = nx;
#pragma unroll
        for (int i = 0; i < 16; ++i) cur.v[i] = nxt.v[i];
    }
#undef CV_SRC
}
__device__ __forceinline__ void combine_all(const Ctx& cx, const float* TOPG, const int* TOKSLOT, const unsigned char* Y, bf16* X, const float* gnorm, unsigned char* H3) {
    const int lane = cx.lane, step = cx.NGW;
    int tok = cx.gw; if (tok >= M) return;
    int4 sl = *(const int4*)(TOKSLOT + (size_t)tok * 4); float4 gs = *(const float4*)(TOPG + (size_t)tok * 4);
    u32x2 xw[4]; unsigned yw[4][4];
#define CMB_ISSUE(T, SL, XW, YW) do { const u32x2* xr_ = (const u32x2*)(X + (size_t)(T) * 1024) + lane; const int s_[4] = {SL.x, SL.y, SL.z, SL.w}; \
        _Pragma("unroll") for (int j = 0; j < 4; ++j) XW[j] = xr_[64 * j]; \
        _Pragma("unroll") for (int k = 0; k < 4; ++k) { const unsigned* yr_ = (const unsigned*)(Y + (size_t)s_[k] * 1024) + lane; _Pragma("unroll") for (int j = 0; j < 4; ++j) YW[k][j] = yr_[64 * j]; } } while (0)
    CMB_ISSUE(tok, sl, xw, yw);
    int4 sl1 = sl; float4 gs1 = gs; { const int t1 = tok + step; if (t1 < M) { sl1 = *(const int4*)(TOKSLOT + (size_t)t1 * 4); gs1 = *(const float4*)(TOPG + (size_t)t1 * 4); } }
    const f32x4* gr = (const f32x4*)gnorm + lane;
    for (;;) {
        const int t1 = tok + step, t2 = tok + 2 * step; const bool has1 = t1 < M;
        u32x2 nxw[4]; unsigned nyw[4][4];
        if (has1) CMB_ISSUE(t1, sl1, nxw, nyw);
        int4 sl2 = sl1; float4 gs2 = gs1; if (t2 < M) { sl2 = *(const int4*)(TOKSLOT + (size_t)t2 * 4); gs2 = *(const float4*)(TOPG + (size_t)t2 * 4); }
        f32x4 v[4]; const float gk[4] = {gs.x, gs.y, gs.z, gs.w};
#pragma unroll
        for (int j = 0; j < 4; ++j) v[j] = (f32x4){lo16(xw[j].x), hi16(xw[j].x), lo16(xw[j].y), hi16(xw[j].y)};
#pragma unroll
        for (int k = 0; k < 4; ++k)
#pragma unroll
            for (int j = 0; j < 4; ++j) v[j] += up4_fp8(yw[k][j]) * gk[k];
        u32x2* xo = (u32x2*)(X + (size_t)tok * 1024) + lane; float s = 0.f;
#pragma unroll
        for (int j = 0; j < 4; ++j) { u32x2 w; w.x = pk2(v[j].x, v[j].y); w.y = pk2(v[j].z, v[j].w); xo[64 * j] = w; s += (v[j].x * v[j].x + v[j].y * v[j].y) + (v[j].z * v[j].z + v[j].w * v[j].w); }
        const float rinv = rsqrtf(wave_sum(s) * (1.f / 1024.f) + 1e-6f); unsigned* o8 = (unsigned*)(H3 + (size_t)tok * 1024) + lane;
#pragma unroll
        for (int j = 0; j < 4; ++j) { const f32x4 gq = gr[64 * j]; o8[64 * j] = pk4_fp8(v[j].x * rinv * gq.x, v[j].y * rinv * gq.y, v[j].z * rinv * gq.z, v[j].w * rinv * gq.w); }
        if (!has1) break;
        tok = t1; gs = gs1; sl1 = sl2; gs1 = gs2;
#pragma unroll
        for (int j = 0; j < 4; ++j) { xw[j] = nxw[j];
#pragma unroll
            for (int k = 0; k < 4; ++k) yw[k][j] = nyw[k][j]; }
    }
#undef CMB_ISSUE
}
template <bool LAST>
__device__ __forceinline__ void combine_pass(const Ctx& cx, int e0, int e1, int row0, const int* TOPE, const float* TOPG, const int* TOKSLOT, const unsigned char* Y, bf16* X, const float* gnorm, unsigned char* H3) {
    for (int tok = cx.gw; tok < M; tok += cx.NGW) {
        const int4 es = *(const int4*)(TOPE + (size_t)tok * 4); const float4 gs = *(const float4*)(TOPG + (size_t)tok * 4); const int4 sl = *(const int4*)(TOKSLOT + (size_t)tok * 4);
        const int ee[4] = {es.x, es.y, es.z, es.w}; const float gg[4] = {gs.x, gs.y, gs.z, gs.w}; const int ss[4] = {sl.x, sl.y, sl.z, sl.w};
        bool any = false;
#pragma unroll
        for (int k = 0; k < 4; ++k) any |= (ee[k] >= e0 && ee[k] < e1);
        if (!LAST && !any) continue;
        u32x2* xr = (u32x2*)(X + (size_t)tok * 1024) + cx.lane; f32x4 v[4];
#pragma unroll
        for (int j = 0; j < 4; ++j) { const u32x2 w = xr[64 * j]; v[j] = (f32x4){lo16(w.x), hi16(w.x), lo16(w.y), hi16(w.y)}; }
#pragma unroll
        for (int k = 0; k < 4; ++k) if (ee[k] >= e0 && ee[k] < e1) { const unsigned* yr = (const unsigned*)(Y + (size_t)(ss[k] - row0) * 1024) + cx.lane; const float g = gg[k];
#pragma unroll
            for (int j = 0; j < 4; ++j) v[j] += up4_fp8(yr[64 * j]) * g; }
        if (any) {
#pragma unroll
            for (int j = 0; j < 4; ++j) { u32x2 w; w.x = pk2(v[j].x, v[j].y); w.y = pk2(v[j].z, v[j].w); xr[64 * j] = w; }
        }
        if (LAST) { float s = 0.f;
#pragma unroll
            for (int j = 0; j < 4; ++j) s += (v[j].x * v[j].x + v[j].y * v[j].y) + (v[j].z * v[j].z + v[j].w * v[j].w);
            const float rinv = rsqrtf(wave_sum(s) * (1.f / 1024.f) + 1e-6f); const f32x4* gr = (const f32x4*)gnorm + cx.lane; unsigned* o8 = (unsigned*)(H3 + (size_t)tok * 1024) + cx.lane;
#pragma unroll
            for (int j = 0; j < 4; ++j) { const f32x4 gq = gr[64 * j]; o8[64 * j] = pk4_fp8(v[j].x * rinv * gq.x, v[j].y * rinv * gq.y, v[j].z * rinv * gq.z, v[j].w * rinv * gq.w); } }
    }
}

#define HBUF ((bf16*)(ws + WS_R1))
#define RKV ((bf16*)(ws + WS_RKV))
#define WAG ((bf16*)(ws + WS_WAG))
#define AG ((bf16*)(ws + WS_AG))
#define UB ((bf16*)(ws + WS_U))
#define LP ((bf16*)(ws + WS_LP))
#define LACT ((bf16*)(ws + WS_LACT))
#define Y1 ((bf16*)(ws + WS_Y1))
#define MIX ((bf16*)(ws + WS_R1))
#define EBUF ((float*)(ws + WS_LP))
#define S0G ((bf16*)(ws + WS_LP))
#define QCT ((bf16*)(ws + WS_U))
#define HCT ((float*)(ws + WS_R1))
#define W1G ((bf16*)(ws + WS_W1))
#define ULG ((bf16*)(ws + WS_ULOC))
#define DLG ((float*)(ws + WS_DL))
#define ATG ((float*)(ws + WS_AT))
#define WCAT ((bf16*)(ws + WS_WCAT))
#define WL2 ((bf16*)(ws + WS_WL2))
#define WGLU ((bf16*)(ws + WS_WGLU))
#define WPP ((bf16*)(ws + WS_WPP))
#define WOUT ((bf16*)(ws + WS_WOUT))
#define WPG ((unsigned char*)(ws + WS_WPG))
#define S5BT ((bf16*)(ws + WS_S5BT))
#define S5ET ((bf16*)(ws + WS_S5ET))
#define PBF ((bf16*)(ws + WS_PBF))
#define H2 ((unsigned char*)(ws + WS_H2))
#define WGU ((unsigned char*)(ws + WS_WGU))
#define WDN ((unsigned char*)(ws + WS_WDN))
#define ACT ((unsigned char*)(ws + WS_ACT))
#define YB ((unsigned char*)(ws + WS_Y))
#define XB ((bf16*)(ws + WS_XB))
#define PP ((bf16*)(ws + WS_ACT))
#define HIST ((unsigned*)(ws + WS_HIST))
#define TOPE ((int*)(ws + WS_TOPE))
#define TOPG ((float*)(ws + WS_TOPG))
#define TOKSLOT ((int*)(ws + WS_TOKSLOT))
#define SLOTTOK ((int*)(ws + WS_SLOTTOK))
#ifndef FUSE_FNORM
#define FUSE_FNORM 1
#endif
#ifndef SPLIT_P5
#define SPLIT_P5 1
#endif
#ifndef MOE_SP2
#define MOE_SP2 true
#endif
#ifndef MOE_ALIGN
#define MOE_ALIGN true
#endif
#ifndef PROBE_PH
#define PROBE_PH -1
#endif
#ifndef PROBE_N
#define PROBE_N 2
#endif
#define REPS(k) ((((k) >= 10 && (k) < 28) ? 10 + ((k) - 10) % 3 : (k)) == PROBE_PH ? PROBE_N : 1)
#ifndef ONLY_PHASE
#define ONLY_PHASE -1
#endif
constexpr int NPH = 31;
struct Args { const float* in[42]; float* out; unsigned char* ws; int ph_lo, ph_hi; };

__global__ void __launch_bounds__(NTHR, 2) mk_fwd(Args args) {
    extern __shared__ __attribute__((aligned(16))) unsigned char lds_raw[];
    LAS unsigned char* lds = (LAS unsigned char*)lds_raw;
#define CAS __attribute__((address_space(4)))
#define FRESH_CX const CAS char* ka_ = (const CAS char*)__builtin_amdgcn_kernarg_segment_ptr(); asm volatile("" : "+s"(ka_)); const float* const CAS* I = (const float* const CAS*)ka_; unsigned char* ws = *(unsigned char* const CAS*)(ka_ + 344); float* OUTP = *(float* const CAS*)(ka_ + 336); (void)I; (void)ws; (void)OUTP; \
    Ctx cx; { int t_ = wv0_ * 64 + (int)__builtin_amdgcn_mbcnt_hi(~0u, __builtin_amdgcn_mbcnt_lo(~0u, 0u)); asm volatile("" : "+v"(t_)); cx.lds = lds; cx.tid = t_; cx.lane = t_ & 63; cx.wave = __builtin_amdgcn_readfirstlane(t_ >> 6); cx.G = gridDim.x; cx.wg = blockIdx.x; cx.gw = cx.wg * NWAVES + cx.wave; cx.NGW = cx.G * NWAVES; }
    unsigned char* ws = args.ws;
    const int lo = args.ph_lo, hi = args.ph_hi;
    volatile LAS unsigned* MISC = (volatile LAS unsigned*)(lds + LDS_MISC);
    const int wv0_ = __builtin_amdgcn_readfirstlane((int)threadIdx.x >> 6);
    if (wv0_ == 0) MISC[__builtin_amdgcn_mbcnt_hi(~0u, __builtin_amdgcn_mbcnt_lo(~0u, 0u))] = 0u;
    __syncthreads();
    XcdBarrier bar; bar.bar = (unsigned*)(ws + WS_CTL) + CW_BAR; bar.x = 0; bar.st = nullptr; bar.wv = wv0_;
    if (hi - lo > 1) bar = xcd_barrier_post((unsigned*)(ws + WS_CTL) + CW_BAR, MISC + 8, wv0_);

#define IN(k) ((ONLY_PHASE < 0 || ONLY_PHASE == (k) || (ONLY_PHASE >= 10 && ONLY_PHASE < 28 && (k) >= 10 && (k) < 28 && ((k) - 10) % 3 == (ONLY_PHASE - 10) % 3)) && lo <= (k) && (k) < hi)
#ifndef PROBE_BAR
#define PROBE_BAR 1
#endif
#ifndef PROBE_T
#define PROBE_T -1
#endif
#define STAMP() do { if (PROBE_T >= 0 && blockIdx.x == 0 && xb_first(wv0_)) { const unsigned long long t_ = __builtin_amdgcn_s_memrealtime(); MISC[16 + 2 * nst] = (unsigned)t_; MISC[17 + 2 * nst] = (unsigned)(t_ >> 32); } ++nst; } while (0)
#define SEAM(k) do { if (IN(k) && IN((k) + 1)) { for (int b_ = 0; b_ < PROBE_BAR; ++b_) xcd_barrier(bar); STAMP(); } } while (0)
    int nst = 0; STAMP();
#define MAKE_RP RwkvP RP; RP.rkv = RKV; RP.wag = WAG; RP.mu_rkv = I[13]; RP.w0 = I[15]; RP.a0 = I[18]; RP.k_k = I[23]; RP.k_a = I[24]; RP.r_k = I[25]; RP.ln_w = I[26]; RP.ln_b = I[27]
#define OPQ(v) ({ int _k = (v); asm volatile("" : "+s"(_k)); _k; })

    if (IN(0)) for (int rep_ = 0; rep_ < REPS(0); ++rep_) {
        FRESH_CX;
        for (int it = cx.wg; it < 256; it += cx.G) s5_tables_item(cx, it >> 3, it & 7, I[4], I[5], I[6], I[7], I[8], I[9], I[10], S5BT, S5ET, ATG);
        const float* mu = I[14];
        transpose_matrix(cx, I[3], 1024, 2048, WCAT, 0, 1024, 0, nullptr, 0);
        transpose_matrix(cx, I[16], 1024, 64, WCAT, 2048, 1024, 0, mu, 1);          transpose_matrix(cx, I[16], 1024, 64, WCAT, 2304, 1024, 0, mu, 0);
        transpose_matrix(cx, I[19], 1024, 64, WCAT, 2112, 1024, 0, mu + 1024, 1);   transpose_matrix(cx, I[19], 1024, 64, WCAT, 2368, 1024, 0, mu + 1024, 0);
        transpose_matrix(cx, I[21], 1024, 128, WCAT, 2176, 1024, 0, mu + 2048, 1);  transpose_matrix(cx, I[21], 1024, 128, WCAT, 2432, 1024, 0, mu + 2048, 0);
        transpose_matrix(cx, I[17], 64, 512, WL2, 0, 256, 0, nullptr, 0);
        transpose_matrix(cx, I[20], 64, 512, WL2, 512, 256, 64, nullptr, 0);
        transpose_matrix(cx, I[22], 128, 512, WL2, 1024, 256, 128, nullptr, 0);
        for (int idx = cx.wg * NTHR + cx.tid; idx < 1536 * 32; idx += cx.G * NTHR) { const int row = idx >> 5, ch = idx & 31, blk = row >> 9; const int kb = blk == 0 ? 0 : (blk == 1 ? 64 : 128), ke = blk == 0 ? 64 : (blk == 1 ? 128 : 256);
            if (ch * 8 < kb || ch * 8 >= ke) *(u32x4*)(WL2 + (size_t)row * 256 + ch * 8) = (u32x4){0u, 0u, 0u, 0u}; }
        transpose_matrix(cx, I[12], 512, 512, WGLU, 0, 512, 0, nullptr, 0);
        transpose_matrix(cx, I[39], 256, 1024, WPP, 0, 256, 0, nullptr, 0);
        transpose_matrix(cx, I[28], 1024, 1024, WOUT, 0, 1024, 0, nullptr, 0);
        { LAS float* scr = (LAS float*)(cx.lds + cx.wave * 16640);
          for (int it = cx.gw; it < 256; it += cx.NGW) { const int kb = it >> 4, nb = it & 15;
              transpose_item_fp8(I[40], 1024, 64 * kb, 64 * nb, WPG + (size_t)(64 * nb) * 1024 + 64 * kb, 1024, 32.0f, scr, cx.lane); } }
        for (int m = 2 * cx.gw; m < M; m += 2 * cx.NGW) rms_rows2_to_bf16(I[0] + (size_t)m * 1024, I[0] + (size_t)(m + 1) * 1024, I[2], HBUF + (size_t)m * 1024, HBUF + (size_t)(m + 1) * 1024, cx.lane);
        for (int m = 4 * cx.gw; m < M; m += 4 * cx.NGW) { f32x4 v[4];
#pragma unroll
            for (int r = 0; r < 4; ++r) v[r] = __builtin_nontemporal_load((const f32x4*)(I[1] + (size_t)(m + r) * 256) + cx.lane);
#pragma unroll
            for (int r = 0; r < 4; ++r) { u32x2 w; w.x = pk2(v[r].x, v[r].y); w.y = pk2(v[r].z, v[r].w); *((u32x2*)(PBF + (size_t)(m + r) * 256) + cx.lane) = w; } }
    }
    SEAM(0);
    if (IN(1)) for (int rep_ = 0; rep_ < REPS(1); ++rep_) {
        FRESH_CX;
        SchedPlain S; S.init(128, 10, cx.G, cx.wg); S.A = (const char*)HBUF; S.B = (const char*)WCAT; S.a_tile = 256 * 1024 * 2; S.b_tile = 256 * 1024 * 2;
        EpiProj E{AG, RKV, LP};
        pg8::gemm_phase<EpiProj, SchedPlain, true, true, false>(lds, cx.tid, OPQ(1024), OPQ(1024), OPQ(1024), S, E);
    }
    SEAM(1);
    if (IN(2)) for (int rep_ = 0; rep_ < REPS(2); ++rep_) {
        FRESH_CX;
        for (int m = 2 * cx.gw; m < M; m += 2 * cx.NGW) {
            const int lane = cx.lane; const bool first = (m & (SEQ - 1)) == 0;
            const u32x2 a0 = *((const u32x2*)(LP + (size_t)m * 512) + lane), a1 = *((const u32x2*)(LP + (size_t)(m + 1) * 512) + lane), b1 = *((const u32x2*)(LP + (size_t)m * 512 + 256) + lane);
            u32x2 b0 = (u32x2){0u, 0u}; if (!first) b0 = *((const u32x2*)(LP + (size_t)(m - 1) * 512 + 256) + lane);
            float v[8] = {lo16(a0.x) + lo16(b0.x), hi16(a0.x) + hi16(b0.x), lo16(a0.y) + lo16(b0.y), hi16(a0.y) + hi16(b0.y), lo16(a1.x) + lo16(b1.x), hi16(a1.x) + hi16(b1.x), lo16(a1.y) + lo16(b1.y), hi16(a1.y) + hi16(b1.y)};
#pragma unroll
            for (int i = 0; i < 8; ++i) v[i] = lane < 16 ? ftanh(v[i]) : (lane < 32 ? v[i] : fsigmoid(v[i]));
            u32x2 o; o.x = pk2(v[0], v[1]); o.y = pk2(v[2], v[3]); *((u32x2*)(LACT + (size_t)m * 256) + lane) = o;
            o.x = pk2(v[4], v[5]); o.y = pk2(v[6], v[7]); *((u32x2*)(LACT + (size_t)(m + 1) * 256) + lane) = o;
        }
    }
    SEAM(2);
    if (IN(3)) for (int rep_ = 0; rep_ < REPS(3); ++rep_) {
        FRESH_CX;
        { SchedPlain S; S.init(128, 6, cx.G, cx.wg); S.A = (const char*)LACT; S.B = (const char*)WL2; S.a_tile = 256 * 256 * 2; S.b_tile = 256 * 256 * 2;
          EpiBf16Plain E{WAG, 1536};
          pg8::gemm_phase<EpiBf16Plain, SchedPlain, true, true, false>(lds, cx.tid, OPQ(256), OPQ(256), OPQ(256), S, E); }
        { SchedS5 S; S.init(128, 1, cx.G, cx.wg); S.A = (const char*)AG; S.B = (const char*)S5ET; S.a_tile = 256 * 640 * 2; S.b_tile = 0; S.b_group = 256 * 512 * 2;
          EpiF32 E{EBUF, 256};
          pg8::gemm_phase<EpiF32, SchedS5, true, true, false>(lds, cx.tid, OPQ(512), OPQ(640), OPQ(512), S, E); }
    }
    SEAM(3);
    if (IN(4)) for (int rep_ = 0; rep_ < REPS(4); ++rep_) {
        FRESH_CX;
        for (int base = cx.wg * 32; base < 8192; base += cx.G * 32) { const int idx = base + (cx.lane & 31), b = idx >> 11, g = (idx >> 6) & 31, p = idx & 63, w8 = cx.wave;
            LAS float* CE = (LAS float*)lds;
            const float ar = ATG[(g * 64 + p) * 2], ai = ATG[(g * 64 + p) * 2 + 1];
            const size_t row0 = (size_t)g * 1024 + b * 256 + 32 * w8;
            float er[32], ei[32];
            if (cx.lane < 32) {
#pragma unroll
                for (int k = 0; k < 32; ++k) { er[k] = EBUF[(row0 + k) * 256 + p]; ei[k] = EBUF[(row0 + k) * 256 + 64 + p]; }
                float sr = 0.f, si = 0.f;
#pragma unroll
                for (int k = 0; k < 32; ++k) { const float nr = ar * sr - ai * si + er[k], ni = ar * si + ai * sr + ei[k]; sr = nr; si = ni; }
                CE[(w8 * 32 + cx.lane) * 2] = sr; CE[(w8 * 32 + cx.lane) * 2 + 1] = si; }
            __syncthreads();
            if (cx.lane < 32) {
                float pr = 1.f, pi = 0.f;
                { float qr = ar, qi = ai;
#pragma unroll
                  for (int i = 0; i < 5; ++i) { const float tr_ = qr * qr - qi * qi, ti_ = 2.f * qr * qi; qr = tr_; qi = ti_; } pr = qr; pi = qi; }
                float cr = 0.f, ci = 0.f;
                for (int w2 = 0; w2 < w8; ++w2) { const float e0 = CE[(w2 * 32 + cx.lane) * 2], e1 = CE[(w2 * 32 + cx.lane) * 2 + 1]; const float nr = pr * cr - pi * ci + e0, ni = pr * ci + pi * cr + e1; cr = nr; ci = ni; }
                float sr = cr, si = ci;
#pragma unroll
                for (int k = 0; k < 32; ++k) { bf16* d = AG + (row0 + k) * 640 + 512 + p; d[0] = (bf16)(pk2(sr, 0.f) & 0xffffu); d[64] = (bf16)(pk2(si, 0.f) & 0xffffu);
                    const float nr = ar * sr - ai * si + er[k], ni = ar * si + ai * sr + ei[k]; sr = nr; si = ni; } }
            __syncthreads();
        }
        MAKE_RP;
        for (int grp = cx.wg; grp < 256; grp += cx.G) rwkv_pass1(lds, RP, grp * 16, 16, cx.tid, QCT, HCT, W1G, ULG, DLG, (float*)(ws + WS_TOKSLOT));
    }
    SEAM(4);
    if (IN(5)) for (int rep_ = 0; rep_ < REPS(5); ++rep_) {
        FRESH_CX;
        if (SPLIT_P5 && cx.G == 256) {
            if (cx.wg < 128) { if (cx.wave == 0) rwkv_pass2(lds, cx.wg >> 2, cx.wg & 3, cx.lane, QCT, HCT, DLG, S0G); }
            else { SchedS5 S; S.init(128, 2, 128, cx.wg - 128); S.A = (const char*)AG; S.B = (const char*)S5BT; S.a_tile = 256 * 640 * 2; S.b_tile = 256 * 640 * 2; S.b_group = 512 * 640 * 2;
                EpiS5Y E{AG, I[11], Y1};
                pg8::gemm_phase<EpiS5Y, SchedS5, true, true, false>(lds, cx.tid, OPQ(640), OPQ(640), OPQ(640), S, E); }
        } else {
            { SchedS5 S; S.init(128, 2, cx.G, cx.wg); S.A = (const char*)AG; S.B = (const char*)S5BT; S.a_tile = 256 * 640 * 2; S.b_tile = 256 * 640 * 2; S.b_group = 512 * 640 * 2;
              EpiS5Y E{AG, I[11], Y1};
              pg8::gemm_phase<EpiS5Y, SchedS5, true, true, false>(lds, cx.tid, OPQ(640), OPQ(640), OPQ(640), S, E); }
            if (cx.wave == 0) for (int it = cx.wg; it < 128; it += cx.G) rwkv_pass2(lds, it >> 2, it & 3, cx.lane, QCT, HCT, DLG, S0G);
        }
    }
    SEAM(5);
    if (IN(6)) for (int rep_ = 0; rep_ < REPS(6); ++rep_) {
        FRESH_CX;
        MAKE_RP;
        for (int grp = cx.wg; grp < 256; grp += cx.G) rwkv_pass3(lds, RP, grp * 16, 16, cx.tid, S0G, W1G, ULG, (const float*)(ws + WS_TOKSLOT), MIX);
        __syncthreads();
        { SchedPlain S; S.init(128, 2, cx.G, cx.wg); S.A = (const char*)Y1; S.B = (const char*)WGLU; S.a_tile = 256 * 512 * 2; S.b_tile = 256 * 512 * 2;
          EpiGlu E{Y1, MIX};
          pg8::gemm_phase<EpiGlu, SchedPlain, true, true, false>(lds, cx.tid, OPQ(512), OPQ(512), OPQ(512), S, E); }
    }
    SEAM(6);
    if (IN(7)) for (int rep_ = 0; rep_ < REPS(7); ++rep_) {
        FRESH_CX;
        SchedPlain S; S.init(128, 4, cx.G, cx.wg); S.A = (const char*)MIX; S.B = (const char*)WOUT; S.a_tile = 256 * 1024 * 2; S.b_tile = 256 * 1024 * 2;
        EpiResid E{I[0], XB};
        pg8::gemm_phase<EpiResid, SchedPlain, true, true, false>(lds, cx.tid, OPQ(1024), OPQ(1024), OPQ(1024), S, E);
    }
    SEAM(7);
    if (IN(8)) for (int rep_ = 0; rep_ < REPS(8); ++rep_) { FRESH_CX; router_phase(cx, XB, I[29], I[30], I[31], H2, TOPE, TOPG, HIST); }
    SEAM(8);
    LAS int* PL = (LAS int*)(lds + LDS_PLAN);
    if (hi > 9 && lo < 28) { FRESH_CX; __syncthreads(); moe_plan(cx, HIST); }
    const int npass = (hi > 9 && lo < 28) ? PL[PL_NPASS] : 0;
    if (IN(9)) for (int rep_ = 0; rep_ < REPS(9); ++rep_) { FRESH_CX; dispatch_phase(cx, HIST, TOPE, SLOTTOK, TOKSLOT); convert_pass(cx, PL[PL_PE0], PL[PL_PE0 + 1], I[32], I[34], I[36], WGU, WDN); }
    SEAM(9);
    for (int p = 0; p < 6; ++p) {
        const bool actv = p < npass;
        const int e0 = actv ? PL[PL_PE0 + p] : 0, e1 = actv ? PL[PL_PE0 + p + 1] : 0, row0 = actv ? PL[PL_PROW0 + p] : 0, rows = actv ? PL[PL_PROW0 + p + 1] - row0 : 0;
        if (IN(10 + 3 * p) && actv) for (int rep_ = 0; rep_ < REPS(10); ++rep_) {
            FRESH_CX;
            SchedMoe<true> S; S.init(rows / 256, 8, cx.G, cx.wg); S.A = (const char*)H2; S.B = (const char*)WGU; S.a_tile = 0; S.b_tile = 256 * 1024; S.b_exp = (size_t)2048 * 1024; S.tile_e = PL + PL_TILEE; S.tile0 = row0 / 256; S.e0 = e0; S.slot_tok = SLOTTOK; S.row0 = row0;
            EpiGU E{ACT, I[33], I[35]};
            pg8::gemm_phase<EpiGU, SchedMoe<true>, MOE_ALIGN, MOE_SP2, true, true>(lds, cx.tid, OPQ(512), OPQ(512), OPQ(512), S, E);
        }
        if (actv) SEAM(10 + 3 * p);
        if (IN(11 + 3 * p) && actv) for (int rep_ = 0; rep_ < REPS(11); ++rep_) {
            FRESH_CX;
            SchedMoe<false> S; S.init(rows / 256, 4, cx.G, cx.wg); S.A = (const char*)ACT; S.B = (const char*)WDN; S.a_tile = 256 * 1024; S.b_tile = 256 * 1024; S.b_exp = (size_t)1024 * 1024; S.tile_e = PL + PL_TILEE; S.tile0 = row0 / 256; S.e0 = e0; S.slot_tok = SLOTTOK; S.row0 = row0;
#ifdef PROBE_NULLEPI
            if (rep_ + 1 < REPS(11)) { PROBE_EPIX E0{YB, I[37]}; pg8::gemm_phase<PROBE_EPIX, SchedMoe<false>, MOE_ALIGN, MOE_SP2, false, true>(lds, cx.tid, OPQ(512), OPQ(512), OPQ(512), S, E0); continue; }
#endif
#ifdef STAG11
            if (rep_ == 0) { const int ns_ = ((cx.wg >> 3) & 3) * STAG11; for (int q_ = 0; q_ < ns_; ++q_) __builtin_amdgcn_s_sleep(127); }
#endif
            EpiDown E{YB, I[37]};
            pg8::gemm_phase<EpiDown, SchedMoe<false>, MOE_ALIGN, MOE_SP2, false, true>(lds, cx.tid, OPQ(512), OPQ(512), OPQ(512), S, E);
        }
        if (actv) SEAM(11 + 3 * p);
        if (IN(12 + 3 * p) && actv) for (int rep_ = 0; rep_ < REPS(12); ++rep_) {
            FRESH_CX;
            if (p + 1 < npass) { combine_pass<false>(cx, e0, e1, row0, TOPE, TOPG, TOKSLOT, YB, XB, nullptr, nullptr); convert_pass(cx, PL[PL_PE0 + p + 1], PL[PL_PE0 + p + 2], I[32], I[34], I[36], WGU, WDN); }
            else {
                if (e0 == 0 && e1 == 32 && row0 == 0) combine_all(cx, TOPG, TOKSLOT, YB, XB, I[38], (unsigned char*)(ws + WS_R1));
                else combine_pass<true>(cx, e0, e1, row0, TOPE, TOPG, TOKSLOT, YB, XB, I[38], (unsigned char*)(ws + WS_R1));
                SchedPlain S; S.init(128, 4, cx.G, cx.wg); S.A = (const char*)PBF; S.B = (const char*)WPP; S.a_tile = 256 * 256 * 2; S.b_tile = 256 * 256 * 2;
                EpiBf16Plain E{PP, 1024};
                pg8::gemm_phase<EpiBf16Plain, SchedPlain, true, true, false>(lds, cx.tid, OPQ(256), OPQ(256), OPQ(256), S, E);
            }
        }
        if (actv) SEAM(12 + 3 * p);
    }
    if (IN(29)) for (int rep_ = 0; rep_ < REPS(29); ++rep_) {
        FRESH_CX;
        SchedPlain S; S.init(128, 4, cx.G, cx.wg); S.A = (const char*)(ws + WS_R1); S.B = (const char*)WPG; S.a_tile = 256 * 1024; S.b_tile = 256 * 1024;
        if (FUSE_FNORM && cx.G == 256) { EpiPleNorm E{PP, XB, OUTP, I[41], (float*)(ws + WS_CTL) + CW_ROWSS, (unsigned*)(ws + WS_CTL) + CW_PCNT};
            pg8::gemm_phase<EpiPleNorm, SchedPlain, true, true, false, true>(lds, cx.tid, OPQ(512), OPQ(512), OPQ(512), S, E); }
        else { EpiPle E{PP, XB};
            pg8::gemm_phase<EpiPle, SchedPlain, true, true, false, true>(lds, cx.tid, OPQ(512), OPQ(512), OPQ(512), S, E); }
    }
    SEAM(29);
    if (IN(30) && !(FUSE_FNORM && gridDim.x == 256)) for (int rep_ = 0; rep_ < REPS(30); ++rep_) {
        FRESH_CX;
        for (int m = 2 * cx.gw; m < M; m += 2 * cx.NGW) {
            const u32x2* ia_ = (const u32x2*)(XB + (size_t)m * 1024) + cx.lane; const u32x2* ib_ = ia_ + 256;
            f32x4* xa = (f32x4*)(OUTP + (size_t)m * 1024) + cx.lane; f32x4* xb = xa + 256; const f32x4* gr = (const f32x4*)I[41] + cx.lane; f32x4 va[4], vb[4]; float sa = 0.f, sb = 0.f;
#pragma unroll
            for (int j = 0; j < 4; ++j) { const u32x2 wa = ia_[64 * j], wb = ib_[64 * j]; va[j] = (f32x4){lo16(wa.x), hi16(wa.x), lo16(wa.y), hi16(wa.y)}; vb[j] = (f32x4){lo16(wb.x), hi16(wb.x), lo16(wb.y), hi16(wb.y)}; }
#pragma unroll
            for (int j = 0; j < 4; ++j) { sa += (va[j].x * va[j].x + va[j].y * va[j].y) + (va[j].z * va[j].z + va[j].w * va[j].w); sb += (vb[j].x * vb[j].x + vb[j].y * vb[j].y) + (vb[j].z * vb[j].z + vb[j].w * vb[j].w); }
#pragma unroll
            for (int o = 1; o < 64; o <<= 1) { sa += __shfl_xor(sa, o); sb += __shfl_xor(sb, o); }
            const float ia = rsqrtf(sa * (1.f / 1024.f) + 1e-6f), ib = rsqrtf(sb * (1.f / 1024.f) + 1e-6f);
#pragma unroll
            for (int j = 0; j < 4; ++j) { const f32x4 gg = gr[64 * j]; xa[64 * j] = (f32x4){va[j].x * ia * gg.x, va[j].y * ia * gg.y, va[j].z * ia * gg.z, va[j].w * ia * gg.w}; xb[64 * j] = (f32x4){vb[j].x * ib * gg.x, vb[j].y * ib * gg.y, vb[j].z * ib * gg.z, vb[j].w * ib * gg.w}; }
        }
    }
    if (PROBE_T >= 0 && blockIdx.x == 0 && xb_first(wv0_)) { STAMP(); asm volatile("s_waitcnt vmcnt(0)" ::: "memory");
        const unsigned long long t0_ = ((unsigned long long)MISC[17 + 2 * PROBE_T] << 32) | MISC[16 + 2 * PROBE_T], t1_ = ((unsigned long long)MISC[19 + 2 * PROBE_T] << 32) | MISC[18 + 2 * PROBE_T];
        (*(float* const CAS*)((const CAS char*)__builtin_amdgcn_kernarg_segment_ptr() + 336))[0] = (float)(t1_ - t0_) * 0.01f; }
#undef IN
#undef SEAM
}

extern "C" void kernel_launch(void* const* d_in, const int* in_sizes, int n_in, void* d_out, int out_size, void* d_ws, size_t ws_size, hipStream_t stream) {
    static int grid = 0;
    if (grid == 0) {
        if (n_in != 42 || out_size != M * DM || ws_size < WS_END) { fprintf(stderr, "kernel_launch: unexpected shapes (n_in %d out %d ws %zu)\n", n_in, out_size, ws_size); grid = -1; return; }
        int dev = 0, cus = 0, per_cu = 0;
        if (hipGetDevice(&dev) != hipSuccess || hipDeviceGetAttribute(&cus, hipDeviceAttributeMultiprocessorCount, dev) != hipSuccess) { grid = -1; return; }
        if (hipFuncSetAttribute((const void*)mk_fwd, hipFuncAttributeMaxDynamicSharedMemorySize, LDS_BYTES) != hipSuccess) { fprintf(stderr, "kernel_launch: hipFuncSetAttribute failed\n"); grid = -1; return; }
        if (hipOccupancyMaxActiveBlocksPerMultiprocessor(&per_cu, (const void*)mk_fwd, NTHR, LDS_BYTES) != hipSuccess || per_cu < 1) fprintf(stderr, "kernel_launch: occupancy query says %d\n", per_cu);
        (void)hipGetLastError();
        grid = cus > 256 ? 256 : cus;
    }
    if (grid < 0) return;
    (void)hipMemsetAsync((char*)d_ws + WS_CTL, 0, CTL_ZERO_BYTES, stream);
    Args a{};
    for (int i = 0; i < 42; ++i) a.in[i] = (const float*)d_in[i];
    a.out = (float*)d_out; a.ws = (unsigned char*)d_ws;
#if MK_PER_PHASE
    for (int ph = 0; ph < NPH; ++ph) { a.ph_lo = ph; a.ph_hi = ph + 1; hipLaunchKernelGGL(mk_fwd, dim3(grid), dim3(NTHR), LDS_BYTES, stream, a); }
#else
    a.ph_lo = 0; a.ph_hi = NPH;
    hipLaunchKernelGGL(mk_fwd, dim3(grid), dim3(NTHR), LDS_BYTES, stream, a);
#endif
}
```

```cpp
#include <hip/hip_runtime.h>
#include <cstdio>
#include <cstdint>

#ifndef MK_PER_PHASE
#define MK_PER_PHASE 0
#endif

#define LAS __attribute__((address_space(3)))
#define GAS __attribute__((address_space(1)))
typedef unsigned short bf16;
typedef short bf16x8 __attribute__((ext_vector_type(8)));
typedef float f32x4 __attribute__((ext_vector_type(4)));
typedef float f32x2 __attribute__((ext_vector_type(2)));
typedef unsigned u32x4 __attribute__((ext_vector_type(4)));
typedef unsigned u32x2 __attribute__((ext_vector_type(2)));
typedef GAS unsigned gu32;

constexpr int NB = 4, SEQ = 8192, DM = 1024, M = NB * SEQ;
constexpr int NEXP = 32, TOPK = 4;
constexpr int NWAVES = 8, NTHR = 512;
constexpr size_t MiB = 1u << 20;

constexpr size_t WS_CTL = 0, CTL_ZERO_BYTES = 1 * MiB;
constexpr size_t WS_HIST = 1 * MiB;
constexpr size_t WS_TOPE = 2 * MiB;
constexpr size_t WS_TOPG = 3 * MiB;
constexpr size_t WS_TOKSLOT = 4 * MiB;
constexpr size_t WS_SLOTTOK = 5 * MiB;
constexpr size_t WS_AT = 6 * MiB;
constexpr size_t WS_DL = 6 * MiB + 65536;
constexpr size_t WS_WCAT = 8 * MiB;
constexpr size_t WS_WL2 = 13 * MiB;
constexpr size_t WS_WGLU = 14 * MiB;
constexpr size_t WS_WPP = 14 * MiB + 524288;
constexpr size_t WS_WOUT = 15 * MiB;
constexpr size_t WS_WPG = 17 * MiB;
constexpr size_t WS_S5BT = 19 * MiB;
constexpr size_t WS_S5ET = 39 * MiB;
constexpr size_t WS_PBF = 48 * MiB;
constexpr size_t WS_R1 = 64 * MiB;
constexpr size_t WS_RKV = 128 * MiB;
constexpr size_t WS_WAG = 224 * MiB;
constexpr size_t WS_AG = 320 * MiB;
constexpr size_t WS_U = 360 * MiB;
constexpr size_t WS_LP = 392 * MiB;
constexpr size_t WS_LACT = 424 * MiB;
constexpr size_t WS_W1 = 440 * MiB;
constexpr size_t WS_ULOC = 472 * MiB;
constexpr size_t WS_Y1 = 504 * MiB;
constexpr size_t WS_H2 = 64 * MiB;
constexpr size_t WS_WDN = 96 * MiB;
constexpr size_t WS_ACT = 128 * MiB;
constexpr size_t WS_Y = 264 * MiB;
constexpr size_t WS_XB = 400 * MiB;
constexpr size_t WS_WGU = 264 * MiB;
constexpr int RMAX = 139264;
constexpr int MAXEPP = 32;
constexpr size_t WS_END = 560 * MiB;
static_assert(WS_Y + (size_t)RMAX * 1024 <= WS_XB && WS_XB + (size_t)M * 2048 <= WS_END && WS_ACT + (size_t)RMAX * 1024 <= WS_Y, "moe map");

constexpr int CW_BAR = 4096;
constexpr int CW_ROWSS = 65536;
constexpr int CW_PCNT = 131072;

constexpr int LDS_PLAN = 147456;
constexpr int LDS_MISC = 155648;
constexpr int LDS_BYTES = 156672;
constexpr int PL_CNT = 0, PL_PSTART = 32, PL_NPASS = 72, PL_PE0 = 80, PL_PROW0 = 88, PL_TILEE = 128, PL_TMP = 768;

#define LDS_WAIT() asm volatile("s_waitcnt lgkmcnt(0)" ::: "memory")
#define VM_WAIT() asm volatile("s_waitcnt vmcnt(0)" ::: "memory")
__device__ __forceinline__ float bf2f(unsigned b) { return __uint_as_float(b << 16); }
typedef __bf16 bf16n2 __attribute__((ext_vector_type(2)));
__device__ __forceinline__ unsigned cvt_pk_bf16(float lo, float hi) { const f32x2 f = {lo, hi}; const bf16n2 v = __builtin_convertvector(f, bf16n2); return __builtin_bit_cast(unsigned, v); }
__device__ __forceinline__ unsigned pk2(float lo, float hi) { return cvt_pk_bf16(lo, hi); }
__device__ __forceinline__ float lo16(unsigned w) { return __uint_as_float(w << 16); }
__device__ __forceinline__ float hi16(unsigned w) { return __uint_as_float(w & 0xffff0000u); }
__device__ __forceinline__ unsigned pk4_fp8(float a, float b, float c, float d) { unsigned w; asm volatile("" : "=v"(w));     w = (unsigned)__builtin_amdgcn_cvt_pk_fp8_f32(a, b, (int)w, false); w = (unsigned)__builtin_amdgcn_cvt_pk_fp8_f32(c, d, (int)w, true); return w; }
__device__ __forceinline__ f32x4 up4_fp8(unsigned w) { const f32x2 lo = __builtin_amdgcn_cvt_pk_f32_fp8((int)w, false), hi = __builtin_amdgcn_cvt_pk_f32_fp8((int)w, true); return (f32x4){lo.x, lo.y, hi.x, hi.y}; }
__device__ __forceinline__ float frcp(float x) { return __builtin_amdgcn_rcpf(x); }
__device__ __forceinline__ float fsigmoid(float x) { return frcp(1.0f + __expf(-x)); }
__device__ __forceinline__ float ftanh(float x) { const float e = __expf(-2.0f * fabsf(x)); const float t = (1.0f - e) * frcp(1.0f + e); return x < 0.f ? -t : t; }
__device__ __forceinline__ float gelu_tanh(float x) { const float u = 0.7978845608f * (x + 0.044715f * x * x * x); return 0.5f * x * (1.0f + ftanh(u)); }
__device__ __forceinline__ float wave_sum(float v) {
#pragma unroll
    for (int o = 1; o < 64; o <<= 1) v += __shfl_xor(v, o);
    return v;
}
__device__ __forceinline__ float wave_max(float v) {
#pragma unroll
    for (int o = 1; o < 64; o <<= 1) v = fmaxf(v, __shfl_xor(v, o));
    return v;
}

#define XB_TMO      128
#define XB_XCNT(j)  (256  + 64 * (j))
#define XB_XSUB(j)  (1280 + 64 * (j))
#define XB_XGEN(j)  (2304 + 64 * (j))
#define XB_TOP      3328
#define XB_TOPGEN   3392
#define XCD_BAR_WORDS 3456
#define XB_SPIN_CAP (1u << 22)

__device__ __forceinline__ unsigned xb_ld(unsigned* p)              { return __hip_atomic_load(p, __ATOMIC_RELAXED, __HIP_MEMORY_SCOPE_AGENT); }
__device__ __forceinline__ unsigned xb_add(unsigned* p, unsigned v) { return __hip_atomic_fetch_add(p, v, __ATOMIC_RELAXED, __HIP_MEMORY_SCOPE_AGENT); }
__device__ __forceinline__ unsigned xb_xcc_id() { return (unsigned)__builtin_amdgcn_s_getreg((3 << 11) | 20) & 0xFu; }
#define XB_SPIN(cond, bar) do { unsigned _sp = 0; while (cond) { __builtin_amdgcn_s_sleep(1); \
    if ((++_sp & 255u) == 0u) { if (xb_ld(&(bar)[XB_TMO])) break; if (_sp > XB_SPIN_CAP) { atomicAdd(&(bar)[XB_TMO], 1u); break; } } } } while (0)

struct XcdBarrier { unsigned* bar; unsigned x; volatile LAS unsigned* st; int wv; };
__device__ __forceinline__ bool xb_first(int wv) { return wv == 0 && __builtin_amdgcn_mbcnt_hi(~0u, __builtin_amdgcn_mbcnt_lo(~0u, 0u)) == 0u; }

__device__ __forceinline__ XcdBarrier xcd_barrier_post(unsigned* bar, volatile LAS unsigned* st, int wv) {
    XcdBarrier b; b.bar = bar; b.x = xb_xcc_id(); b.st = st; b.wv = wv;
    if (xb_first(wv)) (void)xb_add(&bar[XB_XCNT(b.x)], 1u);
    return b;
}
__device__ __forceinline__ void xcd_barrier_complete(unsigned* bar, unsigned x, unsigned& nloc, unsigned& nx) {
    const unsigned G = gridDim.x * gridDim.y * gridDim.z;
    unsigned sum, cnt, mine, sp = 0u;
    for (;;) {
        sum = 0u; cnt = 0u; mine = 0u;
#pragma unroll
        for (unsigned j = 0; j < 16; ++j) { const unsigned c = xb_ld(&bar[XB_XCNT(j)]); sum += c; cnt += (c > 0u) ? 1u : 0u; mine = (j == x) ? c : mine; }
        if (sum == G) break;
        __builtin_amdgcn_s_sleep(1);
        if ((++sp & 255u) == 0u) { if (xb_ld(&bar[XB_TMO])) break; if (sp > XB_SPIN_CAP) { atomicAdd(&bar[XB_TMO], 1u); break; } }
    }
    nloc = mine > 0u ? mine : 1u; nx = cnt > 0u ? cnt : 1u;
}
__device__ __forceinline__ void xcd_barrier(const XcdBarrier& b) {
    asm volatile("s_waitcnt vmcnt(0)" ::: "memory");
    __syncthreads();
    if (xb_first(b.wv)) {
        unsigned* bar = b.bar;
        __builtin_amdgcn_s_waitcnt(0);
        unsigned nloc = b.st[0], nx = b.st[1];
        if (nloc == 0u) { xcd_barrier_complete(bar, b.x, nloc, nx); b.st[0] = nloc; b.st[1] = nx; }
        const unsigned old = xb_add(&bar[XB_XSUB(b.x)], 1u);
        const unsigned gen = old / nloc;
        if (old + 1u == (gen + 1u) * nloc) {
            __builtin_amdgcn_fence(__ATOMIC_RELEASE, "agent");
            asm volatile("s_waitcnt vmcnt(0)" ::: "memory");
            const unsigned og = xb_add(&bar[XB_TOP], 1u);
            const unsigned tg = og / nx;
            if (og + 1u == (tg + 1u) * nx) xb_add(&bar[XB_TOPGEN], 1u);
            else XB_SPIN(xb_ld(&bar[XB_TOPGEN]) == tg, bar);
            __builtin_amdgcn_fence(__ATOMIC_ACQUIRE, "agent");
            xb_add(&bar[XB_XGEN(b.x)], 1u);
            asm volatile("s_waitcnt vmcnt(0)" ::: "memory");
        } else {
            XB_SPIN(xb_ld(&bar[XB_XGEN(b.x)]) == gen, bar);
            __builtin_amdgcn_fence(__ATOMIC_ACQUIRE, "agent");
            asm volatile("s_waitcnt vmcnt(0)" ::: "memory");
        }
    }
    __syncthreads();
}

#ifndef PG8_WGM
#define PG8_WGM 8
#endif
namespace pg8 {
constexpr int BM = 256, BK = 64, HALF = 128, HTB = HALF * BK * 2, STAGE_BYTES = 8 * HTB, NXCD = 8, WGM = PG8_WGM;
__host__ __device__ __forceinline__ int lds_byte(int r, int c) { const int st = (r >> 4) * 2 + (c >> 5), rr = r & 15, cc = c & 31, ob = rr * 64 + cc * 2; return st * 1024 + (ob ^ (((ob >> 9) & 1) << 5)); }
__host__ __device__ __forceinline__ void stage_rc(int b, int& R, int& C) { const int st = b / 1024, sb = b % 1024, swz = sb ^ (((sb >> 9) & 1) << 5); R = (st >> 1) * 16 + swz / 64; C = (st & 1) * 32 + (swz % 64) / 2; }
__host__ __device__ __forceinline__ int perm32(int rho) { const int n = rho >> 4, i = rho & 15; return 8 * (i >> 2) + 4 * n + (i & 3); }

struct Unit { int pm, pn, aux; };

struct Order {
    int nM, nN, nwg, G, c;
    __device__ __forceinline__ void init(int nM_, int nN_, int G_, int c_) { nM = nM_; nN = nN_; nwg = nM * nN; G = G_; c = c_; }
    __device__ __forceinline__ bool tile(int i, int& pm, int& pn) const {
        const long L = (long)i * G + c; if (L >= nwg) return false;
        int wgid = (int)L; { const int q = nwg / NXCD, r = nwg % NXCD, xcd = wgid % NXCD, off = wgid / NXCD; wgid = (xcd < r ? xcd * (q + 1) : r * (q + 1) + (xcd - r) * q) + off; }
        const int nig = WGM * nN, gid = wgid / nig, fm = gid * WGM, gsz = (nM - fm) < WGM ? (nM - fm) : WGM;
        pm = fm + ((wgid % nig) % gsz); pn = (wgid % nig) / gsz; return true;
    }
};


template <class Epi, class Sched, bool ALIGN_EPI, bool SP2, bool GATHER, bool FP8 = false>
__device__ __forceinline__ void gemm_phase(LAS unsigned char* lds, const int tid, const int K, const int lda, const int ldb, const Sched& S, const Epi& E) {
    const int wid = __builtin_amdgcn_readfirstlane(tid >> 6), lane = tid & 63, wr = wid >> 2, wc = wid & 3, fr = lane & 15, fq = lane >> 4;
    const int nt = K / BK;
    unsigned voffA[2], voffB[2]; int rA[2], cA2[2];
#pragma unroll
    for (int i = 0; i < 2; ++i) { int R, C; stage_rc(tid * 16 + i * 8192, R, C); const int Rb = Epi::PERM ? ((R & ~31) + perm32(R & 31)) : R;
        voffA[i] = (unsigned)(R * lda + C) * 2u; voffB[i] = (unsigned)(Rb * ldb + C) * 2u; rA[i] = R; cA2[i] = C * 2; }
    const size_t kstep = (size_t)(BK * 2);
    const size_t hstepA = (size_t)HALF * lda * 2, hstepB = (size_t)HALF * ldb * 2;
    const unsigned ldsw = (unsigned)wid * 1024u;
    const int aoff = FP8 ? lds_byte(wr * 64 + fr, fq * 16) : lds_byte(wr * 64 + fr, fq * 8), boff = FP8 ? lds_byte(wc * 32 + fr, fq * 16) : lds_byte(wc * 32 + fr, fq * 8);
    unsigned cv0[2] = {0u, 0u}, cv1[2] = {0u, 0u};
#define PG8_SA(b, h) (((b) * 2 + (h)) * HTB)
#define PG8_SB(b, h) ((4 + (b) * 2 + (h)) * HTB)
#define PG8_STAGE(bufoff, gbase, voff) do { _Pragma("unroll") for (int _i = 0; _i < 2; ++_i) \
        __builtin_amdgcn_global_load_lds((const unsigned*)((const char*)(gbase) + (voff)[_i]), (LAS unsigned*)(lds + (bufoff) + ldsw + _i * 8192), 16, 0, 0); } while (0)
#define PG8_NROW(h, i) ((has_next ? *(const LAS unsigned*)(pf_rows + (i) * 512 + (h) * 256 + lane * 4) * (unsigned)(lda * 2) + (unsigned)cA2[i] : ((h) ? cv1[i] : cv0[i])))
#define PG8_STAGE_A(bufoff, ptr, h, nx) do { if constexpr (GATHER) { unsigned _v[2]; if (nx) { asm volatile("" ::: "memory"); _v[0] = PG8_NROW(h, 0); _v[1] = PG8_NROW(h, 1); } else { _v[0] = (h) ? cv1[0] : cv0[0]; _v[1] = (h) ? cv1[1] : cv0[1]; } PG8_STAGE(bufoff, ptr, _v); } \
        else { PG8_STAGE(bufoff, (ptr) + (h) * hstepA, voffA); } } while (0)
#define PG8_LDA(dst, b, h) do { if constexpr (FP8) { _Pragma("unroll") for (int m = 0; m < 4; ++m) { dst##8[m].lo = *(const LAS v4i_*)(lds + PG8_SA(b, h) + aoff + m * 2048); dst##8[m].hi = *(const LAS v4i_*)(lds + PG8_SA(b, h) + aoff + m * 2048 + 16); } } \
        else { _Pragma("unroll") for (int m = 0; m < 4; ++m) _Pragma("unroll") for (int k = 0; k < 2; ++k) dst[m][k] = *(const LAS bf16x8*)(lds + PG8_SA(b, h) + aoff + m * 2048 + k * 1024); } } while (0)
#define PG8_LDB(dst, b, h) do { if constexpr (FP8) { _Pragma("unroll") for (int n = 0; n < 2; ++n) { dst##8[n].lo = *(const LAS v4i_*)(lds + PG8_SB(b, h) + boff + n * 2048); dst##8[n].hi = *(const LAS v4i_*)(lds + PG8_SB(b, h) + boff + n * 2048 + 16); } } \
        else { _Pragma("unroll") for (int n = 0; n < 2; ++n) _Pragma("unroll") for (int k = 0; k < 2; ++k) dst[n][k] = *(const LAS bf16x8*)(lds + PG8_SB(b, h) + boff + n * 2048 + k * 1024); } } while (0)
#define PG8_MMA(ai, bj, At, Bt) do { __builtin_amdgcn_s_setprio(1); _Pragma("unroll") for (int m = 0; m < 4; ++m) _Pragma("unroll") for (int n = 0; n < 2; ++n) { \
        if constexpr (FP8) asm volatile("v_mfma_scale_f32_16x16x128_f8f6f4 %0, %1, %2, %0, %3, %4 op_sel_hi:[0,0,0]" : "+v"(acc[ai][bj][m][n]) : "v"(Bt##8[n]), "v"(At##8[m]), "v"(sclW), "v"(sclA));   \
        else { _Pragma("unroll") for (int k = 0; k < 2; ++k) acc[ai][bj][m][n] = __builtin_amdgcn_mfma_f32_16x16x32_bf16(Bt[n][k], At[m][k], acc[ai][bj][m][n], 0, 0, 0); } } \
        __builtin_amdgcn_s_setprio(0); } while (0)
#define PG8_WAIT_V(n) asm volatile("s_waitcnt vmcnt(" #n ")" ::: "memory")
#define PG8_WAIT_L(n) asm volatile("s_waitcnt lgkmcnt(" #n ")" ::: "memory")
#define PG8_BAR __builtin_amdgcn_s_barrier()
#define PG8_SCHED __builtin_amdgcn_sched_barrier(0)
#define PG8_ROWS(u, d0, d1) do { _Pragma("unroll") for (int _i = 0; _i < 2; ++_i) { const int _r0 = S.a_row(u, rA[_i]), _r1 = S.a_row(u, HALF + rA[_i]); \
        d0[_i] = (unsigned)_r0 * (unsigned)(lda * 2) + (unsigned)cA2[_i]; d1[_i] = (unsigned)_r1 * (unsigned)(lda * 2) + (unsigned)cA2[_i]; } } while (0)
    constexpr int PF_OFF = STAGE_BYTES;
    LAS unsigned char* pf_bias = lds + PF_OFF + wid * 256; LAS unsigned char* pf_rows = lds + PF_OFF + 2048 + wid * 1024;
    Unit cur, nxt; int ui = 0; bool has_next = false;
    if (!S.next(0, cur)) return;
    f32x4 acc[2][2][4][2];
#define PG8_ACC_INIT() do { if constexpr (Epi::ACCINIT) { E.init(acc, pf_bias, fq); } else { _Pragma("unroll") for (int a = 0; a < 2; ++a) _Pragma("unroll") for (int b = 0; b < 2; ++b) _Pragma("unroll") for (int m = 0; m < 4; ++m) \
        _Pragma("unroll") for (int n = 0; n < 2; ++n) acc[a][b][m][n] = (f32x4){0.f, 0.f, 0.f, 0.f}; } } while (0)
    if constexpr (Epi::ACCINIT) { E.pref(pf_bias, cur, wc, lane); PG8_WAIT_V(0); }
    PG8_ACC_INIT();
    typedef int v8i_ __attribute__((ext_vector_type(8))); typedef int v4i_ __attribute__((ext_vector_type(4)));
    bf16x8 At[4][2], B0[2][2], B1[2][2]; v8i_ At8[4], B08[2], B18[2];
    const int sclW = 0x7a7a7a7a, sclA = 0x7f7f7f7f;
    const char* cA = S.a_ptr(cur); const char* cB = S.b_ptr(cur);
    if constexpr (GATHER) { PG8_ROWS(cur, cv0, cv1); }
    if constexpr (SP2) {
        PG8_STAGE(PG8_SB(0, 0), cB, voffB); PG8_STAGE(PG8_SB(0, 1), cB + hstepB, voffB); PG8_STAGE_A(PG8_SA(0, 0), cA, 0, false); PG8_STAGE_A(PG8_SA(0, 1), cA, 1, false);
        if (wr == 1) PG8_BAR;
        PG8_WAIT_V(2); PG8_BAR;
        PG8_STAGE(PG8_SB(1, 0), cB + kstep, voffB); PG8_STAGE_A(PG8_SA(1, 0), cA + kstep, 0, false); PG8_STAGE(PG8_SB(1, 1), cB + hstepB + kstep, voffB);
        PG8_WAIT_V(6); PG8_BAR;
    } else {
        PG8_STAGE(PG8_SB(0, 0), cB, voffB); PG8_STAGE_A(PG8_SA(0, 0), cA, 0, false); PG8_STAGE(PG8_SB(0, 1), cB + hstepB, voffB); PG8_STAGE_A(PG8_SA(0, 1), cA, 1, false);
        if (wr == 1) PG8_BAR;
        PG8_WAIT_V(4); PG8_BAR;
        PG8_STAGE(PG8_SB(1, 0), cB + kstep, voffB); PG8_STAGE_A(PG8_SA(1, 0), cA + kstep, 0, false); PG8_STAGE(PG8_SB(1, 1), cB + hstepB + kstep, voffB);
        PG8_WAIT_V(6); PG8_BAR;
    }
    for (;;) {
        has_next = S.next(ui + 1, nxt);
        const char* nA = has_next ? S.a_ptr(nxt) : cA; const char* nB = has_next ? S.b_ptr(nxt) : cB;
        if constexpr (Epi::ACCINIT) { if (has_next) E.pref(pf_bias, nxt, wc, lane); } else if constexpr (Epi::PREF) E.pref(pf_bias, cur, wc, lane);
        if constexpr (GATHER) { if (has_next) {
#pragma unroll
                for (int _i = 0; _i < 2; ++_i) { __builtin_amdgcn_global_load_lds((const unsigned*)S.a_row_ptr(nxt, rA[_i]), (LAS unsigned*)(pf_rows + _i * 512), 4, 0, 0);
                                                 __builtin_amdgcn_global_load_lds((const unsigned*)S.a_row_ptr(nxt, HALF + rA[_i]), (LAS unsigned*)(pf_rows + _i * 512 + 256), 4, 0, 0); } }
            }
        for (int t = 0; t < nt; t += 2) {
            const bool last = (t == nt - 2);
            const char* a1 = cA + (size_t)(t + 1) * kstep;
            const char* a2 = last ? nA : cA + (size_t)(t + 2) * kstep; const char* b2 = last ? nB : cB + (size_t)(t + 2) * kstep;
            const char* a3 = a2 + kstep; const char* b3 = b2 + kstep;
            if constexpr (SP2) {
            PG8_LDB(B0, 0, 0); PG8_LDB(B1, 0, 1); PG8_SCHED; PG8_LDA(At, 0, 0); PG8_STAGE_A(PG8_SA(1, 1), a1, 1, false);
            PG8_WAIT_V(8); PG8_WAIT_L(0); PG8_BAR; PG8_MMA(0, 0, At, B0); PG8_MMA(0, 1, At, B1); PG8_BAR; PG8_SCHED;
            PG8_LDA(At, 0, 1); PG8_STAGE(PG8_SB(0, 0), b2, voffB); PG8_STAGE(PG8_SB(0, 1), b2 + hstepB, voffB); PG8_STAGE_A(PG8_SA(0, 0), a2, 0, last);
            PG8_WAIT_V(8); PG8_WAIT_L(0); PG8_BAR; PG8_MMA(1, 0, At, B0); PG8_MMA(1, 1, At, B1); PG8_BAR; PG8_SCHED;
            PG8_LDB(B0, 1, 0); PG8_LDB(B1, 1, 1); PG8_SCHED; PG8_LDA(At, 1, 0); PG8_STAGE_A(PG8_SA(0, 1), a2, 1, last);
            PG8_WAIT_V(8); PG8_WAIT_L(0); PG8_BAR; PG8_MMA(0, 0, At, B0); PG8_MMA(0, 1, At, B1); PG8_BAR; PG8_SCHED;
            PG8_LDA(At, 1, 1); PG8_STAGE(PG8_SB(1, 0), b3, voffB); PG8_STAGE(PG8_SB(1, 1), b3 + hstepB, voffB); PG8_STAGE_A(PG8_SA(1, 0), a3, 0, last);
            PG8_WAIT_V(8); PG8_WAIT_L(0); PG8_BAR; PG8_MMA(1, 0, At, B0); PG8_MMA(1, 1, At, B1); PG8_BAR; PG8_SCHED;
            } else {
            PG8_LDB(B0, 0, 0); PG8_SCHED; PG8_LDA(At, 0, 0); PG8_STAGE_A(PG8_SA(1, 1), a1, 1, false);
            PG8_WAIT_L(8); PG8_BAR; PG8_WAIT_L(0); PG8_MMA(0, 0, At, B0); PG8_BAR; PG8_SCHED;
            PG8_LDB(B1, 0, 1); PG8_STAGE(PG8_SB(0, 0), b2, voffB);
            PG8_BAR; PG8_WAIT_L(0); PG8_MMA(0, 1, At, B1); PG8_BAR;
            PG8_LDA(At, 0, 1); PG8_STAGE_A(PG8_SA(0, 0), a2, 0, last);
            PG8_BAR; PG8_WAIT_L(0); PG8_MMA(1, 0, At, B0); PG8_BAR; PG8_SCHED;
            PG8_STAGE(PG8_SB(0, 1), b2 + hstepB, voffB);
            PG8_WAIT_V(6); PG8_BAR; PG8_MMA(1, 1, At, B1); PG8_BAR;
            PG8_LDB(B0, 1, 0); PG8_SCHED; PG8_LDA(At, 1, 0); PG8_STAGE_A(PG8_SA(0, 1), a2, 1, last);
            PG8_WAIT_L(8); PG8_BAR; PG8_WAIT_L(0); PG8_MMA(0, 0, At, B0); PG8_BAR; PG8_SCHED;
            PG8_LDB(B1, 1, 1); PG8_STAGE(PG8_SB(1, 0), b3, voffB);
            PG8_BAR; PG8_WAIT_L(0); PG8_MMA(0, 1, At, B1); PG8_BAR;
            PG8_LDA(At, 1, 1); PG8_STAGE_A(PG8_SA(1, 0), a3, 0, last);
            PG8_BAR; PG8_WAIT_L(0); PG8_MMA(1, 0, At, B0); PG8_BAR; PG8_SCHED;
            PG8_STAGE(PG8_SB(1, 1), b3 + hstepB, voffB);
            PG8_WAIT_V(6); PG8_BAR; PG8_MMA(1, 1, At, B1); PG8_BAR;
            }
        }
        if constexpr (ALIGN_EPI) { if (wr == 0) PG8_BAR; }
        if constexpr (FP8) asm volatile("s_nop 15\n\ts_nop 15" ::: "memory");
        E(acc, cur, wr, wc, fr, fq, pf_bias);
        if (!has_next) break;
        PG8_ACC_INIT();
        cur = nxt; cA = nA; cB = nB; ++ui;
        if constexpr (GATHER) { asm volatile("" ::: "memory"); cv0[0] = PG8_NROW(0, 0); cv0[1] = PG8_NROW(0, 1); cv1[0] = PG8_NROW(1, 0); cv1[1] = PG8_NROW(1, 1); }
        if constexpr (ALIGN_EPI) { if (wr == 1) PG8_BAR; }
    }
    PG8_WAIT_V(0);
    if constexpr (!ALIGN_EPI) { if (wr == 0) PG8_BAR; }
    PG8_BAR;
#undef PG8_SA
#undef PG8_SB
#undef PG8_STAGE
#undef PG8_STAGE_A
#undef PG8_NROW
#undef PG8_LDA
#undef PG8_LDB
#undef PG8_MMA
#undef PG8_WAIT_V
#undef PG8_WAIT_L
#undef PG8_BAR
#undef PG8_SCHED
#undef PG8_ROWS
#undef PG8_ACC_INIT
}
}

using pg8::Unit;
struct SchedPlain : pg8::Order {
    const char* A; const char* B; size_t a_tile, b_tile;
    __device__ __forceinline__ bool next(int i, Unit& u) const { u.aux = 0; return tile(i, u.pm, u.pn); }
    __device__ __forceinline__ const char* a_ptr(const Unit& u) const { return A + (size_t)u.pm * a_tile; }
    __device__ __forceinline__ const char* b_ptr(const Unit& u) const { return B + (size_t)u.pn * b_tile; }
    __device__ __forceinline__ int a_row(const Unit&, int) const { return 0; }
    __device__ __forceinline__ const int* a_row_ptr(const Unit&, int) const { return nullptr; }
};
struct SchedS5 : pg8::Order {
    const char* A; const char* B; size_t a_tile, b_tile, b_group;
    __device__ __forceinline__ bool next(int i, Unit& u) const { u.aux = 0; return tile(i, u.pm, u.pn); }
    __device__ __forceinline__ const char* a_ptr(const Unit& u) const { return A + (size_t)u.pm * a_tile; }
    __device__ __forceinline__ const char* b_ptr(const Unit& u) const { return B + (size_t)(u.pm >> 2) * b_group + (size_t)u.pn * b_tile; }
    __device__ __forceinline__ int a_row(const Unit&, int) const { return 0; }
    __device__ __forceinline__ const int* a_row_ptr(const Unit&, int) const { return nullptr; }
};
template <bool GATHER> struct SchedMoe : pg8::Order {
    const char* A; const char* B; size_t a_tile, b_tile, b_exp; const LAS int* tile_e; int tile0, e0; const int* slot_tok; int row0;
    __device__ __forceinline__ bool next(int i, Unit& u) const { const bool ok = tile(i, u.pm, u.pn); u.aux = ok ? tile_e[tile0 + u.pm] : 0; return ok; }
    __device__ __forceinline__ const char* a_ptr(const Unit& u) const { return GATHER ? A : A + (size_t)u.pm * a_tile; }
    __device__ __forceinline__ const char* b_ptr(const Unit& u) const { return B + (size_t)(u.aux - e0) * b_exp + (size_t)u.pn * b_tile; }
    __device__ __forceinline__ int a_row(const Unit& u, int r) const { return slot_tok[row0 + u.pm * 256 + r]; }
    __device__ __forceinline__ const int* a_row_ptr(const Unit& u, int r) const { return slot_tok + row0 + u.pm * 256 + r; }
};

__device__ __forceinline__ void st8(bf16* p, const f32x4 v0, const f32x4 v1) {
    u32x4 w; w.x = cvt_pk_bf16(v0[0], v0[1]); w.y = cvt_pk_bf16(v0[2], v0[3]); w.z = cvt_pk_bf16(v1[0], v1[1]); w.w = cvt_pk_bf16(v1[2], v1[3]); *(u32x4*)p = w;
}
__device__ __forceinline__ void ld8(const bf16* p, f32x4& v0, f32x4& v1) {
    const u32x4 w = *(const u32x4*)p; v0 = (f32x4){lo16(w.x), hi16(w.x), lo16(w.y), hi16(w.y)}; v1 = (f32x4){lo16(w.z), hi16(w.z), lo16(w.w), hi16(w.w)};
}
#define EPI_LOOP_AM _Pragma("unroll") for (int ai = 0; ai < 2; ++ai) _Pragma("unroll") for (int m = 0; m < 4; ++m)
#define EPI_ARGS f32x4 (&acc)[2][2][4][2], const Unit& u, int wr, int wc, int fr, int fq, const LAS unsigned char* pf

struct EpiProj { static constexpr bool PERM = true, PREF = false, ACCINIT = false; bf16 *AG, *RKV, *LP;
    __device__ __forceinline__ void operator()(EPI_ARGS) const {
        const int row0 = u.pm * 256 + wr * 64 + fr;
        if (u.pn < 2) { const int col0 = u.pn * 256 + wc * 32 + 8 * fq;
            EPI_LOOP_AM { const int row = row0 + ai * 128 + m * 16;
#pragma unroll
                for (int bj = 0; bj < 2; ++bj) { const int c = col0 + bj * 128; st8(AG + ((size_t)((c >> 4) * 1024 + (row >> 5))) * 640 + (row & 31) * 16 + (c & 15), acc[ai][bj][m][0], acc[ai][bj][m][1]); } }
        } else {
            bf16* base; int ldc, c0;
            if (u.pn < 8) { base = RKV; ldc = 1536; c0 = (u.pn - 2) * 256; } else { base = LP; ldc = 512; c0 = (u.pn - 8) * 256; }
            const int col0 = c0 + wc * 32 + 8 * fq;
            EPI_LOOP_AM { bf16* rowp = base + (size_t)(row0 + ai * 128 + m * 16) * ldc + col0;
#pragma unroll
                for (int bj = 0; bj < 2; ++bj) st8(rowp + bj * 128, acc[ai][bj][m][0], acc[ai][bj][m][1]); }
        }
    }
};
struct EpiBf16Plain { static constexpr bool PERM = true, PREF = false, ACCINIT = false; bf16* O; int ldc;
    __device__ __forceinline__ void operator()(EPI_ARGS) const {
        const int row0 = u.pm * 256 + wr * 64 + fr, col0 = u.pn * 256 + wc * 32 + 8 * fq;
        EPI_LOOP_AM { bf16* rowp = O + (size_t)(row0 + ai * 128 + m * 16) * ldc + col0;
#pragma unroll
            for (int bj = 0; bj < 2; ++bj) st8(rowp + bj * 128, acc[ai][bj][m][0], acc[ai][bj][m][1]); }
    }
};
struct EpiF32 { static constexpr bool PERM = false, PREF = false, ACCINIT = false; float* C; int ldc;
    __device__ __forceinline__ void operator()(EPI_ARGS) const {
        const int row0 = u.pm * 256 + wr * 64 + fr, col0 = u.pn * 256 + wc * 32 + 4 * fq;
        EPI_LOOP_AM { float* rowp = C + (size_t)(row0 + ai * 128 + m * 16) * ldc + col0;
#pragma unroll
            for (int bj = 0; bj < 2; ++bj)
#pragma unroll
                for (int n = 0; n < 2; ++n) *(f32x4*)(rowp + bj * 128 + n * 16) = acc[ai][bj][m][n]; }
    }
};
struct EpiS5Y { static constexpr bool PERM = true, PREF = false, ACCINIT = false; const bf16* AG; const float* dskip; bf16* Y1;
    __device__ __forceinline__ void operator()(EPI_ARGS) const {
        const int g = u.pm >> 2, crow0 = (u.pm & 3) * 256 + wr * 64 + fr, col0 = u.pn * 256 + wc * 32 + 8 * fq;
        EPI_LOOP_AM { const int crow = crow0 + ai * 128 + m * 16;
#pragma unroll
            for (int bj = 0; bj < 2; ++bj) { const int col = col0 + bj * 128, t = col >> 4, c = col & 15;
                f32x4 u0, u1; ld8(AG + ((size_t)(g * 1024 + crow)) * 640 + col, u0, u1);
                const f32x4 d0 = *(const f32x4*)(dskip + g * 16 + c), d1 = *(const f32x4*)(dskip + g * 16 + c + 4);
                f32x4 v0 = acc[ai][bj][m][0] + d0 * u0, v1 = acc[ai][bj][m][1] + d1 * u1;
#pragma unroll
                for (int j = 0; j < 4; ++j) { v0[j] = gelu_tanh(v0[j]); v1[j] = gelu_tanh(v1[j]); }
                st8(Y1 + (size_t)(crow * 32 + t) * 512 + g * 16 + c, v0, v1); } }
    }
};
struct EpiGlu { static constexpr bool PERM = true, PREF = false, ACCINIT = false; const bf16* Y1; bf16* MIX;
    __device__ __forceinline__ void operator()(EPI_ARGS) const {
        const int row0 = u.pm * 256 + wr * 64 + fr, col0 = u.pn * 256 + wc * 32 + 8 * fq;
        EPI_LOOP_AM { const int row = row0 + ai * 128 + m * 16;
#pragma unroll
            for (int bj = 0; bj < 2; ++bj) { const int col = col0 + bj * 128; f32x4 y0, y1v; ld8(Y1 + (size_t)row * 512 + col, y0, y1v);
                f32x4 v0, v1;
#pragma unroll
                for (int j = 0; j < 4; ++j) { v0[j] = y0[j] * fsigmoid(acc[ai][bj][m][0][j]); v1[j] = y1v[j] * fsigmoid(acc[ai][bj][m][1][j]); }
                st8(MIX + (size_t)row * 1024 + col, v0, v1); } }
    }
};
struct EpiResid { static constexpr bool PERM = true, PREF = false, ACCINIT = false; const float* X; bf16* O;
    __device__ __forceinline__ void operator()(EPI_ARGS) const {
        const int row0 = u.pm * 256 + wr * 64 + fr, col0 = u.pn * 256 + wc * 32 + 8 * fq;
        EPI_LOOP_AM { const size_t off = (size_t)(row0 + ai * 128 + m * 16) * 1024 + col0;
#pragma unroll
            for (int bj = 0; bj < 2; ++bj) { const f32x4 x0 = __builtin_nontemporal_load((const f32x4*)(X + off + bj * 128)), x1 = __builtin_nontemporal_load((const f32x4*)(X + off + bj * 128 + 4)); st8(O + off + bj * 128, x0 + acc[ai][bj][m][0], x1 + acc[ai][bj][m][1]); } }
    }
};
struct EpiGU { static constexpr bool PERM = true, PREF = true, ACCINIT = true; unsigned char* ACT; const float* bg; const float* bu;
    __device__ __forceinline__ void pref(LAS unsigned char* pf, const Unit& u, int wc, int lane) const {
        const float* src = ((lane & 32) ? bu : bg) + u.aux * 1024 + u.pn * 128 + wc * 32 + (lane & 31);
        __builtin_amdgcn_global_load_lds((const unsigned*)src, (LAS unsigned*)pf, 4, 0, 0); }
    __device__ __forceinline__ void init(f32x4 (&acc)[2][2][4][2], const LAS unsigned char* pf, int fq) const {
        const f32x4 one = {1.f, 1.f, 1.f, 1.f};
        const f32x4 g0 = *(const LAS f32x4*)(pf + 32 * fq), g1 = *(const LAS f32x4*)(pf + 32 * fq + 16), u0 = *(const LAS f32x4*)(pf + 128 + 32 * fq) + one, u1 = *(const LAS f32x4*)(pf + 128 + 32 * fq + 16) + one;
#pragma unroll
        for (int ai = 0; ai < 2; ++ai)
#pragma unroll
            for (int m = 0; m < 4; ++m) { acc[ai][0][m][0] = g0; acc[ai][0][m][1] = g1; acc[ai][1][m][0] = u0; acc[ai][1][m][1] = u1; } }
    __device__ __forceinline__ void operator()(EPI_ARGS) const {
        const int row0 = u.pm * 256 + wr * 64 + fr + (fq & 1) * 16, col = u.pn * 128 + wc * 32 + (fq >> 1) * 16;
#pragma unroll
        for (int ai = 0; ai < 2; ++ai)
#pragma unroll
            for (int mp = 0; mp < 2; ++mp) { u32x2 w[2];
#pragma unroll
                for (int q = 0; q < 2; ++q) { const int m = 2 * mp + q; f32x4 v0, v1;
#pragma unroll
                    for (int j = 0; j < 4; ++j) {
                        const float gt0 = fminf(acc[ai][0][m][0][j], 7.0f), up0 = __builtin_amdgcn_fmed3f(acc[ai][1][m][0][j], -6.0f, 8.0f);
                        const float gt1 = fminf(acc[ai][0][m][1][j], 7.0f), up1 = __builtin_amdgcn_fmed3f(acc[ai][1][m][1][j], -6.0f, 8.0f);
                        v0[j] = (up0 * gt0) * frcp(1.0f + __builtin_amdgcn_exp2f(gt0 * -2.4554669f)); v1[j] = (up1 * gt1) * frcp(1.0f + __builtin_amdgcn_exp2f(gt1 * -2.4554669f)); }
                    w[q].x = pk4_fp8(v0[0], v0[1], v0[2], v0[3]); w[q].y = pk4_fp8(v1[0], v1[1], v1[2], v1[3]); }
                const auto rx = __builtin_amdgcn_permlane16_swap(w[0].x, w[1].x, false, false), ry = __builtin_amdgcn_permlane16_swap(w[0].y, w[1].y, false, false);
                *(u32x4*)(ACT + (size_t)(row0 + ai * 128 + mp * 32) * 1024 + col) = (u32x4){rx[0], ry[0], rx[1], ry[1]}; }
    }
};
struct EpiDown { static constexpr bool PERM = true, PREF = true, ACCINIT = true; unsigned char* Y; const float* bd;
    __device__ __forceinline__ void pref(LAS unsigned char* pf, const Unit& u, int wc, int lane) const {
        const float* src = bd + u.aux * 1024 + u.pn * 256 + (lane >> 5) * 128 + wc * 32 + (lane & 31);
        __builtin_amdgcn_global_load_lds((const unsigned*)src, (LAS unsigned*)pf, 4, 0, 0); }
    __device__ __forceinline__ void init(f32x4 (&acc)[2][2][4][2], const LAS unsigned char* pf, int fq) const {
#pragma unroll
        for (int bj = 0; bj < 2; ++bj) { const f32x4 b0 = *(const LAS f32x4*)(pf + 128 * bj + 32 * fq), b1 = *(const LAS f32x4*)(pf + 128 * bj + 32 * fq + 16);
#pragma unroll
            for (int ai = 0; ai < 2; ++ai)
#pragma unroll
                for (int m = 0; m < 4; ++m) { acc[ai][bj][m][0] = b0; acc[ai][bj][m][1] = b1; } } }
    __device__ __forceinline__ void operator()(EPI_ARGS) const {
        const int row0 = u.pm * 256 + wr * 64 + fr, col0 = u.pn * 256 + wc * 32 + (fq >> 1) * 16 + (fq & 1) * 128;
        EPI_LOOP_AM { unsigned char* rowp = Y + (size_t)(row0 + ai * 128 + m * 16) * 1024 + col0; u32x2 w[2];
#pragma unroll
            for (int bj = 0; bj < 2; ++bj) { const f32x4 v0 = acc[ai][bj][m][0], v1 = acc[ai][bj][m][1]; w[bj].x = pk4_fp8(v0[0], v0[1], v0[2], v0[3]); w[bj].y = pk4_fp8(v1[0], v1[1], v1[2], v1[3]); }
            const auto rx = __builtin_amdgcn_permlane16_swap(w[0].x, w[1].x, false, false), ry = __builtin_amdgcn_permlane16_swap(w[0].y, w[1].y, false, false);
            *(u32x4*)rowp = (u32x4){rx[0], ry[0], rx[1], ry[1]}; }
    }
};
struct EpiPle { static constexpr bool PERM = true, PREF = false, ACCINIT = false; const bf16* PP; bf16* O;
    __device__ __forceinline__ void operator()(EPI_ARGS) const {
        const int row0 = u.pm * 256 + wr * 64 + fr, col0 = u.pn * 256 + wc * 32 + 8 * fq;
        EPI_LOOP_AM { const size_t off = (size_t)(row0 + ai * 128 + m * 16) * 1024 + col0;
#pragma unroll
            for (int bj = 0; bj < 2; ++bj) { f32x4 p0, p1, x0, x1; ld8(PP + off + bj * 128, p0, p1); ld8(O + off + bj * 128, x0, x1);
#pragma unroll
                for (int j = 0; j < 4; ++j) { x0[j] += p0[j] * fsigmoid(acc[ai][bj][m][0][j]); x1[j] += p1[j] * fsigmoid(acc[ai][bj][m][1][j]); }
                st8(O + off + bj * 128, x0, x1); } }
    }
};

struct EpiNull { static constexpr bool PERM = true, PREF = false, ACCINIT = false; __device__ __forceinline__ void operator()(EPI_ARGS) const { } };
struct EpiPleNorm { static constexpr bool PERM = true, PREF = false, ACCINIT = false; const bf16* PP; const bf16* XIN; float* OUT; const float* gfin; float* rowss; unsigned* pcnt;
    __device__ __forceinline__ void operator()(EPI_ARGS) const {
        const int row0 = u.pm * 256 + wr * 64 + fr, col0 = u.pn * 256 + wc * 32 + 8 * fq;
        EPI_LOOP_AM { const size_t off = (size_t)(row0 + ai * 128 + m * 16) * 1024 + col0; float s = 0.f;
#pragma unroll
            for (int bj = 0; bj < 2; ++bj) { f32x4 p0, p1, x0, x1; ld8(PP + off + bj * 128, p0, p1); ld8(XIN + off + bj * 128, x0, x1);
#pragma unroll
                for (int j = 0; j < 4; ++j) { x0[j] += p0[j] * fsigmoid(acc[ai][bj][m][0][j]); x1[j] += p1[j] * fsigmoid(acc[ai][bj][m][1][j]); s += x0[j] * x0[j] + x1[j] * x1[j]; }
                acc[ai][bj][m][0] = x0; acc[ai][bj][m][1] = x1; }
            s += __shfl_xor(s, 16); s += __shfl_xor(s, 32);
            if (fq == 0) atomicAdd(rowss + row0 + ai * 128 + m * 16, s); }
        asm volatile("s_waitcnt vmcnt(0)" ::: "memory");
        unsigned* cnt = pcnt + 64 * u.pm;
        if ((fr | fq) == 0) __hip_atomic_fetch_add(cnt, 1u, __ATOMIC_RELAXED, __HIP_MEMORY_SCOPE_AGENT);
        { unsigned sp = 0; while (__builtin_amdgcn_readfirstlane(__hip_atomic_load(cnt, __ATOMIC_RELAXED, __HIP_MEMORY_SCOPE_AGENT)) < 32u) { __builtin_amdgcn_s_sleep(2); if (++sp > (1u << 22)) break; } }
        f32x4 gv[2][2];
#pragma unroll
        for (int bj = 0; bj < 2; ++bj) { gv[bj][0] = *(const f32x4*)(gfin + col0 + bj * 128); gv[bj][1] = *(const f32x4*)(gfin + col0 + bj * 128 + 4); }
        EPI_LOOP_AM { const int row = row0 + ai * 128 + m * 16; const float ssr = __hip_atomic_load(rowss + row, __ATOMIC_RELAXED, __HIP_MEMORY_SCOPE_AGENT); const float rinv = rsqrtf(ssr * (1.f / 1024.f) + 1e-6f);
            float* orow = OUT + (size_t)row * 1024 + col0;
#pragma unroll
            for (int bj = 0; bj < 2; ++bj) { __builtin_nontemporal_store(acc[ai][bj][m][0] * rinv * gv[bj][0], (f32x4*)(orow + bj * 128)); __builtin_nontemporal_store(acc[ai][bj][m][1] * rinv * gv[bj][1], (f32x4*)(orow + bj * 128 + 4)); } }
    }
};

struct Ctx { LAS unsigned char* lds; int tid, lane, wave, G, wg, gw, NGW; };

template <int NBW>
__device__ __forceinline__ void transpose_item(const float* W, int N, int k0, int n0, bf16* dst, int ldk, const float* scl, int flip, LAS float* scr, int lane) {
    constexpr int LPR = NBW / 4, RPI = 64 / LPR, NI = 64 / RPI;
    const int rr = lane / LPR, cc = (lane % LPR) * 4;
    f32x4 v[NI];
#pragma unroll
    for (int i = 0; i < NI; ++i) v[i] = *(const f32x4*)(W + (size_t)(k0 + i * RPI + rr) * N + n0 + cc);
#pragma unroll
    for (int i = 0; i < NI; ++i) { const int kk = i * RPI + rr; f32x4 x = v[i];
        if (scl) { const float s0 = scl[k0 + kk]; const float f = flip ? (1.0f - s0) : s0; x = x * f; }
        LAS float* d = scr + kk * 65 + cc; d[0] = x.x; d[1] = x.y; d[2] = x.z; d[3] = x.w; }
    LDS_WAIT(); asm volatile("" ::: "memory");
    const int c = lane & 7;
#pragma unroll
    for (int j = 0; j < NBW / 8; ++j) { const int n = (lane >> 3) + 8 * j; const LAS float* s = scr + (8 * c) * 65 + n;
        u32x4 o; o.x = pk2(s[0 * 65], s[1 * 65]); o.y = pk2(s[2 * 65], s[3 * 65]); o.z = pk2(s[4 * 65], s[5 * 65]); o.w = pk2(s[6 * 65], s[7 * 65]);
        *(u32x4*)(dst + (size_t)n * ldk + 8 * c) = o; }
    LDS_WAIT(); asm volatile("" ::: "memory");
}
struct F8Item { f32x4 v[16]; };
__device__ __forceinline__ void f8_issue(const float* W, int N, int k0, int n0, int lane, F8Item& it) {
    const int rr = lane >> 4, cc = (lane & 15) * 4;
#pragma unroll
    for (int i = 0; i < 16; ++i) it.v[i] = __builtin_nontemporal_load((const f32x4*)(W + (size_t)(k0 + i * 4 + rr) * N + n0 + cc));
}
__device__ __forceinline__ void f8_finish(const F8Item& it, unsigned char* dst, int ldk, float scale, LAS float* scr, int lane) {
    const int rr = lane >> 4, cc = (lane & 15) * 4;
#pragma unroll
    for (int i = 0; i < 16; ++i) { const int kk = i * 4 + rr; LAS float* d = scr + kk * 65 + cc; d[0] = it.v[i].x * scale; d[1] = it.v[i].y * scale; d[2] = it.v[i].z * scale; d[3] = it.v[i].w * scale; }
    LDS_WAIT(); asm volatile("" ::: "memory");
    const int c = lane & 3;
#pragma unroll
    for (int j = 0; j < 4; ++j) { const int n = (lane >> 2) + 16 * j; const LAS float* s = scr + (16 * c) * 65 + n;
        u32x4 o; o.x = pk4_fp8(s[0 * 65], s[1 * 65], s[2 * 65], s[3 * 65]); o.y = pk4_fp8(s[4 * 65], s[5 * 65], s[6 * 65], s[7 * 65]); o.z = pk4_fp8(s[8 * 65], s[9 * 65], s[10 * 65], s[11 * 65]); o.w = pk4_fp8(s[12 * 65], s[13 * 65], s[14 * 65], s[15 * 65]);
        *(u32x4*)(dst + (size_t)n * ldk + 16 * c) = o; }
    LDS_WAIT(); asm volatile("" ::: "memory");
}
__device__ __forceinline__ void transpose_item_fp8(const float* W, int N, int k0, int n0, unsigned char* dst, int ldk, float scale, LAS float* scr, int lane) {
    F8Item it; f8_issue(W, N, k0, n0, lane, it); f8_finish(it, dst, ldk, scale, scr, lane);
}
__device__ __forceinline__ void transpose_matrix(const Ctx& cx, const float* W, int K, int N, bf16* WT, int row_off, int ldk, int koff, const float* scl, int flip) {
    LAS float* scr = (LAS float*)(cx.lds + cx.wave * 16640);
    const int nblk = N / 64, nitems = (K / 64) * nblk;
    for (int it = cx.gw; it < nitems; it += cx.NGW) { const int kb = it / nblk, nb = it % nblk;
        transpose_item<64>(W, N, 64 * kb, 64 * nb, WT + (size_t)(row_off + 64 * nb) * ldk + koff + 64 * kb, ldk, scl, flip, scr, cx.lane); }
}
__device__ __forceinline__ void rms_row_to_bf16(const float* xrow, const float* g, bf16* orow, int lane) {
    const f32x4* xr = (const f32x4*)xrow + lane; const f32x4* gr = (const f32x4*)g + lane;
    f32x4 v[4]; float s = 0.f;
#pragma unroll
    for (int j = 0; j < 4; ++j) { v[j] = xr[64 * j]; s += (v[j].x * v[j].x + v[j].y * v[j].y) + (v[j].z * v[j].z + v[j].w * v[j].w); }
    const float rinv = rsqrtf(wave_sum(s) * (1.f / 1024.f) + 1e-6f);
    u32x2* o8 = (u32x2*)orow + lane;
#pragma unroll
    for (int j = 0; j < 4; ++j) { const f32x4 gg = gr[64 * j]; u32x2 w; w.x = pk2(v[j].x * rinv * gg.x, v[j].y * rinv * gg.y); w.y = pk2(v[j].z * rinv * gg.z, v[j].w * rinv * gg.w); o8[64 * j] = w; }
}

__device__ __forceinline__ void rms_rows2_to_bf16(const float* xa, const float* xb, const float* g, bf16* oa, bf16* ob, int lane) {
    const f32x4* ra = (const f32x4*)xa + lane; const f32x4* rb = (const f32x4*)xb + lane; const f32x4* gr = (const f32x4*)g + lane;
    f32x4 va[4], vb[4]; float sa = 0.f, sb = 0.f;
#pragma unroll
    for (int j = 0; j < 4; ++j) { va[j] = __builtin_nontemporal_load(ra + 64 * j); vb[j] = __builtin_nontemporal_load(rb + 64 * j); }
#pragma unroll
    for (int j = 0; j < 4; ++j) { sa += (va[j].x * va[j].x + va[j].y * va[j].y) + (va[j].z * va[j].z + va[j].w * va[j].w); sb += (vb[j].x * vb[j].x + vb[j].y * vb[j].y) + (vb[j].z * vb[j].z + vb[j].w * vb[j].w); }
#pragma unroll
    for (int o = 1; o < 64; o <<= 1) { sa += __shfl_xor(sa, o); sb += __shfl_xor(sb, o); }
    const float ia = rsqrtf(sa * (1.f / 1024.f) + 1e-6f), ib = rsqrtf(sb * (1.f / 1024.f) + 1e-6f);
    u32x2* pa = (u32x2*)oa + lane; u32x2* pb = (u32x2*)ob + lane;
#pragma unroll
    for (int j = 0; j < 4; ++j) { const f32x4 gg = gr[64 * j]; u32x2 w; w.x = pk2(va[j].x * ia * gg.x, va[j].y * ia * gg.y); w.y = pk2(va[j].z * ia * gg.z, va[j].w * ia * gg.w); pa[64 * j] = w;
        w.x = pk2(vb[j].x * ib * gg.x, vb[j].y * ib * gg.y); w.y = pk2(vb[j].z * ib * gg.z, vb[j].w * ib * gg.w); pb[64 * j] = w; }
}

__device__ __forceinline__ void s5_tables_item(const Ctx& cx, int g, int part, const float* lam_re, const float* lam_im, const float* log_dt, const float* b_re, const float* b_im, const float* c_re, const float* c_im,
                                               bf16* BT, bf16* ET, float* AT) {
    LAS float* apr = (LAS float*)cx.lds; LAS float* api = apr + 33 * 64; LAS float* bbr = api + 33 * 64; LAS float* bbi = bbr + 1024; LAS float* cr = bbi + 1024; LAS float* ci = cr + 1024; LAS float* kt = ci + 1024;
    const int tid = cx.tid;
    const float dt = __expf(log_dt[g]);
    for (int idx = tid; idx < 33 * 64; idx += NTHR) { const int j = idx >> 6, p = idx & 63;
        const float lre = fminf(lam_re[g * 64 + p], -1e-4f), lim = lam_im[g * 64 + p];
        const float mag = expf(lre * dt * (float)j), ang = lim * dt * (float)j; float sn, cs; sincosf(ang, &sn, &cs);
        apr[idx] = mag * cs; api[idx] = mag * sn; }
    for (int idx = tid; idx < 1024; idx += NTHR) { const int p = idx >> 4;
        const float lre = fminf(lam_re[g * 64 + p], -1e-4f), lim = lam_im[g * 64 + p];
        const float mag = expf(lre * dt); float sn, cs; sincosf(lim * dt, &sn, &cs); const float lbr = mag * cs, lbi = mag * sn;
        const float den = lre * lre + lim * lim, zr = lbr - 1.0f; const float cor = (zr * lre + lbi * lim) / den, coi = (lbi * lre - zr * lim) / den;
        const float br = b_re[g * 1024 + idx], bi = b_im[g * 1024 + idx];
        bbr[idx] = cor * br - coi * bi; bbi[idx] = cor * bi + coi * br;
        cr[idx] = c_re[g * 1024 + idx]; ci[idx] = c_im[g * 1024 + idx]; }
    __syncthreads();
    if (tid < 64) { const int jl = tid >> 4, c = tid & 15, j = 4 * part + jl; float acc[16];
#pragma unroll
        for (int i = 0; i < 16; ++i) acc[i] = 0.f;
        for (int p = 0; p < 64; ++p) { const float ar = apr[j * 64 + p], ai = api[j * 64 + p], xr = cr[c * 64 + p], xi = ci[c * 64 + p];
            const float car = xr * ar - xi * ai, cai = xr * ai + xi * ar;
#pragma unroll
            for (int v4 = 0; v4 < 4; ++v4) { const f32x4 br = *(const LAS f32x4*)(bbr + p * 16 + 4 * v4), bi = *(const LAS f32x4*)(bbi + p * 16 + 4 * v4);
                acc[4 * v4 + 0] += car * br.x - cai * bi.x; acc[4 * v4 + 1] += car * br.y - cai * bi.y; acc[4 * v4 + 2] += car * br.z - cai * bi.z; acc[4 * v4 + 3] += car * br.w - cai * bi.w; } }
#pragma unroll
        for (int i = 0; i < 16; ++i) kt[jl * 256 + c * 16 + i] = acc[i]; }
    __syncthreads();
    bf16* BTg = BT + (size_t)g * 512 * 640; bf16* ETg = ET + (size_t)g * 256 * 512;
    for (int idx = tid; idx < 4096; idx += NTHR) { const int hf = idx & 1, c = (idx >> 1) & 15, t = (idx >> 5) & 31, jl = idx >> 10, j = 4 * part + jl;
        if (t >= j) { const LAS float* s = kt + jl * 256 + c * 16 + hf * 8; u32x4 o; o.x = pk2(s[0], s[1]); o.y = pk2(s[2], s[3]); o.z = pk2(s[4], s[5]); o.w = pk2(s[6], s[7]);
            *(u32x4*)(BTg + (size_t)(t * 16 + c) * 640 + (t - j) * 16 + hf * 8) = o; } }
    for (int idx = tid; idx < 4096; idx += NTHR) { const int hf = idx & 1, c = (idx >> 1) & 15, s = (idx >> 5) & 31, t = 4 * part + (idx >> 10);
        if (s > t) *(u32x4*)(BTg + (size_t)(t * 16 + c) * 640 + s * 16 + hf * 8) = (u32x4){0u, 0u, 0u, 0u}; }
    for (int idx = tid; idx < 1024; idx += NTHR) { const int ch = idx & 15, c = (idx >> 4) & 15, t = 4 * part + (idx >> 8); const int im = ch >> 3, p0 = (ch & 7) * 8; float v[8];
#pragma unroll
        for (int q = 0; q < 8; ++q) { const int p = p0 + q; const float ar = apr[(t + 1) * 64 + p], ai = api[(t + 1) * 64 + p], xr = cr[c * 64 + p], xi = ci[c * 64 + p];
            v[q] = im ? -(xr * ai + xi * ar) : (xr * ar - xi * ai); }
        u32x4 o; o.x = pk2(v[0], v[1]); o.y = pk2(v[2], v[3]); o.z = pk2(v[4], v[5]); o.w = pk2(v[6], v[7]);
        *(u32x4*)(BTg + (size_t)(t * 16 + c) * 640 + 512 + im * 64 + p0) = o; }
    for (int idx = tid; idx < 1024; idx += NTHR) { const int hf = idx & 1, sl = (idx >> 1) & 3, n = idx >> 3, s = 4 * part + sl, p = n & 63, im = n >> 6; float v[8];
        const float ar = apr[(31 - s) * 64 + p], ai = api[(31 - s) * 64 + p];
#pragma unroll
        for (int q = 0; q < 8; ++q) { const float br = bbr[p * 16 + hf * 8 + q], bi = bbi[p * 16 + hf * 8 + q]; v[q] = im ? (ar * bi + ai * br) : (ar * br - ai * bi); }
        u32x4 o; o.x = pk2(v[0], v[1]); o.y = pk2(v[2], v[3]); o.z = pk2(v[4], v[5]); o.w = pk2(v[6], v[7]);
        *(u32x4*)(ETg + (size_t)n * 512 + s * 16 + hf * 8) = o; }
    for (int idx = tid; idx < 1024; idx += NTHR) { const int ch = idx & 63, r = 128 + 16 * part + (idx >> 6); *(u32x4*)(ETg + (size_t)r * 512 + ch * 8) = (u32x4){0u, 0u, 0u, 0u}; }
    if (part == 0 && tid < 64) { AT[(g * 64 + tid) * 2] = apr[32 * 64 + tid]; AT[(g * 64 + tid) * 2 + 1] = api[32 * 64 + tid]; }
    __syncthreads();
}

constexpr int IMG_LD = 80, IMG_B = 64 * IMG_LD * 2;
#define IMG(k) ((LAS bf16*)(lds + (k) * IMG_B))
#define LDS_BARRIER() do { asm volatile("s_waitcnt lgkmcnt(0)" ::: "memory"); __builtin_amdgcn_s_barrier(); asm volatile("" ::: "memory"); } while (0)
struct MmCtx { int tr, tc0, l15, q; };
__device__ __forceinline__ void mm64(const LAS bf16* A, const LAS bf16* Bt, f32x4 (&acc)[2], const MmCtx& w) {
#pragma unroll
    for (int s = 0; s < 2; ++s) {
        const bf16x8 a = *(const LAS bf16x8*)(A + (16 * w.tr + w.l15) * IMG_LD + 32 * s + 8 * w.q);
#pragma unroll
        for (int c = 0; c < 2; ++c) { const bf16x8 b = *(const LAS bf16x8*)(Bt + (16 * (w.tc0 + c) + w.l15) * IMG_LD + 32 * s + 8 * w.q);
            acc[c] = __builtin_amdgcn_mfma_f32_16x16x32_bf16(a, b, acc[c], 0, 0, 0); }
    }
}
__device__ __forceinline__ void mm64_2a(const LAS bf16* A1, const LAS bf16* A2, const LAS bf16* Bt, f32x4 (&acc1)[2], f32x4 (&acc2)[2], const MmCtx& w) {
#pragma unroll
    for (int s = 0; s < 2; ++s) {
        const bf16x8 a1 = *(const LAS bf16x8*)(A1 + (16 * w.tr + w.l15) * IMG_LD + 32 * s + 8 * w.q), a2 = *(const LAS bf16x8*)(A2 + (16 * w.tr + w.l15) * IMG_LD + 32 * s + 8 * w.q);
#pragma unroll
        for (int c = 0; c < 2; ++c) { const bf16x8 b = *(const LAS bf16x8*)(Bt + (16 * (w.tc0 + c) + w.l15) * IMG_LD + 32 * s + 8 * w.q);
            acc1[c] = __builtin_amdgcn_mfma_f32_16x16x32_bf16(a1, b, acc1[c], 0, 0, 0); acc2[c] = __builtin_amdgcn_mfma_f32_16x16x32_bf16(a2, b, acc2[c], 0, 0, 0); }
    }
}
__device__ __forceinline__ void mm64_2b(const LAS bf16* A, const LAS bf16* Bt1, const LAS bf16* Bt2, f32x4 (&acc1)[2], f32x4 (&acc2)[2], const MmCtx& w) {
#pragma unroll
    for (int s = 0; s < 2; ++s) {
        const bf16x8 a = *(const LAS bf16x8*)(A + (16 * w.tr + w.l15) * IMG_LD + 32 * s + 8 * w.q);
#pragma unroll
        for (int c = 0; c < 2; ++c) { const bf16x8 b1 = *(const LAS bf16x8*)(Bt1 + (16 * (w.tc0 + c) + w.l15) * IMG_LD + 32 * s + 8 * w.q), b2 = *(const LAS bf16x8*)(Bt2 + (16 * (w.tc0 + c) + w.l15) * IMG_LD + 32 * s + 8 * w.q);
            acc1[c] = __builtin_amdgcn_mfma_f32_16x16x32_bf16(a, b1, acc1[c], 0, 0, 0); acc2[c] = __builtin_amdgcn_mfma_f32_16x16x32_bf16(a, b2, acc2[c], 0, 0, 0); }
    }
}
__device__ __forceinline__ float dpp_x1(float v) { return __int_as_float(__builtin_amdgcn_update_dpp(0, __float_as_int(v), 0xB1, 0xF, 0xF, true)); }
__device__ __forceinline__ float dpp_x2(float v) { return __int_as_float(__builtin_amdgcn_update_dpp(0, __float_as_int(v), 0x4E, 0xF, 0xF, true)); }
__device__ __forceinline__ f32x4 quad_transpose(const f32x4 v, int b) {
    const bool odd = (b & 1) != 0, hi = (b & 2) != 0;
    const float r0 = dpp_x1(odd ? v[0] : v[1]), r1 = dpp_x1(odd ? v[2] : v[3]);
    const float p0a = odd ? r0 : v[0], p0b = odd ? v[1] : r0, p1a = odd ? r1 : v[2], p1b = odd ? v[3] : r1;
    const float ra = dpp_x2(hi ? p0a : p1a), rb = dpp_x2(hi ? p0b : p1b);
    return hi ? (f32x4){ra, rb, p1a, p1b} : (f32x4){p0a, p0b, ra, rb};
}
__device__ __forceinline__ void st_rm(LAS bf16* img, const f32x4 v, int tr, int tc, const MmCtx& w) {
    const unsigned p01 = pk2(v[0], v[1]), p23 = pk2(v[2], v[3]); LAS bf16* d = img + (16 * tr + 4 * w.q) * IMG_LD + 16 * tc + w.l15;
    d[0] = (bf16)p01; d[IMG_LD] = (bf16)(p01 >> 16); d[2 * IMG_LD] = (bf16)p23; d[3 * IMG_LD] = (bf16)(p23 >> 16);
}
__device__ __forceinline__ void st_tr(LAS bf16* img, const f32x4 v, int tr, int tc, const MmCtx& w) {
    u32x2 o; o.x = pk2(v[0], v[1]); o.y = pk2(v[2], v[3]); *(LAS u32x2*)(img + (16 * tc + w.l15) * IMG_LD + 16 * tr + 4 * w.q) = o;
}
__device__ __forceinline__ void img_to_global(const LAS bf16* img, bf16* g, int tid) { const int row = tid >> 3, ch = tid & 7; *(u32x4*)(g + row * 64 + ch * 8) = *(const LAS u32x4*)(img + row * IMG_LD + ch * 8); }
__device__ __forceinline__ void st_tm8(LAS bf16* img, int t, int cg, const float (&v)[8]) {
    u32x4 o; o.x = pk2(v[0], v[1]); o.y = pk2(v[2], v[3]); o.z = pk2(v[4], v[5]); o.w = pk2(v[6], v[7]); *(LAS u32x4*)(img + t * IMG_LD + 8 * cg) = o;
}
__device__ __forceinline__ void st_cm8(LAS bf16* img, int t, int cg, const float (&v)[8]) {
#pragma unroll
    for (int i = 0; i < 8; i += 2) { const unsigned p = pk2(v[i], v[i + 1]); img[(8 * cg + i) * IMG_LD + t] = (bf16)p; img[(8 * cg + i + 1) * IMG_LD + t] = (bf16)(p >> 16); }
}
__device__ __forceinline__ float red8(float v) { v += __shfl_xor(v, 1); v += __shfl_xor(v, 2); v += __shfl_xor(v, 4); return v; }
__device__ __forceinline__ void unpack8(const u32x4 w, float (&o)[8]) { o[0] = lo16(w.x); o[1] = hi16(w.x); o[2] = lo16(w.y); o[3] = hi16(w.y); o[4] = lo16(w.z); o[5] = hi16(w.z); o[6] = lo16(w.w); o[7] = hi16(w.w); }
__device__ __forceinline__ void ldp8(const float* p, float (&o)[8]) { const f32x4 a = *(const f32x4*)p, b = *(const f32x4*)(p + 4); o[0] = a.x; o[1] = a.y; o[2] = a.z; o[3] = a.w; o[4] = b.x; o[5] = b.y; o[6] = b.z; o[7] = b.w; }

struct RwkvP { const bf16* rkv; const bf16* wag; const float *mu_rkv, *w0, *a0, *k_k, *k_a, *r_k, *ln_w, *ln_b; };
struct RwkvRaw { u32x4 kc, kp, vc, vp, wl, al, rc, rp, gg; };
template <bool PASS3>
__device__ __forceinline__ void rwkv_load(const RwkvP& P, int cidx, int tid, RwkvRaw& R) {
    const int t = tid >> 3, cg = tid & 7, bh = cidx >> 7, c = cidx & 127, b = bh >> 3, h = bh & 7, ch = h * 64 + 8 * cg;
    const size_t tok = (size_t)b * SEQ + c * 64 + t; const bool first = (c == 0 && t == 0);
    const bf16* row = P.rkv + tok * 1536 + ch; const bf16* prow = first ? row : row - 1536;
    R.kc = *(const u32x4*)(row + 512); R.vc = *(const u32x4*)(row + 1024); R.kp = *(const u32x4*)(prow + 512); R.vp = *(const u32x4*)(prow + 1024);
    R.wl = *(const u32x4*)(P.wag + tok * 1536 + ch); R.al = *(const u32x4*)(P.wag + tok * 1536 + 512 + ch);
    if (PASS3) { R.rc = *(const u32x4*)row; R.rp = *(const u32x4*)prow; R.gg = *(const u32x4*)(P.wag + tok * 1536 + 1024 + ch); }
}
constexpr int RC_OFF = 14 * IMG_B;
struct RwkvC { const LAS float* p; };
__device__ __forceinline__ void ldl8(const LAS float* p, float (&o)[8]) { const f32x4 a = *(const LAS f32x4*)p, b = *(const LAS f32x4*)(p + 4); o[0] = a.x; o[1] = a.y; o[2] = a.z; o[3] = a.w; o[4] = b.x; o[5] = b.y; o[6] = b.z; o[7] = b.w; }
__device__ __forceinline__ void rwkv_consts(LAS unsigned char* lds, const RwkvP& P, int h, int tid, RwkvC& C) {
    LAS float* base = (LAS float*)(lds + RC_OFF);
    if (tid < 64) { const int cg = tid >> 3, k = tid & 7, ch = h * 64 + 8 * cg; const float* src = k == 0 ? P.mu_rkv + ch : k == 1 ? P.mu_rkv + 512 + ch : k == 2 ? P.mu_rkv + 1024 + ch : k == 3 ? P.w0 + ch : k == 4 ? P.a0 + ch : k == 5 ? P.k_k + ch : P.k_a + ch;
        if (k < 7) { const f32x4 a = *(const f32x4*)src, b = *(const f32x4*)(src + 4); *(LAS f32x4*)(base + cg * 64 + k * 8) = a; *(LAS f32x4*)(base + cg * 64 + k * 8 + 4) = b; } }
    LDS_BARRIER();
    C.p = base + (tid & 7) * 64;
}
template <bool PASS3>
__device__ __forceinline__ void rwkv_prep(const RwkvRaw& R, const RwkvC& C, bool first, float (&kq)[8], float (&vv)[8], float (&rr)[8], float (&kap)[8], float (&bet)[8], float (&lw)[8]) {
    float kc[8], kp[8], vc[8], vp[8], k[8], wl[8], al[8], a[8], m[8];
    unpack8(R.kc, kc); unpack8(R.vc, vc); unpack8(R.kp, kp); unpack8(R.vp, vp); unpack8(R.wl, wl); unpack8(R.al, al);
    const float pm = first ? 0.f : 1.f;
    ldl8(C.p + 8, m);
#pragma unroll
    for (int i = 0; i < 8; ++i) k[i] = kc[i] + (pm * kp[i] - kc[i]) * m[i];
    ldl8(C.p + 16, m);
#pragma unroll
    for (int i = 0; i < 8; ++i) vv[i] = vc[i] + (pm * vp[i] - vc[i]) * m[i];
    if (PASS3) { float rc[8], rp[8]; unpack8(R.rc, rc); unpack8(R.rp, rp); ldl8(C.p, m);
#pragma unroll
        for (int i = 0; i < 8; ++i) rr[i] = rc[i] + (pm * rp[i] - rc[i]) * m[i];
    } else {
#pragma unroll
        for (int i = 0; i < 8; ++i) rr[i] = 0.f;
    }
    float ss = 0.f;
    ldl8(C.p + 24, m);
#pragma unroll
    for (int i = 0; i < 8; ++i) lw[i] = -0.6065306597126334f * fsigmoid(m[i] + wl[i]);
    ldl8(C.p + 32, m);
#pragma unroll
    for (int i = 0; i < 8; ++i) a[i] = fsigmoid(m[i] + al[i]);
    ldl8(C.p + 40, m);
#pragma unroll
    for (int i = 0; i < 8; ++i) { kap[i] = k[i] * m[i]; ss += kap[i] * kap[i]; }
    ss = red8(ss);
    const float inv = 1.0f / fmaxf(sqrtf(ss), 1e-12f);
    ldl8(C.p + 48, m);
#pragma unroll
    for (int i = 0; i < 8; ++i) { kap[i] *= inv; bet[i] = kap[i] * a[i]; kq[i] = k[i] * (1.0f + (a[i] - 1.0f) * m[i]); }
}
template <int SEGSLOT>
__device__ __forceinline__ void rwkv_cumsum(LAS unsigned char* lds, int tid, const float (&lw)[8], float (&cum)[8], float (&cumL)[8]) {
    LAS float* SEG = (LAS float*)(lds + SEGSLOT * IMG_B);
    const int lane = tid & 63, wv = tid >> 6, cg = tid & 7, tl = lane >> 3;
#pragma unroll
    for (int i = 0; i < 8; ++i) { float v = lw[i];
        { const float u = __shfl_up(v, 8); v += (tl >= 1) ? u : 0.f; }
        { const float u = __shfl_up(v, 16); v += (tl >= 2) ? u : 0.f; }
        { const float u = __shfl_up(v, 32); v += (tl >= 4) ? u : 0.f; }
        cum[i] = v; }
    if (tl == 7) {
#pragma unroll
        for (int i = 0; i < 8; ++i) SEG[wv * 64 + 8 * cg + i] = cum[i]; }
    LDS_BARRIER();
    float pre[8], tot[8];
#pragma unroll
    for (int i = 0; i < 8; ++i) { pre[i] = 0.f; tot[i] = 0.f; }
#pragma unroll 1
    for (int s2 = 0; s2 < 8; ++s2) { const f32x4 a = *(const LAS f32x4*)(SEG + s2 * 64 + 8 * cg), b = *(const LAS f32x4*)(SEG + s2 * 64 + 8 * cg + 4); const float m = (s2 < wv) ? 1.f : 0.f;
        tot[0] += a.x; tot[1] += a.y; tot[2] += a.z; tot[3] += a.w; tot[4] += b.x; tot[5] += b.y; tot[6] += b.z; tot[7] += b.w;
        pre[0] += m * a.x; pre[1] += m * a.y; pre[2] += m * a.z; pre[3] += m * a.w; pre[4] += m * b.x; pre[5] += m * b.y; pre[6] += m * b.z; pre[7] += m * b.w; }
#pragma unroll
    for (int i = 0; i < 8; ++i) { cum[i] += pre[i]; cumL[i] = tot[i]; }
}
#define Z4 (f32x4){0.f, 0.f, 0.f, 0.f}

__device__ __forceinline__ void rwkv_pass1(LAS unsigned char* lds, const RwkvP& P, int c0, int n, int tid, bf16* QCT, float* HCT, bf16* M1G, bf16* YLG, float* DLG, float* BONUS) {
    const int lane = tid & 63, wv = __builtin_amdgcn_readfirstlane(tid >> 6); MmCtx w; w.tr = wv >> 1; w.tc0 = (wv & 1) * 2; w.l15 = lane & 15; w.q = lane >> 4;
    const int t = tid >> 3, cg = tid & 7, ch = ((c0 >> 7) & 7) * 64 + 8 * cg;
    RwkvC C; rwkv_consts(lds, P, (c0 >> 7) & 7, tid, C);
    RwkvRaw R; rwkv_load<true>(P, c0, tid, R);
    for (int ci = 0; ci < n; ++ci) {
        const int cidx = c0 + ci;
        {
            float kq[8], vv[8], rr[8], kap[8], bet[8], lw[8], cum[8], cumL[8];
            rwkv_prep<true>(R, C, (cidx & 127) == 0 && t == 0, kq, vv, rr, kap, bet, lw);
            rwkv_cumsum<10>(lds, tid, lw, cum, cumL);
            { float bs = 0.f, rk[8]; ldp8(P.r_k + ch, rk);
#pragma unroll
              for (int i = 0; i < 8; ++i) bs += rr[i] * kq[i] * rk[i];
              bs = red8(bs); if (cg == 0) BONUS[(size_t)cidx * 64 + t] = bs; }
            float x[8], y[8];
#pragma unroll
            for (int i = 0; i < 8; ++i) { const float en = __expf(-cum[i]); x[i] = kq[i] * en; y[i] = bet[i] * en; }
            st_tm8(IMG(0), t, cg, x);
            st_tm8(IMG(1), t, cg, y);
#pragma unroll
            for (int i = 0; i < 8; ++i) x[i] = kap[i] * __expf(cum[i] - lw[i]);
            st_tm8(IMG(2), t, cg, x);
            st_cm8(IMG(3), t, cg, x);
#pragma unroll
            for (int i = 0; i < 8; ++i) x[i] = rr[i] * __expf(cum[i]);
            st_tm8(IMG(11), t, cg, x);
#pragma unroll
            for (int i = 0; i < 8; ++i) { const float eh = __expf(cumL[i] - cum[i]); x[i] = kq[i] * eh; y[i] = bet[i] * eh; }
            st_cm8(IMG(4), t, cg, x);
            st_cm8(IMG(5), t, cg, y);
            st_cm8(IMG(6), t, cg, vv);
            if (t == 0) {
#pragma unroll
                for (int i = 0; i < 8; ++i) DLG[(size_t)cidx * 64 + 8 * cg + i] = __expf(cumL[i]);
            }
        }
        if (ci + 1 < n) rwkv_load<true>(P, cidx + 1, tid, R);
        LDS_BARRIER();
        f32x4 accX[2];
        {
            f32x4 a[2] = {Z4, Z4}, kk[2] = {Z4, Z4};
            mm64_2a(IMG(1), IMG(0), IMG(2), a, kk, w);
#pragma unroll
            for (int c = 0; c < 2; ++c) { const int nn = 16 * (w.tc0 + c) + w.l15;
#pragma unroll
                for (int r = 0; r < 4; ++r) { const int m = 16 * w.tr + 4 * w.q + r; a[c][r] = (m < nn) ? a[c][r] : 0.f; kk[c][r] = (m < nn) ? kk[c][r] : 0.f; accX[c][r] = ((m == nn) ? 1.0f : 0.f) - a[c][r]; }
                st_rm(IMG(7), a[c], w.tr, w.tc0 + c, w); st_tr(IMG(8), a[c], w.tr, w.tc0 + c, w); st_rm(IMG(10), accX[c], w.tr, w.tc0 + c, w); st_rm(IMG(9), kk[c], w.tr, w.tc0 + c, w); }
        }
        LDS_BARRIER();
        {
            f32x4 p[2] = {Z4, Z4};
            mm64(IMG(7), IMG(8), p, w);
#pragma unroll
            for (int c = 0; c < 2; ++c) { st_rm(IMG(12), p[c], w.tr, w.tc0 + c, w); st_tr(IMG(13), p[c], w.tr, w.tc0 + c, w); }
        }
        LDS_BARRIER();
#define NEUMANN(XC, XN, PC, PTC, PN, PTN, LASTR) do { if (LASTR) { mm64(IMG(XC), IMG(PTC), accX, w); _Pragma("unroll") for (int c = 0; c < 2; ++c) st_tr(IMG(7), accX[c], w.tr, w.tc0 + c, w); }   \
            if (!(LASTR)) { f32x4 p[2] = {Z4, Z4}; mm64_2a(IMG(XC), IMG(PC), IMG(PTC), accX, p, w); \
                _Pragma("unroll") for (int c = 0; c < 2; ++c) { st_rm(IMG(PN), p[c], w.tr, w.tc0 + c, w); st_tr(IMG(PTN), p[c], w.tr, w.tc0 + c, w); st_rm(IMG(XN), accX[c], w.tr, w.tc0 + c, w); } } \
            LDS_BARRIER(); } while (0)
        NEUMANN(10, 2, 12, 13, 7, 8, false);
        NEUMANN(2, 10, 7, 8, 12, 13, false);
        NEUMANN(10, 2, 12, 13, 7, 8, false);
        NEUMANN(2, 10, 7, 8, 12, 13, false);
        NEUMANN(10, 2, 12, 13, 7, 8, true);
#undef NEUMANN
        {
            f32x4 a[2] = {Z4, Z4}, g[2] = {Z4, Z4}, kr[2] = {Z4, Z4}, br[2] = {Z4, Z4};
            mm64_2a(IMG(3), IMG(9), IMG(7), a, g, w); mm64_2b(IMG(11), IMG(0), IMG(1), kr, br, w);
#pragma unroll
            for (int c = 0; c < 2; ++c) { const int nn = 16 * (w.tc0 + c) + w.l15;
#pragma unroll
                for (int r = 0; r < 4; ++r) { const int m = 16 * w.tr + 4 * w.q + r; kr[c][r] = (nn <= m) ? kr[c][r] : 0.f; br[c][r] = (nn <= m) ? br[c][r] : 0.f; }
                st_rm(IMG(12), a[c], w.tr, w.tc0 + c, w); st_tr(IMG(8), g[c], w.tr, w.tc0 + c, w); st_rm(IMG(2), kr[c], w.tr, w.tc0 + c, w); st_rm(IMG(10), br[c], w.tr, w.tc0 + c, w); }
        }
        LDS_BARRIER();
        {
            f32x4 u[2] = {Z4, Z4}, qc[2] = {Z4, Z4}, m1[2] = {Z4, Z4};
            mm64(IMG(6), IMG(8), u, w); mm64(IMG(5), IMG(12), qc, w); mm64(IMG(10), IMG(12), m1, w);
#pragma unroll
            for (int c = 0; c < 2; ++c) { st_rm(IMG(13), u[c], w.tr, w.tc0 + c, w);
                const int tc = w.tc0 + c, cp = 32 * (tc >> 1) + 8 * (w.l15 >> 2) + 4 * (tc & 1) + (w.l15 & 3);
                const unsigned p01 = pk2(qc[c][0], qc[c][1]), p23 = pk2(qc[c][2], qc[c][3]); LAS bf16* d = IMG(0) + (16 * w.tr + 4 * w.q) * IMG_LD + cp;
                d[0] = (bf16)p01; d[IMG_LD] = (bf16)(p01 >> 16); d[2 * IMG_LD] = (bf16)p23; d[3 * IMG_LD] = (bf16)(p23 >> 16);
                f32x4 mv;
#pragma unroll
                for (int r = 0; r < 4; ++r) mv[r] = bf2f(IMG(11)[(16 * w.tr + 4 * w.q + r) * IMG_LD + 16 * tc + w.l15]) - m1[c][r];
                st_rm(IMG(1), mv, w.tr, tc, w); }
        }
        LDS_BARRIER();
        {
            f32x4 hp[2] = {Z4, Z4}, hn[2] = {Z4, Z4}, yp[2] = {Z4, Z4}, yn[2] = {Z4, Z4};
            mm64(IMG(4), IMG(6), hp, w); mm64(IMG(5), IMG(13), hn, w); mm64(IMG(2), IMG(6), yp, w); mm64(IMG(10), IMG(13), yn, w);
#pragma unroll
            for (int c = 0; c < 2; ++c) { *(f32x4*)(HCT + (((size_t)cidx * 16 + w.tr * 4 + w.tc0 + c) * 64 + lane) * 4) = hp[c] - hn[c]; st_rm(IMG(3), yp[c] - yn[c], w.tr, w.tc0 + c, w); }
            img_to_global(IMG(1), M1G + (size_t)cidx * 4096, tid);
            img_to_global(IMG(0), QCT + (size_t)cidx * 4096, tid);
        }
        LDS_BARRIER();
        img_to_global(IMG(3), YLG + (size_t)cidx * 4096, tid);
    }
}

constexpr int P2_SLOT = 12544, P2_DEPTH = 5;
__device__ __forceinline__ void rwkv_pass2(LAS unsigned char* lds, int bh, int ti, int lane, const bf16* QCT, const float* HCT, const float* DLG, bf16* S0G) {
    const int l15 = lane & 15, q = lane >> 4;
    f32x4 X[4];
#pragma unroll
    for (int tj = 0; tj < 4; ++tj) X[tj] = Z4;
#define P2_DMA(cc) do { const size_t ci_ = (size_t)bh * 128 + (cc); LAS unsigned char* sl_ = lds + ((cc) % P2_DEPTH) * P2_SLOT; \
        _Pragma("unroll") for (int i = 0; i < 8; ++i) { const int row_ = i * 8 + (lane >> 3), pc_ = (lane & 7) ^ (row_ & 7); \
            __builtin_amdgcn_global_load_lds((const unsigned*)((const char*)QCT + (ci_ * 64 + row_) * 128 + pc_ * 16), (LAS unsigned*)(sl_ + i * 1024), 16, 0, 0); } \
        _Pragma("unroll") for (int tj = 0; tj < 4; ++tj) __builtin_amdgcn_global_load_lds((const unsigned*)((const char*)HCT + ((ci_ * 16 + tj * 4 + ti) * 64 + lane) * 16), (LAS unsigned*)(sl_ + 8192 + tj * 1024), 16, 0, 0); \
        __builtin_amdgcn_global_load_lds((const unsigned*)((const char*)DLG + (ci_ * 64 + lane) * 4), (LAS unsigned*)(sl_ + 12288), 4, 0, 0); } while (0)
    P2_DMA(0); P2_DMA(1); P2_DMA(2); P2_DMA(3);
    for (int c = 0; c < 128; ++c) {
        if (c < 124) asm volatile("s_waitcnt vmcnt(39)" ::: "memory"); else asm volatile("s_waitcnt vmcnt(0)" ::: "memory");
        const LAS unsigned char* sl = lds + (c % P2_DEPTH) * P2_SLOT;
        bf16x8 a[4][2]; f32x4 h[4], d[4];
#pragma unroll
        for (int tj = 0; tj < 4; ++tj) { const int row = 16 * tj + l15;
#pragma unroll
            for (int s = 0; s < 2; ++s) a[tj][s] = *(const LAS bf16x8*)(sl + row * 128 + (((4 * s + q) ^ (row & 7)) * 16));
            h[tj] = *(const LAS f32x4*)(sl + 8192 + tj * 1024 + lane * 16); d[tj] = *(const LAS f32x4*)(sl + 12288 + (16 * tj + 4 * q) * 4); }
        asm volatile("s_waitcnt lgkmcnt(0)" ::: "memory");
        if (c + 4 < 128) P2_DMA(c + 4);
        const size_t cidx = (size_t)bh * 128 + c;
#pragma unroll
        for (int tj = 0; tj < 4; ++tj) { u32x2 o; o.x = pk2(X[tj][0], X[tj][1]); o.y = pk2(X[tj][2], X[tj][3]); *(u32x2*)(S0G + (cidx * 64 + 16 * ti + l15) * 64 + 16 * tj + 4 * q) = o; }
        bf16x8 b[2];
#pragma unroll
        for (int s = 0; s < 2; ++s) { u32x4 o; o.x = pk2(X[2 * s][0], X[2 * s][1]); o.y = pk2(X[2 * s][2], X[2 * s][3]); o.z = pk2(X[2 * s + 1][0], X[2 * s + 1][1]); o.w = pk2(X[2 * s + 1][2], X[2 * s + 1][3]); b[s] = __builtin_bit_cast(bf16x8, o); }
#pragma unroll
        for (int tj = 0; tj < 4; ++tj) { f32x4 acc = Z4;
            acc = __builtin_amdgcn_mfma_f32_16x16x32_bf16(a[tj][0], b[0], acc, 0, 0, 0); acc = __builtin_amdgcn_mfma_f32_16x16x32_bf16(a[tj][1], b[1], acc, 0, 0, 0);
            X[tj] = d[tj] * X[tj] + h[tj] - acc; }
    }
    asm volatile("s_waitcnt vmcnt(0)" ::: "memory");
#undef P2_DMA
}

__device__ __forceinline__ void rwkv_pass3(LAS unsigned char* lds, const RwkvP& P, int c0, int n, int tid, const bf16* S0G, const bf16* M1G, const bf16* YLG, const float* BONUS, bf16* MIX) {
    const int lane = tid & 63, wv = __builtin_amdgcn_readfirstlane(tid >> 6); MmCtx w; w.tr = wv >> 1; w.tc0 = (wv & 1) * 2; w.l15 = lane & 15; w.q = lane >> 4;
    const int t = tid >> 3, cg = tid & 7, bh = c0 >> 7, b = bh >> 3, h = bh & 7, ch = h * 64 + 8 * cg;
    float muv[8], lnw[8], lnb[8]; ldp8(P.mu_rkv + 1024 + ch, muv); ldp8(P.ln_w + ch, lnw); ldp8(P.ln_b + ch, lnb);
    u32x4 gS0, gM1, gYL, gvc, gvp, ggg; float gbo;
#define P3_LOAD(cc) do { const int cidx_ = (cc), c_ = cidx_ & 127; const size_t o_ = (size_t)cidx_ * 4096 + (tid >> 3) * 64 + (tid & 7) * 8; gS0 = *(const u32x4*)(S0G + o_); gM1 = *(const u32x4*)(M1G + o_); gYL = *(const u32x4*)(YLG + o_); \
        const size_t tok_ = (size_t)b * SEQ + c_ * 64 + t; const bool first_ = (c_ == 0 && t == 0); const bf16* row_ = P.rkv + tok_ * 1536 + 1024 + ch; \
        gvc = *(const u32x4*)row_; gvp = *(const u32x4*)(first_ ? row_ : row_ - 1536); ggg = *(const u32x4*)(P.wag + tok_ * 1536 + 1024 + ch); gbo = BONUS[(size_t)cidx_ * 64 + t]; } while (0)
    P3_LOAD(c0);
    for (int ci = 0; ci < n; ++ci) {
        const int cidx = c0 + ci, c = cidx & 127;
        float vv[8], gg[8]; const float bonus = gbo;
        { float vc[8], vp[8]; unpack8(gvc, vc); unpack8(gvp, vp); unpack8(ggg, gg); const float pm = (c == 0 && t == 0) ? 0.f : 1.f;
#pragma unroll
          for (int i = 0; i < 8; ++i) vv[i] = vc[i] + (pm * vp[i] - vc[i]) * muv[i];
          const int row = tid >> 3, chk = tid & 7; *(LAS u32x4*)(IMG(0) + row * IMG_LD + chk * 8) = gM1; *(LAS u32x4*)(IMG(1) + row * IMG_LD + chk * 8) = gS0; *(LAS u32x4*)(IMG(2) + row * IMG_LD + chk * 8) = gYL; }
        if (ci + 1 < n) P3_LOAD(cidx + 1);
        LDS_BARRIER();
        {
            f32x4 y[2] = {Z4, Z4};
            mm64(IMG(0), IMG(1), y, w);
            LAS float* YF = (LAS float*)(lds + 10 * IMG_B);
#pragma unroll
            for (int cc = 0; cc < 2; ++cc)
#pragma unroll
                for (int r = 0; r < 4; ++r) { const int m = 16 * w.tr + 4 * w.q + r, nn = 16 * (w.tc0 + cc) + w.l15; YF[m * 65 + nn] = y[cc][r] + bf2f(IMG(2)[m * IMG_LD + nn]); }
        }
        LDS_BARRIER();
        {
            const LAS float* YF = (const LAS float*)(lds + 10 * IMG_B);
            float y[8], s = 0.f;
#pragma unroll
            for (int i = 0; i < 8; ++i) { y[i] = YF[t * 65 + 8 * cg + i]; s += y[i]; }
            const float mean = red8(s) * (1.0f / 64.0f); float qv = 0.f;
#pragma unroll
            for (int i = 0; i < 8; ++i) { y[i] -= mean; qv += y[i] * y[i]; }
            const float rstd = rsqrtf(red8(qv) * (1.0f / 64.0f) + 64e-5f);
            float o[8];
#pragma unroll
            for (int i = 0; i < 8; ++i) o[i] = (y[i] * rstd * lnw[i] + lnb[i] + bonus * vv[i]) * gg[i];
            const size_t tok = (size_t)b * SEQ + c * 64 + t;
            u32x4 ov; ov.x = pk2(o[0], o[1]); ov.y = pk2(o[2], o[3]); ov.z = pk2(o[4], o[5]); ov.w = pk2(o[6], o[7]);
            *(u32x4*)(MIX + tok * 1024 + 512 + ch) = ov;
        }
        LDS_BARRIER();
    }
#undef P3_LOAD
}

constexpr int RW_LD = 1032;
__device__ __forceinline__ void router_phase(const Ctx& cx, const bf16* X1, const float* gnorm, const float* rw, const float* rb, unsigned char* H2, int* TOPE, float* TOPG, unsigned* HIST) {
    LAS bf16* WH = (LAS bf16*)cx.lds; LAS bf16* WL = WH + 32 * RW_LD;
    LAS unsigned* hcnt = (LAS unsigned*)(cx.lds + 135168);
    const int lane = cx.lane, l15 = lane & 15, q = lane >> 4;
    for (int idx = cx.tid; idx < 32768; idx += NTHR) { const int col = idx >> 5, e = idx & 31; const float v = rw[idx] * gnorm[col];
        const unsigned h = cvt_pk_bf16(v, 0.f) & 0xffffu; const float lo = v - bf2f(h); WH[e * RW_LD + col] = (bf16)h; WL[e * RW_LD + col] = (bf16)(cvt_pk_bf16(lo, 0.f) & 0xffffu); }
    const float b0 = rb[l15], b1 = rb[l15 + 16];
    for (int tb = cx.wg; tb < 256; tb += cx.G) {
        if (cx.tid < 32) hcnt[cx.tid] = 0u;
        __syncthreads();
        const int tok0 = tb * 128 + cx.wave * 16;
        const bf16* xrow = X1 + (size_t)(tok0 + l15) * 1024 + 8 * q;
        f32x4 acc[2] = {(f32x4){0.f, 0.f, 0.f, 0.f}, (f32x4){0.f, 0.f, 0.f, 0.f}}; float ss = 0.f;
#pragma unroll 8
        for (int s = 0; s < 32; ++s) {
            const u32x4 xw = *(const u32x4*)(xrow + 32 * s);
            { const float a0 = lo16(xw.x), a1 = hi16(xw.x), a2 = lo16(xw.y), a3 = hi16(xw.y), a4 = lo16(xw.z), a5 = hi16(xw.z), a6 = lo16(xw.w), a7 = hi16(xw.w);
              ss += (a0 * a0 + a1 * a1) + (a2 * a2 + a3 * a3) + (a4 * a4 + a5 * a5) + (a6 * a6 + a7 * a7); }
            const bf16x8 ah = __builtin_bit_cast(bf16x8, xw);
#pragma unroll
            for (int n = 0; n < 2; ++n) { const bf16x8 bh = *(const LAS bf16x8*)(WH + (l15 + 16 * n) * RW_LD + 32 * s + 8 * q), bl = *(const LAS bf16x8*)(WL + (l15 + 16 * n) * RW_LD + 32 * s + 8 * q);
                acc[n] = __builtin_amdgcn_mfma_f32_16x16x32_bf16(ah, bh, acc[n], 0, 0, 0); acc[n] = __builtin_amdgcn_mfma_f32_16x16x32_bf16(ah, bl, acc[n], 0, 0, 0); }
        }
        ss += __shfl_xor(ss, 16); ss += __shfl_xor(ss, 32);
        const float rinv_l = rsqrtf(ss * (1.f / 1024.f) + 1e-6f);
#pragma unroll
        for (int r = 0; r < 4; ++r) {
            const float ri = __shfl(rinv_l, 4 * q + r);
            float v0 = acc[0][r] * ri + b0, v1 = acc[1][r] * ri + b1; int se[4]; float sv[4];
#pragma unroll
            for (int k = 0; k < 4; ++k) { float bv = (v1 > v0) ? v1 : v0; int be = (v1 > v0) ? (l15 + 16) : l15;
#pragma unroll
                for (int off = 1; off < 16; off <<= 1) { const float ov = __shfl_xor(bv, off); const int oe = __shfl_xor(be, off); const bool take = (ov > bv) || (ov == bv && oe < be); bv = take ? ov : bv; be = take ? oe : be; }
                se[k] = be; sv[k] = bv; if (be == l15) v0 = -INFINITY; if (be == l15 + 16) v1 = -INFINITY; }
            if (l15 == r) { const int tok = tok0 + 4 * q + r;
                const float w1 = __expf(sv[1] - sv[0]), w2 = __expf(sv[2] - sv[0]), w3 = __expf(sv[3] - sv[0]); const float inv = 1.0f / (1.0f + w1 + w2 + w3);
                *(int4*)(TOPE + (size_t)tok * 4) = make_int4(se[0], se[1], se[2], se[3]);
                *(float4*)(TOPG + (size_t)tok * 4) = make_float4(inv, w1 * inv, w2 * inv, w3 * inv);
                atomicAdd((unsigned*)(hcnt + se[0]), 1u); atomicAdd((unsigned*)(hcnt + se[1]), 1u); atomicAdd((unsigned*)(hcnt + se[2]), 1u); atomicAdd((unsigned*)(hcnt + se[3]), 1u); }
        }
        const f32x4* gr = (const f32x4*)gnorm + lane;
#pragma unroll 4
        for (int i = 0; i < 16; ++i) { const float ri = __shfl(rinv_l, i); const u32x2* xr = (const u32x2*)(X1 + (size_t)(tok0 + i) * 1024) + lane; unsigned* o4 = (unsigned*)(H2 + (size_t)(tok0 + i) * 1024) + lane;
#pragma unroll
            for (int j = 0; j < 4; ++j) { const u32x2 v = xr[64 * j]; const f32x4 gg = gr[64 * j]; o4[64 * j] = pk4_fp8(lo16(v.x) * ri * gg.x, hi16(v.x) * ri * gg.y, lo16(v.y) * ri * gg.z, hi16(v.y) * ri * gg.w); } }
        __syncthreads();
        if (cx.tid < 32) HIST[tb * 32 + cx.tid] = hcnt[cx.tid];
        __syncthreads();
    }
}

constexpr int PL_BASE = 1280, PL_WCNT = 1312;
__device__ __forceinline__ void moe_plan(const Ctx& cx, const unsigned* HIST) {
    LAS int* PL = (LAS int*)(cx.lds + LDS_PLAN);
    const int e = cx.tid & 31, part = cx.tid >> 5;
    { int s = 0; for (int w = 16 * part; w < 16 * part + 16; ++w) s += (int)HIST[w * 32 + e]; PL[PL_TMP + part * 32 + e] = s; }
    __syncthreads();
    if (cx.tid < 32) { int c = 0; for (int p = 0; p < 16; ++p) c += PL[PL_TMP + p * 32 + cx.tid]; PL[PL_CNT + cx.tid] = c; }
    __syncthreads();
    if (cx.tid == 0) {
        int ps = 0;
        for (int x = 0; x < 32; ++x) { PL[PL_PSTART + x] = ps; const int pad = (PL[PL_CNT + x] + 255) & ~255; for (int i = 0; i < pad / 256; ++i) PL[PL_TILEE + ps / 256 + i] = x; ps += pad; }
        PL[PL_PSTART + 32] = ps;
        int np = 0, e0 = 0;
        while (e0 < 32 && np < 7) { PL[PL_PE0 + np] = e0; PL[PL_PROW0 + np] = PL[PL_PSTART + e0]; int rows = 0, e1 = e0;
            while (e1 < 32 && e1 - e0 < MAXEPP) { const int pad = PL[PL_PSTART + e1 + 1] - PL[PL_PSTART + e1]; if (rows + pad > RMAX && e1 > e0) break; rows += pad; ++e1; }
            e0 = e1; ++np; }
        PL[PL_PE0 + np] = 32; PL[PL_PROW0 + np] = ps; PL[PL_NPASS] = np;
    }
    __syncthreads();
}
__device__ __forceinline__ void dispatch_phase(const Ctx& cx, const unsigned* HIST, const int* TOPE, int* SLOTTOK, int* TOKSLOT) {
    LAS int* PL = (LAS int*)(cx.lds + LDS_PLAN);
    const int e5 = cx.tid & 31, part = cx.tid >> 5, lane = cx.lane;
    for (int tb = cx.wg; tb < 256; tb += cx.G) {
        { int s = 0; for (int w = 16 * part; w < 16 * part + 16; ++w) s += (w < tb) ? (int)HIST[w * 32 + e5] : 0; PL[PL_TMP + part * 32 + e5] = s; }
        const int tok = tb * 128 + (cx.tid >> 2), k = cx.tid & 3; const int e = TOPE[(size_t)tok * 4 + k];
        int rank = 0;
        for (int ee = 0; ee < 32; ++ee) { const unsigned long long mask = __ballot(e == ee); if (e == ee) rank = __popcll(mask & ((1ull << lane) - 1ull)); if (lane == 0) PL[PL_WCNT + cx.wave * 32 + ee] = __popcll(mask); }
        __syncthreads();
        if (cx.tid < 32) { int c = 0; for (int p = 0; p < 16; ++p) c += PL[PL_TMP + p * 32 + cx.tid]; PL[PL_BASE + cx.tid] = c; }
        __syncthreads();
        int off = 0; for (int w2 = 0; w2 < 8; ++w2) off += (w2 < cx.wave) ? PL[PL_WCNT + w2 * 32 + e] : 0;
        const int slot = PL[PL_PSTART + e] + PL[PL_BASE + e] + off + rank;
        SLOTTOK[slot] = tok; TOKSLOT[(size_t)tok * 4 + k] = slot;
        __syncthreads();
    }
    for (int e = cx.wg; e < 32; e += cx.G) { const int c = PL[PL_CNT + e], ps = PL[PL_PSTART + e], pe = PL[PL_PSTART + e + 1]; for (int r = ps + c + cx.tid; r < pe; r += NTHR) SLOTTOK[r] = 0; }
}
__device__ __forceinline__ void convert_pass(const Ctx& cx, int e0, int e1, const float* wg, const float* wu, const float* wd, unsigned char* WGU, unsigned char* WDN) {
    LAS float* scr = (LAS float*)(cx.lds + cx.wave * 16640);
    const int nitems = (e1 - e0) * 768;
#define CV_SRC(it_) ((((it_) % 768) >> 8) == 2 ? wd : ((((it_) % 768) >> 8) ? wu : wg)) + (size_t)(e0 + (it_) / 768) * 1048576
    int it = cx.gw; if (it >= nitems) return;
    F8Item cur; f8_issue(CV_SRC(it), 1024, 64 * (((it % 768) & 255) >> 4), 64 * ((it % 768) & 15), cx.lane, cur);
    for (;;) {
        const int nx = it + cx.NGW; const bool has = nx < nitems;
        F8Item nxt;
        if (has) f8_issue(CV_SRC(nx), 1024, 64 * (((nx % 768) & 255) >> 4), 64 * ((nx % 768) & 15), cx.lane, nxt);
        const int le = it / 768, r = it % 768, mat = r >> 8, kb = (r & 255) >> 4, nb = r & 15, n0 = 64 * nb;
        if (mat == 2) f8_finish(cur, WDN + (size_t)le * 1048576 + (size_t)n0 * 1024 + 64 * kb, 1024, 32.0f, scr, cx.lane);
        else { const int drow = (n0 >> 7) * 256 + (n0 & 127) + mat * 128; f8_finish(cur, WGU + (size_t)le * 2097152 + (size_t)drow * 1024 + 64 * kb, 1024, 32.0f, scr, cx.lane); }
        if (!has) break;
        it = nx;
#pragma unroll
        for (int i = 0; i < 16; ++i) cur.v[i] = nxt.v[i];
    }
#undef CV_SRC
}
__device__ __forceinline__ void combine_all(const Ctx& cx, const float* TOPG, const int* TOKSLOT, const unsigned char* Y, bf16* X, const float* gnorm, unsigned char* H3) {
    const int lane = cx.lane, step = cx.NGW;
    int tok = cx.gw; if (tok >= M) return;
    int4 sl = *(const int4*)(TOKSLOT + (size_t)tok * 4); float4 gs = *(const float4*)(TOPG + (size_t)tok * 4);
    u32x2 xw[4]; unsigned yw[4][4];
#define CMB_ISSUE(T, SL, XW, YW) do { const u32x2* xr_ = (const u32x2*)(X + (size_t)(T) * 1024) + lane; const int s_[4] = {SL.x, SL.y, SL.z, SL.w}; \
        _Pragma("unroll") for (int j = 0; j < 4; ++j) XW[j] = xr_[64 * j]; \
        _Pragma("unroll") for (int k = 0; k < 4; ++k) { const unsigned* yr_ = (const unsigned*)(Y + (size_t)s_[k] * 1024) + lane; _Pragma("unroll") for (int j = 0; j < 4; ++j) YW[k][j] = yr_[64 * j]; } } while (0)
    CMB_ISSUE(tok, sl, xw, yw);
    int4 sl1 = sl; float4 gs1 = gs; { const int t1 = tok + step; if (t1 < M) { sl1 = *(const int4*)(TOKSLOT + (size_t)t1 * 4); gs1 = *(const float4*)(TOPG + (size_t)t1 * 4); } }
    const f32x4* gr = (const f32x4*)gnorm + lane;
    for (;;) {
        const int t1 = tok + step, t2 = tok + 2 * step; const bool has1 = t1 < M;
        u32x2 nxw[4]; unsigned nyw[4][4];
        if (has1) CMB_ISSUE(t1, sl1, nxw, nyw);
        int4 sl2 = sl1; float4 gs2 = gs1; if (t2 < M) { sl2 = *(const int4*)(TOKSLOT + (size_t)t2 * 4); gs2 = *(const float4*)(TOPG + (size_t)t2 * 4); }
        f32x4 v[4]; const float gk[4] = {gs.x, gs.y, gs.z, gs.w};
#pragma unroll
        for (int j = 0; j < 4; ++j) v[j] = (f32x4){lo16(xw[j].x), hi16(xw[j].x), lo16(xw[j].y), hi16(xw[j].y)};
#pragma unroll
        for (int k = 0; k < 4; ++k)
#pragma unroll
            for (int j = 0; j < 4; ++j) v[j] += up4_fp8(yw[k][j]) * gk[k];
        u32x2* xo = (u32x2*)(X + (size_t)tok * 1024) + lane; float s = 0.f;
#pragma unroll
        for (int j = 0; j < 4; ++j) { u32x2 w; w.x = pk2(v[j].x, v[j].y); w.y = pk2(v[j].z, v[j].w); xo[64 * j] = w; s += (v[j].x * v[j].x + v[j].y * v[j].y) + (v[j].z * v[j].z + v[j].w * v[j].w); }
        const float rinv = rsqrtf(wave_sum(s) * (1.f / 1024.f) + 1e-6f); unsigned* o8 = (unsigned*)(H3 + (size_t)tok * 1024) + lane;
#pragma unroll
        for (int j = 0; j < 4; ++j) { const f32x4 gq = gr[64 * j]; o8[64 * j] = pk4_fp8(v[j].x * rinv * gq.x, v[j].y * rinv * gq.y, v[j].z * rinv * gq.z, v[j].w * rinv * gq.w); }
        if (!has1) break;
        tok = t1; gs = gs1; sl1 = sl2; gs1 = gs2;
#pragma unroll
        for (int j = 0; j < 4; ++j) { xw[j] = nxw[j];
#pragma unroll
            for (int k = 0; k < 4; ++k) yw[k][j] = nyw[k][j]; }
    }
#undef CMB_ISSUE
}
template <bool LAST>
__device__ __forceinline__ void combine_pass(const Ctx& cx, int e0, int e1, int row0, const int* TOPE, const float* TOPG, const int* TOKSLOT, const unsigned char* Y, bf16* X, const float* gnorm, unsigned char* H3) {
    for (int tok = cx.gw; tok < M; tok += cx.NGW) {
        const int4 es = *(const int4*)(TOPE + (size_t)tok * 4); const float4 gs = *(const float4*)(TOPG + (size_t)tok * 4); const int4 sl = *(const int4*)(TOKSLOT + (size_t)tok * 4);
        const int ee[4] = {es.x, es.y, es.z, es.w}; const float gg[4] = {gs.x, gs.y, gs.z, gs.w}; const int ss[4] = {sl.x, sl.y, sl.z, sl.w};
        bool any = false;
#pragma unroll
        for (int k = 0; k < 4; ++k) any |= (ee[k] >= e0 && ee[k] < e1);
        if (!LAST && !any) continue;
        u32x2* xr = (u32x2*)(X + (size_t)tok * 1024) + cx.lane; f32x4 v[4];
#pragma unroll
        for (int j = 0; j < 4; ++j) { const u32x2 w = xr[64 * j]; v[j] = (f32x4){lo16(w.x), hi16(w.x), lo16(w.y), hi16(w.y)}; }
#pragma unroll
        for (int k = 0; k < 4; ++k) if (ee[k] >= e0 && ee[k] < e1) { const unsigned* yr = (const unsigned*)(Y + (size_t)(ss[k] - row0) * 1024) + cx.lane; const float g = gg[k];
#pragma unroll
            for (int j = 0; j < 4; ++j) v[j] += up4_fp8(yr[64 * j]) * g; }
        if (any) {
#pragma unroll
            for (int j = 0; j < 4; ++j) { u32x2 w; w.x = pk2(v[j].x, v[j].y); w.y = pk2(v[j].z, v[j].w); xr[64 * j] = w; }
        }
        if (LAST) { float s = 0.f;
#pragma unroll
            for (int j = 0; j < 4; ++j) s += (v[j].x * v[j].x + v[j].y * v[j].y) + (v[j].z * v[j].z + v[j].w * v[j].w);
            const float rinv = rsqrtf(wave_sum(s) * (1.f / 1024.f) + 1e-6f); const f32x4* gr = (const f32x4*)gnorm + cx.lane; unsigned* o8 = (unsigned*)(H3 + (size_t)tok * 1024) + cx.lane;
#pragma unroll
            for (int j = 0; j < 4; ++j) { const f32x4 gq = gr[64 * j]; o8[64 * j] = pk4_fp8(v[j].x * rinv * gq.x, v[j].y * rinv * gq.y, v[j].z * rinv * gq.z, v[j].w * rinv * gq.w); } }
    }
}

#define HBUF ((bf16*)(ws + WS_R1))
#define RKV ((bf16*)(ws + WS_RKV))
#define WAG ((bf16*)(ws + WS_WAG))
#define AG ((bf16*)(ws + WS_AG))
#define UB ((bf16*)(ws + WS_U))
#define LP ((bf16*)(ws + WS_LP))
#define LACT ((bf16*)(ws + WS_LACT))
#define Y1 ((bf16*)(ws + WS_Y1))
#define MIX ((bf16*)(ws + WS_R1))
#define EBUF ((float*)(ws + WS_LP))
#define S0G ((bf16*)(ws + WS_LP))
#define QCT ((bf16*)(ws + WS_U))
#define HCT ((float*)(ws + WS_R1))
#define W1G ((bf16*)(ws + WS_W1))
#define ULG ((bf16*)(ws + WS_ULOC))
#define DLG ((float*)(ws + WS_DL))
#define ATG ((float*)(ws + WS_AT))
#define WCAT ((bf16*)(ws + WS_WCAT))
#define WL2 ((bf16*)(ws + WS_WL2))
#define WGLU ((bf16*)(ws + WS_WGLU))
#define WPP ((bf16*)(ws + WS_WPP))
#define WOUT ((bf16*)(ws + WS_WOUT))
#define WPG ((unsigned char*)(ws + WS_WPG))
#define S5BT ((bf16*)(ws + WS_S5BT))
#define S5ET ((bf16*)(ws + WS_S5ET))
#define PBF ((bf16*)(ws + WS_PBF))
#define H2 ((unsigned char*)(ws + WS_H2))
#define WGU ((unsigned char*)(ws + WS_WGU))
#define WDN ((unsigned char*)(ws + WS_WDN))
#define ACT ((unsigned char*)(ws + WS_ACT))
#define YB ((unsigned char*)(ws + WS_Y))
#define XB ((bf16*)(ws + WS_XB))
#define PP ((bf16*)(ws + WS_ACT))
#define HIST ((unsigned*)(ws + WS_HIST))
#define TOPE ((int*)(ws + WS_TOPE))
#define TOPG ((float*)(ws + WS_TOPG))
#define TOKSLOT ((int*)(ws + WS_TOKSLOT))
#define SLOTTOK ((int*)(ws + WS_SLOTTOK))
#ifndef FUSE_FNORM
#define FUSE_FNORM 1
#endif
#ifndef SPLIT_P5
#define SPLIT_P5 1
#endif
#ifndef MOE_SP2
#define MOE_SP2 true
#endif
#ifndef MOE_ALIGN
#define MOE_ALIGN true
#endif
#ifndef PROBE_PH
#define PROBE_PH -1
#endif
#ifndef PROBE_N
#define PROBE_N 2
#endif
#define REPS(k) ((((k) >= 10 && (k) < 28) ? 10 + ((k) - 10) % 3 : (k)) == PROBE_PH ? PROBE_N : 1)
#ifndef ONLY_PHASE
#define ONLY_PHASE -1
#endif
constexpr int NPH = 31;
struct Args { const float* in[42]; float* out; unsigned char* ws; int ph_lo, ph_hi; };

__global__ void __launch_bounds__(NTHR, 2) mk_fwd(Args args) {
    extern __shared__ __attribute__((aligned(16))) unsigned char lds_raw[];
    LAS unsigned char* lds = (LAS unsigned char*)lds_raw;
#define CAS __attribute__((address_space(4)))
#define FRESH_CX const CAS char* ka_ = (const CAS char*)__builtin_amdgcn_kernarg_segment_ptr(); asm volatile("" : "+s"(ka_)); const float* const CAS* I = (const float* const CAS*)ka_; unsigned char* ws = *(unsigned char* const CAS*)(ka_ + 344); float* OUTP = *(float* const CAS*)(ka_ + 336); (void)I; (void)ws; (void)OUTP; \
    Ctx cx; { int t_ = wv0_ * 64 + (int)__builtin_amdgcn_mbcnt_hi(~0u, __builtin_amdgcn_mbcnt_lo(~0u, 0u)); asm volatile("" : "+v"(t_)); cx.lds = lds; cx.tid = t_; cx.lane = t_ & 63; cx.wave = __builtin_amdgcn_readfirstlane(t_ >> 6); cx.G = gridDim.x; cx.wg = blockIdx.x; cx.gw = cx.wg * NWAVES + cx.wave; cx.NGW = cx.G * NWAVES; }
    unsigned char* ws = args.ws;
    const int lo = args.ph_lo, hi = args.ph_hi;
    volatile LAS unsigned* MISC = (volatile LAS unsigned*)(lds + LDS_MISC);
    const int wv0_ = __builtin_amdgcn_readfirstlane((int)threadIdx.x >> 6);
    if (wv0_ == 0) MISC[__builtin_amdgcn_mbcnt_hi(~0u, __builtin_amdgcn_mbcnt_lo(~0u, 0u))] = 0u;
    __syncthreads();
    XcdBarrier bar; bar.bar = (unsigned*)(ws + WS_CTL) + CW_BAR; bar.x = 0; bar.st = nullptr; bar.wv = wv0_;
    if (hi - lo > 1) bar = xcd_barrier_post((unsigned*)(ws + WS_CTL) + CW_BAR, MISC + 8, wv0_);

#define IN(k) ((ONLY_PHASE < 0 || ONLY_PHASE == (k) || (ONLY_PHASE >= 10 && ONLY_PHASE < 28 && (k) >= 10 && (k) < 28 && ((k) - 10) % 3 == (ONLY_PHASE - 10) % 3)) && lo <= (k) && (k) < hi)
#ifndef PROBE_BAR
#define PROBE_BAR 1
#endif
#ifndef PROBE_T
#define PROBE_T -1
#endif
#define STAMP() do { if (PROBE_T >= 0 && blockIdx.x == 0 && xb_first(wv0_)) { const unsigned long long t_ = __builtin_amdgcn_s_memrealtime(); MISC[16 + 2 * nst] = (unsigned)t_; MISC[17 + 2 * nst] = (unsigned)(t_ >> 32); } ++nst; } while (0)
#define SEAM(k) do { if (IN(k) && IN((k) + 1)) { for (int b_ = 0; b_ < PROBE_BAR; ++b_) xcd_barrier(bar); STAMP(); } } while (0)
    int nst = 0; STAMP();
#define MAKE_RP RwkvP RP; RP.rkv = RKV; RP.wag = WAG; RP.mu_rkv = I[13]; RP.w0 = I[15]; RP.a0 = I[18]; RP.k_k = I[23]; RP.k_a = I[24]; RP.r_k = I[25]; RP.ln_w = I[26]; RP.ln_b = I[27]
#define OPQ(v) ({ int _k = (v); asm volatile("" : "+s"(_k)); _k; })

    if (IN(0)) for (int rep_ = 0; rep_ < REPS(0); ++rep_) {
        FRESH_CX;
        for (int it = cx.wg; it < 256; it += cx.G) s5_tables_item(cx, it >> 3, it & 7, I[4], I[5], I[6], I[7], I[8], I[9], I[10], S5BT, S5ET, ATG);
        const float* mu = I[14];
        transpose_matrix(cx, I[3], 1024, 2048, WCAT, 0, 1024, 0, nullptr, 0);
        transpose_matrix(cx, I[16], 1024, 64, WCAT, 2048, 1024, 0, mu, 1);          transpose_matrix(cx, I[16], 1024, 64, WCAT, 2304, 1024, 0, mu, 0);
        transpose_matrix(cx, I[19], 1024, 64, WCAT, 2112, 1024, 0, mu + 1024, 1);   transpose_matrix(cx, I[19], 1024, 64, WCAT, 2368, 1024, 0, mu + 1024, 0);
        transpose_matrix(cx, I[21], 1024, 128, WCAT, 2176, 1024, 0, mu + 2048, 1);  transpose_matrix(cx, I[21], 1024, 128, WCAT, 2432, 1024, 0, mu + 2048, 0);
        transpose_matrix(cx, I[17], 64, 512, WL2, 0, 256, 0, nullptr, 0);
        transpose_matrix(cx, I[20], 64, 512, WL2, 512, 256, 64, nullptr, 0);
        transpose_matrix(cx, I[22], 128, 512, WL2, 1024, 256, 128, nullptr, 0);
        for (int idx = cx.wg * NTHR + cx.tid; idx < 1536 * 32; idx += cx.G * NTHR) { const int row = idx >> 5, ch = idx & 31, blk = row >> 9; const int kb = blk == 0 ? 0 : (blk == 1 ? 64 : 128), ke = blk == 0 ? 64 : (blk == 1 ? 128 : 256);
            if (ch * 8 < kb || ch * 8 >= ke) *(u32x4*)(WL2 + (size_t)row * 256 + ch * 8) = (u32x4){0u, 0u, 0u, 0u}; }
        transpose_matrix(cx, I[12], 512, 512, WGLU, 0, 512, 0, nullptr, 0);
        transpose_matrix(cx, I[39], 256, 1024, WPP, 0, 256, 0, nullptr, 0);
        transpose_matrix(cx, I[28], 1024, 1024, WOUT, 0, 1024, 0, nullptr, 0);
        { LAS float* scr = (LAS float*)(cx.lds + cx.wave * 16640);
          for (int it = cx.gw; it < 256; it += cx.NGW) { const int kb = it >> 4, nb = it & 15;
              transpose_item_fp8(I[40], 1024, 64 * kb, 64 * nb, WPG + (size_t)(64 * nb) * 1024 + 64 * kb, 1024, 32.0f, scr, cx.lane); } }
        for (int m = 2 * cx.gw; m < M; m += 2 * cx.NGW) rms_rows2_to_bf16(I[0] + (size_t)m * 1024, I[0] + (size_t)(m + 1) * 1024, I[2], HBUF + (size_t)m * 1024, HBUF + (size_t)(m + 1) * 1024, cx.lane);
        for (int m = 4 * cx.gw; m < M; m += 4 * cx.NGW) { f32x4 v[4];
#pragma unroll
            for (int r = 0; r < 4; ++r) v[r] = __builtin_nontemporal_load((const f32x4*)(I[1] + (size_t)(m + r) * 256) + cx.lane);
#pragma unroll
            for (int r = 0; r < 4; ++r) { u32x2 w; w.x = pk2(v[r].x, v[r].y); w.y = pk2(v[r].z, v[r].w); *((u32x2*)(PBF + (size_t)(m + r) * 256) + cx.lane) = w; } }
    }
    SEAM(0);
    if (IN(1)) for (int rep_ = 0; rep_ < REPS(1); ++rep_) {
        FRESH_CX;
        SchedPlain S; S.init(128, 10, cx.G, cx.wg); S.A = (const char*)HBUF; S.B = (const char*)WCAT; S.a_tile = 256 * 1024 * 2; S.b_tile = 256 * 1024 * 2;
        EpiProj E{AG, RKV, LP};
        pg8::gemm_phase<EpiProj, SchedPlain, true, true, false>(lds, cx.tid, OPQ(1024), OPQ(1024), OPQ(1024), S, E);
    }
    SEAM(1);
    if (IN(2)) for (int rep_ = 0; rep_ < REPS(2); ++rep_) {
        FRESH_CX;
        for (int m = 2 * cx.gw; m < M; m += 2 * cx.NGW) {
            const int lane = cx.lane; const bool first = (m & (SEQ - 1)) == 0;
            const u32x2 a0 = *((const u32x2*)(LP + (size_t)m * 512) + lane), a1 = *((const u32x2*)(LP + (size_t)(m + 1) * 512) + lane), b1 = *((const u32x2*)(LP + (size_t)m * 512 + 256) + lane);
            u32x2 b0 = (u32x2){0u, 0u}; if (!first) b0 = *((const u32x2*)(LP + (size_t)(m - 1) * 512 + 256) + lane);
            float v[8] = {lo16(a0.x) + lo16(b0.x), hi16(a0.x) + hi16(b0.x), lo16(a0.y) + lo16(b0.y), hi16(a0.y) + hi16(b0.y), lo16(a1.x) + lo16(b1.x), hi16(a1.x) + hi16(b1.x), lo16(a1.y) + lo16(b1.y), hi16(a1.y) + hi16(b1.y)};
#pragma unroll
            for (int i = 0; i < 8; ++i) v[i] = lane < 16 ? ftanh(v[i]) : (lane < 32 ? v[i] : fsigmoid(v[i]));
            u32x2 o; o.x = pk2(v[0], v[1]); o.y = pk2(v[2], v[3]); *((u32x2*)(LACT + (size_t)m * 256) + lane) = o;
            o.x = pk2(v[4], v[5]); o.y = pk2(v[6], v[7]); *((u32x2*)(LACT + (size_t)(m + 1) * 256) + lane) = o;
        }
    }
    SEAM(2);
    if (IN(3)) for (int rep_ = 0; rep_ < REPS(3); ++rep_) {
        FRESH_CX;
        { SchedPlain S; S.init(128, 6, cx.G, cx.wg); S.A = (const char*)LACT; S.B = (const char*)WL2; S.a_tile = 256 * 256 * 2; S.b_tile = 256 * 256 * 2;
          EpiBf16Plain E{WAG, 1536};
          pg8::gemm_phase<EpiBf16Plain, SchedPlain, true, true, false>(lds, cx.tid, OPQ(256), OPQ(256), OPQ(256), S, E); }
        { SchedS5 S; S.init(128, 1, cx.G, cx.wg); S.A = (const char*)AG; S.B = (const char*)S5ET; S.a_tile = 256 * 640 * 2; S.b_tile = 0; S.b_group = 256 * 512 * 2;
          EpiF32 E{EBUF, 256};
          pg8::gemm_phase<EpiF32, SchedS5, true, true, false>(lds, cx.tid, OPQ(512), OPQ(640), OPQ(512), S, E); }
    }
    SEAM(3);
    if (IN(4)) for (int rep_ = 0; rep_ < REPS(4); ++rep_) {
        FRESH_CX;
        for (int base = cx.wg * 32; base < 8192; base += cx.G * 32) { const int idx = base + (cx.lane & 31), b = idx >> 11, g = (idx >> 6) & 31, p = idx & 63, w8 = cx.wave;
            LAS float* CE = (LAS float*)lds;
            const float ar = ATG[(g * 64 + p) * 2], ai = ATG[(g * 64 + p) * 2 + 1];
            const size_t row0 = (size_t)g * 1024 + b * 256 + 32 * w8;
            float er[32], ei[32];
            if (cx.lane < 32) {
#pragma unroll
                for (int k = 0; k < 32; ++k) { er[k] = EBUF[(row0 + k) * 256 + p]; ei[k] = EBUF[(row0 + k) * 256 + 64 + p]; }
                float sr = 0.f, si = 0.f;
#pragma unroll
                for (int k = 0; k < 32; ++k) { const float nr = ar * sr - ai * si + er[k], ni = ar * si + ai * sr + ei[k]; sr = nr; si = ni; }
                CE[(w8 * 32 + cx.lane) * 2] = sr; CE[(w8 * 32 + cx.lane) * 2 + 1] = si; }
            __syncthreads();
            if (cx.lane < 32) {
                float pr = 1.f, pi = 0.f;
                { float qr = ar, qi = ai;
#pragma unroll
                  for (int i = 0; i < 5; ++i) { const float tr_ = qr * qr - qi * qi, ti_ = 2.f * qr * qi; qr = tr_; qi = ti_; } pr = qr; pi = qi; }
                float cr = 0.f, ci = 0.f;
                for (int w2 = 0; w2 < w8; ++w2) { const float e0 = CE[(w2 * 32 + cx.lane) * 2], e1 = CE[(w2 * 32 + cx.lane) * 2 + 1]; const float nr = pr * cr - pi * ci + e0, ni = pr * ci + pi * cr + e1; cr = nr; ci = ni; }
                float sr = cr, si = ci;
#pragma unroll
                for (int k = 0; k < 32; ++k) { bf16* d = AG + (row0 + k) * 640 + 512 + p; d[0] = (bf16)(pk2(sr, 0.f) & 0xffffu); d[64] = (bf16)(pk2(si, 0.f) & 0xffffu);
                    const float nr = ar * sr - ai * si + er[k], ni = ar * si + ai * sr + ei[k]; sr = nr; si = ni; } }
            __syncthreads();
        }
        MAKE_RP;
        for (int grp = cx.wg; grp < 256; grp += cx.G) rwkv_pass1(lds, RP, grp * 16, 16, cx.tid, QCT, HCT, W1G, ULG, DLG, (float*)(ws + WS_TOKSLOT));
    }
    SEAM(4);
    if (IN(5)) for (int rep_ = 0; rep_ < REPS(5); ++rep_) {
        FRESH_CX;
        if (SPLIT_P5 && cx.G == 256) {
            if (cx.wg < 128) { if (cx.wave == 0) rwkv_pass2(lds, cx.wg >> 2, cx.wg & 3, cx.lane, QCT, HCT, DLG, S0G); }
            else { SchedS5 S; S.init(128, 2, 128, cx.wg - 128); S.A = (const char*)AG; S.B = (const char*)S5BT; S.a_tile = 256 * 640 * 2; S.b_tile = 256 * 640 * 2; S.b_group = 512 * 640 * 2;
                EpiS5Y E{AG, I[11], Y1};
                pg8::gemm_phase<EpiS5Y, SchedS5, true, true, false>(lds, cx.tid, OPQ(640), OPQ(640), OPQ(640), S, E); }
        } else {
            { SchedS5 S; S.init(128, 2, cx.G, cx.wg); S.A = (const char*)AG; S.B = (const char*)S5BT; S.a_tile = 256 * 640 * 2; S.b_tile = 256 * 640 * 2; S.b_group = 512 * 640 * 2;
              EpiS5Y E{AG, I[11], Y1};
              pg8::gemm_phase<EpiS5Y, SchedS5, true, true, false>(lds, cx.tid, OPQ(640), OPQ(640), OPQ(640), S, E); }
            if (cx.wave == 0) for (int it = cx.wg; it < 128; it += cx.G) rwkv_pass2(lds, it >> 2, it & 3, cx.lane, QCT, HCT, DLG, S0G);
        }
    }
    SEAM(5);
    if (IN(6)) for (int rep_ = 0; rep_ < REPS(6); ++rep_) {
        FRESH_CX;
        MAKE_RP;
        for (int grp = cx.wg; grp < 256; grp += cx.G) rwkv_pass3(lds, RP, grp * 16, 16, cx.tid, S0G, W1G, ULG, (const float*)(ws + WS_TOKSLOT), MIX);
        __syncthreads();
        { SchedPlain S; S.init(128, 2, cx.G, cx.wg); S.A = (const char*)Y1; S.B = (const char*)WGLU; S.a_tile = 256 * 512 * 2; S.b_tile = 256 * 512 * 2;
          EpiGlu E{Y1, MIX};
          pg8::gemm_phase<EpiGlu, SchedPlain, true, true, false>(lds, cx.tid, OPQ(512), OPQ(512), OPQ(512), S, E); }
    }
    SEAM(6);
    if (IN(7)) for (int rep_ = 0; rep_ < REPS(7); ++rep_) {
        FRESH_CX;
        SchedPlain S; S.init(128, 4, cx.G, cx.wg); S.A = (const char*)MIX; S.B = (const char*)WOUT; S.a_tile = 256 * 1024 * 2; S.b_tile = 256 * 1024 * 2;
        EpiResid E{I[0], XB};
        pg8::gemm_phase<EpiResid, SchedPlain, true, true, false>(lds, cx.tid, OPQ(1024), OPQ(1024), OPQ(1024), S, E);
    }
    SEAM(7);
    if (IN(8)) for (int rep_ = 0; rep_ < REPS(8); ++rep_) { FRESH_CX; router_phase(cx, XB, I[29], I[30], I[31], H2, TOPE, TOPG, HIST); }
    SEAM(8);
    LAS int* PL = (LAS int*)(lds + LDS_PLAN);
    if (hi > 9 && lo < 28) { FRESH_CX; __syncthreads(); moe_plan(cx, HIST); }
    const int npass = (hi > 9 && lo < 28) ? PL[PL_NPASS] : 0;
    if (IN(9)) for (int rep_ = 0; rep_ < REPS(9); ++rep_) { FRESH_CX; dispatch_phase(cx, HIST, TOPE, SLOTTOK, TOKSLOT); convert_pass(cx, PL[PL_PE0], PL[PL_PE0 + 1], I[32], I[34], I[36], WGU, WDN); }
    SEAM(9);
    for (int p = 0; p < 6; ++p) {
        const bool actv = p < npass;
        const int e0 = actv ? PL[PL_PE0 + p] : 0, e1 = actv ? PL[PL_PE0 + p + 1] : 0, row0 = actv ? PL[PL_PROW0 + p] : 0, rows = actv ? PL[PL_PROW0 + p + 1] - row0 : 0;
        if (IN(10 + 3 * p) && actv) for (int rep_ = 0; rep_ < REPS(10); ++rep_) {
            FRESH_CX;
            SchedMoe<true> S; S.init(rows / 256, 8, cx.G, cx.wg); S.A = (const char*)H2; S.B = (const char*)WGU; S.a_tile = 0; S.b_tile = 256 * 1024; S.b_exp = (size_t)2048 * 1024; S.tile_e = PL + PL_TILEE; S.tile0 = row0 / 256; S.e0 = e0; S.slot_tok = SLOTTOK; S.row0 = row0;
#ifdef PROBE_EPI10
            if (rep_ + 1 < REPS(10)) { PROBE_EPI10 E0 PROBE_EPI10_INIT; pg8::gemm_phase<PROBE_EPI10, SchedMoe<true>, MOE_ALIGN, MOE_SP2, true, true>(lds, cx.tid, OPQ(512), OPQ(512), OPQ(512), S, E0); continue; }
#endif
            EpiGU E{ACT, I[33], I[35]};
            pg8::gemm_phase<EpiGU, SchedMoe<true>, MOE_ALIGN, MOE_SP2, true, true>(lds, cx.tid, OPQ(512), OPQ(512), OPQ(512), S, E);
        }
        if (actv) SEAM(10 + 3 * p);
        if (IN(11 + 3 * p) && actv) for (int rep_ = 0; rep_ < REPS(11); ++rep_) {
            FRESH_CX;
            SchedMoe<false> S; S.init(rows / 256, 4, cx.G, cx.wg); S.A = (const char*)ACT; S.B = (const char*)WDN; S.a_tile = 256 * 1024; S.b_tile = 256 * 1024; S.b_exp = (size_t)1024 * 1024; S.tile_e = PL + PL_TILEE; S.tile0 = row0 / 256; S.e0 = e0; S.slot_tok = SLOTTOK; S.row0 = row0;
#ifdef PROBE_NULLEPI
            if (rep_ + 1 < REPS(11)) { PROBE_EPIX E0{YB, I[37]}; pg8::gemm_phase<PROBE_EPIX, SchedMoe<false>, MOE_ALIGN, MOE_SP2, false, true>(lds, cx.tid, OPQ(512), OPQ(512), OPQ(512), S, E0); continue; }
#endif
#ifdef STAG11
            if (rep_ == 0) { const int ns_ = ((cx.wg >> 3) & 3) * STAG11; for (int q_ = 0; q_ < ns_; ++q_) __builtin_amdgcn_s_sleep(127); }
#endif
            EpiDown E{YB, I[37]};
            pg8::gemm_phase<EpiDown, SchedMoe<false>, MOE_ALIGN, MOE_SP2, false, true>(lds, cx.tid, OPQ(512), OPQ(512), OPQ(512), S, E);
        }
        if (actv) SEAM(11 + 3 * p);
        if (IN(12 + 3 * p) && actv) for (int rep_ = 0; rep_ < REPS(12); ++rep_) {
            FRESH_CX;
            if (p + 1 < npass) { combine_pass<false>(cx, e0, e1, row0, TOPE, TOPG, TOKSLOT, YB, XB, nullptr, nullptr); convert_pass(cx, PL[PL_PE0 + p + 1], PL[PL_PE0 + p + 2], I[32], I[34], I[36], WGU, WDN); }
            else {
                if (e0 == 0 && e1 == 32 && row0 == 0) combine_all(cx, TOPG, TOKSLOT, YB, XB, I[38], (unsigned char*)(ws + WS_R1));
                else combine_pass<true>(cx, e0, e1, row0, TOPE, TOPG, TOKSLOT, YB, XB, I[38], (unsigned char*)(ws + WS_R1));
                SchedPlain S; S.init(128, 4, cx.G, cx.wg); S.A = (const char*)PBF; S.B = (const char*)WPP; S.a_tile = 256 * 256 * 2; S.b_tile = 256 * 256 * 2;
                EpiBf16Plain E{PP, 1024};
                pg8::gemm_phase<EpiBf16Plain, SchedPlain, true, true, false>(lds, cx.tid, OPQ(256), OPQ(256), OPQ(256), S, E);
            }
        }
        if (actv) SEAM(12 + 3 * p);
    }
    if (IN(29)) for (int rep_ = 0; rep_ < REPS(29); ++rep_) {
        FRESH_CX;
        SchedPlain S; S.init(128, 4, cx.G, cx.wg); S.A = (const char*)(ws + WS_R1); S.B = (const char*)WPG; S.a_tile = 256 * 1024; S.b_tile = 256 * 1024;
        if (FUSE_FNORM && cx.G == 256) { EpiPleNorm E{PP, XB, OUTP, I[41], (float*)(ws + WS_CTL) + CW_ROWSS, (unsigned*)(ws + WS_CTL) + CW_PCNT};
            pg8::gemm_phase<EpiPleNorm, SchedPlain, true, true, false, true>(lds, cx.tid, OPQ(512), OPQ(512), OPQ(512), S, E); }
        else { EpiPle E{PP, XB};
            pg8::gemm_phase<EpiPle, SchedPlain, true, true, false, true>(lds, cx.tid, OPQ(512), OPQ(512), OPQ(512), S, E); }
    }
    SEAM(29);
    if (IN(30) && !(FUSE_FNORM && gridDim.x == 256)) for (int rep_ = 0; rep_ < REPS(30); ++rep_) {
        FRESH_CX;
        for (int m = 2 * cx.gw; m < M; m += 2 * cx.NGW) {
            const u32x2* ia_ = (const u32x2*)(XB + (size_t)m * 1024) + cx.lane; const u32x2* ib_ = ia_ + 256;
            f32x4* xa = (f32x4*)(OUTP + (size_t)m * 1024) + cx.lane; f32x4* xb = xa + 256; const f32x4* gr = (const f32x4*)I[41] + cx.lane; f32x4 va[4], vb[4]; float sa = 0.f, sb = 0.f;
#pragma unroll
            for (int j = 0; j < 4; ++j) { const u32x2 wa = ia_[64 * j], wb = ib_[64 * j]; va[j] = (f32x4){lo16(wa.x), hi16(wa.x), lo16(wa.y), hi16(wa.y)}; vb[j] = (f32x4){lo16(wb.x), hi16(wb.x), lo16(wb.y), hi16(wb.y)}; }
#pragma unroll
            for (int j = 0; j < 4; ++j) { sa += (va[j].x * va[j].x + va[j].y * va[j].y) + (va[j].z * va[j].z + va[j].w * va[j].w); sb += (vb[j].x * vb[j].x + vb[j].y * vb[j].y) + (vb[j].z * vb[j].z + vb[j].w * vb[j].w); }
#pragma unroll
            for (int o = 1; o < 64; o <<= 1) { sa += __shfl_xor(sa, o); sb += __shfl_xor(sb, o); }
            const float ia = rsqrtf(sa * (1.f / 1024.f) + 1e-6f), ib = rsqrtf(sb * (1.f / 1024.f) + 1e-6f);
#pragma unroll
            for (int j = 0; j < 4; ++j) { const f32x4 gg = gr[64 * j]; xa[64 * j] = (f32x4){va[j].x * ia * gg.x, va[j].y * ia * gg.y, va[j].z * ia * gg.z, va[j].w * ia * gg.w}; xb[64 * j] = (f32x4){vb[j].x * ib * gg.x, vb[j].y * ib * gg.y, vb[j].z * ib * gg.z, vb[j].w * ib * gg.w}; }
        }
    }
    if (PROBE_T >= 0 && blockIdx.x == 0 && xb_first(wv0_)) { STAMP(); asm volatile("s_waitcnt vmcnt(0)" ::: "memory");
        const unsigned long long t0_ = ((unsigned long long)MISC[17 + 2 * PROBE_T] << 32) | MISC[16 + 2 * PROBE_T], t1_ = ((unsigned long long)MISC[19 + 2 * PROBE_T] << 32) | MISC[18 + 2 * PROBE_T];
        (*(float* const CAS*)((const CAS char*)__builtin_amdgcn_kernarg_segment_ptr() + 336))[0] = (float)(t1_ - t0_) * 0.01f; }
#undef IN
#undef SEAM
}

extern "C" void kernel_launch(void* const* d_in, const int* in_sizes, int n_in, void* d_out, int out_size, void* d_ws, size_t ws_size, hipStream_t stream) {
    static int grid = 0;
    if (grid == 0) {
        if (n_in != 42 || out_size != M * DM || ws_size < WS_END) { fprintf(stderr, "kernel_launch: unexpected shapes (n_in %d out %d ws %zu)\n", n_in, out_size, ws_size); grid = -1; return; }
        int dev = 0, cus = 0, per_cu = 0;
        if (hipGetDevice(&dev) != hipSuccess || hipDeviceGetAttribute(&cus, hipDeviceAttributeMultiprocessorCount, dev) != hipSuccess) { grid = -1; return; }
        if (hipFuncSetAttribute((const void*)mk_fwd, hipFuncAttributeMaxDynamicSharedMemorySize, LDS_BYTES) != hipSuccess) { fprintf(stderr, "kernel_launch: hipFuncSetAttribute failed\n"); grid = -1; return; }
        if (hipOccupancyMaxActiveBlocksPerMultiprocessor(&per_cu, (const void*)mk_fwd, NTHR, LDS_BYTES) != hipSuccess || per_cu < 1) fprintf(stderr, "kernel_launch: occupancy query says %d\n", per_cu);
        (void)hipGetLastError();
        grid = cus > 256 ? 256 : cus;
    }
    if (grid < 0) return;
    (void)hipMemsetAsync((char*)d_ws + WS_CTL, 0, CTL_ZERO_BYTES, stream);
    Args a{};
    for (int i = 0; i < 42; ++i) a.in[i] = (const float*)d_in[i];
    a.out = (float*)d_out; a.ws = (unsigned char*)d_ws;
#if MK_PER_PHASE
    for (int ph = 0; ph < NPH; ++ph) { a.ph_lo = ph; a.ph_hi = ph + 1; hipLaunchKernelGGL(mk_fwd, dim3(grid), dim3(NTHR), LDS_BYTES, stream, a); }
#else
    a.ph_lo = 0; a.ph_hi = NPH;
    hipLaunchKernelGGL(mk_fwd, dim3(grid), dim3(NTHR), LDS_BYTES, stream, a);
#endif
}
```

```cpp
#include <hip/hip_runtime.h>
#include <cstdio>
#include <cstdint>

#ifndef MK_PER_PHASE
#define MK_PER_PHASE 0
#endif

#define LAS __attribute__((address_space(3)))
#define GAS __attribute__((address_space(1)))
typedef unsigned short bf16;
typedef short bf16x8 __attribute__((ext_vector_type(8)));
typedef float f32x4 __attribute__((ext_vector_type(4)));
typedef float f32x2 __attribute__((ext_vector_type(2)));
typedef unsigned u32x4 __attribute__((ext_vector_type(4)));
typedef unsigned u32x2 __attribute__((ext_vector_type(2)));
typedef GAS unsigned gu32;

constexpr int NB = 4, SEQ = 8192, DM = 1024, M = NB * SEQ;
constexpr int NEXP = 32, TOPK = 4;
constexpr int NWAVES = 8, NTHR = 512;
constexpr size_t MiB = 1u << 20;

constexpr size_t WS_CTL = 0, CTL_ZERO_BYTES = 1 * MiB;
constexpr size_t WS_HIST = 1 * MiB;
constexpr size_t WS_TOPE = 2 * MiB;
constexpr size_t WS_TOPG = 3 * MiB;
constexpr size_t WS_TOKSLOT = 4 * MiB;
constexpr size_t WS_SLOTTOK = 5 * MiB;
constexpr size_t WS_AT = 6 * MiB;
constexpr size_t WS_DL = 6 * MiB + 65536;
constexpr size_t WS_WCAT = 8 * MiB;
constexpr size_t WS_WL2 = 13 * MiB;
constexpr size_t WS_WGLU = 14 * MiB;
constexpr size_t WS_WPP = 14 * MiB + 524288;
constexpr size_t WS_WOUT = 15 * MiB;
constexpr size_t WS_WPG = 17 * MiB;
constexpr size_t WS_S5BT = 19 * MiB;
constexpr size_t WS_S5ET = 39 * MiB;
constexpr size_t WS_PBF = 48 * MiB;
constexpr size_t WS_R1 = 64 * MiB;
constexpr size_t WS_RKV = 128 * MiB;
constexpr size_t WS_WAG = 224 * MiB;
constexpr size_t WS_AG = 320 * MiB;
constexpr size_t WS_U = 360 * MiB;
constexpr size_t WS_LP = 392 * MiB;
constexpr size_t WS_LACT = 424 * MiB;
constexpr size_t WS_W1 = 440 * MiB;
constexpr size_t WS_ULOC = 472 * MiB;
constexpr size_t WS_Y1 = 504 * MiB;
constexpr size_t WS_H2 = 64 * MiB;
constexpr size_t WS_WDN = 96 * MiB;
constexpr size_t WS_ACT = 128 * MiB;
constexpr size_t WS_Y = 264 * MiB;
constexpr size_t WS_XB = 400 * MiB;
constexpr size_t WS_WGU = 264 * MiB;
constexpr int RMAX = 139264;
constexpr int MAXEPP = 32;
constexpr size_t WS_END = 560 * MiB;
static_assert(WS_Y + (size_t)RMAX * 1024 <= WS_XB && WS_XB + (size_t)M * 2048 <= WS_END && WS_ACT + (size_t)RMAX * 1024 <= WS_Y, "moe map");

constexpr int CW_BAR = 4096;
constexpr int CW_ROWSS = 65536;
constexpr int CW_PCNT = 131072;

constexpr int LDS_PLAN = 147456;
constexpr int LDS_MISC = 155648;
constexpr int LDS_BYTES = 156672;
constexpr int PL_CNT = 0, PL_PSTART = 32, PL_NPASS = 72, PL_PE0 = 80, PL_PROW0 = 88, PL_TILEE = 128, PL_TMP = 768;

#define LDS_WAIT() asm volatile("s_waitcnt lgkmcnt(0)" ::: "memory")
#define VM_WAIT() asm volatile("s_waitcnt vmcnt(0)" ::: "memory")
__device__ __forceinline__ float bf2f(unsigned b) { return __uint_as_float(b << 16); }
typedef __bf16 bf16n2 __attribute__((ext_vector_type(2)));
__device__ __forceinline__ unsigned cvt_pk_bf16(float lo, float hi) { const f32x2 f = {lo, hi}; const bf16n2 v = __builtin_convertvector(f, bf16n2); return __builtin_bit_cast(unsigned, v); }
__device__ __forceinline__ unsigned pk2(float lo, float hi) { return cvt_pk_bf16(lo, hi); }
__device__ __forceinline__ float lo16(unsigned w) { return __uint_as_float(w << 16); }
__device__ __forceinline__ float hi16(unsigned w) { return __uint_as_float(w & 0xffff0000u); }
__device__ __forceinline__ unsigned pk4_fp8(float a, float b, float c, float d) { unsigned w; asm volatile("" : "=v"(w));     w = (unsigned)__builtin_amdgcn_cvt_pk_fp8_f32(a, b, (int)w, false); w = (unsigned)__builtin_amdgcn_cvt_pk_fp8_f32(c, d, (int)w, true); return w; }
__device__ __forceinline__ f32x4 up4_fp8(unsigned w) { const f32x2 lo = __builtin_amdgcn_cvt_pk_f32_fp8((int)w, false), hi = __builtin_amdgcn_cvt_pk_f32_fp8((int)w, true); return (f32x4){lo.x, lo.y, hi.x, hi.y}; }
__device__ __forceinline__ float frcp(float x) { return __builtin_amdgcn_rcpf(x); }
__device__ __forceinline__ float fsigmoid(float x) { return frcp(1.0f + __expf(-x)); }
__device__ __forceinline__ float ftanh(float x) { const float e = __expf(-2.0f * fabsf(x)); const float t = (1.0f - e) * frcp(1.0f + e); return x < 0.f ? -t : t; }
__device__ __forceinline__ float gelu_tanh(float x) { const float u = 0.7978845608f * (x + 0.044715f * x * x * x); return 0.5f * x * (1.0f + ftanh(u)); }
__device__ __forceinline__ float wave_sum(float v) {
#pragma unroll
    for (int o = 1; o < 64; o <<= 1) v += __shfl_xor(v, o);
    return v;
}
__device__ __forceinline__ float wave_max(float v) {
#pragma unroll
    for (int o = 1; o < 64; o <<= 1) v = fmaxf(v, __shfl_xor(v, o));
    return v;
}

#define XB_TMO      128
#define XB_XCNT(j)  (256  + 64 * (j))
#define XB_XSUB(j)  (1280 + 64 * (j))
#define XB_XGEN(j)  (2304 + 64 * (j))
#define XB_TOP      3328
#define XB_TOPGEN   3392
#define XCD_BAR_WORDS 3456
#define XB_SPIN_CAP (1u << 22)

__device__ __forceinline__ unsigned xb_ld(unsigned* p)              { return __hip_atomic_load(p, __ATOMIC_RELAXED, __HIP_MEMORY_SCOPE_AGENT); }
__device__ __forceinline__ unsigned xb_add(unsigned* p, unsigned v) { return __hip_atomic_fetch_add(p, v, __ATOMIC_RELAXED, __HIP_MEMORY_SCOPE_AGENT); }
__device__ __forceinline__ unsigned xb_xcc_id() { return (unsigned)__builtin_amdgcn_s_getreg((3 << 11) | 20) & 0xFu; }
#define XB_SPIN(cond, bar) do { unsigned _sp = 0; while (cond) { __builtin_amdgcn_s_sleep(1); \
    if ((++_sp & 255u) == 0u) { if (xb_ld(&(bar)[XB_TMO])) break; if (_sp > XB_SPIN_CAP) { atomicAdd(&(bar)[XB_TMO], 1u); break; } } } } while (0)

struct XcdBarrier { unsigned* bar; unsigned x; volatile LAS unsigned* st; int wv; };
__device__ __forceinline__ bool xb_first(int wv) { return wv == 0 && __builtin_amdgcn_mbcnt_hi(~0u, __builtin_amdgcn_mbcnt_lo(~0u, 0u)) == 0u; }

__device__ __forceinline__ XcdBarrier xcd_barrier_post(unsigned* bar, volatile LAS unsigned* st, int wv) {
    XcdBarrier b; b.bar = bar; b.x = xb_xcc_id(); b.st = st; b.wv = wv;
    if (xb_first(wv)) (void)xb_add(&bar[XB_XCNT(b.x)], 1u);
    return b;
}
__device__ __forceinline__ void xcd_barrier_complete(unsigned* bar, unsigned x, unsigned& nloc, unsigned& nx) {
    const unsigned G = gridDim.x * gridDim.y * gridDim.z;
    unsigned sum, cnt, mine, sp = 0u;
    for (;;) {
        sum = 0u; cnt = 0u; mine = 0u;
#pragma unroll
        for (unsigned j = 0; j < 16; ++j) { const unsigned c = xb_ld(&bar[XB_XCNT(j)]); sum += c; cnt += (c > 0u) ? 1u : 0u; mine = (j == x) ? c : mine; }
        if (sum == G) break;
        __builtin_amdgcn_s_sleep(1);
        if ((++sp & 255u) == 0u) { if (xb_ld(&bar[XB_TMO])) break; if (sp > XB_SPIN_CAP) { atomicAdd(&bar[XB_TMO], 1u); break; } }
    }
    nloc = mine > 0u ? mine : 1u; nx = cnt > 0u ? cnt : 1u;
}
__device__ __forceinline__ void xcd_barrier(const XcdBarrier& b) {
    asm volatile("s_waitcnt vmcnt(0)" ::: "memory");
    __syncthreads();
    if (xb_first(b.wv)) {
        unsigned* bar = b.bar;
        __builtin_amdgcn_s_waitcnt(0);
        unsigned nloc = b.st[0], nx = b.st[1];
        if (nloc == 0u) { xcd_barrier_complete(bar, b.x, nloc, nx); b.st[0] = nloc; b.st[1] = nx; }
        const unsigned old = xb_add(&bar[XB_XSUB(b.x)], 1u);
        const unsigned gen = old / nloc;
        if (old + 1u == (gen + 1u) * nloc) {
            __builtin_amdgcn_fence(__ATOMIC_RELEASE, "agent");
            asm volatile("s_waitcnt vmcnt(0)" ::: "memory");
            const unsigned og = xb_add(&bar[XB_TOP], 1u);
            const unsigned tg = og / nx;
            if (og + 1u == (tg + 1u) * nx) xb_add(&bar[XB_TOPGEN], 1u);
            else XB_SPIN(xb_ld(&bar[XB_TOPGEN]) == tg, bar);
            __builtin_amdgcn_fence(__ATOMIC_ACQUIRE, "agent");
            xb_add(&bar[XB_XGEN(b.x)], 1u);
            asm volatile("s_waitcnt vmcnt(0)" ::: "memory");
        } else {
            XB_SPIN(xb_ld(&bar[XB_XGEN(b.x)]) == gen, bar);
            __builtin_amdgcn_fence(__ATOMIC_ACQUIRE, "agent");
            asm volatile("s_waitcnt vmcnt(0)" ::: "memory");
        }
    }
    __syncthreads();
}

#ifndef PG8_WGM
#define PG8_WGM 8
#endif
namespace pg8 {
constexpr int BM = 256, BK = 64, HALF = 128, HTB = HALF * BK * 2, STAGE_BYTES = 8 * HTB, NXCD = 8, WGM = PG8_WGM;
__host__ __device__ __forceinline__ int lds_byte(int r, int c) { const int st = (r >> 4) * 2 + (c >> 5), rr = r & 15, cc = c & 31, ob = rr * 64 + cc * 2; return st * 1024 + (ob ^ (((ob >> 9) & 1) << 5)); }
__host__ __device__ __forceinline__ void stage_rc(int b, int& R, int& C) { const int st = b / 1024, sb = b % 1024, swz = sb ^ (((sb >> 9) & 1) << 5); R = (st >> 1) * 16 + swz / 64; C = (st & 1) * 32 + (swz % 64) / 2; }
__host__ __device__ __forceinline__ int perm32(int rho) { const int n = rho >> 4, i = rho & 15; return 8 * (i >> 2) + 4 * n + (i & 3); }

struct Unit { int pm, pn, aux; };

struct Order {
    int nM, nN, nwg, G, c, i0, i1;
    __device__ __forceinline__ void init(int nM_, int nN_, int G_, int c_) { nM = nM_; nN = nN_; nwg = nM * nN; G = G_; c = c_; i0 = 0; i1 = 1 << 28; }
    __device__ __forceinline__ bool tile(int i, int& pm, int& pn) const {
        i += i0; if (i >= i1) return false;
        const long L = (long)i * G + c; if (L >= nwg) return false;
        int wgid = (int)L; { const int q = nwg / NXCD, r = nwg % NXCD, xcd = wgid % NXCD, off = wgid / NXCD; wgid = (xcd < r ? xcd * (q + 1) : r * (q + 1) + (xcd - r) * q) + off; }
        const int nig = WGM * nN, gid = wgid / nig, fm = gid * WGM, gsz = (nM - fm) < WGM ? (nM - fm) : WGM;
        pm = fm + ((wgid % nig) % gsz); pn = (wgid % nig) / gsz; return true;
    }
};


template <class Epi, class Sched, bool ALIGN_EPI, bool SP2, bool GATHER, bool FP8 = false>
__device__ __forceinline__ void gemm_phase(LAS unsigned char* lds, const int tid, const int K, const int lda, const int ldb, const Sched& S, const Epi& E) {
    const int wid = __builtin_amdgcn_readfirstlane(tid >> 6), lane = tid & 63, wr = wid >> 2, wc = wid & 3, fr = lane & 15, fq = lane >> 4;
    const int nt = K / BK;
    unsigned voffA[2], voffB[2]; int rA[2], cA2[2];
#pragma unroll
    for (int i = 0; i < 2; ++i) { int R, C; stage_rc(tid * 16 + i * 8192, R, C); const int Rb = Epi::PERM ? ((R & ~31) + perm32(R & 31)) : R;
        voffA[i] = (unsigned)(R * lda + C) * 2u; voffB[i] = (unsigned)(Rb * ldb + C) * 2u; rA[i] = R; cA2[i] = C * 2; }
    const size_t kstep = (size_t)(BK * 2);
    const size_t hstepA = (size_t)HALF * lda * 2, hstepB = (size_t)HALF * ldb * 2;
    const unsigned ldsw = (unsigned)wid * 1024u;
    const int aoff = FP8 ? lds_byte(wr * 64 + fr, fq * 16) : lds_byte(wr * 64 + fr, fq * 8), boff = FP8 ? lds_byte(wc * 32 + fr, fq * 16) : lds_byte(wc * 32 + fr, fq * 8);
    unsigned cv0[2] = {0u, 0u}, cv1[2] = {0u, 0u};
#define PG8_SA(b, h) (((b) * 2 + (h)) * HTB)
#define PG8_SB(b, h) ((4 + (b) * 2 + (h)) * HTB)
#define PG8_STAGE(bufoff, gbase, voff) do { _Pragma("unroll") for (int _i = 0; _i < 2; ++_i) \
        __builtin_amdgcn_global_load_lds((const unsigned*)((const char*)(gbase) + (voff)[_i]), (LAS unsigned*)(lds + (bufoff) + ldsw + _i * 8192), 16, 0, 0); } while (0)
#define PG8_NROW(h, i) ((has_next ? *(const LAS unsigned*)(pf_rows + (i) * 512 + (h) * 256 + lane * 4) * (unsigned)(lda * 2) + (unsigned)cA2[i] : ((h) ? cv1[i] : cv0[i])))
#define PG8_STAGE_A(bufoff, ptr, h, nx) do { if constexpr (GATHER) { unsigned _v[2]; if (nx) { asm volatile("" ::: "memory"); _v[0] = PG8_NROW(h, 0); _v[1] = PG8_NROW(h, 1); } else { _v[0] = (h) ? cv1[0] : cv0[0]; _v[1] = (h) ? cv1[1] : cv0[1]; } PG8_STAGE(bufoff, ptr, _v); } \
        else { PG8_STAGE(bufoff, (ptr) + (h) * hstepA, voffA); } } while (0)
#define PG8_LDA(dst, b, h) do { if constexpr (FP8) { _Pragma("unroll") for (int m = 0; m < 4; ++m) { dst##8[m].lo = *(const LAS v4i_*)(lds + PG8_SA(b, h) + aoff + m * 2048); dst##8[m].hi = *(const LAS v4i_*)(lds + PG8_SA(b, h) + aoff + m * 2048 + 16); } } \
        else { _Pragma("unroll") for (int m = 0; m < 4; ++m) _Pragma("unroll") for (int k = 0; k < 2; ++k) dst[m][k] = *(const LAS bf16x8*)(lds + PG8_SA(b, h) + aoff + m * 2048 + k * 1024); } } while (0)
#define PG8_LDB(dst, b, h) do { if constexpr (FP8) { _Pragma("unroll") for (int n = 0; n < 2; ++n) { dst##8[n].lo = *(const LAS v4i_*)(lds + PG8_SB(b, h) + boff + n * 2048); dst##8[n].hi = *(const LAS v4i_*)(lds + PG8_SB(b, h) + boff + n * 2048 + 16); } } \
        else { _Pragma("unroll") for (int n = 0; n < 2; ++n) _Pragma("unroll") for (int k = 0; k < 2; ++k) dst[n][k] = *(const LAS bf16x8*)(lds + PG8_SB(b, h) + boff + n * 2048 + k * 1024); } } while (0)
#define PG8_MMA(ai, bj, At, Bt) do { __builtin_amdgcn_s_setprio(1); _Pragma("unroll") for (int m = 0; m < 4; ++m) _Pragma("unroll") for (int n = 0; n < 2; ++n) { \
        if constexpr (FP8) asm volatile("v_mfma_scale_f32_16x16x128_f8f6f4 %0, %1, %2, %0, %3, %4 op_sel_hi:[0,0,0]" : "+v"(acc[ai][bj][m][n]) : "v"(Bt##8[n]), "v"(At##8[m]), "v"(sclW), "v"(sclA));   \
        else { _Pragma("unroll") for (int k = 0; k < 2; ++k) acc[ai][bj][m][n] = __builtin_amdgcn_mfma_f32_16x16x32_bf16(Bt[n][k], At[m][k], acc[ai][bj][m][n], 0, 0, 0); } } \
        __builtin_amdgcn_s_setprio(0); } while (0)
#define PG8_WAIT_V(n) asm volatile("s_waitcnt vmcnt(" #n ")" ::: "memory")
#define PG8_WAIT_L(n) asm volatile("s_waitcnt lgkmcnt(" #n ")" ::: "memory")
#define PG8_BAR __builtin_amdgcn_s_barrier()
#define PG8_SCHED __builtin_amdgcn_sched_barrier(0)
#define PG8_ROWS(u, d0, d1) do { _Pragma("unroll") for (int _i = 0; _i < 2; ++_i) { const int _r0 = S.a_row(u, rA[_i]), _r1 = S.a_row(u, HALF + rA[_i]); \
        d0[_i] = (unsigned)_r0 * (unsigned)(lda * 2) + (unsigned)cA2[_i]; d1[_i] = (unsigned)_r1 * (unsigned)(lda * 2) + (unsigned)cA2[_i]; } } while (0)
    constexpr int PF_OFF = STAGE_BYTES;
    LAS unsigned char* pf_bias = lds + PF_OFF + wid * 256; LAS unsigned char* pf_rows = lds + PF_OFF + 2048 + wid * 1024;
    Unit cur, nxt; int ui = 0; bool has_next = false;
    if (!S.next(0, cur)) return;
    f32x4 acc[2][2][4][2];
#define PG8_ACC_INIT() do { if constexpr (Epi::ACCINIT) { E.init(acc, pf_bias, fq); } else { _Pragma("unroll") for (int a = 0; a < 2; ++a) _Pragma("unroll") for (int b = 0; b < 2; ++b) _Pragma("unroll") for (int m = 0; m < 4; ++m) \
        _Pragma("unroll") for (int n = 0; n < 2; ++n) acc[a][b][m][n] = (f32x4){0.f, 0.f, 0.f, 0.f}; } } while (0)
    if constexpr (Epi::ACCINIT) { E.pref(pf_bias, cur, wc, lane); PG8_WAIT_V(0); }
    PG8_ACC_INIT();
    typedef int v8i_ __attribute__((ext_vector_type(8))); typedef int v4i_ __attribute__((ext_vector_type(4)));
    bf16x8 At[4][2], B0[2][2], B1[2][2]; v8i_ At8[4], B08[2], B18[2];
    const int sclW = 0x7a7a7a7a, sclA = 0x7f7f7f7f;
    const char* cA = S.a_ptr(cur); const char* cB = S.b_ptr(cur);
    if constexpr (GATHER) { PG8_ROWS(cur, cv0, cv1); }
    if constexpr (SP2) {
        PG8_STAGE(PG8_SB(0, 0), cB, voffB); PG8_STAGE(PG8_SB(0, 1), cB + hstepB, voffB); PG8_STAGE_A(PG8_SA(0, 0), cA, 0, false); PG8_STAGE_A(PG8_SA(0, 1), cA, 1, false);
        if (wr == 1) PG8_BAR;
        PG8_WAIT_V(2); PG8_BAR;
        PG8_STAGE(PG8_SB(1, 0), cB + kstep, voffB); PG8_STAGE_A(PG8_SA(1, 0), cA + kstep, 0, false); PG8_STAGE(PG8_SB(1, 1), cB + hstepB + kstep, voffB);
        PG8_WAIT_V(6); PG8_BAR;
    } else {
        PG8_STAGE(PG8_SB(0, 0), cB, voffB); PG8_STAGE_A(PG8_SA(0, 0), cA, 0, false); PG8_STAGE(PG8_SB(0, 1), cB + hstepB, voffB); PG8_STAGE_A(PG8_SA(0, 1), cA, 1, false);
        if (wr == 1) PG8_BAR;
        PG8_WAIT_V(4); PG8_BAR;
        PG8_STAGE(PG8_SB(1, 0), cB + kstep, voffB); PG8_STAGE_A(PG8_SA(1, 0), cA + kstep, 0, false); PG8_STAGE(PG8_SB(1, 1), cB + hstepB + kstep, voffB);
        PG8_WAIT_V(6); PG8_BAR;
    }
    for (;;) {
        has_next = S.next(ui + 1, nxt);
        const char* nA = has_next ? S.a_ptr(nxt) : cA; const char* nB = has_next ? S.b_ptr(nxt) : cB;
        if constexpr (Epi::ACCINIT) { if (has_next) E.pref(pf_bias, nxt, wc, lane); } else if constexpr (Epi::PREF) E.pref(pf_bias, cur, wc, lane);
        if constexpr (GATHER) { if (has_next) {
#pragma unroll
                for (int _i = 0; _i < 2; ++_i) { __builtin_amdgcn_global_load_lds((const unsigned*)S.a_row_ptr(nxt, rA[_i]), (LAS unsigned*)(pf_rows + _i * 512), 4, 0, 0);
                                                 __builtin_amdgcn_global_load_lds((const unsigned*)S.a_row_ptr(nxt, HALF + rA[_i]), (LAS unsigned*)(pf_rows + _i * 512 + 256), 4, 0, 0); } }
            }
        for (int t = 0; t < nt; t += 2) {
            const bool last = (t == nt - 2);
            const char* a1 = cA + (size_t)(t + 1) * kstep;
            const char* a2 = last ? nA : cA + (size_t)(t + 2) * kstep; const char* b2 = last ? nB : cB + (size_t)(t + 2) * kstep;
            const char* a3 = a2 + kstep; const char* b3 = b2 + kstep;
            if constexpr (SP2) {
            PG8_LDB(B0, 0, 0); PG8_LDB(B1, 0, 1); PG8_SCHED; PG8_LDA(At, 0, 0); PG8_STAGE_A(PG8_SA(1, 1), a1, 1, false);
            PG8_WAIT_V(8); PG8_WAIT_L(0); PG8_BAR; PG8_MMA(0, 0, At, B0); PG8_MMA(0, 1, At, B1); PG8_BAR; PG8_SCHED;
            PG8_LDA(At, 0, 1); PG8_STAGE(PG8_SB(0, 0), b2, voffB); PG8_STAGE(PG8_SB(0, 1), b2 + hstepB, voffB); PG8_STAGE_A(PG8_SA(0, 0), a2, 0, last);
            PG8_WAIT_V(8); PG8_WAIT_L(0); PG8_BAR; PG8_MMA(1, 0, At, B0); PG8_MMA(1, 1, At, B1); PG8_BAR; PG8_SCHED;
            PG8_LDB(B0, 1, 0); PG8_LDB(B1, 1, 1); PG8_SCHED; PG8_LDA(At, 1, 0); PG8_STAGE_A(PG8_SA(0, 1), a2, 1, last);
            PG8_WAIT_V(8); PG8_WAIT_L(0); PG8_BAR; PG8_MMA(0, 0, At, B0); PG8_MMA(0, 1, At, B1); PG8_BAR; PG8_SCHED;
            PG8_LDA(At, 1, 1); PG8_STAGE(PG8_SB(1, 0), b3, voffB); PG8_STAGE(PG8_SB(1, 1), b3 + hstepB, voffB); PG8_STAGE_A(PG8_SA(1, 0), a3, 0, last);
            PG8_WAIT_V(8); PG8_WAIT_L(0); PG8_BAR; PG8_MMA(1, 0, At, B0); PG8_MMA(1, 1, At, B1); PG8_BAR; PG8_SCHED;
            } else {
            PG8_LDB(B0, 0, 0); PG8_SCHED; PG8_LDA(At, 0, 0); PG8_STAGE_A(PG8_SA(1, 1), a1, 1, false);
            PG8_WAIT_L(8); PG8_BAR; PG8_WAIT_L(0); PG8_MMA(0, 0, At, B0); PG8_BAR; PG8_SCHED;
            PG8_LDB(B1, 0, 1); PG8_STAGE(PG8_SB(0, 0), b2, voffB);
            PG8_BAR; PG8_WAIT_L(0); PG8_MMA(0, 1, At, B1); PG8_BAR;
            PG8_LDA(At, 0, 1); PG8_STAGE_A(PG8_SA(0, 0), a2, 0, last);
            PG8_BAR; PG8_WAIT_L(0); PG8_MMA(1, 0, At, B0); PG8_BAR; PG8_SCHED;
            PG8_STAGE(PG8_SB(0, 1), b2 + hstepB, voffB);
            PG8_WAIT_V(6); PG8_BAR; PG8_MMA(1, 1, At, B1); PG8_BAR;
            PG8_LDB(B0, 1, 0); PG8_SCHED; PG8_LDA(At, 1, 0); PG8_STAGE_A(PG8_SA(0, 1), a2, 1, last);
            PG8_WAIT_L(8); PG8_BAR; PG8_WAIT_L(0); PG8_MMA(0, 0, At, B0); PG8_BAR; PG8_SCHED;
            PG8_LDB(B1, 1, 1); PG8_STAGE(PG8_SB(1, 0), b3, voffB);
            PG8_BAR; PG8_WAIT_L(0); PG8_MMA(0, 1, At, B1); PG8_BAR;
            PG8_LDA(At, 1, 1); PG8_STAGE_A(PG8_SA(1, 0), a3, 0, last);
            PG8_BAR; PG8_WAIT_L(0); PG8_MMA(1, 0, At, B0); PG8_BAR; PG8_SCHED;
            PG8_STAGE(PG8_SB(1, 1), b3 + hstepB, voffB);
            PG8_WAIT_V(6); PG8_BAR; PG8_MMA(1, 1, At, B1); PG8_BAR;
            }
        }
        if constexpr (ALIGN_EPI) { if (wr == 0) PG8_BAR; }
        if constexpr (FP8) asm volatile("s_nop 15\n\ts_nop 15" ::: "memory");
        E(acc, cur, wr, wc, fr, fq, pf_bias);
        if (!has_next) break;
        PG8_ACC_INIT();
        cur = nxt; cA = nA; cB = nB; ++ui;
        if constexpr (GATHER) { asm volatile("" ::: "memory"); cv0[0] = PG8_NROW(0, 0); cv0[1] = PG8_NROW(0, 1); cv1[0] = PG8_NROW(1, 0); cv1[1] = PG8_NROW(1, 1); }
        if constexpr (ALIGN_EPI) { if (wr == 1) PG8_BAR; }
    }
    PG8_WAIT_V(0);
    if constexpr (!ALIGN_EPI) { if (wr == 0) PG8_BAR; }
    PG8_BAR;
#undef PG8_SA
#undef PG8_SB
#undef PG8_STAGE
#undef PG8_STAGE_A
#undef PG8_NROW
#undef PG8_LDA
#undef PG8_LDB
#undef PG8_MMA
#undef PG8_WAIT_V
#undef PG8_WAIT_L
#undef PG8_BAR
#undef PG8_SCHED
#undef PG8_ROWS
#undef PG8_ACC_INIT
}
}

using pg8::Unit;
struct SchedPlain : pg8::Order {
    const char* A; const char* B; size_t a_tile, b_tile;
    __device__ __forceinline__ bool next(int i, Unit& u) const { u.aux = 0; return tile(i, u.pm, u.pn); }
    __device__ __forceinline__ const char* a_ptr(const Unit& u) const { return A + (size_t)u.pm * a_tile; }
    __device__ __forceinline__ const char* b_ptr(const Unit& u) const { return B + (size_t)u.pn * b_tile; }
    __device__ __forceinline__ int a_row(const Unit&, int) const { return 0; }
    __device__ __forceinline__ const int* a_row_ptr(const Unit&, int) const { return nullptr; }
};
struct SchedS5 : pg8::Order {
    const char* A; const char* B; size_t a_tile, b_tile, b_group;
    __device__ __forceinline__ bool next(int i, Unit& u) const { u.aux = 0; return tile(i, u.pm, u.pn); }
    __device__ __forceinline__ const char* a_ptr(const Unit& u) const { return A + (size_t)u.pm * a_tile; }
    __device__ __forceinline__ const char* b_ptr(const Unit& u) const { return B + (size_t)(u.pm >> 2) * b_group + (size_t)u.pn * b_tile; }
    __device__ __forceinline__ int a_row(const Unit&, int) const { return 0; }
    __device__ __forceinline__ const int* a_row_ptr(const Unit&, int) const { return nullptr; }
};
template <bool GATHER> struct SchedMoe : pg8::Order {
    const char* A; const char* B; size_t a_tile, b_tile, b_exp; const LAS int* tile_e; int tile0, e0; const int* slot_tok; int row0;
    __device__ __forceinline__ bool next(int i, Unit& u) const { const bool ok = tile(i, u.pm, u.pn); u.aux = ok ? tile_e[tile0 + u.pm] : 0; return ok; }
    __device__ __forceinline__ const char* a_ptr(const Unit& u) const { return GATHER ? A : A + (size_t)u.pm * a_tile; }
    __device__ __forceinline__ const char* b_ptr(const Unit& u) const { return B + (size_t)(u.aux - e0) * b_exp + (size_t)u.pn * b_tile; }
    __device__ __forceinline__ int a_row(const Unit& u, int r) const { return slot_tok[row0 + u.pm * 256 + r]; }
    __device__ __forceinline__ const int* a_row_ptr(const Unit& u, int r) const { return slot_tok + row0 + u.pm * 256 + r; }
};

__device__ __forceinline__ void st8(bf16* p, const f32x4 v0, const f32x4 v1) {
    u32x4 w; w.x = cvt_pk_bf16(v0[0], v0[1]); w.y = cvt_pk_bf16(v0[2], v0[3]); w.z = cvt_pk_bf16(v1[0], v1[1]); w.w = cvt_pk_bf16(v1[2], v1[3]); *(u32x4*)p = w;
}
__device__ __forceinline__ void ld8(const bf16* p, f32x4& v0, f32x4& v1) {
    const u32x4 w = *(const u32x4*)p; v0 = (f32x4){lo16(w.x), hi16(w.x), lo16(w.y), hi16(w.y)}; v1 = (f32x4){lo16(w.z), hi16(w.z), lo16(w.w), hi16(w.w)};
}
#define EPI_LOOP_AM _Pragma("unroll") for (int ai = 0; ai < 2; ++ai) _Pragma("unroll") for (int m = 0; m < 4; ++m)
#define EPI_ARGS f32x4 (&acc)[2][2][4][2], const Unit& u, int wr, int wc, int fr, int fq, const LAS unsigned char* pf

struct EpiProj { static constexpr bool PERM = true, PREF = false, ACCINIT = false; bf16 *AG, *RKV, *LP;
    __device__ __forceinline__ void operator()(EPI_ARGS) const {
        const int row0 = u.pm * 256 + wr * 64 + fr;
        if (u.pn < 2) { const int col0 = u.pn * 256 + wc * 32 + 8 * fq;
            EPI_LOOP_AM { const int row = row0 + ai * 128 + m * 16;
#pragma unroll
                for (int bj = 0; bj < 2; ++bj) { const int c = col0 + bj * 128; st8(AG + ((size_t)((c >> 4) * 1024 + (row >> 5))) * 640 + (row & 31) * 16 + (c & 15), acc[ai][bj][m][0], acc[ai][bj][m][1]); } }
        } else {
            bf16* base; int ldc, c0;
            if (u.pn < 8) { base = RKV; ldc = 1536; c0 = (u.pn - 2) * 256; } else { base = LP; ldc = 512; c0 = (u.pn - 8) * 256; }
            const int col0 = c0 + wc * 32 + 8 * fq;
            EPI_LOOP_AM { bf16* rowp = base + (size_t)(row0 + ai * 128 + m * 16) * ldc + col0;
#pragma unroll
                for (int bj = 0; bj < 2; ++bj) st8(rowp + bj * 128, acc[ai][bj][m][0], acc[ai][bj][m][1]); }
        }
    }
};
struct EpiBf16Plain { static constexpr bool PERM = true, PREF = false, ACCINIT = false; bf16* O; int ldc;
    __device__ __forceinline__ void operator()(EPI_ARGS) const {
        const int row0 = u.pm * 256 + wr * 64 + fr, col0 = u.pn * 256 + wc * 32 + 8 * fq;
        EPI_LOOP_AM { bf16* rowp = O + (size_t)(row0 + ai * 128 + m * 16) * ldc + col0;
#pragma unroll
            for (int bj = 0; bj < 2; ++bj) st8(rowp + bj * 128, acc[ai][bj][m][0], acc[ai][bj][m][1]); }
    }
};
struct EpiF32 { static constexpr bool PERM = false, PREF = false, ACCINIT = false; float* C; int ldc;
    __device__ __forceinline__ void operator()(EPI_ARGS) const {
        const int row0 = u.pm * 256 + wr * 64 + fr, col0 = u.pn * 256 + wc * 32 + 4 * fq;
        EPI_LOOP_AM { float* rowp = C + (size_t)(row0 + ai * 128 + m * 16) * ldc + col0;
#pragma unroll
            for (int bj = 0; bj < 2; ++bj)
#pragma unroll
                for (int n = 0; n < 2; ++n) *(f32x4*)(rowp + bj * 128 + n * 16) = acc[ai][bj][m][n]; }
    }
};
struct EpiS5Y { static constexpr bool PERM = true, PREF = false, ACCINIT = false; const bf16* AG; const float* dskip; bf16* Y1;
    __device__ __forceinline__ void operator()(EPI_ARGS) const {
        const int g = u.pm >> 2, crow0 = (u.pm & 3) * 256 + wr * 64 + fr, col0 = u.pn * 256 + wc * 32 + 8 * fq;
        EPI_LOOP_AM { const int crow = crow0 + ai * 128 + m * 16;
#pragma unroll
            for (int bj = 0; bj < 2; ++bj) { const int col = col0 + bj * 128, t = col >> 4, c = col & 15;
                f32x4 u0, u1; ld8(AG + ((size_t)(g * 1024 + crow)) * 640 + col, u0, u1);
                const f32x4 d0 = *(const f32x4*)(dskip + g * 16 + c), d1 = *(const f32x4*)(dskip + g * 16 + c + 4);
                f32x4 v0 = acc[ai][bj][m][0] + d0 * u0, v1 = acc[ai][bj][m][1] + d1 * u1;
#pragma unroll
                for (int j = 0; j < 4; ++j) { v0[j] = gelu_tanh(v0[j]); v1[j] = gelu_tanh(v1[j]); }
                st8(Y1 + (size_t)(crow * 32 + t) * 512 + g * 16 + c, v0, v1); } }
    }
};
struct EpiGlu { static constexpr bool PERM = true, PREF = false, ACCINIT = false; const bf16* Y1; bf16* MIX;
    __device__ __forceinline__ void operator()(EPI_ARGS) const {
        const int row0 = u.pm * 256 + wr * 64 + fr, col0 = u.pn * 256 + wc * 32 + 8 * fq;
        EPI_LOOP_AM { const int row = row0 + ai * 128 + m * 16;
#pragma unroll
            for (int bj = 0; bj < 2; ++bj) { const int col = col0 + bj * 128; f32x4 y0, y1v; ld8(Y1 + (size_t)row * 512 + col, y0, y1v);
                f32x4 v0, v1;
#pragma unroll
                for (int j = 0; j < 4; ++j) { v0[j] = y0[j] * fsigmoid(acc[ai][bj][m][0][j]); v1[j] = y1v[j] * fsigmoid(acc[ai][bj][m][1][j]); }
                st8(MIX + (size_t)row * 1024 + col, v0, v1); } }
    }
};
struct EpiResid { static constexpr bool PERM = true, PREF = false, ACCINIT = false; const float* X; bf16* O;
    __device__ __forceinline__ void operator()(EPI_ARGS) const {
        const int row0 = u.pm * 256 + wr * 64 + fr, col0 = u.pn * 256 + wc * 32 + 8 * fq;
        EPI_LOOP_AM { const size_t off = (size_t)(row0 + ai * 128 + m * 16) * 1024 + col0;
#pragma unroll
            for (int bj = 0; bj < 2; ++bj) { const f32x4 x0 = __builtin_nontemporal_load((const f32x4*)(X + off + bj * 128)), x1 = __builtin_nontemporal_load((const f32x4*)(X + off + bj * 128 + 4)); st8(O + off + bj * 128, x0 + acc[ai][bj][m][0], x1 + acc[ai][bj][m][1]); } }
    }
};
struct EpiGU { static constexpr bool PERM = true, PREF = true, ACCINIT = true; unsigned char* ACT; const float* bg; const float* bu;
    __device__ __forceinline__ void pref(LAS unsigned char* pf, const Unit& u, int wc, int lane) const {
        const float* src = ((lane & 32) ? bu : bg) + u.aux * 1024 + u.pn * 128 + wc * 32 + (lane & 31);
        __builtin_amdgcn_global_load_lds((const unsigned*)src, (LAS unsigned*)pf, 4, 0, 0); }
    __device__ __forceinline__ void init(f32x4 (&acc)[2][2][4][2], const LAS unsigned char* pf, int fq) const {
        const f32x4 one = {1.f, 1.f, 1.f, 1.f};
        const f32x4 g0 = *(const LAS f32x4*)(pf + 32 * fq), g1 = *(const LAS f32x4*)(pf + 32 * fq + 16), u0 = *(const LAS f32x4*)(pf + 128 + 32 * fq) + one, u1 = *(const LAS f32x4*)(pf + 128 + 32 * fq + 16) + one;
#pragma unroll
        for (int ai = 0; ai < 2; ++ai)
#pragma unroll
            for (int m = 0; m < 4; ++m) { acc[ai][0][m][0] = g0; acc[ai][0][m][1] = g1; acc[ai][1][m][0] = u0; acc[ai][1][m][1] = u1; } }
    __device__ __forceinline__ void operator()(EPI_ARGS) const {
        const int row0 = u.pm * 256 + wr * 64 + fr + (fq & 1) * 16, col = u.pn * 128 + wc * 32 + (fq >> 1) * 16;
#pragma unroll
        for (int ai = 0; ai < 2; ++ai)
#pragma unroll
            for (int mp = 0; mp < 2; ++mp) { u32x2 w[2];
#pragma unroll
                for (int q = 0; q < 2; ++q) { const int m = 2 * mp + q; f32x4 v0, v1;
#pragma unroll
                    for (int j = 0; j < 4; ++j) {
                        const float gt0 = fminf(acc[ai][0][m][0][j], 7.0f), up0 = __builtin_amdgcn_fmed3f(acc[ai][1][m][0][j], -6.0f, 8.0f);
                        const float gt1 = fminf(acc[ai][0][m][1][j], 7.0f), up1 = __builtin_amdgcn_fmed3f(acc[ai][1][m][1][j], -6.0f, 8.0f);
                        v0[j] = (up0 * gt0) * frcp(1.0f + __builtin_amdgcn_exp2f(gt0 * -2.4554669f)); v1[j] = (up1 * gt1) * frcp(1.0f + __builtin_amdgcn_exp2f(gt1 * -2.4554669f)); }
                    w[q].x = pk4_fp8(v0[0], v0[1], v0[2], v0[3]); w[q].y = pk4_fp8(v1[0], v1[1], v1[2], v1[3]); }
                const auto rx = __builtin_amdgcn_permlane16_swap(w[0].x, w[1].x, false, false), ry = __builtin_amdgcn_permlane16_swap(w[0].y, w[1].y, false, false);
                *(u32x4*)(ACT + (size_t)(row0 + ai * 128 + mp * 32) * 1024 + col) = (u32x4){rx[0], ry[0], rx[1], ry[1]}; }
    }
};
struct EpiDown { static constexpr bool PERM = true, PREF = true, ACCINIT = true; unsigned char* Y; const float* bd;
    __device__ __forceinline__ void pref(LAS unsigned char* pf, const Unit& u, int wc, int lane) const {
        const float* src = bd + u.aux * 1024 + u.pn * 256 + (lane >> 5) * 128 + wc * 32 + (lane & 31);
        __builtin_amdgcn_global_load_lds((const unsigned*)src, (LAS unsigned*)pf, 4, 0, 0); }
    __device__ __forceinline__ void init(f32x4 (&acc)[2][2][4][2], const LAS unsigned char* pf, int fq) const {
#pragma unroll
        for (int bj = 0; bj < 2; ++bj) { const f32x4 b0 = *(const LAS f32x4*)(pf + 128 * bj + 32 * fq), b1 = *(const LAS f32x4*)(pf + 128 * bj + 32 * fq + 16);
#pragma unroll
            for (int ai = 0; ai < 2; ++ai)
#pragma unroll
                for (int m = 0; m < 4; ++m) { acc[ai][bj][m][0] = b0; acc[ai][bj][m][1] = b1; } } }
    __device__ __forceinline__ void operator()(EPI_ARGS) const {
        const int row0 = u.pm * 256 + wr * 64 + fr, col0 = u.pn * 256 + wc * 32 + (fq >> 1) * 16 + (fq & 1) * 128;
        EPI_LOOP_AM { unsigned char* rowp = Y + (size_t)(row0 + ai * 128 + m * 16) * 1024 + col0; u32x2 w[2];
#pragma unroll
            for (int bj = 0; bj < 2; ++bj) { const f32x4 v0 = acc[ai][bj][m][0], v1 = acc[ai][bj][m][1]; w[bj].x = pk4_fp8(v0[0], v0[1], v0[2], v0[3]); w[bj].y = pk4_fp8(v1[0], v1[1], v1[2], v1[3]); }
            const auto rx = __builtin_amdgcn_permlane16_swap(w[0].x, w[1].x, false, false), ry = __builtin_amdgcn_permlane16_swap(w[0].y, w[1].y, false, false);
            *(u32x4*)rowp = (u32x4){rx[0], ry[0], rx[1], ry[1]}; }
    }
};
struct EpiPle { static constexpr bool PERM = true, PREF = false, ACCINIT = false; const bf16* PP; bf16* O;
    __device__ __forceinline__ void operator()(EPI_ARGS) const {
        const int row0 = u.pm * 256 + wr * 64 + fr, col0 = u.pn * 256 + wc * 32 + 8 * fq;
        EPI_LOOP_AM { const size_t off = (size_t)(row0 + ai * 128 + m * 16) * 1024 + col0;
#pragma unroll
            for (int bj = 0; bj < 2; ++bj) { f32x4 p0, p1, x0, x1; ld8(PP + off + bj * 128, p0, p1); ld8(O + off + bj * 128, x0, x1);
#pragma unroll
                for (int j = 0; j < 4; ++j) { x0[j] += p0[j] * fsigmoid(acc[ai][bj][m][0][j]); x1[j] += p1[j] * fsigmoid(acc[ai][bj][m][1][j]); }
                st8(O + off + bj * 128, x0, x1); } }
    }
};

struct EpiNull { static constexpr bool PERM = true, PREF = false, ACCINIT = false; __device__ __forceinline__ void operator()(EPI_ARGS) const { } };
struct EpiPleNorm { static constexpr bool PERM = true, PREF = false, ACCINIT = false; const bf16* PP; const bf16* XIN; float* OUT; const float* gfin; float* rowss; unsigned* pcnt;
    __device__ __forceinline__ void operator()(EPI_ARGS) const {
        const int row0 = u.pm * 256 + wr * 64 + fr, col0 = u.pn * 256 + wc * 32 + 8 * fq;
        EPI_LOOP_AM { const size_t off = (size_t)(row0 + ai * 128 + m * 16) * 1024 + col0; float s = 0.f;
#pragma unroll
            for (int bj = 0; bj < 2; ++bj) { f32x4 p0, p1, x0, x1; ld8(PP + off + bj * 128, p0, p1); ld8(XIN + off + bj * 128, x0, x1);
#pragma unroll
                for (int j = 0; j < 4; ++j) { x0[j] += p0[j] * fsigmoid(acc[ai][bj][m][0][j]); x1[j] += p1[j] * fsigmoid(acc[ai][bj][m][1][j]); s += x0[j] * x0[j] + x1[j] * x1[j]; }
                acc[ai][bj][m][0] = x0; acc[ai][bj][m][1] = x1; }
            s += __shfl_xor(s, 16); s += __shfl_xor(s, 32);
            if (fq == 0) atomicAdd(rowss + row0 + ai * 128 + m * 16, s); }
        asm volatile("s_waitcnt vmcnt(0)" ::: "memory");
        unsigned* cnt = pcnt + 64 * u.pm;
        if ((fr | fq) == 0) __hip_atomic_fetch_add(cnt, 1u, __ATOMIC_RELAXED, __HIP_MEMORY_SCOPE_AGENT);
        { unsigned sp = 0; while (__builtin_amdgcn_readfirstlane(__hip_atomic_load(cnt, __ATOMIC_RELAXED, __HIP_MEMORY_SCOPE_AGENT)) < 32u) { __builtin_amdgcn_s_sleep(2); if (++sp > (1u << 22)) break; } }
        f32x4 gv[2][2];
#pragma unroll
        for (int bj = 0; bj < 2; ++bj) { gv[bj][0] = *(const f32x4*)(gfin + col0 + bj * 128); gv[bj][1] = *(const f32x4*)(gfin + col0 + bj * 128 + 4); }
        EPI_LOOP_AM { const int row = row0 + ai * 128 + m * 16; const float ssr = __hip_atomic_load(rowss + row, __ATOMIC_RELAXED, __HIP_MEMORY_SCOPE_AGENT); const float rinv = rsqrtf(ssr * (1.f / 1024.f) + 1e-6f);
            float* orow = OUT + (size_t)row * 1024 + col0;
#pragma unroll
            for (int bj = 0; bj < 2; ++bj) { __builtin_nontemporal_store(acc[ai][bj][m][0] * rinv * gv[bj][0], (f32x4*)(orow + bj * 128)); __builtin_nontemporal_store(acc[ai][bj][m][1] * rinv * gv[bj][1], (f32x4*)(orow + bj * 128 + 4)); } }
    }
};

struct Ctx { LAS unsigned char* lds; int tid, lane, wave, G, wg, gw, NGW; };

template <int NBW>
__device__ __forceinline__ void transpose_item(const float* W, int N, int k0, int n0, bf16* dst, int ldk, const float* scl, int flip, LAS float* scr, int lane) {
    constexpr int LPR = NBW / 4, RPI = 64 / LPR, NI = 64 / RPI;
    const int rr = lane / LPR, cc = (lane % LPR) * 4;
    f32x4 v[NI];
#pragma unroll
    for (int i = 0; i < NI; ++i) v[i] = *(const f32x4*)(W + (size_t)(k0 + i * RPI + rr) * N + n0 + cc);
#pragma unroll
    for (int i = 0; i < NI; ++i) { const int kk = i * RPI + rr; f32x4 x = v[i];
        if (scl) { const float s0 = scl[k0 + kk]; const float f = flip ? (1.0f - s0) : s0; x = x * f; }
        LAS float* d = scr + kk * 65 + cc; d[0] = x.x; d[1] = x.y; d[2] = x.z; d[3] = x.w; }
    LDS_WAIT(); asm volatile("" ::: "memory");
    const int c = lane & 7;
#pragma unroll
    for (int j = 0; j < NBW / 8; ++j) { const int n = (lane >> 3) + 8 * j; const LAS float* s = scr + (8 * c) * 65 + n;
        u32x4 o; o.x = pk2(s[0 * 65], s[1 * 65]); o.y = pk2(s[2 * 65], s[3 * 65]); o.z = pk2(s[4 * 65], s[5 * 65]); o.w = pk2(s[6 * 65], s[7 * 65]);
        *(u32x4*)(dst + (size_t)n * ldk + 8 * c) = o; }
    LDS_WAIT(); asm volatile("" ::: "memory");
}
struct F8Item { f32x4 v[16]; };
__device__ __forceinline__ void f8_issue(const float* W, int N, int k0, int n0, int lane, F8Item& it) {
    const int kq = lane >> 3, cc = (lane & 7) * 4;
#pragma unroll
    for (int i = 0; i < 16; ++i) it.v[i] = __builtin_nontemporal_load((const f32x4*)(W + (size_t)(k0 + 16 * kq + i) * N + n0 + cc));
}
__device__ __forceinline__ void f8_finish(const F8Item& it, unsigned char* dst, int ldk, float scale, LAS float*, int lane) {
    const int kq = lane >> 3, cc = (lane & 7) * 4;
#pragma unroll
    for (int j = 0; j < 4; ++j) { u32x4 o;
        o.x = pk4_fp8(it.v[0][j] * scale, it.v[1][j] * scale, it.v[2][j] * scale, it.v[3][j] * scale); o.y = pk4_fp8(it.v[4][j] * scale, it.v[5][j] * scale, it.v[6][j] * scale, it.v[7][j] * scale);
        o.z = pk4_fp8(it.v[8][j] * scale, it.v[9][j] * scale, it.v[10][j] * scale, it.v[11][j] * scale); o.w = pk4_fp8(it.v[12][j] * scale, it.v[13][j] * scale, it.v[14][j] * scale, it.v[15][j] * scale);
        *(u32x4*)(dst + (size_t)(cc + j) * ldk + 16 * kq) = o; }
}
__device__ __forceinline__ void transpose_item_fp8(const float* W, int N, int k0, int n0, unsigned char* dst, int ldk, float scale, LAS float* scr, int lane) {
    F8Item it; f8_issue(W, N, k0, n0, lane, it); f8_finish(it, dst, ldk, scale, scr, lane);
}
__device__ __forceinline__ void transpose_matrix(const Ctx& cx, const float* W, int K, int N, bf16* WT, int row_off, int ldk, int koff, const float* scl, int flip) {
    LAS float* scr = (LAS float*)(cx.lds + cx.wave * 16640);
    const int nblk = N / 64, nitems = (K / 64) * nblk;
    for (int it = cx.gw; it < nitems; it += cx.NGW) { const int kb = it / nblk, nb = it % nblk;
        transpose_item<64>(W, N, 64 * kb, 64 * nb, WT + (size_t)(row_off + 64 * nb) * ldk + koff + 64 * kb, ldk, scl, flip, scr, cx.lane); }
}
__device__ __forceinline__ void rms_row_to_bf16(const float* xrow, const float* g, bf16* orow, int lane) {
    const f32x4* xr = (const f32x4*)xrow + lane; const f32x4* gr = (const f32x4*)g + lane;
    f32x4 v[4]; float s = 0.f;
#pragma unroll
    for (int j = 0; j < 4; ++j) { v[j] = xr[64 * j]; s += (v[j].x * v[j].x + v[j].y * v[j].y) + (v[j].z * v[j].z + v[j].w * v[j].w); }
    const float rinv = rsqrtf(wave_sum(s) * (1.f / 1024.f) + 1e-6f);
    u32x2* o8 = (u32x2*)orow + lane;
#pragma unroll
    for (int j = 0; j < 4; ++j) { const f32x4 gg = gr[64 * j]; u32x2 w; w.x = pk2(v[j].x * rinv * gg.x, v[j].y * rinv * gg.y); w.y = pk2(v[j].z * rinv * gg.z, v[j].w * rinv * gg.w); o8[64 * j] = w; }
}

__device__ __forceinline__ void rms_rows2_to_bf16(const float* xa, const float* xb, const float* g, bf16* oa, bf16* ob, int lane) {
    const f32x4* ra = (const f32x4*)xa + lane; const f32x4* rb = (const f32x4*)xb + lane; const f32x4* gr = (const f32x4*)g + lane;
    f32x4 va[4], vb[4]; float sa = 0.f, sb = 0.f;
#pragma unroll
    for (int j = 0; j < 4; ++j) { va[j] = __builtin_nontemporal_load(ra + 64 * j); vb[j] = __builtin_nontemporal_load(rb + 64 * j); }
#pragma unroll
    for (int j = 0; j < 4; ++j) { sa += (va[j].x * va[j].x + va[j].y * va[j].y) + (va[j].z * va[j].z + va[j].w * va[j].w); sb += (vb[j].x * vb[j].x + vb[j].y * vb[j].y) + (vb[j].z * vb[j].z + vb[j].w * vb[j].w); }
#pragma unroll
    for (int o = 1; o < 64; o <<= 1) { sa += __shfl_xor(sa, o); sb += __shfl_xor(sb, o); }
    const float ia = rsqrtf(sa * (1.f / 1024.f) + 1e-6f), ib = rsqrtf(sb * (1.f / 1024.f) + 1e-6f);
    u32x2* pa = (u32x2*)oa + lane; u32x2* pb = (u32x2*)ob + lane;
#pragma unroll
    for (int j = 0; j < 4; ++j) { const f32x4 gg = gr[64 * j]; u32x2 w; w.x = pk2(va[j].x * ia * gg.x, va[j].y * ia * gg.y); w.y = pk2(va[j].z * ia * gg.z, va[j].w * ia * gg.w); pa[64 * j] = w;
        w.x = pk2(vb[j].x * ib * gg.x, vb[j].y * ib * gg.y); w.y = pk2(vb[j].z * ib * gg.z, vb[j].w * ib * gg.w); pb[64 * j] = w; }
}

__device__ __forceinline__ void s5_tables_item(const Ctx& cx, int g, int part, const float* lam_re, const float* lam_im, const float* log_dt, const float* b_re, const float* b_im, const float* c_re, const float* c_im,
                                               bf16* BT, bf16* ET, float* AT) {
    LAS float* apr = (LAS float*)cx.lds; LAS float* api = apr + 33 * 64; LAS float* bbr = api + 33 * 64; LAS float* bbi = bbr + 1024; LAS float* cr = bbi + 1024; LAS float* ci = cr + 1024; LAS float* kt = ci + 1024;
    const int tid = cx.tid;
    const float dt = __expf(log_dt[g]);
    for (int idx = tid; idx < 33 * 64; idx += NTHR) { const int j = idx >> 6, p = idx & 63;
        const float lre = fminf(lam_re[g * 64 + p], -1e-4f), lim = lam_im[g * 64 + p];
        const float mag = expf(lre * dt * (float)j), ang = lim * dt * (float)j; float sn, cs; sincosf(ang, &sn, &cs);
        apr[idx] = mag * cs; api[idx] = mag * sn; }
    for (int idx = tid; idx < 1024; idx += NTHR) { const int p = idx >> 4;
        const float lre = fminf(lam_re[g * 64 + p], -1e-4f), lim = lam_im[g * 64 + p];
        const float mag = expf(lre * dt); float sn, cs; sincosf(lim * dt, &sn, &cs); const float lbr = mag * cs, lbi = mag * sn;
        const float den = lre * lre + lim * lim, zr = lbr - 1.0f; const float cor = (zr * lre + lbi * lim) / den, coi = (lbi * lre - zr * lim) / den;
        const float br = b_re[g * 1024 + idx], bi = b_im[g * 1024 + idx];
        bbr[idx] = cor * br - coi * bi; bbi[idx] = cor * bi + coi * br;
        cr[idx] = c_re[g * 1024 + idx]; ci[idx] = c_im[g * 1024 + idx]; }
    __syncthreads();
    if (tid < 64) { const int jl = tid >> 4, c = tid & 15, j = 4 * part + jl; float acc[16];
#pragma unroll
        for (int i = 0; i < 16; ++i) acc[i] = 0.f;
        for (int p = 0; p < 64; ++p) { const float ar = apr[j * 64 + p], ai = api[j * 64 + p], xr = cr[c * 64 + p], xi = ci[c * 64 + p];
            const float car = xr * ar - xi * ai, cai = xr * ai + xi * ar;
#pragma unroll
            for (int v4 = 0; v4 < 4; ++v4) { const f32x4 br = *(const LAS f32x4*)(bbr + p * 16 + 4 * v4), bi = *(const LAS f32x4*)(bbi + p * 16 + 4 * v4);
                acc[4 * v4 + 0] += car * br.x - cai * bi.x; acc[4 * v4 + 1] += car * br.y - cai * bi.y; acc[4 * v4 + 2] += car * br.z - cai * bi.z; acc[4 * v4 + 3] += car * br.w - cai * bi.w; } }
#pragma unroll
        for (int i = 0; i < 16; ++i) kt[jl * 256 + c * 16 + i] = acc[i]; }
    __syncthreads();
    bf16* BTg = BT + (size_t)g * 512 * 640; bf16* ETg = ET + (size_t)g * 256 * 512;
    for (int idx = tid; idx < 4096; idx += NTHR) { const int hf = idx & 1, c = (idx >> 1) & 15, t = (idx >> 5) & 31, jl = idx >> 10, j = 4 * part + jl;
        if (t >= j) { const LAS float* s = kt + jl * 256 + c * 16 + hf * 8; u32x4 o; o.x = pk2(s[0], s[1]); o.y = pk2(s[2], s[3]); o.z = pk2(s[4], s[5]); o.w = pk2(s[6], s[7]);
            *(u32x4*)(BTg + (size_t)(t * 16 + c) * 640 + (t - j) * 16 + hf * 8) = o; } }
    for (int idx = tid; idx < 4096; idx += NTHR) { const int hf = idx & 1, c = (idx >> 1) & 15, s = (idx >> 5) & 31, t = 4 * part + (idx >> 10);
        if (s > t) *(u32x4*)(BTg + (size_t)(t * 16 + c) * 640 + s * 16 + hf * 8) = (u32x4){0u, 0u, 0u, 0u}; }
    for (int idx = tid; idx < 1024; idx += NTHR) { const int ch = idx & 15, c = (idx >> 4) & 15, t = 4 * part + (idx >> 8); const int im = ch >> 3, p0 = (ch & 7) * 8; float v[8];
#pragma unroll
        for (int q = 0; q < 8; ++q) { const int p = p0 + q; const float ar = apr[(t + 1) * 64 + p], ai = api[(t + 1) * 64 + p], xr = cr[c * 64 + p], xi = ci[c * 64 + p];
            v[q] = im ? -(xr * ai + xi * ar) : (xr * ar - xi * ai); }
        u32x4 o; o.x = pk2(v[0], v[1]); o.y = pk2(v[2], v[3]); o.z = pk2(v[4], v[5]); o.w = pk2(v[6], v[7]);
        *(u32x4*)(BTg + (size_t)(t * 16 + c) * 640 + 512 + im * 64 + p0) = o; }
    for (int idx = tid; idx < 1024; idx += NTHR) { const int hf = idx & 1, sl = (idx >> 1) & 3, n = idx >> 3, s = 4 * part + sl, p = n & 63, im = n >> 6; float v[8];
        const float ar = apr[(31 - s) * 64 + p], ai = api[(31 - s) * 64 + p];
#pragma unroll
        for (int q = 0; q < 8; ++q) { const float br = bbr[p * 16 + hf * 8 + q], bi = bbi[p * 16 + hf * 8 + q]; v[q] = im ? (ar * bi + ai * br) : (ar * br - ai * bi); }
        u32x4 o; o.x = pk2(v[0], v[1]); o.y = pk2(v[2], v[3]); o.z = pk2(v[4], v[5]); o.w = pk2(v[6], v[7]);
        *(u32x4*)(ETg + (size_t)n * 512 + s * 16 + hf * 8) = o; }
    for (int idx = tid; idx < 1024; idx += NTHR) { const int ch = idx & 63, r = 128 + 16 * part + (idx >> 6); *(u32x4*)(ETg + (size_t)r * 512 + ch * 8) = (u32x4){0u, 0u, 0u, 0u}; }
    if (part == 0 && tid < 64) { AT[(g * 64 + tid) * 2] = apr[32 * 64 + tid]; AT[(g * 64 + tid) * 2 + 1] = api[32 * 64 + tid]; }
    __syncthreads();
}

constexpr int IMG_LD = 80, IMG_B = 64 * IMG_LD * 2;
#define IMG(k) ((LAS bf16*)(lds + (k) * IMG_B))
#define LDS_BARRIER() do { asm volatile("s_waitcnt lgkmcnt(0)" ::: "memory"); __builtin_amdgcn_s_barrier(); asm volatile("" ::: "memory"); } while (0)
struct MmCtx { int tr, tc0, l15, q; };
__device__ __forceinline__ void mm64(const LAS bf16* A, const LAS bf16* Bt, f32x4 (&acc)[2], const MmCtx& w) {
#pragma unroll
    for (int s = 0; s < 2; ++s) {
        const bf16x8 a = *(const LAS bf16x8*)(A + (16 * w.tr + w.l15) * IMG_LD + 32 * s + 8 * w.q);
#pragma unroll
        for (int c = 0; c < 2; ++c) { const bf16x8 b = *(const LAS bf16x8*)(Bt + (16 * (w.tc0 + c) + w.l15) * IMG_LD + 32 * s + 8 * w.q);
            acc[c] = __builtin_amdgcn_mfma_f32_16x16x32_bf16(a, b, acc[c], 0, 0, 0); }
    }
}
__device__ __forceinline__ void mm64_2a(const LAS bf16* A1, const LAS bf16* A2, const LAS bf16* Bt, f32x4 (&acc1)[2], f32x4 (&acc2)[2], const MmCtx& w) {
#pragma unroll
    for (int s = 0; s < 2; ++s) {
        const bf16x8 a1 = *(const LAS bf16x8*)(A1 + (16 * w.tr + w.l15) * IMG_LD + 32 * s + 8 * w.q), a2 = *(const LAS bf16x8*)(A2 + (16 * w.tr + w.l15) * IMG_LD + 32 * s + 8 * w.q);
#pragma unroll
        for (int c = 0; c < 2; ++c) { const bf16x8 b = *(const LAS bf16x8*)(Bt + (16 * (w.tc0 + c) + w.l15) * IMG_LD + 32 * s + 8 * w.q);
            acc1[c] = __builtin_amdgcn_mfma_f32_16x16x32_bf16(a1, b, acc1[c], 0, 0, 0); acc2[c] = __builtin_amdgcn_mfma_f32_16x16x32_bf16(a2, b, acc2[c], 0, 0, 0); }
    }
}
__device__ __forceinline__ void mm64_2b(const LAS bf16* A, const LAS bf16* Bt1, const LAS bf16* Bt2, f32x4 (&acc1)[2], f32x4 (&acc2)[2], const MmCtx& w) {
#pragma unroll
    for (int s = 0; s < 2; ++s) {
        const bf16x8 a = *(const LAS bf16x8*)(A + (16 * w.tr + w.l15) * IMG_LD + 32 * s + 8 * w.q);
#pragma unroll
        for (int c = 0; c < 2; ++c) { const bf16x8 b1 = *(const LAS bf16x8*)(Bt1 + (16 * (w.tc0 + c) + w.l15) * IMG_LD + 32 * s + 8 * w.q), b2 = *(const LAS bf16x8*)(Bt2 + (16 * (w.tc0 + c) + w.l15) * IMG_LD + 32 * s + 8 * w.q);
            acc1[c] = __builtin_amdgcn_mfma_f32_16x16x32_bf16(a, b1, acc1[c], 0, 0, 0); acc2[c] = __builtin_amdgcn_mfma_f32_16x16x32_bf16(a, b2, acc2[c], 0, 0, 0); }
    }
}
__device__ __forceinline__ float dpp_x1(float v) { return __int_as_float(__builtin_amdgcn_update_dpp(0, __float_as_int(v), 0xB1, 0xF, 0xF, true)); }
__device__ __forceinline__ float dpp_x2(float v) { return __int_as_float(__builtin_amdgcn_update_dpp(0, __float_as_int(v), 0x4E, 0xF, 0xF, true)); }
__device__ __forceinline__ f32x4 quad_transpose(const f32x4 v, int b) {
    const bool odd = (b & 1) != 0, hi = (b & 2) != 0;
    const float r0 = dpp_x1(odd ? v[0] : v[1]), r1 = dpp_x1(odd ? v[2] : v[3]);
    const float p0a = odd ? r0 : v[0], p0b = odd ? v[1] : r0, p1a = odd ? r1 : v[2], p1b = odd ? v[3] : r1;
    const float ra = dpp_x2(hi ? p0a : p1a), rb = dpp_x2(hi ? p0b : p1b);
    return hi ? (f32x4){ra, rb, p1a, p1b} : (f32x4){p0a, p0b, ra, rb};
}
__device__ __forceinline__ void st_rm(LAS bf16* img, const f32x4 v, int tr, int tc, const MmCtx& w) {
    const unsigned p01 = pk2(v[0], v[1]), p23 = pk2(v[2], v[3]); LAS bf16* d = img + (16 * tr + 4 * w.q) * IMG_LD + 16 * tc + w.l15;
    d[0] = (bf16)p01; d[IMG_LD] = (bf16)(p01 >> 16); d[2 * IMG_LD] = (bf16)p23; d[3 * IMG_LD] = (bf16)(p23 >> 16);
}
__device__ __forceinline__ void st_tr(LAS bf16* img, const f32x4 v, int tr, int tc, const MmCtx& w) {
    u32x2 o; o.x = pk2(v[0], v[1]); o.y = pk2(v[2], v[3]); *(LAS u32x2*)(img + (16 * tc + w.l15) * IMG_LD + 16 * tr + 4 * w.q) = o;
}
__device__ __forceinline__ void img_to_global(const LAS bf16* img, bf16* g, int tid) { const int row = tid >> 3, ch = tid & 7; *(u32x4*)(g + row * 64 + ch * 8) = *(const LAS u32x4*)(img + row * IMG_LD + ch * 8); }
__device__ __forceinline__ void st_tm8(LAS bf16* img, int t, int cg, const float (&v)[8]) {
    u32x4 o; o.x = pk2(v[0], v[1]); o.y = pk2(v[2], v[3]); o.z = pk2(v[4], v[5]); o.w = pk2(v[6], v[7]); *(LAS u32x4*)(img + t * IMG_LD + 8 * cg) = o;
}
__device__ __forceinline__ void st_cm8(LAS bf16* img, int t, int cg, const float (&v)[8]) {
#pragma unroll
    for (int i = 0; i < 8; i += 2) { const unsigned p = pk2(v[i], v[i + 1]); img[(8 * cg + i) * IMG_LD + t] = (bf16)p; img[(8 * cg + i + 1) * IMG_LD + t] = (bf16)(p >> 16); }
}
__device__ __forceinline__ float red8(float v) { v += __shfl_xor(v, 1); v += __shfl_xor(v, 2); v += __shfl_xor(v, 4); return v; }
__device__ __forceinline__ void unpack8(const u32x4 w, float (&o)[8]) { o[0] = lo16(w.x); o[1] = hi16(w.x); o[2] = lo16(w.y); o[3] = hi16(w.y); o[4] = lo16(w.z); o[5] = hi16(w.z); o[6] = lo16(w.w); o[7] = hi16(w.w); }
__device__ __forceinline__ void ldp8(const float* p, float (&o)[8]) { const f32x4 a = *(const f32x4*)p, b = *(const f32x4*)(p + 4); o[0] = a.x; o[1] = a.y; o[2] = a.z; o[3] = a.w; o[4] = b.x; o[5] = b.y; o[6] = b.z; o[7] = b.w; }

struct RwkvP { const bf16* rkv; const bf16* wag; const float *mu_rkv, *w0, *a0, *k_k, *k_a, *r_k, *ln_w, *ln_b; };
struct RwkvRaw { u32x4 kc, kp, vc, vp, wl, al, rc, rp, gg; };
template <bool PASS3>
__device__ __forceinline__ void rwkv_load(const RwkvP& P, int cidx, int tid, RwkvRaw& R) {
    const int t = tid >> 3, cg = tid & 7, bh = cidx >> 7, c = cidx & 127, b = bh >> 3, h = bh & 7, ch = h * 64 + 8 * cg;
    const size_t tok = (size_t)b * SEQ + c * 64 + t; const bool first = (c == 0 && t == 0);
    const bf16* row = P.rkv + tok * 1536 + ch; const bf16* prow = first ? row : row - 1536;
    R.kc = *(const u32x4*)(row + 512); R.vc = *(const u32x4*)(row + 1024); R.kp = *(const u32x4*)(prow + 512); R.vp = *(const u32x4*)(prow + 1024);
    R.wl = *(const u32x4*)(P.wag + tok * 1536 + ch); R.al = *(const u32x4*)(P.wag + tok * 1536 + 512 + ch);
    if (PASS3) { R.rc = *(const u32x4*)row; R.rp = *(const u32x4*)prow; R.gg = *(const u32x4*)(P.wag + tok * 1536 + 1024 + ch); }
}
constexpr int RC_OFF = 14 * IMG_B;
struct RwkvC { const LAS float* p; };
__device__ __forceinline__ void ldl8(const LAS float* p, float (&o)[8]) { const f32x4 a = *(const LAS f32x4*)p, b = *(const LAS f32x4*)(p + 4); o[0] = a.x; o[1] = a.y; o[2] = a.z; o[3] = a.w; o[4] = b.x; o[5] = b.y; o[6] = b.z; o[7] = b.w; }
__device__ __forceinline__ void rwkv_consts(LAS unsigned char* lds, const RwkvP& P, int h, int tid, RwkvC& C) {
    LAS float* base = (LAS float*)(lds + RC_OFF);
    if (tid < 64) { const int cg = tid >> 3, k = tid & 7, ch = h * 64 + 8 * cg; const float* src = k == 0 ? P.mu_rkv + ch : k == 1 ? P.mu_rkv + 512 + ch : k == 2 ? P.mu_rkv + 1024 + ch : k == 3 ? P.w0 + ch : k == 4 ? P.a0 + ch : k == 5 ? P.k_k + ch : P.k_a + ch;
        if (k < 7) { const f32x4 a = *(const f32x4*)src, b = *(const f32x4*)(src + 4); *(LAS f32x4*)(base + cg * 64 + k * 8) = a; *(LAS f32x4*)(base + cg * 64 + k * 8 + 4) = b; } }
    LDS_BARRIER();
    C.p = base + (tid & 7) * 64;
}
template <bool PASS3>
__device__ __forceinline__ void rwkv_prep(const RwkvRaw& R, const RwkvC& C, bool first, float (&kq)[8], float (&vv)[8], float (&rr)[8], float (&kap)[8], float (&bet)[8], float (&lw)[8]) {
    float kc[8], kp[8], vc[8], vp[8], k[8], wl[8], al[8], a[8], m[8];
    unpack8(R.kc, kc); unpack8(R.vc, vc); unpack8(R.kp, kp); unpack8(R.vp, vp); unpack8(R.wl, wl); unpack8(R.al, al);
    const float pm = first ? 0.f : 1.f;
    ldl8(C.p + 8, m);
#pragma unroll
    for (int i = 0; i < 8; ++i) k[i] = kc[i] + (pm * kp[i] - kc[i]) * m[i];
    ldl8(C.p + 16, m);
#pragma unroll
    for (int i = 0; i < 8; ++i) vv[i] = vc[i] + (pm * vp[i] - vc[i]) * m[i];
    if (PASS3) { float rc[8], rp[8]; unpack8(R.rc, rc); unpack8(R.rp, rp); ldl8(C.p, m);
#pragma unroll
        for (int i = 0; i < 8; ++i) rr[i] = rc[i] + (pm * rp[i] - rc[i]) * m[i];
    } else {
#pragma unroll
        for (int i = 0; i < 8; ++i) rr[i] = 0.f;
    }
    float ss = 0.f;
    ldl8(C.p + 24, m);
#pragma unroll
    for (int i = 0; i < 8; ++i) lw[i] = -0.6065306597126334f * fsigmoid(m[i] + wl[i]);
    ldl8(C.p + 32, m);
#pragma unroll
    for (int i = 0; i < 8; ++i) a[i] = fsigmoid(m[i] + al[i]);
    ldl8(C.p + 40, m);
#pragma unroll
    for (int i = 0; i < 8; ++i) { kap[i] = k[i] * m[i]; ss += kap[i] * kap[i]; }
    ss = red8(ss);
    const float inv = 1.0f / fmaxf(sqrtf(ss), 1e-12f);
    ldl8(C.p + 48, m);
#pragma unroll
    for (int i = 0; i < 8; ++i) { kap[i] *= inv; bet[i] = kap[i] * a[i]; kq[i] = k[i] * (1.0f + (a[i] - 1.0f) * m[i]); }
}
template <int SEGSLOT>
__device__ __forceinline__ void rwkv_cumsum(LAS unsigned char* lds, int tid, const float (&lw)[8], float (&cum)[8], float (&cumL)[8]) {
    LAS float* SEG = (LAS float*)(lds + SEGSLOT * IMG_B);
    const int lane = tid & 63, wv = tid >> 6, cg = tid & 7, tl = lane >> 3;
#pragma unroll
    for (int i = 0; i < 8; ++i) { float v = lw[i];
        { const float u = __shfl_up(v, 8); v += (tl >= 1) ? u : 0.f; }
        { const float u = __shfl_up(v, 16); v += (tl >= 2) ? u : 0.f; }
        { const float u = __shfl_up(v, 32); v += (tl >= 4) ? u : 0.f; }
        cum[i] = v; }
    if (tl == 7) {
#pragma unroll
        for (int i = 0; i < 8; ++i) SEG[wv * 64 + 8 * cg + i] = cum[i]; }
    LDS_BARRIER();
    float pre[8], tot[8];
#pragma unroll
    for (int i = 0; i < 8; ++i) { pre[i] = 0.f; tot[i] = 0.f; }
#pragma unroll 1
    for (int s2 = 0; s2 < 8; ++s2) { const f32x4 a = *(const LAS f32x4*)(SEG + s2 * 64 + 8 * cg), b = *(const LAS f32x4*)(SEG + s2 * 64 + 8 * cg + 4); const float m = (s2 < wv) ? 1.f : 0.f;
        tot[0] += a.x; tot[1] += a.y; tot[2] += a.z; tot[3] += a.w; tot[4] += b.x; tot[5] += b.y; tot[6] += b.z; tot[7] += b.w;
        pre[0] += m * a.x; pre[1] += m * a.y; pre[2] += m * a.z; pre[3] += m * a.w; pre[4] += m * b.x; pre[5] += m * b.y; pre[6] += m * b.z; pre[7] += m * b.w; }
#pragma unroll
    for (int i = 0; i < 8; ++i) { cum[i] += pre[i]; cumL[i] = tot[i]; }
}
#define Z4 (f32x4){0.f, 0.f, 0.f, 0.f}

__device__ __forceinline__ void rwkv_pass1(LAS unsigned char* lds, const RwkvP& P, int c0, int n, int tid, bf16* QCT, float* HCT, bf16* M1G, bf16* YLG, float* DLG, float* BONUS) {
    const int lane = tid & 63, wv = __builtin_amdgcn_readfirstlane(tid >> 6); MmCtx w; w.tr = wv >> 1; w.tc0 = (wv & 1) * 2; w.l15 = lane & 15; w.q = lane >> 4;
    const int t = tid >> 3, cg = tid & 7, ch = ((c0 >> 7) & 7) * 64 + 8 * cg;
    RwkvC C; rwkv_consts(lds, P, (c0 >> 7) & 7, tid, C);
    RwkvRaw R; rwkv_load<true>(P, c0, tid, R);
    for (int ci = 0; ci < n; ++ci) {
        const int cidx = c0 + ci;
        {
            float kq[8], vv[8], rr[8], kap[8], bet[8], lw[8], cum[8], cumL[8];
            rwkv_prep<true>(R, C, (cidx & 127) == 0 && t == 0, kq, vv, rr, kap, bet, lw);
            rwkv_cumsum<10>(lds, tid, lw, cum, cumL);
            { float bs = 0.f, rk[8]; ldp8(P.r_k + ch, rk);
#pragma unroll
              for (int i = 0; i < 8; ++i) bs += rr[i] * kq[i] * rk[i];
              bs = red8(bs); if (cg == 0) BONUS[(size_t)cidx * 64 + t] = bs; }
            float x[8], y[8];
#pragma unroll
            for (int i = 0; i < 8; ++i) { const float en = __expf(-cum[i]); x[i] = kq[i] * en; y[i] = bet[i] * en; }
            st_tm8(IMG(0), t, cg, x);
            st_tm8(IMG(1), t, cg, y);
#pragma unroll
            for (int i = 0; i < 8; ++i) x[i] = kap[i] * __expf(cum[i] - lw[i]);
            st_tm8(IMG(2), t, cg, x);
            st_cm8(IMG(3), t, cg, x);
#pragma unroll
            for (int i = 0; i < 8; ++i) x[i] = rr[i] * __expf(cum[i]);
            st_tm8(IMG(11), t, cg, x);
#pragma unroll
            for (int i = 0; i < 8; ++i) { const float eh = __expf(cumL[i] - cum[i]); x[i] = kq[i] * eh; y[i] = bet[i] * eh; }
            st_cm8(IMG(4), t, cg, x);
            st_cm8(IMG(5), t, cg, y);
            st_cm8(IMG(6), t, cg, vv);
            if (t == 0) {
#pragma unroll
                for (int i = 0; i < 8; ++i) DLG[(size_t)cidx * 64 + 8 * cg + i] = __expf(cumL[i]);
            }
        }
        if (ci + 1 < n) rwkv_load<true>(P, cidx + 1, tid, R);
        LDS_BARRIER();
        f32x4 accX[2];
        {
            f32x4 a[2] = {Z4, Z4}, kk[2] = {Z4, Z4};
            mm64_2a(IMG(1), IMG(0), IMG(2), a, kk, w);
#pragma unroll
            for (int c = 0; c < 2; ++c) { const int nn = 16 * (w.tc0 + c) + w.l15;
#pragma unroll
                for (int r = 0; r < 4; ++r) { const int m = 16 * w.tr + 4 * w.q + r; a[c][r] = (m < nn) ? a[c][r] : 0.f; kk[c][r] = (m < nn) ? kk[c][r] : 0.f; accX[c][r] = ((m == nn) ? 1.0f : 0.f) - a[c][r]; }
                st_rm(IMG(7), a[c], w.tr, w.tc0 + c, w); st_tr(IMG(8), a[c], w.tr, w.tc0 + c, w); st_rm(IMG(10), accX[c], w.tr, w.tc0 + c, w); st_rm(IMG(9), kk[c], w.tr, w.tc0 + c, w); }
        }
        LDS_BARRIER();
        {
            f32x4 p[2] = {Z4, Z4};
            mm64(IMG(7), IMG(8), p, w);
#pragma unroll
            for (int c = 0; c < 2; ++c) { st_rm(IMG(12), p[c], w.tr, w.tc0 + c, w); st_tr(IMG(13), p[c], w.tr, w.tc0 + c, w); }
        }
        LDS_BARRIER();
#define NEUMANN(XC, XN, PC, PTC, PN, PTN, LASTR) do { if (LASTR) { mm64(IMG(XC), IMG(PTC), accX, w); _Pragma("unroll") for (int c = 0; c < 2; ++c) st_tr(IMG(7), accX[c], w.tr, w.tc0 + c, w); }   \
            if (!(LASTR)) { f32x4 p[2] = {Z4, Z4}; mm64_2a(IMG(XC), IMG(PC), IMG(PTC), accX, p, w); \
                _Pragma("unroll") for (int c = 0; c < 2; ++c) { st_rm(IMG(PN), p[c], w.tr, w.tc0 + c, w); st_tr(IMG(PTN), p[c], w.tr, w.tc0 + c, w); st_rm(IMG(XN), accX[c], w.tr, w.tc0 + c, w); } } \
            LDS_BARRIER(); } while (0)
        NEUMANN(10, 2, 12, 13, 7, 8, false);
        NEUMANN(2, 10, 7, 8, 12, 13, false);
        NEUMANN(10, 2, 12, 13, 7, 8, false);
        NEUMANN(2, 10, 7, 8, 12, 13, false);
        NEUMANN(10, 2, 12, 13, 7, 8, true);
#undef NEUMANN
        {
            f32x4 a[2] = {Z4, Z4}, g[2] = {Z4, Z4}, kr[2] = {Z4, Z4}, br[2] = {Z4, Z4};
            mm64_2a(IMG(3), IMG(9), IMG(7), a, g, w); mm64_2b(IMG(11), IMG(0), IMG(1), kr, br, w);
#pragma unroll
            for (int c = 0; c < 2; ++c) { const int nn = 16 * (w.tc0 + c) + w.l15;
#pragma unroll
                for (int r = 0; r < 4; ++r) { const int m = 16 * w.tr + 4 * w.q + r; kr[c][r] = (nn <= m) ? kr[c][r] : 0.f; br[c][r] = (nn <= m) ? br[c][r] : 0.f; }
                st_rm(IMG(12), a[c], w.tr, w.tc0 + c, w); st_tr(IMG(8), g[c], w.tr, w.tc0 + c, w); st_rm(IMG(2), kr[c], w.tr, w.tc0 + c, w); st_rm(IMG(10), br[c], w.tr, w.tc0 + c, w); }
        }
        LDS_BARRIER();
        {
            f32x4 u[2] = {Z4, Z4}, qc[2] = {Z4, Z4}, m1[2] = {Z4, Z4};
            mm64(IMG(6), IMG(8), u, w); mm64(IMG(5), IMG(12), qc, w); mm64(IMG(10), IMG(12), m1, w);
#pragma unroll
            for (int c = 0; c < 2; ++c) { st_rm(IMG(13), u[c], w.tr, w.tc0 + c, w);
                const int tc = w.tc0 + c, cp = 32 * (tc >> 1) + 8 * (w.l15 >> 2) + 4 * (tc & 1) + (w.l15 & 3);
                const unsigned p01 = pk2(qc[c][0], qc[c][1]), p23 = pk2(qc[c][2], qc[c][3]); LAS bf16* d = IMG(0) + (16 * w.tr + 4 * w.q) * IMG_LD + cp;
                d[0] = (bf16)p01; d[IMG_LD] = (bf16)(p01 >> 16); d[2 * IMG_LD] = (bf16)p23; d[3 * IMG_LD] = (bf16)(p23 >> 16);
                f32x4 mv;
#pragma unroll
                for (int r = 0; r < 4; ++r) mv[r] = bf2f(IMG(11)[(16 * w.tr + 4 * w.q + r) * IMG_LD + 16 * tc + w.l15]) - m1[c][r];
                st_rm(IMG(1), mv, w.tr, tc, w); }
        }
        LDS_BARRIER();
        {
            f32x4 hp[2] = {Z4, Z4}, hn[2] = {Z4, Z4}, yp[2] = {Z4, Z4}, yn[2] = {Z4, Z4};
            mm64(IMG(4), IMG(6), hp, w); mm64(IMG(5), IMG(13), hn, w); mm64(IMG(2), IMG(6), yp, w); mm64(IMG(10), IMG(13), yn, w);
#pragma unroll
            for (int c = 0; c < 2; ++c) { *(f32x4*)(HCT + (((size_t)cidx * 16 + w.tr * 4 + w.tc0 + c) * 64 + lane) * 4) = hp[c] - hn[c]; st_rm(IMG(3), yp[c] - yn[c], w.tr, w.tc0 + c, w); }
            img_to_global(IMG(1), M1G + (size_t)cidx * 4096, tid);
            img_to_global(IMG(0), QCT + (size_t)cidx * 4096, tid);
        }
        LDS_BARRIER();
        img_to_global(IMG(3), YLG + (size_t)cidx * 4096, tid);
    }
}

constexpr int P2_SLOT = 12544, P2_DEPTH = 5;
__device__ __forceinline__ void rwkv_pass2(LAS unsigned char* lds, int bh, int ti, int lane, const bf16* QCT, const float* HCT, const float* DLG, bf16* S0G) {
    const int l15 = lane & 15, q = lane >> 4;
    f32x4 X[4];
#pragma unroll
    for (int tj = 0; tj < 4; ++tj) X[tj] = Z4;
#define P2_DMA(cc) do { const size_t ci_ = (size_t)bh * 128 + (cc); LAS unsigned char* sl_ = lds + ((cc) % P2_DEPTH) * P2_SLOT; \
        _Pragma("unroll") for (int i = 0; i < 8; ++i) { const int row_ = i * 8 + (lane >> 3), pc_ = (lane & 7) ^ (row_ & 7); \
            __builtin_amdgcn_global_load_lds((const unsigned*)((const char*)QCT + (ci_ * 64 + row_) * 128 + pc_ * 16), (LAS unsigned*)(sl_ + i * 1024), 16, 0, 0); } \
        _Pragma("unroll") for (int tj = 0; tj < 4; ++tj) __builtin_amdgcn_global_load_lds((const unsigned*)((const char*)HCT + ((ci_ * 16 + tj * 4 + ti) * 64 + lane) * 16), (LAS unsigned*)(sl_ + 8192 + tj * 1024), 16, 0, 0); \
        __builtin_amdgcn_global_load_lds((const unsigned*)((const char*)DLG + (ci_ * 64 + lane) * 4), (LAS unsigned*)(sl_ + 12288), 4, 0, 0); } while (0)
    P2_DMA(0); P2_DMA(1); P2_DMA(2); P2_DMA(3);
    for (int c = 0; c < 128; ++c) {
        if (c < 124) asm volatile("s_waitcnt vmcnt(39)" ::: "memory"); else asm volatile("s_waitcnt vmcnt(0)" ::: "memory");
        const LAS unsigned char* sl = lds + (c % P2_DEPTH) * P2_SLOT;
        bf16x8 a[4][2]; f32x4 h[4], d[4];
#pragma unroll
        for (int tj = 0; tj < 4; ++tj) { const int row = 16 * tj + l15;
#pragma unroll
            for (int s = 0; s < 2; ++s) a[tj][s] = *(const LAS bf16x8*)(sl + row * 128 + (((4 * s + q) ^ (row & 7)) * 16));
            h[tj] = *(const LAS f32x4*)(sl + 8192 + tj * 1024 + lane * 16); d[tj] = *(const LAS f32x4*)(sl + 12288 + (16 * tj + 4 * q) * 4); }
        asm volatile("s_waitcnt lgkmcnt(0)" ::: "memory");
        if (c + 4 < 128) P2_DMA(c + 4);
        const size_t cidx = (size_t)bh * 128 + c;
#pragma unroll
        for (int tj = 0; tj < 4; ++tj) { u32x2 o; o.x = pk2(X[tj][0], X[tj][1]); o.y = pk2(X[tj][2], X[tj][3]); *(u32x2*)(S0G + (cidx * 64 + 16 * ti + l15) * 64 + 16 * tj + 4 * q) = o; }
        bf16x8 b[2];
#pragma unroll
        for (int s = 0; s < 2; ++s) { u32x4 o; o.x = pk2(X[2 * s][0], X[2 * s][1]); o.y = pk2(X[2 * s][2], X[2 * s][3]); o.z = pk2(X[2 * s + 1][0], X[2 * s + 1][1]); o.w = pk2(X[2 * s + 1][2], X[2 * s + 1][3]); b[s] = __builtin_bit_cast(bf16x8, o); }
#pragma unroll
        for (int tj = 0; tj < 4; ++tj) { f32x4 acc = Z4;
            acc = __builtin_amdgcn_mfma_f32_16x16x32_bf16(a[tj][0], b[0], acc, 0, 0, 0); acc = __builtin_amdgcn_mfma_f32_16x16x32_bf16(a[tj][1], b[1], acc, 0, 0, 0);
            X[tj] = d[tj] * X[tj] + h[tj] - acc; }
    }
    asm volatile("s_waitcnt vmcnt(0)" ::: "memory");
#undef P2_DMA
}

__device__ __forceinline__ void rwkv_pass3(LAS unsigned char* lds, const RwkvP& P, int c0, int n, int tid, const bf16* S0G, const bf16* M1G, const bf16* YLG, const float* BONUS, bf16* MIX) {
    const int lane = tid & 63, wv = __builtin_amdgcn_readfirstlane(tid >> 6); MmCtx w; w.tr = wv >> 1; w.tc0 = (wv & 1) * 2; w.l15 = lane & 15; w.q = lane >> 4;
    const int t = tid >> 3, cg = tid & 7, bh = c0 >> 7, b = bh >> 3, h = bh & 7, ch = h * 64 + 8 * cg;
    float muv[8], lnw[8], lnb[8]; ldp8(P.mu_rkv + 1024 + ch, muv); ldp8(P.ln_w + ch, lnw); ldp8(P.ln_b + ch, lnb);
    u32x4 gS0, gM1, gYL, gvc, gvp, ggg; float gbo;
#define P3_LOAD(cc) do { const int cidx_ = (cc), c_ = cidx_ & 127; const size_t o_ = (size_t)cidx_ * 4096 + (tid >> 3) * 64 + (tid & 7) * 8; gS0 = *(const u32x4*)(S0G + o_); gM1 = *(const u32x4*)(M1G + o_); gYL = *(const u32x4*)(YLG + o_); \
        const size_t tok_ = (size_t)b * SEQ + c_ * 64 + t; const bool first_ = (c_ == 0 && t == 0); const bf16* row_ = P.rkv + tok_ * 1536 + 1024 + ch; \
        gvc = *(const u32x4*)row_; gvp = *(const u32x4*)(first_ ? row_ : row_ - 1536); ggg = *(const u32x4*)(P.wag + tok_ * 1536 + 1024 + ch); gbo = BONUS[(size_t)cidx_ * 64 + t]; } while (0)
    P3_LOAD(c0);
    for (int ci = 0; ci < n; ++ci) {
        const int cidx = c0 + ci, c = cidx & 127;
        float vv[8], gg[8]; const float bonus = gbo;
        { float vc[8], vp[8]; unpack8(gvc, vc); unpack8(gvp, vp); unpack8(ggg, gg); const float pm = (c == 0 && t == 0) ? 0.f : 1.f;
#pragma unroll
          for (int i = 0; i < 8; ++i) vv[i] = vc[i] + (pm * vp[i] - vc[i]) * muv[i];
          const int row = tid >> 3, chk = tid & 7; *(LAS u32x4*)(IMG(0) + row * IMG_LD + chk * 8) = gM1; *(LAS u32x4*)(IMG(1) + row * IMG_LD + chk * 8) = gS0; *(LAS u32x4*)(IMG(2) + row * IMG_LD + chk * 8) = gYL; }
        if (ci + 1 < n) P3_LOAD(cidx + 1);
        LDS_BARRIER();
        {
            f32x4 y[2] = {Z4, Z4};
            mm64(IMG(0), IMG(1), y, w);
            LAS float* YF = (LAS float*)(lds + 10 * IMG_B);
#pragma unroll
            for (int cc = 0; cc < 2; ++cc)
#pragma unroll
                for (int r = 0; r < 4; ++r) { const int m = 16 * w.tr + 4 * w.q + r, nn = 16 * (w.tc0 + cc) + w.l15; YF[m * 65 + nn] = y[cc][r] + bf2f(IMG(2)[m * IMG_LD + nn]); }
        }
        LDS_BARRIER();
        {
            const LAS float* YF = (const LAS float*)(lds + 10 * IMG_B);
            float y[8], s = 0.f;
#pragma unroll
            for (int i = 0; i < 8; ++i) { y[i] = YF[t * 65 + 8 * cg + i]; s += y[i]; }
            const float mean = red8(s) * (1.0f / 64.0f); float qv = 0.f;
#pragma unroll
            for (int i = 0; i < 8; ++i) { y[i] -= mean; qv += y[i] * y[i]; }
            const float rstd = rsqrtf(red8(qv) * (1.0f / 64.0f) + 64e-5f);
            float o[8];
#pragma unroll
            for (int i = 0; i < 8; ++i) o[i] = (y[i] * rstd * lnw[i] + lnb[i] + bonus * vv[i]) * gg[i];
            const size_t tok = (size_t)b * SEQ + c * 64 + t;
            u32x4 ov; ov.x = pk2(o[0], o[1]); ov.y = pk2(o[2], o[3]); ov.z = pk2(o[4], o[5]); ov.w = pk2(o[6], o[7]);
            *(u32x4*)(MIX + tok * 1024 + 512 + ch) = ov;
        }
        LDS_BARRIER();
    }
#undef P3_LOAD
}

constexpr int RW_LD = 1032;
__device__ __forceinline__ void router_phase(const Ctx& cx, const bf16* X1, const float* gnorm, const float* rw, const float* rb, unsigned char* H2, int* TOPE, float* TOPG, unsigned* HIST) {
    LAS bf16* WH = (LAS bf16*)cx.lds; LAS bf16* WL = WH + 32 * RW_LD;
    LAS unsigned* hcnt = (LAS unsigned*)(cx.lds + 135168);
    const int lane = cx.lane, l15 = lane & 15, q = lane >> 4;
    for (int idx = cx.tid; idx < 32768; idx += NTHR) { const int col = idx >> 5, e = idx & 31; const float v = rw[idx] * gnorm[col];
        const unsigned h = cvt_pk_bf16(v, 0.f) & 0xffffu; const float lo = v - bf2f(h); WH[e * RW_LD + col] = (bf16)h; WL[e * RW_LD + col] = (bf16)(cvt_pk_bf16(lo, 0.f) & 0xffffu); }
    const float b0 = rb[l15], b1 = rb[l15 + 16];
    for (int tb = cx.wg; tb < 256; tb += cx.G) {
        if (cx.tid < 32) hcnt[cx.tid] = 0u;
        __syncthreads();
        const int tok0 = tb * 128 + cx.wave * 16;
        const bf16* xrow = X1 + (size_t)(tok0 + l15) * 1024 + 8 * q;
        f32x4 acc[2] = {(f32x4){0.f, 0.f, 0.f, 0.f}, (f32x4){0.f, 0.f, 0.f, 0.f}}; float ss = 0.f;
#pragma unroll 8
        for (int s = 0; s < 32; ++s) {
            const u32x4 xw = *(const u32x4*)(xrow + 32 * s);
            { const float a0 = lo16(xw.x), a1 = hi16(xw.x), a2 = lo16(xw.y), a3 = hi16(xw.y), a4 = lo16(xw.z), a5 = hi16(xw.z), a6 = lo16(xw.w), a7 = hi16(xw.w);
              ss += (a0 * a0 + a1 * a1) + (a2 * a2 + a3 * a3) + (a4 * a4 + a5 * a5) + (a6 * a6 + a7 * a7); }
            const bf16x8 ah = __builtin_bit_cast(bf16x8, xw);
#pragma unroll
            for (int n = 0; n < 2; ++n) { const bf16x8 bh = *(const LAS bf16x8*)(WH + (l15 + 16 * n) * RW_LD + 32 * s + 8 * q), bl = *(const LAS bf16x8*)(WL + (l15 + 16 * n) * RW_LD + 32 * s + 8 * q);
                acc[n] = __builtin_amdgcn_mfma_f32_16x16x32_bf16(ah, bh, acc[n], 0, 0, 0); acc[n] = __builtin_amdgcn_mfma_f32_16x16x32_bf16(ah, bl, acc[n], 0, 0, 0); }
        }
        ss += __shfl_xor(ss, 16); ss += __shfl_xor(ss, 32);
        const float rinv_l = rsqrtf(ss * (1.f / 1024.f) + 1e-6f);
#pragma unroll
        for (int r = 0; r < 4; ++r) {
            const float ri = __shfl(rinv_l, 4 * q + r);
            float v0 = acc[0][r] * ri + b0, v1 = acc[1][r] * ri + b1; int se[4]; float sv[4];
#pragma unroll
            for (int k = 0; k < 4; ++k) { float bv = (v1 > v0) ? v1 : v0; int be = (v1 > v0) ? (l15 + 16) : l15;
#pragma unroll
                for (int off = 1; off < 16; off <<= 1) { const float ov = __shfl_xor(bv, off); const int oe = __shfl_xor(be, off); const bool take = (ov > bv) || (ov == bv && oe < be); bv = take ? ov : bv; be = take ? oe : be; }
                se[k] = be; sv[k] = bv; if (be == l15) v0 = -INFINITY; if (be == l15 + 16) v1 = -INFINITY; }
            if (l15 == r) { const int tok = tok0 + 4 * q + r;
                const float w1 = __expf(sv[1] - sv[0]), w2 = __expf(sv[2] - sv[0]), w3 = __expf(sv[3] - sv[0]); const float inv = 1.0f / (1.0f + w1 + w2 + w3);
                *(int4*)(TOPE + (size_t)tok * 4) = make_int4(se[0], se[1], se[2], se[3]);
                *(float4*)(TOPG + (size_t)tok * 4) = make_float4(inv, w1 * inv, w2 * inv, w3 * inv);
                atomicAdd((unsigned*)(hcnt + se[0]), 1u); atomicAdd((unsigned*)(hcnt + se[1]), 1u); atomicAdd((unsigned*)(hcnt + se[2]), 1u); atomicAdd((unsigned*)(hcnt + se[3]), 1u); }
        }
        const f32x4* gr = (const f32x4*)gnorm + lane;
#pragma unroll 4
        for (int i = 0; i < 16; ++i) { const float ri = __shfl(rinv_l, i); const u32x2* xr = (const u32x2*)(X1 + (size_t)(tok0 + i) * 1024) + lane; unsigned* o4 = (unsigned*)(H2 + (size_t)(tok0 + i) * 1024) + lane;
#pragma unroll
            for (int j = 0; j < 4; ++j) { const u32x2 v = xr[64 * j]; const f32x4 gg = gr[64 * j]; o4[64 * j] = pk4_fp8(lo16(v.x) * ri * gg.x, hi16(v.x) * ri * gg.y, lo16(v.y) * ri * gg.z, hi16(v.y) * ri * gg.w); } }
        __syncthreads();
        if (cx.tid < 32) HIST[tb * 32 + cx.tid] = hcnt[cx.tid];
        __syncthreads();
    }
}

constexpr int PL_BASE = 1280, PL_WCNT = 1312;
__device__ __forceinline__ void moe_plan(const Ctx& cx, const unsigned* HIST) {
    LAS int* PL = (LAS int*)(cx.lds + LDS_PLAN);
    const int e = cx.tid & 31, part = cx.tid >> 5;
    { int s = 0; for (int w = 16 * part; w < 16 * part + 16; ++w) s += (int)HIST[w * 32 + e]; PL[PL_TMP + part * 32 + e] = s; }
    __syncthreads();
    if (cx.tid < 32) { int c = 0; for (int p = 0; p < 16; ++p) c += PL[PL_TMP + p * 32 + cx.tid]; PL[PL_CNT + cx.tid] = c; }
    __syncthreads();
    if (cx.tid == 0) {
        int ps = 0;
        for (int x = 0; x < 32; ++x) { PL[PL_PSTART + x] = ps; const int pad = (PL[PL_CNT + x] + 255) & ~255; for (int i = 0; i < pad / 256; ++i) PL[PL_TILEE + ps / 256 + i] = x; ps += pad; }
        PL[PL_PSTART + 32] = ps;
        int np = 0, e0 = 0;
        while (e0 < 32 && np < 7) { PL[PL_PE0 + np] = e0; PL[PL_PROW0 + np] = PL[PL_PSTART + e0]; int rows = 0, e1 = e0;
            while (e1 < 32 && e1 - e0 < MAXEPP) { const int pad = PL[PL_PSTART + e1 + 1] - PL[PL_PSTART + e1]; if (rows + pad > RMAX && e1 > e0) break; rows += pad; ++e1; }
            e0 = e1; ++np; }
        PL[PL_PE0 + np] = 32; PL[PL_PROW0 + np] = ps; PL[PL_NPASS] = np;
    }
    __syncthreads();
}
__device__ __forceinline__ void dispatch_phase(const Ctx& cx, const unsigned* HIST, const int* TOPE, int* SLOTTOK, int* TOKSLOT) {
    LAS int* PL = (LAS int*)(cx.lds + LDS_PLAN);
    const int e5 = cx.tid & 31, part = cx.tid >> 5, lane = cx.lane;
    for (int tb = cx.wg; tb < 256; tb += cx.G) {
        { int s = 0; for (int w = 16 * part; w < 16 * part + 16; ++w) s += (w < tb) ? (int)HIST[w * 32 + e5] : 0; PL[PL_TMP + part * 32 + e5] = s; }
        const int tok = tb * 128 + (cx.tid >> 2), k = cx.tid & 3; const int e = TOPE[(size_t)tok * 4 + k];
        int rank = 0;
        for (int ee = 0; ee < 32; ++ee) { const unsigned long long mask = __ballot(e == ee); if (e == ee) rank = __popcll(mask & ((1ull << lane) - 1ull)); if (lane == 0) PL[PL_WCNT + cx.wave * 32 + ee] = __popcll(mask); }
        __syncthreads();
        if (cx.tid < 32) { int c = 0; for (int p = 0; p < 16; ++p) c += PL[PL_TMP + p * 32 + cx.tid]; PL[PL_BASE + cx.tid] = c; }
        __syncthreads();
        int off = 0; for (int w2 = 0; w2 < 8; ++w2) off += (w2 < cx.wave) ? PL[PL_WCNT + w2 * 32 + e] : 0;
        const int slot = PL[PL_PSTART + e] + PL[PL_BASE + e] + off + rank;
        SLOTTOK[slot] = tok; TOKSLOT[(size_t)tok * 4 + k] = slot;
        __syncthreads();
    }
    for (int e = cx.wg; e < 32; e += cx.G) { const int c = PL[PL_CNT + e], ps = PL[PL_PSTART + e], pe = PL[PL_PSTART + e + 1]; for (int r = ps + c + cx.tid; r < pe; r += NTHR) SLOTTOK[r] = 0; }
}
template <int MODE>
__device__ __forceinline__ void convert_pass(const Ctx& cx, int e0, int e1, const float* wg, const float* wu, const float* wd, unsigned char* WGU, unsigned char* WDN) {
    LAS float* scr = (LAS float*)(cx.lds + cx.wave * 16640);
    constexpr int PER = MODE == 0 ? 768 : (MODE == 1 ? 512 : 256), ROFF = MODE == 2 ? 512 : 0;
    const int nitems = (e1 - e0) * PER;
#define CV_R(it_) ((it_) % PER + ROFF)
#define CV_SRC(it_) ((CV_R(it_) >> 8) == 2 ? wd : ((CV_R(it_) >> 8) ? wu : wg)) + (size_t)(e0 + (it_) / PER) * 1048576
    int it = cx.gw; if (it >= nitems) return;
    F8Item cur; f8_issue(CV_SRC(it), 1024, 128 * ((CV_R(it) & 255) >> 5), 32 * (CV_R(it) & 31), cx.lane, cur);
    for (;;) {
        const int nx = it + cx.NGW; const bool has = nx < nitems;
        F8Item nxt;
        if (has) f8_issue(CV_SRC(nx), 1024, 128 * ((CV_R(nx) & 255) >> 5), 32 * (CV_R(nx) & 31), cx.lane, nxt);
        const int le = it / PER, r = CV_R(it), mat = r >> 8, kb = (r & 255) >> 5, nb = r & 31, n0 = 32 * nb;
        if (mat == 2) f8_finish(cur, WDN + (size_t)le * 1048576 + (size_t)n0 * 1024 + 128 * kb, 1024, 32.0f, scr, cx.lane);
        else { const int drow = (n0 >> 7) * 256 + (n0 & 127) + mat * 128; f8_finish(cur, WGU + (size_t)le * 2097152 + (size_t)drow * 1024 + 128 * kb, 1024, 32.0f, scr, cx.lane); }
        if (!has) break;
        it = nx;
#pragma unroll
        for (int i = 0; i < 16; ++i) cur.v[i] = nxt.v[i];
    }
#undef CV_SRC
#undef CV_R
}
__device__ __forceinline__ void combine_all(const Ctx& cx, const float* TOPG, const int* TOKSLOT, const unsigned char* Y, bf16* X, const float* gnorm, unsigned char* H3) {
    const int lane = cx.lane, step = cx.NGW;
    int tok = cx.gw; if (tok >= M) return;
    int4 sl = *(const int4*)(TOKSLOT + (size_t)tok * 4); float4 gs = *(const float4*)(TOPG + (size_t)tok * 4);
    u32x2 xw[4]; unsigned yw[4][4];
#define CMB_ISSUE(T, SL, XW, YW) do { const u32x2* xr_ = (const u32x2*)(X + (size_t)(T) * 1024) + lane; const int s_[4] = {SL.x, SL.y, SL.z, SL.w}; \
        _Pragma("unroll") for (int j = 0; j < 4; ++j) XW[j] = xr_[64 * j]; \
        _Pragma("unroll") for (int k = 0; k < 4; ++k) { const unsigned* yr_ = (const unsigned*)(Y + (size_t)s_[k] * 1024) + lane; _Pragma("unroll") for (int j = 0; j < 4; ++j) YW[k][j] = yr_[64 * j]; } } while (0)
    CMB_ISSUE(tok, sl, xw, yw);
    int4 sl1 = sl; float4 gs1 = gs; { const int t1 = tok + step; if (t1 < M) { sl1 = *(const int4*)(TOKSLOT + (size_t)t1 * 4); gs1 = *(const float4*)(TOPG + (size_t)t1 * 4); } }
    const f32x4* gr = (const f32x4*)gnorm + lane;
    for (;;) {
        const int t1 = tok + step, t2 = tok + 2 * step; const bool has1 = t1 < M;
        u32x2 nxw[4]; unsigned nyw[4][4];
        if (has1) CMB_ISSUE(t1, sl1, nxw, nyw);
        int4 sl2 = sl1; float4 gs2 = gs1; if (t2 < M) { sl2 = *(const int4*)(TOKSLOT + (size_t)t2 * 4); gs2 = *(const float4*)(TOPG + (size_t)t2 * 4); }
        f32x4 v[4]; const float gk[4] = {gs.x, gs.y, gs.z, gs.w};
#pragma unroll
        for (int j = 0; j < 4; ++j) v[j] = (f32x4){lo16(xw[j].x), hi16(xw[j].x), lo16(xw[j].y), hi16(xw[j].y)};
#pragma unroll
        for (int k = 0; k < 4; ++k)
#pragma unroll
            for (int j = 0; j < 4; ++j) v[j] += up4_fp8(yw[k][j]) * gk[k];
        u32x2* xo = (u32x2*)(X + (size_t)tok * 1024) + lane; float s = 0.f;
#pragma unroll
        for (int j = 0; j < 4; ++j) { u32x2 w; w.x = pk2(v[j].x, v[j].y); w.y = pk2(v[j].z, v[j].w); xo[64 * j] = w; s += (v[j].x * v[j].x + v[j].y * v[j].y) + (v[j].z * v[j].z + v[j].w * v[j].w); }
        const float rinv = rsqrtf(wave_sum(s) * (1.f / 1024.f) + 1e-6f); unsigned* o8 = (unsigned*)(H3 + (size_t)tok * 1024) + lane;
#pragma unroll
        for (int j = 0; j < 4; ++j) { const f32x4 gq = gr[64 * j]; o8[64 * j] = pk4_fp8(v[j].x * rinv * gq.x, v[j].y * rinv * gq.y, v[j].z * rinv * gq.z, v[j].w * rinv * gq.w); }
        if (!has1) break;
        tok = t1; gs = gs1; sl1 = sl2; gs1 = gs2;
#pragma unroll
        for (int j = 0; j < 4; ++j) { xw[j] = nxw[j];
#pragma unroll
            for (int k = 0; k < 4; ++k) yw[k][j] = nyw[k][j]; }
    }
#undef CMB_ISSUE
}
template <bool LAST>
__device__ __forceinline__ void combine_pass(const Ctx& cx, int e0, int e1, int row0, const int* TOPE, const float* TOPG, const int* TOKSLOT, const unsigned char* Y, bf16* X, const float* gnorm, unsigned char* H3) {
    for (int tok = cx.gw; tok < M; tok += cx.NGW) {
        const int4 es = *(const int4*)(TOPE + (size_t)tok * 4); const float4 gs = *(const float4*)(TOPG + (size_t)tok * 4); const int4 sl = *(const int4*)(TOKSLOT + (size_t)tok * 4);
        const int ee[4] = {es.x, es.y, es.z, es.w}; const float gg[4] = {gs.x, gs.y, gs.z, gs.w}; const int ss[4] = {sl.x, sl.y, sl.z, sl.w};
        bool any = false;
#pragma unroll
        for (int k = 0; k < 4; ++k) any |= (ee[k] >= e0 && ee[k] < e1);
        if (!LAST && !any) continue;
        u32x2* xr = (u32x2*)(X + (size_t)tok * 1024) + cx.lane; f32x4 v[4];
#pragma unroll
        for (int j = 0; j < 4; ++j) { const u32x2 w = xr[64 * j]; v[j] = (f32x4){lo16(w.x), hi16(w.x), lo16(w.y), hi16(w.y)}; }
#pragma unroll
        for (int k = 0; k < 4; ++k) if (ee[k] >= e0 && ee[k] < e1) { const unsigned* yr = (const unsigned*)(Y + (size_t)(ss[k] - row0) * 1024) + cx.lane; const float g = gg[k];
#pragma unroll
            for (int j = 0; j < 4; ++j) v[j] += up4_fp8(yr[64 * j]) * g; }
        if (any) {
#pragma unroll
            for (int j = 0; j < 4; ++j) { u32x2 w; w.x = pk2(v[j].x, v[j].y); w.y = pk2(v[j].z, v[j].w); xr[64 * j] = w; }
        }
        if (LAST) { float s = 0.f;
#pragma unroll
            for (int j = 0; j < 4; ++j) s += (v[j].x * v[j].x + v[j].y * v[j].y) + (v[j].z * v[j].z + v[j].w * v[j].w);
            const float rinv = rsqrtf(wave_sum(s) * (1.f / 1024.f) + 1e-6f); const f32x4* gr = (const f32x4*)gnorm + cx.lane; unsigned* o8 = (unsigned*)(H3 + (size_t)tok * 1024) + cx.lane;
#pragma unroll
            for (int j = 0; j < 4; ++j) { const f32x4 gq = gr[64 * j]; o8[64 * j] = pk4_fp8(v[j].x * rinv * gq.x, v[j].y * rinv * gq.y, v[j].z * rinv * gq.z, v[j].w * rinv * gq.w); } }
    }
}

#define HBUF ((bf16*)(ws + WS_R1))
#define RKV ((bf16*)(ws + WS_RKV))
#define WAG ((bf16*)(ws + WS_WAG))
#define AG ((bf16*)(ws + WS_AG))
#define UB ((bf16*)(ws + WS_U))
#define LP ((bf16*)(ws + WS_LP))
#define LACT ((bf16*)(ws + WS_LACT))
#define Y1 ((bf16*)(ws + WS_Y1))
#define MIX ((bf16*)(ws + WS_R1))
#define EBUF ((float*)(ws + WS_LP))
#define S0G ((bf16*)(ws + WS_LP))
#define QCT ((bf16*)(ws + WS_U))
#define HCT ((float*)(ws + WS_R1))
#define W1G ((bf16*)(ws + WS_W1))
#define ULG ((bf16*)(ws + WS_ULOC))
#define DLG ((float*)(ws + WS_DL))
#define ATG ((float*)(ws + WS_AT))
#define WCAT ((bf16*)(ws + WS_WCAT))
#define WL2 ((bf16*)(ws + WS_WL2))
#define WGLU ((bf16*)(ws + WS_WGLU))
#define WPP ((bf16*)(ws + WS_WPP))
#define WOUT ((bf16*)(ws + WS_WOUT))
#define WPG ((unsigned char*)(ws + WS_WPG))
#define S5BT ((bf16*)(ws + WS_S5BT))
#define S5ET ((bf16*)(ws + WS_S5ET))
#define PBF ((bf16*)(ws + WS_PBF))
#define H2 ((unsigned char*)(ws + WS_H2))
#ifndef CONV_EARLY
#define CONV_EARLY 1
#endif
#if CONV_EARLY
#define WGU ((unsigned char*)OUTP)
#define WDN ((unsigned char*)OUTP + 64 * MiB)
#else
#define WGU ((unsigned char*)(ws + WS_WGU))
#define WDN ((unsigned char*)(ws + WS_WDN))
#endif
#define ACT ((unsigned char*)(ws + WS_ACT))
#define YB ((unsigned char*)(ws + WS_Y))
#define XB ((bf16*)(ws + WS_XB))
#define PP ((bf16*)(ws + WS_ACT))
#define HIST ((unsigned*)(ws + WS_HIST))
#define TOPE ((int*)(ws + WS_TOPE))
#define TOPG ((float*)(ws + WS_TOPG))
#define TOKSLOT ((int*)(ws + WS_TOKSLOT))
#define SLOTTOK ((int*)(ws + WS_SLOTTOK))
#ifndef FUSE_FNORM
#define FUSE_FNORM 1
#endif
#ifndef SPLIT_P5
#define SPLIT_P5 1
#endif
#ifndef MOE_SP2
#define MOE_SP2 true
#endif
#ifndef MOE_ALIGN
#define MOE_ALIGN true
#endif
#ifndef PROBE_PH
#define PROBE_PH -1
#endif
#ifndef PROBE_N
#define PROBE_N 2
#endif
#define REPS(k) ((((k) >= 10 && (k) < 28) ? 10 + ((k) - 10) % 3 : (k)) == PROBE_PH ? PROBE_N : 1)
#ifndef ONLY_PHASE
#define ONLY_PHASE -1
#endif
constexpr int NPH = 31;
struct Args { const float* in[42]; float* out; unsigned char* ws; int ph_lo, ph_hi; };

__global__ void __launch_bounds__(NTHR, 2) mk_fwd(Args args) {
    extern __shared__ __attribute__((aligned(16))) unsigned char lds_raw[];
    LAS unsigned char* lds = (LAS unsigned char*)lds_raw;
#define CAS __attribute__((address_space(4)))
#define FRESH_CX const CAS char* ka_ = (const CAS char*)__builtin_amdgcn_kernarg_segment_ptr(); asm volatile("" : "+s"(ka_)); const float* const CAS* I = (const float* const CAS*)ka_; unsigned char* ws = *(unsigned char* const CAS*)(ka_ + 344); float* OUTP = *(float* const CAS*)(ka_ + 336); (void)I; (void)ws; (void)OUTP; \
    Ctx cx; { int t_; asm volatile("v_mbcnt_lo_u32_b32 %0, -1, 0\n\tv_mbcnt_hi_u32_b32 %0, -1, %0" : "=v"(t_)); t_ += wv0_ * 64;      cx.lds = lds; cx.tid = t_; cx.lane = t_ & 63; cx.wave = __builtin_amdgcn_readfirstlane(t_ >> 6); cx.G = gridDim.x; cx.wg = blockIdx.x; cx.gw = cx.wg * NWAVES + cx.wave; cx.NGW = cx.G * NWAVES; }
    unsigned char* ws = args.ws;
    const int lo = args.ph_lo, hi = args.ph_hi;
    volatile LAS unsigned* MISC = (volatile LAS unsigned*)(lds + LDS_MISC);
    const int wv0_ = __builtin_amdgcn_readfirstlane((int)threadIdx.x >> 6);
    if (wv0_ == 0) MISC[__builtin_amdgcn_mbcnt_hi(~0u, __builtin_amdgcn_mbcnt_lo(~0u, 0u))] = 0u;
    __syncthreads();
    XcdBarrier bar; bar.bar = (unsigned*)(ws + WS_CTL) + CW_BAR; bar.x = 0; bar.st = nullptr; bar.wv = wv0_;
    if (hi - lo > 1) bar = xcd_barrier_post((unsigned*)(ws + WS_CTL) + CW_BAR, MISC + 8, wv0_);

#define IN(k) ((ONLY_PHASE < 0 || ONLY_PHASE == (k) || (ONLY_PHASE >= 10 && ONLY_PHASE < 28 && (k) >= 10 && (k) < 28 && ((k) - 10) % 3 == (ONLY_PHASE - 10) % 3)) && lo <= (k) && (k) < hi)
#ifndef PROBE_BAR
#define PROBE_BAR 1
#endif
#ifndef PROBE_T
#define PROBE_T -1
#endif
#define STAMP() do { if (PROBE_T >= 0 && blockIdx.x == 0 && xb_first(wv0_)) { const unsigned long long t_ = __builtin_amdgcn_s_memrealtime(); MISC[16 + 2 * nst] = (unsigned)t_; MISC[17 + 2 * nst] = (unsigned)(t_ >> 32); } ++nst; } while (0)
#define SEAM(k) do { if (IN(k) && IN((k) + 1)) { for (int b_ = 0; b_ < PROBE_BAR; ++b_) xcd_barrier(bar); STAMP(); } } while (0)
    int nst = 0; STAMP();
#define MAKE_RP RwkvP RP; RP.rkv = RKV; RP.wag = WAG; RP.mu_rkv = I[13]; RP.w0 = I[15]; RP.a0 = I[18]; RP.k_k = I[23]; RP.k_a = I[24]; RP.r_k = I[25]; RP.ln_w = I[26]; RP.ln_b = I[27]
#define OPQ(v) ({ int _k = (v); asm volatile("" : "+s"(_k)); _k; })

    if (IN(0)) for (int rep_ = 0; rep_ < REPS(0); ++rep_) {
        FRESH_CX;
        for (int it = cx.wg; it < 256; it += cx.G) s5_tables_item(cx, it >> 3, it & 7, I[4], I[5], I[6], I[7], I[8], I[9], I[10], S5BT, S5ET, ATG);
        const float* mu = I[14];
        transpose_matrix(cx, I[3], 1024, 2048, WCAT, 0, 1024, 0, nullptr, 0);
        transpose_matrix(cx, I[16], 1024, 64, WCAT, 2048, 1024, 0, mu, 1);          transpose_matrix(cx, I[16], 1024, 64, WCAT, 2304, 1024, 0, mu, 0);
        transpose_matrix(cx, I[19], 1024, 64, WCAT, 2112, 1024, 0, mu + 1024, 1);   transpose_matrix(cx, I[19], 1024, 64, WCAT, 2368, 1024, 0, mu + 1024, 0);
        transpose_matrix(cx, I[21], 1024, 128, WCAT, 2176, 1024, 0, mu + 2048, 1);  transpose_matrix(cx, I[21], 1024, 128, WCAT, 2432, 1024, 0, mu + 2048, 0);
        transpose_matrix(cx, I[17], 64, 512, WL2, 0, 256, 0, nullptr, 0);
        transpose_matrix(cx, I[20], 64, 512, WL2, 512, 256, 64, nullptr, 0);
        transpose_matrix(cx, I[22], 128, 512, WL2, 1024, 256, 128, nullptr, 0);
        for (int idx = cx.wg * NTHR + cx.tid; idx < 1536 * 32; idx += cx.G * NTHR) { const int row = idx >> 5, ch = idx & 31, blk = row >> 9; const int kb = blk == 0 ? 0 : (blk == 1 ? 64 : 128), ke = blk == 0 ? 64 : (blk == 1 ? 128 : 256);
            if (ch * 8 < kb || ch * 8 >= ke) *(u32x4*)(WL2 + (size_t)row * 256 + ch * 8) = (u32x4){0u, 0u, 0u, 0u}; }
        transpose_matrix(cx, I[12], 512, 512, WGLU, 0, 512, 0, nullptr, 0);
        transpose_matrix(cx, I[39], 256, 1024, WPP, 0, 256, 0, nullptr, 0);
        transpose_matrix(cx, I[28], 1024, 1024, WOUT, 0, 1024, 0, nullptr, 0);
        { LAS float* scr = (LAS float*)(cx.lds + cx.wave * 16640);
          for (int it = cx.gw; it < 256; it += cx.NGW) { const int kb = it >> 5, nb = it & 31;
              transpose_item_fp8(I[40], 1024, 128 * kb, 32 * nb, WPG + (size_t)(32 * nb) * 1024 + 128 * kb, 1024, 32.0f, scr, cx.lane); } }
        for (int m = 2 * cx.gw; m < M; m += 2 * cx.NGW) rms_rows2_to_bf16(I[0] + (size_t)m * 1024, I[0] + (size_t)(m + 1) * 1024, I[2], HBUF + (size_t)m * 1024, HBUF + (size_t)(m + 1) * 1024, cx.lane);
        for (int m = 4 * cx.gw; m < M; m += 4 * cx.NGW) { f32x4 v[4];
#pragma unroll
            for (int r = 0; r < 4; ++r) v[r] = __builtin_nontemporal_load((const f32x4*)(I[1] + (size_t)(m + r) * 256) + cx.lane);
#pragma unroll
            for (int r = 0; r < 4; ++r) { u32x2 w; w.x = pk2(v[r].x, v[r].y); w.y = pk2(v[r].z, v[r].w); *((u32x2*)(PBF + (size_t)(m + r) * 256) + cx.lane) = w; } }
    }
    SEAM(0);
    if (IN(1)) for (int rep_ = 0; rep_ < REPS(1); ++rep_) {
        FRESH_CX;
        SchedPlain S; S.init(128, 10, cx.G, cx.wg); S.A = (const char*)HBUF; S.B = (const char*)WCAT; S.a_tile = 256 * 1024 * 2; S.b_tile = 256 * 1024 * 2;
        EpiProj E{AG, RKV, LP};
#if CONV_EARLY
        const int kins = (cx.wg >> 3) % 6;
        S.i0 = 0; S.i1 = kins;
        pg8::gemm_phase<EpiProj, SchedPlain, true, true, false>(lds, cx.tid, OPQ(1024), OPQ(1024), OPQ(1024), S, E);
        if (rep_ == 0) { FRESH_CX;
#ifdef PROBE_CONV1
            for (int q_ = 0; q_ < PROBE_CONV1; ++q_) { convert_pass<1>(cx, 0, 32, I[32], I[34], I[36], WGU, WDN); __syncthreads(); }
#endif
            convert_pass<1>(cx, 0, 32, I[32], I[34], I[36], WGU, WDN); __syncthreads(); }
        { FRESH_CX;
          SchedPlain S; S.init(128, 10, cx.G, cx.wg); S.A = (const char*)HBUF; S.B = (const char*)WCAT; S.a_tile = 256 * 1024 * 2; S.b_tile = 256 * 1024 * 2; S.i0 = (cx.wg >> 3) % 6;
          EpiProj E{AG, RKV, LP};
          pg8::gemm_phase<EpiProj, SchedPlain, true, true, false>(lds, cx.tid, OPQ(1024), OPQ(1024), OPQ(1024), S, E); }
#else
        pg8::gemm_phase<EpiProj, SchedPlain, true, true, false>(lds, cx.tid, OPQ(1024), OPQ(1024), OPQ(1024), S, E);
#endif
    }
    SEAM(1);
    if (IN(2)) for (int rep_ = 0; rep_ < REPS(2); ++rep_) {
        FRESH_CX;
        for (int m = 2 * cx.gw; m < M; m += 2 * cx.NGW) {
            const int lane = cx.lane; const bool first = (m & (SEQ - 1)) == 0;
            const u32x2 a0 = *((const u32x2*)(LP + (size_t)m * 512) + lane), a1 = *((const u32x2*)(LP + (size_t)(m + 1) * 512) + lane), b1 = *((const u32x2*)(LP + (size_t)m * 512 + 256) + lane);
            u32x2 b0 = (u32x2){0u, 0u}; if (!first) b0 = *((const u32x2*)(LP + (size_t)(m - 1) * 512 + 256) + lane);
            float v[8] = {lo16(a0.x) + lo16(b0.x), hi16(a0.x) + hi16(b0.x), lo16(a0.y) + lo16(b0.y), hi16(a0.y) + hi16(b0.y), lo16(a1.x) + lo16(b1.x), hi16(a1.x) + hi16(b1.x), lo16(a1.y) + lo16(b1.y), hi16(a1.y) + hi16(b1.y)};
#pragma unroll
            for (int i = 0; i < 8; ++i) v[i] = lane < 16 ? ftanh(v[i]) : (lane < 32 ? v[i] : fsigmoid(v[i]));
            u32x2 o; o.x = pk2(v[0], v[1]); o.y = pk2(v[2], v[3]); *((u32x2*)(LACT + (size_t)m * 256) + lane) = o;
            o.x = pk2(v[4], v[5]); o.y = pk2(v[6], v[7]); *((u32x2*)(LACT + (size_t)(m + 1) * 256) + lane) = o;
        }
    }
    SEAM(2);
    if (IN(3)) for (int rep_ = 0; rep_ < REPS(3); ++rep_) {
        FRESH_CX;
        { SchedPlain S; S.init(128, 6, cx.G, cx.wg); S.A = (const char*)LACT; S.B = (const char*)WL2; S.a_tile = 256 * 256 * 2; S.b_tile = 256 * 256 * 2;
          EpiBf16Plain E{WAG, 1536};
          pg8::gemm_phase<EpiBf16Plain, SchedPlain, true, true, false>(lds, cx.tid, OPQ(256), OPQ(256), OPQ(256), S, E); }
        { SchedS5 S; S.init(128, 1, cx.G, cx.wg); S.A = (const char*)AG; S.B = (const char*)S5ET; S.a_tile = 256 * 640 * 2; S.b_tile = 0; S.b_group = 256 * 512 * 2;
          EpiF32 E{EBUF, 256};
          pg8::gemm_phase<EpiF32, SchedS5, true, true, false>(lds, cx.tid, OPQ(512), OPQ(640), OPQ(512), S, E); }
    }
    SEAM(3);
    if (IN(4)) for (int rep_ = 0; rep_ < REPS(4); ++rep_) {
        FRESH_CX;
        for (int base = cx.wg * 32; base < 8192; base += cx.G * 32) { const int idx = base + (cx.lane & 31), b = idx >> 11, g = (idx >> 6) & 31, p = idx & 63, w8 = cx.wave;
            LAS float* CE = (LAS float*)lds;
            const float ar = ATG[(g * 64 + p) * 2], ai = ATG[(g * 64 + p) * 2 + 1];
            const size_t row0 = (size_t)g * 1024 + b * 256 + 32 * w8;
            float er[32], ei[32];
            if (cx.lane < 32) {
#pragma unroll
                for (int k = 0; k < 32; ++k) { er[k] = EBUF[(row0 + k) * 256 + p]; ei[k] = EBUF[(row0 + k) * 256 + 64 + p]; }
                float sr = 0.f, si = 0.f;
#pragma unroll
                for (int k = 0; k < 32; ++k) { const float nr = ar * sr - ai * si + er[k], ni = ar * si + ai * sr + ei[k]; sr = nr; si = ni; }
                CE[(w8 * 32 + cx.lane) * 2] = sr; CE[(w8 * 32 + cx.lane) * 2 + 1] = si; }
            __syncthreads();
            if (cx.lane < 32) {
                float pr = 1.f, pi = 0.f;
                { float qr = ar, qi = ai;
#pragma unroll
                  for (int i = 0; i < 5; ++i) { const float tr_ = qr * qr - qi * qi, ti_ = 2.f * qr * qi; qr = tr_; qi = ti_; } pr = qr; pi = qi; }
                float cr = 0.f, ci = 0.f;
                for (int w2 = 0; w2 < w8; ++w2) { const float e0 = CE[(w2 * 32 + cx.lane) * 2], e1 = CE[(w2 * 32 + cx.lane) * 2 + 1]; const float nr = pr * cr - pi * ci + e0, ni = pr * ci + pi * cr + e1; cr = nr; ci = ni; }
                float sr = cr, si = ci;
#pragma unroll
                for (int k = 0; k < 32; ++k) { bf16* d = AG + (row0 + k) * 640 + 512 + p; d[0] = (bf16)(pk2(sr, 0.f) & 0xffffu); d[64] = (bf16)(pk2(si, 0.f) & 0xffffu);
                    const float nr = ar * sr - ai * si + er[k], ni = ar * si + ai * sr + ei[k]; sr = nr; si = ni; } }
            __syncthreads();
        }
        MAKE_RP;
        for (int grp = cx.wg; grp < 256; grp += cx.G) rwkv_pass1(lds, RP, grp * 16, 16, cx.tid, QCT, HCT, W1G, ULG, DLG, (float*)(ws + WS_TOKSLOT));
    }
    SEAM(4);
    if (IN(5)) for (int rep_ = 0; rep_ < REPS(5); ++rep_) {
        FRESH_CX;
        if (SPLIT_P5 && cx.G == 256) {
            if (cx.wg < 128) { if (cx.wave == 0) rwkv_pass2(lds, cx.wg >> 2, cx.wg & 3, cx.lane, QCT, HCT, DLG, S0G); }
            else { SchedS5 S; S.init(128, 2, 128, cx.wg - 128); S.A = (const char*)AG; S.B = (const char*)S5BT; S.a_tile = 256 * 640 * 2; S.b_tile = 256 * 640 * 2; S.b_group = 512 * 640 * 2;
                EpiS5Y E{AG, I[11], Y1};
                pg8::gemm_phase<EpiS5Y, SchedS5, true, true, false>(lds, cx.tid, OPQ(640), OPQ(640), OPQ(640), S, E); }
        } else {
            { SchedS5 S; S.init(128, 2, cx.G, cx.wg); S.A = (const char*)AG; S.B = (const char*)S5BT; S.a_tile = 256 * 640 * 2; S.b_tile = 256 * 640 * 2; S.b_group = 512 * 640 * 2;
              EpiS5Y E{AG, I[11], Y1};
              pg8::gemm_phase<EpiS5Y, SchedS5, true, true, false>(lds, cx.tid, OPQ(640), OPQ(640), OPQ(640), S, E); }
            if (cx.wave == 0) for (int it = cx.wg; it < 128; it += cx.G) rwkv_pass2(lds, it >> 2, it & 3, cx.lane, QCT, HCT, DLG, S0G);
        }
    }
    SEAM(5);
    if (IN(6)) for (int rep_ = 0; rep_ < REPS(6); ++rep_) {
        FRESH_CX;
        MAKE_RP;
        for (int grp = cx.wg; grp < 256; grp += cx.G) rwkv_pass3(lds, RP, grp * 16, 16, cx.tid, S0G, W1G, ULG, (const float*)(ws + WS_TOKSLOT), MIX);
        __syncthreads();
        { SchedPlain S; S.init(128, 2, cx.G, cx.wg); S.A = (const char*)Y1; S.B = (const char*)WGLU; S.a_tile = 256 * 512 * 2; S.b_tile = 256 * 512 * 2;
          EpiGlu E{Y1, MIX};
          pg8::gemm_phase<EpiGlu, SchedPlain, true, true, false>(lds, cx.tid, OPQ(512), OPQ(512), OPQ(512), S, E); }
    }
    SEAM(6);
    if (IN(7)) for (int rep_ = 0; rep_ < REPS(7); ++rep_) {
        FRESH_CX;
        SchedPlain S; S.init(128, 4, cx.G, cx.wg); S.A = (const char*)MIX; S.B = (const char*)WOUT; S.a_tile = 256 * 1024 * 2; S.b_tile = 256 * 1024 * 2;
#ifdef STAG7
        if ((cx.wg >> 3) & 1) for (int q_ = 0; q_ < STAG7; ++q_) __builtin_amdgcn_s_sleep(127);
#endif
        EpiResid E{I[0], XB};
        pg8::gemm_phase<EpiResid, SchedPlain, true, true, false>(lds, cx.tid, OPQ(1024), OPQ(1024), OPQ(1024), S, E);
    }
    SEAM(7);
    if (IN(8)) for (int rep_ = 0; rep_ < REPS(8); ++rep_) { FRESH_CX; router_phase(cx, XB, I[29], I[30], I[31], H2, TOPE, TOPG, HIST); }
    SEAM(8);
    LAS int* PL = (LAS int*)(lds + LDS_PLAN);
    if (hi > 9 && lo < 28) { FRESH_CX; __syncthreads(); moe_plan(cx, HIST); }
    const int npass = (hi > 9 && lo < 28) ? PL[PL_NPASS] : 0;
    if (IN(9)) for (int rep_ = 0; rep_ < REPS(9); ++rep_) { FRESH_CX; dispatch_phase(cx, HIST, TOPE, SLOTTOK, TOKSLOT);
#if !CONV_EARLY
        convert_pass<0>(cx, PL[PL_PE0], PL[PL_PE0 + 1], I[32], I[34], I[36], WGU, WDN);
#endif
    }
    SEAM(9);
    for (int p = 0; p < 6; ++p) {
        const bool actv = p < npass;
        const int e0 = actv ? PL[PL_PE0 + p] : 0, e1 = actv ? PL[PL_PE0 + p + 1] : 0, row0 = actv ? PL[PL_PROW0 + p] : 0, rows = actv ? PL[PL_PROW0 + p + 1] - row0 : 0;
        if (IN(10 + 3 * p) && actv) for (int rep_ = 0; rep_ < REPS(10); ++rep_) {
            FRESH_CX;
            SchedMoe<true> S; S.init(rows / 256, 8, cx.G, cx.wg); S.A = (const char*)H2; S.B = (const char*)WGU; S.a_tile = 0; S.b_tile = 256 * 1024; S.b_exp = (size_t)2048 * 1024; S.tile_e = PL + PL_TILEE; S.tile0 = row0 / 256; S.e0 = e0; S.slot_tok = SLOTTOK; S.row0 = row0;
#ifdef PROBE_EPI10
            if (rep_ + 1 < REPS(10)) { PROBE_EPI10 E0 PROBE_EPI10_INIT; pg8::gemm_phase<PROBE_EPI10, SchedMoe<true>, MOE_ALIGN, MOE_SP2, true, true>(lds, cx.tid, OPQ(512), OPQ(512), OPQ(512), S, E0); continue; }
#endif
            EpiGU E{ACT, I[33], I[35]};
#if CONV_EARLY
            S.e0 = 0;
            const int kins = (cx.wg >> 3) % 16;
            S.i0 = 0; S.i1 = kins;
            pg8::gemm_phase<EpiGU, SchedMoe<true>, MOE_ALIGN, MOE_SP2, true, true>(lds, cx.tid, OPQ(512), OPQ(512), OPQ(512), S, E);
            if (rep_ == 0 && p == 0) { FRESH_CX;
#ifdef PROBE_CONV10
                for (int q_ = 0; q_ < PROBE_CONV10; ++q_) { convert_pass<2>(cx, 0, 32, I[32], I[34], I[36], WGU, WDN); __syncthreads(); }
#endif
                convert_pass<2>(cx, 0, 32, I[32], I[34], I[36], WGU, WDN); __syncthreads(); }
            { FRESH_CX;
              SchedMoe<true> S; S.init(rows / 256, 8, cx.G, cx.wg); S.A = (const char*)H2; S.B = (const char*)WGU; S.a_tile = 0; S.b_tile = 256 * 1024; S.b_exp = (size_t)2048 * 1024; S.tile_e = PL + PL_TILEE; S.tile0 = row0 / 256; S.e0 = 0; S.slot_tok = SLOTTOK; S.row0 = row0;
              S.i0 = (cx.wg >> 3) % 16;
              EpiGU E{ACT, I[33], I[35]};
              pg8::gemm_phase<EpiGU, SchedMoe<true>, MOE_ALIGN, MOE_SP2, true, true>(lds, cx.tid, OPQ(512), OPQ(512), OPQ(512), S, E); }
#else
            pg8::gemm_phase<EpiGU, SchedMoe<true>, MOE_ALIGN, MOE_SP2, true, true>(lds, cx.tid, OPQ(512), OPQ(512), OPQ(512), S, E);
#endif
        }
        if (actv) SEAM(10 + 3 * p);
        if (IN(11 + 3 * p) && actv) for (int rep_ = 0; rep_ < REPS(11); ++rep_) {
            FRESH_CX;
            SchedMoe<false> S; S.init(rows / 256, 4, cx.G, cx.wg); S.A = (const char*)ACT; S.B = (const char*)WDN; S.a_tile = 256 * 1024; S.b_tile = 256 * 1024; S.b_exp = (size_t)1024 * 1024; S.tile_e = PL + PL_TILEE; S.tile0 = row0 / 256; S.e0 = e0; S.slot_tok = SLOTTOK; S.row0 = row0;
#ifdef PROBE_NULLEPI
            if (rep_ + 1 < REPS(11)) { PROBE_EPIX E0{YB, I[37]}; pg8::gemm_phase<PROBE_EPIX, SchedMoe<false>, MOE_ALIGN, MOE_SP2, false, true>(lds, cx.tid, OPQ(512), OPQ(512), OPQ(512), S, E0); continue; }
#endif
#ifdef STAG11
            if (rep_ == 0) { const int ns_ = ((cx.wg >> 3) & 3) * STAG11; for (int q_ = 0; q_ < ns_; ++q_) __builtin_amdgcn_s_sleep(127); }
#endif
            EpiDown E{YB, I[37]};
#if CONV_EARLY
            S.e0 = 0;
#endif
            pg8::gemm_phase<EpiDown, SchedMoe<false>, MOE_ALIGN, MOE_SP2, false, true>(lds, cx.tid, OPQ(512), OPQ(512), OPQ(512), S, E);
        }
        if (actv) SEAM(11 + 3 * p);
        if (IN(12 + 3 * p) && actv) for (int rep_ = 0; rep_ < REPS(12); ++rep_) {
            FRESH_CX;
            if (p + 1 < npass) { combine_pass<false>(cx, e0, e1, row0, TOPE, TOPG, TOKSLOT, YB, XB, nullptr, nullptr);
#if !CONV_EARLY
                convert_pass<0>(cx, PL[PL_PE0 + p + 1], PL[PL_PE0 + p + 2], I[32], I[34], I[36], WGU, WDN);
#endif
            }
            else {
                if (e0 == 0 && e1 == 32 && row0 == 0) combine_all(cx, TOPG, TOKSLOT, YB, XB, I[38], (unsigned char*)(ws + WS_R1));
                else combine_pass<true>(cx, e0, e1, row0, TOPE, TOPG, TOKSLOT, YB, XB, I[38], (unsigned char*)(ws + WS_R1));
                SchedPlain S; S.init(128, 4, cx.G, cx.wg); S.A = (const char*)PBF; S.B = (const char*)WPP; S.a_tile = 256 * 256 * 2; S.b_tile = 256 * 256 * 2;
                EpiBf16Plain E{PP, 1024};
                pg8::gemm_phase<EpiBf16Plain, SchedPlain, true, true, false>(lds, cx.tid, OPQ(256), OPQ(256), OPQ(256), S, E);
            }
        }
        if (actv) SEAM(12 + 3 * p);
    }
    if (IN(29)) for (int rep_ = 0; rep_ < REPS(29); ++rep_) {
        FRESH_CX;
        SchedPlain S; S.init(128, 4, cx.G, cx.wg); S.A = (const char*)(ws + WS_R1); S.B = (const char*)WPG; S.a_tile = 256 * 1024; S.b_tile = 256 * 1024;
        if (FUSE_FNORM && cx.G == 256) { EpiPleNorm E{PP, XB, OUTP, I[41], (float*)(ws + WS_CTL) + CW_ROWSS, (unsigned*)(ws + WS_CTL) + CW_PCNT};
            pg8::gemm_phase<EpiPleNorm, SchedPlain, true, true, false, true>(lds, cx.tid, OPQ(512), OPQ(512), OPQ(512), S, E); }
        else { EpiPle E{PP, XB};
            pg8::gemm_phase<EpiPle, SchedPlain, true, true, false, true>(lds, cx.tid, OPQ(512), OPQ(512), OPQ(512), S, E); }
    }
    SEAM(29);
    if (IN(30) && !(FUSE_FNORM && gridDim.x == 256)) for (int rep_ = 0; rep_ < REPS(30); ++rep_) {
        FRESH_CX;
        for (int m = 2 * cx.gw; m < M; m += 2 * cx.NGW) {
            const u32x2* ia_ = (const u32x2*)(XB + (size_t)m * 1024) + cx.lane; const u32x2* ib_ = ia_ + 256;
            f32x4* xa = (f32x4*)(OUTP + (size_t)m * 1024) + cx.lane; f32x4* xb = xa + 256; const f32x4* gr = (const f32x4*)I[41] + cx.lane; f32x4 va[4], vb[4]; float sa = 0.f, sb = 0.f;
#pragma unroll
            for (int j = 0; j < 4; ++j) { const u32x2 wa = ia_[64 * j], wb = ib_[64 * j]; va[j] = (f32x4){lo16(wa.x), hi16(wa.x), lo16(wa.y), hi16(wa.y)}; vb[j] = (f32x4){lo16(wb.x), hi16(wb.x), lo16(wb.y), hi16(wb.y)}; }
#pragma unroll
            for (int j = 0; j < 4; ++j) { sa += (va[j].x * va[j].x + va[j].y * va[j].y) + (va[j].z * va[j].z + va[j].w * va[j].w); sb += (vb[j].x * vb[j].x + vb[j].y * vb[j].y) + (vb[j].z * vb[j].z + vb[j].w * vb[j].w); }
#pragma unroll
            for (int o = 1; o < 64; o <<= 1) { sa += __shfl_xor(sa, o); sb += __shfl_xor(sb, o); }
            const float ia = rsqrtf(sa * (1.f / 1024.f) + 1e-6f), ib = rsqrtf(sb * (1.f / 1024.f) + 1e-6f);
#pragma unroll
            for (int j = 0; j < 4; ++j) { const f32x4 gg = gr[64 * j]; xa[64 * j] = (f32x4){va[j].x * ia * gg.x, va[j].y * ia * gg.y, va[j].z * ia * gg.z, va[j].w * ia * gg.w}; xb[64 * j] = (f32x4){vb[j].x * ib * gg.x, vb[j].y * ib * gg.y, vb[j].z * ib * gg.z, vb[j].w * ib * gg.w}; }
        }
    }
    if (PROBE_T >= 0 && blockIdx.x == 0 && xb_first(wv0_)) { STAMP(); asm volatile("s_waitcnt vmcnt(0)" ::: "memory");
        const unsigned long long t0_ = ((unsigned long long)MISC[17 + 2 * PROBE_T] << 32) | MISC[16 + 2 * PROBE_T], t1_ = ((unsigned long long)MISC[19 + 2 * PROBE_T] << 32) | MISC[18 + 2 * PROBE_T];
        (*(float* const CAS*)((const CAS char*)__builtin_amdgcn_kernarg_segment_ptr() + 336))[0] = (float)(t1_ - t0_) * 0.01f; }
#undef IN
#undef SEAM
}

extern "C" void kernel_launch(void* const* d_in, const int* in_sizes, int n_in, void* d_out, int out_size, void* d_ws, size_t ws_size, hipStream_t stream) {
    static int grid = 0;
    if (grid == 0) {
        if (n_in != 42 || out_size != M * DM || ws_size < WS_END) { fprintf(stderr, "kernel_launch: unexpected shapes (n_in %d out %d ws %zu)\n", n_in, out_size, ws_size); grid = -1; return; }
        int dev = 0, cus = 0, per_cu = 0;
        if (hipGetDevice(&dev) != hipSuccess || hipDeviceGetAttribute(&cus, hipDeviceAttributeMultiprocessorCount, dev) != hipSuccess) { grid = -1; return; }
        if (hipFuncSetAttribute((const void*)mk_fwd, hipFuncAttributeMaxDynamicSharedMemorySize, LDS_BYTES) != hipSuccess) { fprintf(stderr, "kernel_launch: hipFuncSetAttribute failed\n"); grid = -1; return; }
        if (hipOccupancyMaxActiveBlocksPerMultiprocessor(&per_cu, (const void*)mk_fwd, NTHR, LDS_BYTES) != hipSuccess || per_cu < 1) fprintf(stderr, "kernel_launch: occupancy query says %d\n", per_cu);
        (void)hipGetLastError();
        grid = cus > 256 ? 256 : cus;
    }
    if (grid < 0) return;
    (void)hipMemsetAsync((char*)d_ws + WS_CTL, 0, CTL_ZERO_BYTES, stream);
    Args a{};
    for (int i = 0; i < 42; ++i) a.in[i] = (const float*)d_in[i];
    a.out = (float*)d_out; a.ws = (unsigned char*)d_ws;
#if MK_PER_PHASE
    for (int ph = 0; ph < NPH; ++ph) { a.ph_lo = ph; a.ph_hi = ph + 1; hipLaunchKernelGGL(mk_fwd, dim3(grid), dim3(NTHR), LDS_BYTES, stream, a); }
#else
    a.ph_lo = 0; a.ph_hi = NPH;
    hipLaunchKernelGGL(mk_fwd, dim3(grid), dim3(NTHR), LDS_BYTES, stream, a);
#endif
}
```

```cpp
#include <hip/hip_runtime.h>
#include <cstdio>
#include <cstdint>

#ifndef MK_PER_PHASE
#define MK_PER_PHASE 0
#endif

#define LAS __attribute__((address_space(3)))
#define GAS __attribute__((address_space(1)))
typedef unsigned short bf16;
typedef short bf16x8 __attribute__((ext_vector_type(8)));
typedef float f32x4 __attribute__((ext_vector_type(4)));
typedef float f32x2 __attribute__((ext_vector_type(2)));
typedef unsigned u32x4 __attribute__((ext_vector_type(4)));
typedef unsigned u32x2 __attribute__((ext_vector_type(2)));
typedef GAS unsigned gu32;

constexpr int NB = 4, SEQ = 8192, DM = 1024, M = NB * SEQ;
constexpr int NEXP = 32, TOPK = 4;
constexpr int NWAVES = 8, NTHR = 512;
constexpr size_t MiB = 1u << 20;

constexpr size_t WS_CTL = 0, CTL_ZERO_BYTES = 1 * MiB;
constexpr size_t WS_HIST = 1 * MiB;
constexpr size_t WS_TOPE = 2 * MiB;
constexpr size_t WS_TOPG = 3 * MiB;
constexpr size_t WS_TOKSLOT = 4 * MiB;
constexpr size_t WS_SLOTTOK = 5 * MiB;
constexpr size_t WS_AT = 6 * MiB;
constexpr size_t WS_DL = 6 * MiB + 65536;
constexpr size_t WS_WCAT = 8 * MiB;
constexpr size_t WS_WL2 = 13 * MiB;
constexpr size_t WS_WGLU = 14 * MiB;
constexpr size_t WS_WPP = 14 * MiB + 524288;
constexpr size_t WS_WOUT = 15 * MiB;
constexpr size_t WS_WPG = 17 * MiB;
constexpr size_t WS_S5BT = 19 * MiB;
constexpr size_t WS_S5ET = 39 * MiB;
constexpr size_t WS_PBF = 48 * MiB;
constexpr size_t WS_R1 = 64 * MiB;
constexpr size_t WS_RKV = 128 * MiB;
constexpr size_t WS_WAG = 224 * MiB;
constexpr size_t WS_AG = 320 * MiB;
constexpr size_t WS_U = 360 * MiB;
constexpr size_t WS_LP = 392 * MiB;
constexpr size_t WS_LACT = 424 * MiB;
constexpr size_t WS_W1 = 440 * MiB;
constexpr size_t WS_ULOC = 472 * MiB;
constexpr size_t WS_Y1 = 504 * MiB;
constexpr size_t WS_H2 = 64 * MiB;
constexpr size_t WS_WDN = 96 * MiB;
constexpr size_t WS_ACT = 128 * MiB;
constexpr size_t WS_Y = 264 * MiB;
constexpr size_t WS_XB = 400 * MiB;
constexpr size_t WS_WGU = 264 * MiB;
constexpr int RMAX = 139264;
constexpr int MAXEPP = 32;
constexpr size_t WS_END = 560 * MiB;
static_assert(WS_Y + (size_t)RMAX * 1024 <= WS_XB && WS_XB + (size_t)M * 2048 <= WS_END && WS_ACT + (size_t)RMAX * 1024 <= WS_Y, "moe map");

constexpr int CW_BAR = 4096;
constexpr int CW_ROWSS = 65536;
constexpr int CW_PCNT = 131072;

constexpr int LDS_PLAN = 147456;
constexpr int LDS_MISC = 155648;
constexpr int LDS_BYTES = 156672;
constexpr int PL_CNT = 0, PL_PSTART = 32, PL_NPASS = 72, PL_PE0 = 80, PL_PROW0 = 88, PL_TILEE = 128, PL_TMP = 768;

#define LDS_WAIT() asm volatile("s_waitcnt lgkmcnt(0)" ::: "memory")
#define VM_WAIT() asm volatile("s_waitcnt vmcnt(0)" ::: "memory")
__device__ __forceinline__ float bf2f(unsigned b) { return __uint_as_float(b << 16); }
typedef __bf16 bf16n2 __attribute__((ext_vector_type(2)));
__device__ __forceinline__ unsigned cvt_pk_bf16(float lo, float hi) { const f32x2 f = {lo, hi}; const bf16n2 v = __builtin_convertvector(f, bf16n2); return __builtin_bit_cast(unsigned, v); }
__device__ __forceinline__ unsigned pk2(float lo, float hi) { return cvt_pk_bf16(lo, hi); }
__device__ __forceinline__ float lo16(unsigned w) { return __uint_as_float(w << 16); }
__device__ __forceinline__ float hi16(unsigned w) { return __uint_as_float(w & 0xffff0000u); }
__device__ __forceinline__ unsigned pk4_fp8(float a, float b, float c, float d) { unsigned w; asm volatile("" : "=v"(w));     w = (unsigned)__builtin_amdgcn_cvt_pk_fp8_f32(a, b, (int)w, false); w = (unsigned)__builtin_amdgcn_cvt_pk_fp8_f32(c, d, (int)w, true); return w; }
__device__ __forceinline__ f32x4 up4_fp8(unsigned w) { const f32x2 lo = __builtin_amdgcn_cvt_pk_f32_fp8((int)w, false), hi = __builtin_amdgcn_cvt_pk_f32_fp8((int)w, true); return (f32x4){lo.x, lo.y, hi.x, hi.y}; }
__device__ __forceinline__ float frcp(float x) { return __builtin_amdgcn_rcpf(x); }
__device__ __forceinline__ float fsigmoid(float x) { return frcp(1.0f + __expf(-x)); }
__device__ __forceinline__ float ftanh(float x) { const float e = __expf(-2.0f * fabsf(x)); const float t = (1.0f - e) * frcp(1.0f + e); return x < 0.f ? -t : t; }
__device__ __forceinline__ float gelu_tanh(float x) { const float u = 0.7978845608f * (x + 0.044715f * x * x * x); return 0.5f * x * (1.0f + ftanh(u)); }
__device__ __forceinline__ float wave_sum(float v) {
#pragma unroll
    for (int o = 1; o < 64; o <<= 1) v += __shfl_xor(v, o);
    return v;
}
__device__ __forceinline__ float wave_max(float v) {
#pragma unroll
    for (int o = 1; o < 64; o <<= 1) v = fmaxf(v, __shfl_xor(v, o));
    return v;
}

#define XB_TMO      128
#define XB_XCNT(j)  (256  + 64 * (j))
#define XB_XSUB(j)  (1280 + 64 * (j))
#define XB_XGEN(j)  (2304 + 64 * (j))
#define XB_TOP      3328
#define XB_TOPGEN   3392
#define XCD_BAR_WORDS 3456
#define XB_SPIN_CAP (1u << 22)

__device__ __forceinline__ unsigned xb_ld(unsigned* p)              { return __hip_atomic_load(p, __ATOMIC_RELAXED, __HIP_MEMORY_SCOPE_AGENT); }
__device__ __forceinline__ unsigned xb_add(unsigned* p, unsigned v) { return __hip_atomic_fetch_add(p, v, __ATOMIC_RELAXED, __HIP_MEMORY_SCOPE_AGENT); }
__device__ __forceinline__ unsigned xb_xcc_id() { return (unsigned)__builtin_amdgcn_s_getreg((3 << 11) | 20) & 0xFu; }
#define XB_SPIN(cond, bar) do { unsigned _sp = 0; while (cond) { __builtin_amdgcn_s_sleep(1); \
    if ((++_sp & 255u) == 0u) { if (xb_ld(&(bar)[XB_TMO])) break; if (_sp > XB_SPIN_CAP) { atomicAdd(&(bar)[XB_TMO], 1u); break; } } } } while (0)

struct XcdBarrier { unsigned* bar; unsigned x; volatile LAS unsigned* st; int wv; };
__device__ __forceinline__ bool xb_first(int wv) { return wv == 0 && __builtin_amdgcn_mbcnt_hi(~0u, __builtin_amdgcn_mbcnt_lo(~0u, 0u)) == 0u; }

__device__ __forceinline__ XcdBarrier xcd_barrier_post(unsigned* bar, volatile LAS unsigned* st, int wv) {
    XcdBarrier b; b.bar = bar; b.x = xb_xcc_id(); b.st = st; b.wv = wv;
    if (xb_first(wv)) (void)xb_add(&bar[XB_XCNT(b.x)], 1u);
    return b;
}
__device__ __forceinline__ void xcd_barrier_complete(unsigned* bar, unsigned x, unsigned& nloc, unsigned& nx) {
    const unsigned G = gridDim.x * gridDim.y * gridDim.z;
    unsigned sum, cnt, mine, sp = 0u;
    for (;;) {
        sum = 0u; cnt = 0u; mine = 0u;
#pragma unroll
        for (unsigned j = 0; j < 16; ++j) { const unsigned c = xb_ld(&bar[XB_XCNT(j)]); sum += c; cnt += (c > 0u) ? 1u : 0u; mine = (j == x) ? c : mine; }
        if (sum == G) break;
        __builtin_amdgcn_s_sleep(1);
        if ((++sp & 255u) == 0u) { if (xb_ld(&bar[XB_TMO])) break; if (sp > XB_SPIN_CAP) { atomicAdd(&bar[XB_TMO], 1u); break; } }
    }
    nloc = mine > 0u ? mine : 1u; nx = cnt > 0u ? cnt : 1u;
}
__device__ __forceinline__ void xcd_barrier(const XcdBarrier& b) {
    asm volatile("s_waitcnt vmcnt(0)" ::: "memory");
    __syncthreads();
    if (xb_first(b.wv)) {
        unsigned* bar = b.bar;
        __builtin_amdgcn_s_waitcnt(0);
        unsigned nloc = b.st[0], nx = b.st[1];
        if (nloc == 0u) { xcd_barrier_complete(bar, b.x, nloc, nx); b.st[0] = nloc; b.st[1] = nx; }
        const unsigned old = xb_add(&bar[XB_XSUB(b.x)], 1u);
        const unsigned gen = old / nloc;
        if (old + 1u == (gen + 1u) * nloc) {
            __builtin_amdgcn_fence(__ATOMIC_RELEASE, "agent");
            asm volatile("s_waitcnt vmcnt(0)" ::: "memory");
            const unsigned og = xb_add(&bar[XB_TOP], 1u);
            const unsigned tg = og / nx;
            if (og + 1u == (tg + 1u) * nx) xb_add(&bar[XB_TOPGEN], 1u);
            else XB_SPIN(xb_ld(&bar[XB_TOPGEN]) == tg, bar);
            __builtin_amdgcn_fence(__ATOMIC_ACQUIRE, "agent");
            xb_add(&bar[XB_XGEN(b.x)], 1u);
            asm volatile("s_waitcnt vmcnt(0)" ::: "memory");
        } else {
            XB_SPIN(xb_ld(&bar[XB_XGEN(b.x)]) == gen, bar);
            __builtin_amdgcn_fence(__ATOMIC_ACQUIRE, "agent");
            asm volatile("s_waitcnt vmcnt(0)" ::: "memory");
        }
    }
    __syncthreads();
}

#ifndef PG8_WGM
#define PG8_WGM 8
#endif
namespace pg8 {
constexpr int BM = 256, BK = 64, HALF = 128, HTB = HALF * BK * 2, STAGE_BYTES = 8 * HTB, NXCD = 8, WGM = PG8_WGM;
__host__ __device__ __forceinline__ int lds_byte(int r, int c) { const int st = (r >> 4) * 2 + (c >> 5), rr = r & 15, cc = c & 31, ob = rr * 64 + cc * 2; return st * 1024 + (ob ^ (((ob >> 9) & 1) << 5)); }
__host__ __device__ __forceinline__ void stage_rc(int b, int& R, int& C) { const int st = b / 1024, sb = b % 1024, swz = sb ^ (((sb >> 9) & 1) << 5); R = (st >> 1) * 16 + swz / 64; C = (st & 1) * 32 + (swz % 64) / 2; }
__host__ __device__ __forceinline__ int perm32(int rho) { const int n = rho >> 4, i = rho & 15; return 8 * (i >> 2) + 4 * n + (i & 3); }

struct Unit { int pm, pn, aux; };

struct Order {
    int nM, nN, nwg, G, c, i0, i1;
    __device__ __forceinline__ void init(int nM_, int nN_, int G_, int c_) { nM = nM_; nN = nN_; nwg = nM * nN; G = G_; c = c_; i0 = 0; i1 = 1 << 28; }
    __device__ __forceinline__ bool tile(int i, int& pm, int& pn) const {
        i += i0; if (i >= i1) return false;
        const long L = (long)i * G + c; if (L >= nwg) return false;
        int wgid = (int)L; { const int q = nwg / NXCD, r = nwg % NXCD, xcd = wgid % NXCD, off = wgid / NXCD; wgid = (xcd < r ? xcd * (q + 1) : r * (q + 1) + (xcd - r) * q) + off; }
        const int nig = WGM * nN, gid = wgid / nig, fm = gid * WGM, gsz = (nM - fm) < WGM ? (nM - fm) : WGM;
        pm = fm + ((wgid % nig) % gsz); pn = (wgid % nig) / gsz; return true;
    }
};


template <class Epi, class Sched, bool ALIGN_EPI, bool SP2, bool GATHER, bool FP8 = false>
__device__ __forceinline__ void gemm_phase(LAS unsigned char* lds, const int tid, const int K, const int lda, const int ldb, const Sched& S, const Epi& E) {
    const int wid = __builtin_amdgcn_readfirstlane(tid >> 6), lane = tid & 63, wr = wid >> 2, wc = wid & 3, fr = lane & 15, fq = lane >> 4;
    const int nt = K / BK;
    unsigned voffA[2], voffB[2]; int rA[2], cA2[2];
#pragma unroll
    for (int i = 0; i < 2; ++i) { int R, C; stage_rc(tid * 16 + i * 8192, R, C); const int Rb = Epi::PERM ? ((R & ~31) + perm32(R & 31)) : R;
        voffA[i] = (unsigned)(R * lda + C) * 2u; voffB[i] = (unsigned)(Rb * ldb + C) * 2u; rA[i] = R; cA2[i] = C * 2; }
    const size_t kstep = (size_t)(BK * 2);
    const size_t hstepA = (size_t)HALF * lda * 2, hstepB = (size_t)HALF * ldb * 2;
    const unsigned ldsw = (unsigned)wid * 1024u;
    const int aoff = FP8 ? lds_byte(wr * 64 + fr, fq * 16) : lds_byte(wr * 64 + fr, fq * 8), boff = FP8 ? lds_byte(wc * 32 + fr, fq * 16) : lds_byte(wc * 32 + fr, fq * 8);
    unsigned cv0[2] = {0u, 0u}, cv1[2] = {0u, 0u};
#define PG8_SA(b, h) (((b) * 2 + (h)) * HTB)
#define PG8_SB(b, h) ((4 + (b) * 2 + (h)) * HTB)
#define PG8_STAGE(bufoff, gbase, voff) do { _Pragma("unroll") for (int _i = 0; _i < 2; ++_i) \
        __builtin_amdgcn_global_load_lds((const unsigned*)((const char*)(gbase) + (voff)[_i]), (LAS unsigned*)(lds + (bufoff) + ldsw + _i * 8192), 16, 0, 0); } while (0)
#define PG8_NROW(h, i) ((has_next ? *(const LAS unsigned*)(pf_rows + (i) * 512 + (h) * 256 + lane * 4) * (unsigned)(lda * 2) + (unsigned)cA2[i] : ((h) ? cv1[i] : cv0[i])))
#define PG8_STAGE_A(bufoff, ptr, h, nx) do { if constexpr (GATHER) { unsigned _v[2]; if (nx) { asm volatile("" ::: "memory"); _v[0] = PG8_NROW(h, 0); _v[1] = PG8_NROW(h, 1); } else { _v[0] = (h) ? cv1[0] : cv0[0]; _v[1] = (h) ? cv1[1] : cv0[1]; } PG8_STAGE(bufoff, ptr, _v); } \
        else { PG8_STAGE(bufoff, (ptr) + (h) * hstepA, voffA); } } while (0)
#define PG8_LDA(dst, b, h) do { if constexpr (FP8) { _Pragma("unroll") for (int m = 0; m < 4; ++m) { dst##8[m].lo = *(const LAS v4i_*)(lds + PG8_SA(b, h) + aoff + m * 2048); dst##8[m].hi = *(const LAS v4i_*)(lds + PG8_SA(b, h) + aoff + m * 2048 + 16); } } \
        else { _Pragma("unroll") for (int m = 0; m < 4; ++m) _Pragma("unroll") for (int k = 0; k < 2; ++k) dst[m][k] = *(const LAS bf16x8*)(lds + PG8_SA(b, h) + aoff + m * 2048 + k * 1024); } } while (0)
#define PG8_LDB(dst, b, h) do { if constexpr (FP8) { _Pragma("unroll") for (int n = 0; n < 2; ++n) { dst##8[n].lo = *(const LAS v4i_*)(lds + PG8_SB(b, h) + boff + n * 2048); dst##8[n].hi = *(const LAS v4i_*)(lds + PG8_SB(b, h) + boff + n * 2048 + 16); } } \
        else { _Pragma("unroll") for (int n = 0; n < 2; ++n) _Pragma("unroll") for (int k = 0; k < 2; ++k) dst[n][k] = *(const LAS bf16x8*)(lds + PG8_SB(b, h) + boff + n * 2048 + k * 1024); } } while (0)
#define PG8_MMA(ai, bj, At, Bt) do { __builtin_amdgcn_s_setprio(1); _Pragma("unroll") for (int m = 0; m < 4; ++m) _Pragma("unroll") for (int n = 0; n < 2; ++n) { \
        if constexpr (FP8) asm volatile("v_mfma_scale_f32_16x16x128_f8f6f4 %0, %1, %2, %0, %3, %4 op_sel_hi:[0,0,0]" : "+v"(acc[ai][bj][m][n]) : "v"(Bt##8[n]), "v"(At##8[m]), "v"(sclW), "v"(sclA));   \
        else { _Pragma("unroll") for (int k = 0; k < 2; ++k) acc[ai][bj][m][n] = __builtin_amdgcn_mfma_f32_16x16x32_bf16(Bt[n][k], At[m][k], acc[ai][bj][m][n], 0, 0, 0); } } \
        __builtin_amdgcn_s_setprio(0); } while (0)
#define PG8_WAIT_V(n) asm volatile("s_waitcnt vmcnt(" #n ")" ::: "memory")
#define PG8_WAIT_L(n) asm volatile("s_waitcnt lgkmcnt(" #n ")" ::: "memory")
#define PG8_BAR __builtin_amdgcn_s_barrier()
#define PG8_SCHED __builtin_amdgcn_sched_barrier(0)
#define PG8_ROWS(u, d0, d1) do { _Pragma("unroll") for (int _i = 0; _i < 2; ++_i) { const int _r0 = S.a_row(u, rA[_i]), _r1 = S.a_row(u, HALF + rA[_i]); \
        d0[_i] = (unsigned)_r0 * (unsigned)(lda * 2) + (unsigned)cA2[_i]; d1[_i] = (unsigned)_r1 * (unsigned)(lda * 2) + (unsigned)cA2[_i]; } } while (0)
    constexpr int PF_OFF = STAGE_BYTES;
    LAS unsigned char* pf_bias = lds + PF_OFF + wid * 256; LAS unsigned char* pf_rows = lds + PF_OFF + 2048 + wid * 1024;
    Unit cur, nxt; int ui = 0; bool has_next = false;
    if (!S.next(0, cur)) return;
    f32x4 acc[2][2][4][2];
#define PG8_ACC_INIT() do { if constexpr (Epi::ACCINIT) { E.init(acc, pf_bias, fq); } else { _Pragma("unroll") for (int a = 0; a < 2; ++a) _Pragma("unroll") for (int b = 0; b < 2; ++b) _Pragma("unroll") for (int m = 0; m < 4; ++m) \
        _Pragma("unroll") for (int n = 0; n < 2; ++n) acc[a][b][m][n] = (f32x4){0.f, 0.f, 0.f, 0.f}; } } while (0)
    if constexpr (Epi::ACCINIT) { E.pref(pf_bias, cur, wc, lane); PG8_WAIT_V(0); }
    PG8_ACC_INIT();
    typedef int v8i_ __attribute__((ext_vector_type(8))); typedef int v4i_ __attribute__((ext_vector_type(4)));
    bf16x8 At[4][2], B0[2][2], B1[2][2]; v8i_ At8[4], B08[2], B18[2];
    const int sclW = 0x7a7a7a7a, sclA = 0x7f7f7f7f;
    const char* cA = S.a_ptr(cur); const char* cB = S.b_ptr(cur);
    if constexpr (GATHER) { PG8_ROWS(cur, cv0, cv1); }
    if constexpr (SP2) {
        PG8_STAGE(PG8_SB(0, 0), cB, voffB); PG8_STAGE(PG8_SB(0, 1), cB + hstepB, voffB); PG8_STAGE_A(PG8_SA(0, 0), cA, 0, false); PG8_STAGE_A(PG8_SA(0, 1), cA, 1, false);
        if (wr == 1) PG8_BAR;
        PG8_WAIT_V(2); PG8_BAR;
        PG8_STAGE(PG8_SB(1, 0), cB + kstep, voffB); PG8_STAGE_A(PG8_SA(1, 0), cA + kstep, 0, false); PG8_STAGE(PG8_SB(1, 1), cB + hstepB + kstep, voffB);
        PG8_WAIT_V(6); PG8_BAR;
    } else {
        PG8_STAGE(PG8_SB(0, 0), cB, voffB); PG8_STAGE_A(PG8_SA(0, 0), cA, 0, false); PG8_STAGE(PG8_SB(0, 1), cB + hstepB, voffB); PG8_STAGE_A(PG8_SA(0, 1), cA, 1, false);
        if (wr == 1) PG8_BAR;
        PG8_WAIT_V(4); PG8_BAR;
        PG8_STAGE(PG8_SB(1, 0), cB + kstep, voffB); PG8_STAGE_A(PG8_SA(1, 0), cA + kstep, 0, false); PG8_STAGE(PG8_SB(1, 1), cB + hstepB + kstep, voffB);
        PG8_WAIT_V(6); PG8_BAR;
    }
    for (;;) {
        has_next = S.next(ui + 1, nxt);
        const char* nA = has_next ? S.a_ptr(nxt) : cA; const char* nB = has_next ? S.b_ptr(nxt) : cB;
        if constexpr (Epi::ACCINIT) { if (has_next) E.pref(pf_bias, nxt, wc, lane); } else if constexpr (Epi::PREF) E.pref(pf_bias, cur, wc, lane);
        if constexpr (GATHER) { if (has_next) {
#pragma unroll
                for (int _i = 0; _i < 2; ++_i) { __builtin_amdgcn_global_load_lds((const unsigned*)S.a_row_ptr(nxt, rA[_i]), (LAS unsigned*)(pf_rows + _i * 512), 4, 0, 0);
                                                 __builtin_amdgcn_global_load_lds((const unsigned*)S.a_row_ptr(nxt, HALF + rA[_i]), (LAS unsigned*)(pf_rows + _i * 512 + 256), 4, 0, 0); } }
            }
        for (int t = 0; t < nt; t += 2) {
            const bool last = (t == nt - 2);
            const char* a1 = cA + (size_t)(t + 1) * kstep;
            const char* a2 = last ? nA : cA + (size_t)(t + 2) * kstep; const char* b2 = last ? nB : cB + (size_t)(t + 2) * kstep;
            const char* a3 = a2 + kstep; const char* b3 = b2 + kstep;
            if constexpr (SP2) {
            PG8_LDB(B0, 0, 0); PG8_LDB(B1, 0, 1); PG8_SCHED; PG8_LDA(At, 0, 0); PG8_STAGE_A(PG8_SA(1, 1), a1, 1, false);
            PG8_WAIT_V(8); PG8_WAIT_L(0); PG8_BAR; PG8_MMA(0, 0, At, B0); PG8_MMA(0, 1, At, B1); PG8_BAR; PG8_SCHED;
            PG8_LDA(At, 0, 1); PG8_STAGE(PG8_SB(0, 0), b2, voffB); PG8_STAGE(PG8_SB(0, 1), b2 + hstepB, voffB); PG8_STAGE_A(PG8_SA(0, 0), a2, 0, last);
            PG8_WAIT_V(8); PG8_WAIT_L(0); PG8_BAR; PG8_MMA(1, 0, At, B0); PG8_MMA(1, 1, At, B1); PG8_BAR; PG8_SCHED;
            PG8_LDB(B0, 1, 0); PG8_LDB(B1, 1, 1); PG8_SCHED; PG8_LDA(At, 1, 0); PG8_STAGE_A(PG8_SA(0, 1), a2, 1, last);
            PG8_WAIT_V(8); PG8_WAIT_L(0); PG8_BAR; PG8_MMA(0, 0, At, B0); PG8_MMA(0, 1, At, B1); PG8_BAR; PG8_SCHED;
            PG8_LDA(At, 1, 1); PG8_STAGE(PG8_SB(1, 0), b3, voffB); PG8_STAGE(PG8_SB(1, 1), b3 + hstepB, voffB); PG8_STAGE_A(PG8_SA(1, 0), a3, 0, last);
            PG8_WAIT_V(8); PG8_WAIT_L(0); PG8_BAR; PG8_MMA(1, 0, At, B0); PG8_MMA(1, 1, At, B1); PG8_BAR; PG8_SCHED;
            } else {
            PG8_LDB(B0, 0, 0); PG8_SCHED; PG8_LDA(At, 0, 0); PG8_STAGE_A(PG8_SA(1, 1), a1, 1, false);
            PG8_WAIT_L(8); PG8_BAR; PG8_WAIT_L(0); PG8_MMA(0, 0, At, B0); PG8_BAR; PG8_SCHED;
            PG8_LDB(B1, 0, 1); PG8_STAGE(PG8_SB(0, 0), b2, voffB);
            PG8_BAR; PG8_WAIT_L(0); PG8_MMA(0, 1, At, B1); PG8_BAR;
            PG8_LDA(At, 0, 1); PG8_STAGE_A(PG8_SA(0, 0), a2, 0, last);
            PG8_BAR; PG8_WAIT_L(0); PG8_MMA(1, 0, At, B0); PG8_BAR; PG8_SCHED;
            PG8_STAGE(PG8_SB(0, 1), b2 + hstepB, voffB);
            PG8_WAIT_V(6); PG8_BAR; PG8_MMA(1, 1, At, B1); PG8_BAR;
            PG8_LDB(B0, 1, 0); PG8_SCHED; PG8_LDA(At, 1, 0); PG8_STAGE_A(PG8_SA(0, 1), a2, 1, last);
            PG8_WAIT_L(8); PG8_BAR; PG8_WAIT_L(0); PG8_MMA(0, 0, At, B0); PG8_BAR; PG8_SCHED;
            PG8_LDB(B1, 1, 1); PG8_STAGE(PG8_SB(1, 0), b3, voffB);
            PG8_BAR; PG8_WAIT_L(0); PG8_MMA(0, 1, At, B1); PG8_BAR;
            PG8_LDA(At, 1, 1); PG8_STAGE_A(PG8_SA(1, 0), a3, 0, last);
            PG8_BAR; PG8_WAIT_L(0); PG8_MMA(1, 0, At, B0); PG8_BAR; PG8_SCHED;
            PG8_STAGE(PG8_SB(1, 1), b3 + hstepB, voffB);
            PG8_WAIT_V(6); PG8_BAR; PG8_MMA(1, 1, At, B1); PG8_BAR;
            }
        }
        if constexpr (ALIGN_EPI) { if (wr == 0) PG8_BAR; }
        if constexpr (FP8) asm volatile("s_nop 15\n\ts_nop 15" ::: "memory");
        E(acc, cur, wr, wc, fr, fq, pf_bias);
        if (!has_next) break;
        PG8_ACC_INIT();
        cur = nxt; cA = nA; cB = nB; ++ui;
        if constexpr (GATHER) { asm volatile("" ::: "memory"); cv0[0] = PG8_NROW(0, 0); cv0[1] = PG8_NROW(0, 1); cv1[0] = PG8_NROW(1, 0); cv1[1] = PG8_NROW(1, 1); }
        if constexpr (ALIGN_EPI) { if (wr == 1) PG8_BAR; }
    }
    PG8_WAIT_V(0);
    if constexpr (!ALIGN_EPI) { if (wr == 0) PG8_BAR; }
    PG8_BAR;
#undef PG8_SA
#undef PG8_SB
#undef PG8_STAGE
#undef PG8_STAGE_A
#undef PG8_NROW
#undef PG8_LDA
#undef PG8_LDB
#undef PG8_MMA
#undef PG8_WAIT_V
#undef PG8_WAIT_L
#undef PG8_BAR
#undef PG8_SCHED
#undef PG8_ROWS
#undef PG8_ACC_INIT
}
}

using pg8::Unit;
struct SchedPlain : pg8::Order {
    const char* A; const char* B; size_t a_tile, b_tile;
    __device__ __forceinline__ bool next(int i, Unit& u) const { u.aux = 0; return tile(i, u.pm, u.pn); }
    __device__ __forceinline__ const char* a_ptr(const Unit& u) const { return A + (size_t)u.pm * a_tile; }
    __device__ __forceinline__ const char* b_ptr(const Unit& u) const { return B + (size_t)u.pn * b_tile; }
    __device__ __forceinline__ int a_row(const Unit&, int) const { return 0; }
    __device__ __forceinline__ const int* a_row_ptr(const Unit&, int) const { return nullptr; }
};
struct SchedS5 : pg8::Order {
    const char* A; const char* B; size_t a_tile, b_tile, b_group;
    __device__ __forceinline__ bool next(int i, Unit& u) const { u.aux = 0; return tile(i, u.pm, u.pn); }
    __device__ __forceinline__ const char* a_ptr(const Unit& u) const { return A + (size_t)u.pm * a_tile; }
    __device__ __forceinline__ const char* b_ptr(const Unit& u) const { return B + (size_t)(u.pm >> 2) * b_group + (size_t)u.pn * b_tile; }
    __device__ __forceinline__ int a_row(const Unit&, int) const { return 0; }
    __device__ __forceinline__ const int* a_row_ptr(const Unit&, int) const { return nullptr; }
};
template <bool GATHER> struct SchedMoe : pg8::Order {
    const char* A; const char* B; size_t a_tile, b_tile, b_exp; const LAS int* tile_e; int tile0, e0; const int* slot_tok; int row0;
    __device__ __forceinline__ bool next(int i, Unit& u) const { const bool ok = tile(i, u.pm, u.pn); u.aux = ok ? tile_e[tile0 + u.pm] : 0; return ok; }
    __device__ __forceinline__ const char* a_ptr(const Unit& u) const { return GATHER ? A : A + (size_t)u.pm * a_tile; }
    __device__ __forceinline__ const char* b_ptr(const Unit& u) const { return B + (size_t)(u.aux - e0) * b_exp + (size_t)u.pn * b_tile; }
    __device__ __forceinline__ int a_row(const Unit& u, int r) const { return slot_tok[row0 + u.pm * 256 + r]; }
    __device__ __forceinline__ const int* a_row_ptr(const Unit& u, int r) const { return slot_tok + row0 + u.pm * 256 + r; }
};

__device__ __forceinline__ void st8(bf16* p, const f32x4 v0, const f32x4 v1) {
    u32x4 w; w.x = cvt_pk_bf16(v0[0], v0[1]); w.y = cvt_pk_bf16(v0[2], v0[3]); w.z = cvt_pk_bf16(v1[0], v1[1]); w.w = cvt_pk_bf16(v1[2], v1[3]); *(u32x4*)p = w;
}
__device__ __forceinline__ void ld8(const bf16* p, f32x4& v0, f32x4& v1) {
    const u32x4 w = *(const u32x4*)p; v0 = (f32x4){lo16(w.x), hi16(w.x), lo16(w.y), hi16(w.y)}; v1 = (f32x4){lo16(w.z), hi16(w.z), lo16(w.w), hi16(w.w)};
}
#define EPI_LOOP_AM _Pragma("unroll") for (int ai = 0; ai < 2; ++ai) _Pragma("unroll") for (int m = 0; m < 4; ++m)
#define EPI_ARGS f32x4 (&acc)[2][2][4][2], const Unit& u, int wr, int wc, int fr, int fq, const LAS unsigned char* pf

struct EpiProj { static constexpr bool PERM = true, PREF = false, ACCINIT = false; bf16 *AG, *RKV, *LP;
    __device__ __forceinline__ void operator()(EPI_ARGS) const {
        const int row0 = u.pm * 256 + wr * 64 + fr;
        if (u.pn < 2) { const int col0 = u.pn * 256 + wc * 32 + 8 * fq;
            EPI_LOOP_AM { const int row = row0 + ai * 128 + m * 16;
#pragma unroll
                for (int bj = 0; bj < 2; ++bj) { const int c = col0 + bj * 128; st8(AG + ((size_t)((c >> 4) * 1024 + (row >> 5))) * 640 + (row & 31) * 16 + (c & 15), acc[ai][bj][m][0], acc[ai][bj][m][1]); } }
        } else {
            bf16* base; int ldc, c0;
            if (u.pn < 8) { base = RKV; ldc = 1536; c0 = (u.pn - 2) * 256; } else { base = LP; ldc = 512; c0 = (u.pn - 8) * 256; }
            const int col0 = c0 + wc * 32 + 8 * fq;
            EPI_LOOP_AM { bf16* rowp = base + (size_t)(row0 + ai * 128 + m * 16) * ldc + col0;
#pragma unroll
                for (int bj = 0; bj < 2; ++bj) st8(rowp + bj * 128, acc[ai][bj][m][0], acc[ai][bj][m][1]); }
        }
    }
};
struct EpiBf16Plain { static constexpr bool PERM = true, PREF = false, ACCINIT = false; bf16* O; int ldc;
    __device__ __forceinline__ void operator()(EPI_ARGS) const {
        const int row0 = u.pm * 256 + wr * 64 + fr, col0 = u.pn * 256 + wc * 32 + 8 * fq;
        EPI_LOOP_AM { bf16* rowp = O + (size_t)(row0 + ai * 128 + m * 16) * ldc + col0;
#pragma unroll
            for (int bj = 0; bj < 2; ++bj) st8(rowp + bj * 128, acc[ai][bj][m][0], acc[ai][bj][m][1]); }
    }
};
struct EpiF32 { static constexpr bool PERM = false, PREF = false, ACCINIT = false; float* C; int ldc;
    __device__ __forceinline__ void operator()(EPI_ARGS) const {
        const int row0 = u.pm * 256 + wr * 64 + fr, col0 = u.pn * 256 + wc * 32 + 4 * fq;
        EPI_LOOP_AM { float* rowp = C + (size_t)(row0 + ai * 128 + m * 16) * ldc + col0;
#pragma unroll
            for (int bj = 0; bj < 2; ++bj)
#pragma unroll
                for (int n = 0; n < 2; ++n) *(f32x4*)(rowp + bj * 128 + n * 16) = acc[ai][bj][m][n]; }
    }
};
struct EpiS5Y { static constexpr bool PERM = true, PREF = false, ACCINIT = false; const bf16* AG; const float* dskip; bf16* Y1;
    __device__ __forceinline__ void operator()(EPI_ARGS) const {
        const int g = u.pm >> 2, crow0 = (u.pm & 3) * 256 + wr * 64 + fr, col0 = u.pn * 256 + wc * 32 + 8 * fq, c = col0 & 15;
        const f32x4 d0 = *(const f32x4*)(dskip + g * 16 + c), d1 = *(const f32x4*)(dskip + g * 16 + c + 4);
#pragma unroll
        for (int ai = 0; ai < 2; ++ai) { u32x4 uu[4][2];
#pragma unroll
            for (int m = 0; m < 4; ++m)
#pragma unroll
                for (int bj = 0; bj < 2; ++bj) uu[m][bj] = *(const u32x4*)(AG + ((size_t)(g * 1024 + crow0 + ai * 128 + m * 16)) * 640 + col0 + bj * 128);
#pragma unroll
            for (int m = 0; m < 4; ++m)
#pragma unroll
                for (int bj = 0; bj < 2; ++bj) { const int crow = crow0 + ai * 128 + m * 16, col = col0 + bj * 128, t = col >> 4; const u32x4 w = uu[m][bj];
                    const f32x4 u0 = {lo16(w.x), hi16(w.x), lo16(w.y), hi16(w.y)}, u1 = {lo16(w.z), hi16(w.z), lo16(w.w), hi16(w.w)};
                    f32x4 v0 = acc[ai][bj][m][0] + d0 * u0, v1 = acc[ai][bj][m][1] + d1 * u1;
#pragma unroll
                    for (int j = 0; j < 4; ++j) { v0[j] = gelu_tanh(v0[j]); v1[j] = gelu_tanh(v1[j]); }
                    st8(Y1 + (size_t)(crow * 32 + t) * 512 + g * 16 + c, v0, v1); } }
    }
};
struct EpiGlu { static constexpr bool PERM = true, PREF = false, ACCINIT = false; const bf16* Y1; bf16* MIX;
    __device__ __forceinline__ void operator()(EPI_ARGS) const {
        const int row0 = u.pm * 256 + wr * 64 + fr, col0 = u.pn * 256 + wc * 32 + 8 * fq;
#pragma unroll
        for (int ai = 0; ai < 2; ++ai) { u32x4 yy[4][2];
#pragma unroll
            for (int m = 0; m < 4; ++m)
#pragma unroll
                for (int bj = 0; bj < 2; ++bj) yy[m][bj] = *(const u32x4*)(Y1 + (size_t)(row0 + ai * 128 + m * 16) * 512 + col0 + bj * 128);
#pragma unroll
            for (int m = 0; m < 4; ++m)
#pragma unroll
                for (int bj = 0; bj < 2; ++bj) { const int row = row0 + ai * 128 + m * 16, col = col0 + bj * 128; const u32x4 w = yy[m][bj];
                    const f32x4 y0 = {lo16(w.x), hi16(w.x), lo16(w.y), hi16(w.y)}, y1v = {lo16(w.z), hi16(w.z), lo16(w.w), hi16(w.w)}; f32x4 v0, v1;
#pragma unroll
                    for (int j = 0; j < 4; ++j) { v0[j] = y0[j] * fsigmoid(acc[ai][bj][m][0][j]); v1[j] = y1v[j] * fsigmoid(acc[ai][bj][m][1][j]); }
                    st8(MIX + (size_t)row * 1024 + col, v0, v1); } }
    }
};
struct EpiResid { static constexpr bool PERM = true, PREF = false, ACCINIT = false; const float* X; bf16* O;
    __device__ __forceinline__ void operator()(EPI_ARGS) const {
        const int row0 = u.pm * 256 + wr * 64 + fr, col0 = u.pn * 256 + wc * 32 + 8 * fq;
#pragma unroll
        for (int ai = 0; ai < 2; ++ai)
#pragma unroll
            for (int bj = 0; bj < 2; ++bj) { f32x4 xa[4][2];
#pragma unroll
                for (int m = 0; m < 4; ++m) { const float* xp = X + (size_t)(row0 + ai * 128 + m * 16) * 1024 + col0 + bj * 128; xa[m][0] = __builtin_nontemporal_load((const f32x4*)xp); xa[m][1] = __builtin_nontemporal_load((const f32x4*)(xp + 4)); }
#pragma unroll
                for (int m = 0; m < 4; ++m) st8(O + (size_t)(row0 + ai * 128 + m * 16) * 1024 + col0 + bj * 128, xa[m][0] + acc[ai][bj][m][0], xa[m][1] + acc[ai][bj][m][1]); }
    }
};
struct EpiGU { static constexpr bool PERM = true, PREF = true, ACCINIT = true; unsigned char* ACT; const float* bg; const float* bu;
    __device__ __forceinline__ void pref(LAS unsigned char* pf, const Unit& u, int wc, int lane) const {
        const float* src = ((lane & 32) ? bu : bg) + u.aux * 1024 + u.pn * 128 + wc * 32 + (lane & 31);
        __builtin_amdgcn_global_load_lds((const unsigned*)src, (LAS unsigned*)pf, 4, 0, 0); }
    __device__ __forceinline__ void init(f32x4 (&acc)[2][2][4][2], const LAS unsigned char* pf, int fq) const {
        const f32x4 one = {1.f, 1.f, 1.f, 1.f};
        const f32x4 g0 = *(const LAS f32x4*)(pf + 32 * fq), g1 = *(const LAS f32x4*)(pf + 32 * fq + 16), u0 = *(const LAS f32x4*)(pf + 128 + 32 * fq) + one, u1 = *(const LAS f32x4*)(pf + 128 + 32 * fq + 16) + one;
#pragma unroll
        for (int ai = 0; ai < 2; ++ai)
#pragma unroll
            for (int m = 0; m < 4; ++m) { acc[ai][0][m][0] = g0; acc[ai][0][m][1] = g1; acc[ai][1][m][0] = u0; acc[ai][1][m][1] = u1; } }
    __device__ __forceinline__ void operator()(EPI_ARGS) const {
        const int row0 = u.pm * 256 + wr * 64 + fr + (fq & 1) * 16, col = u.pn * 128 + wc * 32 + (fq >> 1) * 16;
#pragma unroll
        for (int ai = 0; ai < 2; ++ai)
#pragma unroll
            for (int mp = 0; mp < 2; ++mp) { u32x2 w[2];
#pragma unroll
                for (int q = 0; q < 2; ++q) { const int m = 2 * mp + q; f32x4 v0, v1;
#pragma unroll
                    for (int j = 0; j < 4; ++j) {
                        const float gt0 = fminf(acc[ai][0][m][0][j], 7.0f), up0 = __builtin_amdgcn_fmed3f(acc[ai][1][m][0][j], -6.0f, 8.0f);
                        const float gt1 = fminf(acc[ai][0][m][1][j], 7.0f), up1 = __builtin_amdgcn_fmed3f(acc[ai][1][m][1][j], -6.0f, 8.0f);
                        v0[j] = (up0 * gt0) * frcp(1.0f + __builtin_amdgcn_exp2f(gt0 * -2.4554669f)); v1[j] = (up1 * gt1) * frcp(1.0f + __builtin_amdgcn_exp2f(gt1 * -2.4554669f)); }
                    w[q].x = pk4_fp8(v0[0], v0[1], v0[2], v0[3]); w[q].y = pk4_fp8(v1[0], v1[1], v1[2], v1[3]); }
                const auto rx = __builtin_amdgcn_permlane16_swap(w[0].x, w[1].x, false, false), ry = __builtin_amdgcn_permlane16_swap(w[0].y, w[1].y, false, false);
                *(u32x4*)(ACT + (size_t)(row0 + ai * 128 + mp * 32) * 1024 + col) = (u32x4){rx[0], ry[0], rx[1], ry[1]}; }
    }
};
struct EpiDown { static constexpr bool PERM = true, PREF = true, ACCINIT = true; unsigned char* Y; const float* bd;
    __device__ __forceinline__ void pref(LAS unsigned char* pf, const Unit& u, int wc, int lane) const {
        const float* src = bd + u.aux * 1024 + u.pn * 256 + (lane >> 5) * 128 + wc * 32 + (lane & 31);
        __builtin_amdgcn_global_load_lds((const unsigned*)src, (LAS unsigned*)pf, 4, 0, 0); }
    __device__ __forceinline__ void init(f32x4 (&acc)[2][2][4][2], const LAS unsigned char* pf, int fq) const {
#pragma unroll
        for (int bj = 0; bj < 2; ++bj) { const f32x4 b0 = *(const LAS f32x4*)(pf + 128 * bj + 32 * fq), b1 = *(const LAS f32x4*)(pf + 128 * bj + 32 * fq + 16);
#pragma unroll
            for (int ai = 0; ai < 2; ++ai)
#pragma unroll
                for (int m = 0; m < 4; ++m) { acc[ai][bj][m][0] = b0; acc[ai][bj][m][1] = b1; } } }
    __device__ __forceinline__ void operator()(EPI_ARGS) const {
        const int row0 = u.pm * 256 + wr * 64 + fr, col0 = u.pn * 256 + wc * 32 + (fq >> 1) * 16 + (fq & 1) * 128;
        EPI_LOOP_AM { unsigned char* rowp = Y + (size_t)(row0 + ai * 128 + m * 16) * 1024 + col0; u32x2 w[2];
#pragma unroll
            for (int bj = 0; bj < 2; ++bj) { const f32x4 v0 = acc[ai][bj][m][0], v1 = acc[ai][bj][m][1]; w[bj].x = pk4_fp8(v0[0], v0[1], v0[2], v0[3]); w[bj].y = pk4_fp8(v1[0], v1[1], v1[2], v1[3]); }
            const auto rx = __builtin_amdgcn_permlane16_swap(w[0].x, w[1].x, false, false), ry = __builtin_amdgcn_permlane16_swap(w[0].y, w[1].y, false, false);
            *(u32x4*)rowp = (u32x4){rx[0], ry[0], rx[1], ry[1]}; }
    }
};
struct EpiPle { static constexpr bool PERM = true, PREF = false, ACCINIT = false; const bf16* PP; bf16* O;
    __device__ __forceinline__ void operator()(EPI_ARGS) const {
        const int row0 = u.pm * 256 + wr * 64 + fr, col0 = u.pn * 256 + wc * 32 + 8 * fq;
        EPI_LOOP_AM { const size_t off = (size_t)(row0 + ai * 128 + m * 16) * 1024 + col0;
#pragma unroll
            for (int bj = 0; bj < 2; ++bj) { f32x4 p0, p1, x0, x1; ld8(PP + off + bj * 128, p0, p1); ld8(O + off + bj * 128, x0, x1);
#pragma unroll
                for (int j = 0; j < 4; ++j) { x0[j] += p0[j] * fsigmoid(acc[ai][bj][m][0][j]); x1[j] += p1[j] * fsigmoid(acc[ai][bj][m][1][j]); }
                st8(O + off + bj * 128, x0, x1); } }
    }
};

struct EpiNull { static constexpr bool PERM = true, PREF = false, ACCINIT = false; __device__ __forceinline__ void operator()(EPI_ARGS) const { } };
struct EpiPleNorm { static constexpr bool PERM = true, PREF = false, ACCINIT = false; const bf16* PP; const bf16* XIN; float* OUT; const float* gfin; float* rowss; unsigned* pcnt;
    __device__ __forceinline__ void operator()(EPI_ARGS) const {
        const int row0 = u.pm * 256 + wr * 64 + fr, col0 = u.pn * 256 + wc * 32 + 8 * fq;
#pragma unroll
        for (int ai = 0; ai < 2; ++ai)
#pragma unroll
            for (int mh = 0; mh < 2; ++mh) { u32x4 pw[2][2], xw[2][2];
#pragma unroll
                for (int mm = 0; mm < 2; ++mm)
#pragma unroll
                    for (int bj = 0; bj < 2; ++bj) { const size_t off = (size_t)(row0 + ai * 128 + (2 * mh + mm) * 16) * 1024 + col0 + bj * 128; pw[mm][bj] = *(const u32x4*)(PP + off); xw[mm][bj] = *(const u32x4*)(XIN + off); }
#pragma unroll
                for (int mm = 0; mm < 2; ++mm) { const int m = 2 * mh + mm; float s = 0.f;
#pragma unroll
                    for (int bj = 0; bj < 2; ++bj) { const u32x4 a = pw[mm][bj], b = xw[mm][bj];
                        const f32x4 p0 = {lo16(a.x), hi16(a.x), lo16(a.y), hi16(a.y)}, p1 = {lo16(a.z), hi16(a.z), lo16(a.w), hi16(a.w)}; f32x4 x0 = {lo16(b.x), hi16(b.x), lo16(b.y), hi16(b.y)}, x1 = {lo16(b.z), hi16(b.z), lo16(b.w), hi16(b.w)};
#pragma unroll
                        for (int j = 0; j < 4; ++j) { x0[j] += p0[j] * fsigmoid(acc[ai][bj][m][0][j]); x1[j] += p1[j] * fsigmoid(acc[ai][bj][m][1][j]); s += x0[j] * x0[j] + x1[j] * x1[j]; }
                        acc[ai][bj][m][0] = x0; acc[ai][bj][m][1] = x1; }
                    s += __shfl_xor(s, 16); s += __shfl_xor(s, 32);
                    if (fq == 0) atomicAdd(rowss + row0 + ai * 128 + m * 16, s); } }
        asm volatile("s_waitcnt vmcnt(0)" ::: "memory");
        unsigned* cnt = pcnt + 64 * u.pm;
        if ((fr | fq) == 0) __hip_atomic_fetch_add(cnt, 1u, __ATOMIC_RELAXED, __HIP_MEMORY_SCOPE_AGENT);
        { unsigned sp = 0; while (__builtin_amdgcn_readfirstlane(__hip_atomic_load(cnt, __ATOMIC_RELAXED, __HIP_MEMORY_SCOPE_AGENT)) < 32u) { __builtin_amdgcn_s_sleep(2); if (++sp > (1u << 22)) break; } }
        f32x4 gv[2][2];
#pragma unroll
        for (int bj = 0; bj < 2; ++bj) { gv[bj][0] = *(const f32x4*)(gfin + col0 + bj * 128); gv[bj][1] = *(const f32x4*)(gfin + col0 + bj * 128 + 4); }
        EPI_LOOP_AM { const int row = row0 + ai * 128 + m * 16; const float ssr = __hip_atomic_load(rowss + row, __ATOMIC_RELAXED, __HIP_MEMORY_SCOPE_AGENT); const float rinv = rsqrtf(ssr * (1.f / 1024.f) + 1e-6f);
            float* orow = OUT + (size_t)row * 1024 + col0;
#pragma unroll
            for (int bj = 0; bj < 2; ++bj) { __builtin_nontemporal_store(acc[ai][bj][m][0] * rinv * gv[bj][0], (f32x4*)(orow + bj * 128)); __builtin_nontemporal_store(acc[ai][bj][m][1] * rinv * gv[bj][1], (f32x4*)(orow + bj * 128 + 4)); } }
    }
};

struct Ctx { LAS unsigned char* lds; int tid, lane, wave, G, wg, gw, NGW; };

template <int NBW>
__device__ __forceinline__ void transpose_item(const float* W, int N, int k0, int n0, bf16* dst, int ldk, const float* scl, int flip, LAS float* scr, int lane) {
    constexpr int LPR = NBW / 4, RPI = 64 / LPR, NI = 64 / RPI;
    const int rr = lane / LPR, cc = (lane % LPR) * 4;
    f32x4 v[NI];
#pragma unroll
    for (int i = 0; i < NI; ++i) v[i] = *(const f32x4*)(W + (size_t)(k0 + i * RPI + rr) * N + n0 + cc);
#pragma unroll
    for (int i = 0; i < NI; ++i) { const int kk = i * RPI + rr; f32x4 x = v[i];
        if (scl) { const float s0 = scl[k0 + kk]; const float f = flip ? (1.0f - s0) : s0; x = x * f; }
        LAS float* d = scr + kk * 65 + cc; d[0] = x.x; d[1] = x.y; d[2] = x.z; d[3] = x.w; }
    LDS_WAIT(); asm volatile("" ::: "memory");
    const int c = lane & 7;
#pragma unroll
    for (int j = 0; j < NBW / 8; ++j) { const int n = (lane >> 3) + 8 * j; const LAS float* s = scr + (8 * c) * 65 + n;
        u32x4 o; o.x = pk2(s[0 * 65], s[1 * 65]); o.y = pk2(s[2 * 65], s[3 * 65]); o.z = pk2(s[4 * 65], s[5 * 65]); o.w = pk2(s[6 * 65], s[7 * 65]);
        *(u32x4*)(dst + (size_t)n * ldk + 8 * c) = o; }
    LDS_WAIT(); asm volatile("" ::: "memory");
}
struct F8Item { f32x4 v[16]; };
__device__ __forceinline__ void f8_issue(const float* W, int N, int k0, int n0, int lane, F8Item& it) {
    const int kq = lane >> 3, cc = (lane & 7) * 4;
#pragma unroll
    for (int i = 0; i < 16; ++i) it.v[i] = __builtin_nontemporal_load((const f32x4*)(W + (size_t)(k0 + 16 * kq + i) * N + n0 + cc));
}
__device__ __forceinline__ void f8_finish(const F8Item& it, unsigned char* dst, int ldk, float scale, LAS float*, int lane) {
    const int kq = lane >> 3, cc = (lane & 7) * 4;
#pragma unroll
    for (int j = 0; j < 4; ++j) { u32x4 o;
        o.x = pk4_fp8(it.v[0][j] * scale, it.v[1][j] * scale, it.v[2][j] * scale, it.v[3][j] * scale); o.y = pk4_fp8(it.v[4][j] * scale, it.v[5][j] * scale, it.v[6][j] * scale, it.v[7][j] * scale);
        o.z = pk4_fp8(it.v[8][j] * scale, it.v[9][j] * scale, it.v[10][j] * scale, it.v[11][j] * scale); o.w = pk4_fp8(it.v[12][j] * scale, it.v[13][j] * scale, it.v[14][j] * scale, it.v[15][j] * scale);
        *(u32x4*)(dst + (size_t)(cc + j) * ldk + 16 * kq) = o; }
}
__device__ __forceinline__ void transpose_item_fp8(const float* W, int N, int k0, int n0, unsigned char* dst, int ldk, float scale, LAS float* scr, int lane) {
    F8Item it; f8_issue(W, N, k0, n0, lane, it); f8_finish(it, dst, ldk, scale, scr, lane);
}
__device__ __forceinline__ void transpose_matrix(const Ctx& cx, const float* W, int K, int N, bf16* WT, int row_off, int ldk, int koff, const float* scl, int flip) {
    LAS float* scr = (LAS float*)(cx.lds + cx.wave * 16640);
    const int nblk = N / 64, nitems = (K / 64) * nblk;
    for (int it = cx.gw; it < nitems; it += cx.NGW) { const int kb = it / nblk, nb = it % nblk;
        transpose_item<64>(W, N, 64 * kb, 64 * nb, WT + (size_t)(row_off + 64 * nb) * ldk + koff + 64 * kb, ldk, scl, flip, scr, cx.lane); }
}
__device__ __forceinline__ void rms_row_to_bf16(const float* xrow, const float* g, bf16* orow, int lane) {
    const f32x4* xr = (const f32x4*)xrow + lane; const f32x4* gr = (const f32x4*)g + lane;
    f32x4 v[4]; float s = 0.f;
#pragma unroll
    for (int j = 0; j < 4; ++j) { v[j] = xr[64 * j]; s += (v[j].x * v[j].x + v[j].y * v[j].y) + (v[j].z * v[j].z + v[j].w * v[j].w); }
    const float rinv = rsqrtf(wave_sum(s) * (1.f / 1024.f) + 1e-6f);
    u32x2* o8 = (u32x2*)orow + lane;
#pragma unroll
    for (int j = 0; j < 4; ++j) { const f32x4 gg = gr[64 * j]; u32x2 w; w.x = pk2(v[j].x * rinv * gg.x, v[j].y * rinv * gg.y); w.y = pk2(v[j].z * rinv * gg.z, v[j].w * rinv * gg.w); o8[64 * j] = w; }
}

__device__ __forceinline__ void rms_rows2_to_bf16(const float* xa, const float* xb, const float* g, bf16* oa, bf16* ob, int lane) {
    const f32x4* ra = (const f32x4*)xa + lane; const f32x4* rb = (const f32x4*)xb + lane; const f32x4* gr = (const f32x4*)g + lane;
    f32x4 va[4], vb[4]; float sa = 0.f, sb = 0.f;
#pragma unroll
    for (int j = 0; j < 4; ++j) { va[j] = __builtin_nontemporal_load(ra + 64 * j); vb[j] = __builtin_nontemporal_load(rb + 64 * j); }
#pragma unroll
    for (int j = 0; j < 4; ++j) { sa += (va[j].x * va[j].x + va[j].y * va[j].y) + (va[j].z * va[j].z + va[j].w * va[j].w); sb += (vb[j].x * vb[j].x + vb[j].y * vb[j].y) + (vb[j].z * vb[j].z + vb[j].w * vb[j].w); }
#pragma unroll
    for (int o = 1; o < 64; o <<= 1) { sa += __shfl_xor(sa, o); sb += __shfl_xor(sb, o); }
    const float ia = rsqrtf(sa * (1.f / 1024.f) + 1e-6f), ib = rsqrtf(sb * (1.f / 1024.f) + 1e-6f);
    u32x2* pa = (u32x2*)oa + lane; u32x2* pb = (u32x2*)ob + lane;
#pragma unroll
    for (int j = 0; j < 4; ++j) { const f32x4 gg = gr[64 * j]; u32x2 w; w.x = pk2(va[j].x * ia * gg.x, va[j].y * ia * gg.y); w.y = pk2(va[j].z * ia * gg.z, va[j].w * ia * gg.w); pa[64 * j] = w;
        w.x = pk2(vb[j].x * ib * gg.x, vb[j].y * ib * gg.y); w.y = pk2(vb[j].z * ib * gg.z, vb[j].w * ib * gg.w); pb[64 * j] = w; }
}

__device__ __forceinline__ void s5_tables_item(const Ctx& cx, int g, int part, const float* lam_re, const float* lam_im, const float* log_dt, const float* b_re, const float* b_im, const float* c_re, const float* c_im,
                                               bf16* BT, bf16* ET, float* AT) {
    LAS float* apr = (LAS float*)cx.lds; LAS float* api = apr + 33 * 64; LAS float* bbr = api + 33 * 64; LAS float* bbi = bbr + 1024; LAS float* cr = bbi + 1024; LAS float* ci = cr + 1024; LAS float* kt = ci + 1024;
    const int tid = cx.tid;
    const float dt = __expf(log_dt[g]);
    for (int idx = tid; idx < 33 * 64; idx += NTHR) { const int j = idx >> 6, p = idx & 63;
        const float lre = fminf(lam_re[g * 64 + p], -1e-4f), lim = lam_im[g * 64 + p];
        const float mag = expf(lre * dt * (float)j), ang = lim * dt * (float)j; float sn, cs; sincosf(ang, &sn, &cs);
        apr[idx] = mag * cs; api[idx] = mag * sn; }
    for (int idx = tid; idx < 1024; idx += NTHR) { const int p = idx >> 4;
        const float lre = fminf(lam_re[g * 64 + p], -1e-4f), lim = lam_im[g * 64 + p];
        const float mag = expf(lre * dt); float sn, cs; sincosf(lim * dt, &sn, &cs); const float lbr = mag * cs, lbi = mag * sn;
        const float den = lre * lre + lim * lim, zr = lbr - 1.0f; const float cor = (zr * lre + lbi * lim) / den, coi = (lbi * lre - zr * lim) / den;
        const float br = b_re[g * 1024 + idx], bi = b_im[g * 1024 + idx];
        bbr[idx] = cor * br - coi * bi; bbi[idx] = cor * bi + coi * br;
        cr[idx] = c_re[g * 1024 + idx]; ci[idx] = c_im[g * 1024 + idx]; }
    __syncthreads();
    if (tid < 64) { const int jl = tid >> 4, c = tid & 15, j = 4 * part + jl; float acc[16];
#pragma unroll
        for (int i = 0; i < 16; ++i) acc[i] = 0.f;
        for (int p = 0; p < 64; ++p) { const float ar = apr[j * 64 + p], ai = api[j * 64 + p], xr = cr[c * 64 + p], xi = ci[c * 64 + p];
            const float car = xr * ar - xi * ai, cai = xr * ai + xi * ar;
#pragma unroll
            for (int v4 = 0; v4 < 4; ++v4) { const f32x4 br = *(const LAS f32x4*)(bbr + p * 16 + 4 * v4), bi = *(const LAS f32x4*)(bbi + p * 16 + 4 * v4);
                acc[4 * v4 + 0] += car * br.x - cai * bi.x; acc[4 * v4 + 1] += car * br.y - cai * bi.y; acc[4 * v4 + 2] += car * br.z - cai * bi.z; acc[4 * v4 + 3] += car * br.w - cai * bi.w; } }
#pragma unroll
        for (int i = 0; i < 16; ++i) kt[jl * 256 + c * 16 + i] = acc[i]; }
    __syncthreads();
    bf16* BTg = BT + (size_t)g * 512 * 640; bf16* ETg = ET + (size_t)g * 256 * 512;
    for (int idx = tid; idx < 4096; idx += NTHR) { const int hf = idx & 1, c = (idx >> 1) & 15, t = (idx >> 5) & 31, jl = idx >> 10, j = 4 * part + jl;
        if (t >= j) { const LAS float* s = kt + jl * 256 + c * 16 + hf * 8; u32x4 o; o.x = pk2(s[0], s[1]); o.y = pk2(s[2], s[3]); o.z = pk2(s[4], s[5]); o.w = pk2(s[6], s[7]);
            *(u32x4*)(BTg + (size_t)(t * 16 + c) * 640 + (t - j) * 16 + hf * 8) = o; } }
    for (int idx = tid; idx < 4096; idx += NTHR) { const int hf = idx & 1, c = (idx >> 1) & 15, s = (idx >> 5) & 31, t = 4 * part + (idx >> 10);
        if (s > t) *(u32x4*)(BTg + (size_t)(t * 16 + c) * 640 + s * 16 + hf * 8) = (u32x4){0u, 0u, 0u, 0u}; }
    for (int idx = tid; idx < 1024; idx += NTHR) { const int ch = idx & 15, c = (idx >> 4) & 15, t = 4 * part + (idx >> 8); const int im = ch >> 3, p0 = (ch & 7) * 8; float v[8];
#pragma unroll
        for (int q = 0; q < 8; ++q) { const int p = p0 + q; const float ar = apr[(t + 1) * 64 + p], ai = api[(t + 1) * 64 + p], xr = cr[c * 64 + p], xi = ci[c * 64 + p];
            v[q] = im ? -(xr * ai + xi * ar) : (xr * ar - xi * ai); }
        u32x4 o; o.x = pk2(v[0], v[1]); o.y = pk2(v[2], v[3]); o.z = pk2(v[4], v[5]); o.w = pk2(v[6], v[7]);
        *(u32x4*)(BTg + (size_t)(t * 16 + c) * 640 + 512 + im * 64 + p0) = o; }
    for (int idx = tid; idx < 1024; idx += NTHR) { const int hf = idx & 1, sl = (idx >> 1) & 3, n = idx >> 3, s = 4 * part + sl, p = n & 63, im = n >> 6; float v[8];
        const float ar = apr[(31 - s) * 64 + p], ai = api[(31 - s) * 64 + p];
#pragma unroll
        for (int q = 0; q < 8; ++q) { const float br = bbr[p * 16 + hf * 8 + q], bi = bbi[p * 16 + hf * 8 + q]; v[q] = im ? (ar * bi + ai * br) : (ar * br - ai * bi); }
        u32x4 o; o.x = pk2(v[0], v[1]); o.y = pk2(v[2], v[3]); o.z = pk2(v[4], v[5]); o.w = pk2(v[6], v[7]);
        *(u32x4*)(ETg + (size_t)n * 512 + s * 16 + hf * 8) = o; }
    for (int idx = tid; idx < 1024; idx += NTHR) { const int ch = idx & 63, r = 128 + 16 * part + (idx >> 6); *(u32x4*)(ETg + (size_t)r * 512 + ch * 8) = (u32x4){0u, 0u, 0u, 0u}; }
    if (part == 0 && tid < 64) { AT[(g * 64 + tid) * 2] = apr[32 * 64 + tid]; AT[(g * 64 + tid) * 2 + 1] = api[32 * 64 + tid]; }
    __syncthreads();
}

constexpr int IMG_LD = 80, IMG_B = 64 * IMG_LD * 2;
#define IMG(k) ((LAS bf16*)(lds + (k) * IMG_B))
#define LDS_BARRIER() do { asm volatile("s_waitcnt lgkmcnt(0)" ::: "memory"); __builtin_amdgcn_s_barrier(); asm volatile("" ::: "memory"); } while (0)
struct MmCtx { int tr, tc0, l15, q; };
__device__ __forceinline__ void mm64(const LAS bf16* A, const LAS bf16* Bt, f32x4 (&acc)[2], const MmCtx& w) {
#pragma unroll
    for (int s = 0; s < 2; ++s) {
        const bf16x8 a = *(const LAS bf16x8*)(A + (16 * w.tr + w.l15) * IMG_LD + 32 * s + 8 * w.q);
#pragma unroll
        for (int c = 0; c < 2; ++c) { const bf16x8 b = *(const LAS bf16x8*)(Bt + (16 * (w.tc0 + c) + w.l15) * IMG_LD + 32 * s + 8 * w.q);
            acc[c] = __builtin_amdgcn_mfma_f32_16x16x32_bf16(a, b, acc[c], 0, 0, 0); }
    }
}
__device__ __forceinline__ void mm64_2a(const LAS bf16* A1, const LAS bf16* A2, const LAS bf16* Bt, f32x4 (&acc1)[2], f32x4 (&acc2)[2], const MmCtx& w) {
#pragma unroll
    for (int s = 0; s < 2; ++s) {
        const bf16x8 a1 = *(const LAS bf16x8*)(A1 + (16 * w.tr + w.l15) * IMG_LD + 32 * s + 8 * w.q), a2 = *(const LAS bf16x8*)(A2 + (16 * w.tr + w.l15) * IMG_LD + 32 * s + 8 * w.q);
#pragma unroll
        for (int c = 0; c < 2; ++c) { const bf16x8 b = *(const LAS bf16x8*)(Bt + (16 * (w.tc0 + c) + w.l15) * IMG_LD + 32 * s + 8 * w.q);
            acc1[c] = __builtin_amdgcn_mfma_f32_16x16x32_bf16(a1, b, acc1[c], 0, 0, 0); acc2[c] = __builtin_amdgcn_mfma_f32_16x16x32_bf16(a2, b, acc2[c], 0, 0, 0); }
    }
}
__device__ __forceinline__ void mm64_2b(const LAS bf16* A, const LAS bf16* Bt1, const LAS bf16* Bt2, f32x4 (&acc1)[2], f32x4 (&acc2)[2], const MmCtx& w) {
#pragma unroll
    for (int s = 0; s < 2; ++s) {
        const bf16x8 a = *(const LAS bf16x8*)(A + (16 * w.tr + w.l15) * IMG_LD + 32 * s + 8 * w.q);
#pragma unroll
        for (int c = 0; c < 2; ++c) { const bf16x8 b1 = *(const LAS bf16x8*)(Bt1 + (16 * (w.tc0 + c) + w.l15) * IMG_LD + 32 * s + 8 * w.q), b2 = *(const LAS bf16x8*)(Bt2 + (16 * (w.tc0 + c) + w.l15) * IMG_LD + 32 * s + 8 * w.q);
            acc1[c] = __builtin_amdgcn_mfma_f32_16x16x32_bf16(a, b1, acc1[c], 0, 0, 0); acc2[c] = __builtin_amdgcn_mfma_f32_16x16x32_bf16(a, b2, acc2[c], 0, 0, 0); }
    }
}
__device__ __forceinline__ float dpp_x1(float v) { return __int_as_float(__builtin_amdgcn_update_dpp(0, __float_as_int(v), 0xB1, 0xF, 0xF, true)); }
__device__ __forceinline__ float dpp_x2(float v) { return __int_as_float(__builtin_amdgcn_update_dpp(0, __float_as_int(v), 0x4E, 0xF, 0xF, true)); }
__device__ __forceinline__ f32x4 quad_transpose(const f32x4 v, int b) {
    const bool odd = (b & 1) != 0, hi = (b & 2) != 0;
    const float r0 = dpp_x1(odd ? v[0] : v[1]), r1 = dpp_x1(odd ? v[2] : v[3]);
    const float p0a = odd ? r0 : v[0], p0b = odd ? v[1] : r0, p1a = odd ? r1 : v[2], p1b = odd ? v[3] : r1;
    const float ra = dpp_x2(hi ? p0a : p1a), rb = dpp_x2(hi ? p0b : p1b);
    return hi ? (f32x4){ra, rb, p1a, p1b} : (f32x4){p0a, p0b, ra, rb};
}
__device__ __forceinline__ void st_rm(LAS bf16* img, const f32x4 v, int tr, int tc, const MmCtx& w) {
    const unsigned p01 = pk2(v[0], v[1]), p23 = pk2(v[2], v[3]); LAS bf16* d = img + (16 * tr + 4 * w.q) * IMG_LD + 16 * tc + w.l15;
    d[0] = (bf16)p01; d[IMG_LD] = (bf16)(p01 >> 16); d[2 * IMG_LD] = (bf16)p23; d[3 * IMG_LD] = (bf16)(p23 >> 16);
}
__device__ __forceinline__ void st_tr(LAS bf16* img, const f32x4 v, int tr, int tc, const MmCtx& w) {
    u32x2 o; o.x = pk2(v[0], v[1]); o.y = pk2(v[2], v[3]); *(LAS u32x2*)(img + (16 * tc + w.l15) * IMG_LD + 16 * tr + 4 * w.q) = o;
}
__device__ __forceinline__ void img_to_global(const LAS bf16* img, bf16* g, int tid) { const int row = tid >> 3, ch = tid & 7; *(u32x4*)(g + row * 64 + ch * 8) = *(const LAS u32x4*)(img + row * IMG_LD + ch * 8); }
__device__ __forceinline__ void st_tm8(LAS bf16* img, int t, int cg, const float (&v)[8]) {
    u32x4 o; o.x = pk2(v[0], v[1]); o.y = pk2(v[2], v[3]); o.z = pk2(v[4], v[5]); o.w = pk2(v[6], v[7]); *(LAS u32x4*)(img + t * IMG_LD + 8 * cg) = o;
}
__device__ __forceinline__ void st_cm8(LAS bf16* img, int t, int cg, const float (&v)[8]) {
#pragma unroll
    for (int i = 0; i < 8; i += 2) { const unsigned p = pk2(v[i], v[i + 1]); img[(8 * cg + i) * IMG_LD + t] = (bf16)p; img[(8 * cg + i + 1) * IMG_LD + t] = (bf16)(p >> 16); }
}
__device__ __forceinline__ float red8(float v) { v += __shfl_xor(v, 1); v += __shfl_xor(v, 2); v += __shfl_xor(v, 4); return v; }
__device__ __forceinline__ void unpack8(const u32x4 w, float (&o)[8]) { o[0] = lo16(w.x); o[1] = hi16(w.x); o[2] = lo16(w.y); o[3] = hi16(w.y); o[4] = lo16(w.z); o[5] = hi16(w.z); o[6] = lo16(w.w); o[7] = hi16(w.w); }
__device__ __forceinline__ void ldp8(const float* p, float (&o)[8]) { const f32x4 a = *(const f32x4*)p, b = *(const f32x4*)(p + 4); o[0] = a.x; o[1] = a.y; o[2] = a.z; o[3] = a.w; o[4] = b.x; o[5] = b.y; o[6] = b.z; o[7] = b.w; }

struct RwkvP { const bf16* rkv; const bf16* wag; const float *mu_rkv, *w0, *a0, *k_k, *k_a, *r_k, *ln_w, *ln_b; };
struct RwkvRaw { u32x4 kc, kp, vc, vp, wl, al, rc, rp, gg; };
template <bool PASS3>
__device__ __forceinline__ void rwkv_load(const RwkvP& P, int cidx, int tid, RwkvRaw& R) {
    const int t = tid >> 3, cg = tid & 7, bh = cidx >> 7, c = cidx & 127, b = bh >> 3, h = bh & 7, ch = h * 64 + 8 * cg;
    const size_t tok = (size_t)b * SEQ + c * 64 + t; const bool first = (c == 0 && t == 0);
    const bf16* row = P.rkv + tok * 1536 + ch; const bf16* prow = first ? row : row - 1536;
    R.kc = *(const u32x4*)(row + 512); R.vc = *(const u32x4*)(row + 1024); R.kp = *(const u32x4*)(prow + 512); R.vp = *(const u32x4*)(prow + 1024);
    R.wl = *(const u32x4*)(P.wag + tok * 1536 + ch); R.al = *(const u32x4*)(P.wag + tok * 1536 + 512 + ch);
    if (PASS3) { R.rc = *(const u32x4*)row; R.rp = *(const u32x4*)prow; R.gg = *(const u32x4*)(P.wag + tok * 1536 + 1024 + ch); }
}
constexpr int RC_OFF = 14 * IMG_B;
struct RwkvC { const LAS float* p; };
__device__ __forceinline__ void ldl8(const LAS float* p, float (&o)[8]) { const f32x4 a = *(const LAS f32x4*)p, b = *(const LAS f32x4*)(p + 4); o[0] = a.x; o[1] = a.y; o[2] = a.z; o[3] = a.w; o[4] = b.x; o[5] = b.y; o[6] = b.z; o[7] = b.w; }
__device__ __forceinline__ void rwkv_consts(LAS unsigned char* lds, const RwkvP& P, int h, int tid, RwkvC& C) {
    LAS float* base = (LAS float*)(lds + RC_OFF);
    if (tid < 64) { const int cg = tid >> 3, k = tid & 7, ch = h * 64 + 8 * cg; const float* src = k == 0 ? P.mu_rkv + ch : k == 1 ? P.mu_rkv + 512 + ch : k == 2 ? P.mu_rkv + 1024 + ch : k == 3 ? P.w0 + ch : k == 4 ? P.a0 + ch : k == 5 ? P.k_k + ch : P.k_a + ch;
        if (k < 7) { const f32x4 a = *(const f32x4*)src, b = *(const f32x4*)(src + 4); *(LAS f32x4*)(base + cg * 64 + k * 8) = a; *(LAS f32x4*)(base + cg * 64 + k * 8 + 4) = b; } }
    LDS_BARRIER();
    C.p = base + (tid & 7) * 64;
}
template <bool PASS3>
__device__ __forceinline__ void rwkv_prep(const RwkvRaw& R, const RwkvC& C, bool first, float (&kq)[8], float (&vv)[8], float (&rr)[8], float (&kap)[8], float (&bet)[8], float (&lw)[8]) {
    float kc[8], kp[8], vc[8], vp[8], k[8], wl[8], al[8], a[8], m[8];
    unpack8(R.kc, kc); unpack8(R.vc, vc); unpack8(R.kp, kp); unpack8(R.vp, vp); unpack8(R.wl, wl); unpack8(R.al, al);
    const float pm = first ? 0.f : 1.f;
    ldl8(C.p + 8, m);
#pragma unroll
    for (int i = 0; i < 8; ++i) k[i] = kc[i] + (pm * kp[i] - kc[i]) * m[i];
    ldl8(C.p + 16, m);
#pragma unroll
    for (int i = 0; i < 8; ++i) vv[i] = vc[i] + (pm * vp[i] - vc[i]) * m[i];
    if (PASS3) { float rc[8], rp[8]; unpack8(R.rc, rc); unpack8(R.rp, rp); ldl8(C.p, m);
#pragma unroll
        for (int i = 0; i < 8; ++i) rr[i] = rc[i] + (pm * rp[i] - rc[i]) * m[i];
    } else {
#pragma unroll
        for (int i = 0; i < 8; ++i) rr[i] = 0.f;
    }
    float ss = 0.f;
    ldl8(C.p + 24, m);
#pragma unroll
    for (int i = 0; i < 8; ++i) lw[i] = -0.6065306597126334f * fsigmoid(m[i] + wl[i]);
    ldl8(C.p + 32, m);
#pragma unroll
    for (int i = 0; i < 8; ++i) a[i] = fsigmoid(m[i] + al[i]);
    ldl8(C.p + 40, m);
#pragma unroll
    for (int i = 0; i < 8; ++i) { kap[i] = k[i] * m[i]; ss += kap[i] * kap[i]; }
    ss = red8(ss);
    const float inv = 1.0f / fmaxf(sqrtf(ss), 1e-12f);
    ldl8(C.p + 48, m);
#pragma unroll
    for (int i = 0; i < 8; ++i) { kap[i] *= inv; bet[i] = kap[i] * a[i]; kq[i] = k[i] * (1.0f + (a[i] - 1.0f) * m[i]); }
}
template <int SEGSLOT>
__device__ __forceinline__ void rwkv_cumsum(LAS unsigned char* lds, int tid, const float (&lw)[8], float (&cum)[8], float (&cumL)[8]) {
    LAS float* SEG = (LAS float*)(lds + SEGSLOT * IMG_B);
    const int lane = tid & 63, wv = tid >> 6, cg = tid & 7, tl = lane >> 3;
#pragma unroll
    for (int i = 0; i < 8; ++i) { float v = lw[i];
        { const float u = __shfl_up(v, 8); v += (tl >= 1) ? u : 0.f; }
        { const float u = __shfl_up(v, 16); v += (tl >= 2) ? u : 0.f; }
        { const float u = __shfl_up(v, 32); v += (tl >= 4) ? u : 0.f; }
        cum[i] = v; }
    if (tl == 7) {
#pragma unroll
        for (int i = 0; i < 8; ++i) SEG[wv * 64 + 8 * cg + i] = cum[i]; }
    LDS_BARRIER();
    float pre[8], tot[8];
#pragma unroll
    for (int i = 0; i < 8; ++i) { pre[i] = 0.f; tot[i] = 0.f; }
#pragma unroll 1
    for (int s2 = 0; s2 < 8; ++s2) { const f32x4 a = *(const LAS f32x4*)(SEG + s2 * 64 + 8 * cg), b = *(const LAS f32x4*)(SEG + s2 * 64 + 8 * cg + 4); const float m = (s2 < wv) ? 1.f : 0.f;
        tot[0] += a.x; tot[1] += a.y; tot[2] += a.z; tot[3] += a.w; tot[4] += b.x; tot[5] += b.y; tot[6] += b.z; tot[7] += b.w;
        pre[0] += m * a.x; pre[1] += m * a.y; pre[2] += m * a.z; pre[3] += m * a.w; pre[4] += m * b.x; pre[5] += m * b.y; pre[6] += m * b.z; pre[7] += m * b.w; }
#pragma unroll
    for (int i = 0; i < 8; ++i) { cum[i] += pre[i]; cumL[i] = tot[i]; }
}
#define Z4 (f32x4){0.f, 0.f, 0.f, 0.f}

__device__ __forceinline__ void rwkv_pass1(LAS unsigned char* lds, const RwkvP& P, int c0, int n, int tid, bf16* QCT, float* HCT, bf16* M1G, bf16* YLG, float* DLG, float* BONUS) {
    const int lane = tid & 63, wv = __builtin_amdgcn_readfirstlane(tid >> 6); MmCtx w; w.tr = wv >> 1; w.tc0 = (wv & 1) * 2; w.l15 = lane & 15; w.q = lane >> 4;
    const int t = tid >> 3, cg = tid & 7, ch = ((c0 >> 7) & 7) * 64 + 8 * cg;
    RwkvC C; rwkv_consts(lds, P, (c0 >> 7) & 7, tid, C);
    RwkvRaw R; rwkv_load<true>(P, c0, tid, R);
    for (int ci = 0; ci < n; ++ci) {
        const int cidx = c0 + ci;
        {
            float kq[8], vv[8], rr[8], kap[8], bet[8], lw[8], cum[8], cumL[8];
            rwkv_prep<true>(R, C, (cidx & 127) == 0 && t == 0, kq, vv, rr, kap, bet, lw);
            rwkv_cumsum<10>(lds, tid, lw, cum, cumL);
            { float bs = 0.f, rk[8]; ldp8(P.r_k + ch, rk);
#pragma unroll
              for (int i = 0; i < 8; ++i) bs += rr[i] * kq[i] * rk[i];
              bs = red8(bs); if (cg == 0) BONUS[(size_t)cidx * 64 + t] = bs; }
            float x[8], y[8];
#pragma unroll
            for (int i = 0; i < 8; ++i) { const float en = __expf(-cum[i]); x[i] = kq[i] * en; y[i] = bet[i] * en; }
            st_tm8(IMG(0), t, cg, x);
            st_tm8(IMG(1), t, cg, y);
#pragma unroll
            for (int i = 0; i < 8; ++i) x[i] = kap[i] * __expf(cum[i] - lw[i]);
            st_tm8(IMG(2), t, cg, x);
            st_cm8(IMG(3), t, cg, x);
#pragma unroll
            for (int i = 0; i < 8; ++i) x[i] = rr[i] * __expf(cum[i]);
            st_tm8(IMG(11), t, cg, x);
#pragma unroll
            for (int i = 0; i < 8; ++i) { const float eh = __expf(cumL[i] - cum[i]); x[i] = kq[i] * eh; y[i] = bet[i] * eh; }
            st_cm8(IMG(4), t, cg, x);
            st_cm8(IMG(5), t, cg, y);
            st_cm8(IMG(6), t, cg, vv);
            if (t == 0) {
#pragma unroll
                for (int i = 0; i < 8; ++i) DLG[(size_t)cidx * 64 + 8 * cg + i] = __expf(cumL[i]);
            }
        }
        if (ci + 1 < n) rwkv_load<true>(P, cidx + 1, tid, R);
        LDS_BARRIER();
        f32x4 accX[2];
        {
            f32x4 a[2] = {Z4, Z4}, kk[2] = {Z4, Z4};
            mm64_2a(IMG(1), IMG(0), IMG(2), a, kk, w);
#pragma unroll
            for (int c = 0; c < 2; ++c) { const int nn = 16 * (w.tc0 + c) + w.l15;
#pragma unroll
                for (int r = 0; r < 4; ++r) { const int m = 16 * w.tr + 4 * w.q + r; a[c][r] = (m < nn) ? a[c][r] : 0.f; kk[c][r] = (m < nn) ? kk[c][r] : 0.f; accX[c][r] = ((m == nn) ? 1.0f : 0.f) - a[c][r]; }
                st_rm(IMG(7), a[c], w.tr, w.tc0 + c, w); st_tr(IMG(8), a[c], w.tr, w.tc0 + c, w); st_rm(IMG(10), accX[c], w.tr, w.tc0 + c, w); st_rm(IMG(9), kk[c], w.tr, w.tc0 + c, w); }
        }
        LDS_BARRIER();
        {
            f32x4 p[2] = {Z4, Z4};
            mm64(IMG(7), IMG(8), p, w);
#pragma unroll
            for (int c = 0; c < 2; ++c) { st_rm(IMG(12), p[c], w.tr, w.tc0 + c, w); st_tr(IMG(13), p[c], w.tr, w.tc0 + c, w); }
        }
        LDS_BARRIER();
#define NEUMANN(XC, XN, PC, PTC, PN, PTN, LASTR) do { if (LASTR) { mm64(IMG(XC), IMG(PTC), accX, w); _Pragma("unroll") for (int c = 0; c < 2; ++c) st_tr(IMG(7), accX[c], w.tr, w.tc0 + c, w); }   \
            if (!(LASTR)) { f32x4 p[2] = {Z4, Z4}; mm64_2a(IMG(XC), IMG(PC), IMG(PTC), accX, p, w); \
                _Pragma("unroll") for (int c = 0; c < 2; ++c) { st_rm(IMG(PN), p[c], w.tr, w.tc0 + c, w); st_tr(IMG(PTN), p[c], w.tr, w.tc0 + c, w); st_rm(IMG(XN), accX[c], w.tr, w.tc0 + c, w); } } \
            LDS_BARRIER(); } while (0)
        NEUMANN(10, 2, 12, 13, 7, 8, false);
        NEUMANN(2, 10, 7, 8, 12, 13, false);
        NEUMANN(10, 2, 12, 13, 7, 8, false);
        NEUMANN(2, 10, 7, 8, 12, 13, false);
        NEUMANN(10, 2, 12, 13, 7, 8, true);
#undef NEUMANN
        {
            f32x4 a[2] = {Z4, Z4}, g[2] = {Z4, Z4}, kr[2] = {Z4, Z4}, br[2] = {Z4, Z4};
            mm64_2a(IMG(3), IMG(9), IMG(7), a, g, w); mm64_2b(IMG(11), IMG(0), IMG(1), kr, br, w);
#pragma unroll
            for (int c = 0; c < 2; ++c) { const int nn = 16 * (w.tc0 + c) + w.l15;
#pragma unroll
                for (int r = 0; r < 4; ++r) { const int m = 16 * w.tr + 4 * w.q + r; kr[c][r] = (nn <= m) ? kr[c][r] : 0.f; br[c][r] = (nn <= m) ? br[c][r] : 0.f; }
                st_rm(IMG(12), a[c], w.tr, w.tc0 + c, w); st_tr(IMG(8), g[c], w.tr, w.tc0 + c, w); st_rm(IMG(2), kr[c], w.tr, w.tc0 + c, w); st_rm(IMG(10), br[c], w.tr, w.tc0 + c, w); }
        }
        LDS_BARRIER();
        {
            f32x4 u[2] = {Z4, Z4}, qc[2] = {Z4, Z4}, m1[2] = {Z4, Z4};
            mm64(IMG(6), IMG(8), u, w); mm64(IMG(5), IMG(12), qc, w); mm64(IMG(10), IMG(12), m1, w);
#pragma unroll
            for (int c = 0; c < 2; ++c) { st_rm(IMG(13), u[c], w.tr, w.tc0 + c, w);
                const int tc = w.tc0 + c, cp = 32 * (tc >> 1) + 8 * (w.l15 >> 2) + 4 * (tc & 1) + (w.l15 & 3);
                const unsigned p01 = pk2(qc[c][0], qc[c][1]), p23 = pk2(qc[c][2], qc[c][3]); LAS bf16* d = IMG(0) + (16 * w.tr + 4 * w.q) * IMG_LD + cp;
                d[0] = (bf16)p01; d[IMG_LD] = (bf16)(p01 >> 16); d[2 * IMG_LD] = (bf16)p23; d[3 * IMG_LD] = (bf16)(p23 >> 16);
                f32x4 mv;
#pragma unroll
                for (int r = 0; r < 4; ++r) mv[r] = bf2f(IMG(11)[(16 * w.tr + 4 * w.q + r) * IMG_LD + 16 * tc + w.l15]) - m1[c][r];
                st_rm(IMG(1), mv, w.tr, tc, w); }
        }
        LDS_BARRIER();
        {
            f32x4 hp[2] = {Z4, Z4}, hn[2] = {Z4, Z4}, yp[2] = {Z4, Z4}, yn[2] = {Z4, Z4};
            mm64(IMG(4), IMG(6), hp, w); mm64(IMG(5), IMG(13), hn, w); mm64(IMG(2), IMG(6), yp, w); mm64(IMG(10), IMG(13), yn, w);
#pragma unroll
            for (int c = 0; c < 2; ++c) { *(f32x4*)(HCT + (((size_t)cidx * 16 + w.tr * 4 + w.tc0 + c) * 64 + lane) * 4) = hp[c] - hn[c]; st_rm(IMG(3), yp[c] - yn[c], w.tr, w.tc0 + c, w); }
            img_to_global(IMG(1), M1G + (size_t)cidx * 4096, tid);
            img_to_global(IMG(0), QCT + (size_t)cidx * 4096, tid);
        }
        LDS_BARRIER();
        img_to_global(IMG(3), YLG + (size_t)cidx * 4096, tid);
    }
}

constexpr int P2_SLOT = 12544, P2_DEPTH = 11;
__device__ __forceinline__ void rwkv_pass2(LAS unsigned char* lds, int bh, int ti, int wave, int lane, const bf16* QCT, const float* HCT, const float* DLG, bf16* S0G) {
    const int l15 = lane & 15, q = lane >> 4;
    f32x4 X[4];
#pragma unroll
    for (int tj = 0; tj < 4; ++tj) X[tj] = Z4;
#define P2_DMA(cc) do { const size_t ci_ = (size_t)bh * 128 + (cc); LAS unsigned char* sl_ = lds + ((cc) % P2_DEPTH) * P2_SLOT; \
        if (wave >= 1 && wave <= 4) { _Pragma("unroll") for (int k_ = 0; k_ < 2; ++k_) { const int i = 2 * (wave - 1) + k_, row_ = i * 8 + (lane >> 3), pc_ = (lane & 7) ^ (row_ & 7); \
            __builtin_amdgcn_global_load_lds((const unsigned*)((const char*)QCT + (ci_ * 64 + row_) * 128 + pc_ * 16), (LAS unsigned*)(sl_ + i * 1024), 16, 0, 0); } } \
        else if (wave == 5 || wave == 6) { _Pragma("unroll") for (int k_ = 0; k_ < 2; ++k_) { const int tj = 2 * (wave - 5) + k_; \
            __builtin_amdgcn_global_load_lds((const unsigned*)((const char*)HCT + ((ci_ * 16 + tj * 4 + ti) * 64 + lane) * 16), (LAS unsigned*)(sl_ + 8192 + tj * 1024), 16, 0, 0); } } \
        else if (wave == 7) __builtin_amdgcn_global_load_lds((const unsigned*)((const char*)DLG + (ci_ * 64 + lane) * 4), (LAS unsigned*)(sl_ + 12288), 4, 0, 0); } while (0)
    for (int cc = 0; cc < P2_DEPTH - 1; ++cc) P2_DMA(cc);
    for (int c = 0; c < 128; ++c) {
        if (c + P2_DEPTH - 2 <= 127) { if (wave == 7) asm volatile("s_waitcnt vmcnt(%0)" :: "n"(P2_DEPTH - 2) : "memory"); else if (wave >= 1) asm volatile("s_waitcnt vmcnt(%0)" :: "n"(2 * (P2_DEPTH - 2)) : "memory"); }
        else if (wave >= 1) asm volatile("s_waitcnt vmcnt(0)" ::: "memory");
        __builtin_amdgcn_s_barrier();
        if (c + P2_DEPTH - 1 < 128) P2_DMA(c + P2_DEPTH - 1);
        if (wave == 0) {
            const LAS unsigned char* sl = lds + (c % P2_DEPTH) * P2_SLOT;
            bf16x8 a[4][2]; f32x4 h[4], d[4];
#pragma unroll
            for (int tj = 0; tj < 4; ++tj) { const int row = 16 * tj + l15;
#pragma unroll
                for (int s = 0; s < 2; ++s) a[tj][s] = *(const LAS bf16x8*)(sl + row * 128 + (((4 * s + q) ^ (row & 7)) * 16));
                h[tj] = *(const LAS f32x4*)(sl + 8192 + tj * 1024 + lane * 16); d[tj] = *(const LAS f32x4*)(sl + 12288 + (16 * tj + 4 * q) * 4); }
            const size_t cidx = (size_t)bh * 128 + c;
#pragma unroll
            for (int tj = 0; tj < 4; ++tj) { u32x2 o; o.x = pk2(X[tj][0], X[tj][1]); o.y = pk2(X[tj][2], X[tj][3]); *(u32x2*)(S0G + (cidx * 64 + 16 * ti + l15) * 64 + 16 * tj + 4 * q) = o; }
            bf16x8 b[2];
#pragma unroll
            for (int s = 0; s < 2; ++s) { u32x4 o; o.x = pk2(X[2 * s][0], X[2 * s][1]); o.y = pk2(X[2 * s][2], X[2 * s][3]); o.z = pk2(X[2 * s + 1][0], X[2 * s + 1][1]); o.w = pk2(X[2 * s + 1][2], X[2 * s + 1][3]); b[s] = __builtin_bit_cast(bf16x8, o); }
            asm volatile("s_waitcnt lgkmcnt(0)" ::: "memory");
#pragma unroll
            for (int tj = 0; tj < 4; ++tj) { f32x4 acc = Z4;
                acc = __builtin_amdgcn_mfma_f32_16x16x32_bf16(a[tj][0], b[0], acc, 0, 0, 0); acc = __builtin_amdgcn_mfma_f32_16x16x32_bf16(a[tj][1], b[1], acc, 0, 0, 0);
                X[tj] = d[tj] * X[tj] + h[tj] - acc; }
        }
    }
    asm volatile("s_waitcnt vmcnt(0)" ::: "memory");
#undef P2_DMA
}

__device__ __forceinline__ void rwkv_pass3(LAS unsigned char* lds, const RwkvP& P, int c0, int n, int tid, const bf16* S0G, const bf16* M1G, const bf16* YLG, const float* BONUS, bf16* MIX) {
    const int lane = tid & 63, wv = __builtin_amdgcn_readfirstlane(tid >> 6); MmCtx w; w.tr = wv >> 1; w.tc0 = (wv & 1) * 2; w.l15 = lane & 15; w.q = lane >> 4;
    const int t = tid >> 3, cg = tid & 7, bh = c0 >> 7, b = bh >> 3, h = bh & 7, ch = h * 64 + 8 * cg;
    float muv[8], lnw[8], lnb[8]; ldp8(P.mu_rkv + 1024 + ch, muv); ldp8(P.ln_w + ch, lnw); ldp8(P.ln_b + ch, lnb);
    u32x4 gS0, gM1, gYL, gvc, gvp, ggg; float gbo;
#define P3_LOAD(cc) do { const int cidx_ = (cc), c_ = cidx_ & 127; const size_t o_ = (size_t)cidx_ * 4096 + (tid >> 3) * 64 + (tid & 7) * 8; gS0 = *(const u32x4*)(S0G + o_); gM1 = *(const u32x4*)(M1G + o_); gYL = *(const u32x4*)(YLG + o_); \
        const size_t tok_ = (size_t)b * SEQ + c_ * 64 + t; const bool first_ = (c_ == 0 && t == 0); const bf16* row_ = P.rkv + tok_ * 1536 + 1024 + ch; \
        gvc = *(const u32x4*)row_; gvp = *(const u32x4*)(first_ ? row_ : row_ - 1536); ggg = *(const u32x4*)(P.wag + tok_ * 1536 + 1024 + ch); gbo = BONUS[(size_t)cidx_ * 64 + t]; } while (0)
    P3_LOAD(c0);
    for (int ci = 0; ci < n; ++ci) {
        const int cidx = c0 + ci, c = cidx & 127;
        float vv[8], gg[8]; const float bonus = gbo;
        { float vc[8], vp[8]; unpack8(gvc, vc); unpack8(gvp, vp); unpack8(ggg, gg); const float pm = (c == 0 && t == 0) ? 0.f : 1.f;
#pragma unroll
          for (int i = 0; i < 8; ++i) vv[i] = vc[i] + (pm * vp[i] - vc[i]) * muv[i];
          const int row = tid >> 3, chk = tid & 7; *(LAS u32x4*)(IMG(0) + row * IMG_LD + chk * 8) = gM1; *(LAS u32x4*)(IMG(1) + row * IMG_LD + chk * 8) = gS0; *(LAS u32x4*)(IMG(2) + row * IMG_LD + chk * 8) = gYL; }
        if (ci + 1 < n) P3_LOAD(cidx + 1);
        LDS_BARRIER();
        {
            f32x4 y[2] = {Z4, Z4};
            mm64(IMG(0), IMG(1), y, w);
            LAS float* YF = (LAS float*)(lds + 10 * IMG_B);
#pragma unroll
            for (int cc = 0; cc < 2; ++cc)
#pragma unroll
                for (int r = 0; r < 4; ++r) { const int m = 16 * w.tr + 4 * w.q + r, nn = 16 * (w.tc0 + cc) + w.l15; YF[m * 65 + nn] = y[cc][r] + bf2f(IMG(2)[m * IMG_LD + nn]); }
        }
        LDS_BARRIER();
        {
            const LAS float* YF = (const LAS float*)(lds + 10 * IMG_B);
            float y[8], s = 0.f;
#pragma unroll
            for (int i = 0; i < 8; ++i) { y[i] = YF[t * 65 + 8 * cg + i]; s += y[i]; }
            const float mean = red8(s) * (1.0f / 64.0f); float qv = 0.f;
#pragma unroll
            for (int i = 0; i < 8; ++i) { y[i] -= mean; qv += y[i] * y[i]; }
            const float rstd = rsqrtf(red8(qv) * (1.0f / 64.0f) + 64e-5f);
            float o[8];
#pragma unroll
            for (int i = 0; i < 8; ++i) o[i] = (y[i] * rstd * lnw[i] + lnb[i] + bonus * vv[i]) * gg[i];
            const size_t tok = (size_t)b * SEQ + c * 64 + t;
            u32x4 ov; ov.x = pk2(o[0], o[1]); ov.y = pk2(o[2], o[3]); ov.z = pk2(o[4], o[5]); ov.w = pk2(o[6], o[7]);
            *(u32x4*)(MIX + tok * 1024 + 512 + ch) = ov;
        }
        LDS_BARRIER();
    }
#undef P3_LOAD
}

constexpr int RW_LD = 1032;
__device__ __forceinline__ void router_phase(const Ctx& cx, const bf16* X1, const float* gnorm, const float* rw, const float* rb, unsigned char* H2, int* TOPE, float* TOPG, unsigned* HIST) {
    LAS bf16* WH = (LAS bf16*)cx.lds; LAS bf16* WL = WH + 32 * RW_LD;
    LAS unsigned* hcnt = (LAS unsigned*)(cx.lds + 135168);
    const int lane = cx.lane, l15 = lane & 15, q = lane >> 4;
    for (int idx = cx.tid; idx < 32768; idx += NTHR) { const int col = idx >> 5, e = idx & 31; const float v = rw[idx] * gnorm[col];
        const unsigned h = cvt_pk_bf16(v, 0.f) & 0xffffu; const float lo = v - bf2f(h); WH[e * RW_LD + col] = (bf16)h; WL[e * RW_LD + col] = (bf16)(cvt_pk_bf16(lo, 0.f) & 0xffffu); }
    const float b0 = rb[l15], b1 = rb[l15 + 16];
    for (int tb = cx.wg; tb < 256; tb += cx.G) {
        if (cx.tid < 32) hcnt[cx.tid] = 0u;
        __syncthreads();
        const int tok0 = tb * 128 + cx.wave * 16;
        const bf16* xrow = X1 + (size_t)(tok0 + l15) * 1024 + 8 * q;
        f32x4 acc[2] = {(f32x4){0.f, 0.f, 0.f, 0.f}, (f32x4){0.f, 0.f, 0.f, 0.f}}; float ss = 0.f;
#pragma unroll 8
        for (int s = 0; s < 32; ++s) {
            const u32x4 xw = *(const u32x4*)(xrow + 32 * s);
            { const float a0 = lo16(xw.x), a1 = hi16(xw.x), a2 = lo16(xw.y), a3 = hi16(xw.y), a4 = lo16(xw.z), a5 = hi16(xw.z), a6 = lo16(xw.w), a7 = hi16(xw.w);
              ss += (a0 * a0 + a1 * a1) + (a2 * a2 + a3 * a3) + (a4 * a4 + a5 * a5) + (a6 * a6 + a7 * a7); }
            const bf16x8 ah = __builtin_bit_cast(bf16x8, xw);
#pragma unroll
            for (int n = 0; n < 2; ++n) { const bf16x8 bh = *(const LAS bf16x8*)(WH + (l15 + 16 * n) * RW_LD + 32 * s + 8 * q), bl = *(const LAS bf16x8*)(WL + (l15 + 16 * n) * RW_LD + 32 * s + 8 * q);
                acc[n] = __builtin_amdgcn_mfma_f32_16x16x32_bf16(ah, bh, acc[n], 0, 0, 0); acc[n] = __builtin_amdgcn_mfma_f32_16x16x32_bf16(ah, bl, acc[n], 0, 0, 0); }
        }
        ss += __shfl_xor(ss, 16); ss += __shfl_xor(ss, 32);
        const float rinv_l = rsqrtf(ss * (1.f / 1024.f) + 1e-6f);
#pragma unroll
        for (int r = 0; r < 4; ++r) {
            const float ri = __shfl(rinv_l, 4 * q + r);
            float v0 = acc[0][r] * ri + b0, v1 = acc[1][r] * ri + b1; int se[4]; float sv[4];
#pragma unroll
            for (int k = 0; k < 4; ++k) { float bv = (v1 > v0) ? v1 : v0; int be = (v1 > v0) ? (l15 + 16) : l15;
#pragma unroll
                for (int off = 1; off < 16; off <<= 1) { const float ov = __shfl_xor(bv, off); const int oe = __shfl_xor(be, off); const bool take = (ov > bv) || (ov == bv && oe < be); bv = take ? ov : bv; be = take ? oe : be; }
                se[k] = be; sv[k] = bv; if (be == l15) v0 = -INFINITY; if (be == l15 + 16) v1 = -INFINITY; }
            if (l15 == r) { const int tok = tok0 + 4 * q + r;
                const float w1 = __expf(sv[1] - sv[0]), w2 = __expf(sv[2] - sv[0]), w3 = __expf(sv[3] - sv[0]); const float inv = 1.0f / (1.0f + w1 + w2 + w3);
                *(int4*)(TOPE + (size_t)tok * 4) = make_int4(se[0], se[1], se[2], se[3]);
                *(float4*)(TOPG + (size_t)tok * 4) = make_float4(inv, w1 * inv, w2 * inv, w3 * inv);
                atomicAdd((unsigned*)(hcnt + se[0]), 1u); atomicAdd((unsigned*)(hcnt + se[1]), 1u); atomicAdd((unsigned*)(hcnt + se[2]), 1u); atomicAdd((unsigned*)(hcnt + se[3]), 1u); }
        }
        const f32x4* gr = (const f32x4*)gnorm + lane;
#pragma unroll 4
        for (int i = 0; i < 16; ++i) { const float ri = __shfl(rinv_l, i); const u32x2* xr = (const u32x2*)(X1 + (size_t)(tok0 + i) * 1024) + lane; unsigned* o4 = (unsigned*)(H2 + (size_t)(tok0 + i) * 1024) + lane;
#pragma unroll
            for (int j = 0; j < 4; ++j) { const u32x2 v = xr[64 * j]; const f32x4 gg = gr[64 * j]; o4[64 * j] = pk4_fp8(lo16(v.x) * ri * gg.x, hi16(v.x) * ri * gg.y, lo16(v.y) * ri * gg.z, hi16(v.y) * ri * gg.w); } }
        __syncthreads();
        if (cx.tid < 32) HIST[tb * 32 + cx.tid] = hcnt[cx.tid];
        __syncthreads();
    }
}

constexpr int PL_BASE = 1280, PL_WCNT = 1312;
__device__ __forceinline__ void moe_plan(const Ctx& cx, const unsigned* HIST) {
    LAS int* PL = (LAS int*)(cx.lds + LDS_PLAN);
    const int e = cx.tid & 31, part = cx.tid >> 5;
    { int s = 0; for (int w = 16 * part; w < 16 * part + 16; ++w) s += (int)HIST[w * 32 + e]; PL[PL_TMP + part * 32 + e] = s; }
    __syncthreads();
    if (cx.tid < 32) { int c = 0; for (int p = 0; p < 16; ++p) c += PL[PL_TMP + p * 32 + cx.tid]; PL[PL_CNT + cx.tid] = c; }
    __syncthreads();
    if (cx.tid == 0) {
        int ps = 0;
        for (int x = 0; x < 32; ++x) { PL[PL_PSTART + x] = ps; const int pad = (PL[PL_CNT + x] + 255) & ~255; for (int i = 0; i < pad / 256; ++i) PL[PL_TILEE + ps / 256 + i] = x; ps += pad; }
        PL[PL_PSTART + 32] = ps;
        int np = 0, e0 = 0;
        while (e0 < 32 && np < 7) { PL[PL_PE0 + np] = e0; PL[PL_PROW0 + np] = PL[PL_PSTART + e0]; int rows = 0, e1 = e0;
            while (e1 < 32 && e1 - e0 < MAXEPP) { const int pad = PL[PL_PSTART + e1 + 1] - PL[PL_PSTART + e1]; if (rows + pad > RMAX && e1 > e0) break; rows += pad; ++e1; }
            e0 = e1; ++np; }
        PL[PL_PE0 + np] = 32; PL[PL_PROW0 + np] = ps; PL[PL_NPASS] = np;
    }
    __syncthreads();
}
__device__ __forceinline__ void dispatch_phase(const Ctx& cx, const unsigned* HIST, const int* TOPE, int* SLOTTOK, int* TOKSLOT) {
    LAS int* PL = (LAS int*)(cx.lds + LDS_PLAN);
    const int e5 = cx.tid & 31, part = cx.tid >> 5, lane = cx.lane;
    for (int tb = cx.wg; tb < 256; tb += cx.G) {
        { int s = 0; for (int w = 16 * part; w < 16 * part + 16; ++w) s += (w < tb) ? (int)HIST[w * 32 + e5] : 0; PL[PL_TMP + part * 32 + e5] = s; }
        const int tok = tb * 128 + (cx.tid >> 2), k = cx.tid & 3; const int e = TOPE[(size_t)tok * 4 + k];
        int rank = 0;
        for (int ee = 0; ee < 32; ++ee) { const unsigned long long mask = __ballot(e == ee); if (e == ee) rank = __popcll(mask & ((1ull << lane) - 1ull)); if (lane == 0) PL[PL_WCNT + cx.wave * 32 + ee] = __popcll(mask); }
        __syncthreads();
        if (cx.tid < 32) { int c = 0; for (int p = 0; p < 16; ++p) c += PL[PL_TMP + p * 32 + cx.tid]; PL[PL_BASE + cx.tid] = c; }
        __syncthreads();
        int off = 0; for (int w2 = 0; w2 < 8; ++w2) off += (w2 < cx.wave) ? PL[PL_WCNT + w2 * 32 + e] : 0;
        const int slot = PL[PL_PSTART + e] + PL[PL_BASE + e] + off + rank;
        SLOTTOK[slot] = tok; TOKSLOT[(size_t)tok * 4 + k] = slot;
        __syncthreads();
    }
    for (int e = cx.wg; e < 32; e += cx.G) { const int c = PL[PL_CNT + e], ps = PL[PL_PSTART + e], pe = PL[PL_PSTART + e + 1]; for (int r = ps + c + cx.tid; r < pe; r += NTHR) SLOTTOK[r] = 0; }
}
template <int MODE>
__device__ __forceinline__ void convert_pass(const Ctx& cx, int e0, int e1, const float* wg, const float* wu, const float* wd, unsigned char* WGU, unsigned char* WDN) {
    LAS float* scr = (LAS float*)(cx.lds + cx.wave * 16640);
    constexpr int PER = MODE == 0 ? 768 : (MODE == 1 ? 512 : 256), ROFF = MODE == 2 ? 512 : 0;
    const int nitems = (e1 - e0) * PER;
#define CV_R(it_) ((it_) % PER + ROFF)
#define CV_SRC(it_) ((CV_R(it_) >> 8) == 2 ? wd : ((CV_R(it_) >> 8) ? wu : wg)) + (size_t)(e0 + (it_) / PER) * 1048576
    int it = cx.gw; if (it >= nitems) return;
    F8Item cur; f8_issue(CV_SRC(it), 1024, 128 * ((CV_R(it) & 255) >> 5), 32 * (CV_R(it) & 31), cx.lane, cur);
    for (;;) {
        const int nx = it + cx.NGW; const bool has = nx < nitems;
        F8Item nxt;
        if (has) f8_issue(CV_SRC(nx), 1024, 128 * ((CV_R(nx) & 255) >> 5), 32 * (CV_R(nx) & 31), cx.lane, nxt);
        const int le = it / PER, r = CV_R(it), mat = r >> 8, kb = (r & 255) >> 5, nb = r & 31, n0 = 32 * nb;
        if (mat == 2) f8_finish(cur, WDN + (size_t)le * 1048576 + (size_t)n0 * 1024 + 128 * kb, 1024, 32.0f, scr, cx.lane);
        else { const int drow = (n0 >> 7) * 256 + (n0 & 127) + mat * 128; f8_finish(cur, WGU + (size_t)le * 2097152 + (size_t)drow * 1024 + 128 * kb, 1024, 32.0f, scr, cx.lane); }
        if (!has) break;
        it = nx;
#pragma unroll
        for (int i = 0; i < 16; ++i) cur.v[i] = nxt.v[i];
    }
#undef CV_SRC
#undef CV_R
}
__device__ __forceinline__ void combine_all(const Ctx& cx, const float* TOPG, const int* TOKSLOT, const unsigned char* Y, bf16* X, const float* gnorm, unsigned char* H3) {
    const int lane = cx.lane, step = cx.NGW;
    int tok = cx.gw; if (tok >= M) return;
    int4 sl = *(const int4*)(TOKSLOT + (size_t)tok * 4); float4 gs = *(const float4*)(TOPG + (size_t)tok * 4);
    u32x2 xw[4]; unsigned yw[4][4];
#define CMB_ISSUE(T, SL, XW, YW) do { const u32x2* xr_ = (const u32x2*)(X + (size_t)(T) * 1024) + lane; const int s_[4] = {SL.x, SL.y, SL.z, SL.w}; \
        _Pragma("unroll") for (int j = 0; j < 4; ++j) XW[j] = xr_[64 * j]; \
        _Pragma("unroll") for (int k = 0; k < 4; ++k) { const unsigned* yr_ = (const unsigned*)(Y + (size_t)s_[k] * 1024) + lane; _Pragma("unroll") for (int j = 0; j < 4; ++j) YW[k][j] = yr_[64 * j]; } } while (0)
    CMB_ISSUE(tok, sl, xw, yw);
    int4 sl1 = sl; float4 gs1 = gs; { const int t1 = tok + step; if (t1 < M) { sl1 = *(const int4*)(TOKSLOT + (size_t)t1 * 4); gs1 = *(const float4*)(TOPG + (size_t)t1 * 4); } }
    const f32x4* gr = (const f32x4*)gnorm + lane;
    for (;;) {
        const int t1 = tok + step, t2 = tok + 2 * step; const bool has1 = t1 < M;
        u32x2 nxw[4]; unsigned nyw[4][4];
        if (has1) CMB_ISSUE(t1, sl1, nxw, nyw);
        int4 sl2 = sl1; float4 gs2 = gs1; if (t2 < M) { sl2 = *(const int4*)(TOKSLOT + (size_t)t2 * 4); gs2 = *(const float4*)(TOPG + (size_t)t2 * 4); }
        f32x4 v[4]; const float gk[4] = {gs.x, gs.y, gs.z, gs.w};
#pragma unroll
        for (int j = 0; j < 4; ++j) v[j] = (f32x4){lo16(xw[j].x), hi16(xw[j].x), lo16(xw[j].y), hi16(xw[j].y)};
#pragma unroll
        for (int k = 0; k < 4; ++k)
#pragma unroll
            for (int j = 0; j < 4; ++j) v[j] += up4_fp8(yw[k][j]) * gk[k];
        u32x2* xo = (u32x2*)(X + (size_t)tok * 1024) + lane; float s = 0.f;
#pragma unroll
        for (int j = 0; j < 4; ++j) { u32x2 w; w.x = pk2(v[j].x, v[j].y); w.y = pk2(v[j].z, v[j].w); xo[64 * j] = w; s += (v[j].x * v[j].x + v[j].y * v[j].y) + (v[j].z * v[j].z + v[j].w * v[j].w); }
        const float rinv = rsqrtf(wave_sum(s) * (1.f / 1024.f) + 1e-6f); unsigned* o8 = (unsigned*)(H3 + (size_t)tok * 1024) + lane;
#pragma unroll
        for (int j = 0; j < 4; ++j) { const f32x4 gq = gr[64 * j]; o8[64 * j] = pk4_fp8(v[j].x * rinv * gq.x, v[j].y * rinv * gq.y, v[j].z * rinv * gq.z, v[j].w * rinv * gq.w); }
        if (!has1) break;
        tok = t1; gs = gs1; sl1 = sl2; gs1 = gs2;
#pragma unroll
        for (int j = 0; j < 4; ++j) { xw[j] = nxw[j];
#pragma unroll
            for (int k = 0; k < 4; ++k) yw[k][j] = nyw[k][j]; }
    }
#undef CMB_ISSUE
}
template <bool LAST>
__device__ __forceinline__ void combine_pass(const Ctx& cx, int e0, int e1, int row0, const int* TOPE, const float* TOPG, const int* TOKSLOT, const unsigned char* Y, bf16* X, const float* gnorm, unsigned char* H3) {
    for (int tok = cx.gw; tok < M; tok += cx.NGW) {
        const int4 es = *(const int4*)(TOPE + (size_t)tok * 4); const float4 gs = *(const float4*)(TOPG + (size_t)tok * 4); const int4 sl = *(const int4*)(TOKSLOT + (size_t)tok * 4);
        const int ee[4] = {es.x, es.y, es.z, es.w}; const float gg[4] = {gs.x, gs.y, gs.z, gs.w}; const int ss[4] = {sl.x, sl.y, sl.z, sl.w};
        bool any = false;
#pragma unroll
        for (int k = 0; k < 4; ++k) any |= (ee[k] >= e0 && ee[k] < e1);
        if (!LAST && !any) continue;
        u32x2* xr = (u32x2*)(X + (size_t)tok * 1024) + cx.lane; f32x4 v[4];
#pragma unroll
        for (int j = 0; j < 4; ++j) { const u32x2 w = xr[64 * j]; v[j] = (f32x4){lo16(w.x), hi16(w.x), lo16(w.y), hi16(w.y)}; }
#pragma unroll
        for (int k = 0; k < 4; ++k) if (ee[k] >= e0 && ee[k] < e1) { const unsigned* yr = (const unsigned*)(Y + (size_t)(ss[k] - row0) * 1024) + cx.lane; const float g = gg[k];
#pragma unroll
            for (int j = 0; j < 4; ++j) v[j] += up4_fp8(yr[64 * j]) * g; }
        if (any) {
#pragma unroll
            for (int j = 0; j < 4; ++j) { u32x2 w; w.x = pk2(v[j].x, v[j].y); w.y = pk2(v[j].z, v[j].w); xr[64 * j] = w; }
        }
        if (LAST) { float s = 0.f;
#pragma unroll
            for (int j = 0; j < 4; ++j) s += (v[j].x * v[j].x + v[j].y * v[j].y) + (v[j].z * v[j].z + v[j].w * v[j].w);
            const float rinv = rsqrtf(wave_sum(s) * (1.f / 1024.f) + 1e-6f); const f32x4* gr = (const f32x4*)gnorm + cx.lane; unsigned* o8 = (unsigned*)(H3 + (size_t)tok * 1024) + cx.lane;
#pragma unroll
            for (int j = 0; j < 4; ++j) { const f32x4 gq = gr[64 * j]; o8[64 * j] = pk4_fp8(v[j].x * rinv * gq.x, v[j].y * rinv * gq.y, v[j].z * rinv * gq.z, v[j].w * rinv * gq.w); } }
    }
}

#define HBUF ((bf16*)(ws + WS_R1))
#define RKV ((bf16*)(ws + WS_RKV))
#define WAG ((bf16*)(ws + WS_WAG))
#define AG ((bf16*)(ws + WS_AG))
#define UB ((bf16*)(ws + WS_U))
#define LP ((bf16*)(ws + WS_LP))
#define LACT ((bf16*)(ws + WS_LACT))
#define Y1 ((bf16*)(ws + WS_Y1))
#define MIX ((bf16*)(ws + WS_R1))
#define EBUF ((float*)(ws + WS_LP))
#define S0G ((bf16*)(ws + WS_LP))
#define QCT ((bf16*)(ws + WS_U))
#define HCT ((float*)(ws + WS_R1))
#define W1G ((bf16*)(ws + WS_W1))
#define ULG ((bf16*)(ws + WS_ULOC))
#define DLG ((float*)(ws + WS_DL))
#define ATG ((float*)(ws + WS_AT))
#define WCAT ((bf16*)(ws + WS_WCAT))
#define WL2 ((bf16*)(ws + WS_WL2))
#define WGLU ((bf16*)(ws + WS_WGLU))
#define WPP ((bf16*)(ws + WS_WPP))
#define WOUT ((bf16*)(ws + WS_WOUT))
#define WPG ((unsigned char*)(ws + WS_WPG))
#define S5BT ((bf16*)(ws + WS_S5BT))
#define S5ET ((bf16*)(ws + WS_S5ET))
#define PBF ((bf16*)(ws + WS_PBF))
#define H2 ((unsigned char*)(ws + WS_H2))
#ifndef CONV_EARLY
#define CONV_EARLY 1
#endif
#if CONV_EARLY
#define WGU ((unsigned char*)OUTP)
#define WDN ((unsigned char*)OUTP + 64 * MiB)
#else
#define WGU ((unsigned char*)(ws + WS_WGU))
#define WDN ((unsigned char*)(ws + WS_WDN))
#endif
#define ACT ((unsigned char*)(ws + WS_ACT))
#define YB ((unsigned char*)(ws + WS_Y))
#define XB ((bf16*)(ws + WS_XB))
#define PP ((bf16*)(ws + WS_ACT))
#define HIST ((unsigned*)(ws + WS_HIST))
#define TOPE ((int*)(ws + WS_TOPE))
#define TOPG ((float*)(ws + WS_TOPG))
#define TOKSLOT ((int*)(ws + WS_TOKSLOT))
#define SLOTTOK ((int*)(ws + WS_SLOTTOK))
#ifndef FUSE_FNORM
#define FUSE_FNORM 1
#endif
#ifndef SPLIT_P5
#define SPLIT_P5 1
#endif
#ifndef MOE_SP2
#define MOE_SP2 true
#endif
#ifndef MOE_ALIGN
#define MOE_ALIGN true
#endif
#ifndef PROBE_SKIP
#define PROBE_SKIP 0
#endif
#ifndef PROBE_PH
#define PROBE_PH -1
#endif
#ifndef PROBE_N
#define PROBE_N 2
#endif
#define REPS(k) ((((k) >= 10 && (k) < 28) ? 10 + ((k) - 10) % 3 : (k)) == PROBE_PH ? PROBE_N : 1)
#ifndef ONLY_PHASE
#define ONLY_PHASE -1
#endif
constexpr int NPH = 31;
struct Args { const float* in[42]; float* out; unsigned char* ws; int ph_lo, ph_hi; };

__global__ void __launch_bounds__(NTHR, 2) mk_fwd(Args args) {
    extern __shared__ __attribute__((aligned(16))) unsigned char lds_raw[];
    LAS unsigned char* lds = (LAS unsigned char*)lds_raw;
#define CAS __attribute__((address_space(4)))
#define FRESH_CX const CAS char* ka_ = (const CAS char*)__builtin_amdgcn_kernarg_segment_ptr(); asm volatile("" : "+s"(ka_)); const float* const CAS* I = (const float* const CAS*)ka_; unsigned char* ws = *(unsigned char* const CAS*)(ka_ + 344); float* OUTP = *(float* const CAS*)(ka_ + 336); (void)I; (void)ws; (void)OUTP; \
    Ctx cx; { int t_; asm volatile("v_mbcnt_lo_u32_b32 %0, -1, 0\n\tv_mbcnt_hi_u32_b32 %0, -1, %0" : "=v"(t_)); t_ += wv0_ * 64;      cx.lds = lds; cx.tid = t_; cx.lane = t_ & 63; cx.wave = __builtin_amdgcn_readfirstlane(t_ >> 6); cx.G = gridDim.x; cx.wg = blockIdx.x; cx.gw = cx.wg * NWAVES + cx.wave; cx.NGW = cx.G * NWAVES; }
    unsigned char* ws = args.ws;
    const int lo = args.ph_lo, hi = args.ph_hi;
    volatile LAS unsigned* MISC = (volatile LAS unsigned*)(lds + LDS_MISC);
    const int wv0_ = __builtin_amdgcn_readfirstlane((int)threadIdx.x >> 6);
    if (wv0_ == 0) MISC[__builtin_amdgcn_mbcnt_hi(~0u, __builtin_amdgcn_mbcnt_lo(~0u, 0u))] = 0u;
    __syncthreads();
    XcdBarrier bar; bar.bar = (unsigned*)(ws + WS_CTL) + CW_BAR; bar.x = 0; bar.st = nullptr; bar.wv = wv0_;
    if (hi - lo > 1) bar = xcd_barrier_post((unsigned*)(ws + WS_CTL) + CW_BAR, MISC + 8, wv0_);

#define IN(k) ((ONLY_PHASE < 0 || ONLY_PHASE == (k) || (ONLY_PHASE >= 10 && ONLY_PHASE < 28 && (k) >= 10 && (k) < 28 && ((k) - 10) % 3 == (ONLY_PHASE - 10) % 3)) && lo <= (k) && (k) < hi)
#ifndef PROBE_BAR
#define PROBE_BAR 1
#endif
#ifndef PROBE_T
#define PROBE_T -1
#endif
#define STAMP() do { if (PROBE_T >= 0 && blockIdx.x == 0 && xb_first(wv0_)) { const unsigned long long t_ = __builtin_amdgcn_s_memrealtime(); MISC[16 + 2 * nst] = (unsigned)t_; MISC[17 + 2 * nst] = (unsigned)(t_ >> 32); } ++nst; } while (0)
#define SEAM(k) do { if (IN(k) && IN((k) + 1)) { for (int b_ = 0; b_ < PROBE_BAR; ++b_) xcd_barrier(bar); STAMP(); } } while (0)
    int nst = 0; STAMP();
#define MAKE_RP RwkvP RP; RP.rkv = RKV; RP.wag = WAG; RP.mu_rkv = I[13]; RP.w0 = I[15]; RP.a0 = I[18]; RP.k_k = I[23]; RP.k_a = I[24]; RP.r_k = I[25]; RP.ln_w = I[26]; RP.ln_b = I[27]
#define OPQ(v) ({ int _k = (v); asm volatile("" : "+s"(_k)); _k; })

    if (IN(0)) for (int rep_ = 0; rep_ < REPS(0); ++rep_) {
        FRESH_CX;
        for (int it = cx.wg; it < 256; it += cx.G) s5_tables_item(cx, it >> 3, it & 7, I[4], I[5], I[6], I[7], I[8], I[9], I[10], S5BT, S5ET, ATG);
        const float* mu = I[14];
        transpose_matrix(cx, I[3], 1024, 2048, WCAT, 0, 1024, 0, nullptr, 0);
        transpose_matrix(cx, I[16], 1024, 64, WCAT, 2048, 1024, 0, mu, 1);          transpose_matrix(cx, I[16], 1024, 64, WCAT, 2304, 1024, 0, mu, 0);
        transpose_matrix(cx, I[19], 1024, 64, WCAT, 2112, 1024, 0, mu + 1024, 1);   transpose_matrix(cx, I[19], 1024, 64, WCAT, 2368, 1024, 0, mu + 1024, 0);
        transpose_matrix(cx, I[21], 1024, 128, WCAT, 2176, 1024, 0, mu + 2048, 1);  transpose_matrix(cx, I[21], 1024, 128, WCAT, 2432, 1024, 0, mu + 2048, 0);
        transpose_matrix(cx, I[17], 64, 512, WL2, 0, 256, 0, nullptr, 0);
        transpose_matrix(cx, I[20], 64, 512, WL2, 512, 256, 64, nullptr, 0);
        transpose_matrix(cx, I[22], 128, 512, WL2, 1024, 256, 128, nullptr, 0);
        for (int idx = cx.wg * NTHR + cx.tid; idx < 1536 * 32; idx += cx.G * NTHR) { const int row = idx >> 5, ch = idx & 31, blk = row >> 9; const int kb = blk == 0 ? 0 : (blk == 1 ? 64 : 128), ke = blk == 0 ? 64 : (blk == 1 ? 128 : 256);
            if (ch * 8 < kb || ch * 8 >= ke) *(u32x4*)(WL2 + (size_t)row * 256 + ch * 8) = (u32x4){0u, 0u, 0u, 0u}; }
        transpose_matrix(cx, I[12], 512, 512, WGLU, 0, 512, 0, nullptr, 0);
        transpose_matrix(cx, I[39], 256, 1024, WPP, 0, 256, 0, nullptr, 0);
        transpose_matrix(cx, I[28], 1024, 1024, WOUT, 0, 1024, 0, nullptr, 0);
        { LAS float* scr = (LAS float*)(cx.lds + cx.wave * 16640);
          for (int it = cx.gw; it < 256; it += cx.NGW) { const int kb = it >> 5, nb = it & 31;
              transpose_item_fp8(I[40], 1024, 128 * kb, 32 * nb, WPG + (size_t)(32 * nb) * 1024 + 128 * kb, 1024, 32.0f, scr, cx.lane); } }
        for (int m = 2 * cx.gw; m < M; m += 2 * cx.NGW) rms_rows2_to_bf16(I[0] + (size_t)m * 1024, I[0] + (size_t)(m + 1) * 1024, I[2], HBUF + (size_t)m * 1024, HBUF + (size_t)(m + 1) * 1024, cx.lane);
        for (int m = 4 * cx.gw; m < M; m += 4 * cx.NGW) { f32x4 v[4];
#pragma unroll
            for (int r = 0; r < 4; ++r) v[r] = __builtin_nontemporal_load((const f32x4*)(I[1] + (size_t)(m + r) * 256) + cx.lane);
#pragma unroll
            for (int r = 0; r < 4; ++r) { u32x2 w; w.x = pk2(v[r].x, v[r].y); w.y = pk2(v[r].z, v[r].w); *((u32x2*)(PBF + (size_t)(m + r) * 256) + cx.lane) = w; } }
    }
    SEAM(0);
    if (IN(1)) for (int rep_ = 0; rep_ < REPS(1); ++rep_) {
        FRESH_CX;
        SchedPlain S; S.init(128, 10, cx.G, cx.wg); S.A = (const char*)HBUF; S.B = (const char*)WCAT; S.a_tile = 256 * 1024 * 2; S.b_tile = 256 * 1024 * 2;
        EpiProj E{AG, RKV, LP};
#if CONV_EARLY
        const int kins = (cx.wg >> 3) % 6;
        S.i0 = 0; S.i1 = kins;
        pg8::gemm_phase<EpiProj, SchedPlain, true, true, false>(lds, cx.tid, OPQ(1024), OPQ(1024), OPQ(1024), S, E);
        if (rep_ == 0) { FRESH_CX;
#ifdef PROBE_CONV1
            for (int q_ = 0; q_ < PROBE_CONV1; ++q_) { convert_pass<1>(cx, 0, 32, I[32], I[34], I[36], WGU, WDN); __syncthreads(); }
#endif
            convert_pass<1>(cx, 0, 32, I[32], I[34], I[36], WGU, WDN); __syncthreads(); }
        { FRESH_CX;
          SchedPlain S; S.init(128, 10, cx.G, cx.wg); S.A = (const char*)HBUF; S.B = (const char*)WCAT; S.a_tile = 256 * 1024 * 2; S.b_tile = 256 * 1024 * 2; S.i0 = (cx.wg >> 3) % 6;
          EpiProj E{AG, RKV, LP};
          pg8::gemm_phase<EpiProj, SchedPlain, true, true, false>(lds, cx.tid, OPQ(1024), OPQ(1024), OPQ(1024), S, E); }
#else
        pg8::gemm_phase<EpiProj, SchedPlain, true, true, false>(lds, cx.tid, OPQ(1024), OPQ(1024), OPQ(1024), S, E);
#endif
    }
    SEAM(1);
    if (IN(2)) for (int rep_ = 0; rep_ < REPS(2); ++rep_) {
        FRESH_CX;
        for (int m = 2 * cx.gw; m < M; m += 2 * cx.NGW) {
            const int lane = cx.lane; const bool first = (m & (SEQ - 1)) == 0;
            const u32x2 a0 = *((const u32x2*)(LP + (size_t)m * 512) + lane), a1 = *((const u32x2*)(LP + (size_t)(m + 1) * 512) + lane), b1 = *((const u32x2*)(LP + (size_t)m * 512 + 256) + lane);
            u32x2 b0 = (u32x2){0u, 0u}; if (!first) b0 = *((const u32x2*)(LP + (size_t)(m - 1) * 512 + 256) + lane);
            float v[8] = {lo16(a0.x) + lo16(b0.x), hi16(a0.x) + hi16(b0.x), lo16(a0.y) + lo16(b0.y), hi16(a0.y) + hi16(b0.y), lo16(a1.x) + lo16(b1.x), hi16(a1.x) + hi16(b1.x), lo16(a1.y) + lo16(b1.y), hi16(a1.y) + hi16(b1.y)};
#pragma unroll
            for (int i = 0; i < 8; ++i) v[i] = lane < 16 ? ftanh(v[i]) : (lane < 32 ? v[i] : fsigmoid(v[i]));
            u32x2 o; o.x = pk2(v[0], v[1]); o.y = pk2(v[2], v[3]); *((u32x2*)(LACT + (size_t)m * 256) + lane) = o;
            o.x = pk2(v[4], v[5]); o.y = pk2(v[6], v[7]); *((u32x2*)(LACT + (size_t)(m + 1) * 256) + lane) = o;
        }
    }
    SEAM(2);
    if (IN(3)) for (int rep_ = 0; rep_ < REPS(3); ++rep_) {
        FRESH_CX;
        { SchedPlain S; S.init(128, 6, cx.G, cx.wg); S.A = (const char*)LACT; S.B = (const char*)WL2; S.a_tile = 256 * 256 * 2; S.b_tile = 256 * 256 * 2;
          EpiBf16Plain E{WAG, 1536};
          pg8::gemm_phase<EpiBf16Plain, SchedPlain, true, true, false>(lds, cx.tid, OPQ(256), OPQ(256), OPQ(256), S, E); }
        { SchedS5 S; S.init(128, 1, cx.G, cx.wg); S.A = (const char*)AG; S.B = (const char*)S5ET; S.a_tile = 256 * 640 * 2; S.b_tile = 0; S.b_group = 256 * 512 * 2;
          EpiF32 E{EBUF, 256};
          pg8::gemm_phase<EpiF32, SchedS5, true, true, false>(lds, cx.tid, OPQ(512), OPQ(640), OPQ(512), S, E); }
    }
    SEAM(3);
    if (IN(4)) for (int rep_ = 0; rep_ < REPS(4); ++rep_) {
        FRESH_CX;
        for (int base = cx.wg * 32; base < 8192; base += cx.G * 32) { const int idx = base + (cx.lane & 31), b = idx >> 11, g = (idx >> 6) & 31, p = idx & 63, w8 = cx.wave;
            LAS float* CE = (LAS float*)lds;
            const float ar = ATG[(g * 64 + p) * 2], ai = ATG[(g * 64 + p) * 2 + 1];
            const size_t row0 = (size_t)g * 1024 + b * 256 + 32 * w8;
            float er[32], ei[32];
            if (cx.lane < 32) {
#pragma unroll
                for (int k = 0; k < 32; ++k) { er[k] = EBUF[(row0 + k) * 256 + p]; ei[k] = EBUF[(row0 + k) * 256 + 64 + p]; }
                float sr = 0.f, si = 0.f;
#pragma unroll
                for (int k = 0; k < 32; ++k) { const float nr = ar * sr - ai * si + er[k], ni = ar * si + ai * sr + ei[k]; sr = nr; si = ni; }
                CE[(w8 * 32 + cx.lane) * 2] = sr; CE[(w8 * 32 + cx.lane) * 2 + 1] = si; }
            __syncthreads();
            if (cx.lane < 32) {
                float pr = 1.f, pi = 0.f;
                { float qr = ar, qi = ai;
#pragma unroll
                  for (int i = 0; i < 5; ++i) { const float tr_ = qr * qr - qi * qi, ti_ = 2.f * qr * qi; qr = tr_; qi = ti_; } pr = qr; pi = qi; }
                float cr = 0.f, ci = 0.f;
                for (int w2 = 0; w2 < w8; ++w2) { const float e0 = CE[(w2 * 32 + cx.lane) * 2], e1 = CE[(w2 * 32 + cx.lane) * 2 + 1]; const float nr = pr * cr - pi * ci + e0, ni = pr * ci + pi * cr + e1; cr = nr; ci = ni; }
                float sr = cr, si = ci;
#pragma unroll
                for (int k = 0; k < 32; ++k) { bf16* d = AG + (row0 + k) * 640 + 512 + p; d[0] = (bf16)(pk2(sr, 0.f) & 0xffffu); d[64] = (bf16)(pk2(si, 0.f) & 0xffffu);
                    const float nr = ar * sr - ai * si + er[k], ni = ar * si + ai * sr + ei[k]; sr = nr; si = ni; } }
            __syncthreads();
        }
        MAKE_RP;
        for (int grp = cx.wg; grp < 256; grp += cx.G) rwkv_pass1(lds, RP, grp * 16, 16, cx.tid, QCT, HCT, W1G, ULG, DLG, (float*)(ws + WS_TOKSLOT));
    }
    SEAM(4);
    if (IN(5)) for (int rep_ = 0; rep_ < REPS(5); ++rep_) {
        FRESH_CX;
        if (SPLIT_P5 && cx.G == 256) {
            if (cx.wg < 128) { const int x_ = cx.wg & 7, j_ = cx.wg >> 3; if (!(PROBE_SKIP == 1 && hi < NPH)) rwkv_pass2(lds, x_ + 8 * (j_ >> 2), j_ & 3, cx.wave, cx.lane, QCT, HCT, DLG, S0G); }
            else if (!(PROBE_SKIP == 2 && hi < NPH)) { SchedS5 S; S.init(128, 2, 128, cx.wg - 128); S.A = (const char*)AG; S.B = (const char*)S5BT; S.a_tile = 256 * 640 * 2; S.b_tile = 256 * 640 * 2; S.b_group = 512 * 640 * 2;
                EpiS5Y E{AG, I[11], Y1};
                pg8::gemm_phase<EpiS5Y, SchedS5, true, true, false>(lds, cx.tid, OPQ(640), OPQ(640), OPQ(640), S, E); }
        } else {
            { SchedS5 S; S.init(128, 2, cx.G, cx.wg); S.A = (const char*)AG; S.B = (const char*)S5BT; S.a_tile = 256 * 640 * 2; S.b_tile = 256 * 640 * 2; S.b_group = 512 * 640 * 2;
              EpiS5Y E{AG, I[11], Y1};
              pg8::gemm_phase<EpiS5Y, SchedS5, true, true, false>(lds, cx.tid, OPQ(640), OPQ(640), OPQ(640), S, E); }
            for (int it = cx.wg; it < 128; it += cx.G) { __syncthreads(); rwkv_pass2(lds, it >> 2, it & 3, cx.wave, cx.lane, QCT, HCT, DLG, S0G); }
        }
    }
    SEAM(5);
    if (IN(6)) for (int rep_ = 0; rep_ < REPS(6); ++rep_) {
        FRESH_CX;
        MAKE_RP;
        for (int grp = cx.wg; grp < 256; grp += cx.G) rwkv_pass3(lds, RP, grp * 16, 16, cx.tid, S0G, W1G, ULG, (const float*)(ws + WS_TOKSLOT), MIX);
        __syncthreads();
        { SchedPlain S; S.init(128, 2, cx.G, cx.wg); S.A = (const char*)Y1; S.B = (const char*)WGLU; S.a_tile = 256 * 512 * 2; S.b_tile = 256 * 512 * 2;
          EpiGlu E{Y1, MIX};
          pg8::gemm_phase<EpiGlu, SchedPlain, true, true, false>(lds, cx.tid, OPQ(512), OPQ(512), OPQ(512), S, E); }
    }
    SEAM(6);
    if (IN(7)) for (int rep_ = 0; rep_ < REPS(7); ++rep_) {
        FRESH_CX;
        SchedPlain S; S.init(128, 4, cx.G, cx.wg); S.A = (const char*)MIX; S.B = (const char*)WOUT; S.a_tile = 256 * 1024 * 2; S.b_tile = 256 * 1024 * 2;
#ifdef STAG7
        if ((cx.wg >> 3) & 1) for (int q_ = 0; q_ < STAG7; ++q_) __builtin_amdgcn_s_sleep(127);
#endif
        EpiResid E{I[0], XB};
        pg8::gemm_phase<EpiResid, SchedPlain, true, true, false>(lds, cx.tid, OPQ(1024), OPQ(1024), OPQ(1024), S, E);
    }
    SEAM(7);
    if (IN(8)) for (int rep_ = 0; rep_ < REPS(8); ++rep_) { FRESH_CX; router_phase(cx, XB, I[29], I[30], I[31], H2, TOPE, TOPG, HIST); }
    SEAM(8);
    LAS int* PL = (LAS int*)(lds + LDS_PLAN);
    if (hi > 9 && lo < 28) { FRESH_CX; __syncthreads(); moe_plan(cx, HIST); }
    const int npass = (hi > 9 && lo < 28) ? PL[PL_NPASS] : 0;
    if (IN(9)) for (int rep_ = 0; rep_ < REPS(9); ++rep_) { FRESH_CX; dispatch_phase(cx, HIST, TOPE, SLOTTOK, TOKSLOT);
#if !CONV_EARLY
        convert_pass<0>(cx, PL[PL_PE0], PL[PL_PE0 + 1], I[32], I[34], I[36], WGU, WDN);
#endif
    }
    SEAM(9);
    for (int p = 0; p < 6; ++p) {
        const bool actv = p < npass;
        const int e0 = actv ? PL[PL_PE0 + p] : 0, e1 = actv ? PL[PL_PE0 + p + 1] : 0, row0 = actv ? PL[PL_PROW0 + p] : 0, rows = actv ? PL[PL_PROW0 + p + 1] - row0 : 0;
        if (IN(10 + 3 * p) && actv) for (int rep_ = 0; rep_ < REPS(10); ++rep_) {
            FRESH_CX;
            SchedMoe<true> S; S.init(rows / 256, 8, cx.G, cx.wg); S.A = (const char*)H2; S.B = (const char*)WGU; S.a_tile = 0; S.b_tile = 256 * 1024; S.b_exp = (size_t)2048 * 1024; S.tile_e = PL + PL_TILEE; S.tile0 = row0 / 256; S.e0 = e0; S.slot_tok = SLOTTOK; S.row0 = row0;
#ifdef PROBE_EPI10
            if (rep_ + 1 < REPS(10)) { PROBE_EPI10 E0 PROBE_EPI10_INIT; pg8::gemm_phase<PROBE_EPI10, SchedMoe<true>, MOE_ALIGN, MOE_SP2, true, true>(lds, cx.tid, OPQ(512), OPQ(512), OPQ(512), S, E0); continue; }
#endif
            EpiGU E{ACT, I[33], I[35]};
#if CONV_EARLY
            S.e0 = 0;
            const int kins = (cx.wg >> 3) % 16;
            S.i0 = 0; S.i1 = kins;
            pg8::gemm_phase<EpiGU, SchedMoe<true>, MOE_ALIGN, MOE_SP2, true, true>(lds, cx.tid, OPQ(512), OPQ(512), OPQ(512), S, E);
            if (rep_ == 0 && p == 0) { FRESH_CX;
#ifdef PROBE_CONV10
                for (int q_ = 0; q_ < PROBE_CONV10; ++q_) { convert_pass<2>(cx, 0, 32, I[32], I[34], I[36], WGU, WDN); __syncthreads(); }
#endif
                convert_pass<2>(cx, 0, 32, I[32], I[34], I[36], WGU, WDN); __syncthreads(); }
            { FRESH_CX;
              SchedMoe<true> S; S.init(rows / 256, 8, cx.G, cx.wg); S.A = (const char*)H2; S.B = (const char*)WGU; S.a_tile = 0; S.b_tile = 256 * 1024; S.b_exp = (size_t)2048 * 1024; S.tile_e = PL + PL_TILEE; S.tile0 = row0 / 256; S.e0 = 0; S.slot_tok = SLOTTOK; S.row0 = row0;
              S.i0 = (cx.wg >> 3) % 16;
              EpiGU E{ACT, I[33], I[35]};
              pg8::gemm_phase<EpiGU, SchedMoe<true>, MOE_ALIGN, MOE_SP2, true, true>(lds, cx.tid, OPQ(512), OPQ(512), OPQ(512), S, E); }
#else
            pg8::gemm_phase<EpiGU, SchedMoe<true>, MOE_ALIGN, MOE_SP2, true, true>(lds, cx.tid, OPQ(512), OPQ(512), OPQ(512), S, E);
#endif
        }
        if (actv) SEAM(10 + 3 * p);
        if (IN(11 + 3 * p) && actv) for (int rep_ = 0; rep_ < REPS(11); ++rep_) {
            FRESH_CX;
            SchedMoe<false> S; S.init(rows / 256, 4, cx.G, cx.wg); S.A = (const char*)ACT; S.B = (const char*)WDN; S.a_tile = 256 * 1024; S.b_tile = 256 * 1024; S.b_exp = (size_t)1024 * 1024; S.tile_e = PL + PL_TILEE; S.tile0 = row0 / 256; S.e0 = e0; S.slot_tok = SLOTTOK; S.row0 = row0;
#ifdef PROBE_NULLEPI
            if (rep_ + 1 < REPS(11)) { PROBE_EPIX E0{YB, I[37]}; pg8::gemm_phase<PROBE_EPIX, SchedMoe<false>, MOE_ALIGN, MOE_SP2, false, true>(lds, cx.tid, OPQ(512), OPQ(512), OPQ(512), S, E0); continue; }
#endif
#ifdef STAG11
            if (rep_ == 0) { const int ns_ = ((cx.wg >> 3) & 3) * STAG11; for (int q_ = 0; q_ < ns_; ++q_) __builtin_amdgcn_s_sleep(127); }
#endif
            EpiDown E{YB, I[37]};
#if CONV_EARLY
            S.e0 = 0;
#endif
            pg8::gemm_phase<EpiDown, SchedMoe<false>, MOE_ALIGN, MOE_SP2, false, true>(lds, cx.tid, OPQ(512), OPQ(512), OPQ(512), S, E);
        }
        if (actv) SEAM(11 + 3 * p);
        if (IN(12 + 3 * p) && actv) for (int rep_ = 0; rep_ < REPS(12); ++rep_) {
            FRESH_CX;
            if (p + 1 < npass) { combine_pass<false>(cx, e0, e1, row0, TOPE, TOPG, TOKSLOT, YB, XB, nullptr, nullptr);
#if !CONV_EARLY
                convert_pass<0>(cx, PL[PL_PE0 + p + 1], PL[PL_PE0 + p + 2], I[32], I[34], I[36], WGU, WDN);
#endif
            }
            else {
                if (e0 == 0 && e1 == 32 && row0 == 0) combine_all(cx, TOPG, TOKSLOT, YB, XB, I[38], (unsigned char*)(ws + WS_R1));
                else combine_pass<true>(cx, e0, e1, row0, TOPE, TOPG, TOKSLOT, YB, XB, I[38], (unsigned char*)(ws + WS_R1));
                SchedPlain S; S.init(128, 4, cx.G, cx.wg); S.A = (const char*)PBF; S.B = (const char*)WPP; S.a_tile = 256 * 256 * 2; S.b_tile = 256 * 256 * 2;
                EpiBf16Plain E{PP, 1024};
                pg8::gemm_phase<EpiBf16Plain, SchedPlain, true, true, false>(lds, cx.tid, OPQ(256), OPQ(256), OPQ(256), S, E);
            }
        }
        if (actv) SEAM(12 + 3 * p);
    }
    if (IN(29)) for (int rep_ = 0; rep_ < REPS(29); ++rep_) {
        FRESH_CX;
        SchedPlain S; S.init(128, 4, cx.G, cx.wg); S.A = (const char*)(ws + WS_R1); S.B = (const char*)WPG; S.a_tile = 256 * 1024; S.b_tile = 256 * 1024;
        if (FUSE_FNORM && cx.G == 256) { EpiPleNorm E{PP, XB, OUTP, I[41], (float*)(ws + WS_CTL) + CW_ROWSS, (unsigned*)(ws + WS_CTL) + CW_PCNT};
            pg8::gemm_phase<EpiPleNorm, SchedPlain, true, true, false, true>(lds, cx.tid, OPQ(512), OPQ(512), OPQ(512), S, E); }
        else { EpiPle E{PP, XB};
            pg8::gemm_phase<EpiPle, SchedPlain, true, true, false, true>(lds, cx.tid, OPQ(512), OPQ(512), OPQ(512), S, E); }
    }
    SEAM(29);
    if (IN(30) && !(FUSE_FNORM && gridDim.x == 256)) for (int rep_ = 0; rep_ < REPS(30); ++rep_) {
        FRESH_CX;
        for (int m = 2 * cx.gw; m < M; m += 2 * cx.NGW) {
            const u32x2* ia_ = (const u32x2*)(XB + (size_t)m * 1024) + cx.lane; const u32x2* ib_ = ia_ + 256;
            f32x4* xa = (f32x4*)(OUTP + (size_t)m * 1024) + cx.lane; f32x4* xb = xa + 256; const f32x4* gr = (const f32x4*)I[41] + cx.lane; f32x4 va[4], vb[4]; float sa = 0.f, sb = 0.f;
#pragma unroll
            for (int j = 0; j < 4; ++j) { const u32x2 wa = ia_[64 * j], wb = ib_[64 * j]; va[j] = (f32x4){lo16(wa.x), hi16(wa.x), lo16(wa.y), hi16(wa.y)}; vb[j] = (f32x4){lo16(wb.x), hi16(wb.x), lo16(wb.y), hi16(wb.y)}; }
#pragma unroll
            for (int j = 0; j < 4; ++j) { sa += (va[j].x * va[j].x + va[j].y * va[j].y) + (va[j].z * va[j].z + va[j].w * va[j].w); sb += (vb[j].x * vb[j].x + vb[j].y * vb[j].y) + (vb[j].z * vb[j].z + vb[j].w * vb[j].w); }
#pragma unroll
            for (int o = 1; o < 64; o <<= 1) { sa += __shfl_xor(sa, o); sb += __shfl_xor(sb, o); }
            const float ia = rsqrtf(sa * (1.f / 1024.f) + 1e-6f), ib = rsqrtf(sb * (1.f / 1024.f) + 1e-6f);
#pragma unroll
            for (int j = 0; j < 4; ++j) { const f32x4 gg = gr[64 * j]; xa[64 * j] = (f32x4){va[j].x * ia * gg.x, va[j].y * ia * gg.y, va[j].z * ia * gg.z, va[j].w * ia * gg.w}; xb[64 * j] = (f32x4){vb[j].x * ib * gg.x, vb[j].y * ib * gg.y, vb[j].z * ib * gg.z, vb[j].w * ib * gg.w}; }
        }
    }
    if (PROBE_T >= 0 && blockIdx.x == 0 && xb_first(wv0_)) { STAMP(); asm volatile("s_waitcnt vmcnt(0)" ::: "memory");
        const unsigned long long t0_ = ((unsigned long long)MISC[17 + 2 * PROBE_T] << 32) | MISC[16 + 2 * PROBE_T], t1_ = ((unsigned long long)MISC[19 + 2 * PROBE_T] << 32) | MISC[18 + 2 * PROBE_T];
        (*(float* const CAS*)((const CAS char*)__builtin_amdgcn_kernarg_segment_ptr() + 336))[0] = (float)(t1_ - t0_) * 0.01f; }
#undef IN
#undef SEAM
}

extern "C" void kernel_launch(void* const* d_in, const int* in_sizes, int n_in, void* d_out, int out_size, void* d_ws, size_t ws_size, hipStream_t stream) {
    static int grid = 0;
    if (grid == 0) {
        if (n_in != 42 || out_size != M * DM || ws_size < WS_END) { fprintf(stderr, "kernel_launch: unexpected shapes (n_in %d out %d ws %zu)\n", n_in, out_size, ws_size); grid = -1; return; }
        int dev = 0, cus = 0, per_cu = 0;
        if (hipGetDevice(&dev) != hipSuccess || hipDeviceGetAttribute(&cus, hipDeviceAttributeMultiprocessorCount, dev) != hipSuccess) { grid = -1; return; }
        if (hipFuncSetAttribute((const void*)mk_fwd, hipFuncAttributeMaxDynamicSharedMemorySize, LDS_BYTES) != hipSuccess) { fprintf(stderr, "kernel_launch: hipFuncSetAttribute failed\n"); grid = -1; return; }
        if (hipOccupancyMaxActiveBlocksPerMultiprocessor(&per_cu, (const void*)mk_fwd, NTHR, LDS_BYTES) != hipSuccess || per_cu < 1) fprintf(stderr, "kernel_launch: occupancy query says %d\n", per_cu);
        (void)hipGetLastError();
        grid = cus > 256 ? 256 : cus;
    }
    if (grid < 0) return;
    (void)hipMemsetAsync((char*)d_ws + WS_CTL, 0, CTL_ZERO_BYTES, stream);
    Args a{};
    for (int i = 0; i < 42; ++i) a.in[i] = (const float*)d_in[i];
    a.out = (float*)d_out; a.ws = (unsigned char*)d_ws;
#if MK_PER_PHASE
    for (int ph = 0; ph < NPH; ++ph) { a.ph_lo = ph; a.ph_hi = ph + 1; hipLaunchKernelGGL(mk_fwd, dim3(grid), dim3(NTHR), LDS_BYTES, stream, a); }
#else
#ifdef PROBE_PREFIX
    a.ph_lo = 0; a.ph_hi = PROBE_PREFIX;
    hipLaunchKernelGGL(mk_fwd, dim3(grid), dim3(NTHR), LDS_BYTES, stream, a);
    (void)hipMemsetAsync((char*)d_ws + WS_CTL, 0, CTL_ZERO_BYTES, stream);
#endif
    a.ph_lo = 0; a.ph_hi = NPH;
    hipLaunchKernelGGL(mk_fwd, dim3(grid), dim3(NTHR), LDS_BYTES, stream, a);
#endif
}
```
